# Optimizing an MI355X kernel written in HIP

```python
import math
import jax, jax.numpy as jnp
from jax import lax
import numpy as np

D_MODEL = 1024
BATCH = 8
SEQ = 2048
DEPTH = 2

MEM_LEN = 256
EPS = 1e-6

SB_HEADS = 8
SB_HD = 64
SB_W = SB_HEADS * SB_HD
SB_BLOCK = 128

DN_HEADS = 4
DN_HD = 128
DN_W = DN_HEADS * DN_HD
DN_CONV = 4
DN_CHUNK = 64

RET_HEADS = 4
RET_QK_HD = 64
RET_V_HD = 128
RET_QK_W = RET_HEADS * RET_QK_HD
RET_V_W = RET_HEADS * RET_V_HD
RET_CHUNK = 128
ROPE_BASE = 10000.0

MEM_HEADS = 4
MEM_HD = 64
MEM_W = MEM_HEADS * MEM_HD

N_BRANCH = 4

IN_SPLITS = (SB_W, SB_W, SB_W, SB_W,
             DN_W, DN_W, DN_W, DN_W, DN_HEADS, DN_HEADS,
             RET_QK_W, RET_QK_W, RET_V_W, RET_V_W,
             MEM_W,
             N_BRANCH * D_MODEL)
IN_COLS = sum(IN_SPLITS)

kernel_name = "hybrid_gated_parallel_mixers"


def rmsnorm(x, g):
    xf = x.astype(jnp.float32)
    y = xf * lax.rsqrt(jnp.mean(xf * xf, axis=-1, keepdims=True) + EPS) * g.astype(jnp.float32)
    return y.astype(x.dtype)


def l2norm(x):
    return x * lax.rsqrt(jnp.sum(x * x, axis=-1, keepdims=True) + EPS)


def split_heads(t, n_heads):
    b, s, _ = t.shape
    return t.reshape(b, s, n_heads, -1).transpose(0, 2, 1, 3)


def merge_heads(t):
    b, h, s, d = t.shape
    return t.transpose(0, 2, 1, 3).reshape(b, s, h * d)


def stick_breaking_attention(q, k, v):
    s_len = q.shape[2]
    scale = SB_HD ** -0.5
    qf, kf, vf = q.astype(jnp.float32), k.astype(jnp.float32), v.astype(jnp.float32)
    outs = []
    for i in range(s_len // SB_BLOCK):
        q0, q1 = i * SB_BLOCK, (i + 1) * SB_BLOCK
        z = jnp.einsum('bhqd,bhkd->bhqk', qf[:, :, q0:q1], kf[:, :, :q1]) * scale
        t_idx = q0 + jnp.arange(SB_BLOCK)[:, None]
        s_idx = jnp.arange(q1)[None, :]
        causal = s_idx < t_idx
        log_stay = jnp.where(causal, jax.nn.log_sigmoid(-z), 0.0)
        after = lax.cumsum(log_stay, axis=3, reverse=True) - log_stay
        w = jnp.where(causal, jnp.exp(jax.nn.log_sigmoid(z) + after), 0.0)
        outs.append(jnp.einsum('bhqk,bhkd->bhqd', w, vf[:, :, :q1]))
    return jnp.concatenate(outs, axis=2).astype(q.dtype)


def causal_depthwise_conv(x, w):
    c = x.shape[-1]
    return lax.conv_general_dilated(
        x, w[:, None, :].astype(x.dtype), window_strides=(1,), padding=[(DN_CONV - 1, 0)],
        dimension_numbers=('NWC', 'WIO', 'NWC'), feature_group_count=c)


def gated_delta_rule(q, k, v, g, beta):
    out_dtype = v.dtype
    q, k, v = q.astype(jnp.float32), k.astype(jnp.float32), v.astype(jnp.float32)
    b, h, s_len, dk = q.shape
    dv = v.shape[-1]
    c = DN_CHUNK
    n = s_len // c
    q = q * dk ** -0.5

    def chunk(t):
        return t.reshape(b, h, n, c, *t.shape[3:])

    q, k, v, g, beta = chunk(q), chunk(k), chunk(v), chunk(g), chunk(beta)
    gc = jnp.cumsum(g, axis=-1)
    tril = jnp.tril(jnp.ones((c, c), bool))
    strict = jnp.tril(jnp.ones((c, c), bool), -1)
    decay = jnp.exp(jnp.where(tril, gc[..., :, None] - gc[..., None, :], -jnp.inf))
    k_beta = k * beta[..., None]
    v_beta = v * beta[..., None]
    lower = jnp.where(strict, jnp.einsum('bhncd,bhnmd->bhncm', k_beta, k) * decay, 0.0)
    eye = jnp.eye(c, dtype=jnp.float32)
    t_inv = lax.linalg.triangular_solve(eye + lower, jnp.broadcast_to(eye, lower.shape),
                                        left_side=True, lower=True, unit_diagonal=True)
    u = jnp.einsum('bhncm,bhnme->bhnce', t_inv, v_beta)
    w = jnp.einsum('bhncm,bhnmd->bhncd', t_inv, k_beta * jnp.exp(gc)[..., None])
    a_intra = jnp.where(tril, jnp.einsum('bhncd,bhnmd->bhncm', q, k) * decay, 0.0)

    def step(state, xs):
        q_c, k_c, u_c, w_c, a_c, g_c = xs
        v_new = u_c - jnp.einsum('bhcd,bhde->bhce', w_c, state)
        o = jnp.einsum('bhcd,bhde->bhce', q_c * jnp.exp(g_c)[..., None], state) \
            + jnp.einsum('bhcm,bhme->bhce', a_c, v_new)
        g_last = g_c[..., -1]
        state = state * jnp.exp(g_last)[..., None, None] + jnp.einsum(
            'bhcd,bhce->bhde', k_c * jnp.exp(g_last[..., None] - g_c)[..., None], v_new)
        return state, o

    xs = tuple(jnp.moveaxis(t, 2, 0) for t in (q, k, u, w, a_intra, gc))
    _, o = lax.scan(step, jnp.zeros((b, h, dk, dv), jnp.float32), xs)
    o = jnp.moveaxis(o, 0, 2).reshape(b, h, s_len, dv)
    return o.astype(out_dtype)


def rope(x, positions):
    half = x.shape[-1] // 2
    inv = ROPE_BASE ** (-jnp.arange(half, dtype=jnp.float32) / half)
    ang = positions[:, None, :, None].astype(jnp.float32) * inv
    cos, sin = jnp.cos(ang), jnp.sin(ang)
    xf = x.astype(jnp.float32)
    x1, x2 = xf[..., :half], xf[..., half:]
    return jnp.concatenate([x1 * cos - x2 * sin, x1 * sin + x2 * cos], axis=-1).astype(x.dtype)


def retention_chunkwise(q, k, v):
    out_dtype = v.dtype
    q, k, v = q.astype(jnp.float32), k.astype(jnp.float32), v.astype(jnp.float32)
    b, h, s_len, dk = q.shape
    dv = v.shape[-1]
    c = RET_CHUNK
    n = s_len // c
    k = k * dk ** -0.5
    log_gamma = jnp.log1p(-(2.0 ** (-5.0 - jnp.arange(h, dtype=jnp.float32))))
    idx = jnp.arange(c, dtype=jnp.float32)
    rel = idx[:, None] - idx[None, :]
    intra_decay = jnp.where(rel >= 0, jnp.exp(jnp.maximum(rel, 0.0) * log_gamma[:, None, None]), 0.0)
    cross_decay = jnp.exp((idx + 1.0) * log_gamma[:, None])
    state_decay = jnp.exp((c - 1.0 - idx) * log_gamma[:, None])
    chunk_decay = jnp.exp(c * log_gamma)

    def chunk(t):
        return jnp.moveaxis(t.reshape(b, h, n, c, t.shape[-1]), 2, 0)

    qc, kc, vc = chunk(q), chunk(k), chunk(v)
    scores = jnp.einsum('nbhcd,nbhmd->nbhcm', qc, kc) * intra_decay[None, None]
    o_intra = jnp.einsum('nbhcm,nbhme->nbhce', scores, vc)

    def step(state, xs):
        q_c, k_c, v_c = xs
        o_cross = jnp.einsum('bhcd,bhde->bhce', q_c, state) * cross_decay[None, :, :, None]
        state = state * chunk_decay[None, :, None, None] + jnp.einsum(
            'bhcd,bhce->bhde', k_c * state_decay[None, :, :, None], v_c)
        return state, o_cross

    _, o_cross = lax.scan(step, jnp.zeros((b, h, dk, dv), jnp.float32), (qc, kc, vc))
    o = jnp.moveaxis(o_intra + o_cross, 0, 2).reshape(b, h, s_len, dv)
    return o.astype(out_dtype)


def head_groupnorm(o, g):
    of = o.astype(jnp.float32)
    mu = jnp.mean(of, axis=-1, keepdims=True)
    var = jnp.mean(jnp.square(of - mu), axis=-1, keepdims=True)
    y = (of - mu) * lax.rsqrt(var + EPS) * g[None, :, None, :].astype(jnp.float32)
    return y.astype(o.dtype)


def memory_cross_attention(q, mem, mem_g, w_kv):
    mem_n = rmsnorm(mem, mem_g)
    kv = jnp.einsum('bmd,de->bme', mem_n, w_kv)
    km, vm = jnp.split(kv, 2, axis=-1)
    qh, kh, vh = split_heads(q, MEM_HEADS), split_heads(km, MEM_HEADS), split_heads(vm, MEM_HEADS)
    scores = jnp.einsum('bhsd,bhmd->bhsm', qh.astype(jnp.float32), kh.astype(jnp.float32)) * MEM_HD ** -0.5
    p = jax.nn.softmax(scores, axis=-1).astype(vh.dtype)
    return merge_heads(jnp.einsum('bhsm,bhmd->bhsd', p, vh))


def setup_inputs(seed: int = 0) -> dict:
    key = jax.random.key(seed)
    ks = jax.random.split(key, 24)
    f32 = jnp.float32

    def nrm(k, shape, scale):
        return jax.random.normal(k, shape, f32) * scale

    x = nrm(ks[0], (BATCH, SEQ, D_MODEL), 1.0)
    mem = nrm(ks[1], (BATCH, MEM_LEN, D_MODEL), 1.0)
    offset = jax.random.randint(ks[2], (BATCH, 1), 0, 4096, dtype=jnp.int32)
    positions = (offset + jnp.arange(SEQ, dtype=jnp.int32)[None, :]).astype(jnp.int32)

    norm_g = 1.0 + nrm(ks[3], (DEPTH, D_MODEL), 0.02)
    mem_norm_g = 1.0 + nrm(ks[4], (DEPTH, D_MODEL), 0.02)
    w_in = nrm(ks[5], (DEPTH, D_MODEL, IN_COLS), D_MODEL ** -0.5)
    b_gate = nrm(ks[6], (DEPTH, N_BRANCH * D_MODEL), 0.1)
    dn_conv_w = nrm(ks[7], (DEPTH, DN_CONV, 3 * DN_W), DN_CONV ** -0.5)
    dn_a_log = jnp.log(jax.random.uniform(ks[8], (DEPTH, DN_HEADS), f32, 1.0, 16.0))
    dt = jnp.exp(jax.random.uniform(ks[9], (DEPTH, DN_HEADS), f32, math.log(1e-3), math.log(1e-1)))
    dn_dt_bias = dt + jnp.log(-jnp.expm1(-dt))
    dn_norm_g = 1.0 + nrm(ks[10], (DEPTH, DN_HD), 0.02)
    ret_norm_g = 1.0 + nrm(ks[11], (DEPTH, RET_V_W), 0.02)
    w_mem_kv = nrm(ks[12], (DEPTH, D_MODEL, 2 * MEM_W), D_MODEL ** -0.5)
    w_br_sb = nrm(ks[13], (DEPTH, SB_W, D_MODEL), SB_W ** -0.5)
    w_br_dn = nrm(ks[14], (DEPTH, DN_W, D_MODEL), DN_W ** -0.5)
    w_br_ret = nrm(ks[15], (DEPTH, RET_V_W, D_MODEL), RET_V_W ** -0.5)
    w_br_mem = nrm(ks[16], (DEPTH, MEM_W, D_MODEL), MEM_W ** -0.5)
    w_out = nrm(ks[17], (DEPTH, D_MODEL, D_MODEL), D_MODEL ** -0.5)
    final_norm_g = 1.0 + nrm(ks[18], (D_MODEL,), 0.02)
    return {"x": x, "mem": mem, "positions": positions, "norm_g": norm_g,
            "mem_norm_g": mem_norm_g, "w_in": w_in, "b_gate": b_gate, "dn_conv_w": dn_conv_w,
            "dn_a_log": dn_a_log, "dn_dt_bias": dn_dt_bias, "dn_norm_g": dn_norm_g,
            "ret_norm_g": ret_norm_g, "w_mem_kv": w_mem_kv, "w_br_sb": w_br_sb,
            "w_br_dn": w_br_dn, "w_br_ret": w_br_ret, "w_br_mem": w_br_mem,
            "w_out": w_out, "final_norm_g": final_norm_g}


def reference(x, mem, positions, norm_g, mem_norm_g, w_in, b_gate, dn_conv_w, dn_a_log,
              dn_dt_bias, dn_norm_g, ret_norm_g, w_mem_kv, w_br_sb, w_br_dn, w_br_ret,
              w_br_mem, w_out, final_norm_g):
    b, s_len, _ = x.shape
    split_idx = np.cumsum(IN_SPLITS)[:-1].tolist()
    for l in range(DEPTH):
        h = rmsnorm(x, norm_g[l])
        proj = jnp.einsum('bsd,de->bse', h, w_in[l])
        (sb_q, sb_k, sb_v, sb_z,
         dn_q, dn_k, dn_v, dn_z, dn_a, dn_b,
         rt_q, rt_k, rt_v, rt_z,
         mem_q, gate_logits) = jnp.split(proj, split_idx, axis=-1)

        o_sb = stick_breaking_attention(split_heads(sb_q, SB_HEADS), split_heads(sb_k, SB_HEADS),
                                        split_heads(sb_v, SB_HEADS))
        o_sb = merge_heads(o_sb) * jax.nn.silu(sb_z)

        qkv = jax.nn.silu(causal_depthwise_conv(jnp.concatenate([dn_q, dn_k, dn_v], axis=-1), dn_conv_w[l]))
        cq, ck, cv = jnp.split(qkv, 3, axis=-1)
        cq = l2norm(split_heads(cq, DN_HEADS).astype(jnp.float32))
        ck = l2norm(split_heads(ck, DN_HEADS).astype(jnp.float32))
        cv = split_heads(cv, DN_HEADS)
        g_log = -jnp.exp(dn_a_log[l].astype(jnp.float32)) * jax.nn.softplus(
            dn_a.astype(jnp.float32) + dn_dt_bias[l].astype(jnp.float32))
        beta = jax.nn.sigmoid(dn_b.astype(jnp.float32))
        o_dn = gated_delta_rule(cq, ck, cv, g_log.transpose(0, 2, 1), beta.transpose(0, 2, 1))
        o_dn = merge_heads(rmsnorm(o_dn, dn_norm_g[l])) * jax.nn.silu(dn_z)

        rq = rope(split_heads(rt_q, RET_HEADS), positions)
        rk = rope(split_heads(rt_k, RET_HEADS), positions)
        o_rt = retention_chunkwise(rq, rk, split_heads(rt_v, RET_HEADS))
        o_rt = head_groupnorm(o_rt, ret_norm_g[l].reshape(RET_HEADS, RET_V_HD))
        o_rt = merge_heads(o_rt) * jax.nn.silu(rt_z)

        o_mem = memory_cross_attention(mem_q, mem, mem_norm_g[l], w_mem_kv[l])

        gates = jax.nn.sigmoid(gate_logits.astype(jnp.float32) + b_gate[l].astype(jnp.float32))
        gates = gates.reshape(b, s_len, N_BRANCH, D_MODEL).astype(x.dtype)
        merged = (gates[:, :, 0] * jnp.einsum('bsw,wd->bsd', o_sb, w_br_sb[l])
                  + gates[:, :, 1] * jnp.einsum('bsw,wd->bsd', o_dn, w_br_dn[l])
                  + gates[:, :, 2] * jnp.einsum('bsw,wd->bsd', o_rt, w_br_ret[l])
                  + gates[:, :, 3] * jnp.einsum('bsw,wd->bsd', o_mem, w_br_mem[l]))
        x = x + jnp.einsum('bsd,de->bse', merged, w_out[l])
    return rmsnorm(x, final_norm_g)
```

```cpp
#include <hip/hip_runtime.h>
#include <cstdio>
#include <cstdint>
#include <cmath>

#define LAS __attribute__((address_space(3)))
#define GAS __attribute__((address_space(1)))
#define DI __device__ __forceinline__
typedef unsigned short bf16_t;
typedef short bf16x8 __attribute__((ext_vector_type(8)));
typedef float f32x4 __attribute__((ext_vector_type(4)));
typedef unsigned u32x4 __attribute__((ext_vector_type(4)));
typedef unsigned u32x2 __attribute__((ext_vector_type(2)));

#ifndef MK_N_LAUNCHES
#define MK_N_LAUNCHES 1
#endif

constexpr int BATCH = 8, SEQ = 2048, D = 1024, T = BATCH * SEQ, DEPTH = 2, MEMLEN = 256;
constexpr int IN_COLS = 9992;
constexpr float EPS = 1e-6f;
constexpr int NPHASE = 14;

constexpr size_t MiB = 1u << 20;
constexpr size_t WS_CTL = 0, CTL_ZERO_BYTES = 1 * MiB;
constexpr size_t WS_WINA = 1 * MiB;
constexpr size_t WS_WINB = 13 * MiB;
constexpr size_t WS_WG = 25 * MiB;
constexpr size_t WS_WBR = 41 * MiB;
constexpr size_t WS_WOUT = 49 * MiB;
constexpr size_t WS_WKV = 53 * MiB;
constexpr size_t WS_XN = 55 * MiB;
constexpr size_t WS_P = 87 * MiB;
constexpr size_t WS_R = 127 * MiB;
constexpr size_t WS_DNI = 223 * MiB;
constexpr size_t WS_KVM = 295 * MiB;
constexpr size_t WS_ROPE = 299 * MiB;
constexpr size_t WS_AB = 303 * MiB;
constexpr size_t WS_GB = WS_AB + 512 * 1024;
constexpr size_t WS_SS = 304 * MiB;
constexpr size_t WS_END = 305 * MiB;
constexpr size_t WS_MEMN = WS_DNI;
constexpr int PLD = 1280, RALD = 1536, RBLD = 3072;
constexpr int P_DNZ = 0, P_MEMQ = 512, P_RTQ = 768, P_RTK = 1024;
constexpr int RB_SBQ = 0, RB_SBK = 512, RB_SBV = 1024, RB_SBZ = 1536, RB_RTV = 2048, RB_RTZ = 2560;
constexpr int RB_MERGED = 512;
constexpr int CW_BAR = 4096;

constexpr int RING_BYTES = 131072;
constexpr int LDSCTL_OFF = RING_BYTES, MISC_OFF = LDSCTL_OFF + 320, SPARE_OFF = LDSCTL_OFF + 1024;
constexpr int LDS_BYTES = 147456;
constexpr int NWAVES = 8, NTHREADS = 512;

DI unsigned f2bf(float f) { unsigned u = __builtin_bit_cast(unsigned, f); return (u + 0x7fffu + ((u >> 16) & 1u)) >> 16; }
DI unsigned pk2(float lo, float hi) { return f2bf(lo) | (f2bf(hi) << 16); }
DI float bf2f(unsigned short h) { return __builtin_bit_cast(float, (unsigned)h << 16); }
DI float bflo(unsigned w) { return __builtin_bit_cast(float, w << 16); }
DI float bfhi(unsigned w) { return __builtin_bit_cast(float, w & 0xffff0000u); }
DI float shx(float v, int m, int lane) { return __builtin_bit_cast(float, __builtin_amdgcn_ds_bpermute((lane ^ m) << 2, __builtin_bit_cast(int, v))); }
DI float wave_sum(float v, int lane) {
#pragma unroll
    for (int o = 1; o < 64; o <<= 1) v += shx(v, o, lane);
    return v;
}
DI float sigmoidf_(float x) { return 1.f / (1.f + __expf(-x)); }
DI float siluf_(float x) { return x / (1.f + __expf(-x)); }
DI int opaque_tid(int wv) { int lane; asm volatile("v_mbcnt_lo_u32_b32 %0, -1, 0\n\tv_mbcnt_hi_u32_b32 %0, -1, %0" : "=v"(lane)); return wv * 64 + lane; }
#define LDS_WAIT() asm volatile("s_waitcnt lgkmcnt(0)" ::: "memory")
#define VM_WAIT() asm volatile("s_waitcnt vmcnt(0)" ::: "memory")

#define XB_TMO      128
#define XB_XCNT(j)  (256  + 64 * (j))
#define XB_XSUB(j)  (1280 + 64 * (j))
#define XB_XGEN(j)  (2304 + 64 * (j))
#define XB_TOP      3328
#define XB_TOPGEN   3392
#define XCD_BAR_WORDS 3456
#define XB_SPIN_CAP (1u << 18)
DI unsigned xb_ld(unsigned* p)              { return __hip_atomic_load(p, __ATOMIC_RELAXED, __HIP_MEMORY_SCOPE_AGENT); }
DI unsigned xb_add(unsigned* p, unsigned v) { return __hip_atomic_fetch_add(p, v, __ATOMIC_RELAXED, __HIP_MEMORY_SCOPE_AGENT); }
DI unsigned xb_xcc_id() { return (unsigned)__builtin_amdgcn_s_getreg((3 << 11) | 20) & 0xFu; }
#define XB_SPIN(cond, bar) do { unsigned _sp = 0; while (cond) { __builtin_amdgcn_s_sleep(1); \
    if ((++_sp & 255u) == 0u) { if (xb_ld(&(bar)[XB_TMO])) break; if (_sp > XB_SPIN_CAP) { atomicAdd(&(bar)[XB_TMO], 1u); break; } } } } while (0)
struct XcdBarrier { unsigned* bar; unsigned x; volatile LAS unsigned* st; };
DI XcdBarrier xcd_barrier_post(unsigned* bar, volatile LAS unsigned* st, int wv) {
    XcdBarrier b; b.bar = bar; b.x = xb_xcc_id(); b.st = st;
    if (opaque_tid(wv) == 0) (void)xb_add(&bar[XB_XCNT(b.x)], 1u);
    return b;
}
DI void xcd_barrier_complete(unsigned* bar, unsigned x, unsigned& nloc, unsigned& nx) {
    const unsigned G = gridDim.x * gridDim.y * gridDim.z;
    unsigned sum, cnt, mine, sp = 0u;
    for (;;) {
        sum = 0u; cnt = 0u; mine = 0u;
#pragma unroll
        for (unsigned j = 0; j < 16; ++j) { const unsigned c = xb_ld(&bar[XB_XCNT(j)]); sum += c; cnt += (c > 0u) ? 1u : 0u; mine = (j == x) ? c : mine; }
        if (sum == G) break;
        __builtin_amdgcn_s_sleep(1);
        if ((++sp & 255u) == 0u) { if (xb_ld(&bar[XB_TMO])) break; if (sp > XB_SPIN_CAP) { atomicAdd(&bar[XB_TMO], 1u); break; } }
    }
    nloc = mine > 0u ? mine : 1u; nx = cnt > 0u ? cnt : 1u;
}
DI void xcd_barrier(const XcdBarrier& b, int wv) {
    asm volatile("s_waitcnt vmcnt(0)" ::: "memory");
    __syncthreads();
    if (opaque_tid(wv) == 0) {
        unsigned* bar = b.bar;
        __builtin_amdgcn_s_waitcnt(0);
        unsigned nloc = b.st[0], nx = b.st[1];
        if (nloc == 0u) { xcd_barrier_complete(bar, b.x, nloc, nx); b.st[0] = nloc; b.st[1] = nx; }
        const unsigned old = xb_add(&bar[XB_XSUB(b.x)], 1u);
        const unsigned gen = old / nloc;
        if (old + 1u == (gen + 1u) * nloc) {
            __builtin_amdgcn_fence(__ATOMIC_RELEASE, "agent");
            asm volatile("s_waitcnt vmcnt(0)" ::: "memory");
            const unsigned og = xb_add(&bar[XB_TOP], 1u);
            const unsigned tg = og / nx;
            if (og + 1u == (tg + 1u) * nx) xb_add(&bar[XB_TOPGEN], 1u);
            else XB_SPIN(xb_ld(&bar[XB_TOPGEN]) == tg, bar);
            __builtin_amdgcn_fence(__ATOMIC_ACQUIRE, "agent");
            xb_add(&bar[XB_XGEN(b.x)], 1u);
            asm volatile("s_waitcnt vmcnt(0)" ::: "memory");
        } else {
            XB_SPIN(xb_ld(&bar[XB_XGEN(b.x)]) == gen, bar);
            __builtin_amdgcn_fence(__ATOMIC_ACQUIRE, "agent");
            asm volatile("s_waitcnt vmcnt(0)" ::: "memory");
        }
    }
    __syncthreads();
}

namespace gm {
constexpr int BM = 256, BK = 64, HALF = 128, HTB = HALF * BK * 2, STAGE_BYTES = 8 * HTB;
DI int lds_byte(int r, int c) { const int st = (r >> 4) * 2 + (c >> 5), rr = r & 15, cc = c & 31, ob = rr * 64 + cc * 2; return st * 1024 + (ob ^ (((ob >> 9) & 1) << 5)); }
DI void stage_rc(int b, int& R, int& C) { const int st = b / 1024, sb = b % 1024, swz = sb ^ (((sb >> 9) & 1) << 5); R = (st >> 1) * 16 + swz / 64; C = (st & 1) * 32 + (swz % 64) / 2; }
DI int perm32(int rho) { const int n = rho >> 4, i = rho & 15; return 8 * (i >> 2) + 4 * n + (i & 3); }

enum Kind { K_STORE = 0, K_AB = 1, K_GATE = 2, K_BRANCH = 3, K_OUT = 4 };
struct Unit {
    const bf16_t* A; const bf16_t* B;
    int lda, ldb, K, pm, pn, kind, sub, l;
};
struct TileOrder {
    int nM, nN, nwg, G, c;
    DI void init(int nM_, int nN_, int G_, int c_) { nM = nM_; nN = nN_; nwg = nM * nN; G = G_; c = c_; }
    DI bool tile(int i, int& pm, int& pn) const {
        const long L = (long)i * G + c; if (L >= nwg) return false;
        int wgid = (int)L; { const int q = nwg / 8, r = nwg % 8, xcd = wgid % 8, off = wgid / 8; wgid = (xcd < r ? xcd * (q + 1) : r * (q + 1) + (xcd - r) * q) + off; }
        const int WGM = 8, nig = WGM * nN, gid = wgid / nig, fm = gid * WGM, gsz = (nM - fm) < WGM ? (nM - fm) : WGM;
        pm = __builtin_amdgcn_readfirstlane(fm + ((wgid % nig) % gsz)); pn = __builtin_amdgcn_readfirstlane((wgid % nig) / gsz); return true;
    }
};

template <class Sched, class Epi>
DI void gemm_phase(LAS unsigned char* lds, int wv, const Sched& S, const Epi& E) {
    const int tid = opaque_tid(wv), wid = __builtin_amdgcn_readfirstlane(tid >> 6), lane = tid & 63, wr = wid >> 2, wc = wid & 3, fr = lane & 15, fq = lane >> 4;
    int R0_, C0_; stage_rc(tid * 16, R0_, C0_);
    const unsigned R0 = 2u * (unsigned)R0_, C2 = 2u * (unsigned)C0_;
    const unsigned RbP = 2u * (unsigned)((R0_ & ~31) + perm32(R0_ & 31));
    const unsigned ldsw = (unsigned)wid * 1024u;
    const int aoff = lds_byte(wr * 64 + fr, fq * 8), boff = lds_byte(wc * 32 + fr, fq * 8);
#define GM_SA(b, h) (((b) * 2 + (h)) * HTB)
#define GM_SB(b, h) ((4 + (b) * 2 + (h)) * HTB)
#define GM_STAGE(bufoff, gbase, ld, R2) do { const unsigned _v = (unsigned)(R2) * (unsigned)(ld) + C2; \
        __builtin_amdgcn_global_load_lds((const unsigned*)((const char*)(gbase) + _v), (LAS unsigned*)(lds + (bufoff) + ldsw), 16, 0, 0); \
        __builtin_amdgcn_global_load_lds((const unsigned*)((const char*)(gbase) + (_v + (unsigned)(ld) * 128u)), (LAS unsigned*)(lds + (bufoff) + ldsw + 8192), 16, 0, 0); } while (0)
#define GM_LDA(dst, b, h) do { _Pragma("unroll") for (int m = 0; m < 4; ++m) _Pragma("unroll") for (int k = 0; k < 2; ++k) dst[m][k] = *(const LAS bf16x8*)(lds + GM_SA(b, h) + aoff + m * 2048 + k * 1024); } while (0)
#define GM_LDB(dst, b, h) do { _Pragma("unroll") for (int n = 0; n < 2; ++n) _Pragma("unroll") for (int k = 0; k < 2; ++k) dst[n][k] = *(const LAS bf16x8*)(lds + GM_SB(b, h) + boff + n * 2048 + k * 1024); } while (0)
#define GM_MMA(ai, bj, At, Bt) do { __builtin_amdgcn_s_setprio(1); _Pragma("unroll") for (int m = 0; m < 4; ++m) _Pragma("unroll") for (int n = 0; n < 2; ++n) _Pragma("unroll") for (int k = 0; k < 2; ++k) \
        acc[ai][bj][m][n] = __builtin_amdgcn_mfma_f32_16x16x32_bf16(Bt[n][k], At[m][k], acc[ai][bj][m][n], 0, 0, 0); __builtin_amdgcn_s_setprio(0); } while (0)
#define GM_WAIT_V(n) asm volatile("s_waitcnt vmcnt(" #n ")" ::: "memory")
#define GM_WAIT_L(n) asm volatile("s_waitcnt lgkmcnt(" #n ")" ::: "memory")
#define GM_BAR __builtin_amdgcn_s_barrier()
#define GM_SCHED __builtin_amdgcn_sched_barrier(0)
    Unit cur, nxt; int ui = 0;
    if (!S.next(0, cur)) return;
    f32x4 acc[2][2][4][2];
#pragma unroll
    for (int a = 0; a < 2; ++a)
#pragma unroll
        for (int b = 0; b < 2; ++b)
#pragma unroll
            for (int m = 0; m < 4; ++m)
#pragma unroll
                for (int n = 0; n < 2; ++n) acc[a][b][m][n] = (f32x4){0.f, 0.f, 0.f, 0.f};
    bf16x8 At[4][2], B0[2][2], B1[2][2];
    const char* cA = (const char*)cur.A; const char* cB = (const char*)cur.B; int clda = cur.lda, cldb = cur.ldb;
    GM_STAGE(GM_SB(0, 0), cB, cldb, RbP); GM_STAGE(GM_SB(0, 1), cB + (size_t)cldb * 256, cldb, RbP); GM_STAGE(GM_SA(0, 0), cA, clda, R0); GM_STAGE(GM_SA(0, 1), cA + (size_t)clda * 256, clda, R0);
    if (wr == 1) GM_BAR;
    GM_WAIT_V(2); GM_BAR;
    GM_STAGE(GM_SB(1, 0), cB + 128, cldb, RbP); GM_STAGE(GM_SA(1, 0), cA + 128, clda, R0); GM_STAGE(GM_SB(1, 1), cB + (size_t)cldb * 256 + 128, cldb, RbP);
    GM_WAIT_V(6); GM_BAR;
    for (;;) {
        const bool has_next = S.next(ui + 1, nxt);
        const char* nA = has_next ? (const char*)nxt.A : cA; const char* nB = has_next ? (const char*)nxt.B : cB;
        const int nlda = has_next ? nxt.lda : clda, nldb = has_next ? nxt.ldb : cldb;
        const int nt = cur.K / BK;
        for (int t = 0; t < nt; t += 2) {
            const bool last = (t == nt - 2);
            const char* a1 = cA + (size_t)(t + 1) * 128;
            const char* a2 = last ? nA : cA + (size_t)(t + 2) * 128; const char* b2 = last ? nB : cB + (size_t)(t + 2) * 128;
            const int lda2 = last ? nlda : clda, ldb2 = last ? nldb : cldb;
            const char* a3 = a2 + 128; const char* b3 = b2 + 128;
            GM_LDB(B0, 0, 0); GM_LDB(B1, 0, 1); GM_SCHED; GM_LDA(At, 0, 0); GM_STAGE(GM_SA(1, 1), a1 + (size_t)clda * 256, clda, R0);
            GM_WAIT_V(8); GM_WAIT_L(0); GM_BAR; GM_MMA(0, 0, At, B0); GM_MMA(0, 1, At, B1); GM_BAR; GM_SCHED;
            GM_LDA(At, 0, 1); GM_STAGE(GM_SB(0, 0), b2, ldb2, RbP); GM_STAGE(GM_SB(0, 1), b2 + (size_t)ldb2 * 256, ldb2, RbP); GM_STAGE(GM_SA(0, 0), a2, lda2, R0);
            GM_WAIT_V(8); GM_WAIT_L(0); GM_BAR; GM_MMA(1, 0, At, B0); GM_MMA(1, 1, At, B1); GM_BAR; GM_SCHED;
            GM_LDB(B0, 1, 0); GM_LDB(B1, 1, 1); GM_SCHED; GM_LDA(At, 1, 0); GM_STAGE(GM_SA(0, 1), a2 + (size_t)lda2 * 256, lda2, R0);
            GM_WAIT_V(8); GM_WAIT_L(0); GM_BAR; GM_MMA(0, 0, At, B0); GM_MMA(0, 1, At, B1); GM_BAR; GM_SCHED;
            GM_LDA(At, 1, 1); GM_STAGE(GM_SB(1, 0), b3, ldb2, RbP); GM_STAGE(GM_SB(1, 1), b3 + (size_t)ldb2 * 256, ldb2, RbP); GM_STAGE(GM_SA(1, 0), a3, lda2, R0);
            GM_WAIT_V(8); GM_WAIT_L(0); GM_BAR; GM_MMA(1, 0, At, B0); GM_MMA(1, 1, At, B1); GM_BAR; GM_SCHED;
        }
        if (wr == 0) GM_BAR;
        E(acc, cur, wr, wc, fr, fq, lane);
        if (!has_next) break;
#pragma unroll
        for (int a = 0; a < 2; ++a)
#pragma unroll
            for (int b = 0; b < 2; ++b)
#pragma unroll
                for (int m = 0; m < 4; ++m)
#pragma unroll
                    for (int n = 0; n < 2; ++n) acc[a][b][m][n] = (f32x4){0.f, 0.f, 0.f, 0.f};
        cur = nxt; cA = nA; cB = nB; clda = nlda; cldb = nldb; ++ui;
        if (wr == 1) GM_BAR;
    }
    GM_WAIT_V(0);
    GM_BAR;
#undef GM_SA
#undef GM_SB
#undef GM_STAGE
#undef GM_LDA
#undef GM_LDB
#undef GM_MMA
#undef GM_WAIT_V
#undef GM_WAIT_L
#undef GM_BAR
#undef GM_SCHED
}

struct Epi {
    unsigned char* ws;
    const float* xin; float* xout;
    const float* b_gate;
    const float* gnext;
    LAS float* spare;
    DI float row_scale(int row) const { const f32x4 s = *(const f32x4*)((const float*)(ws + WS_SS) + (size_t)row * 4); return rsqrtf(((s.x + s.y) + (s.z + s.w)) * (1.0f / 1024.0f) + EPS); }
    DI bf16_t* scratch_tile(int pm, int pn) const { return (bf16_t*)(ws + WS_R) + (size_t)pm * 256 * RBLD + (pn < 2 ? RB_SBZ + pn * 256 : RB_RTZ + (pn - 2) * 256); }
    DI void operator()(f32x4 (&acc)[2][2][4][2], const Unit& u, int wr, int wc, int fr, int fq, int lane) const {
        int rl0 = wr * 64 + fr, cl0 = wc * 32 + 8 * fq;
        asm volatile("" : "+v"(rl0), "+v"(cl0));
        if (u.kind == K_STORE) {
            bf16_t* base; int ldc; bool scale = true;
            if (u.sub == 0) {
                if (u.pn < 6) { base = (bf16_t*)(ws + WS_R) + (size_t)u.pm * 256 * RALD + u.pn * 256; ldc = RALD; }
                else { const int pc = u.pn < 8 ? (u.pn - 6) * 256 : (u.pn - 7) * 256; base = (bf16_t*)(ws + WS_P) + (size_t)u.pm * 256 * PLD + pc; ldc = PLD; }
            } else if (u.sub == 1) { base = (bf16_t*)(ws + WS_R) + (size_t)u.pm * 256 * RBLD + u.pn * 256; ldc = RBLD; }
            else { base = (bf16_t*)(ws + WS_KVM) + ((size_t)u.l * 2048 + u.pm * 256) * 512 + u.pn * 256; ldc = 512; scale = false; }
#pragma unroll
            for (int ai = 0; ai < 2; ++ai)
#pragma unroll
                for (int m = 0; m < 4; ++m) {
                    const int rl = rl0 + ai * HALF + m * 16;
                    const float sc = scale ? row_scale(u.pm * BM + rl) : 1.0f;
                    bf16_t* rowp = base + (size_t)rl * ldc + cl0;
#pragma unroll
                    for (int bj = 0; bj < 2; ++bj) { const f32x4 v0 = acc[ai][bj][m][0] * sc, v1 = acc[ai][bj][m][1] * sc;
                        u32x4 w; w.x = pk2(v0[0], v0[1]); w.y = pk2(v0[2], v0[3]); w.z = pk2(v1[0], v1[1]); w.w = pk2(v1[2], v1[3]);
                        *(u32x4*)(rowp + bj * HALF) = w; }
                }
        } else if (u.kind == K_AB) {
            if (wc == 0 && fq == 0) {
                float* base = (float*)(ws + WS_AB) + (size_t)u.pm * 256 * 8;
#pragma unroll
                for (int ai = 0; ai < 2; ++ai)
#pragma unroll
                    for (int m = 0; m < 4; ++m) {
                        const int rl = rl0 + ai * HALF + m * 16;
                        const float sc = row_scale(u.pm * BM + rl);
                        float* rowp = base + (size_t)rl * 8;
                        *(f32x4*)(rowp) = acc[ai][0][m][0] * sc; *(f32x4*)(rowp + 4) = acc[ai][0][m][1] * sc;
                    }
            }
        } else if (u.kind == K_GATE) {
            bf16_t* base = scratch_tile(u.pm, u.pn);
            const float* bias = b_gate + (size_t)u.l * 4096 + u.sub * 1024 + u.pn * 256;
            f32x4 bv[2][2];
#pragma unroll
            for (int bj = 0; bj < 2; ++bj)
#pragma unroll
                for (int n = 0; n < 2; ++n) bv[bj][n] = *(const f32x4*)(bias + cl0 + bj * HALF + 4 * n);
#pragma unroll
            for (int ai = 0; ai < 2; ++ai)
#pragma unroll
                for (int m = 0; m < 4; ++m) {
                    const int rl = rl0 + ai * HALF + m * 16;
                    const float sc = row_scale(u.pm * BM + rl);
                    bf16_t* rowp = base + (size_t)rl * RBLD + cl0;
#pragma unroll
                    for (int bj = 0; bj < 2; ++bj) { f32x4 v0 = acc[ai][bj][m][0] * sc + bv[bj][0], v1 = acc[ai][bj][m][1] * sc + bv[bj][1];
#pragma unroll
                        for (int j = 0; j < 4; ++j) { v0[j] = sigmoidf_(v0[j]); v1[j] = sigmoidf_(v1[j]); }
                        u32x4 w; w.x = pk2(v0[0], v0[1]); w.y = pk2(v0[2], v0[3]); w.z = pk2(v1[0], v1[1]); w.w = pk2(v1[2], v1[3]);
                        *(u32x4*)(rowp + bj * HALF) = w; }
                }
        } else if (u.kind == K_BRANCH) {
            bf16_t* base = (bf16_t*)(ws + WS_R) + (size_t)u.pm * 256 * RBLD + RB_MERGED + u.pn * 256; const bf16_t* gbase = scratch_tile(u.pm, u.pn);
            const bool first = (u.sub == 0);
#pragma unroll
            for (int ai = 0; ai < 2; ++ai)
#pragma unroll
                for (int m = 0; m < 4; ++m) {
                    const int rl = rl0 + ai * HALF + m * 16;
                    bf16_t* rowp = base + (size_t)rl * RBLD + cl0; const bf16_t* growp = gbase + (size_t)rl * RBLD + cl0;
#pragma unroll
                    for (int bj = 0; bj < 2; ++bj) {
                        const u32x4 g = *(const u32x4*)(growp + bj * HALF);
                        u32x4 t = (u32x4){0u, 0u, 0u, 0u}; if (!first) t = *(const u32x4*)(rowp + bj * HALF);
                        const f32x4 v0 = acc[ai][bj][m][0], v1 = acc[ai][bj][m][1];
                        u32x4 w;
                        w.x = pk2(bflo(t.x) + bflo(g.x) * v0[0], bfhi(t.x) + bfhi(g.x) * v0[1]);
                        w.y = pk2(bflo(t.y) + bflo(g.y) * v0[2], bfhi(t.y) + bfhi(g.y) * v0[3]);
                        w.z = pk2(bflo(t.z) + bflo(g.z) * v1[0], bfhi(t.z) + bfhi(g.z) * v1[1]);
                        w.w = pk2(bflo(t.w) + bflo(g.w) * v1[2], bfhi(t.w) + bfhi(g.w) * v1[3]);
                        *(u32x4*)(rowp + bj * HALF) = w; }
                    asm volatile("" ::: "memory");
                }
        } else {
            bf16_t* base = (bf16_t*)(ws + WS_XN) + (size_t)u.pm * 256 * 1024 + u.pn * 256;
            const bool wxn = gnext != nullptr;
#pragma unroll
            for (int ai = 0; ai < 2; ++ai)
#pragma unroll
                for (int m = 0; m < 4; ++m) {
                    const int rl = rl0 + ai * HALF + m * 16;
                    const size_t goff = (size_t)(u.pm * BM + rl) * D + u.pn * BM + cl0;
                    float sq = 0.f;
#pragma unroll
                    for (int bj = 0; bj < 2; ++bj) {
                        const f32x4 x0 = *(const f32x4*)(xin + goff + bj * HALF), x1 = *(const f32x4*)(xin + goff + bj * HALF + 4);
                        const f32x4 v0 = acc[ai][bj][m][0] + x0, v1 = acc[ai][bj][m][1] + x1;
                        *(f32x4*)(xout + goff + bj * HALF) = v0; *(f32x4*)(xout + goff + bj * HALF + 4) = v1;
                        sq += (v0[0] * v0[0] + v0[1] * v0[1]) + (v0[2] * v0[2] + v0[3] * v0[3]) + (v1[0] * v1[0] + v1[1] * v1[1]) + (v1[2] * v1[2] + v1[3] * v1[3]);
                        if (wxn) { const f32x4 g0 = *(const f32x4*)(gnext + u.pn * BM + cl0 + bj * HALF), g1 = *(const f32x4*)(gnext + u.pn * BM + cl0 + bj * HALF + 4);
                            const f32x4 a = v0 * g0, b = v1 * g1;
                            u32x4 w; w.x = pk2(a[0], a[1]); w.y = pk2(a[2], a[3]); w.z = pk2(b[0], b[1]); w.w = pk2(b[2], b[3]);
                            *(u32x4*)(base + (size_t)rl * 1024 + cl0 + bj * HALF) = w; }
                    }
                    sq += shx(sq, 16, lane); sq += shx(sq, 32, lane);
                    if (fq == 0) spare[rl * 4 + wc] = sq;
                    asm volatile("" ::: "memory");
                }
            LDS_WAIT(); __builtin_amdgcn_s_barrier(); asm volatile("" ::: "memory");
            { const int t_ = wr * 256 + wc * 64 + lane; if (t_ < 256) { const int rl = t_; const f32x4 p = *(const LAS f32x4*)(spare + rl * 4);
                ((float*)(ws + WS_SS))[(size_t)(u.pm * BM + rl) * 4 + u.pn] = (p.x + p.y) + (p.z + p.w); } }
        }
    }
};
}

struct Args {
    const float* x; const float* mem; const int* positions; const float* norm_g; const float* mem_norm_g; const float* w_in; const float* b_gate;
    const float* dn_conv_w; const float* dn_a_log; const float* dn_dt_bias; const float* dn_norm_g; const float* ret_norm_g; const float* w_mem_kv;
    const float* w_br_sb; const float* w_br_dn; const float* w_br_ret; const float* w_br_mem; const float* w_out; const float* final_norm_g;
    float* out; unsigned char* ws; int ph_lo, ph_hi, li, pad;
};
struct Frame { LAS unsigned char* lds; int tid, lane, wave, G, gw, NGW; };
DI Frame mkframe(int wv) {
    extern __shared__ __attribute__((aligned(16))) unsigned char lds_raw[];
    Frame F; F.lds = (LAS unsigned char*)lds_raw; F.tid = opaque_tid(wv); F.lane = F.tid & 63; F.wave = wv;
    F.G = gridDim.x; F.gw = blockIdx.x * NWAVES + F.wave; F.NGW = F.G * NWAVES; return F;
}
typedef const __attribute__((address_space(4))) Args* ArgsP;
DI ArgsP kargs() { unsigned long long p = (unsigned long long)__builtin_amdgcn_kernarg_segment_ptr(); asm volatile("" : "+s"(p)); return (ArgsP)p; }

DI void transpose_seg(const Frame& F, const float* W, int K, int Nsrc, int c0, int ncols, bf16_t* WT, int r0) {
    LAS float* scr = (LAS float*)(F.lds + F.wave * 16384);
    const int nblk = ncols / 32, nitems = (K / 64) * nblk, lane = F.lane;
    for (int item = F.gw; item < nitems; item += F.NGW) {
        const int kb = item / nblk, nb = item % nblk, k0 = 64 * kb, n0 = 32 * nb;
#pragma unroll 8
        for (int i = 0; i < 32; ++i) { const int kk = 2 * i + (lane >> 5); scr[kk * 33 + (lane & 31)] = W[(size_t)(k0 + kk) * Nsrc + c0 + n0 + (lane & 31)]; }
        LDS_WAIT(); asm volatile("" ::: "memory");
        const int c = lane & 7;
#pragma unroll
        for (int j = 0; j < 4; ++j) { const int n = (lane >> 3) + 8 * j; const LAS float* s = scr + (8 * c) * 33 + n;
            u32x4 o; o.x = pk2(s[0 * 33], s[1 * 33]); o.y = pk2(s[2 * 33], s[3 * 33]); o.z = pk2(s[4 * 33], s[5 * 33]); o.w = pk2(s[6 * 33], s[7 * 33]);
            *(u32x4*)(WT + (size_t)(r0 + n0 + n) * K + k0 + 8 * c) = o; }
        LDS_WAIT(); asm volatile("" ::: "memory");
    }
}
DI void p0_prologue(int wv) {
    const Frame F = mkframe(wv);
    const ArgsP ap = kargs();
    unsigned char* ws = ap->ws;
    for (int l = 0; l < DEPTH; ++l) {
        const float* win = ap->w_in + (size_t)l * D * IN_COLS;
        bf16_t* wa = (bf16_t*)(ws + WS_WINA) + (size_t)l * 3072 * 1024; bf16_t* wb = (bf16_t*)(ws + WS_WINB) + (size_t)l * 3072 * 1024;
        bf16_t* wg = (bf16_t*)(ws + WS_WG) + (size_t)l * 4096 * 1024; bf16_t* wbr = (bf16_t*)(ws + WS_WBR) + (size_t)l * 2 * 1024 * 1024;
        transpose_seg(F, win, 1024, IN_COLS, 2048, 2048, wa, 0);
        transpose_seg(F, win, 1024, IN_COLS, 5640, 256, wa, 2304);
        transpose_seg(F, win, 1024, IN_COLS, 4104, 256, wa, 2560);
        transpose_seg(F, win, 1024, IN_COLS, 4360, 256, wa, 2816);
        transpose_seg(F, win, 1024, IN_COLS, 0, 2048, wb, 0);
        transpose_seg(F, win, 1024, IN_COLS, 4616, 512, wb, 2048);
        transpose_seg(F, win, 1024, IN_COLS, 5128, 512, wb, 2560);
        transpose_seg(F, win, 1024, IN_COLS, 5896, 4096, wg, 0);
        transpose_seg(F, ap->w_br_sb + (size_t)l * 512 * 1024, 512, 1024, 0, 1024, wbr, 0);
        transpose_seg(F, ap->w_br_dn + (size_t)l * 512 * 1024, 512, 1024, 0, 1024, wbr + 1024 * 512, 0);
        transpose_seg(F, ap->w_br_ret + (size_t)l * 512 * 1024, 512, 1024, 0, 1024, wbr + 2 * 1024 * 512, 0);
        transpose_seg(F, ap->w_br_mem + (size_t)l * 256 * 1024, 256, 1024, 0, 1024, wbr + 3 * 1024 * 512, 0);
        transpose_seg(F, ap->w_out + (size_t)l * 1024 * 1024, 1024, 1024, 0, 1024, (bf16_t*)(ws + WS_WOUT) + (size_t)l * 1024 * 1024, 0);
        transpose_seg(F, ap->w_mem_kv + (size_t)l * 1024 * 512, 1024, 512, 0, 512, (bf16_t*)(ws + WS_WKV) + (size_t)l * 512 * 1024, 0);
        for (int i = F.gw * 64 + F.lane; i < 256 * 1024; i += F.NGW * 64) { const int r = i >> 10, k = i & 1023;
            wa[(size_t)(2048 + r) * 1024 + k] = r < 8 ? (bf16_t)f2bf(win[(size_t)k * IN_COLS + 4096 + r]) : (bf16_t)0; }
    }
    for (int m = F.gw; m < T; m += F.NGW) {
        const f32x4* xr = (const f32x4*)(ap->x + (size_t)m * D) + F.lane; const f32x4* gr = (const f32x4*)ap->norm_g + F.lane;
        unsigned long long* o8 = (unsigned long long*)((bf16_t*)(ws + WS_XN) + (size_t)m * D) + F.lane; float s = 0.f;
#pragma unroll
        for (int j = 0; j < 4; ++j) { const f32x4 v = xr[64 * j], g = gr[64 * j]; s += (v.x * v.x + v.y * v.y) + (v.z * v.z + v.w * v.w);
            o8[64 * j] = (unsigned long long)pk2(v.x * g.x, v.y * g.y) | ((unsigned long long)pk2(v.z * g.z, v.w * g.w) << 32); }
        s = wave_sum(s, F.lane);
        if (F.lane == 0) *(f32x4*)((float*)(ws + WS_SS) + (size_t)m * 4) = (f32x4){s, 0.f, 0.f, 0.f};
    }
    for (int it = F.gw; it < DEPTH * BATCH * MEMLEN; it += F.NGW) {
        const int l = it / (BATCH * MEMLEN), m = it % (BATCH * MEMLEN);
        const f32x4* xr = (const f32x4*)(ap->mem + (size_t)m * D) + F.lane; const f32x4* gr = (const f32x4*)(ap->mem_norm_g + (size_t)l * D) + F.lane;
        f32x4 v[4]; float s = 0.f;
#pragma unroll
        for (int j = 0; j < 4; ++j) { v[j] = xr[64 * j]; s += (v[j].x * v[j].x + v[j].y * v[j].y) + (v[j].z * v[j].z + v[j].w * v[j].w); }
        const float rs = rsqrtf(wave_sum(s, F.lane) * (1.f / D) + EPS);
        unsigned long long* o8 = (unsigned long long*)((bf16_t*)(ws + WS_MEMN) + ((size_t)l * BATCH * MEMLEN + m) * D) + F.lane;
#pragma unroll
        for (int j = 0; j < 4; ++j) { const f32x4 g = gr[64 * j];
            o8[64 * j] = (unsigned long long)pk2(v[j].x * rs * g.x, v[j].y * rs * g.y) | ((unsigned long long)pk2(v[j].z * rs * g.z, v[j].w * rs * g.w) << 32); }
    }
    for (int i = F.gw * 64 + F.lane; i < T * 32; i += F.NGW * 64) {
        const int t = i >> 5, f = i & 31;
        const float inv = (float)pow(10000.0, -(double)f / 32.0);
        const float ang = (float)ap->positions[t] * inv;
        ((float*)(ws + WS_ROPE))[i] = (float)cos((double)ang); ((float*)(ws + WS_ROPE))[T * 32 + i] = (float)sin((double)ang);
    }
}

struct SchedP1 {
    gm::TileOrder ord; unsigned char* ws; int l, half, c; bool with_kvm;
    DI bool next(int i, gm::Unit& u) const {
        int pm, pn;
        if (ord.tile(i, pm, pn)) {
            u.A = (const bf16_t*)(ws + WS_XN) + (size_t)pm * 256 * 1024; u.lda = 1024; u.K = 1024; u.ldb = 1024; u.pm = pm; u.pn = pn; u.kind = (half == 0 && pn == 8) ? gm::K_AB : gm::K_STORE; u.sub = half; u.l = l;
            u.B = (const bf16_t*)(ws + (half == 0 ? WS_WINA : WS_WINB)) + ((size_t)l * 3072 + pn * 256) * 1024;
            return true;
        }
        if (with_kvm && c < 32 && i == (ord.nwg + ord.G - 1 - c) / ord.G) {
            const int ll = c >> 4, pm2 = (c >> 1) & 7, pn2 = c & 1;
            u.A = (const bf16_t*)(ws + WS_MEMN) + ((size_t)ll * 2048 + pm2 * 256) * 1024; u.lda = 1024; u.K = 1024; u.ldb = 1024;
            u.B = (const bf16_t*)(ws + WS_WKV) + ((size_t)ll * 512 + pn2 * 256) * 1024;
            u.pm = pm2; u.pn = pn2; u.kind = gm::K_STORE; u.sub = 2; u.l = ll;
            return true;
        }
        return false;
    }
};
struct SchedP3 {
    int pm, pn, l; bool ok; unsigned char* ws;
    DI bool next(int i, gm::Unit& u) const {
        if (!ok || i >= 8) return false;
        const int br = i >> 1;
        const bf16_t* R = (const bf16_t*)(ws + WS_R); const bf16_t* P = (const bf16_t*)(ws + WS_P);
        u.pm = pm; u.pn = pn; u.sub = br; u.l = l;
        if ((i & 1) == 0) {
            u.A = (const bf16_t*)(ws + WS_XN) + (size_t)pm * 256 * 1024; u.lda = 1024; u.K = 1024; u.ldb = 1024;
            u.B = (const bf16_t*)(ws + WS_WG) + ((size_t)l * 4096 + br * 1024 + pn * 256) * 1024;
            u.kind = gm::K_GATE;
        } else {
            const bf16_t* wbr = (const bf16_t*)(ws + WS_WBR) + (size_t)l * 2 * 1024 * 1024 + (size_t)br * 1024 * 512;
            const int K = br == 3 ? 256 : 512;
            const int acol = br == 0 ? RB_SBQ : (br == 1 ? P_DNZ : (br == 2 ? RB_RTV : P_MEMQ));
            const bool inP = (br & 1) != 0;
            u.lda = inP ? PLD : RBLD; u.A = (inP ? P : R) + (size_t)pm * 256 * u.lda + acol; u.K = K; u.ldb = K; u.B = wbr + (size_t)pn * 256 * K;
            u.kind = gm::K_BRANCH;
        }
        return true;
    }
};
struct SchedP4 {
    int pm, pn, l; bool ok; unsigned char* ws;
    DI bool next(int i, gm::Unit& u) const {
        if (!ok || i >= 1) return false;
        u.A = (const bf16_t*)(ws + WS_R) + (size_t)pm * 256 * RBLD + RB_MERGED; u.lda = RBLD; u.K = 1024; u.ldb = 1024;
        u.B = (const bf16_t*)(ws + WS_WOUT) + ((size_t)l * 1024 + pn * 256) * 1024;
        u.pm = pm; u.pn = pn; u.kind = gm::K_OUT; u.sub = 0; u.l = l;
        return true;
    }
};

DI void dnprep_naive(int wv, int l) {
    const Frame F = mkframe(wv);
    const ArgsP ap = kargs();
    unsigned char* ws = ap->ws;
    const bf16_t* RA = (const bf16_t*)(ws + WS_R); bf16_t* DNC = (bf16_t*)(ws + WS_DNI);
    const float* cw = ap->dn_conv_w + (size_t)l * 4 * 1536;
    for (int it = F.gw; it < T * 4; it += F.NGW) {
        const int t = it >> 2, h = it & 3, s = t & (SEQ - 1);
        float val[3][2];
#pragma unroll
        for (int part = 0; part < 3; ++part)
#pragma unroll
            for (int e = 0; e < 2; ++e) {
                const int ch = part * 512 + h * 128 + F.lane + 64 * e; float acc = 0.f;
#pragma unroll
                for (int j = 0; j < 4; ++j) { const int sj = s - 3 + j; if (sj >= 0) acc += cw[j * 1536 + ch] * bf2f(RA[(size_t)(t - 3 + j) * RALD + ch]); }
                val[part][e] = siluf_(acc);
            }
        const float nq = wave_sum(val[0][0] * val[0][0] + val[0][1] * val[0][1], F.lane), nk = wave_sum(val[1][0] * val[1][0] + val[1][1] * val[1][1], F.lane);
        const float rq = rsqrtf(nq + EPS), rk = rsqrtf(nk + EPS);
#pragma unroll
        for (int e = 0; e < 2; ++e) {
            const int c = h * 128 + F.lane + 64 * e;
            DNC[(size_t)t * 1536 + c] = (bf16_t)f2bf(val[0][e] * rq); DNC[(size_t)t * 1536 + 512 + c] = (bf16_t)f2bf(val[1][e] * rk); DNC[(size_t)t * 1536 + 1024 + c] = (bf16_t)f2bf(val[2][e]);
        }
        if (F.lane == 0) {
            const float* ab = (const float*)(ws + WS_AB) + (size_t)t * 8; float* gb = (float*)(ws + WS_GB) + (size_t)t * 8;
            const float xa = ab[h] + ap->dn_dt_bias[l * 4 + h]; const float sp = xa > 20.f ? xa : log1pf(__expf(xa));
            gb[h] = -__expf(ap->dn_a_log[l * 4 + h]) * sp; gb[4 + h] = sigmoidf_(ab[4 + h]);
        }
    }
}
DI void mem_naive(int wv, int l) {
    const Frame F = mkframe(wv);
    const ArgsP ap = kargs();
    unsigned char* ws = ap->ws; bf16_t* P = (bf16_t*)(ws + WS_P); const bf16_t* KVM = (const bf16_t*)(ws + WS_KVM) + (size_t)l * 2048 * 512;
    for (int unit = blockIdx.x; unit < T * 4 / NTHREADS; unit += gridDim.x) {
        const int idx = unit * NTHREADS + F.tid, t = idx >> 2, h = idx & 3, b = t >> 11;
        bf16_t* qp = P + (size_t)t * PLD + P_MEMQ + h * 64;
        float q[64], o[64];
#pragma unroll
        for (int d = 0; d < 64; ++d) { q[d] = bf2f(qp[d]) * 0.125f; o[d] = 0.f; }
        float mx = -1e30f, lsum = 0.f;
        for (int key = 0; key < MEMLEN; ++key) {
            const bf16_t* kp = KVM + (size_t)(b * MEMLEN + key) * 512 + h * 64; const bf16_t* vp = kp + 256;
            float sc = 0.f;
#pragma unroll
            for (int d = 0; d < 64; ++d) sc += q[d] * bf2f(kp[d]);
            const float mn = fmaxf(mx, sc), corr = __expf(mx - mn), p = __expf(sc - mn);
            lsum = lsum * corr + p; mx = mn;
#pragma unroll
            for (int d = 0; d < 64; ++d) o[d] = o[d] * corr + p * bf2f(vp[d]);
        }
        const float inv = 1.f / lsum;
#pragma unroll
        for (int d = 0; d < 64; d += 2) *(unsigned*)(qp + d) = pk2(o[d] * inv, o[d + 1] * inv);
    }
}
DI void dn_naive(int wv, int l, int wg) {
    const Frame F = mkframe(wv);
    const ArgsP ap = kargs();
    unsigned char* ws = ap->ws; bf16_t* P = (bf16_t*)(ws + WS_P); const bf16_t* DNC = (const bf16_t*)(ws + WS_DNI); const float* GB = (const float*)(ws + WS_GB);
    const int grp = F.tid >> 8, e = F.tid & 127, dh = (F.tid >> 7) & 1, bh = wg * 2 + grp, b = bh >> 2, h = bh & 3;
    LAS float* sq = (LAS float*)(F.lds) + grp * 1024;
    LAS float* sk = sq + 128; LAS float* rpart = sq + 256; LAS float* opart = sq + 512; LAS float* sred = sq + 768;
    float S[64];
#pragma unroll
    for (int d = 0; d < 64; ++d) S[d] = 0.f;
    const float gn = ap->dn_norm_g[l * 128 + e];
    for (int s = 0; s < SEQ; ++s) {
        const int t = b * SEQ + s;
        if (dh == 0) sq[e] = bf2f(DNC[(size_t)t * 1536 + h * 128 + e]); else sk[e] = bf2f(DNC[(size_t)t * 1536 + 512 + h * 128 + e]);
        const float v = bf2f(DNC[(size_t)t * 1536 + 1024 + h * 128 + e]);
        const float g = GB[(size_t)t * 8 + h], beta = GB[(size_t)t * 8 + 4 + h];
        __syncthreads();
        const float al = __expf(g); float r = 0.f;
#pragma unroll
        for (int d0 = 0; d0 < 64; d0 += 16) {
#pragma unroll
            for (int d = d0; d < d0 + 16; ++d) { S[d] *= al; r += S[d] * sk[dh * 64 + d]; }
            asm volatile("" ::: "memory"); }
        rpart[dh * 128 + e] = r;
        __syncthreads();
        r = (v - (rpart[e] + rpart[128 + e])) * beta; float o = 0.f;
#pragma unroll
        for (int d0 = 0; d0 < 64; d0 += 16) {
#pragma unroll
            for (int d = d0; d < d0 + 16; ++d) { S[d] += sk[dh * 64 + d] * r; o += S[d] * sq[dh * 64 + d]; }
            asm volatile("" ::: "memory"); }
        opart[dh * 128 + e] = o;
        __syncthreads();
        o = (opart[e] + opart[128 + e]) * 0.08838834764831845f;
        const float part = wave_sum(o * o, F.lane);
        if (F.lane == 0 && dh == 0) sred[(F.wave & 1)] = part;
        __syncthreads();
        if (dh == 0) {
            const float rs = rsqrtf((sred[0] + sred[1]) * (1.f / 128.f) + EPS);
            bf16_t* zp = P + (size_t)t * PLD + P_DNZ + h * 128 + e;
            const float z = bf2f(*zp);
            *zp = (bf16_t)f2bf(o * rs * gn * siluf_(z));
        }
    }
}
DI void ret_naive(int wv, int l, int wg) {
    const Frame F = mkframe(wv);
    const ArgsP ap = kargs();
    unsigned char* ws = ap->ws; bf16_t* R = (bf16_t*)(ws + WS_R); const bf16_t* P = (const bf16_t*)(ws + WS_P);
    const float* rc = (const float*)(ws + WS_ROPE); const float* rsn = rc + T * 32;
    const int grp = F.tid >> 7, e = F.tid & 127, bh = wg * 4 + grp, b = bh >> 2, h = bh & 3;
    LAS float* sq = (LAS float*)(F.lds) + grp * 512; LAS float* sk = sq + 64; LAS float* sred = sq + 128;
    float S[64];
#pragma unroll
    for (int d = 0; d < 64; ++d) S[d] = 0.f;
    const float gamma = 1.0f - exp2f(-5.0f - (float)h);
    const float gn = ap->ret_norm_g[l * 512 + h * 128 + e];
    for (int s = 0; s < SEQ; ++s) {
        const int t = b * SEQ + s;
        if (e < 64) {
            const int i = e & 31; const float c = rc[(size_t)t * 32 + i], sn = rsn[(size_t)t * 32 + i];
            const bf16_t* qp = P + (size_t)t * PLD + P_RTQ + h * 64; const bf16_t* kp = P + (size_t)t * PLD + P_RTK + h * 64;
            const float q1 = bf2f(qp[i]), q2 = bf2f(qp[i + 32]), k1 = bf2f(kp[i]), k2 = bf2f(kp[i + 32]);
            sq[e] = e < 32 ? q1 * c - q2 * sn : q1 * sn + q2 * c;
            sk[e] = (e < 32 ? k1 * c - k2 * sn : k1 * sn + k2 * c) * 0.125f;
        }
        bf16_t* vp = R + (size_t)t * RBLD + RB_RTV + h * 128 + e;
        const float v = bf2f(*vp);
        __syncthreads();
        float o = 0.f;
#pragma unroll
        for (int d = 0; d < 64; ++d) { S[d] = S[d] * gamma + sk[d] * v; o += S[d] * sq[d]; }
        const float p1 = wave_sum(o, F.lane);
        if (F.lane == 0) sred[(F.wave & 1)] = p1;
        __syncthreads();
        const float mu = (sred[0] + sred[1]) * (1.f / 128.f); const float dlt = o - mu;
        const float p2 = wave_sum(dlt * dlt, F.lane);
        if (F.lane == 0) sred[2 + (F.wave & 1)] = p2;
        __syncthreads();
        const float rs = rsqrtf((sred[2] + sred[3]) * (1.f / 128.f) + EPS);
        const float z = bf2f(R[(size_t)t * RBLD + RB_RTZ + h * 128 + e]);
        *vp = (bf16_t)f2bf(dlt * rs * gn * siluf_(z));
    }
}
DI void sb_naive(int wv, int unit) {
    const Frame F = mkframe(wv);
    unsigned char* ws = kargs()->ws; bf16_t* R = (bf16_t*)(ws + WS_R);
    const int bh = unit >> 2, qt = unit & 3, b = bh >> 3, h = bh & 7, s_q = qt * 512 + F.tid, t = b * SEQ + s_q;
    bf16_t* qp = R + (size_t)t * RBLD + RB_SBQ + h * 64;
    float q[64], o[64];
#pragma unroll
    for (int d = 0; d < 64; ++d) { q[d] = bf2f(qp[d]) * (0.125f * 1.4426950408889634f); o[d] = 0.f; }
    float carry = 0.f;
    const int s_hi = qt * 512 + (F.wave * 64 + 63);
    for (int s = s_hi - 1; s >= 0; --s) {
        const bf16_t* kp = R + (size_t)(b * SEQ + s) * RBLD + RB_SBK + h * 64; const bf16_t* vp = kp + 512;
        float z = 0.f;
#pragma unroll
        for (int d = 0; d < 64; ++d) z += q[d] * bf2f(kp[d]);
        const bool act = s < s_q;
        const float sp = z > 40.f ? z : __log2f(1.f + exp2f(z));
        const float w = act ? exp2f(z - sp + carry) : 0.f;
        carry -= act ? sp : 0.f;
#pragma unroll
        for (int d = 0; d < 64; ++d) o[d] += w * bf2f(vp[d]);
        if (__all(carry < -160.f)) break;
    }
    const bf16_t* zp = R + (size_t)t * RBLD + RB_SBZ + h * 64;
#pragma unroll
    for (int d = 0; d < 64; d += 2) { const unsigned zz = *(const unsigned*)(zp + d); *(unsigned*)(qp + d) = pk2(o[d] * siluf_(bflo(zz)), o[d + 1] * siluf_(bfhi(zz))); }
}
DI void final_norm(int wv) {
    const Frame F = mkframe(wv);
    const ArgsP ap = kargs();
    const float* ss = (const float*)(ap->ws + WS_SS);
    for (int m = F.gw; m < T; m += F.NGW) {
        const f32x4 s = *(const f32x4*)(ss + (size_t)m * 4); const float rs = rsqrtf(((s.x + s.y) + (s.z + s.w)) * (1.f / D) + EPS);
        f32x4* xr = (f32x4*)(ap->out + (size_t)m * D) + F.lane; const f32x4* gr = (const f32x4*)ap->final_norm_g + F.lane;
#pragma unroll
        for (int j = 0; j < 4; ++j) { const f32x4 v = xr[64 * j], g = gr[64 * j]; xr[64 * j] = v * rs * g; }
    }
}

__global__ void __launch_bounds__(NTHREADS, 2) mk_fwd(Args args) {
    extern __shared__ __attribute__((aligned(16))) unsigned char lds_raw[];
    LAS unsigned char* const lds = (LAS unsigned char*)lds_raw;
    volatile LAS unsigned* MISC = (volatile LAS unsigned*)(lds + MISC_OFF);
    const int wv = __builtin_amdgcn_readfirstlane((int)threadIdx.x >> 6);
    { const int t0 = opaque_tid(wv); for (int u = t0; u < (LDS_BYTES - LDSCTL_OFF) / 4; u += NTHREADS) ((LAS unsigned*)(lds + LDSCTL_OFF))[u] = 0u; }
    __syncthreads();
    const int G = gridDim.x;
    XcdBarrier bar; bar.bar = (unsigned*)(args.ws + WS_CTL) + CW_BAR + args.li * XCD_BAR_WORDS; bar.x = 0; bar.st = nullptr;
    if (args.ph_hi - args.ph_lo > 1) bar = xcd_barrier_post(bar.bar, MISC + 8, wv);
#define IN(k) (kargs()->ph_lo <= (k) && (k) < kargs()->ph_hi)
#define SEAM(k) do { if (IN(k) && IN((k) + 1)) xcd_barrier(bar, wv); } while (0)
#define MK_EPI(E) gm::Epi E; E.ws = kargs()->ws; E.xin = nullptr; E.xout = nullptr; E.b_gate = nullptr; E.gnext = nullptr; E.spare = (LAS float*)(lds + SPARE_OFF);

#if !defined(ONLY_PH) || ONLY_PH == 0
    if (IN(0)) { p0_prologue(wv); }
#endif
    SEAM(0);

    for (int l = 0; l < DEPTH; ++l) {
        const int pb = 1 + 6 * l;
#if !defined(ONLY_PH) || ONLY_PH == 1
        if (IN(pb)) { MK_EPI(E); SchedP1 S; S.ord.init(64, 12, G, (int)blockIdx.x); S.ws = kargs()->ws; S.l = l; S.half = 0; S.c = (int)blockIdx.x; S.with_kvm = (l == 0);
            gm::gemm_phase(lds, wv, S, E); }
#endif
        SEAM(pb);
#if !defined(ONLY_PH) || ONLY_PH == 2
        if (IN(pb + 1)) {
#ifndef NO_P2A
 dnprep_naive(wv, l); mem_naive(wv, l);
#endif
 }
#endif
        SEAM(pb + 1);
#if !defined(ONLY_PH) || ONLY_PH == 3
        if (IN(pb + 2)) { MK_EPI(E); SchedP1 S; S.ord.init(64, 12, G, (int)blockIdx.x); S.ws = kargs()->ws; S.l = l; S.half = 1; S.c = (int)blockIdx.x; S.with_kvm = false;
            gm::gemm_phase(lds, wv, S, E); }
#endif
        SEAM(pb + 2);
#if !defined(ONLY_PH) || ONLY_PH == 4
        if (IN(pb + 3)) {
            const int wg = (int)blockIdx.x;
#ifndef NO_DN
            if (wg < 16) dn_naive(wv, l, wg);
#endif
#ifndef NO_RET
            if (wg >= 16 && wg < 24) ret_naive(wv, l, wg - 16);
#endif
#ifndef NO_SB
            if (wg >= 24) for (int unit = wg - 24; unit < 256; unit += G - 24) sb_naive(wv, unit);
#endif
        }
#endif
        SEAM(pb + 3);
#if !defined(ONLY_PH) || ONLY_PH == 5
        if (IN(pb + 4)) { MK_EPI(E); gm::TileOrder ord; ord.init(64, 4, G, (int)blockIdx.x); SchedP3 S; S.ok = ord.tile(0, S.pm, S.pn); S.l = l; S.ws = kargs()->ws; E.b_gate = kargs()->b_gate;
            gm::gemm_phase(lds, wv, S, E); }
#endif
        SEAM(pb + 4);
#if !defined(ONLY_PH) || ONLY_PH == 6
        if (IN(pb + 5)) { MK_EPI(E); gm::TileOrder ord; ord.init(64, 4, G, (int)blockIdx.x); SchedP4 S; S.ok = ord.tile(0, S.pm, S.pn); S.l = l; S.ws = kargs()->ws;
            E.gnext = (l + 1 < DEPTH) ? kargs()->norm_g + (size_t)(l + 1) * D : nullptr;
            E.xout = kargs()->out; E.xin = (l == 0) ? kargs()->x : (const float*)kargs()->out;
            gm::gemm_phase(lds, wv, S, E); }
#endif
        SEAM(pb + 5);
    }
#if !defined(ONLY_PH) || ONLY_PH == 13
    if (IN(13)) final_norm(wv);
#endif
#undef IN
#undef SEAM
#undef MK_EPI
}

extern "C" void kernel_launch(void* const* d_in, const int* in_sizes, int n_in, void* d_out, int out_size, void* d_ws, size_t ws_size, hipStream_t stream) {
    static int grid = 0;
    if (grid == 0) {
        if (n_in != 19 || out_size != T * D || ws_size < WS_END) { fprintf(stderr, "kernel_launch: unexpected problem (n_in %d, out %d, ws %zu)\n", n_in, out_size, ws_size); grid = -1; return; }
        int dev = 0, cus = 0, per_cu = 0;
        if (hipGetDevice(&dev) != hipSuccess || hipDeviceGetAttribute(&cus, hipDeviceAttributeMultiprocessorCount, dev) != hipSuccess) { grid = -1; return; }
        if (hipFuncSetAttribute((const void*)mk_fwd, hipFuncAttributeMaxDynamicSharedMemorySize, LDS_BYTES) != hipSuccess) { fprintf(stderr, "kernel_launch: hipFuncSetAttribute failed\n"); grid = -1; return; }
        if (hipOccupancyMaxActiveBlocksPerMultiprocessor(&per_cu, (const void*)mk_fwd, NTHREADS, LDS_BYTES) != hipSuccess || per_cu < 1)
            fprintf(stderr, "kernel_launch: occupancy query reports %d workgroups per CU\n", per_cu);
        (void)hipGetLastError();
        grid = cus;
    }
    if (grid < 0) return;
    if (hipMemsetAsync((char*)d_ws + WS_CTL, 0, CTL_ZERO_BYTES, stream) != hipSuccess) return;
    Args a{};
    a.x = (const float*)d_in[0]; a.mem = (const float*)d_in[1]; a.positions = (const int*)d_in[2]; a.norm_g = (const float*)d_in[3]; a.mem_norm_g = (const float*)d_in[4];
    a.w_in = (const float*)d_in[5]; a.b_gate = (const float*)d_in[6]; a.dn_conv_w = (const float*)d_in[7]; a.dn_a_log = (const float*)d_in[8]; a.dn_dt_bias = (const float*)d_in[9];
    a.dn_norm_g = (const float*)d_in[10]; a.ret_norm_g = (const float*)d_in[11]; a.w_mem_kv = (const float*)d_in[12]; a.w_br_sb = (const float*)d_in[13]; a.w_br_dn = (const float*)d_in[14];
    a.w_br_ret = (const float*)d_in[15]; a.w_br_mem = (const float*)d_in[16]; a.w_out = (const float*)d_in[17]; a.final_norm_g = (const float*)d_in[18];
    a.out = (float*)d_out; a.ws = (unsigned char*)d_ws;
#if MK_N_LAUNCHES == 1
    a.ph_lo = 0; a.ph_hi = NPHASE; a.li = 0;
    hipLaunchKernelGGL(mk_fwd, dim3(grid), dim3(NTHREADS), LDS_BYTES, stream, a);
#else
    for (int p = 0; p < NPHASE; ++p) { a.ph_lo = p; a.ph_hi = p + 1; a.li = 0;
        hipLaunchKernelGGL(mk_fwd, dim3(grid), dim3(NTHREADS), LDS_BYTES, stream, a); }
#endif
}
```

```cpp
#include <hip/hip_runtime.h>
#include <cstdio>
#include <cstdint>
#include <cmath>

#define LAS __attribute__((address_space(3)))
#define GAS __attribute__((address_space(1)))
#define DI __device__ __forceinline__
typedef unsigned short bf16_t;
typedef short bf16x8 __attribute__((ext_vector_type(8)));
typedef float f32x4 __attribute__((ext_vector_type(4)));
typedef unsigned u32x4 __attribute__((ext_vector_type(4)));
typedef unsigned u32x2 __attribute__((ext_vector_type(2)));

#ifndef MK_N_LAUNCHES
#define MK_N_LAUNCHES 1
#endif

constexpr int BATCH = 8, SEQ = 2048, D = 1024, T = BATCH * SEQ, DEPTH = 2, MEMLEN = 256;
constexpr int IN_COLS = 9992;
constexpr float EPS = 1e-6f;
constexpr int NPHASE = 14;

constexpr size_t MiB = 1u << 20;
constexpr size_t WS_CTL = 0, CTL_ZERO_BYTES = 1 * MiB;
constexpr size_t WS_WINA = 1 * MiB;
constexpr size_t WS_WINB = 13 * MiB;
constexpr size_t WS_WG = 25 * MiB;
constexpr size_t WS_WBR = 41 * MiB;
constexpr size_t WS_WOUT = 49 * MiB;
constexpr size_t WS_WKV = 53 * MiB;
constexpr size_t WS_XN = 55 * MiB;
constexpr size_t WS_P = 87 * MiB;
constexpr size_t WS_R = 127 * MiB;
constexpr size_t WS_VTSB = WS_R + 64 * MiB, WS_VTRT = WS_R + 80 * MiB;
constexpr size_t WS_SCR = WS_R + 64 * MiB;
constexpr size_t WS_DNI = 223 * MiB;
constexpr size_t WS_KVM = 295 * MiB;
constexpr size_t WS_ROPE = 299 * MiB;
constexpr size_t WS_AB = 303 * MiB;
constexpr size_t WS_GB = WS_AB + 512 * 1024;
constexpr size_t WS_SS = 304 * MiB;
constexpr size_t WS_END = 305 * MiB;
constexpr size_t WS_MEMN = WS_DNI;
constexpr int PLD = 1280, RALD = 1536, RBLD = 2048, SCRLD = 1024;
constexpr int P_DNZ = 0, P_MEMQ = 512, P_RTQ = 768, P_RTK = 1024;
constexpr int RB_SBQ = 0, RB_SBK = 512, RB_SBZ = 1024, RB_RTZ = 1536;
constexpr int RB_MERGED = 512;
constexpr int CW_BAR = 4096;
constexpr int CW_QUEUE = 64;

constexpr int RING_BYTES = 155648;
constexpr int LDSCTL_OFF = RING_BYTES, MISC_OFF = LDSCTL_OFF + 320, SPARE_OFF = LDSCTL_OFF + 1024;
constexpr int LDS_BYTES = 163840;
constexpr int NWAVES = 8, NTHREADS = 512;

DI unsigned f2bf(float f) { unsigned u = __builtin_bit_cast(unsigned, f); return (u + 0x7fffu + ((u >> 16) & 1u)) >> 16; }
DI unsigned pk2(float lo, float hi) { return f2bf(lo) | (f2bf(hi) << 16); }
DI float bf2f(unsigned short h) { return __builtin_bit_cast(float, (unsigned)h << 16); }
DI float bflo(unsigned w) { return __builtin_bit_cast(float, w << 16); }
DI float bfhi(unsigned w) { return __builtin_bit_cast(float, w & 0xffff0000u); }
DI float shx(float v, int m, int lane) { return __builtin_bit_cast(float, __builtin_amdgcn_ds_bpermute((lane ^ m) << 2, __builtin_bit_cast(int, v))); }
DI float wave_sum(float v, int lane) {
#pragma unroll
    for (int o = 1; o < 64; o <<= 1) v += shx(v, o, lane);
    return v;
}
DI float sigmoidf_(float x) { return 1.f / (1.f + __expf(-x)); }
DI float siluf_(float x) { return x / (1.f + __expf(-x)); }
DI int opaque_tid(int wv) { int lane; asm volatile("v_mbcnt_lo_u32_b32 %0, -1, 0\n\tv_mbcnt_hi_u32_b32 %0, -1, %0" : "=v"(lane)); return wv * 64 + lane; }
#define LDS_WAIT() asm volatile("s_waitcnt lgkmcnt(0)" ::: "memory")
#define VM_WAIT() asm volatile("s_waitcnt vmcnt(0)" ::: "memory")

#define XB_TMO      128
#define XB_XCNT(j)  (256  + 64 * (j))
#define XB_XSUB(j)  (1280 + 64 * (j))
#define XB_XGEN(j)  (2304 + 64 * (j))
#define XB_TOP      3328
#define XB_TOPGEN   3392
#define XCD_BAR_WORDS 3456
#define XB_SPIN_CAP (1u << 18)
DI unsigned xb_ld(unsigned* p)              { return __hip_atomic_load(p, __ATOMIC_RELAXED, __HIP_MEMORY_SCOPE_AGENT); }
DI unsigned xb_add(unsigned* p, unsigned v) { return __hip_atomic_fetch_add(p, v, __ATOMIC_RELAXED, __HIP_MEMORY_SCOPE_AGENT); }
DI unsigned xb_xcc_id() { return (unsigned)__builtin_amdgcn_s_getreg((3 << 11) | 20) & 0xFu; }
#define XB_SPIN(cond, bar) do { unsigned _sp = 0; while (cond) { __builtin_amdgcn_s_sleep(1); \
    if ((++_sp & 255u) == 0u) { if (xb_ld(&(bar)[XB_TMO])) break; if (_sp > XB_SPIN_CAP) { atomicAdd(&(bar)[XB_TMO], 1u); break; } } } } while (0)
struct XcdBarrier { unsigned* bar; unsigned x; volatile LAS unsigned* st; };
DI XcdBarrier xcd_barrier_post(unsigned* bar, volatile LAS unsigned* st, int wv) {
    XcdBarrier b; b.bar = bar; b.x = xb_xcc_id(); b.st = st;
    if (opaque_tid(wv) == 0) (void)xb_add(&bar[XB_XCNT(b.x)], 1u);
    return b;
}
DI void xcd_barrier_complete(unsigned* bar, unsigned x, unsigned& nloc, unsigned& nx) {
    const unsigned G = gridDim.x * gridDim.y * gridDim.z;
    unsigned sum, cnt, mine, sp = 0u;
    for (;;) {
        sum = 0u; cnt = 0u; mine = 0u;
#pragma unroll
        for (unsigned j = 0; j < 16; ++j) { const unsigned c = xb_ld(&bar[XB_XCNT(j)]); sum += c; cnt += (c > 0u) ? 1u : 0u; mine = (j == x) ? c : mine; }
        if (sum == G) break;
        __builtin_amdgcn_s_sleep(1);
        if ((++sp & 255u) == 0u) { if (xb_ld(&bar[XB_TMO])) break; if (sp > XB_SPIN_CAP) { atomicAdd(&bar[XB_TMO], 1u); break; } }
    }
    nloc = mine > 0u ? mine : 1u; nx = cnt > 0u ? cnt : 1u;
}
DI void xcd_barrier(const XcdBarrier& b, int wv) {
    asm volatile("s_waitcnt vmcnt(0)" ::: "memory");
    __syncthreads();
    if (opaque_tid(wv) == 0) {
        unsigned* bar = b.bar;
        __builtin_amdgcn_s_waitcnt(0);
        unsigned nloc = b.st[0], nx = b.st[1];
        if (nloc == 0u) { xcd_barrier_complete(bar, b.x, nloc, nx); b.st[0] = nloc; b.st[1] = nx; }
        const unsigned old = xb_add(&bar[XB_XSUB(b.x)], 1u);
        const unsigned gen = old / nloc;
        if (old + 1u == (gen + 1u) * nloc) {
            __builtin_amdgcn_fence(__ATOMIC_RELEASE, "agent");
            asm volatile("s_waitcnt vmcnt(0)" ::: "memory");
            const unsigned og = xb_add(&bar[XB_TOP], 1u);
            const unsigned tg = og / nx;
            if (og + 1u == (tg + 1u) * nx) xb_add(&bar[XB_TOPGEN], 1u);
            else XB_SPIN(xb_ld(&bar[XB_TOPGEN]) == tg, bar);
            __builtin_amdgcn_fence(__ATOMIC_ACQUIRE, "agent");
            xb_add(&bar[XB_XGEN(b.x)], 1u);
            asm volatile("s_waitcnt vmcnt(0)" ::: "memory");
        } else {
            XB_SPIN(xb_ld(&bar[XB_XGEN(b.x)]) == gen, bar);
            __builtin_amdgcn_fence(__ATOMIC_ACQUIRE, "agent");
            asm volatile("s_waitcnt vmcnt(0)" ::: "memory");
        }
    }
    __syncthreads();
}

namespace gm {
constexpr int BM = 256, BK = 64, HALF = 128, HTB = HALF * BK * 2, STAGE_BYTES = 8 * HTB;
DI int lds_byte(int r, int c) { const int st = (r >> 4) * 2 + (c >> 5), rr = r & 15, cc = c & 31, ob = rr * 64 + cc * 2; return st * 1024 + (ob ^ (((ob >> 9) & 1) << 5)); }
DI void stage_rc(int b, int& R, int& C) { const int st = b / 1024, sb = b % 1024, swz = sb ^ (((sb >> 9) & 1) << 5); R = (st >> 1) * 16 + swz / 64; C = (st & 1) * 32 + (swz % 64) / 2; }
DI int perm32(int rho) { const int n = rho >> 4, i = rho & 15; return 8 * (i >> 2) + 4 * n + (i & 3); }

enum Kind { K_STORE = 0, K_AB = 1, K_GATE = 2, K_BRANCH = 3, K_OUT = 4, K_STORE_T = 5 };
struct Unit {
    const bf16_t* A; const bf16_t* B;
    int lda, ldb, K, pm, pn, kind, sub, l;
};
struct TileOrder {
    int nM, nN, nwg, G, c;
    DI void init(int nM_, int nN_, int G_, int c_) { nM = nM_; nN = nN_; nwg = nM * nN; G = G_; c = c_; }
    DI bool tile(int i, int& pm, int& pn) const {
        const long L = (long)i * G + c; if (L >= nwg) return false;
        int wgid = (int)L; { const int q = nwg / 8, r = nwg % 8, xcd = wgid % 8, off = wgid / 8; wgid = (xcd < r ? xcd * (q + 1) : r * (q + 1) + (xcd - r) * q) + off; }
        const int WGM = 8, nig = WGM * nN, gid = wgid / nig, fm = gid * WGM, gsz = (nM - fm) < WGM ? (nM - fm) : WGM;
        pm = __builtin_amdgcn_readfirstlane(fm + ((wgid % nig) % gsz)); pn = __builtin_amdgcn_readfirstlane((wgid % nig) / gsz); return true;
    }
};

template <class Sched, class Epi>
DI void gemm_phase(LAS unsigned char* lds, int wv, const Sched& S, const Epi& E) {
    const int tid = opaque_tid(wv), wid = __builtin_amdgcn_readfirstlane(tid >> 6), lane = tid & 63, wr = wid >> 2, wc = wid & 3, fr = lane & 15, fq = lane >> 4;
    int R0_, C0_; stage_rc(tid * 16, R0_, C0_);
    const unsigned R0 = 2u * (unsigned)R0_, C2 = 2u * (unsigned)C0_;
    const unsigned RbP = 2u * (unsigned)((R0_ & ~31) + perm32(R0_ & 31));
    const unsigned ldsw = (unsigned)wid * 1024u;
    const int aoff = lds_byte(wr * 64 + fr, fq * 8), boff = lds_byte(wc * 32 + fr, fq * 8);
#define GM_SA(b, h) (((b) * 2 + (h)) * HTB)
#define GM_SB(b, h) ((4 + (b) * 2 + (h)) * HTB)
#define GM_STAGE(bufoff, gbase, ld, R2) do { const unsigned _v = (unsigned)(R2) * (unsigned)(ld) + C2; \
        __builtin_amdgcn_global_load_lds((const unsigned*)((const char*)(gbase) + _v), (LAS unsigned*)(lds + (bufoff) + ldsw), 16, 0, 0); \
        __builtin_amdgcn_global_load_lds((const unsigned*)((const char*)(gbase) + (_v + (unsigned)(ld) * 128u)), (LAS unsigned*)(lds + (bufoff) + ldsw + 8192), 16, 0, 0); } while (0)
#define GM_LDA(dst, b, h) do { _Pragma("unroll") for (int m = 0; m < 4; ++m) _Pragma("unroll") for (int k = 0; k < 2; ++k) dst[m][k] = *(const LAS bf16x8*)(lds + GM_SA(b, h) + aoff + m * 2048 + k * 1024); } while (0)
#define GM_LDB(dst, b, h) do { _Pragma("unroll") for (int n = 0; n < 2; ++n) _Pragma("unroll") for (int k = 0; k < 2; ++k) dst[n][k] = *(const LAS bf16x8*)(lds + GM_SB(b, h) + boff + n * 2048 + k * 1024); } while (0)
#define GM_MMA(ai, bj, At, Bt) do { __builtin_amdgcn_s_setprio(1); _Pragma("unroll") for (int m = 0; m < 4; ++m) _Pragma("unroll") for (int n = 0; n < 2; ++n) _Pragma("unroll") for (int k = 0; k < 2; ++k) \
        acc[ai][bj][m][n] = __builtin_amdgcn_mfma_f32_16x16x32_bf16(Bt[n][k], At[m][k], acc[ai][bj][m][n], 0, 0, 0); __builtin_amdgcn_s_setprio(0); } while (0)
#define GM_WAIT_V(n) asm volatile("s_waitcnt vmcnt(" #n ")" ::: "memory")
#define GM_WAIT_L(n) asm volatile("s_waitcnt lgkmcnt(" #n ")" ::: "memory")
#define GM_BAR __builtin_amdgcn_s_barrier()
#define GM_SCHED __builtin_amdgcn_sched_barrier(0)
    Unit cur, nxt; int ui = 0;
    if (!S.next(0, cur)) return;
    f32x4 acc[2][2][4][2];
#pragma unroll
    for (int a = 0; a < 2; ++a)
#pragma unroll
        for (int b = 0; b < 2; ++b)
#pragma unroll
            for (int m = 0; m < 4; ++m)
#pragma unroll
                for (int n = 0; n < 2; ++n) acc[a][b][m][n] = (f32x4){0.f, 0.f, 0.f, 0.f};
    bf16x8 At[4][2], B0[2][2], B1[2][2];
    const char* cA = (const char*)cur.A; const char* cB = (const char*)cur.B; int clda = cur.lda, cldb = cur.ldb;
    GM_STAGE(GM_SB(0, 0), cB, cldb, RbP); GM_STAGE(GM_SB(0, 1), cB + (size_t)cldb * 256, cldb, RbP); GM_STAGE(GM_SA(0, 0), cA, clda, R0); GM_STAGE(GM_SA(0, 1), cA + (size_t)clda * 256, clda, R0);
    if (wr == 1) GM_BAR;
    GM_WAIT_V(2); GM_BAR;
    GM_STAGE(GM_SB(1, 0), cB + 128, cldb, RbP); GM_STAGE(GM_SA(1, 0), cA + 128, clda, R0); GM_STAGE(GM_SB(1, 1), cB + (size_t)cldb * 256 + 128, cldb, RbP);
    GM_WAIT_V(6); GM_BAR;
    for (;;) {
        const bool has_next = S.next(ui + 1, nxt);
        const char* nA = has_next ? (const char*)nxt.A : cA; const char* nB = has_next ? (const char*)nxt.B : cB;
        const int nlda = has_next ? nxt.lda : clda, nldb = has_next ? nxt.ldb : cldb;
        const int nt = cur.K / BK;
        for (int t = 0; t < nt; t += 2) {
            const bool last = (t == nt - 2);
            const char* a1 = cA + (size_t)(t + 1) * 128;
            const char* a2 = last ? nA : cA + (size_t)(t + 2) * 128; const char* b2 = last ? nB : cB + (size_t)(t + 2) * 128;
            const int lda2 = last ? nlda : clda, ldb2 = last ? nldb : cldb;
            const char* a3 = a2 + 128; const char* b3 = b2 + 128;
            GM_LDB(B0, 0, 0); GM_LDB(B1, 0, 1); GM_SCHED; GM_LDA(At, 0, 0); GM_STAGE(GM_SA(1, 1), a1 + (size_t)clda * 256, clda, R0);
            GM_WAIT_V(8); GM_WAIT_L(0); GM_BAR; GM_MMA(0, 0, At, B0); GM_MMA(0, 1, At, B1); GM_BAR; GM_SCHED;
            GM_LDA(At, 0, 1); GM_STAGE(GM_SB(0, 0), b2, ldb2, RbP); GM_STAGE(GM_SB(0, 1), b2 + (size_t)ldb2 * 256, ldb2, RbP); GM_STAGE(GM_SA(0, 0), a2, lda2, R0);
            GM_WAIT_V(8); GM_WAIT_L(0); GM_BAR; GM_MMA(1, 0, At, B0); GM_MMA(1, 1, At, B1); GM_BAR; GM_SCHED;
            GM_LDB(B0, 1, 0); GM_LDB(B1, 1, 1); GM_SCHED; GM_LDA(At, 1, 0); GM_STAGE(GM_SA(0, 1), a2 + (size_t)lda2 * 256, lda2, R0);
            GM_WAIT_V(8); GM_WAIT_L(0); GM_BAR; GM_MMA(0, 0, At, B0); GM_MMA(0, 1, At, B1); GM_BAR; GM_SCHED;
            GM_LDA(At, 1, 1); GM_STAGE(GM_SB(1, 0), b3, ldb2, RbP); GM_STAGE(GM_SB(1, 1), b3 + (size_t)ldb2 * 256, ldb2, RbP); GM_STAGE(GM_SA(1, 0), a3, lda2, R0);
            GM_WAIT_V(8); GM_WAIT_L(0); GM_BAR; GM_MMA(1, 0, At, B0); GM_MMA(1, 1, At, B1); GM_BAR; GM_SCHED;
        }
        if (wr == 0) GM_BAR;
        E(acc, cur, wr, wc, fr, fq, lane);
        if (!has_next) break;
#pragma unroll
        for (int a = 0; a < 2; ++a)
#pragma unroll
            for (int b = 0; b < 2; ++b)
#pragma unroll
                for (int m = 0; m < 4; ++m)
#pragma unroll
                    for (int n = 0; n < 2; ++n) acc[a][b][m][n] = (f32x4){0.f, 0.f, 0.f, 0.f};
        cur = nxt; cA = nA; cB = nB; clda = nlda; cldb = nldb; ++ui;
        if (wr == 1) GM_BAR;
    }
    GM_WAIT_V(0);
    GM_BAR;
#undef GM_SA
#undef GM_SB
#undef GM_STAGE
#undef GM_LDA
#undef GM_LDB
#undef GM_MMA
#undef GM_WAIT_V
#undef GM_WAIT_L
#undef GM_BAR
#undef GM_SCHED
}

struct Epi {
    unsigned char* ws;
    const float* xin; float* xout;
    const float* b_gate;
    const float* gnext;
    LAS float* spare;
    DI float row_scale(int row) const { const f32x4 s = *(const f32x4*)((const float*)(ws + WS_SS) + (size_t)row * 4); return rsqrtf(((s.x + s.y) + (s.z + s.w)) * (1.0f / 1024.0f) + EPS); }
    DI bf16_t* scratch_tile(int pm, int pn) const { return (bf16_t*)(ws + WS_SCR) + (size_t)pm * 256 * SCRLD + pn * 256; }
    DI void operator()(f32x4 (&acc)[2][2][4][2], const Unit& u, int wr, int wc, int fr, int fq, int lane) const {
        int rl0 = wr * 64 + fr, cl0 = wc * 32 + 8 * fq;
        asm volatile("" : "+v"(rl0), "+v"(cl0));
        if (u.kind == K_STORE) {
            bf16_t* base; int ldc; bool scale = true;
            if (u.sub == 0) {
                if (u.pn < 6) { base = (bf16_t*)(ws + WS_R) + (size_t)u.pm * 256 * RALD + u.pn * 256; ldc = RALD; }
                else { const int pc = u.pn < 8 ? (u.pn - 6) * 256 : (u.pn - 7) * 256; base = (bf16_t*)(ws + WS_P) + (size_t)u.pm * 256 * PLD + pc; ldc = PLD; }
            } else if (u.sub == 1) { base = (bf16_t*)(ws + WS_R) + (size_t)u.pm * 256 * RBLD + u.pn * 256; ldc = RBLD; }
            else { base = (bf16_t*)(ws + WS_KVM) + (size_t)u.l * 1024 * 1024 + (size_t)u.pm * 256 * 256; ldc = 256; scale = false; }
#pragma unroll
            for (int ai = 0; ai < 2; ++ai)
#pragma unroll
                for (int m = 0; m < 4; ++m) {
                    const int rl = rl0 + ai * HALF + m * 16;
                    const float sc = scale ? row_scale(u.pm * BM + rl) : 1.0f;
                    bf16_t* rowp = base + (size_t)rl * ldc + cl0;
#pragma unroll
                    for (int bj = 0; bj < 2; ++bj) { const f32x4 v0 = acc[ai][bj][m][0] * sc, v1 = acc[ai][bj][m][1] * sc;
                        u32x4 w; w.x = pk2(v0[0], v0[1]); w.y = pk2(v0[2], v0[3]); w.z = pk2(v1[0], v1[1]); w.w = pk2(v1[2], v1[3]);
                        *(u32x4*)(rowp + bj * HALF) = w; }
                }
        } else if (u.kind == K_STORE_T) {
            bf16_t* base; const bool scale = (u.sub == 0);
            if (u.sub == 0) base = (bf16_t*)(ws + WS_VTSB) + (size_t)u.pm * 256 * T + u.pn * 256;
            else base = (bf16_t*)(ws + WS_KVM) + (size_t)u.l * 1024 * 1024 + 256 * 2048 + u.pn * 256;
            const int ldc = (u.sub == 0) ? T : 2048;
            f32x4 cs[2][2];
#pragma unroll
            for (int bj = 0; bj < 2; ++bj)
#pragma unroll
                for (int n = 0; n < 2; ++n)
#pragma unroll
                    for (int j = 0; j < 4; ++j) cs[bj][n][j] = scale ? row_scale(u.pn * BM + cl0 + bj * HALF + 4 * n + j) : 1.0f;
#pragma unroll
            for (int ai = 0; ai < 2; ++ai)
#pragma unroll
                for (int m = 0; m < 4; ++m) {
                    const int rl = rl0 + ai * HALF + m * 16;
                    bf16_t* rowp = base + (size_t)rl * ldc + cl0;
#pragma unroll
                    for (int bj = 0; bj < 2; ++bj) { const f32x4 v0 = acc[ai][bj][m][0] * cs[bj][0], v1 = acc[ai][bj][m][1] * cs[bj][1];
                        u32x4 w; w.x = pk2(v0[0], v0[1]); w.y = pk2(v0[2], v0[3]); w.z = pk2(v1[0], v1[1]); w.w = pk2(v1[2], v1[3]);
                        *(u32x4*)(rowp + bj * HALF) = w; }
                }
        } else if (u.kind == K_AB) {
            if (wc == 0 && fq == 0) {
                float* base = (float*)(ws + WS_AB) + (size_t)u.pm * 256 * 8;
#pragma unroll
                for (int ai = 0; ai < 2; ++ai)
#pragma unroll
                    for (int m = 0; m < 4; ++m) {
                        const int rl = rl0 + ai * HALF + m * 16;
                        const float sc = row_scale(u.pm * BM + rl);
                        float* rowp = base + (size_t)rl * 8;
                        *(f32x4*)(rowp) = acc[ai][0][m][0] * sc; *(f32x4*)(rowp + 4) = acc[ai][0][m][1] * sc;
                    }
            }
        } else if (u.kind == K_GATE) {
            bf16_t* base = scratch_tile(u.pm, u.pn);
            const float* bias = b_gate + (size_t)u.l * 4096 + u.sub * 1024 + u.pn * 256;
            f32x4 bv[2][2];
#pragma unroll
            for (int bj = 0; bj < 2; ++bj)
#pragma unroll
                for (int n = 0; n < 2; ++n) bv[bj][n] = *(const f32x4*)(bias + cl0 + bj * HALF + 4 * n);
#pragma unroll
            for (int ai = 0; ai < 2; ++ai)
#pragma unroll
                for (int m = 0; m < 4; ++m) {
                    const int rl = rl0 + ai * HALF + m * 16;
                    const float sc = row_scale(u.pm * BM + rl);
                    bf16_t* rowp = base + (size_t)rl * SCRLD + cl0;
#pragma unroll
                    for (int bj = 0; bj < 2; ++bj) { f32x4 v0 = acc[ai][bj][m][0] * sc + bv[bj][0], v1 = acc[ai][bj][m][1] * sc + bv[bj][1];
#pragma unroll
                        for (int j = 0; j < 4; ++j) { v0[j] = sigmoidf_(v0[j]); v1[j] = sigmoidf_(v1[j]); }
                        u32x4 w; w.x = pk2(v0[0], v0[1]); w.y = pk2(v0[2], v0[3]); w.z = pk2(v1[0], v1[1]); w.w = pk2(v1[2], v1[3]);
                        *(u32x4*)(rowp + bj * HALF) = w; }
                }
        } else if (u.kind == K_BRANCH) {
            bf16_t* base = (bf16_t*)(ws + WS_R) + (size_t)u.pm * 256 * RBLD + RB_MERGED + u.pn * 256; const bf16_t* gbase = scratch_tile(u.pm, u.pn);
            const bool first = (u.sub == 0);
#pragma unroll
            for (int ai = 0; ai < 2; ++ai)
#pragma unroll
                for (int m = 0; m < 4; ++m) {
                    const int rl = rl0 + ai * HALF + m * 16;
                    bf16_t* rowp = base + (size_t)rl * RBLD + cl0; const bf16_t* growp = gbase + (size_t)rl * SCRLD + cl0;
#pragma unroll
                    for (int bj = 0; bj < 2; ++bj) {
                        const u32x4 g = *(const u32x4*)(growp + bj * HALF);
                        u32x4 t = (u32x4){0u, 0u, 0u, 0u}; if (!first) t = *(const u32x4*)(rowp + bj * HALF);
                        const f32x4 v0 = acc[ai][bj][m][0], v1 = acc[ai][bj][m][1];
                        u32x4 w;
                        w.x = pk2(bflo(t.x) + bflo(g.x) * v0[0], bfhi(t.x) + bfhi(g.x) * v0[1]);
                        w.y = pk2(bflo(t.y) + bflo(g.y) * v0[2], bfhi(t.y) + bfhi(g.y) * v0[3]);
                        w.z = pk2(bflo(t.z) + bflo(g.z) * v1[0], bfhi(t.z) + bfhi(g.z) * v1[1]);
                        w.w = pk2(bflo(t.w) + bflo(g.w) * v1[2], bfhi(t.w) + bfhi(g.w) * v1[3]);
                        *(u32x4*)(rowp + bj * HALF) = w; }
                    asm volatile("" ::: "memory");
                }
        } else {
            bf16_t* base = (bf16_t*)(ws + WS_XN) + (size_t)u.pm * 256 * 1024 + u.pn * 256;
            const bool wxn = gnext != nullptr;
#pragma unroll
            for (int ai = 0; ai < 2; ++ai)
#pragma unroll
                for (int m = 0; m < 4; ++m) {
                    const int rl = rl0 + ai * HALF + m * 16;
                    const size_t goff = (size_t)(u.pm * BM + rl) * D + u.pn * BM + cl0;
                    float sq = 0.f;
#pragma unroll
                    for (int bj = 0; bj < 2; ++bj) {
                        const f32x4 x0 = *(const f32x4*)(xin + goff + bj * HALF), x1 = *(const f32x4*)(xin + goff + bj * HALF + 4);
                        const f32x4 v0 = acc[ai][bj][m][0] + x0, v1 = acc[ai][bj][m][1] + x1;
                        *(f32x4*)(xout + goff + bj * HALF) = v0; *(f32x4*)(xout + goff + bj * HALF + 4) = v1;
                        sq += (v0[0] * v0[0] + v0[1] * v0[1]) + (v0[2] * v0[2] + v0[3] * v0[3]) + (v1[0] * v1[0] + v1[1] * v1[1]) + (v1[2] * v1[2] + v1[3] * v1[3]);
                        if (wxn) { const f32x4 g0 = *(const f32x4*)(gnext + u.pn * BM + cl0 + bj * HALF), g1 = *(const f32x4*)(gnext + u.pn * BM + cl0 + bj * HALF + 4);
                            const f32x4 a = v0 * g0, b = v1 * g1;
                            u32x4 w; w.x = pk2(a[0], a[1]); w.y = pk2(a[2], a[3]); w.z = pk2(b[0], b[1]); w.w = pk2(b[2], b[3]);
                            *(u32x4*)(base + (size_t)rl * 1024 + cl0 + bj * HALF) = w; }
                    }
                    sq += shx(sq, 16, lane); sq += shx(sq, 32, lane);
                    if (fq == 0) spare[rl * 4 + wc] = sq;
                    asm volatile("" ::: "memory");
                }
            LDS_WAIT(); __builtin_amdgcn_s_barrier(); asm volatile("" ::: "memory");
            { const int t_ = wr * 256 + wc * 64 + lane; if (t_ < 256) { const int rl = t_; const f32x4 p = *(const LAS f32x4*)(spare + rl * 4);
                ((float*)(ws + WS_SS))[(size_t)(u.pm * BM + rl) * 4 + u.pn] = (p.x + p.y) + (p.z + p.w); } }
        }
    }
};
}

struct Args {
    const float* x; const float* mem; const int* positions; const float* norm_g; const float* mem_norm_g; const float* w_in; const float* b_gate;
    const float* dn_conv_w; const float* dn_a_log; const float* dn_dt_bias; const float* dn_norm_g; const float* ret_norm_g; const float* w_mem_kv;
    const float* w_br_sb; const float* w_br_dn; const float* w_br_ret; const float* w_br_mem; const float* w_out; const float* final_norm_g;
    float* out; unsigned char* ws; int ph_lo, ph_hi, li, pad;
};
struct Frame { LAS unsigned char* lds; int tid, lane, wave, G, gw, NGW; };
DI Frame mkframe(int wv) {
    extern __shared__ __attribute__((aligned(16))) unsigned char lds_raw[];
    Frame F; F.lds = (LAS unsigned char*)lds_raw; F.tid = opaque_tid(wv); F.lane = F.tid & 63; F.wave = wv;
    F.G = gridDim.x; F.gw = blockIdx.x * NWAVES + F.wave; F.NGW = F.G * NWAVES; return F;
}
typedef const __attribute__((address_space(4))) Args* ArgsP;
DI ArgsP kargs() { unsigned long long p = (unsigned long long)__builtin_amdgcn_kernarg_segment_ptr(); asm volatile("" : "+s"(p)); return (ArgsP)p; }

DI void transpose_seg(const Frame& F, const float* W, int K, int Nsrc, int c0, int ncols, bf16_t* WT, int r0) {
    LAS float* scr = (LAS float*)(F.lds + F.wave * 16384);
    const int nblk = ncols / 32, nitems = (K / 64) * nblk, lane = F.lane;
    for (int item = F.gw; item < nitems; item += F.NGW) {
        const int kb = item / nblk, nb = item % nblk, k0 = 64 * kb, n0 = 32 * nb;
#pragma unroll 8
        for (int i = 0; i < 32; ++i) { const int kk = 2 * i + (lane >> 5); scr[kk * 33 + (lane & 31)] = W[(size_t)(k0 + kk) * Nsrc + c0 + n0 + (lane & 31)]; }
        LDS_WAIT(); asm volatile("" ::: "memory");
        const int c = lane & 7;
#pragma unroll
        for (int j = 0; j < 4; ++j) { const int n = (lane >> 3) + 8 * j; const LAS float* s = scr + (8 * c) * 33 + n;
            u32x4 o; o.x = pk2(s[0 * 33], s[1 * 33]); o.y = pk2(s[2 * 33], s[3 * 33]); o.z = pk2(s[4 * 33], s[5 * 33]); o.w = pk2(s[6 * 33], s[7 * 33]);
            *(u32x4*)(WT + (size_t)(r0 + n0 + n) * K + k0 + 8 * c) = o; }
        LDS_WAIT(); asm volatile("" ::: "memory");
    }
}
DI void p0_prologue(int wv) {
    const Frame F = mkframe(wv);
    const ArgsP ap = kargs();
    unsigned char* ws = ap->ws;
    for (int l = 0; l < DEPTH; ++l) {
        const float* win = ap->w_in + (size_t)l * D * IN_COLS;
        bf16_t* wa = (bf16_t*)(ws + WS_WINA) + (size_t)l * 3072 * 1024; bf16_t* wb = (bf16_t*)(ws + WS_WINB) + (size_t)l * 3072 * 1024;
        bf16_t* wg = (bf16_t*)(ws + WS_WG) + (size_t)l * 4096 * 1024; bf16_t* wbr = (bf16_t*)(ws + WS_WBR) + (size_t)l * 2 * 1024 * 1024;
        transpose_seg(F, win, 1024, IN_COLS, 2048, 2048, wa, 0);
        transpose_seg(F, win, 1024, IN_COLS, 5640, 256, wa, 2304);
        transpose_seg(F, win, 1024, IN_COLS, 4104, 256, wa, 2560);
        transpose_seg(F, win, 1024, IN_COLS, 4360, 256, wa, 2816);
        transpose_seg(F, win, 1024, IN_COLS, 0, 1024, wb, 0);
        transpose_seg(F, win, 1024, IN_COLS, 1536, 512, wb, 1024);
        transpose_seg(F, win, 1024, IN_COLS, 5128, 512, wb, 1536);
        transpose_seg(F, win, 1024, IN_COLS, 1024, 512, wb, 2048);
        transpose_seg(F, win, 1024, IN_COLS, 4616, 512, wb, 2560);
        transpose_seg(F, win, 1024, IN_COLS, 5896, 4096, wg, 0);
        transpose_seg(F, ap->w_br_sb + (size_t)l * 512 * 1024, 512, 1024, 0, 1024, wbr, 0);
        transpose_seg(F, ap->w_br_dn + (size_t)l * 512 * 1024, 512, 1024, 0, 1024, wbr + 1024 * 512, 0);
        transpose_seg(F, ap->w_br_ret + (size_t)l * 512 * 1024, 512, 1024, 0, 1024, wbr + 2 * 1024 * 512, 0);
        transpose_seg(F, ap->w_br_mem + (size_t)l * 256 * 1024, 256, 1024, 0, 1024, wbr + 3 * 1024 * 512, 0);
        transpose_seg(F, ap->w_out + (size_t)l * 1024 * 1024, 1024, 1024, 0, 1024, (bf16_t*)(ws + WS_WOUT) + (size_t)l * 1024 * 1024, 0);
        transpose_seg(F, ap->w_mem_kv + (size_t)l * 1024 * 512, 1024, 512, 0, 512, (bf16_t*)(ws + WS_WKV) + (size_t)l * 512 * 1024, 0);
        for (int i = F.gw * 64 + F.lane; i < 256 * 1024; i += F.NGW * 64) { const int r = i >> 10, k = i & 1023;
            wa[(size_t)(2048 + r) * 1024 + k] = r < 8 ? (bf16_t)f2bf(win[(size_t)k * IN_COLS + 4096 + r]) : (bf16_t)0; }
    }
    for (int m = F.gw; m < T; m += F.NGW) {
        const f32x4* xr = (const f32x4*)(ap->x + (size_t)m * D) + F.lane; const f32x4* gr = (const f32x4*)ap->norm_g + F.lane;
        unsigned long long* o8 = (unsigned long long*)((bf16_t*)(ws + WS_XN) + (size_t)m * D) + F.lane; float s = 0.f;
#pragma unroll
        for (int j = 0; j < 4; ++j) { const f32x4 v = xr[64 * j], g = gr[64 * j]; s += (v.x * v.x + v.y * v.y) + (v.z * v.z + v.w * v.w);
            o8[64 * j] = (unsigned long long)pk2(v.x * g.x, v.y * g.y) | ((unsigned long long)pk2(v.z * g.z, v.w * g.w) << 32); }
        s = wave_sum(s, F.lane);
        if (F.lane == 0) *(f32x4*)((float*)(ws + WS_SS) + (size_t)m * 4) = (f32x4){s, 0.f, 0.f, 0.f};
    }
    for (int it = F.gw; it < DEPTH * BATCH * MEMLEN; it += F.NGW) {
        const int l = it / (BATCH * MEMLEN), m = it % (BATCH * MEMLEN);
        const f32x4* xr = (const f32x4*)(ap->mem + (size_t)m * D) + F.lane; const f32x4* gr = (const f32x4*)(ap->mem_norm_g + (size_t)l * D) + F.lane;
        f32x4 v[4]; float s = 0.f;
#pragma unroll
        for (int j = 0; j < 4; ++j) { v[j] = xr[64 * j]; s += (v[j].x * v[j].x + v[j].y * v[j].y) + (v[j].z * v[j].z + v[j].w * v[j].w); }
        const float rs = rsqrtf(wave_sum(s, F.lane) * (1.f / D) + EPS);
        unsigned long long* o8 = (unsigned long long*)((bf16_t*)(ws + WS_MEMN) + ((size_t)l * BATCH * MEMLEN + m) * D) + F.lane;
#pragma unroll
        for (int j = 0; j < 4; ++j) { const f32x4 g = gr[64 * j];
            o8[64 * j] = (unsigned long long)pk2(v[j].x * rs * g.x, v[j].y * rs * g.y) | ((unsigned long long)pk2(v[j].z * rs * g.z, v[j].w * rs * g.w) << 32); }
    }
    for (int i = F.gw * 64 + F.lane; i < T * 32; i += F.NGW * 64) {
        const int t = i >> 5, f = i & 31;
        const float inv = (float)pow(10000.0, -(double)f / 32.0);
        const float ang = (float)ap->positions[t] * inv;
        ((float*)(ws + WS_ROPE))[i] = (float)cos((double)ang); ((float*)(ws + WS_ROPE))[T * 32 + i] = (float)sin((double)ang);
    }
}

struct SchedP1 {
    gm::TileOrder ord; unsigned char* ws; int l, half, c; bool with_kvm;
    DI bool next(int i, gm::Unit& u) const {
        int pm, pn;
        if (ord.tile(i, pm, pn)) {
            const bf16_t* xn = (const bf16_t*)(ws + WS_XN) + (size_t)pm * 256 * 1024;
            const bf16_t* w = (const bf16_t*)(ws + (half == 0 ? WS_WINA : WS_WINB)) + ((size_t)l * 3072 + pn * 256) * 1024;
            u.lda = 1024; u.K = 1024; u.ldb = 1024; u.l = l; u.sub = half;
            if (half == 1 && pn >= 8) { u.A = w; u.B = xn; u.pm = pn - 8; u.pn = pm; u.kind = gm::K_STORE_T; u.sub = 0; }
            else { u.A = xn; u.B = w; u.pm = pm; u.pn = pn; u.kind = (half == 0 && pn == 8) ? gm::K_AB : gm::K_STORE; }
            return true;
        }
        if (with_kvm && c < 32 && i == (ord.nwg + ord.G - 1 - c) / ord.G) {
            const int ll = c >> 4, ty = (c >> 3) & 1, idx = c & 7;
            const bf16_t* mn = (const bf16_t*)(ws + WS_MEMN) + ((size_t)ll * 2048 + idx * 256) * 1024;
            const bf16_t* w = (const bf16_t*)(ws + WS_WKV) + ((size_t)ll * 512 + ty * 256) * 1024;
            u.lda = 1024; u.K = 1024; u.ldb = 1024; u.l = ll;
            if (ty == 0) { u.A = mn; u.B = w; u.pm = idx; u.pn = 0; u.kind = gm::K_STORE; u.sub = 2; }
            else { u.A = w; u.B = mn; u.pm = 0; u.pn = idx; u.kind = gm::K_STORE_T; u.sub = 1; }
            return true;
        }
        return false;
    }
};
struct SchedP3 {
    int pm, pn, l; bool ok; unsigned char* ws;
    DI bool next(int i, gm::Unit& u) const {
        if (!ok || i >= 8) return false;
        const int br = i >> 1;
        const bf16_t* R = (const bf16_t*)(ws + WS_R); const bf16_t* P = (const bf16_t*)(ws + WS_P);
        u.pm = pm; u.pn = pn; u.sub = br; u.l = l;
        if ((i & 1) == 0) {
            u.A = (const bf16_t*)(ws + WS_XN) + (size_t)pm * 256 * 1024; u.lda = 1024; u.K = 1024; u.ldb = 1024;
            u.B = (const bf16_t*)(ws + WS_WG) + ((size_t)l * 4096 + br * 1024 + pn * 256) * 1024;
            u.kind = gm::K_GATE;
        } else {
            const bf16_t* wbr = (const bf16_t*)(ws + WS_WBR) + (size_t)l * 2 * 1024 * 1024 + (size_t)br * 1024 * 512;
            const int K = br == 3 ? 256 : 512;
            const int acol = br == 0 ? RB_SBQ : (br == 1 ? P_DNZ : (br == 2 ? RB_RTZ : P_MEMQ));
            const bool inP = (br & 1) != 0;
            u.lda = inP ? PLD : RBLD; u.A = (inP ? P : R) + (size_t)pm * 256 * u.lda + acol; u.K = K; u.ldb = K; u.B = wbr + (size_t)pn * 256 * K;
            u.kind = gm::K_BRANCH;
        }
        return true;
    }
};
struct SchedP4 {
    int pm, pn, l; bool ok; unsigned char* ws;
    DI bool next(int i, gm::Unit& u) const {
        if (!ok || i >= 1) return false;
        u.A = (const bf16_t*)(ws + WS_R) + (size_t)pm * 256 * RBLD + RB_MERGED; u.lda = RBLD; u.K = 1024; u.ldb = 1024;
        u.B = (const bf16_t*)(ws + WS_WOUT) + ((size_t)l * 1024 + pn * 256) * 1024;
        u.pm = pm; u.pn = pn; u.kind = gm::K_OUT; u.sub = 0; u.l = l;
        return true;
    }
};

typedef float f32x16 __attribute__((ext_vector_type(16)));
typedef short s16x4 __attribute__((ext_vector_type(4)));
#define MFMA32(a, b, c) __builtin_amdgcn_mfma_f32_32x32x16_bf16((a), (b), (c), 0, 0, 0)
DI int crow(int reg, int hh) { return (reg & 3) + 8 * (reg >> 2) + 4 * hh; }
DI bf16x8 pack8(float a0, float a1, float a2, float a3, float a4, float a5, float a6, float a7) {
    u32x4 p;
    asm volatile("v_cvt_pk_bf16_f32 %0, %4, %5\n\tv_cvt_pk_bf16_f32 %1, %6, %7\n\tv_cvt_pk_bf16_f32 %2, %8, %9\n\tv_cvt_pk_bf16_f32 %3, %10, %11\n\ts_nop 1"
                 : "=&v"(p[0]), "=&v"(p[1]), "=&v"(p[2]), "=&v"(p[3]) : "v"(a0), "v"(a1), "v"(a2), "v"(a3), "v"(a4), "v"(a5), "v"(a6), "v"(a7));
    return __builtin_bit_cast(bf16x8, p);
}
DI bf16x8 pack8m(float a0, float a1, float a2, float a3, float a4, float a5, float a6, float a7) {
    u32x4 p;
    asm volatile("s_nop 15\n\ts_nop 3\n\tv_cvt_pk_bf16_f32 %0, %4, %5\n\tv_cvt_pk_bf16_f32 %1, %6, %7\n\tv_cvt_pk_bf16_f32 %2, %8, %9\n\tv_cvt_pk_bf16_f32 %3, %10, %11\n\ts_nop 1"
                 : "=&v"(p[0]), "=&v"(p[1]), "=&v"(p[2]), "=&v"(p[3]) : "v"(a0), "v"(a1), "v"(a2), "v"(a3), "v"(a4), "v"(a5), "v"(a6), "v"(a7));
    return __builtin_bit_cast(bf16x8, p);
}
namespace at {
constexpr int KST = 144, VST = 136;
constexpr int KT_BYTES = 64 * KST;
DI bf16x8 kfrag(LAS unsigned char* kt, int row, int ks, int hh) { return *(const LAS bf16x8*)(kt + row * KST + ks * 32 + hh * 16); }
DI bf16x8 vfrag(LAS unsigned char* vt, int row, int keyoff, int hh) {
    const LAS unsigned char* pp = vt + row * VST + (keyoff + 4 * hh) * 2;
    const u32x2 lo = *(const LAS u32x2*)pp, hi = *(const LAS u32x2*)(pp + 16);
    u32x4 r; r.x = lo.x; r.y = lo.y; r.z = hi.x; r.w = hi.y; return __builtin_bit_cast(bf16x8, r);
}
}

DI void mem_unit(int wv, int l, int unit) {
    const Frame F = mkframe(wv);
    unsigned char* ws = kargs()->ws; bf16_t* P = (bf16_t*)(ws + WS_P);
    const bf16_t* KM = (const bf16_t*)(ws + WS_KVM) + (size_t)l * 1024 * 1024; const bf16_t* VTM = KM + 2048 * 256;
    const int b = unit >> 5, h = (unit >> 3) & 3, qt = unit & 7, lane = F.lane, r = lane & 31, hh = lane >> 5;
    LAS unsigned char* kt = F.lds; LAS unsigned char* vt = F.lds + 256 * at::KST;
    constexpr int VS = 520;
#pragma unroll
    for (int i = 0; i < 4; ++i) { const int id = F.tid + 512 * i, row = id >> 3, ch = id & 7;
        const u32x4 v = *(const u32x4*)(KM + (size_t)(b * 256 + row) * 256 + h * 64 + ch * 8);
        *(LAS u32x4*)(kt + row * at::KST + ch * 16) = v; }
#pragma unroll
    for (int i = 0; i < 4; ++i) { const int id = F.tid + 512 * i, row = id >> 5, ch = id & 31;
        const u32x4 v = *(const u32x4*)(VTM + (size_t)(h * 64 + row) * 2048 + b * 256 + ch * 8);
        *(LAS u32x2*)(vt + row * VS + ch * 16) = (u32x2){v.x, v.y}; *(LAS u32x2*)(vt + row * VS + ch * 16 + 8) = (u32x2){v.z, v.w}; }
    const int t = b * SEQ + qt * 256 + wv * 32 + r;
    bf16_t* qp = P + (size_t)t * PLD + P_MEMQ + h * 64;
    bf16x8 qf[4];
#pragma unroll
    for (int ks = 0; ks < 4; ++ks) qf[ks] = *(const bf16x8*)(qp + 16 * ks + 8 * hh);
    __syncthreads();
    f32x16 z[8];
#pragma unroll
    for (int st = 0; st < 8; ++st) {
        f32x16 a = {0.f, 0.f, 0.f, 0.f, 0.f, 0.f, 0.f, 0.f, 0.f, 0.f, 0.f, 0.f, 0.f, 0.f, 0.f, 0.f};
#pragma unroll
        for (int ks = 0; ks < 4; ++ks) a = MFMA32(at::kfrag(kt, 32 * st + r, ks, hh), qf[ks], a);
        z[st] = a;
    }
    float mx = -3.0e38f;
#pragma unroll
    for (int st = 0; st < 8; ++st)
#pragma unroll
        for (int i = 0; i < 16; ++i) mx = fmaxf(mx, z[st][i]);
    mx = fmaxf(mx, shx(mx, 32, lane));
    const float c2 = 0.125f * 1.4426950408889634f; float sum = 0.f;
#pragma unroll
    for (int st = 0; st < 8; ++st)
#pragma unroll
        for (int i = 0; i < 16; ++i) { const float e = exp2f((z[st][i] - mx) * c2); z[st][i] = e; sum += e; }
    sum += shx(sum, 32, lane);
    f32x16 o0 = {0.f, 0.f, 0.f, 0.f, 0.f, 0.f, 0.f, 0.f, 0.f, 0.f, 0.f, 0.f, 0.f, 0.f, 0.f, 0.f}, o1 = o0;
#pragma unroll
    for (int st = 0; st < 8; ++st)
#pragma unroll
        for (int s2 = 0; s2 < 2; ++s2) {
            const bf16x8 pf = pack8(z[st][8 * s2], z[st][8 * s2 + 1], z[st][8 * s2 + 2], z[st][8 * s2 + 3], z[st][8 * s2 + 4], z[st][8 * s2 + 5], z[st][8 * s2 + 6], z[st][8 * s2 + 7]);
            const int keyoff = 32 * st + 16 * s2;
            { const LAS unsigned char* pp = vt + r * VS + (keyoff + 4 * hh) * 2; const u32x2 lo = *(const LAS u32x2*)pp, hi = *(const LAS u32x2*)(pp + 16);
              u32x4 q; q.x = lo.x; q.y = lo.y; q.z = hi.x; q.w = hi.y; o0 = MFMA32(__builtin_bit_cast(bf16x8, q), pf, o0); }
            { const LAS unsigned char* pp = vt + (32 + r) * VS + (keyoff + 4 * hh) * 2; const u32x2 lo = *(const LAS u32x2*)pp, hi = *(const LAS u32x2*)(pp + 16);
              u32x4 q; q.x = lo.x; q.y = lo.y; q.z = hi.x; q.w = hi.y; o1 = MFMA32(__builtin_bit_cast(bf16x8, q), pf, o1); }
        }
    const float inv = 1.f / sum;
#pragma unroll
    for (int g = 0; g < 4; ++g) {
        *(u32x2*)(qp + 8 * g + 4 * hh) = (u32x2){pk2(o0[4 * g] * inv, o0[4 * g + 1] * inv), pk2(o0[4 * g + 2] * inv, o0[4 * g + 3] * inv)};
        *(u32x2*)(qp + 32 + 8 * g + 4 * hh) = (u32x2){pk2(o1[4 * g] * inv, o1[4 * g + 1] * inv), pk2(o1[4 * g + 2] * inv, o1[4 * g + 3] * inv)};
    }
    __syncthreads();
}

DI void ret_rope_prep(int wv) {
    const Frame F = mkframe(wv);
    unsigned char* ws = kargs()->ws; bf16_t* P = (bf16_t*)(ws + WS_P);
    const float* rc = (const float*)(ws + WS_ROPE); const float* rsn = rc + T * 32;
    for (int it = blockIdx.x * NTHREADS + F.tid; it < T * 32; it += gridDim.x * NTHREADS) {
        const int t = it >> 5, w = (it >> 4) & 1, h = (it >> 2) & 3, g = it & 3;
        bf16_t* pp = P + (size_t)t * PLD + (w ? P_RTK : P_RTQ) + h * 64 + g * 8;
        const u32x4 a = *(const u32x4*)pp, bq = *(const u32x4*)(pp + 32);
        const f32x4 c0 = *(const f32x4*)(rc + (size_t)t * 32 + g * 8), c1 = *(const f32x4*)(rc + (size_t)t * 32 + g * 8 + 4);
        const f32x4 s0 = *(const f32x4*)(rsn + (size_t)t * 32 + g * 8), s1 = *(const f32x4*)(rsn + (size_t)t * 32 + g * 8 + 4);
        const float sc = w ? 0.125f : 1.0f;
        float x1[8] = {bflo(a.x), bfhi(a.x), bflo(a.y), bfhi(a.y), bflo(a.z), bfhi(a.z), bflo(a.w), bfhi(a.w)};
        float x2[8] = {bflo(bq.x), bfhi(bq.x), bflo(bq.y), bfhi(bq.y), bflo(bq.z), bfhi(bq.z), bflo(bq.w), bfhi(bq.w)};
        float cc[8] = {c0.x, c0.y, c0.z, c0.w, c1.x, c1.y, c1.z, c1.w}, ss[8] = {s0.x, s0.y, s0.z, s0.w, s1.x, s1.y, s1.z, s1.w};
        float y1[8], y2[8];
#pragma unroll
        for (int j = 0; j < 8; ++j) { y1[j] = (x1[j] * cc[j] - x2[j] * ss[j]) * sc; y2[j] = (x1[j] * ss[j] + x2[j] * cc[j]) * sc; }
        *(u32x4*)pp = (u32x4){pk2(y1[0], y1[1]), pk2(y1[2], y1[3]), pk2(y1[4], y1[5]), pk2(y1[6], y1[7])};
        *(u32x4*)(pp + 32) = (u32x4){pk2(y2[0], y2[1]), pk2(y2[2], y2[3]), pk2(y2[4], y2[5]), pk2(y2[6], y2[7])};
    }
}

template <int MODE>
DI void attn_unit(int wv, int l, int unit) {
    constexpr int DV = MODE == 0 ? 64 : 128, NDT = DV / 32, VT_BYTES = DV * at::VST, BUF = at::KT_BYTES + VT_BYTES;
    const Frame F = mkframe(wv);
    const ArgsP ap = kargs();
    unsigned char* ws = ap->ws; bf16_t* R = (bf16_t*)(ws + WS_R); bf16_t* P = (bf16_t*)(ws + WS_P);
    const int lane = F.lane, r = lane & 31, hh = lane >> 5;
    int b, h, qt;
    if (MODE == 0) { b = unit >> 6; h = (unit >> 3) & 7; qt = unit & 7; } else { b = unit >> 5; h = (unit >> 3) & 3; qt = 7 - (unit & 7); }
    const int q0 = qt * 256, qw0 = q0 + 32 * wv, tq = qw0 + r, t = b * SEQ + tq;
    const bf16_t* Kg = MODE == 0 ? R + RB_SBK + h * 64 : P + P_RTK + h * 64; const int kld = MODE == 0 ? RBLD : PLD;
    const bf16_t* VTg = (const bf16_t*)(ws + (MODE == 0 ? WS_VTSB : WS_VTRT)) + (size_t)h * DV * T + b * SEQ;
    const bf16_t* qp = MODE == 0 ? R + (size_t)t * RBLD + RB_SBQ + h * 64 : P + (size_t)t * PLD + P_RTQ + h * 64;
    bf16x8 qf[4];
#pragma unroll
    for (int ks = 0; ks < 4; ++ks) qf[ks] = *(const bf16x8*)(qp + 16 * ks + 8 * hh);
    f32x16 o[NDT];
#pragma unroll
    for (int d = 0; d < NDT; ++d) o[d] = (f32x16){0.f, 0.f, 0.f, 0.f, 0.f, 0.f, 0.f, 0.f, 0.f, 0.f, 0.f, 0.f, 0.f, 0.f, 0.f, 0.f};
    volatile LAS unsigned* flags = (volatile LAS unsigned*)(F.lds + 2 * BUF);
    const int jtop = (q0 + 255) >> 6;
    const int srow = F.tid >> 3, sch = F.tid & 7;
    u32x4 kreg, vreg[NDT / 2];
#define AT_LOAD(j) do { const int key0_ = (j) * 64; kreg = *(const u32x4*)(Kg + (size_t)(b * SEQ + key0_ + srow) * kld + sch * 8); \
        _Pragma("unroll") for (int i_ = 0; i_ < NDT / 2; ++i_) vreg[i_] = *(const u32x4*)(VTg + (size_t)(srow + 64 * i_) * T + key0_ + sch * 8); } while (0)
#define AT_WRITE(pbuf) do { LAS unsigned char* kb_ = F.lds + (pbuf) * BUF; *(LAS u32x4*)(kb_ + srow * at::KST + sch * 16) = kreg; \
        _Pragma("unroll") for (int i_ = 0; i_ < NDT / 2; ++i_) { LAS unsigned char* vp_ = kb_ + at::KT_BYTES + (srow + 64 * i_) * at::VST + sch * 16; \
            *(LAS u32x2*)vp_ = (u32x2){vreg[i_].x, vreg[i_].y}; *(LAS u32x2*)(vp_ + 8) = (u32x2){vreg[i_].z, vreg[i_].w}; } } while (0)
    AT_LOAD(jtop); AT_WRITE(0);
    __syncthreads();
    float carry = 0.f; bool done_w = false;
    const float c2 = 0.125f * 1.4426950408889634f;
    const float lg = MODE == 1 ? log2f(1.0f - exp2f(-5.0f - (float)h)) : 0.f;
    for (int j = jtop, it = 0; ; --j, ++it) {
        const int pbuf = it & 1;
        if (j > 0) AT_LOAD(j - 1);
        LAS unsigned char* kt = F.lds + pbuf * BUF; LAS unsigned char* vt = kt + at::KT_BYTES;
        const int key0 = j * 64;
        if (!done_w) {
#pragma unroll
            for (int sti = 0; sti < 2; ++sti) {
                const int st = 1 - sti, ks0 = key0 + 32 * st;
                if (ks0 <= qw0 + 31 - (MODE == 0 ? 1 : 0)) {
                    f32x16 z = {0.f, 0.f, 0.f, 0.f, 0.f, 0.f, 0.f, 0.f, 0.f, 0.f, 0.f, 0.f, 0.f, 0.f, 0.f, 0.f};
#pragma unroll
                    for (int ks = 0; ks < 4; ++ks) z = MFMA32(at::kfrag(kt, 32 * st + r, ks, hh), qf[ks], z);
                    float w[16];
                    if (MODE == 0) {
                        float ls[16], lz[16];
#pragma unroll
                        for (int i = 0; i < 16; ++i) {
                            const float z2 = z[i] * c2; const bool m = (ks0 + crow(i, hh)) < tq;
                            const float sp = z2 > 30.f ? z2 : __log2f(1.f + exp2f(z2));
                            ls[i] = m ? -sp : 0.f; lz[i] = m ? z2 - sp : -1.0e30f;
                        }
                        float qs[4], pq[4], aq[4];
#pragma unroll
                        for (int i = 0; i < 4; ++i) { qs[i] = (ls[4 * i] + ls[4 * i + 1]) + (ls[4 * i + 2] + ls[4 * i + 3]); pq[i] = shx(qs[i], 32, lane); }
                        float run = carry;
#pragma unroll
                        for (int i = 3; i >= 0; --i) { aq[i] = run + (hh == 0 ? pq[i] : 0.f); run += qs[i] + pq[i]; }
                        carry = run;
#pragma unroll
                        for (int i = 0; i < 4; ++i) {
                            const float a3 = aq[i], a2 = a3 + ls[4 * i + 3], a1 = a2 + ls[4 * i + 2], a0 = a1 + ls[4 * i + 1];
                            w[4 * i + 3] = exp2f(lz[4 * i + 3] + a3); w[4 * i + 2] = exp2f(lz[4 * i + 2] + a2); w[4 * i + 1] = exp2f(lz[4 * i + 1] + a1); w[4 * i] = exp2f(lz[4 * i] + a0);
                        }
                    } else {
#pragma unroll
                        for (int i = 0; i < 16; ++i) { const int dlt = tq - (ks0 + crow(i, hh)); w[i] = dlt >= 0 ? z[i] * exp2f(lg * (float)dlt) : 0.f; }
                    }
#pragma unroll
                    for (int s2 = 0; s2 < 2; ++s2) {
                        const bf16x8 pf = pack8(w[8 * s2], w[8 * s2 + 1], w[8 * s2 + 2], w[8 * s2 + 3], w[8 * s2 + 4], w[8 * s2 + 5], w[8 * s2 + 6], w[8 * s2 + 7]);
#pragma unroll
                        for (int d = 0; d < NDT; ++d) o[d] = MFMA32(at::vfrag(vt, 32 * d + r, 32 * st + 16 * s2, hh), pf, o[d]);
                    }
                }
            }
            if (MODE == 0) done_w = __all(carry < -150.f);
        }
        if (j > 0) AT_WRITE(pbuf ^ 1);
        if (F.lane == 0) flags[(it & 1) * 8 + wv] = done_w ? 1u : 0u;
        __syncthreads();
        if (j == 0) break;
        if (MODE == 0) { unsigned all = 1u;
#pragma unroll
            for (int w8 = 0; w8 < 8; ++w8) all &= flags[(it & 1) * 8 + w8];
            if (all) break; }
    }
#undef AT_LOAD
#undef AT_WRITE
    if (MODE == 0) {
        bf16_t* op = R + (size_t)t * RBLD + RB_SBQ + h * 64; const bf16_t* zp = R + (size_t)t * RBLD + RB_SBZ + h * 64;
#pragma unroll
        for (int d = 0; d < NDT; ++d)
#pragma unroll
            for (int g = 0; g < 4; ++g) { const int c = 32 * d + 8 * g + 4 * hh; const u32x2 zz = *(const u32x2*)(zp + c);
                *(u32x2*)(op + c) = (u32x2){pk2(o[d][4 * g] * siluf_(bflo(zz.x)), o[d][4 * g + 1] * siluf_(bfhi(zz.x))), pk2(o[d][4 * g + 2] * siluf_(bflo(zz.y)), o[d][4 * g + 3] * siluf_(bfhi(zz.y)))}; }
    } else {
        float s1 = 0.f;
#pragma unroll
        for (int d = 0; d < NDT; ++d)
#pragma unroll
            for (int i = 0; i < 16; ++i) s1 += o[d][i];
        s1 += shx(s1, 32, lane);
        const float mu = s1 * (1.f / 128.f); float s2 = 0.f;
#pragma unroll
        for (int d = 0; d < NDT; ++d)
#pragma unroll
            for (int i = 0; i < 16; ++i) { const float dl = o[d][i] - mu; s2 += dl * dl; }
        s2 += shx(s2, 32, lane);
        const float rs = rsqrtf(s2 * (1.f / 128.f) + EPS);
        bf16_t* zp = R + (size_t)t * RBLD + RB_RTZ + h * 128; const float* gp = ap->ret_norm_g + (size_t)l * 512 + h * 128;
#pragma unroll
        for (int d = 0; d < NDT; ++d)
#pragma unroll
            for (int g = 0; g < 4; ++g) { const int c = 32 * d + 8 * g + 4 * hh; const u32x2 zz = *(const u32x2*)(zp + c); const f32x4 gg = *(const f32x4*)(gp + c);
                *(u32x2*)(zp + c) = (u32x2){pk2((o[d][4 * g] - mu) * rs * gg.x * siluf_(bflo(zz.x)), (o[d][4 * g + 1] - mu) * rs * gg.y * siluf_(bfhi(zz.x))),
                                            pk2((o[d][4 * g + 2] - mu) * rs * gg.z * siluf_(bflo(zz.y)), (o[d][4 * g + 3] - mu) * rs * gg.w * siluf_(bfhi(zz.y)))}; }
    }
    __syncthreads();
}

namespace dn {
constexpr int HC_BYTES = 73728, OFF_W = 0, OFF_QG = 16384, OFF_KD = 32768, OFF_AI = 49152, OFF_U = 57344;
constexpr int QST = 272, TST = 144;
constexpr int GRP_BYTES = 71680, Q_OFF = 0, K_OFF = 17408, KT_OFF = 34816, VT_OFF = 53248, VEC_OFF = 143360, VEC_BYTES = 2048;
}

DI void dn_prep(int wv, int l, int pair) {
    const Frame F = mkframe(wv);
    const ArgsP ap = kargs();
    unsigned char* ws = ap->ws;
    const int lane = F.lane, r = lane & 31, hh = lane >> 5, grp = wv >> 2, gw = wv & 3, gt = F.tid & 255;
    const int hc = pair * 2 + grp, h = hc & 3, bn = hc >> 2, b = bn >> 5, n = bn & 31, t0 = b * SEQ + n * 64;
    LAS unsigned char* gb = F.lds + grp * dn::GRP_BYTES;
    LAS unsigned char* qimg = gb + dn::Q_OFF; LAS unsigned char* kimg = gb + dn::K_OFF; LAS unsigned char* ktimg = gb + dn::KT_OFF; LAS unsigned char* vtimg = gb + dn::VT_OFF;
    LAS float* vec = (LAS float*)(F.lds + dn::VEC_OFF + grp * dn::VEC_BYTES);
    LAS float* gcv = vec; LAS float* btv = vec + 64; LAS float* f1v = vec + 128; LAS float* f2v = vec + 192; LAS float* egv = vec + 256;
    unsigned char* blk = ws + WS_DNI + (size_t)hc * dn::HC_BYTES;
    const bf16_t* RA = (const bf16_t*)(ws + WS_R); const float* cw = ap->dn_conv_w + (size_t)l * 4 * 1536; const float* AB = (const float*)(ws + WS_AB);
    {
        const int g8 = gt & 15, ch = g8 * 8;
#pragma unroll 1
        for (int part = 0; part < 3; ++part) {
            const int col = part * 512 + h * 128 + ch;
            f32x4 wj[4][2];
#pragma unroll
            for (int j = 0; j < 4; ++j) { wj[j][0] = *(const f32x4*)(cw + j * 1536 + col); wj[j][1] = *(const f32x4*)(cw + j * 1536 + col + 4); }
#pragma unroll 1
            for (int k = 0; k < 4; ++k) {
                const int m = (gt >> 4) + 16 * k, t = t0 + m, sq = n * 64 + m;
                float a[8] = {0.f, 0.f, 0.f, 0.f, 0.f, 0.f, 0.f, 0.f};
#pragma unroll
                for (int j = 0; j < 4; ++j) if (sq - 3 + j >= 0) {
                    const u32x4 x = *(const u32x4*)(RA + (size_t)(t - 3 + j) * RALD + col);
                    a[0] += wj[j][0].x * bflo(x.x); a[1] += wj[j][0].y * bfhi(x.x); a[2] += wj[j][0].z * bflo(x.y); a[3] += wj[j][0].w * bfhi(x.y);
                    a[4] += wj[j][1].x * bflo(x.z); a[5] += wj[j][1].y * bfhi(x.z); a[6] += wj[j][1].z * bflo(x.w); a[7] += wj[j][1].w * bfhi(x.w);
                }
                float ssq = 0.f;
#pragma unroll
                for (int i = 0; i < 8; ++i) { a[i] = siluf_(a[i]); ssq += a[i] * a[i]; }
                if (part < 2) {
                    ssq += shx(ssq, 1, lane); ssq += shx(ssq, 2, lane); ssq += shx(ssq, 4, lane); ssq += shx(ssq, 8, lane);
                    const float rn = rsqrtf(ssq + EPS);
#pragma unroll
                    for (int i = 0; i < 8; ++i) a[i] *= rn;
                } else {
                    const float beta = sigmoidf_(AB[(size_t)t * 8 + 4 + h]);
#pragma unroll
                    for (int i = 0; i < 8; ++i) a[i] *= beta;
                }
                const u32x4 pk = (u32x4){pk2(a[0], a[1]), pk2(a[2], a[3]), pk2(a[4], a[5]), pk2(a[6], a[7])};
                if (part == 0) {
                    *(LAS u32x4*)(qimg + m * dn::QST + ch * 2) = pk;
                    if (g8 == 0) { const float xa = AB[(size_t)t * 8 + h] + ap->dn_dt_bias[l * 4 + h]; const float sp = xa > 20.f ? xa : log1pf(__expf(xa));
                        gcv[m] = -__expf(ap->dn_a_log[l * 4 + h]) * sp; btv[m] = sigmoidf_(AB[(size_t)t * 8 + 4 + h]); }
                } else {
                    if (part == 1) *(LAS u32x4*)(kimg + m * dn::QST + ch * 2) = pk;
                    LAS unsigned char* timg = (part == 1 ? ktimg : vtimg) + m * 2;
#pragma unroll
                    for (int i = 0; i < 8; ++i) *(LAS unsigned short*)(timg + (ch + i) * dn::TST) = (unsigned short)f2bf(a[i]);
                }
            }
        }
    }
    __syncthreads();
    if (gw == 0) {
        float gc = gcv[lane];
#pragma unroll
        for (int off = 1; off < 64; off <<= 1) { const float o = shx(gc, 0, lane - off < 0 ? lane : lane - off) ; gc += (lane >= off) ? o : 0.f; }
        const float glast = shx(gc, 0, 63);
        const float eg = __expf(gc);
        gcv[lane] = gc; f1v[lane] = btv[lane] * eg; f2v[lane] = __expf(glast - gc); egv[lane] = eg * 0.08838834764831845f;
        if (lane == 0) ((float*)(ws + WS_GB))[hc] = __expf(glast);
    }
    __syncthreads();
    f32x16 Lt = {0.f, 0.f, 0.f, 0.f, 0.f, 0.f, 0.f, 0.f, 0.f, 0.f, 0.f, 0.f, 0.f, 0.f, 0.f, 0.f};
    if (gw < 3) {
        {
            const int ct = gw == 0 ? 0 : 1, mt = gw == 2 ? 1 : 0;
            f32x16 acc = {0.f, 0.f, 0.f, 0.f, 0.f, 0.f, 0.f, 0.f, 0.f, 0.f, 0.f, 0.f, 0.f, 0.f, 0.f, 0.f};
#pragma unroll
            for (int ks = 0; ks < 8; ++ks) acc = MFMA32(*(const LAS bf16x8*)(kimg + (32 * ct + r) * dn::QST + ks * 32 + hh * 16), *(const LAS bf16x8*)(kimg + (32 * mt + r) * dn::QST + ks * 32 + hh * 16), acc);
            const int m = 32 * mt + r; const float gm = gcv[m];
#pragma unroll
            for (int i = 0; i < 16; ++i) { const int c = 32 * ct + crow(i, hh); Lt[i] = (m < c) ? acc[i] * btv[c] * __expf(gcv[c] - gm) : 0.f; }
        }
        {
            const int mt = gw == 2 ? 1 : 0, ct = gw == 0 ? 0 : 1;
            f32x16 acc = {0.f, 0.f, 0.f, 0.f, 0.f, 0.f, 0.f, 0.f, 0.f, 0.f, 0.f, 0.f, 0.f, 0.f, 0.f, 0.f};
#pragma unroll
            for (int ks = 0; ks < 8; ++ks) acc = MFMA32(*(const LAS bf16x8*)(kimg + (32 * mt + r) * dn::QST + ks * 32 + hh * 16), *(const LAS bf16x8*)(qimg + (32 * ct + r) * dn::QST + ks * 32 + hh * 16), acc);
            const int c = 32 * ct + r; const float gcc = gcv[c]; float v[16];
#pragma unroll
            for (int i = 0; i < 16; ++i) { const int m = 32 * mt + crow(i, hh); v[i] = (m <= c) ? acc[i] * __expf(gcc - gcv[m]) * 0.08838834764831845f : 0.f; }
#pragma unroll
            for (int s2 = 0; s2 < 2; ++s2) *(bf16x8*)(blk + dn::OFF_AI + ((ct * 2 + mt) * 2 + s2) * 1024 + lane * 16) = pack8(v[8 * s2], v[8 * s2 + 1], v[8 * s2 + 2], v[8 * s2 + 3], v[8 * s2 + 4], v[8 * s2 + 5], v[8 * s2 + 6], v[8 * s2 + 7]);
        }
    } else {
#pragma unroll 1
        for (int f = 0; f < 16; ++f) { const int ct = f >> 3, tau = (f >> 1) & 3, s2 = f & 1, c = 32 * ct + r; const float e = egv[c];
            const LAS unsigned char* pp = qimg + c * dn::QST + (32 * tau + 16 * s2 + 4 * hh) * 2; const u32x2 lo = *(const LAS u32x2*)pp, hi = *(const LAS u32x2*)(pp + 16);
            *(bf16x8*)(blk + dn::OFF_QG + f * 1024 + lane * 16) = pack8(bflo(lo.x) * e, bfhi(lo.x) * e, bflo(lo.y) * e, bfhi(lo.y) * e, bflo(hi.x) * e, bfhi(hi.x) * e, bflo(hi.y) * e, bfhi(hi.y) * e); }
#pragma unroll 1
        for (int f = 0; f < 16; ++f) { const int tau = f >> 2, m0 = 32 * ((f >> 1) & 1) + 16 * (f & 1) + 4 * hh;
            const LAS unsigned char* pp = ktimg + (32 * tau + r) * dn::TST + m0 * 2; const u32x2 lo = *(const LAS u32x2*)pp, hi = *(const LAS u32x2*)(pp + 16);
            const f32x4 fa = *(const LAS f32x4*)(f2v + m0), fb = *(const LAS f32x4*)(f2v + m0 + 8);
            *(bf16x8*)(blk + dn::OFF_KD + f * 1024 + lane * 16) = pack8(bflo(lo.x) * fa.x, bfhi(lo.x) * fa.y, bflo(lo.y) * fa.z, bfhi(lo.y) * fa.w, bflo(hi.x) * fb.x, bfhi(hi.x) * fb.y, bflo(hi.y) * fb.z, bfhi(hi.y) * fb.w); }
    }
    __syncthreads();
    LAS float* Lm = (LAS float*)qimg;
    if (gw < 3) { const int ct = gw == 0 ? 0 : 1, mt = gw == 2 ? 1 : 0;
#pragma unroll
        for (int i = 0; i < 16; ++i) Lm[(32 * ct + crow(i, hh)) * 64 + 32 * mt + r] = Lt[i]; }
    __syncthreads();
    if (gw == 0) {
        float Tc[64];
#pragma unroll
        for (int i = 0; i < 64; ++i) {
            float a0 = (i == lane) ? 1.f : 0.f, a1 = 0.f, a2 = 0.f, a3 = 0.f;
#pragma unroll
            for (int k4 = 0; k4 < (i + 3) / 4; ++k4) { const f32x4 lv = *(const LAS f32x4*)(Lm + i * 64 + 4 * k4);
                if (4 * k4 + 0 < i) a0 -= lv.x * Tc[4 * k4 + 0]; if (4 * k4 + 1 < i) a1 -= lv.y * Tc[4 * k4 + 1];
                if (4 * k4 + 2 < i) a2 -= lv.z * Tc[4 * k4 + 2]; if (4 * k4 + 3 < i) a3 -= lv.w * Tc[4 * k4 + 3]; }
            Tc[i] = (a0 + a1) + (a2 + a3);
        }
        LDS_WAIT(); asm volatile("" ::: "memory");
#pragma unroll
        for (int i = 0; i < 64; ++i) *(LAS unsigned short*)(kimg + i * dn::TST + lane * 2) = (unsigned short)f2bf(Tc[i]);
    }
    __syncthreads();
    {
        LAS unsigned char* timg = kimg;
        bf16x8 afr[4];
#pragma unroll
        for (int s4 = 0; s4 < 4; ++s4) { const u32x4 x = *(const LAS u32x4*)(ktimg + (32 * gw + r) * dn::TST + s4 * 32 + hh * 16);
            const f32x4 fa = *(const LAS f32x4*)(f1v + 16 * s4 + 8 * hh), fb = *(const LAS f32x4*)(f1v + 16 * s4 + 8 * hh + 4);
            afr[s4] = pack8(-bflo(x.x) * fa.x, -bfhi(x.x) * fa.y, -bflo(x.y) * fa.z, -bfhi(x.y) * fa.w, -bflo(x.z) * fb.x, -bfhi(x.z) * fb.y, -bflo(x.w) * fb.z, -bfhi(x.w) * fb.w); }
#pragma unroll
        for (int ct = 0; ct < 2; ++ct) {
            f32x16 acc = {0.f, 0.f, 0.f, 0.f, 0.f, 0.f, 0.f, 0.f, 0.f, 0.f, 0.f, 0.f, 0.f, 0.f, 0.f, 0.f};
#pragma unroll
            for (int s4 = 0; s4 < 4; ++s4) acc = MFMA32(afr[s4], *(const LAS bf16x8*)(timg + (32 * ct + r) * dn::TST + s4 * 32 + hh * 16), acc);
#pragma unroll
            for (int s2 = 0; s2 < 2; ++s2) *(bf16x8*)(blk + dn::OFF_W + ((ct * 4 + gw) * 2 + s2) * 1024 + lane * 16) = pack8m(acc[8 * s2], acc[8 * s2 + 1], acc[8 * s2 + 2], acc[8 * s2 + 3], acc[8 * s2 + 4], acc[8 * s2 + 5], acc[8 * s2 + 6], acc[8 * s2 + 7]);
        }
#pragma unroll
        for (int ct = 0; ct < 2; ++ct) {
            f32x16 acc = {0.f, 0.f, 0.f, 0.f, 0.f, 0.f, 0.f, 0.f, 0.f, 0.f, 0.f, 0.f, 0.f, 0.f, 0.f, 0.f};
#pragma unroll
            for (int s4 = 0; s4 < 4; ++s4) acc = MFMA32(*(const LAS bf16x8*)(timg + (32 * ct + r) * dn::TST + s4 * 32 + hh * 16), *(const LAS bf16x8*)(vtimg + (32 * gw + r) * dn::TST + s4 * 32 + hh * 16), acc);
#pragma unroll
            for (int s2 = 0; s2 < 2; ++s2) *(bf16x8*)(blk + dn::OFF_U + ((ct * 4 + gw) * 2 + s2) * 1024 + lane * 16) = pack8m(acc[8 * s2], acc[8 * s2 + 1], acc[8 * s2 + 2], acc[8 * s2 + 3], acc[8 * s2 + 4], acc[8 * s2 + 5], acc[8 * s2 + 6], acc[8 * s2 + 7]);
        }
    }
    __syncthreads();
}

DI void dn_scan(int wv, int l, int bh) {
    const Frame F = mkframe(wv);
    const ArgsP ap = kargs();
    unsigned char* ws = ap->ws; bf16_t* P = (bf16_t*)(ws + WS_P);
    const int lane = F.lane, hh = lane >> 5, b = bh >> 2, h = bh & 3;
    const float* GL = (const float*)(ws + WS_GB);
    LAS float* part = (LAS float*)(F.lds + 2 * dn::HC_BYTES);
    LAS float* gnl = part + 512;
    if (F.tid < 128) gnl[F.tid] = ap->dn_norm_g[l * 128 + F.tid];
    const size_t hc_stride = 4 * (size_t)dn::HC_BYTES;
    const unsigned char* blk0 = ws + WS_DNI + ((size_t)(b * 32) * 4 + h) * dn::HC_BYTES;
#define DN_LOAD(nn, pbuf) do { const unsigned char* src_ = blk0 + (size_t)(nn) * hc_stride; \
        _Pragma("unroll") for (int i_ = 0; i_ < 9; ++i_) { const int pc_ = wv * 9 + i_; \
            __builtin_amdgcn_global_load_lds((const unsigned*)(src_ + pc_ * 1024 + lane * 16), (LAS unsigned*)(F.lds + (pbuf) * dn::HC_BYTES + pc_ * 1024), 16, 0, 0); } } while (0)
    DN_LOAD(0, 0);
    f32x16 S[4];
#pragma unroll
    for (int i = 0; i < 4; ++i) S[i] = (f32x16){0.f, 0.f, 0.f, 0.f, 0.f, 0.f, 0.f, 0.f, 0.f, 0.f, 0.f, 0.f, 0.f, 0.f, 0.f, 0.f};
    u32x4 held[4];
#pragma unroll
    for (int i = 0; i < 4; ++i) held[i] = (u32x4){0u, 0u, 0u, 0u};
    __syncthreads();
#define DN_FINAL(nn) do { const int par_ = (nn) & 1; const f32x4 p4_ = *(const LAS f32x4*)(part + (par_ * 64 + lane) * 4); \
        const float rs_ = rsqrtf(((p4_.x + p4_.y) + (p4_.z + p4_.w)) * (1.f / 128.f) + EPS); \
        bf16_t* zp_ = P + (size_t)(b * SEQ + (nn) * 64 + lane) * PLD + P_DNZ + h * 128 + 32 * wv; \
        _Pragma("unroll") for (int q_ = 0; q_ < 4; ++q_) { const u32x4 zz_ = *(const u32x4*)(zp_ + 8 * q_); const f32x4 ga_ = *(const LAS f32x4*)(gnl + 32 * wv + 8 * q_), gb_ = *(const LAS f32x4*)(gnl + 32 * wv + 8 * q_ + 4); \
            u32x4 w_; \
            w_.x = pk2(bflo(held[q_].x) * rs_ * ga_.x * siluf_(bflo(zz_.x)), bfhi(held[q_].x) * rs_ * ga_.y * siluf_(bfhi(zz_.x))); \
            w_.y = pk2(bflo(held[q_].y) * rs_ * ga_.z * siluf_(bflo(zz_.y)), bfhi(held[q_].y) * rs_ * ga_.w * siluf_(bfhi(zz_.y))); \
            w_.z = pk2(bflo(held[q_].z) * rs_ * gb_.x * siluf_(bflo(zz_.z)), bfhi(held[q_].z) * rs_ * gb_.y * siluf_(bfhi(zz_.z))); \
            w_.w = pk2(bflo(held[q_].w) * rs_ * gb_.z * siluf_(bflo(zz_.w)), bfhi(held[q_].w) * rs_ * gb_.w * siluf_(bfhi(zz_.w))); \
            *(u32x4*)(zp_ + 8 * q_) = w_; } } while (0)
    for (int n = 0; n < 32; ++n) {
        const int pbuf = n & 1;
        LAS unsigned char* buf = F.lds + pbuf * dn::HC_BYTES;
        if (n > 0 && wv < 4) DN_FINAL(n - 1);
        if (n + 1 < 32) DN_LOAD(n + 1, pbuf ^ 1);
        if (wv < 4) {
            const float dec = GL[(size_t)(b * 32 + n) * 4 + h];
            f32x16 vn[2], o[2];
#pragma unroll
            for (int ct = 0; ct < 2; ++ct) {
                o[ct] = (f32x16){0.f, 0.f, 0.f, 0.f, 0.f, 0.f, 0.f, 0.f, 0.f, 0.f, 0.f, 0.f, 0.f, 0.f, 0.f, 0.f};
#pragma unroll
                for (int s2 = 0; s2 < 2; ++s2) { const u32x4 x = *(const LAS u32x4*)(buf + dn::OFF_U + ((ct * 4 + wv) * 2 + s2) * 1024 + lane * 16);
                    vn[ct][8 * s2] = bflo(x.x); vn[ct][8 * s2 + 1] = bfhi(x.x); vn[ct][8 * s2 + 2] = bflo(x.y); vn[ct][8 * s2 + 3] = bfhi(x.y);
                    vn[ct][8 * s2 + 4] = bflo(x.z); vn[ct][8 * s2 + 5] = bfhi(x.z); vn[ct][8 * s2 + 6] = bflo(x.w); vn[ct][8 * s2 + 7] = bfhi(x.w); }
            }
#pragma unroll
            for (int tau = 0; tau < 4; ++tau)
#pragma unroll
                for (int s2 = 0; s2 < 2; ++s2) {
                    const bf16x8 sf = pack8m(S[tau][8 * s2], S[tau][8 * s2 + 1], S[tau][8 * s2 + 2], S[tau][8 * s2 + 3], S[tau][8 * s2 + 4], S[tau][8 * s2 + 5], S[tau][8 * s2 + 6], S[tau][8 * s2 + 7]);
#pragma unroll
                    for (int ct = 0; ct < 2; ++ct) {
                        vn[ct] = MFMA32(*(const LAS bf16x8*)(buf + dn::OFF_W + ((ct * 4 + tau) * 2 + s2) * 1024 + lane * 16), sf, vn[ct]);
                        o[ct] = MFMA32(*(const LAS bf16x8*)(buf + dn::OFF_QG + ((ct * 4 + tau) * 2 + s2) * 1024 + lane * 16), sf, o[ct]);
                    }
                }
#pragma unroll
            for (int tau = 0; tau < 4; ++tau) S[tau] = S[tau] * dec;
#pragma unroll
            for (int cm = 0; cm < 2; ++cm)
#pragma unroll
                for (int s2 = 0; s2 < 2; ++s2) {
                    const bf16x8 vf = pack8m(vn[cm][8 * s2], vn[cm][8 * s2 + 1], vn[cm][8 * s2 + 2], vn[cm][8 * s2 + 3], vn[cm][8 * s2 + 4], vn[cm][8 * s2 + 5], vn[cm][8 * s2 + 6], vn[cm][8 * s2 + 7]);
#pragma unroll
                    for (int ct = cm; ct < 2; ++ct) o[ct] = MFMA32(*(const LAS bf16x8*)(buf + dn::OFF_AI + ((ct * 2 + cm) * 2 + s2) * 1024 + lane * 16), vf, o[ct]);
#pragma unroll
                    for (int tau = 0; tau < 4; ++tau) S[tau] = MFMA32(*(const LAS bf16x8*)(buf + dn::OFF_KD + ((tau * 2 + cm) * 2 + s2) * 1024 + lane * 16), vf, S[tau]);
                }
            LDS_WAIT(); asm volatile("" ::: "memory");
#pragma unroll
            for (int ct = 0; ct < 2; ++ct)
#pragma unroll
                for (int i = 0; i < 16; ++i) { const int c = 32 * ct + crow(i, hh), q = c >> 4;
                    *(LAS unsigned short*)(buf + dn::OFF_U + (((q >> 1) * 4 + wv) * 2 + (q & 1)) * 1024 + (c & 15) * 64 + (lane & 31) * 2) = (unsigned short)f2bf(o[ct][i]); }
            LDS_WAIT(); asm volatile("" ::: "memory");
            { const int q = lane >> 4; const LAS unsigned char* rp = buf + dn::OFF_U + (((q >> 1) * 4 + wv) * 2 + (q & 1)) * 1024 + (lane & 15) * 64;
                float ssq = 0.f;
#pragma unroll
                for (int i = 0; i < 4; ++i) { held[i] = *(const LAS u32x4*)(rp + 16 * i);
                    ssq += bflo(held[i].x) * bflo(held[i].x) + bfhi(held[i].x) * bfhi(held[i].x) + bflo(held[i].y) * bflo(held[i].y) + bfhi(held[i].y) * bfhi(held[i].y)
                         + bflo(held[i].z) * bflo(held[i].z) + bfhi(held[i].z) * bfhi(held[i].z) + bflo(held[i].w) * bflo(held[i].w) + bfhi(held[i].w) * bfhi(held[i].w); }
                part[(pbuf * 64 + lane) * 4 + wv] = ssq; }
        }
        VM_WAIT(); __syncthreads();
    }
    if (wv < 4) DN_FINAL(31);
    __syncthreads();
#undef DN_LOAD
#undef DN_FINAL
}

DI void final_norm(int wv) {
    const Frame F = mkframe(wv);
    const ArgsP ap = kargs();
    const float* ss = (const float*)(ap->ws + WS_SS);
    for (int m = F.gw; m < T; m += F.NGW) {
        const f32x4 s = *(const f32x4*)(ss + (size_t)m * 4); const float rs = rsqrtf(((s.x + s.y) + (s.z + s.w)) * (1.f / D) + EPS);
        f32x4* xr = (f32x4*)(ap->out + (size_t)m * D) + F.lane; const f32x4* gr = (const f32x4*)ap->final_norm_g + F.lane;
#pragma unroll
        for (int j = 0; j < 4; ++j) { const f32x4 v = xr[64 * j], g = gr[64 * j]; xr[64 * j] = v * rs * g; }
    }
}

__global__ void __launch_bounds__(NTHREADS, 2) mk_fwd(Args args) {
    extern __shared__ __attribute__((aligned(16))) unsigned char lds_raw[];
    LAS unsigned char* const lds = (LAS unsigned char*)lds_raw;
    volatile LAS unsigned* MISC = (volatile LAS unsigned*)(lds + MISC_OFF);
    const int wv = __builtin_amdgcn_readfirstlane((int)threadIdx.x >> 6);
    { const int t0 = opaque_tid(wv); for (int u = t0; u < (LDS_BYTES - LDSCTL_OFF) / 4; u += NTHREADS) ((LAS unsigned*)(lds + LDSCTL_OFF))[u] = 0u; }
    __syncthreads();
    const int G = gridDim.x;
    XcdBarrier bar; bar.bar = (unsigned*)(args.ws + WS_CTL) + CW_BAR + args.li * XCD_BAR_WORDS; bar.x = 0; bar.st = nullptr;
    if (args.ph_hi - args.ph_lo > 1) bar = xcd_barrier_post(bar.bar, MISC + 8, wv);
#define IN(k) (kargs()->ph_lo <= (k) && (k) < kargs()->ph_hi)
#define SEAM(k) do { if (IN(k) && IN((k) + 1)) xcd_barrier(bar, wv); } while (0)
#define MK_EPI(E) gm::Epi E; E.ws = kargs()->ws; E.xin = nullptr; E.xout = nullptr; E.b_gate = nullptr; E.gnext = nullptr; E.spare = (LAS float*)(lds + SPARE_OFF);

#if !defined(ONLY_PH) || ONLY_PH == 0
    if (IN(0)) { p0_prologue(wv); }
#endif
    SEAM(0);

    for (int l = 0; l < DEPTH; ++l) {
        const int pb = 1 + 6 * l;
#if !defined(ONLY_PH) || ONLY_PH == 1
        if (IN(pb)) { MK_EPI(E); SchedP1 S; S.ord.init(64, 12, G, (int)blockIdx.x); S.ws = kargs()->ws; S.l = l; S.half = 0; S.c = (int)blockIdx.x; S.with_kvm = (l == 0);
            gm::gemm_phase(lds, wv, S, E); }
#endif
        SEAM(pb);
#if !defined(ONLY_PH) || ONLY_PH == 2
        if (IN(pb + 1)) {
            ret_rope_prep(wv);
            for (int pair = (int)blockIdx.x; pair < 512; pair += G) dn_prep(wv, l, pair);
            for (int unit = (int)blockIdx.x; unit < 256; unit += G) mem_unit(wv, l, unit);
 }
#endif
        SEAM(pb + 1);
#if !defined(ONLY_PH) || ONLY_PH == 3
        if (IN(pb + 2)) { MK_EPI(E); SchedP1 S; S.ord.init(64, 12, G, (int)blockIdx.x); S.ws = kargs()->ws; S.l = l; S.half = 1; S.c = (int)blockIdx.x; S.with_kvm = false;
            gm::gemm_phase(lds, wv, S, E); }
#endif
        SEAM(pb + 2);
#if !defined(ONLY_PH) || ONLY_PH == 4
        if (IN(pb + 3)) {
            const int wg = (int)blockIdx.x;
            if (wg < 32) dn_scan(wv, l, wg);
            unsigned* head = (unsigned*)(kargs()->ws + WS_CTL) + CW_QUEUE + 64 * l;
            volatile LAS unsigned* qslot = (volatile LAS unsigned*)(lds + MISC_OFF + 64);
            for (;;) {
                if (opaque_tid(wv) == 0) qslot[0] = __hip_atomic_fetch_add(head, 1u, __ATOMIC_RELAXED, __HIP_MEMORY_SCOPE_AGENT);
                __syncthreads();
                const int unit = (int)qslot[0];
                __syncthreads();
                if (unit >= 768) break;
                if (unit < 256) attn_unit<1>(wv, l, unit); else attn_unit<0>(wv, l, unit - 256);
            }
        }
#endif
        SEAM(pb + 3);
#if !defined(ONLY_PH) || ONLY_PH == 5
        if (IN(pb + 4)) { MK_EPI(E); gm::TileOrder ord; ord.init(64, 4, G, (int)blockIdx.x); SchedP3 S; S.ok = ord.tile(0, S.pm, S.pn); S.l = l; S.ws = kargs()->ws; E.b_gate = kargs()->b_gate;
            gm::gemm_phase(lds, wv, S, E); }
#endif
        SEAM(pb + 4);
#if !defined(ONLY_PH) || ONLY_PH == 6
        if (IN(pb + 5)) { MK_EPI(E); gm::TileOrder ord; ord.init(64, 4, G, (int)blockIdx.x); SchedP4 S; S.ok = ord.tile(0, S.pm, S.pn); S.l = l; S.ws = kargs()->ws;
            E.gnext = (l + 1 < DEPTH) ? kargs()->norm_g + (size_t)(l + 1) * D : nullptr;
            E.xout = kargs()->out; E.xin = (l == 0) ? kargs()->x : (const float*)kargs()->out;
            gm::gemm_phase(lds, wv, S, E); }
#endif
        SEAM(pb + 5);
    }
#if !defined(ONLY_PH) || ONLY_PH == 13
    if (IN(13)) final_norm(wv);
#endif
#undef IN
#undef SEAM
#undef MK_EPI
}

extern "C" void kernel_launch(void* const* d_in, const int* in_sizes, int n_in, void* d_out, int out_size, void* d_ws, size_t ws_size, hipStream_t stream) {
    static int grid = 0;
    if (grid == 0) {
        if (n_in != 19 || out_size != T * D || ws_size < WS_END) { fprintf(stderr, "kernel_launch: unexpected problem (n_in %d, out %d, ws %zu)\n", n_in, out_size, ws_size); grid = -1; return; }
        int dev = 0, cus = 0, per_cu = 0;
        if (hipGetDevice(&dev) != hipSuccess || hipDeviceGetAttribute(&cus, hipDeviceAttributeMultiprocessorCount, dev) != hipSuccess) { grid = -1; return; }
        if (hipFuncSetAttribute((const void*)mk_fwd, hipFuncAttributeMaxDynamicSharedMemorySize, LDS_BYTES) != hipSuccess) { fprintf(stderr, "kernel_launch: hipFuncSetAttribute failed\n"); grid = -1; return; }
        if (hipOccupancyMaxActiveBlocksPerMultiprocessor(&per_cu, (const void*)mk_fwd, NTHREADS, LDS_BYTES) != hipSuccess || per_cu < 1)
            fprintf(stderr, "kernel_launch: occupancy query reports %d workgroups per CU\n", per_cu);
        (void)hipGetLastError();
        grid = cus;
    }
    if (grid < 0) return;
    if (hipMemsetAsync((char*)d_ws + WS_CTL, 0, CTL_ZERO_BYTES, stream) != hipSuccess) return;
    Args a{};
    a.x = (const float*)d_in[0]; a.mem = (const float*)d_in[1]; a.positions = (const int*)d_in[2]; a.norm_g = (const float*)d_in[3]; a.mem_norm_g = (const float*)d_in[4];
    a.w_in = (const float*)d_in[5]; a.b_gate = (const float*)d_in[6]; a.dn_conv_w = (const float*)d_in[7]; a.dn_a_log = (const float*)d_in[8]; a.dn_dt_bias = (const float*)d_in[9];
    a.dn_norm_g = (const float*)d_in[10]; a.ret_norm_g = (const float*)d_in[11]; a.w_mem_kv = (const float*)d_in[12]; a.w_br_sb = (const float*)d_in[13]; a.w_br_dn = (const float*)d_in[14];
    a.w_br_ret = (const float*)d_in[15]; a.w_br_mem = (const float*)d_in[16]; a.w_out = (const float*)d_in[17]; a.final_norm_g = (const float*)d_in[18];
    a.out = (float*)d_out; a.ws = (unsigned char*)d_ws;
#if MK_N_LAUNCHES == 1
    a.ph_lo = 0; a.ph_hi = NPHASE; a.li = 0;
    hipLaunchKernelGGL(mk_fwd, dim3(grid), dim3(NTHREADS), LDS_BYTES, stream, a);
#else
    for (int p = 0; p < NPHASE; ++p) { a.ph_lo = p; a.ph_hi = p + 1; a.li = 0;
        hipLaunchKernelGGL(mk_fwd, dim3(grid), dim3(NTHREADS), LDS_BYTES, stream, a); }
#endif
}
```

```cpp
#include <hip/hip_runtime.h>
#include <cstdio>
#include <cstdint>
#include <cmath>

#define LAS __attribute__((address_space(3)))
#define GAS __attribute__((address_space(1)))
#define DI __device__ __forceinline__
typedef unsigned short bf16_t;
typedef short bf16x8 __attribute__((ext_vector_type(8)));
typedef float f32x4 __attribute__((ext_vector_type(4)));
typedef unsigned u32x4 __attribute__((ext_vector_type(4)));
typedef unsigned u32x2 __attribute__((ext_vector_type(2)));

#ifndef MK_N_LAUNCHES
#define MK_N_LAUNCHES 1
#endif

constexpr int BATCH = 8, SEQ = 2048, D = 1024, T = BATCH * SEQ, DEPTH = 2, MEMLEN = 256;
constexpr int IN_COLS = 9992;
constexpr float EPS = 1e-6f;
constexpr int NPHASE = 14;

constexpr size_t MiB = 1u << 20;
constexpr size_t WS_CTL = 0, CTL_ZERO_BYTES = 1 * MiB;
constexpr size_t WS_WINA = 1 * MiB;
constexpr size_t WS_WINB = 13 * MiB;
constexpr size_t WS_WG = 25 * MiB;
constexpr size_t WS_WBR = 41 * MiB;
constexpr size_t WS_WOUT = 49 * MiB;
constexpr size_t WS_WKV = 53 * MiB;
constexpr size_t WS_XN = 55 * MiB;
constexpr size_t WS_P = 87 * MiB;
constexpr size_t WS_R = 127 * MiB;
constexpr size_t WS_VTSB = WS_R + 64 * MiB, WS_VTRT = WS_R + 80 * MiB;
constexpr size_t WS_SCR = WS_R + 64 * MiB;
constexpr size_t WS_DNI = 223 * MiB;
constexpr size_t WS_KVM = 295 * MiB;
constexpr size_t WS_ROPE = 299 * MiB;
constexpr size_t WS_AB = 303 * MiB;
constexpr size_t WS_GB = WS_AB + 512 * 1024;
constexpr size_t WS_SS = 304 * MiB;
constexpr size_t WS_END = 305 * MiB;
constexpr size_t WS_MEMN = WS_DNI;
constexpr int PLD = 1280, RALD = 1536, RBLD = 2048, SCRLD = 1024;
constexpr int P_DNZ = 0, P_MEMQ = 512, P_RTQ = 768, P_RTK = 1024;
constexpr int RB_SBQ = 0, RB_SBK = 512, RB_SBZ = 1024, RB_RTZ = 1536;
constexpr int RB_MERGED = 512;
constexpr int CW_BAR = 4096;
constexpr int CW_QUEUE = 64;

constexpr int RING_BYTES = 155648;
constexpr int LDSCTL_OFF = RING_BYTES, MISC_OFF = LDSCTL_OFF + 320, SPARE_OFF = LDSCTL_OFF + 1024;
constexpr int LDS_BYTES = 163840;
constexpr int NWAVES = 8, NTHREADS = 512;

DI unsigned f2bf(float f) { unsigned u = __builtin_bit_cast(unsigned, f); return (u + 0x7fffu + ((u >> 16) & 1u)) >> 16; }
DI unsigned pk2(float lo, float hi) { unsigned r; asm("s_nop 0\n\tv_cvt_pk_bf16_f32 %0, %1, %2" : "=v"(r) : "v"(lo), "v"(hi)); return r; }
DI float bf2f(unsigned short h) { return __builtin_bit_cast(float, (unsigned)h << 16); }
DI float bflo(unsigned w) { return __builtin_bit_cast(float, w << 16); }
DI float bfhi(unsigned w) { return __builtin_bit_cast(float, w & 0xffff0000u); }
DI float shx(float v, int m, int lane) { return __builtin_bit_cast(float, __builtin_amdgcn_ds_bpermute((lane ^ m) << 2, __builtin_bit_cast(int, v))); }
DI float wave_sum(float v, int lane) {
#pragma unroll
    for (int o = 1; o < 64; o <<= 1) v += shx(v, o, lane);
    return v;
}
DI float sigmoidf_(float x) { return __builtin_amdgcn_rcpf(1.f + __builtin_amdgcn_exp2f(x * -1.4426950408889634f)); }
DI float siluf_(float x) { return x * __builtin_amdgcn_rcpf(1.f + __builtin_amdgcn_exp2f(x * -1.4426950408889634f)); }
DI int opaque_tid(int wv) { int lane; asm volatile("v_mbcnt_lo_u32_b32 %0, -1, 0\n\tv_mbcnt_hi_u32_b32 %0, -1, %0" : "=v"(lane)); return wv * 64 + lane; }
#define LDS_WAIT() asm volatile("s_waitcnt lgkmcnt(0)" ::: "memory")
#define VM_WAIT() asm volatile("s_waitcnt vmcnt(0)" ::: "memory")

#define XB_TMO      128
#define XB_XCNT(j)  (256  + 64 * (j))
#define XB_XSUB(j)  (1280 + 64 * (j))
#define XB_XGEN(j)  (2304 + 64 * (j))
#define XB_TOP      3328
#define XB_TOPGEN   3392
#define XCD_BAR_WORDS 3456
#define XB_SPIN_CAP (1u << 18)
DI unsigned xb_ld(unsigned* p)              { return __hip_atomic_load(p, __ATOMIC_RELAXED, __HIP_MEMORY_SCOPE_AGENT); }
DI unsigned xb_add(unsigned* p, unsigned v) { return __hip_atomic_fetch_add(p, v, __ATOMIC_RELAXED, __HIP_MEMORY_SCOPE_AGENT); }
DI unsigned xb_xcc_id() { return (unsigned)__builtin_amdgcn_s_getreg((3 << 11) | 20) & 0xFu; }
#define XB_SPIN(cond, bar) do { unsigned _sp = 0; while (cond) { __builtin_amdgcn_s_sleep(1); \
    if ((++_sp & 255u) == 0u) { if (xb_ld(&(bar)[XB_TMO])) break; if (_sp > XB_SPIN_CAP) { atomicAdd(&(bar)[XB_TMO], 1u); break; } } } } while (0)
struct XcdBarrier { unsigned* bar; unsigned x; volatile LAS unsigned* st; };
DI XcdBarrier xcd_barrier_post(unsigned* bar, volatile LAS unsigned* st, int wv) {
    XcdBarrier b; b.bar = bar; b.x = xb_xcc_id(); b.st = st;
    if (opaque_tid(wv) == 0) (void)xb_add(&bar[XB_XCNT(b.x)], 1u);
    return b;
}
DI void xcd_barrier_complete(unsigned* bar, unsigned x, unsigned& nloc, unsigned& nx) {
    const unsigned G = gridDim.x * gridDim.y * gridDim.z;
    unsigned sum, cnt, mine, sp = 0u;
    for (;;) {
        sum = 0u; cnt = 0u; mine = 0u;
#pragma unroll
        for (unsigned j = 0; j < 16; ++j) { const unsigned c = xb_ld(&bar[XB_XCNT(j)]); sum += c; cnt += (c > 0u) ? 1u : 0u; mine = (j == x) ? c : mine; }
        if (sum == G) break;
        __builtin_amdgcn_s_sleep(1);
        if ((++sp & 255u) == 0u) { if (xb_ld(&bar[XB_TMO])) break; if (sp > XB_SPIN_CAP) { atomicAdd(&bar[XB_TMO], 1u); break; } }
    }
    nloc = mine > 0u ? mine : 1u; nx = cnt > 0u ? cnt : 1u;
}
DI void xcd_barrier(const XcdBarrier& b, int wv) {
    asm volatile("s_waitcnt vmcnt(0)" ::: "memory");
    __syncthreads();
    if (opaque_tid(wv) == 0) {
        unsigned* bar = b.bar;
        __builtin_amdgcn_s_waitcnt(0);
        unsigned nloc = b.st[0], nx = b.st[1];
        if (nloc == 0u) { xcd_barrier_complete(bar, b.x, nloc, nx); b.st[0] = nloc; b.st[1] = nx; }
        const unsigned old = xb_add(&bar[XB_XSUB(b.x)], 1u);
        const unsigned gen = old / nloc;
        if (old + 1u == (gen + 1u) * nloc) {
            __builtin_amdgcn_fence(__ATOMIC_RELEASE, "agent");
            asm volatile("s_waitcnt vmcnt(0)" ::: "memory");
            const unsigned og = xb_add(&bar[XB_TOP], 1u);
            const unsigned tg = og / nx;
            if (og + 1u == (tg + 1u) * nx) xb_add(&bar[XB_TOPGEN], 1u);
            else XB_SPIN(xb_ld(&bar[XB_TOPGEN]) == tg, bar);
            __builtin_amdgcn_fence(__ATOMIC_ACQUIRE, "agent");
            xb_add(&bar[XB_XGEN(b.x)], 1u);
            asm volatile("s_waitcnt vmcnt(0)" ::: "memory");
        } else {
            XB_SPIN(xb_ld(&bar[XB_XGEN(b.x)]) == gen, bar);
            __builtin_amdgcn_fence(__ATOMIC_ACQUIRE, "agent");
            asm volatile("s_waitcnt vmcnt(0)" ::: "memory");
        }
    }
    __syncthreads();
}

namespace gm {
constexpr int BM = 256, BK = 64, HALF = 128, HTB = HALF * BK * 2, STAGE_BYTES = 8 * HTB;
DI int lds_byte(int r, int c) { const int st = (r >> 4) * 2 + (c >> 5), rr = r & 15, cc = c & 31, ob = rr * 64 + cc * 2; return st * 1024 + (ob ^ (((ob >> 9) & 1) << 5)); }
DI void stage_rc(int b, int& R, int& C) { const int st = b / 1024, sb = b % 1024, swz = sb ^ (((sb >> 9) & 1) << 5); R = (st >> 1) * 16 + swz / 64; C = (st & 1) * 32 + (swz % 64) / 2; }
DI int perm32(int rho) { const int n = rho >> 4, i = rho & 15; return 8 * (i >> 2) + 4 * n + (i & 3); }

enum Kind { K_STORE = 0, K_AB = 1, K_GATE = 2, K_BRANCH = 3, K_OUT = 4, K_STORE_T = 5 };
struct Unit {
    const bf16_t* A; const bf16_t* B;
    int lda, ldb, K, pm, pn, kind, sub, l;
};
struct TileOrder {
    int nM, nN, nwg, G, c;
    DI void init(int nM_, int nN_, int G_, int c_) { nM = nM_; nN = nN_; nwg = nM * nN; G = G_; c = c_; }
    DI bool tile(int i, int& pm, int& pn) const {
        const long L = (long)i * G + c; if (L >= nwg) return false;
        int wgid = (int)L; { const int q = nwg / 8, r = nwg % 8, xcd = wgid % 8, off = wgid / 8; wgid = (xcd < r ? xcd * (q + 1) : r * (q + 1) + (xcd - r) * q) + off; }
        const int WGM = 8, nig = WGM * nN, gid = wgid / nig, fm = gid * WGM, gsz = (nM - fm) < WGM ? (nM - fm) : WGM;
        pm = __builtin_amdgcn_readfirstlane(fm + ((wgid % nig) % gsz)); pn = __builtin_amdgcn_readfirstlane((wgid % nig) / gsz); return true;
    }
};

template <class Sched, class Epi>
DI void gemm_phase(LAS unsigned char* lds, int wv, const Sched& S, const Epi& E) {
    const int tid = opaque_tid(wv), wid = __builtin_amdgcn_readfirstlane(tid >> 6), lane = tid & 63, wr = wid >> 2, wc = wid & 3, fr = lane & 15, fq = lane >> 4;
    int R0_, C0_; stage_rc(tid * 16, R0_, C0_);
    const unsigned R0 = 2u * (unsigned)R0_, C2 = 2u * (unsigned)C0_;
    const unsigned RbP = 2u * (unsigned)((R0_ & ~31) + perm32(R0_ & 31));
    const unsigned ldsw = (unsigned)wid * 1024u;
    const int aoff = lds_byte(wr * 64 + fr, fq * 8), boff = lds_byte(wc * 32 + fr, fq * 8);
#define GM_SA(b, h) (((b) * 2 + (h)) * HTB)
#define GM_SB(b, h) ((4 + (b) * 2 + (h)) * HTB)
#define GM_STAGE(bufoff, gbase, ld, R2) do { const unsigned _v = (unsigned)(R2) * (unsigned)(ld) + C2; \
        __builtin_amdgcn_global_load_lds((const unsigned*)((const char*)(gbase) + _v), (LAS unsigned*)(lds + (bufoff) + ldsw), 16, 0, 0); \
        __builtin_amdgcn_global_load_lds((const unsigned*)((const char*)(gbase) + (_v + (unsigned)(ld) * 128u)), (LAS unsigned*)(lds + (bufoff) + ldsw + 8192), 16, 0, 0); } while (0)
#define GM_LDA(dst, b, h) do { _Pragma("unroll") for (int m = 0; m < 4; ++m) _Pragma("unroll") for (int k = 0; k < 2; ++k) dst[m][k] = *(const LAS bf16x8*)(lds + GM_SA(b, h) + aoff + m * 2048 + k * 1024); } while (0)
#define GM_LDB(dst, b, h) do { _Pragma("unroll") for (int n = 0; n < 2; ++n) _Pragma("unroll") for (int k = 0; k < 2; ++k) dst[n][k] = *(const LAS bf16x8*)(lds + GM_SB(b, h) + boff + n * 2048 + k * 1024); } while (0)
#define GM_MMA(ai, bj, At, Bt) do { __builtin_amdgcn_s_setprio(1); _Pragma("unroll") for (int m = 0; m < 4; ++m) _Pragma("unroll") for (int n = 0; n < 2; ++n) _Pragma("unroll") for (int k = 0; k < 2; ++k) \
        acc[ai][bj][m][n] = __builtin_amdgcn_mfma_f32_16x16x32_bf16(Bt[n][k], At[m][k], acc[ai][bj][m][n], 0, 0, 0); __builtin_amdgcn_s_setprio(0); } while (0)
#define GM_WAIT_V(n) asm volatile("s_waitcnt vmcnt(" #n ")" ::: "memory")
#define GM_WAIT_L(n) asm volatile("s_waitcnt lgkmcnt(" #n ")" ::: "memory")
#define GM_BAR __builtin_amdgcn_s_barrier()
#define GM_SCHED __builtin_amdgcn_sched_barrier(0)
    Unit cur, nxt; int ui = 0;
    if (!S.next(0, cur)) return;
    f32x4 acc[2][2][4][2];
#pragma unroll
    for (int a = 0; a < 2; ++a)
#pragma unroll
        for (int b = 0; b < 2; ++b)
#pragma unroll
            for (int m = 0; m < 4; ++m)
#pragma unroll
                for (int n = 0; n < 2; ++n) acc[a][b][m][n] = (f32x4){0.f, 0.f, 0.f, 0.f};
    bf16x8 At[4][2], B0[2][2], B1[2][2];
    const char* cA = (const char*)cur.A; const char* cB = (const char*)cur.B; int clda = cur.lda, cldb = cur.ldb;
    GM_STAGE(GM_SB(0, 0), cB, cldb, RbP); GM_STAGE(GM_SB(0, 1), cB + (size_t)cldb * 256, cldb, RbP); GM_STAGE(GM_SA(0, 0), cA, clda, R0); GM_STAGE(GM_SA(0, 1), cA + (size_t)clda * 256, clda, R0);
    if (wr == 1) GM_BAR;
    GM_WAIT_V(2); GM_BAR;
    GM_STAGE(GM_SB(1, 0), cB + 128, cldb, RbP); GM_STAGE(GM_SA(1, 0), cA + 128, clda, R0); GM_STAGE(GM_SB(1, 1), cB + (size_t)cldb * 256 + 128, cldb, RbP);
    GM_WAIT_V(6); GM_BAR;
    for (;;) {
        const bool has_next = S.next(ui + 1, nxt);
        const char* nA = has_next ? (const char*)nxt.A : cA; const char* nB = has_next ? (const char*)nxt.B : cB;
        const int nlda = has_next ? nxt.lda : clda, nldb = has_next ? nxt.ldb : cldb;
        const int nt = cur.K / BK;
        for (int t = 0; t < nt; t += 2) {
            const bool last = (t == nt - 2);
            const char* a1 = cA + (size_t)(t + 1) * 128;
            const char* a2 = last ? nA : cA + (size_t)(t + 2) * 128; const char* b2 = last ? nB : cB + (size_t)(t + 2) * 128;
            const int lda2 = last ? nlda : clda, ldb2 = last ? nldb : cldb;
            const char* a3 = a2 + 128; const char* b3 = b2 + 128;
            GM_LDB(B0, 0, 0); GM_LDB(B1, 0, 1); GM_SCHED; GM_LDA(At, 0, 0); GM_STAGE(GM_SA(1, 1), a1 + (size_t)clda * 256, clda, R0);
            GM_WAIT_V(8); GM_WAIT_L(0); GM_BAR; GM_MMA(0, 0, At, B0); GM_MMA(0, 1, At, B1); GM_BAR; GM_SCHED;
            GM_LDA(At, 0, 1); GM_STAGE(GM_SB(0, 0), b2, ldb2, RbP); GM_STAGE(GM_SB(0, 1), b2 + (size_t)ldb2 * 256, ldb2, RbP); GM_STAGE(GM_SA(0, 0), a2, lda2, R0);
            GM_WAIT_V(8); GM_WAIT_L(0); GM_BAR; GM_MMA(1, 0, At, B0); GM_MMA(1, 1, At, B1); GM_BAR; GM_SCHED;
            GM_LDB(B0, 1, 0); GM_LDB(B1, 1, 1); GM_SCHED; GM_LDA(At, 1, 0); GM_STAGE(GM_SA(0, 1), a2 + (size_t)lda2 * 256, lda2, R0);
            GM_WAIT_V(8); GM_WAIT_L(0); GM_BAR; GM_MMA(0, 0, At, B0); GM_MMA(0, 1, At, B1); GM_BAR; GM_SCHED;
            GM_LDA(At, 1, 1); GM_STAGE(GM_SB(1, 0), b3, ldb2, RbP); GM_STAGE(GM_SB(1, 1), b3 + (size_t)ldb2 * 256, ldb2, RbP); GM_STAGE(GM_SA(1, 0), a3, lda2, R0);
            GM_WAIT_V(8); GM_WAIT_L(0); GM_BAR; GM_MMA(1, 0, At, B0); GM_MMA(1, 1, At, B1); GM_BAR; GM_SCHED;
        }
        if (wr == 0) GM_BAR;
        E(acc, cur, wr, wc, fr, fq, lane);
        if (!has_next) break;
#pragma unroll
        for (int a = 0; a < 2; ++a)
#pragma unroll
            for (int b = 0; b < 2; ++b)
#pragma unroll
                for (int m = 0; m < 4; ++m)
#pragma unroll
                    for (int n = 0; n < 2; ++n) acc[a][b][m][n] = (f32x4){0.f, 0.f, 0.f, 0.f};
        cur = nxt; cA = nA; cB = nB; clda = nlda; cldb = nldb; ++ui;
        if (wr == 1) GM_BAR;
    }
    GM_WAIT_V(0);
    GM_BAR;
#undef GM_SA
#undef GM_SB
#undef GM_STAGE
#undef GM_LDA
#undef GM_LDB
#undef GM_MMA
#undef GM_WAIT_V
#undef GM_WAIT_L
#undef GM_BAR
#undef GM_SCHED
}

struct Epi {
    unsigned char* ws;
    const float* xin; float* xout;
    const float* b_gate;
    const float* gnext;
    LAS float* spare;
    DI float row_scale(int row) const { const f32x4 s = *(const f32x4*)((const float*)(ws + WS_SS) + (size_t)row * 4); return rsqrtf(((s.x + s.y) + (s.z + s.w)) * (1.0f / 1024.0f) + EPS); }
    DI bf16_t* scratch_tile(int pm, int pn) const { return (bf16_t*)(ws + WS_SCR) + (size_t)pm * 256 * SCRLD + pn * 256; }
    DI void operator()(f32x4 (&acc)[2][2][4][2], const Unit& u, int wr, int wc, int fr, int fq, int lane) const {
        int rl0 = wr * 64 + fr, cl0 = wc * 32 + 8 * fq;
        asm volatile("" : "+v"(rl0), "+v"(cl0));
        if (u.kind == K_STORE) {
            bf16_t* base; int ldc; bool scale = true;
            if (u.sub == 0) {
                if (u.pn < 6) { base = (bf16_t*)(ws + WS_R) + (size_t)u.pm * 256 * RALD + u.pn * 256; ldc = RALD; }
                else { const int pc = u.pn < 8 ? (u.pn - 6) * 256 : (u.pn - 7) * 256; base = (bf16_t*)(ws + WS_P) + (size_t)u.pm * 256 * PLD + pc; ldc = PLD; }
            } else if (u.sub == 1) { base = (bf16_t*)(ws + WS_R) + (size_t)u.pm * 256 * RBLD + u.pn * 256; ldc = RBLD; }
            else { base = (bf16_t*)(ws + WS_KVM) + (size_t)u.l * 1024 * 1024 + (size_t)u.pm * 256 * 256; ldc = 256; scale = false; }
#pragma unroll
            for (int ai = 0; ai < 2; ++ai)
#pragma unroll
                for (int m = 0; m < 4; ++m) {
                    const int rl = rl0 + ai * HALF + m * 16;
                    const float sc = scale ? row_scale(u.pm * BM + rl) : 1.0f;
                    bf16_t* rowp = base + (size_t)rl * ldc + cl0;
#pragma unroll
                    for (int bj = 0; bj < 2; ++bj) { const f32x4 v0 = acc[ai][bj][m][0] * sc, v1 = acc[ai][bj][m][1] * sc;
                        u32x4 w; w.x = pk2(v0[0], v0[1]); w.y = pk2(v0[2], v0[3]); w.z = pk2(v1[0], v1[1]); w.w = pk2(v1[2], v1[3]);
                        *(u32x4*)(rowp + bj * HALF) = w; }
                }
        } else if (u.kind == K_STORE_T) {
            bf16_t* base; const bool scale = (u.sub == 0);
            if (u.sub == 0) base = (bf16_t*)(ws + WS_VTSB) + (size_t)u.pm * 256 * T + u.pn * 256;
            else base = (bf16_t*)(ws + WS_KVM) + (size_t)u.l * 1024 * 1024 + 256 * 2048 + u.pn * 256;
            const int ldc = (u.sub == 0) ? T : 2048;
            f32x4 cs[2][2];
#pragma unroll
            for (int bj = 0; bj < 2; ++bj)
#pragma unroll
                for (int n = 0; n < 2; ++n)
#pragma unroll
                    for (int j = 0; j < 4; ++j) cs[bj][n][j] = scale ? row_scale(u.pn * BM + cl0 + bj * HALF + 4 * n + j) : 1.0f;
#pragma unroll
            for (int ai = 0; ai < 2; ++ai)
#pragma unroll
                for (int m = 0; m < 4; ++m) {
                    const int rl = rl0 + ai * HALF + m * 16;
                    bf16_t* rowp = base + (size_t)rl * ldc + cl0;
#pragma unroll
                    for (int bj = 0; bj < 2; ++bj) { const f32x4 v0 = acc[ai][bj][m][0] * cs[bj][0], v1 = acc[ai][bj][m][1] * cs[bj][1];
                        u32x4 w; w.x = pk2(v0[0], v0[1]); w.y = pk2(v0[2], v0[3]); w.z = pk2(v1[0], v1[1]); w.w = pk2(v1[2], v1[3]);
                        *(u32x4*)(rowp + bj * HALF) = w; }
                }
        } else if (u.kind == K_AB) {
            if (wc == 0 && fq == 0) {
                float* base = (float*)(ws + WS_AB) + (size_t)u.pm * 256 * 8;
#pragma unroll
                for (int ai = 0; ai < 2; ++ai)
#pragma unroll
                    for (int m = 0; m < 4; ++m) {
                        const int rl = rl0 + ai * HALF + m * 16;
                        const float sc = row_scale(u.pm * BM + rl);
                        float* rowp = base + (size_t)rl * 8;
                        *(f32x4*)(rowp) = acc[ai][0][m][0] * sc; *(f32x4*)(rowp + 4) = acc[ai][0][m][1] * sc;
                    }
            }
        } else if (u.kind == K_GATE) {
            bf16_t* base = scratch_tile(u.pm, u.pn);
            const float* bias = b_gate + (size_t)u.l * 4096 + u.sub * 1024 + u.pn * 256;
            f32x4 bv[2][2];
#pragma unroll
            for (int bj = 0; bj < 2; ++bj)
#pragma unroll
                for (int n = 0; n < 2; ++n) bv[bj][n] = *(const f32x4*)(bias + cl0 + bj * HALF + 4 * n);
#pragma unroll
            for (int ai = 0; ai < 2; ++ai)
#pragma unroll
                for (int m = 0; m < 4; ++m) {
                    const int rl = rl0 + ai * HALF + m * 16;
                    const float sc = row_scale(u.pm * BM + rl);
                    bf16_t* rowp = base + (size_t)rl * SCRLD + cl0;
#pragma unroll
                    for (int bj = 0; bj < 2; ++bj) { f32x4 v0 = acc[ai][bj][m][0] * sc + bv[bj][0], v1 = acc[ai][bj][m][1] * sc + bv[bj][1];
#pragma unroll
                        for (int j = 0; j < 4; ++j) { v0[j] = sigmoidf_(v0[j]); v1[j] = sigmoidf_(v1[j]); }
                        u32x4 w; w.x = pk2(v0[0], v0[1]); w.y = pk2(v0[2], v0[3]); w.z = pk2(v1[0], v1[1]); w.w = pk2(v1[2], v1[3]);
                        *(u32x4*)(rowp + bj * HALF) = w; }
                }
        } else if (u.kind == K_BRANCH) {
            bf16_t* base = (bf16_t*)(ws + WS_R) + (size_t)u.pm * 256 * RBLD + RB_MERGED + u.pn * 256; const bf16_t* gbase = scratch_tile(u.pm, u.pn);
            const bool first = (u.sub == 0);
#pragma unroll
            for (int ai = 0; ai < 2; ++ai)
#pragma unroll
                for (int m = 0; m < 4; ++m) {
                    const int rl = rl0 + ai * HALF + m * 16;
                    bf16_t* rowp = base + (size_t)rl * RBLD + cl0; const bf16_t* growp = gbase + (size_t)rl * SCRLD + cl0;
#pragma unroll
                    for (int bj = 0; bj < 2; ++bj) {
                        const u32x4 g = *(const u32x4*)(growp + bj * HALF);
                        u32x4 t = (u32x4){0u, 0u, 0u, 0u}; if (!first) t = *(const u32x4*)(rowp + bj * HALF);
                        const f32x4 v0 = acc[ai][bj][m][0], v1 = acc[ai][bj][m][1];
                        u32x4 w;
                        w.x = pk2(bflo(t.x) + bflo(g.x) * v0[0], bfhi(t.x) + bfhi(g.x) * v0[1]);
                        w.y = pk2(bflo(t.y) + bflo(g.y) * v0[2], bfhi(t.y) + bfhi(g.y) * v0[3]);
                        w.z = pk2(bflo(t.z) + bflo(g.z) * v1[0], bfhi(t.z) + bfhi(g.z) * v1[1]);
                        w.w = pk2(bflo(t.w) + bflo(g.w) * v1[2], bfhi(t.w) + bfhi(g.w) * v1[3]);
                        *(u32x4*)(rowp + bj * HALF) = w; }
                    asm volatile("" ::: "memory");
                }
        } else {
            bf16_t* base = (bf16_t*)(ws + WS_XN) + (size_t)u.pm * 256 * 1024 + u.pn * 256;
            const bool wxn = gnext != nullptr;
#pragma unroll
            for (int ai = 0; ai < 2; ++ai)
#pragma unroll
                for (int m = 0; m < 4; ++m) {
                    const int rl = rl0 + ai * HALF + m * 16;
                    const size_t goff = (size_t)(u.pm * BM + rl) * D + u.pn * BM + cl0;
                    float sq = 0.f;
#pragma unroll
                    for (int bj = 0; bj < 2; ++bj) {
                        const f32x4 x0 = *(const f32x4*)(xin + goff + bj * HALF), x1 = *(const f32x4*)(xin + goff + bj * HALF + 4);
                        const f32x4 v0 = acc[ai][bj][m][0] + x0, v1 = acc[ai][bj][m][1] + x1;
                        *(f32x4*)(xout + goff + bj * HALF) = v0; *(f32x4*)(xout + goff + bj * HALF + 4) = v1;
                        sq += (v0[0] * v0[0] + v0[1] * v0[1]) + (v0[2] * v0[2] + v0[3] * v0[3]) + (v1[0] * v1[0] + v1[1] * v1[1]) + (v1[2] * v1[2] + v1[3] * v1[3]);
                        if (wxn) { const f32x4 g0 = *(const f32x4*)(gnext + u.pn * BM + cl0 + bj * HALF), g1 = *(const f32x4*)(gnext + u.pn * BM + cl0 + bj * HALF + 4);
                            const f32x4 a = v0 * g0, b = v1 * g1;
                            u32x4 w; w.x = pk2(a[0], a[1]); w.y = pk2(a[2], a[3]); w.z = pk2(b[0], b[1]); w.w = pk2(b[2], b[3]);
                            *(u32x4*)(base + (size_t)rl * 1024 + cl0 + bj * HALF) = w; }
                    }
                    sq += shx(sq, 16, lane); sq += shx(sq, 32, lane);
                    if (fq == 0) spare[rl * 4 + wc] = sq;
                    asm volatile("" ::: "memory");
                }
            LDS_WAIT(); __builtin_amdgcn_s_barrier(); asm volatile("" ::: "memory");
            { const int t_ = wr * 256 + wc * 64 + lane; if (t_ < 256) { const int rl = t_; const f32x4 p = *(const LAS f32x4*)(spare + rl * 4);
                ((float*)(ws + WS_SS))[(size_t)(u.pm * BM + rl) * 4 + u.pn] = (p.x + p.y) + (p.z + p.w); } }
        }
    }
};
}

struct Args {
    const float* x; const float* mem; const int* positions; const float* norm_g; const float* mem_norm_g; const float* w_in; const float* b_gate;
    const float* dn_conv_w; const float* dn_a_log; const float* dn_dt_bias; const float* dn_norm_g; const float* ret_norm_g; const float* w_mem_kv;
    const float* w_br_sb; const float* w_br_dn; const float* w_br_ret; const float* w_br_mem; const float* w_out; const float* final_norm_g;
    float* out; unsigned char* ws; int ph_lo, ph_hi, li, pad;
};
struct Frame { LAS unsigned char* lds; int tid, lane, wave, G, gw, NGW; };
DI Frame mkframe(int wv) {
    extern __shared__ __attribute__((aligned(16))) unsigned char lds_raw[];
    Frame F; F.lds = (LAS unsigned char*)lds_raw; F.tid = opaque_tid(wv); F.lane = F.tid & 63; F.wave = wv;
    F.G = gridDim.x; F.gw = blockIdx.x * NWAVES + F.wave; F.NGW = F.G * NWAVES; return F;
}
typedef const __attribute__((address_space(4))) Args* ArgsP;
DI ArgsP kargs() { unsigned long long p = (unsigned long long)__builtin_amdgcn_kernarg_segment_ptr(); asm volatile("" : "+s"(p)); return (ArgsP)p; }

DI void transpose_seg(const Frame& F, const float* W, int K, int Nsrc, int c0, int ncols, bf16_t* WT, int r0) {
    LAS float* scr = (LAS float*)(F.lds + F.wave * 16384);
    const int nblk = ncols / 32, nitems = (K / 64) * nblk, lane = F.lane;
    for (int item = F.gw; item < nitems; item += F.NGW) {
        const int kb = item / nblk, nb = item % nblk, k0 = 64 * kb, n0 = 32 * nb;
#pragma unroll 8
        for (int i = 0; i < 32; ++i) { const int kk = 2 * i + (lane >> 5); scr[kk * 33 + (lane & 31)] = W[(size_t)(k0 + kk) * Nsrc + c0 + n0 + (lane & 31)]; }
        LDS_WAIT(); asm volatile("" ::: "memory");
        const int c = lane & 7;
#pragma unroll
        for (int j = 0; j < 4; ++j) { const int n = (lane >> 3) + 8 * j; const LAS float* s = scr + (8 * c) * 33 + n;
            u32x4 o; o.x = pk2(s[0 * 33], s[1 * 33]); o.y = pk2(s[2 * 33], s[3 * 33]); o.z = pk2(s[4 * 33], s[5 * 33]); o.w = pk2(s[6 * 33], s[7 * 33]);
            *(u32x4*)(WT + (size_t)(r0 + n0 + n) * K + k0 + 8 * c) = o; }
        LDS_WAIT(); asm volatile("" ::: "memory");
    }
}
DI void p0_prologue(int wv) {
    const Frame F = mkframe(wv);
    const ArgsP ap = kargs();
    unsigned char* ws = ap->ws;
    for (int l = 0; l < DEPTH; ++l) {
        const float* win = ap->w_in + (size_t)l * D * IN_COLS;
        bf16_t* wa = (bf16_t*)(ws + WS_WINA) + (size_t)l * 3072 * 1024; bf16_t* wb = (bf16_t*)(ws + WS_WINB) + (size_t)l * 3072 * 1024;
        bf16_t* wg = (bf16_t*)(ws + WS_WG) + (size_t)l * 4096 * 1024; bf16_t* wbr = (bf16_t*)(ws + WS_WBR) + (size_t)l * 2 * 1024 * 1024;
        transpose_seg(F, win, 1024, IN_COLS, 2048, 2048, wa, 0);
        transpose_seg(F, win, 1024, IN_COLS, 5640, 256, wa, 2304);
        transpose_seg(F, win, 1024, IN_COLS, 4104, 256, wa, 2560);
        transpose_seg(F, win, 1024, IN_COLS, 4360, 256, wa, 2816);
        transpose_seg(F, win, 1024, IN_COLS, 0, 1024, wb, 0);
        transpose_seg(F, win, 1024, IN_COLS, 1536, 512, wb, 1024);
        transpose_seg(F, win, 1024, IN_COLS, 5128, 512, wb, 1536);
        transpose_seg(F, win, 1024, IN_COLS, 1024, 512, wb, 2048);
        transpose_seg(F, win, 1024, IN_COLS, 4616, 512, wb, 2560);
        transpose_seg(F, win, 1024, IN_COLS, 5896, 4096, wg, 0);
        transpose_seg(F, ap->w_br_sb + (size_t)l * 512 * 1024, 512, 1024, 0, 1024, wbr, 0);
        transpose_seg(F, ap->w_br_dn + (size_t)l * 512 * 1024, 512, 1024, 0, 1024, wbr + 1024 * 512, 0);
        transpose_seg(F, ap->w_br_ret + (size_t)l * 512 * 1024, 512, 1024, 0, 1024, wbr + 2 * 1024 * 512, 0);
        transpose_seg(F, ap->w_br_mem + (size_t)l * 256 * 1024, 256, 1024, 0, 1024, wbr + 3 * 1024 * 512, 0);
        transpose_seg(F, ap->w_out + (size_t)l * 1024 * 1024, 1024, 1024, 0, 1024, (bf16_t*)(ws + WS_WOUT) + (size_t)l * 1024 * 1024, 0);
        transpose_seg(F, ap->w_mem_kv + (size_t)l * 1024 * 512, 1024, 512, 0, 512, (bf16_t*)(ws + WS_WKV) + (size_t)l * 512 * 1024, 0);
        for (int i = F.gw * 64 + F.lane; i < 256 * 1024; i += F.NGW * 64) { const int r = i >> 10, k = i & 1023;
            wa[(size_t)(2048 + r) * 1024 + k] = r < 8 ? (bf16_t)f2bf(win[(size_t)k * IN_COLS + 4096 + r]) : (bf16_t)0; }
    }
    for (int m = F.gw; m < T; m += F.NGW) {
        const f32x4* xr = (const f32x4*)(ap->x + (size_t)m * D) + F.lane; const f32x4* gr = (const f32x4*)ap->norm_g + F.lane;
        unsigned long long* o8 = (unsigned long long*)((bf16_t*)(ws + WS_XN) + (size_t)m * D) + F.lane; float s = 0.f;
#pragma unroll
        for (int j = 0; j < 4; ++j) { const f32x4 v = xr[64 * j], g = gr[64 * j]; s += (v.x * v.x + v.y * v.y) + (v.z * v.z + v.w * v.w);
            o8[64 * j] = (unsigned long long)pk2(v.x * g.x, v.y * g.y) | ((unsigned long long)pk2(v.z * g.z, v.w * g.w) << 32); }
        s = wave_sum(s, F.lane);
        if (F.lane == 0) *(f32x4*)((float*)(ws + WS_SS) + (size_t)m * 4) = (f32x4){s, 0.f, 0.f, 0.f};
    }
    for (int it = F.gw; it < DEPTH * BATCH * MEMLEN; it += F.NGW) {
        const int l = it / (BATCH * MEMLEN), m = it % (BATCH * MEMLEN);
        const f32x4* xr = (const f32x4*)(ap->mem + (size_t)m * D) + F.lane; const f32x4* gr = (const f32x4*)(ap->mem_norm_g + (size_t)l * D) + F.lane;
        f32x4 v[4]; float s = 0.f;
#pragma unroll
        for (int j = 0; j < 4; ++j) { v[j] = xr[64 * j]; s += (v[j].x * v[j].x + v[j].y * v[j].y) + (v[j].z * v[j].z + v[j].w * v[j].w); }
        const float rs = rsqrtf(wave_sum(s, F.lane) * (1.f / D) + EPS);
        unsigned long long* o8 = (unsigned long long*)((bf16_t*)(ws + WS_MEMN) + ((size_t)l * BATCH * MEMLEN + m) * D) + F.lane;
#pragma unroll
        for (int j = 0; j < 4; ++j) { const f32x4 g = gr[64 * j];
            o8[64 * j] = (unsigned long long)pk2(v[j].x * rs * g.x, v[j].y * rs * g.y) | ((unsigned long long)pk2(v[j].z * rs * g.z, v[j].w * rs * g.w) << 32); }
    }
    for (int i = F.gw * 64 + F.lane; i < T * 32; i += F.NGW * 64) {
        const int t = i >> 5, f = i & 31;
        const float inv = (float)pow(10000.0, -(double)f / 32.0);
        const float ang = (float)ap->positions[t] * inv;
        ((float*)(ws + WS_ROPE))[i] = (float)cos((double)ang); ((float*)(ws + WS_ROPE))[T * 32 + i] = (float)sin((double)ang);
    }
}

struct SchedP1 {
    gm::TileOrder ord; unsigned char* ws; int l, half, c; bool with_kvm;
    DI bool next(int i, gm::Unit& u) const {
        int pm, pn;
        if (ord.tile(i, pm, pn)) {
            const bf16_t* xn = (const bf16_t*)(ws + WS_XN) + (size_t)pm * 256 * 1024;
            const bf16_t* w = (const bf16_t*)(ws + (half == 0 ? WS_WINA : WS_WINB)) + ((size_t)l * 3072 + pn * 256) * 1024;
            u.lda = 1024; u.K = 1024; u.ldb = 1024; u.l = l; u.sub = half;
            if (half == 1 && pn >= 8) { u.A = w; u.B = xn; u.pm = pn - 8; u.pn = pm; u.kind = gm::K_STORE_T; u.sub = 0; }
            else { u.A = xn; u.B = w; u.pm = pm; u.pn = pn; u.kind = (half == 0 && pn == 8) ? gm::K_AB : gm::K_STORE; }
            return true;
        }
        if (with_kvm && c < 32 && i == (ord.nwg + ord.G - 1 - c) / ord.G) {
            const int ll = c >> 4, ty = (c >> 3) & 1, idx = c & 7;
            const bf16_t* mn = (const bf16_t*)(ws + WS_MEMN) + ((size_t)ll * 2048 + idx * 256) * 1024;
            const bf16_t* w = (const bf16_t*)(ws + WS_WKV) + ((size_t)ll * 512 + ty * 256) * 1024;
            u.lda = 1024; u.K = 1024; u.ldb = 1024; u.l = ll;
            if (ty == 0) { u.A = mn; u.B = w; u.pm = idx; u.pn = 0; u.kind = gm::K_STORE; u.sub = 2; }
            else { u.A = w; u.B = mn; u.pm = 0; u.pn = idx; u.kind = gm::K_STORE_T; u.sub = 1; }
            return true;
        }
        return false;
    }
};
struct SchedP3 {
    int pm, pn, l; bool ok; unsigned char* ws;
    DI bool next(int i, gm::Unit& u) const {
        if (!ok || i >= 8) return false;
        const int br = i >> 1;
        const bf16_t* R = (const bf16_t*)(ws + WS_R); const bf16_t* P = (const bf16_t*)(ws + WS_P);
        u.pm = pm; u.pn = pn; u.sub = br; u.l = l;
        if ((i & 1) == 0) {
            u.A = (const bf16_t*)(ws + WS_XN) + (size_t)pm * 256 * 1024; u.lda = 1024; u.K = 1024; u.ldb = 1024;
            u.B = (const bf16_t*)(ws + WS_WG) + ((size_t)l * 4096 + br * 1024 + pn * 256) * 1024;
            u.kind = gm::K_GATE;
        } else {
            const bf16_t* wbr = (const bf16_t*)(ws + WS_WBR) + (size_t)l * 2 * 1024 * 1024 + (size_t)br * 1024 * 512;
            const int K = br == 3 ? 256 : 512;
            const int acol = br == 0 ? RB_SBQ : (br == 1 ? P_DNZ : (br == 2 ? RB_RTZ : P_MEMQ));
            const bool inP = (br & 1) != 0;
            u.lda = inP ? PLD : RBLD; u.A = (inP ? P : R) + (size_t)pm * 256 * u.lda + acol; u.K = K; u.ldb = K; u.B = wbr + (size_t)pn * 256 * K;
            u.kind = gm::K_BRANCH;
        }
        return true;
    }
};
struct SchedP4 {
    int pm, pn, l; bool ok; unsigned char* ws;
    DI bool next(int i, gm::Unit& u) const {
        if (!ok || i >= 1) return false;
        u.A = (const bf16_t*)(ws + WS_R) + (size_t)pm * 256 * RBLD + RB_MERGED; u.lda = RBLD; u.K = 1024; u.ldb = 1024;
        u.B = (const bf16_t*)(ws + WS_WOUT) + ((size_t)l * 1024 + pn * 256) * 1024;
        u.pm = pm; u.pn = pn; u.kind = gm::K_OUT; u.sub = 0; u.l = l;
        return true;
    }
};

typedef float f32x16 __attribute__((ext_vector_type(16)));
typedef short s16x4 __attribute__((ext_vector_type(4)));
#define MFMA32(a, b, c) __builtin_amdgcn_mfma_f32_32x32x16_bf16((a), (b), (c), 0, 0, 0)
DI int crow(int reg, int hh) { return (reg & 3) + 8 * (reg >> 2) + 4 * hh; }
DI bf16x8 pack8(float a0, float a1, float a2, float a3, float a4, float a5, float a6, float a7) {
    u32x4 p;
    asm volatile("s_nop 0\n\tv_cvt_pk_bf16_f32 %0, %4, %5\n\tv_cvt_pk_bf16_f32 %1, %6, %7\n\tv_cvt_pk_bf16_f32 %2, %8, %9\n\tv_cvt_pk_bf16_f32 %3, %10, %11\n\ts_nop 1"
                 : "=&v"(p[0]), "=&v"(p[1]), "=&v"(p[2]), "=&v"(p[3]) : "v"(a0), "v"(a1), "v"(a2), "v"(a3), "v"(a4), "v"(a5), "v"(a6), "v"(a7));
    return __builtin_bit_cast(bf16x8, p);
}
DI bf16x8 pack8m(float a0, float a1, float a2, float a3, float a4, float a5, float a6, float a7) {
    u32x4 p;
    asm volatile("s_nop 15\n\ts_nop 3\n\tv_cvt_pk_bf16_f32 %0, %4, %5\n\tv_cvt_pk_bf16_f32 %1, %6, %7\n\tv_cvt_pk_bf16_f32 %2, %8, %9\n\tv_cvt_pk_bf16_f32 %3, %10, %11\n\ts_nop 1"
                 : "=&v"(p[0]), "=&v"(p[1]), "=&v"(p[2]), "=&v"(p[3]) : "v"(a0), "v"(a1), "v"(a2), "v"(a3), "v"(a4), "v"(a5), "v"(a6), "v"(a7));
    return __builtin_bit_cast(bf16x8, p);
}
namespace at {
constexpr int KST = 144, VST = 136;
constexpr int KT_BYTES = 64 * KST;
DI bf16x8 kfrag(LAS unsigned char* kt, int row, int ks, int hh) { return *(const LAS bf16x8*)(kt + row * KST + ks * 32 + hh * 16); }
DI bf16x8 vfrag(LAS unsigned char* vt, int row, int keyoff, int hh) {
    const LAS unsigned char* pp = vt + row * VST + (keyoff + 4 * hh) * 2;
    const u32x2 lo = *(const LAS u32x2*)pp, hi = *(const LAS u32x2*)(pp + 16);
    u32x4 r; r.x = lo.x; r.y = lo.y; r.z = hi.x; r.w = hi.y; return __builtin_bit_cast(bf16x8, r);
}
}

DI void mem_unit(int wv, int l, int unit) {
    const Frame F = mkframe(wv);
    unsigned char* ws = kargs()->ws; bf16_t* P = (bf16_t*)(ws + WS_P);
    const bf16_t* KM = (const bf16_t*)(ws + WS_KVM) + (size_t)l * 1024 * 1024; const bf16_t* VTM = KM + 2048 * 256;
    const int b = unit >> 5, h = (unit >> 3) & 3, qt = unit & 7, lane = F.lane, r = lane & 31, hh = lane >> 5;
    LAS unsigned char* kt = F.lds; LAS unsigned char* vt = F.lds + 256 * at::KST;
    constexpr int VS = 520;
#pragma unroll
    for (int i = 0; i < 4; ++i) { const int id = F.tid + 512 * i, row = id >> 3, ch = id & 7;
        const u32x4 v = *(const u32x4*)(KM + (size_t)(b * 256 + row) * 256 + h * 64 + ch * 8);
        *(LAS u32x4*)(kt + row * at::KST + ch * 16) = v; }
#pragma unroll
    for (int i = 0; i < 4; ++i) { const int id = F.tid + 512 * i, row = id >> 5, ch = id & 31;
        const u32x4 v = *(const u32x4*)(VTM + (size_t)(h * 64 + row) * 2048 + b * 256 + ch * 8);
        *(LAS u32x2*)(vt + row * VS + ch * 16) = (u32x2){v.x, v.y}; *(LAS u32x2*)(vt + row * VS + ch * 16 + 8) = (u32x2){v.z, v.w}; }
    const int t = b * SEQ + qt * 256 + wv * 32 + r;
    bf16_t* qp = P + (size_t)t * PLD + P_MEMQ + h * 64;
    bf16x8 qf[4];
#pragma unroll
    for (int ks = 0; ks < 4; ++ks) qf[ks] = *(const bf16x8*)(qp + 16 * ks + 8 * hh);
    __syncthreads();
    f32x16 z[8];
#pragma unroll
    for (int st = 0; st < 8; ++st) {
        f32x16 a = {0.f, 0.f, 0.f, 0.f, 0.f, 0.f, 0.f, 0.f, 0.f, 0.f, 0.f, 0.f, 0.f, 0.f, 0.f, 0.f};
#pragma unroll
        for (int ks = 0; ks < 4; ++ks) a = MFMA32(at::kfrag(kt, 32 * st + r, ks, hh), qf[ks], a);
        z[st] = a;
    }
    float mx = -3.0e38f;
#pragma unroll
    for (int st = 0; st < 8; ++st)
#pragma unroll
        for (int i = 0; i < 16; ++i) mx = fmaxf(mx, z[st][i]);
    mx = fmaxf(mx, shx(mx, 32, lane));
    const float c2 = 0.125f * 1.4426950408889634f; float sum = 0.f;
#pragma unroll
    for (int st = 0; st < 8; ++st)
#pragma unroll
        for (int i = 0; i < 16; ++i) { const float e = exp2f((z[st][i] - mx) * c2); z[st][i] = e; sum += e; }
    sum += shx(sum, 32, lane);
    f32x16 o0 = {0.f, 0.f, 0.f, 0.f, 0.f, 0.f, 0.f, 0.f, 0.f, 0.f, 0.f, 0.f, 0.f, 0.f, 0.f, 0.f}, o1 = o0;
#pragma unroll
    for (int st = 0; st < 8; ++st)
#pragma unroll
        for (int s2 = 0; s2 < 2; ++s2) {
            const bf16x8 pf = pack8(z[st][8 * s2], z[st][8 * s2 + 1], z[st][8 * s2 + 2], z[st][8 * s2 + 3], z[st][8 * s2 + 4], z[st][8 * s2 + 5], z[st][8 * s2 + 6], z[st][8 * s2 + 7]);
            const int keyoff = 32 * st + 16 * s2;
            { const LAS unsigned char* pp = vt + r * VS + (keyoff + 4 * hh) * 2; const u32x2 lo = *(const LAS u32x2*)pp, hi = *(const LAS u32x2*)(pp + 16);
              u32x4 q; q.x = lo.x; q.y = lo.y; q.z = hi.x; q.w = hi.y; o0 = MFMA32(__builtin_bit_cast(bf16x8, q), pf, o0); }
            { const LAS unsigned char* pp = vt + (32 + r) * VS + (keyoff + 4 * hh) * 2; const u32x2 lo = *(const LAS u32x2*)pp, hi = *(const LAS u32x2*)(pp + 16);
              u32x4 q; q.x = lo.x; q.y = lo.y; q.z = hi.x; q.w = hi.y; o1 = MFMA32(__builtin_bit_cast(bf16x8, q), pf, o1); }
        }
    const float inv = 1.f / sum;
#pragma unroll
    for (int g = 0; g < 4; ++g) {
        *(u32x2*)(qp + 8 * g + 4 * hh) = (u32x2){pk2(o0[4 * g] * inv, o0[4 * g + 1] * inv), pk2(o0[4 * g + 2] * inv, o0[4 * g + 3] * inv)};
        *(u32x2*)(qp + 32 + 8 * g + 4 * hh) = (u32x2){pk2(o1[4 * g] * inv, o1[4 * g + 1] * inv), pk2(o1[4 * g + 2] * inv, o1[4 * g + 3] * inv)};
    }
    __syncthreads();
}

DI void ret_rope_prep(int wv) {
    const Frame F = mkframe(wv);
    unsigned char* ws = kargs()->ws; bf16_t* P = (bf16_t*)(ws + WS_P);
    const float* rc = (const float*)(ws + WS_ROPE); const float* rsn = rc + T * 32;
    for (int it = blockIdx.x * NTHREADS + F.tid; it < T * 32; it += gridDim.x * NTHREADS) {
        const int t = it >> 5, w = (it >> 4) & 1, h = (it >> 2) & 3, g = it & 3;
        bf16_t* pp = P + (size_t)t * PLD + (w ? P_RTK : P_RTQ) + h * 64 + g * 8;
        const u32x4 a = *(const u32x4*)pp, bq = *(const u32x4*)(pp + 32);
        const f32x4 c0 = *(const f32x4*)(rc + (size_t)t * 32 + g * 8), c1 = *(const f32x4*)(rc + (size_t)t * 32 + g * 8 + 4);
        const f32x4 s0 = *(const f32x4*)(rsn + (size_t)t * 32 + g * 8), s1 = *(const f32x4*)(rsn + (size_t)t * 32 + g * 8 + 4);
        const float sc = w ? 0.125f : 1.0f;
        float x1[8] = {bflo(a.x), bfhi(a.x), bflo(a.y), bfhi(a.y), bflo(a.z), bfhi(a.z), bflo(a.w), bfhi(a.w)};
        float x2[8] = {bflo(bq.x), bfhi(bq.x), bflo(bq.y), bfhi(bq.y), bflo(bq.z), bfhi(bq.z), bflo(bq.w), bfhi(bq.w)};
        float cc[8] = {c0.x, c0.y, c0.z, c0.w, c1.x, c1.y, c1.z, c1.w}, ss[8] = {s0.x, s0.y, s0.z, s0.w, s1.x, s1.y, s1.z, s1.w};
        float y1[8], y2[8];
#pragma unroll
        for (int j = 0; j < 8; ++j) { y1[j] = (x1[j] * cc[j] - x2[j] * ss[j]) * sc; y2[j] = (x1[j] * ss[j] + x2[j] * cc[j]) * sc; }
        *(u32x4*)pp = (u32x4){pk2(y1[0], y1[1]), pk2(y1[2], y1[3]), pk2(y1[4], y1[5]), pk2(y1[6], y1[7])};
        *(u32x4*)(pp + 32) = (u32x4){pk2(y2[0], y2[1]), pk2(y2[2], y2[3]), pk2(y2[4], y2[5]), pk2(y2[6], y2[7])};
    }
}

template <int MODE>
DI void attn_unit(int wv, int l, int unit) {
    constexpr int DV = MODE == 0 ? 64 : 128, NDT = DV / 32, VT_BYTES = DV * at::VST, BUF = at::KT_BYTES + VT_BYTES;
    const Frame F = mkframe(wv);
    const ArgsP ap = kargs();
    unsigned char* ws = ap->ws; bf16_t* R = (bf16_t*)(ws + WS_R); bf16_t* P = (bf16_t*)(ws + WS_P);
    const int lane = F.lane, r = lane & 31, hh = lane >> 5;
    int b, h, qt;
    if (MODE == 0) { b = unit >> 6; h = (unit >> 3) & 7; qt = unit & 7; } else { b = unit >> 5; h = (unit >> 3) & 3; qt = 7 - (unit & 7); }
    const int q0 = qt * 256, qw0 = q0 + 32 * wv, tq = qw0 + r, t = b * SEQ + tq;
    const bf16_t* Kg = MODE == 0 ? R + RB_SBK + h * 64 : P + P_RTK + h * 64; const int kld = MODE == 0 ? RBLD : PLD;
    const bf16_t* VTg = (const bf16_t*)(ws + (MODE == 0 ? WS_VTSB : WS_VTRT)) + (size_t)h * DV * T + b * SEQ;
    const bf16_t* qp = MODE == 0 ? R + (size_t)t * RBLD + RB_SBQ + h * 64 : P + (size_t)t * PLD + P_RTQ + h * 64;
    bf16x8 qf[4];
#pragma unroll
    for (int ks = 0; ks < 4; ++ks) qf[ks] = *(const bf16x8*)(qp + 16 * ks + 8 * hh);
    f32x16 o[NDT];
#pragma unroll
    for (int d = 0; d < NDT; ++d) o[d] = (f32x16){0.f, 0.f, 0.f, 0.f, 0.f, 0.f, 0.f, 0.f, 0.f, 0.f, 0.f, 0.f, 0.f, 0.f, 0.f, 0.f};
    volatile LAS unsigned* flags = (volatile LAS unsigned*)(F.lds + 2 * BUF);
    const int jtop = (q0 + 255) >> 6;
    const int srow = F.tid >> 3, sch = F.tid & 7;
    u32x4 kreg, vreg[NDT / 2];
#define AT_LOAD(j) do { const int key0_ = (j) * 64; kreg = *(const u32x4*)(Kg + (size_t)(b * SEQ + key0_ + srow) * kld + sch * 8); \
        _Pragma("unroll") for (int i_ = 0; i_ < NDT / 2; ++i_) vreg[i_] = *(const u32x4*)(VTg + (size_t)(srow + 64 * i_) * T + key0_ + sch * 8); } while (0)
#define AT_WRITE(pbuf) do { LAS unsigned char* kb_ = F.lds + (pbuf) * BUF; *(LAS u32x4*)(kb_ + srow * at::KST + sch * 16) = kreg; \
        _Pragma("unroll") for (int i_ = 0; i_ < NDT / 2; ++i_) { LAS unsigned char* vp_ = kb_ + at::KT_BYTES + (srow + 64 * i_) * at::VST + sch * 16; \
            *(LAS u32x2*)vp_ = (u32x2){vreg[i_].x, vreg[i_].y}; *(LAS u32x2*)(vp_ + 8) = (u32x2){vreg[i_].z, vreg[i_].w}; } } while (0)
    AT_LOAD(jtop); AT_WRITE(0);
    __syncthreads();
    float carry = 0.f; bool done_w = false;
    const float c2 = 0.125f * 1.4426950408889634f;
    const float lg = MODE == 1 ? log2f(1.0f - exp2f(-5.0f - (float)h)) : 0.f;
    for (int j = jtop, it = 0; ; --j, ++it) {
        const int pbuf = it & 1;
        if (j > 0) AT_LOAD(j - 1);
        LAS unsigned char* kt = F.lds + pbuf * BUF; LAS unsigned char* vt = kt + at::KT_BYTES;
        const int key0 = j * 64;
        if (!done_w) {
#pragma unroll
            for (int sti = 0; sti < 2; ++sti) {
                const int st = 1 - sti, ks0 = key0 + 32 * st;
                if (ks0 <= qw0 + 31 - (MODE == 0 ? 1 : 0)) {
                    f32x16 z = {0.f, 0.f, 0.f, 0.f, 0.f, 0.f, 0.f, 0.f, 0.f, 0.f, 0.f, 0.f, 0.f, 0.f, 0.f, 0.f};
#pragma unroll
                    for (int ks = 0; ks < 4; ++ks) z = MFMA32(at::kfrag(kt, 32 * st + r, ks, hh), qf[ks], z);
                    float w[16];
                    if (MODE == 0) {
                        float ls[16], lz[16];
#pragma unroll
                        for (int i = 0; i < 16; ++i) {
                            const float z2 = z[i] * c2; const bool m = (ks0 + crow(i, hh)) < tq;
                            const float sp = z2 > 30.f ? z2 : __log2f(1.f + exp2f(z2));
                            ls[i] = m ? -sp : 0.f; lz[i] = m ? z2 - sp : -1.0e30f;
                        }
                        float qs[4], pq[4], aq[4];
#pragma unroll
                        for (int i = 0; i < 4; ++i) { qs[i] = (ls[4 * i] + ls[4 * i + 1]) + (ls[4 * i + 2] + ls[4 * i + 3]); pq[i] = shx(qs[i], 32, lane); }
                        float run = carry;
#pragma unroll
                        for (int i = 3; i >= 0; --i) { aq[i] = run + (hh == 0 ? pq[i] : 0.f); run += qs[i] + pq[i]; }
                        carry = run;
#pragma unroll
                        for (int i = 0; i < 4; ++i) {
                            const float a3 = aq[i], a2 = a3 + ls[4 * i + 3], a1 = a2 + ls[4 * i + 2], a0 = a1 + ls[4 * i + 1];
                            w[4 * i + 3] = exp2f(lz[4 * i + 3] + a3); w[4 * i + 2] = exp2f(lz[4 * i + 2] + a2); w[4 * i + 1] = exp2f(lz[4 * i + 1] + a1); w[4 * i] = exp2f(lz[4 * i] + a0);
                        }
                    } else {
#pragma unroll
                        for (int i = 0; i < 16; ++i) { const int dlt = tq - (ks0 + crow(i, hh)); w[i] = dlt >= 0 ? z[i] * exp2f(lg * (float)dlt) : 0.f; }
                    }
#pragma unroll
                    for (int s2 = 0; s2 < 2; ++s2) {
                        const bf16x8 pf = pack8(w[8 * s2], w[8 * s2 + 1], w[8 * s2 + 2], w[8 * s2 + 3], w[8 * s2 + 4], w[8 * s2 + 5], w[8 * s2 + 6], w[8 * s2 + 7]);
#pragma unroll
                        for (int d = 0; d < NDT; ++d) o[d] = MFMA32(at::vfrag(vt, 32 * d + r, 32 * st + 16 * s2, hh), pf, o[d]);
                    }
                }
            }
            if (MODE == 0) done_w = __all(carry < -150.f);
        }
        if (j > 0) AT_WRITE(pbuf ^ 1);
        if (F.lane == 0) flags[(it & 1) * 8 + wv] = done_w ? 1u : 0u;
        __syncthreads();
        if (j == 0) break;
        if (MODE == 0) { unsigned all = 1u;
#pragma unroll
            for (int w8 = 0; w8 < 8; ++w8) all &= flags[(it & 1) * 8 + w8];
            if (all) break; }
    }
#undef AT_LOAD
#undef AT_WRITE
    if (MODE == 0) {
        bf16_t* op = R + (size_t)t * RBLD + RB_SBQ + h * 64; const bf16_t* zp = R + (size_t)t * RBLD + RB_SBZ + h * 64;
#pragma unroll
        for (int d = 0; d < NDT; ++d)
#pragma unroll
            for (int g = 0; g < 4; ++g) { const int c = 32 * d + 8 * g + 4 * hh; const u32x2 zz = *(const u32x2*)(zp + c);
                *(u32x2*)(op + c) = (u32x2){pk2(o[d][4 * g] * siluf_(bflo(zz.x)), o[d][4 * g + 1] * siluf_(bfhi(zz.x))), pk2(o[d][4 * g + 2] * siluf_(bflo(zz.y)), o[d][4 * g + 3] * siluf_(bfhi(zz.y)))}; }
    } else {
        float s1 = 0.f;
#pragma unroll
        for (int d = 0; d < NDT; ++d)
#pragma unroll
            for (int i = 0; i < 16; ++i) s1 += o[d][i];
        s1 += shx(s1, 32, lane);
        const float mu = s1 * (1.f / 128.f); float s2 = 0.f;
#pragma unroll
        for (int d = 0; d < NDT; ++d)
#pragma unroll
            for (int i = 0; i < 16; ++i) { const float dl = o[d][i] - mu; s2 += dl * dl; }
        s2 += shx(s2, 32, lane);
        const float rs = rsqrtf(s2 * (1.f / 128.f) + EPS);
        bf16_t* zp = R + (size_t)t * RBLD + RB_RTZ + h * 128; const float* gp = ap->ret_norm_g + (size_t)l * 512 + h * 128;
#pragma unroll
        for (int d = 0; d < NDT; ++d)
#pragma unroll
            for (int g = 0; g < 4; ++g) { const int c = 32 * d + 8 * g + 4 * hh; const u32x2 zz = *(const u32x2*)(zp + c); const f32x4 gg = *(const f32x4*)(gp + c);
                *(u32x2*)(zp + c) = (u32x2){pk2((o[d][4 * g] - mu) * rs * gg.x * siluf_(bflo(zz.x)), (o[d][4 * g + 1] - mu) * rs * gg.y * siluf_(bfhi(zz.x))),
                                            pk2((o[d][4 * g + 2] - mu) * rs * gg.z * siluf_(bflo(zz.y)), (o[d][4 * g + 3] - mu) * rs * gg.w * siluf_(bfhi(zz.y)))}; }
    }
    __syncthreads();
}

namespace dn {
constexpr int HC_BYTES = 73728, OFF_W = 0, OFF_QG = 16384, OFF_KD = 32768, OFF_AI = 49152, OFF_U = 57344;
constexpr int QST = 272, TST = 144;
constexpr int GRP_BYTES = 71680, Q_OFF = 0, K_OFF = 17408, KT_OFF = 34816, VT_OFF = 53248, VEC_OFF = 143360, VEC_BYTES = 2048;
}

DI void dn_prep(int wv, int l, int pair) {
    const Frame F = mkframe(wv);
    const ArgsP ap = kargs();
    unsigned char* ws = ap->ws;
    const int lane = F.lane, r = lane & 31, hh = lane >> 5, grp = wv >> 2, gw = wv & 3, gt = F.tid & 255;
    const int hc = pair * 2 + grp, h = hc & 3, bn = hc >> 2, b = bn >> 5, n = bn & 31, t0 = b * SEQ + n * 64;
    LAS unsigned char* gb = F.lds + grp * dn::GRP_BYTES;
    LAS unsigned char* qimg = gb + dn::Q_OFF; LAS unsigned char* kimg = gb + dn::K_OFF; LAS unsigned char* ktimg = gb + dn::KT_OFF; LAS unsigned char* vtimg = gb + dn::VT_OFF;
    LAS float* vec = (LAS float*)(F.lds + dn::VEC_OFF + grp * dn::VEC_BYTES);
    LAS float* gcv = vec; LAS float* btv = vec + 64; LAS float* f1v = vec + 128; LAS float* f2v = vec + 192; LAS float* egv = vec + 256;
    unsigned char* blk = ws + WS_DNI + (size_t)hc * dn::HC_BYTES;
    const bf16_t* RA = (const bf16_t*)(ws + WS_R); const float* cw = ap->dn_conv_w + (size_t)l * 4 * 1536; const float* AB = (const float*)(ws + WS_AB);
    {
        const int g8 = gt & 15, ch = g8 * 8;
#pragma unroll 1
        for (int part = 0; part < 3; ++part) {
            const int col = part * 512 + h * 128 + ch;
            f32x4 wj[4][2];
#pragma unroll
            for (int j = 0; j < 4; ++j) { wj[j][0] = *(const f32x4*)(cw + j * 1536 + col); wj[j][1] = *(const f32x4*)(cw + j * 1536 + col + 4); }
            u32x4 xr[4][4];
#pragma unroll
            for (int k = 0; k < 4; ++k)
#pragma unroll
                for (int j = 0; j < 4; ++j) { const int m = (gt >> 4) + 16 * k; xr[k][j] = (n * 64 + m - 3 + j >= 0) ? *(const u32x4*)(RA + (size_t)(t0 + m - 3 + j) * RALD + col) : (u32x4){0u, 0u, 0u, 0u}; }
#pragma unroll
            for (int k = 0; k < 4; ++k) {
                const int m = (gt >> 4) + 16 * k, t = t0 + m;
                float a[8] = {0.f, 0.f, 0.f, 0.f, 0.f, 0.f, 0.f, 0.f};
#pragma unroll
                for (int j = 0; j < 4; ++j) { const u32x4 x = xr[k][j];
                    a[0] += wj[j][0].x * bflo(x.x); a[1] += wj[j][0].y * bfhi(x.x); a[2] += wj[j][0].z * bflo(x.y); a[3] += wj[j][0].w * bfhi(x.y);
                    a[4] += wj[j][1].x * bflo(x.z); a[5] += wj[j][1].y * bfhi(x.z); a[6] += wj[j][1].z * bflo(x.w); a[7] += wj[j][1].w * bfhi(x.w);
                }
                float ssq = 0.f;
#pragma unroll
                for (int i = 0; i < 8; ++i) { a[i] = siluf_(a[i]); ssq += a[i] * a[i]; }
                if (part < 2) {
                    ssq += shx(ssq, 1, lane); ssq += shx(ssq, 2, lane); ssq += shx(ssq, 4, lane); ssq += shx(ssq, 8, lane);
                    const float rn = rsqrtf(ssq + EPS);
#pragma unroll
                    for (int i = 0; i < 8; ++i) a[i] *= rn;
                } else {
                    const float beta = sigmoidf_(AB[(size_t)t * 8 + 4 + h]);
#pragma unroll
                    for (int i = 0; i < 8; ++i) a[i] *= beta;
                }
                const u32x4 pk = (u32x4){pk2(a[0], a[1]), pk2(a[2], a[3]), pk2(a[4], a[5]), pk2(a[6], a[7])};
                if (part == 0) {
                    *(LAS u32x4*)(qimg + m * dn::QST + ch * 2) = pk;
                    if (g8 == 0) { const float xa = AB[(size_t)t * 8 + h] + ap->dn_dt_bias[l * 4 + h]; const float sp = xa > 20.f ? xa : log1pf(__expf(xa));
                        gcv[m] = -__expf(ap->dn_a_log[l * 4 + h]) * sp; btv[m] = sigmoidf_(AB[(size_t)t * 8 + 4 + h]); }
                } else {
                    if (part == 1) *(LAS u32x4*)(kimg + m * dn::QST + ch * 2) = pk;
                    LAS unsigned char* timg = (part == 1 ? ktimg : vtimg) + m * 2;
                    *(LAS unsigned short*)(timg + (ch + 0) * dn::TST) = (unsigned short)pk.x; *(LAS unsigned short*)(timg + (ch + 1) * dn::TST) = (unsigned short)(pk.x >> 16);
                    *(LAS unsigned short*)(timg + (ch + 2) * dn::TST) = (unsigned short)pk.y; *(LAS unsigned short*)(timg + (ch + 3) * dn::TST) = (unsigned short)(pk.y >> 16);
                    *(LAS unsigned short*)(timg + (ch + 4) * dn::TST) = (unsigned short)pk.z; *(LAS unsigned short*)(timg + (ch + 5) * dn::TST) = (unsigned short)(pk.z >> 16);
                    *(LAS unsigned short*)(timg + (ch + 6) * dn::TST) = (unsigned short)pk.w; *(LAS unsigned short*)(timg + (ch + 7) * dn::TST) = (unsigned short)(pk.w >> 16);
                }
            }
        }
    }
    __syncthreads();
    if (gw == 0) {
        float gc = gcv[lane];
#pragma unroll
        for (int off = 1; off < 64; off <<= 1) { const float o = shx(gc, 0, lane - off < 0 ? lane : lane - off) ; gc += (lane >= off) ? o : 0.f; }
        const float glast = shx(gc, 0, 63);
        const float eg = __expf(gc);
        gcv[lane] = gc; f1v[lane] = btv[lane] * eg; f2v[lane] = __expf(glast - gc); egv[lane] = eg * 0.08838834764831845f;
        if (lane == 0) ((float*)(ws + WS_GB))[hc] = __expf(glast);
    }
    __syncthreads();
    f32x16 Lt = {0.f, 0.f, 0.f, 0.f, 0.f, 0.f, 0.f, 0.f, 0.f, 0.f, 0.f, 0.f, 0.f, 0.f, 0.f, 0.f};
    if (gw < 3) {
        {
            const int ct = gw == 0 ? 0 : 1, mt = gw == 2 ? 1 : 0;
            f32x16 acc = {0.f, 0.f, 0.f, 0.f, 0.f, 0.f, 0.f, 0.f, 0.f, 0.f, 0.f, 0.f, 0.f, 0.f, 0.f, 0.f};
#pragma unroll
            for (int ks = 0; ks < 8; ++ks) acc = MFMA32(*(const LAS bf16x8*)(kimg + (32 * ct + r) * dn::QST + ks * 32 + hh * 16), *(const LAS bf16x8*)(kimg + (32 * mt + r) * dn::QST + ks * 32 + hh * 16), acc);
            const int m = 32 * mt + r; const float gm = gcv[m];
#pragma unroll
            for (int i = 0; i < 16; ++i) { const int c = 32 * ct + crow(i, hh); Lt[i] = (m < c) ? acc[i] * btv[c] * __expf(gcv[c] - gm) : 0.f; }
        }
        {
            const int mt = gw == 2 ? 1 : 0, ct = gw == 0 ? 0 : 1;
            f32x16 acc = {0.f, 0.f, 0.f, 0.f, 0.f, 0.f, 0.f, 0.f, 0.f, 0.f, 0.f, 0.f, 0.f, 0.f, 0.f, 0.f};
#pragma unroll
            for (int ks = 0; ks < 8; ++ks) acc = MFMA32(*(const LAS bf16x8*)(kimg + (32 * mt + r) * dn::QST + ks * 32 + hh * 16), *(const LAS bf16x8*)(qimg + (32 * ct + r) * dn::QST + ks * 32 + hh * 16), acc);
            const int c = 32 * ct + r; const float gcc = gcv[c]; float v[16];
#pragma unroll
            for (int i = 0; i < 16; ++i) { const int m = 32 * mt + crow(i, hh); v[i] = (m <= c) ? acc[i] * __expf(gcc - gcv[m]) * 0.08838834764831845f : 0.f; }
#pragma unroll
            for (int s2 = 0; s2 < 2; ++s2) *(bf16x8*)(blk + dn::OFF_AI + ((ct * 2 + mt) * 2 + s2) * 1024 + lane * 16) = pack8(v[8 * s2], v[8 * s2 + 1], v[8 * s2 + 2], v[8 * s2 + 3], v[8 * s2 + 4], v[8 * s2 + 5], v[8 * s2 + 6], v[8 * s2 + 7]);
        }
    } else {
#pragma unroll 1
        for (int f = 0; f < 16; ++f) { const int ct = f >> 3, tau = (f >> 1) & 3, s2 = f & 1, c = 32 * ct + r; const float e = egv[c];
            const LAS unsigned char* pp = qimg + c * dn::QST + (32 * tau + 16 * s2 + 4 * hh) * 2; const u32x2 lo = *(const LAS u32x2*)pp, hi = *(const LAS u32x2*)(pp + 16);
            *(bf16x8*)(blk + dn::OFF_QG + f * 1024 + lane * 16) = pack8(bflo(lo.x) * e, bfhi(lo.x) * e, bflo(lo.y) * e, bfhi(lo.y) * e, bflo(hi.x) * e, bfhi(hi.x) * e, bflo(hi.y) * e, bfhi(hi.y) * e); }
#pragma unroll 1
        for (int f = 0; f < 16; ++f) { const int tau = f >> 2, m0 = 32 * ((f >> 1) & 1) + 16 * (f & 1) + 4 * hh;
            const LAS unsigned char* pp = ktimg + (32 * tau + r) * dn::TST + m0 * 2; const u32x2 lo = *(const LAS u32x2*)pp, hi = *(const LAS u32x2*)(pp + 16);
            const f32x4 fa = *(const LAS f32x4*)(f2v + m0), fb = *(const LAS f32x4*)(f2v + m0 + 8);
            *(bf16x8*)(blk + dn::OFF_KD + f * 1024 + lane * 16) = pack8(bflo(lo.x) * fa.x, bfhi(lo.x) * fa.y, bflo(lo.y) * fa.z, bfhi(lo.y) * fa.w, bflo(hi.x) * fb.x, bfhi(hi.x) * fb.y, bflo(hi.y) * fb.z, bfhi(hi.y) * fb.w); }
    }
    __syncthreads();
    LAS float* Lm = (LAS float*)qimg;
    if (gw < 3) { const int ct = gw == 0 ? 0 : 1, mt = gw == 2 ? 1 : 0;
#pragma unroll
        for (int i = 0; i < 16; ++i) Lm[(32 * ct + crow(i, hh)) * 64 + 32 * mt + r] = Lt[i]; }
    __syncthreads();
    if (gw == 0) {
        float Tc[64];
#pragma unroll
        for (int i = 0; i < 64; ++i) {
            float a0 = (i == lane) ? 1.f : 0.f, a1 = 0.f, a2 = 0.f, a3 = 0.f;
#pragma unroll
            for (int k4 = 0; k4 < (i + 3) / 4; ++k4) { const f32x4 lv = *(const LAS f32x4*)(Lm + i * 64 + 4 * k4);
                if (4 * k4 + 0 < i) a0 -= lv.x * Tc[4 * k4 + 0]; if (4 * k4 + 1 < i) a1 -= lv.y * Tc[4 * k4 + 1];
                if (4 * k4 + 2 < i) a2 -= lv.z * Tc[4 * k4 + 2]; if (4 * k4 + 3 < i) a3 -= lv.w * Tc[4 * k4 + 3]; }
            Tc[i] = (a0 + a1) + (a2 + a3);
        }
        LDS_WAIT(); asm volatile("" ::: "memory");
#pragma unroll
        for (int i = 0; i < 64; ++i) *(LAS unsigned short*)(kimg + i * dn::TST + lane * 2) = (unsigned short)f2bf(Tc[i]);
    }
    __syncthreads();
    {
        LAS unsigned char* timg = kimg;
        bf16x8 afr[4];
#pragma unroll
        for (int s4 = 0; s4 < 4; ++s4) { const u32x4 x = *(const LAS u32x4*)(ktimg + (32 * gw + r) * dn::TST + s4 * 32 + hh * 16);
            const f32x4 fa = *(const LAS f32x4*)(f1v + 16 * s4 + 8 * hh), fb = *(const LAS f32x4*)(f1v + 16 * s4 + 8 * hh + 4);
            afr[s4] = pack8(-bflo(x.x) * fa.x, -bfhi(x.x) * fa.y, -bflo(x.y) * fa.z, -bfhi(x.y) * fa.w, -bflo(x.z) * fb.x, -bfhi(x.z) * fb.y, -bflo(x.w) * fb.z, -bfhi(x.w) * fb.w); }
#pragma unroll
        for (int ct = 0; ct < 2; ++ct) {
            f32x16 acc = {0.f, 0.f, 0.f, 0.f, 0.f, 0.f, 0.f, 0.f, 0.f, 0.f, 0.f, 0.f, 0.f, 0.f, 0.f, 0.f};
#pragma unroll
            for (int s4 = 0; s4 < 4; ++s4) acc = MFMA32(afr[s4], *(const LAS bf16x8*)(timg + (32 * ct + r) * dn::TST + s4 * 32 + hh * 16), acc);
#pragma unroll
            for (int s2 = 0; s2 < 2; ++s2) *(bf16x8*)(blk + dn::OFF_W + ((ct * 4 + gw) * 2 + s2) * 1024 + lane * 16) = pack8m(acc[8 * s2], acc[8 * s2 + 1], acc[8 * s2 + 2], acc[8 * s2 + 3], acc[8 * s2 + 4], acc[8 * s2 + 5], acc[8 * s2 + 6], acc[8 * s2 + 7]);
        }
#pragma unroll
        for (int ct = 0; ct < 2; ++ct) {
            f32x16 acc = {0.f, 0.f, 0.f, 0.f, 0.f, 0.f, 0.f, 0.f, 0.f, 0.f, 0.f, 0.f, 0.f, 0.f, 0.f, 0.f};
#pragma unroll
            for (int s4 = 0; s4 < 4; ++s4) acc = MFMA32(*(const LAS bf16x8*)(timg + (32 * ct + r) * dn::TST + s4 * 32 + hh * 16), *(const LAS bf16x8*)(vtimg + (32 * gw + r) * dn::TST + s4 * 32 + hh * 16), acc);
#pragma unroll
            for (int s2 = 0; s2 < 2; ++s2) *(bf16x8*)(blk + dn::OFF_U + ((ct * 4 + gw) * 2 + s2) * 1024 + lane * 16) = pack8m(acc[8 * s2], acc[8 * s2 + 1], acc[8 * s2 + 2], acc[8 * s2 + 3], acc[8 * s2 + 4], acc[8 * s2 + 5], acc[8 * s2 + 6], acc[8 * s2 + 7]);
        }
    }
    __syncthreads();
}

DI void dn_scan(int wv, int l, int bh) {
    const Frame F = mkframe(wv);
    const ArgsP ap = kargs();
    unsigned char* ws = ap->ws; bf16_t* P = (bf16_t*)(ws + WS_P);
    const int lane = F.lane, hh = lane >> 5, b = bh >> 2, h = bh & 3, w4 = wv & 3;
    LAS float* part = (LAS float*)(F.lds + 2 * dn::HC_BYTES);
    LAS float* gnl = part + 512;
    LAS float* decs = gnl + 128;
    if (F.tid < 128) gnl[F.tid] = ap->dn_norm_g[l * 128 + F.tid];
    if (F.tid < 32) decs[F.tid] = ((const float*)(ws + WS_GB))[(size_t)(b * 32 + F.tid) * 4 + h];
    const size_t hc_stride = 4 * (size_t)dn::HC_BYTES;
    const unsigned char* blk0 = ws + WS_DNI + ((size_t)(b * 32) * 4 + h) * dn::HC_BYTES;
#define DN_PIECE(src_, pbuf, pc_) __builtin_amdgcn_global_load_lds((const unsigned*)((src_) + (pc_) * 1024 + lane * 16), (LAS unsigned*)(F.lds + (pbuf) * dn::HC_BYTES + (pc_) * 1024), 16, 0, 0)
#define DN_LOAD(nn, pbuf) do { const unsigned char* src_ = blk0 + (size_t)(nn) * hc_stride; \
        if (wv < 4) { _Pragma("unroll") for (int i_ = 0; i_ < 9; ++i_) DN_PIECE(src_, pbuf, wv * 9 + i_); } \
        else { _Pragma("unroll") for (int i_ = 0; i_ < 5; ++i_) DN_PIECE(src_, pbuf, 36 + 5 * w4 + i_); \
               DN_PIECE(src_, pbuf, 56 + 2 * w4); DN_PIECE(src_, pbuf, 57 + 2 * w4); DN_PIECE(src_, pbuf, 64 + 2 * w4); DN_PIECE(src_, pbuf, 65 + 2 * w4); } } while (0)
    DN_LOAD(0, 0);
    f32x16 S[4];
#pragma unroll
    for (int i = 0; i < 4; ++i) S[i] = (f32x16){0.f, 0.f, 0.f, 0.f, 0.f, 0.f, 0.f, 0.f, 0.f, 0.f, 0.f, 0.f, 0.f, 0.f, 0.f, 0.f};
    u32x4 heldO[4], zO[4];
#pragma unroll
    for (int i = 0; i < 4; ++i) { heldO[i] = (u32x4){0u, 0u, 0u, 0u}; zO[i] = heldO[i]; }
    VM_WAIT(); __syncthreads();
    for (int k = 0; k < 34; ++k) {
        const int pbuf = k & 1;
        LAS unsigned char* buf = F.lds + pbuf * dn::HC_BYTES;
        if (wv < 4) {
            if (k + 1 < 32) DN_LOAD(k + 1, pbuf ^ 1);
            if (k < 32) {
                const float dec = decs[k];
                f32x16 vn[2], o[2];
#pragma unroll
                for (int ct = 0; ct < 2; ++ct) {
                    o[ct] = (f32x16){0.f, 0.f, 0.f, 0.f, 0.f, 0.f, 0.f, 0.f, 0.f, 0.f, 0.f, 0.f, 0.f, 0.f, 0.f, 0.f};
#pragma unroll
                    for (int s2 = 0; s2 < 2; ++s2) { const u32x4 x = *(const LAS u32x4*)(buf + dn::OFF_U + ((ct * 4 + wv) * 2 + s2) * 1024 + lane * 16);
                        vn[ct][8 * s2] = bflo(x.x); vn[ct][8 * s2 + 1] = bfhi(x.x); vn[ct][8 * s2 + 2] = bflo(x.y); vn[ct][8 * s2 + 3] = bfhi(x.y);
                        vn[ct][8 * s2 + 4] = bflo(x.z); vn[ct][8 * s2 + 5] = bfhi(x.z); vn[ct][8 * s2 + 6] = bflo(x.w); vn[ct][8 * s2 + 7] = bfhi(x.w); }
                }
#pragma unroll
                for (int tau = 0; tau < 4; ++tau)
#pragma unroll
                    for (int s2 = 0; s2 < 2; ++s2) {
                        const bf16x8 sf = pack8m(S[tau][8 * s2], S[tau][8 * s2 + 1], S[tau][8 * s2 + 2], S[tau][8 * s2 + 3], S[tau][8 * s2 + 4], S[tau][8 * s2 + 5], S[tau][8 * s2 + 6], S[tau][8 * s2 + 7]);
#pragma unroll
                        for (int ct = 0; ct < 2; ++ct) {
                            vn[ct] = MFMA32(*(const LAS bf16x8*)(buf + dn::OFF_W + ((ct * 4 + tau) * 2 + s2) * 1024 + lane * 16), sf, vn[ct]);
                            o[ct] = MFMA32(*(const LAS bf16x8*)(buf + dn::OFF_QG + ((ct * 4 + tau) * 2 + s2) * 1024 + lane * 16), sf, o[ct]);
                        }
                    }
#pragma unroll
                for (int tau = 0; tau < 4; ++tau) S[tau] = S[tau] * dec;
#pragma unroll
                for (int cm = 0; cm < 2; ++cm)
#pragma unroll
                    for (int s2 = 0; s2 < 2; ++s2) {
                        const bf16x8 vf = pack8m(vn[cm][8 * s2], vn[cm][8 * s2 + 1], vn[cm][8 * s2 + 2], vn[cm][8 * s2 + 3], vn[cm][8 * s2 + 4], vn[cm][8 * s2 + 5], vn[cm][8 * s2 + 6], vn[cm][8 * s2 + 7]);
#pragma unroll
                        for (int ct = cm; ct < 2; ++ct) o[ct] = MFMA32(*(const LAS bf16x8*)(buf + dn::OFF_AI + ((ct * 2 + cm) * 2 + s2) * 1024 + lane * 16), vf, o[ct]);
#pragma unroll
                        for (int tau = 0; tau < 4; ++tau) S[tau] = MFMA32(*(const LAS bf16x8*)(buf + dn::OFF_KD + ((tau * 2 + cm) * 2 + s2) * 1024 + lane * 16), vf, S[tau]);
                    }
                LDS_WAIT(); __builtin_amdgcn_sched_barrier(0); asm volatile("s_nop 15\n\ts_nop 3" ::: "memory"); __builtin_amdgcn_sched_barrier(0);
#pragma unroll
                for (int ct = 0; ct < 2; ++ct)
#pragma unroll
                    for (int i = 0; i < 16; i += 2) { const int c = 32 * ct + crow(i, hh), q = c >> 4; const unsigned u2 = pk2(o[ct][i], o[ct][i + 1]);
                        LAS unsigned char* wp = buf + dn::OFF_U + (((q >> 1) * 4 + wv) * 2 + (q & 1)) * 1024 + (c & 15) * 64 + (lane & 31) * 2;
                        *(LAS unsigned short*)wp = (unsigned short)u2; *(LAS unsigned short*)(wp + 64) = (unsigned short)(u2 >> 16); }
            }
        } else {
            if (k >= 2) {
                const int nn = k - 2; const f32x4 p4 = *(const LAS f32x4*)(part + ((nn & 1) * 64 + lane) * 4);
                const float rs = rsqrtf(((p4.x + p4.y) + (p4.z + p4.w)) * (1.f / 128.f) + EPS);
                bf16_t* zp = P + (size_t)(b * SEQ + nn * 64 + lane) * PLD + P_DNZ + h * 128 + 32 * w4;
#pragma unroll
                for (int q = 0; q < 4; ++q) { const u32x4 zz = zO[q], hv = heldO[q]; const f32x4 ga = *(const LAS f32x4*)(gnl + 32 * w4 + 8 * q), gb = *(const LAS f32x4*)(gnl + 32 * w4 + 8 * q + 4);
                    u32x4 wo;
                    wo.x = pk2(bflo(hv.x) * rs * ga.x * siluf_(bflo(zz.x)), bfhi(hv.x) * rs * ga.y * siluf_(bfhi(zz.x)));
                    wo.y = pk2(bflo(hv.y) * rs * ga.z * siluf_(bflo(zz.y)), bfhi(hv.y) * rs * ga.w * siluf_(bfhi(zz.y)));
                    wo.z = pk2(bflo(hv.z) * rs * gb.x * siluf_(bflo(zz.z)), bfhi(hv.z) * rs * gb.y * siluf_(bfhi(zz.z)));
                    wo.w = pk2(bflo(hv.w) * rs * gb.z * siluf_(bflo(zz.w)), bfhi(hv.w) * rs * gb.w * siluf_(bfhi(zz.w)));
                    *(u32x4*)(zp + 8 * q) = wo; }
            }
            if (k >= 1 && k <= 32) {
                const int nn = k - 1; LAS unsigned char* pb = F.lds + (nn & 1) * dn::HC_BYTES;
                const int q = lane >> 4; const LAS unsigned char* rp = pb + dn::OFF_U + (((q >> 1) * 4 + w4) * 2 + (q & 1)) * 1024 + (lane & 15) * 64;
                float ssq = 0.f;
#pragma unroll
                for (int i = 0; i < 4; ++i) { const u32x4 hv = *(const LAS u32x4*)(rp + 16 * i); heldO[i] = hv;
                    ssq += bflo(hv.x) * bflo(hv.x) + bfhi(hv.x) * bfhi(hv.x) + bflo(hv.y) * bflo(hv.y) + bfhi(hv.y) * bfhi(hv.y)
                         + bflo(hv.z) * bflo(hv.z) + bfhi(hv.z) * bfhi(hv.z) + bflo(hv.w) * bflo(hv.w) + bfhi(hv.w) * bfhi(hv.w); }
                part[((nn & 1) * 64 + lane) * 4 + w4] = ssq;
                const bf16_t* zp = P + (size_t)(b * SEQ + nn * 64 + lane) * PLD + P_DNZ + h * 128 + 32 * w4;
#pragma unroll
                for (int i = 0; i < 4; ++i) zO[i] = *(const u32x4*)(zp + 8 * i);
            }
            LDS_WAIT(); asm volatile("" ::: "memory");
            if (k + 1 < 32) DN_LOAD(k + 1, pbuf ^ 1);
        }
        VM_WAIT(); __syncthreads();
    }
#undef DN_LOAD
#undef DN_PIECE
}

DI void final_norm(int wv) {
    const Frame F = mkframe(wv);
    const ArgsP ap = kargs();
    const float* ss = (const float*)(ap->ws + WS_SS);
    for (int m = F.gw; m < T; m += F.NGW) {
        const f32x4 s = *(const f32x4*)(ss + (size_t)m * 4); const float rs = rsqrtf(((s.x + s.y) + (s.z + s.w)) * (1.f / D) + EPS);
        f32x4* xr = (f32x4*)(ap->out + (size_t)m * D) + F.lane; const f32x4* gr = (const f32x4*)ap->final_norm_g + F.lane;
#pragma unroll
        for (int j = 0; j < 4; ++j) { const f32x4 v = xr[64 * j], g = gr[64 * j]; xr[64 * j] = v * rs * g; }
    }
}

__global__ void __launch_bounds__(NTHREADS, 2) mk_fwd(Args args) {
    extern __shared__ __attribute__((aligned(16))) unsigned char lds_raw[];
    LAS unsigned char* const lds = (LAS unsigned char*)lds_raw;
    volatile LAS unsigned* MISC = (volatile LAS unsigned*)(lds + MISC_OFF);
    const int wv = __builtin_amdgcn_readfirstlane((int)threadIdx.x >> 6);
    { const int t0 = opaque_tid(wv); for (int u = t0; u < (LDS_BYTES - LDSCTL_OFF) / 4; u += NTHREADS) ((LAS unsigned*)(lds + LDSCTL_OFF))[u] = 0u; }
    __syncthreads();
    const int G = gridDim.x;
    XcdBarrier bar; bar.bar = (unsigned*)(args.ws + WS_CTL) + CW_BAR + args.li * XCD_BAR_WORDS; bar.x = 0; bar.st = nullptr;
    if (args.ph_hi - args.ph_lo > 1) bar = xcd_barrier_post(bar.bar, MISC + 8, wv);
#define IN(k) (kargs()->ph_lo <= (k) && (k) < kargs()->ph_hi)
#define SEAM(k) do { if (IN(k) && IN((k) + 1)) xcd_barrier(bar, wv); } while (0)
#define MK_EPI(E) gm::Epi E; E.ws = kargs()->ws; E.xin = nullptr; E.xout = nullptr; E.b_gate = nullptr; E.gnext = nullptr; E.spare = (LAS float*)(lds + SPARE_OFF);

#if !defined(ONLY_PH) || ONLY_PH == 0
    if (IN(0)) { p0_prologue(wv); }
#endif
    SEAM(0);

    for (int l = 0; l < DEPTH; ++l) {
        const int pb = 1 + 6 * l;
#if !defined(ONLY_PH) || ONLY_PH == 1
        if (IN(pb)) { MK_EPI(E); SchedP1 S; S.ord.init(64, 12, G, (int)blockIdx.x); S.ws = kargs()->ws; S.l = l; S.half = 0; S.c = (int)blockIdx.x; S.with_kvm = (l == 0);
            gm::gemm_phase(lds, wv, S, E);
#ifdef PROBE_DUP_GEMM
            xcd_barrier(bar, wv); gm::gemm_phase(lds, wv, S, E);
#endif
            }
#endif
        SEAM(pb);
#if !defined(ONLY_PH) || ONLY_PH == 2
        if (IN(pb + 1)) {
            ret_rope_prep(wv);
            for (int pair = (int)blockIdx.x; pair < 512; pair += G) dn_prep(wv, l, pair);
            for (int unit = (int)blockIdx.x; unit < 256; unit += G) mem_unit(wv, l, unit);
 }
#endif
        SEAM(pb + 1);
#if !defined(ONLY_PH) || ONLY_PH == 3
        if (IN(pb + 2)) { MK_EPI(E); SchedP1 S; S.ord.init(64, 12, G, (int)blockIdx.x); S.ws = kargs()->ws; S.l = l; S.half = 1; S.c = (int)blockIdx.x; S.with_kvm = false;
            gm::gemm_phase(lds, wv, S, E);
#ifdef PROBE_DUP_GEMM
            xcd_barrier(bar, wv); gm::gemm_phase(lds, wv, S, E);
#endif
            }
#endif
        SEAM(pb + 2);
#if !defined(ONLY_PH) || ONLY_PH == 4
        if (IN(pb + 3)) {
            const int wg = (int)blockIdx.x;
            if (wg < 32) dn_scan(wv, l, wg);
            unsigned* head = (unsigned*)(kargs()->ws + WS_CTL) + CW_QUEUE + 64 * l;
            volatile LAS unsigned* qslot = (volatile LAS unsigned*)(lds + MISC_OFF + 64);
            for (;;) {
                if (opaque_tid(wv) == 0) qslot[0] = __hip_atomic_fetch_add(head, 1u, __ATOMIC_RELAXED, __HIP_MEMORY_SCOPE_AGENT);
                __syncthreads();
                const int unit = (int)qslot[0];
                __syncthreads();
                if (unit >= 768) break;
                if (unit < 256) attn_unit<1>(wv, l, unit); else attn_unit<0>(wv, l, unit - 256);
            }
        }
#endif
        SEAM(pb + 3);
#if !defined(ONLY_PH) || ONLY_PH == 5
        if (IN(pb + 4)) { MK_EPI(E); gm::TileOrder ord; ord.init(64, 4, G, (int)blockIdx.x); SchedP3 S; S.ok = ord.tile(0, S.pm, S.pn); S.l = l; S.ws = kargs()->ws; E.b_gate = kargs()->b_gate;
            gm::gemm_phase(lds, wv, S, E);
#ifdef PROBE_DUP_GEMM
            xcd_barrier(bar, wv); gm::gemm_phase(lds, wv, S, E);
#endif
            }
#endif
        SEAM(pb + 4);
#if !defined(ONLY_PH) || ONLY_PH == 6
        if (IN(pb + 5)) { MK_EPI(E); gm::TileOrder ord; ord.init(64, 4, G, (int)blockIdx.x); SchedP4 S; S.ok = ord.tile(0, S.pm, S.pn); S.l = l; S.ws = kargs()->ws;
            E.gnext = (l + 1 < DEPTH) ? kargs()->norm_g + (size_t)(l + 1) * D : nullptr;
            E.xout = kargs()->out; E.xin = (l == 0) ? kargs()->x : (const float*)kargs()->out;
            gm::gemm_phase(lds, wv, S, E); }
#endif
        SEAM(pb + 5);
    }
#if !defined(ONLY_PH) || ONLY_PH == 13
    if (IN(13)) final_norm(wv);
#endif
#undef IN
#undef SEAM
#undef MK_EPI
}

extern "C" void kernel_launch(void* const* d_in, const int* in_sizes, int n_in, void* d_out, int out_size, void* d_ws, size_t ws_size, hipStream_t stream) {
    static int grid = 0;
    if (grid == 0) {
        if (n_in != 19 || out_size != T * D || ws_size < WS_END) { fprintf(stderr, "kernel_launch: unexpected problem (n_in %d, out %d, ws %zu)\n", n_in, out_size, ws_size); grid = -1; return; }
        int dev = 0, cus = 0, per_cu = 0;
        if (hipGetDevice(&dev) != hipSuccess || hipDeviceGetAttribute(&cus, hipDeviceAttributeMultiprocessorCount, dev) != hipSuccess) { grid = -1; return; }
        if (hipFuncSetAttribute((const void*)mk_fwd, hipFuncAttributeMaxDynamicSharedMemorySize, LDS_BYTES) != hipSuccess) { fprintf(stderr, "kernel_launch: hipFuncSetAttribute failed\n"); grid = -1; return; }
        if (hipOccupancyMaxActiveBlocksPerMultiprocessor(&per_cu, (const void*)mk_fwd, NTHREADS, LDS_BYTES) != hipSuccess || per_cu < 1)
            fprintf(stderr, "kernel_launch: occupancy query reports %d workgroups per CU\n", per_cu);
        (void)hipGetLastError();
        grid = cus;
    }
    if (grid < 0) return;
    if (hipMemsetAsync((char*)d_ws + WS_CTL, 0, CTL_ZERO_BYTES, stream) != hipSuccess) return;
    Args a{};
    a.x = (const float*)d_in[0]; a.mem = (const float*)d_in[1]; a.positions = (const int*)d_in[2]; a.norm_g = (const float*)d_in[3]; a.mem_norm_g = (const float*)d_in[4];
    a.w_in = (const float*)d_in[5]; a.b_gate = (const float*)d_in[6]; a.dn_conv_w = (const float*)d_in[7]; a.dn_a_log = (const float*)d_in[8]; a.dn_dt_bias = (const float*)d_in[9];
    a.dn_norm_g = (const float*)d_in[10]; a.ret_norm_g = (const float*)d_in[11]; a.w_mem_kv = (const float*)d_in[12]; a.w_br_sb = (const float*)d_in[13]; a.w_br_dn = (const float*)d_in[14];
    a.w_br_ret = (const float*)d_in[15]; a.w_br_mem = (const float*)d_in[16]; a.w_out = (const float*)d_in[17]; a.final_norm_g = (const float*)d_in[18];
    a.out = (float*)d_out; a.ws = (unsigned char*)d_ws;
#if MK_N_LAUNCHES == 1
    a.ph_lo = 0; a.ph_hi = NPHASE; a.li = 0;
    hipLaunchKernelGGL(mk_fwd, dim3(grid), dim3(NTHREADS), LDS_BYTES, stream, a);
#else
    for (int p = 0; p < NPHASE; ++p) { a.ph_lo = p; a.ph_hi = p + 1; a.li = 0;
        hipLaunchKernelGGL(mk_fwd, dim3(grid), dim3(NTHREADS), LDS_BYTES, stream, a); }
#endif
}
```

```cpp
#include <hip/hip_runtime.h>
#include <cstdio>
#include <cstdint>
#include <cmath>

#define LAS __attribute__((address_space(3)))
#define GAS __attribute__((address_space(1)))
#define DI __device__ __forceinline__
typedef unsigned short bf16_t;
typedef short bf16x8 __attribute__((ext_vector_type(8)));
typedef float f32x4 __attribute__((ext_vector_type(4)));
typedef unsigned u32x4 __attribute__((ext_vector_type(4)));
typedef unsigned u32x2 __attribute__((ext_vector_type(2)));
typedef float f32x2 __attribute__((ext_vector_type(2)));

#ifndef AUX_P1
#define AUX_P1 0
#endif
#ifndef AUX_P3
#define AUX_P3 0
#endif
#ifndef AUX_P4
#define AUX_P4 0
#endif
#ifdef EPI_NT
#define EPI_LD(p) __builtin_nontemporal_load(p)
#define EPI_ST(p, v) __builtin_nontemporal_store((v), (p))
#else
#define EPI_LD(p) (*(p))
#define EPI_ST(p, v) (*(p) = (v))
#endif
#ifndef FRESH_WAITS
#define FRESH_WAITS 0
#endif
#ifndef SS_PREFETCH
#define SS_PREFETCH 1
#endif
#ifndef MK_N_LAUNCHES
#define MK_N_LAUNCHES 1
#endif

constexpr int BATCH = 8, SEQ = 2048, D = 1024, T = BATCH * SEQ, DEPTH = 2, MEMLEN = 256;
constexpr int IN_COLS = 9992;
constexpr float EPS = 1e-6f;
constexpr int NPHASE = 14;

constexpr size_t MiB = 1u << 20;
constexpr size_t WS_CTL = 0, CTL_ZERO_BYTES = 1 * MiB;
constexpr size_t WS_WINA = 1 * MiB;
constexpr size_t WS_WINB = 13 * MiB;
constexpr size_t WS_WG = 25 * MiB;
constexpr size_t WS_WBR = 41 * MiB;
constexpr size_t WS_WOUT = 49 * MiB;
constexpr size_t WS_WKV = 53 * MiB;
constexpr size_t WS_XN = 55 * MiB;
constexpr size_t WS_P = 87 * MiB;
constexpr size_t WS_R = 127 * MiB;
constexpr int VTLD = T + 64;
constexpr size_t WS_VTSB = WS_R + 64 * MiB, WS_VTRT = WS_VTSB + (size_t)512 * VTLD * 2;
constexpr size_t WS_SCR = 224 * MiB;
constexpr size_t WS_MRG = 240 * MiB;
constexpr size_t WS_DNI = 224 * MiB;
constexpr size_t WS_KVM = 296 * MiB;
constexpr size_t WS_ROPE = 300 * MiB;
constexpr size_t WS_AB = 304 * MiB;
constexpr size_t WS_GB = WS_AB + 512 * 1024;
constexpr size_t WS_SS = 305 * MiB;
constexpr size_t WS_END = 310 * MiB;
constexpr size_t WS_MEMN = 306 * MiB;
constexpr int PLD = 1280, RALD = 1536, RBLD = 2048, SCRLD = 1024, MRGLD = 1024;
constexpr int P_DNZ = 0, P_MEMQ = 512, P_RTQ = 768, P_RTK = 1024;
constexpr int RB_SBQ = 0, RB_SBK = 512, RB_SBZ = 1024, RB_RTZ = 1536;
constexpr int CW_BAR = 4096;
constexpr int CW_PANEL = 16384;
constexpr int CW_QUEUE = 64;
constexpr int CW_RST = 49152;
constexpr int CW_READY = 32768;

constexpr int RING_BYTES = 155648;
constexpr int LDSCTL_OFF = RING_BYTES, MISC_OFF = LDSCTL_OFF + 320, SPARE_OFF = LDSCTL_OFF + 1024;
constexpr int LDS_BYTES = 163840;
constexpr int NWAVES = 8, NTHREADS = 512;

DI unsigned f2bf(float f) { unsigned u = __builtin_bit_cast(unsigned, f); return (u + 0x7fffu + ((u >> 16) & 1u)) >> 16; }
DI unsigned pk2(float lo, float hi) { unsigned r; asm("s_nop 0\n\tv_cvt_pk_bf16_f32 %0, %1, %2" : "=v"(r) : "v"(lo), "v"(hi)); return r; }
DI float bf2f(unsigned short h) { return __builtin_bit_cast(float, (unsigned)h << 16); }
DI float bflo(unsigned w) { return __builtin_bit_cast(float, w << 16); }
DI float bfhi(unsigned w) { return __builtin_bit_cast(float, w & 0xffff0000u); }
DI float shx(float v, int m, int lane) { return __builtin_bit_cast(float, __builtin_amdgcn_ds_bpermute((lane ^ m) << 2, __builtin_bit_cast(int, v))); }
DI float wave_sum(float v, int lane) {
#pragma unroll
    for (int o = 1; o < 64; o <<= 1) v += shx(v, o, lane);
    return v;
}
DI float sum16(float v) {
    v += __builtin_bit_cast(float, __builtin_amdgcn_update_dpp(0, __builtin_bit_cast(int, v), 0xB1, 0xf, 0xf, true));
    v += __builtin_bit_cast(float, __builtin_amdgcn_update_dpp(0, __builtin_bit_cast(int, v), 0x4E, 0xf, 0xf, true));
    v += __builtin_bit_cast(float, __builtin_amdgcn_update_dpp(0, __builtin_bit_cast(int, v), 0x141, 0xf, 0xf, true));
    v += __builtin_bit_cast(float, __builtin_amdgcn_update_dpp(0, __builtin_bit_cast(int, v), 0x140, 0xf, 0xf, true));
    return v;
}
DI float sigmoidf_(float x) { return __builtin_amdgcn_rcpf(1.f + __builtin_amdgcn_exp2f(x * -1.4426950408889634f)); }
DI float siluf_(float x) { return x * __builtin_amdgcn_rcpf(1.f + __builtin_amdgcn_exp2f(x * -1.4426950408889634f)); }
DI int opaque_bid() { int b = blockIdx.x; asm volatile("" : "+s"(b)); return b; }
DI int opaque_tid(int wv) { int lane; asm volatile("v_mbcnt_lo_u32_b32 %0, -1, 0\n\tv_mbcnt_hi_u32_b32 %0, -1, %0" : "=v"(lane)); return wv * 64 + lane; }
#define LDS_WAIT() asm volatile("s_waitcnt lgkmcnt(0)" ::: "memory")
DI void lds_barrier() { asm volatile("s_waitcnt lgkmcnt(0)" ::: "memory"); __builtin_amdgcn_s_barrier(); asm volatile("" ::: "memory"); }
#define VM_WAIT() asm volatile("s_waitcnt vmcnt(0)" ::: "memory")
DI unsigned shxu(unsigned v, int m, int lane) { return (unsigned)__builtin_amdgcn_ds_bpermute((lane ^ m) << 2, (int)v); }
DI void st16_wt(void* p, u32x4 v) { asm volatile("global_store_dwordx4 %0, %1, off sc1\n\ts_nop 1" :: "v"(p), "v"(v) : "memory"); }
DI void unit_done(unsigned char* ws, int l, int pm, int tid) {
    VM_WAIT(); lds_barrier();
    if (tid == 0) (void)__hip_atomic_fetch_add((unsigned*)(ws + WS_CTL) + CW_READY + 4096 * l + 64 * pm, 1u, __ATOMIC_RELAXED, __HIP_MEMORY_SCOPE_AGENT);
}

#define XB_TMO      128
#define XB_XCNT(j)  (256  + 64 * (j))
#define XB_XSUB(j)  (1280 + 64 * (j))
#define XB_XGEN(j)  (2304 + 64 * (j))
#define XB_TOP      3328
#define XB_TOPGEN   3392
#define XCD_BAR_WORDS 3456
#define XB_SPIN_CAP (1u << 18)
DI unsigned xb_ld(unsigned* p)              { return __hip_atomic_load(p, __ATOMIC_RELAXED, __HIP_MEMORY_SCOPE_AGENT); }
DI unsigned xb_add(unsigned* p, unsigned v) { return __hip_atomic_fetch_add(p, v, __ATOMIC_RELAXED, __HIP_MEMORY_SCOPE_AGENT); }
DI unsigned xb_xcc_id() { return (unsigned)__builtin_amdgcn_s_getreg((3 << 11) | 20) & 0xFu; }
#define XB_SPIN(cond, bar) do { unsigned _sp = 0; while (cond) { __builtin_amdgcn_s_sleep(1); \
    if ((++_sp & 255u) == 0u) { if (xb_ld(&(bar)[XB_TMO])) break; if (_sp > XB_SPIN_CAP) { atomicAdd(&(bar)[XB_TMO], 1u); break; } } } } while (0)
struct XcdBarrier { unsigned* bar; unsigned x; volatile LAS unsigned* st; };
DI XcdBarrier xcd_barrier_post(unsigned* bar, volatile LAS unsigned* st, int wv) {
    XcdBarrier b; b.bar = bar; b.x = xb_xcc_id(); b.st = st;
    if (opaque_tid(wv) == 0) (void)xb_add(&bar[XB_XCNT(b.x)], 1u);
    return b;
}
DI void xcd_barrier_complete(unsigned* bar, unsigned x, unsigned& nloc, unsigned& nx) {
    const unsigned G = gridDim.x * gridDim.y * gridDim.z;
    unsigned sum, cnt, mine, sp = 0u;
    for (;;) {
        sum = 0u; cnt = 0u; mine = 0u;
#pragma unroll
        for (unsigned j = 0; j < 16; ++j) { const unsigned c = xb_ld(&bar[XB_XCNT(j)]); sum += c; cnt += (c > 0u) ? 1u : 0u; mine = (j == x) ? c : mine; }
        if (sum == G) break;
        __builtin_amdgcn_s_sleep(1);
        if ((++sp & 255u) == 0u) { if (xb_ld(&bar[XB_TMO])) break; if (sp > XB_SPIN_CAP) { atomicAdd(&bar[XB_TMO], 1u); break; } }
    }
    nloc = mine > 0u ? mine : 1u; nx = cnt > 0u ? cnt : 1u;
}
DI void xcd_barrier(const XcdBarrier& b, int wv) {
    asm volatile("s_waitcnt vmcnt(0)" ::: "memory");
    __syncthreads();
    if (opaque_tid(wv) == 0) {
        unsigned* bar = b.bar;
        __builtin_amdgcn_s_waitcnt(0);
        unsigned nloc = b.st[0], nx = b.st[1];
        if (nloc == 0u) { xcd_barrier_complete(bar, b.x, nloc, nx); b.st[0] = nloc; b.st[1] = nx; }
        const unsigned old = xb_add(&bar[XB_XSUB(b.x)], 1u);
        const unsigned gen = old / nloc;
        if (old + 1u == (gen + 1u) * nloc) {
            __builtin_amdgcn_fence(__ATOMIC_RELEASE, "agent");
            asm volatile("s_waitcnt vmcnt(0)" ::: "memory");
            const unsigned og = xb_add(&bar[XB_TOP], 1u);
            const unsigned tg = og / nx;
            if (og + 1u == (tg + 1u) * nx) xb_add(&bar[XB_TOPGEN], 1u);
            else XB_SPIN(xb_ld(&bar[XB_TOPGEN]) == tg, bar);
            __builtin_amdgcn_fence(__ATOMIC_ACQUIRE, "agent");
            xb_add(&bar[XB_XGEN(b.x)], 1u);
            asm volatile("s_waitcnt vmcnt(0)" ::: "memory");
        } else {
            XB_SPIN(xb_ld(&bar[XB_XGEN(b.x)]) == gen, bar);
            __builtin_amdgcn_fence(__ATOMIC_ACQUIRE, "agent");
            asm volatile("s_waitcnt vmcnt(0)" ::: "memory");
        }
    }
    __syncthreads();
}

namespace gm {
constexpr int BM = 256, BK = 64, HALF = 128, HTB = HALF * BK * 2, STAGE_BYTES = 8 * HTB;
DI int lds_byte(int r, int c) { const int st = (r >> 4) * 2 + (c >> 5), rr = r & 15, cc = c & 31, ob = rr * 64 + cc * 2; return st * 1024 + (ob ^ (((ob >> 9) & 1) << 5)); }
DI void stage_rc(int b, int& R, int& C) { const int st = b / 1024, sb = b % 1024, swz = sb ^ (((sb >> 9) & 1) << 5); R = (st >> 1) * 16 + swz / 64; C = (st & 1) * 32 + (swz % 64) / 2; }
DI int perm32(int rho) { const int n = rho >> 4, i = rho & 15; return 8 * (i >> 2) + 4 * n + (i & 3); }

enum Kind { K_STORE = 0, K_AB = 1, K_GATE = 2, K_BRANCH = 3, K_OUT = 4, K_STORE_T = 5 };
struct Unit {
    const bf16_t* A; const bf16_t* B;
    int lda, ldb, K, pm, pn, kind, sub, l;
};
struct TileOrder {
    int nM, nN, nwg, G, c;
    DI void init(int nM_, int nN_, int G_, int c_) { nM = nM_; nN = nN_; nwg = nM * nN; G = G_; c = c_; }
    DI bool tile(int i, int& pm, int& pn) const {
        const long L = (long)i * G + c; if (L >= nwg) return false;
        int wgid = (int)L; { const int q = nwg / 8, r = nwg % 8, xcd = wgid % 8, off = wgid / 8; wgid = (xcd < r ? xcd * (q + 1) : r * (q + 1) + (xcd - r) * q) + off; }
        const int WGM = 8, nig = WGM * nN, gid = wgid / nig, fm = gid * WGM, gsz = (nM - fm) < WGM ? (nM - fm) : WGM;
        pm = __builtin_amdgcn_readfirstlane(fm + ((wgid % nig) % gsz)); pn = __builtin_amdgcn_readfirstlane((wgid % nig) / gsz); return true;
    }
};

template <int AUX, class Sched, class Epi>
DI void gemm_phase(LAS unsigned char* lds, int wv, const Sched& S, const Epi& E) {
    const int tid = opaque_tid(wv), wid = __builtin_amdgcn_readfirstlane(tid >> 6), lane = tid & 63, wr = wid >> 2, wc = wid & 3, fr = lane & 15, fq = lane >> 4;
    int R0_, C0_; stage_rc(tid * 16, R0_, C0_);
    const unsigned R0 = 2u * (unsigned)R0_, C2 = 2u * (unsigned)C0_;
    const unsigned RbP = 2u * (unsigned)((R0_ & ~31) + perm32(R0_ & 31));
    const unsigned ldsw = (unsigned)wid * 1024u;
    const int aoff = lds_byte(wr * 64 + fr, fq * 8), boff = lds_byte(wc * 32 + fr, fq * 8);
#define GM_SA(b, h) (((b) * 2 + (h)) * HTB)
#define GM_SB(b, h) ((4 + (b) * 2 + (h)) * HTB)
#define GM_STAGE(bufoff, gbase, ld, R2) do { const unsigned _v = (unsigned)(R2) * (unsigned)(ld) + C2; \
        __builtin_amdgcn_global_load_lds((const unsigned*)((const char*)(gbase) + _v), (LAS unsigned*)(lds + (bufoff) + ldsw), 16, 0, AUX); \
        __builtin_amdgcn_global_load_lds((const unsigned*)((const char*)(gbase) + (_v + (unsigned)(ld) * 128u)), (LAS unsigned*)(lds + (bufoff) + ldsw + 8192), 16, 0, AUX); } while (0)
#define GM_LDA(dst, b, h) do { _Pragma("unroll") for (int m = 0; m < 4; ++m) _Pragma("unroll") for (int k = 0; k < 2; ++k) dst[m][k] = *(const LAS bf16x8*)(lds + GM_SA(b, h) + aoff + m * 2048 + k * 1024); } while (0)
#define GM_LDB(dst, b, h) do { _Pragma("unroll") for (int n = 0; n < 2; ++n) _Pragma("unroll") for (int k = 0; k < 2; ++k) dst[n][k] = *(const LAS bf16x8*)(lds + GM_SB(b, h) + boff + n * 2048 + k * 1024); } while (0)
#define GM_MMA(ai, bj, At, Bt) do { __builtin_amdgcn_s_setprio(1); _Pragma("unroll") for (int m = 0; m < 4; ++m) _Pragma("unroll") for (int n = 0; n < 2; ++n) _Pragma("unroll") for (int k = 0; k < 2; ++k) \
        acc[ai][bj][m][n] = __builtin_amdgcn_mfma_f32_16x16x32_bf16(Bt[n][k], At[m][k], acc[ai][bj][m][n], 0, 0, 0); __builtin_amdgcn_s_setprio(0); } while (0)
#define GM_WAIT_V(n) asm volatile("s_waitcnt vmcnt(" #n ")" ::: "memory")
#define GM_WAIT_L(n) asm volatile("s_waitcnt lgkmcnt(" #n ")" ::: "memory")
#define GM_BAR __builtin_amdgcn_s_barrier()
#define GM_SCHED __builtin_amdgcn_sched_barrier(0)
    Unit cur, nxt; int ui = 0;
    if (!S.next(0, cur)) return;
    S.a_ready(cur, wid, lane);
    f32x4 acc[2][2][4][2];
#pragma unroll
    for (int a = 0; a < 2; ++a)
#pragma unroll
        for (int b = 0; b < 2; ++b)
#pragma unroll
            for (int m = 0; m < 4; ++m)
#pragma unroll
                for (int n = 0; n < 2; ++n) acc[a][b][m][n] = (f32x4){0.f, 0.f, 0.f, 0.f};
    bf16x8 At[4][2], B0[2][2], B1[2][2];
    const char* cA = (const char*)cur.A; const char* cB = (const char*)cur.B; int clda = cur.lda, cldb = cur.ldb;
    GM_STAGE(GM_SB(0, 0), cB, cldb, RbP); GM_STAGE(GM_SB(0, 1), cB + (size_t)cldb * 256, cldb, RbP); GM_STAGE(GM_SA(0, 0), cA, clda, R0); GM_STAGE(GM_SA(0, 1), cA + (size_t)clda * 256, clda, R0);
    if (wr == 1) GM_BAR;
    GM_WAIT_V(2); GM_BAR;
    GM_STAGE(GM_SB(1, 0), cB + 128, cldb, RbP); GM_STAGE(GM_SA(1, 0), cA + 128, clda, R0); GM_STAGE(GM_SB(1, 1), cB + (size_t)cldb * 256 + 128, cldb, RbP);
    GM_WAIT_V(6); GM_BAR;
    for (;;) {
        const bool has_next = S.next(ui + 1, nxt);
        const char* nA = has_next ? (const char*)nxt.A : cA; const char* nB = has_next ? (const char*)nxt.B : cB;
        const int nlda = has_next ? nxt.lda : clda, nldb = has_next ? nxt.ldb : cldb;
        const int nt = cur.K / BK;
#if SS_PREFETCH
        if (wid < 4) __builtin_amdgcn_global_load_lds((const unsigned*)(E.ws + WS_SS + ((size_t)(cur.kind == K_STORE_T ? cur.pn : cur.pm) * 256 + tid) * 16), (LAS unsigned*)(lds + STAGE_BYTES + (ui & 1) * 4096 + wid * 1024), 16, 0, 0);
        if (wid == 4 && cur.kind == K_OUT && (E.gnext != nullptr || E.gfinal != nullptr))
            __builtin_amdgcn_global_load_lds((const unsigned*)((E.gnext != nullptr ? E.gnext : E.gfinal) + cur.pn * 256 + lane * 4), (LAS unsigned*)(lds + STAGE_BYTES + 8192 + (ui & 1) * 1024), 16, 0, 0);
        if (wid == 4 && cur.kind == K_GATE) __builtin_amdgcn_global_load_lds((const unsigned*)(E.b_gate + (size_t)cur.l * 4096 + (cur.sub & 3) * 1024 + cur.pn * 256 + lane * 4), (LAS unsigned*)(lds + STAGE_BYTES + 8192 + (ui & 1) * 1024), 16, 0, 0);
#endif
        for (int t = 0; t < nt; t += 2) {
            const bool last = (t == nt - 2);
            if (last && has_next) S.a_ready(nxt, wid, lane);
            const char* a1 = cA + (size_t)(t + 1) * 128;
            const char* a2 = last ? nA : cA + (size_t)(t + 2) * 128; const char* b2 = last ? nB : cB + (size_t)(t + 2) * 128;
            const int lda2 = last ? nlda : clda, ldb2 = last ? nldb : cldb;
            const char* a3 = a2 + 128; const char* b3 = b2 + 128;
            const int later = __builtin_amdgcn_readfirstlane((t != 0) ? 1 : 0);
#if FRESH_WAITS
#define GM_WAIT_V8_LATER asm volatile("s_cmp_eq_u32 %0, 0\n\ts_cbranch_scc1 .Lgmw%=\n\ts_waitcnt vmcnt(8)\n.Lgmw%=:" :: "s"(later) : "scc", "memory")
#else
#define GM_WAIT_V8_LATER GM_WAIT_V(8)
#endif
            GM_LDB(B0, 0, 0); GM_LDB(B1, 0, 1); GM_SCHED; GM_LDA(At, 0, 0); GM_STAGE(GM_SA(1, 1), a1 + (size_t)clda * 256, clda, R0);
            GM_WAIT_V8_LATER; GM_WAIT_L(0); GM_BAR; GM_MMA(0, 0, At, B0); GM_MMA(0, 1, At, B1); GM_BAR; GM_SCHED;
            GM_LDA(At, 0, 1); GM_STAGE(GM_SB(0, 0), b2, ldb2, RbP); GM_STAGE(GM_SB(0, 1), b2 + (size_t)ldb2 * 256, ldb2, RbP); GM_STAGE(GM_SA(0, 0), a2, lda2, R0);
            GM_WAIT_V8_LATER; GM_WAIT_L(0); GM_BAR; GM_MMA(1, 0, At, B0); GM_MMA(1, 1, At, B1); GM_BAR; GM_SCHED;
#undef GM_WAIT_V8_LATER
            GM_LDB(B0, 1, 0); GM_LDB(B1, 1, 1); GM_SCHED; GM_LDA(At, 1, 0); GM_STAGE(GM_SA(0, 1), a2 + (size_t)lda2 * 256, lda2, R0);
            GM_WAIT_V(8); GM_WAIT_L(0); GM_BAR; GM_MMA(0, 0, At, B0); GM_MMA(0, 1, At, B1); GM_BAR; GM_SCHED;
            GM_LDA(At, 1, 1); GM_STAGE(GM_SB(1, 0), b3, ldb2, RbP); GM_STAGE(GM_SB(1, 1), b3 + (size_t)ldb2 * 256, ldb2, RbP); GM_STAGE(GM_SA(1, 0), a3, lda2, R0);
            GM_WAIT_V(8); GM_WAIT_L(0); GM_BAR; GM_MMA(1, 0, At, B0); GM_MMA(1, 1, At, B1); GM_BAR; GM_SCHED;
        }
        if (wr == 0) GM_BAR;
        if (FRESH_WAITS && (cur.kind == K_AB || (cur.kind == K_STORE && cur.sub == 2) || (cur.kind == K_STORE_T && cur.sub == 1))) GM_WAIT_V(0);
#ifdef PROBE_EPI
        const unsigned long long te0_ = __builtin_amdgcn_s_memrealtime();
#endif
        E(acc, cur, wr, wc, fr, fq, lane, (const LAS float*)(lds + STAGE_BYTES + (ui & 1) * 4096), (const LAS float*)(lds + STAGE_BYTES + 8192 + (ui & 1) * 1024));
#ifdef PROBE_EPI
        if (cur.kind == PROBE_EPI) { asm volatile("s_waitcnt vmcnt(0)" ::: "memory"); const unsigned long long t1_ = __builtin_amdgcn_s_memrealtime(); const unsigned long long d_ = t1_ - te0_; while (__builtin_amdgcn_s_memrealtime() - t1_ < d_) __builtin_amdgcn_s_sleep(2); }
#endif
        if (!has_next) break;
#pragma unroll
        for (int a = 0; a < 2; ++a)
#pragma unroll
            for (int b = 0; b < 2; ++b)
#pragma unroll
                for (int m = 0; m < 4; ++m)
#pragma unroll
                    for (int n = 0; n < 2; ++n) acc[a][b][m][n] = (f32x4){0.f, 0.f, 0.f, 0.f};
        cur = nxt; cA = nA; cB = nB; clda = nlda; cldb = nldb; ++ui;
        if (wr == 1) GM_BAR;
    }
    GM_WAIT_V(0);
    GM_BAR;
#undef GM_SA
#undef GM_SB
#undef GM_STAGE
#undef GM_LDA
#undef GM_LDB
#undef GM_MMA
#undef GM_WAIT_V
#undef GM_WAIT_L
#undef GM_BAR
#undef GM_SCHED
}

#if SS_PREFETCH
#define SSROW(pan, r) row_scale_l(ssl, (r))
#else
#define SSROW(pan, r) row_scale((pan) * BM + (r))
#endif
struct Epi {
    unsigned char* ws;
    const float* xin; float* xout;
    const float* b_gate;
    const float* gnext;
    const float* gfinal;
    LAS float* spare;
    DI float row_scale(int row) const { const f32x4 s = *(const f32x4*)((const float*)(ws + WS_SS) + (size_t)row * 4); return rsqrtf(((s.x + s.y) + (s.z + s.w)) * (1.0f / 1024.0f) + EPS); }
    static DI float row_scale_l(const LAS float* ssl, int r) { const f32x4 s = *(const LAS f32x4*)(ssl + r * 4); return rsqrtf(((s.x + s.y) + (s.z + s.w)) * (1.0f / 1024.0f) + EPS); }
    DI unsigned char* scratch_tile(int pm, int pn) const { return ws + WS_SCR + (size_t)pm * 256 * SCRLD + pn * 256; }
    DI void operator()(f32x4 (&acc)[2][2][4][2], const Unit& u, int wr, int wc, int fr, int fq, int lane, const LAS float* ssl, const LAS float* bil) const {
        int rl0 = wr * 64 + fr, cl0 = wc * 32 + 8 * fq;
        asm volatile("" : "+v"(rl0), "+v"(cl0));
        if (u.kind == K_STORE) {
            bf16_t* base; int ldc; bool scale = true;
            if (u.sub == 0) {
                if (u.pn < 6) { base = (bf16_t*)(ws + WS_R) + (size_t)u.pm * 256 * RALD + u.pn * 256; ldc = RALD; }
                else { const int pc = u.pn < 8 ? (u.pn - 6) * 256 : (u.pn - 7) * 256; base = (bf16_t*)(ws + WS_P) + (size_t)u.pm * 256 * PLD + pc; ldc = PLD; }
            } else if (u.sub == 1) { base = (bf16_t*)(ws + WS_R) + (size_t)u.pm * 256 * RBLD + u.pn * 256; ldc = RBLD; }
            else { base = (bf16_t*)(ws + WS_KVM) + (size_t)u.l * 1024 * 1024 + (size_t)u.pm * 256 * 256; ldc = 256; scale = false; }
            const bool rope = (u.sub == 0 && u.pn >= 10);
            const float rsc = (u.pn == 11) ? 0.125f : 1.0f;
            const float* rc = (const float*)(ws + WS_ROPE); const int fi = (cl0 & 63) >> 1;
            float scq[2][4];
#pragma unroll
            for (int ai = 0; ai < 2; ++ai)
#pragma unroll
                for (int m = 0; m < 4; ++m) scq[ai][m] = scale ? SSROW(u.pm, rl0 + ai * HALF + m * 16) : 1.0f;
#pragma unroll
            for (int ai = 0; ai < 2; ++ai) {
                f32x4 csq[4], snq[4];
                if (rope) {
#pragma unroll
                    for (int m = 0; m < 4; ++m) { const size_t ro = (size_t)(u.pm * BM + rl0 + ai * HALF + m * 16) * 32 + fi; csq[m] = *(const f32x4*)(rc + ro); snq[m] = *(const f32x4*)(rc + (size_t)T * 32 + ro); }
                }
#pragma unroll
                for (int m = 0; m < 4; ++m) {
                    const int rl = rl0 + ai * HALF + m * 16;
                    const float sc = scq[ai][m];
                    bf16_t* rowp = base + (size_t)rl * ldc + cl0;
                    f32x4 cs4 = {1.f, 1.f, 1.f, 1.f}, sn4 = {0.f, 0.f, 0.f, 0.f};
                    if (rope) { cs4 = csq[m]; sn4 = snq[m]; }
#pragma unroll
                    for (int bj = 0; bj < 2; ++bj) { f32x4 v0 = acc[ai][bj][m][0] * sc, v1 = acc[ai][bj][m][1] * sc;
                        if (rope) { f32x4 r0, r1;
                            r0[0] = (v0[0] * cs4[0] - v0[1] * sn4[0]) * rsc; r0[1] = (v0[0] * sn4[0] + v0[1] * cs4[0]) * rsc; r0[2] = (v0[2] * cs4[1] - v0[3] * sn4[1]) * rsc; r0[3] = (v0[2] * sn4[1] + v0[3] * cs4[1]) * rsc;
                            r1[0] = (v1[0] * cs4[2] - v1[1] * sn4[2]) * rsc; r1[1] = (v1[0] * sn4[2] + v1[1] * cs4[2]) * rsc; r1[2] = (v1[2] * cs4[3] - v1[3] * sn4[3]) * rsc; r1[3] = (v1[2] * sn4[3] + v1[3] * cs4[3]) * rsc;
                            v0 = r0; v1 = r1; }
                        u32x4 w; w.x = pk2(v0[0], v0[1]); w.y = pk2(v0[2], v0[3]); w.z = pk2(v1[0], v1[1]); w.w = pk2(v1[2], v1[3]);
                        *(u32x4*)(rowp + bj * HALF) = w; }
                }
            }
        } else if (u.kind == K_STORE_T) {
            bf16_t* base; const bool scale = (u.sub == 0);
            if (u.sub == 0) base = (bf16_t*)(ws + WS_VTSB) + (size_t)u.pm * 256 * VTLD + u.pn * 256;
            else base = (bf16_t*)(ws + WS_KVM) + (size_t)u.l * 1024 * 1024 + 256 * 2048 + u.pn * 256;
            const int ldc = (u.sub == 0) ? VTLD : 2048;
            f32x4 cs[2][2];
#pragma unroll
            for (int bj = 0; bj < 2; ++bj)
#pragma unroll
                for (int n = 0; n < 2; ++n)
#pragma unroll
                    for (int j = 0; j < 4; ++j) cs[bj][n][j] = scale ? SSROW(u.pn, cl0 + bj * HALF + 4 * n + j) : 1.0f;
#pragma unroll
            for (int ai = 0; ai < 2; ++ai)
#pragma unroll
                for (int m = 0; m < 4; ++m) {
                    const int rl = rl0 + ai * HALF + m * 16;
                    bf16_t* rowp = base + (size_t)rl * ldc + cl0;
#pragma unroll
                    for (int bj = 0; bj < 2; ++bj) { const f32x4 v0 = acc[ai][bj][m][0] * cs[bj][0], v1 = acc[ai][bj][m][1] * cs[bj][1];
                        u32x4 w; w.x = pk2(v0[0], v0[1]); w.y = pk2(v0[2], v0[3]); w.z = pk2(v1[0], v1[1]); w.w = pk2(v1[2], v1[3]);
                        *(u32x4*)(rowp + bj * HALF) = w; }
                }
        } else if (u.kind == K_AB) {
            if (wc == 0 && fq == 0) {
                float* base = (float*)(ws + WS_AB) + (size_t)u.pm * 256 * 8;
#pragma unroll
                for (int ai = 0; ai < 2; ++ai)
#pragma unroll
                    for (int m = 0; m < 4; ++m) {
                        const int rl = rl0 + ai * HALF + m * 16;
                        const float sc = SSROW(u.pm, rl);
                        float* rowp = base + (size_t)rl * 8;
                        *(f32x4*)(rowp) = acc[ai][0][m][0] * sc; *(f32x4*)(rowp + 4) = acc[ai][0][m][1] * sc;
                    }
            }
        } else if (u.kind == K_GATE) {
            unsigned char* base = scratch_tile(u.pm, u.pn);
            const float* bias = b_gate + (size_t)u.l * 4096 + (u.sub & 3) * 1024 + u.pn * 256;
            f32x4 bv[2][2];
#pragma unroll
            for (int bj = 0; bj < 2; ++bj)
#pragma unroll
#if SS_PREFETCH
                for (int n = 0; n < 2; ++n) bv[bj][n] = *(const LAS f32x4*)(bil + cl0 + bj * HALF + 4 * n) * -1.4426950408889634f;
#else
                for (int n = 0; n < 2; ++n) bv[bj][n] = *(const f32x4*)(bias + cl0 + bj * HALF + 4 * n) * -1.4426950408889634f;
#endif
            float scq[2][4];
#pragma unroll
            for (int ai = 0; ai < 2; ++ai)
#pragma unroll
                for (int m = 0; m < 4; ++m) scq[ai][m] = SSROW(u.pm, rl0 + ai * HALF + m * 16) * -1.4426950408889634f;
#pragma unroll
            for (int ai = 0; ai < 2; ++ai)
#pragma unroll
                for (int m = 0; m < 4; ++m) {
                    const int rl = rl0 + ai * HALF + m * 16;
                    const float sc = scq[ai][m];
                    unsigned char* rowp = base + (size_t)rl * SCRLD + cl0;
#pragma unroll
                    for (int bj = 0; bj < 2; ++bj) { const f32x4 v0 = acc[ai][bj][m][0] * sc + bv[bj][0], v1 = acc[ai][bj][m][1] * sc + bv[bj][1];
                        unsigned pa = 0u, pb = 0u;
#define G255(x) __builtin_amdgcn_rcpf(__builtin_amdgcn_exp2f(x) * (1.0f / 255.0f) + (1.0f / 255.0f))
                        pa = __builtin_amdgcn_cvt_pk_u8_f32(G255(v0[0]), 0, pa); pa = __builtin_amdgcn_cvt_pk_u8_f32(G255(v0[1]), 1, pa);
                        pa = __builtin_amdgcn_cvt_pk_u8_f32(G255(v0[2]), 2, pa); pa = __builtin_amdgcn_cvt_pk_u8_f32(G255(v0[3]), 3, pa);
                        pb = __builtin_amdgcn_cvt_pk_u8_f32(G255(v1[0]), 0, pb); pb = __builtin_amdgcn_cvt_pk_u8_f32(G255(v1[1]), 1, pb);
                        pb = __builtin_amdgcn_cvt_pk_u8_f32(G255(v1[2]), 2, pb); pb = __builtin_amdgcn_cvt_pk_u8_f32(G255(v1[3]), 3, pb);
#undef G255
                        EPI_ST((u32x2*)(rowp + bj * HALF), ((u32x2){pa, pb})); }
                }
        } else if (u.kind == K_BRANCH) {
            bf16_t* base = (bf16_t*)(ws + WS_MRG) + (size_t)u.pm * 256 * MRGLD + u.pn * 256; const unsigned char* gbase = scratch_tile(u.pm, u.pn);
            const bool first = (u.sub & 4) != 0;
            const float i255 = 1.0f / 255.0f;
#ifdef BR_ALL_IN_FLIGHT
            u32x2 gq2[2][4][2]; u32x4 tq[2][4][2];
#pragma unroll
            for (int ai = 0; ai < 2; ++ai)
#pragma unroll
                for (int m = 0; m < 4; ++m) { const int rl = rl0 + ai * HALF + m * 16;
#pragma unroll
                    for (int bj = 0; bj < 2; ++bj) { gq2[ai][m][bj] = EPI_LD((const u32x2*)(gbase + (size_t)rl * SCRLD + cl0 + bj * HALF));
                        tq[ai][m][bj] = first ? (u32x4){0u, 0u, 0u, 0u} : EPI_LD((const u32x4*)(base + (size_t)rl * MRGLD + cl0 + bj * HALF)); } }
#pragma unroll
            for (int ai = 0; ai < 2; ++ai) {
#pragma unroll
                for (int m = 0; m < 4; ++m) { const int rl = rl0 + ai * HALF + m * 16;
#pragma unroll
                    for (int bj = 0; bj < 2; ++bj) {
                        const u32x4 t = tq[ai][m][bj]; const f32x4 v0 = acc[ai][bj][m][0], v1 = acc[ai][bj][m][1]; const unsigned ga = gq2[ai][m][bj].x, gb = gq2[ai][m][bj].y;
                        u32x4 w;
                        w.x = pk2(bflo(t.x) + (float)(ga & 0xffu) * i255 * v0[0], bfhi(t.x) + (float)((ga >> 8) & 0xffu) * i255 * v0[1]);
                        w.y = pk2(bflo(t.y) + (float)((ga >> 16) & 0xffu) * i255 * v0[2], bfhi(t.y) + (float)(ga >> 24) * i255 * v0[3]);
                        w.z = pk2(bflo(t.z) + (float)(gb & 0xffu) * i255 * v1[0], bfhi(t.z) + (float)((gb >> 8) & 0xffu) * i255 * v1[1]);
                        w.w = pk2(bflo(t.w) + (float)((gb >> 16) & 0xffu) * i255 * v1[2], bfhi(t.w) + (float)(gb >> 24) * i255 * v1[3]);
                        EPI_ST((u32x4*)(base + (size_t)rl * MRGLD + cl0 + bj * HALF), w); } }
                asm volatile("" ::: "memory");
            }
#else
#pragma unroll
            for (int ai = 0; ai < 2; ++ai) {
                u32x2 gq2[4][2]; u32x4 tq[4][2];
#pragma unroll
                for (int m = 0; m < 4; ++m) { const int rl = rl0 + ai * HALF + m * 16;
#pragma unroll
                    for (int bj = 0; bj < 2; ++bj) { gq2[m][bj] = EPI_LD((const u32x2*)(gbase + (size_t)rl * SCRLD + cl0 + bj * HALF));
                        tq[m][bj] = first ? (u32x4){0u, 0u, 0u, 0u} : EPI_LD((const u32x4*)(base + (size_t)rl * MRGLD + cl0 + bj * HALF)); } }
#pragma unroll
                for (int m = 0; m < 4; ++m) { const int rl = rl0 + ai * HALF + m * 16;
#pragma unroll
                    for (int bj = 0; bj < 2; ++bj) {
                        const u32x4 t = tq[m][bj]; const f32x4 v0 = acc[ai][bj][m][0], v1 = acc[ai][bj][m][1]; const unsigned ga = gq2[m][bj].x, gb = gq2[m][bj].y;
                        u32x4 w;
                        w.x = pk2(bflo(t.x) + (float)(ga & 0xffu) * i255 * v0[0], bfhi(t.x) + (float)((ga >> 8) & 0xffu) * i255 * v0[1]);
                        w.y = pk2(bflo(t.y) + (float)((ga >> 16) & 0xffu) * i255 * v0[2], bfhi(t.y) + (float)(ga >> 24) * i255 * v0[3]);
                        w.z = pk2(bflo(t.z) + (float)(gb & 0xffu) * i255 * v1[0], bfhi(t.z) + (float)((gb >> 8) & 0xffu) * i255 * v1[1]);
                        w.w = pk2(bflo(t.w) + (float)((gb >> 16) & 0xffu) * i255 * v1[2], bfhi(t.w) + (float)(gb >> 24) * i255 * v1[3]);
                        EPI_ST((u32x4*)(base + (size_t)rl * MRGLD + cl0 + bj * HALF), w); } }
                asm volatile("" ::: "memory");
            }
#endif
        } else {
            bf16_t* base = (bf16_t*)(ws + WS_XN) + (size_t)u.pm * 256 * 1024 + u.pn * 256;
            const bool wxn = gnext != nullptr, fin = gfinal != nullptr;
            f32x4 gv[2][2];
#pragma unroll
            for (int bj = 0; bj < 2; ++bj)
#pragma unroll
#if SS_PREFETCH
                for (int n = 0; n < 2; ++n) gv[bj][n] = (wxn || fin) ? *(const LAS f32x4*)(bil + cl0 + bj * HALF + 4 * n) : (f32x4){0.f, 0.f, 0.f, 0.f};
#else
                for (int n = 0; n < 2; ++n) gv[bj][n] = wxn ? *(const f32x4*)(gnext + u.pn * BM + cl0 + bj * HALF + 4 * n) : (fin ? *(const f32x4*)(gfinal + u.pn * BM + cl0 + bj * HALF + 4 * n) : (f32x4){0.f, 0.f, 0.f, 0.f});
#endif
#pragma unroll
            for (int ah = 0; ah < 4; ++ah) {
                const int ai = ah >> 1, m0 = (ah & 1) * 2;
                f32x4 xq[2][2][2];
#pragma unroll
                for (int mm = 0; mm < 2; ++mm) { const size_t goff = (size_t)(u.pm * BM + rl0 + ai * HALF + (m0 + mm) * 16) * D + u.pn * BM + cl0;
#pragma unroll
                    for (int bj = 0; bj < 2; ++bj) { xq[mm][bj][0] = *(const f32x4*)(xin + goff + bj * HALF); xq[mm][bj][1] = *(const f32x4*)(xin + goff + bj * HALF + 4); } }
#pragma unroll
                for (int mm = 0; mm < 2; ++mm) {
                    const int m = m0 + mm, rl = rl0 + ai * HALF + m * 16;
                    const size_t goff = (size_t)(u.pm * BM + rl) * D + u.pn * BM + cl0;
                    float sq = 0.f;
#pragma unroll
                    for (int bj = 0; bj < 2; ++bj) {
                        const f32x4 v0 = acc[ai][bj][m][0] + xq[mm][bj][0], v1 = acc[ai][bj][m][1] + xq[mm][bj][1];
                        acc[ai][bj][m][0] = v0; acc[ai][bj][m][1] = v1;
                        if (!fin) { *(f32x4*)(xout + goff + bj * HALF) = v0; *(f32x4*)(xout + goff + bj * HALF + 4) = v1; }
                        sq += (v0[0] * v0[0] + v0[1] * v0[1]) + (v0[2] * v0[2] + v0[3] * v0[3]) + (v1[0] * v1[0] + v1[1] * v1[1]) + (v1[2] * v1[2] + v1[3] * v1[3]);
                        if (wxn) { const f32x4 a = v0 * gv[bj][0], b = v1 * gv[bj][1];
                            u32x4 w; w.x = pk2(a[0], a[1]); w.y = pk2(a[2], a[3]); w.z = pk2(b[0], b[1]); w.w = pk2(b[2], b[3]);
                            *(u32x4*)(base + (size_t)rl * 1024 + cl0 + bj * HALF) = w; }
                    }
                    sq += shx(sq, 16, lane); sq += shx(sq, 32, lane);
                    if (fq == 0) spare[rl * 4 + wc] = sq;
                }
                asm volatile("" ::: "memory");
            }
            LDS_WAIT(); __builtin_amdgcn_s_barrier(); asm volatile("" ::: "memory");
            const int t_ = wr * 256 + wc * 64 + lane;
            unsigned* ssw = (unsigned*)(ws + WS_SS);
            if (t_ < 256) { const int rl = t_; const f32x4 p = *(const LAS f32x4*)(spare + rl * 4); const float tot = (p.x + p.y) + (p.z + p.w);
                if (fin) __hip_atomic_store(ssw + (size_t)(u.pm * BM + rl) * 4 + u.pn, __builtin_bit_cast(unsigned, tot), __ATOMIC_RELAXED, __HIP_MEMORY_SCOPE_AGENT);
                else ((float*)ssw)[(size_t)(u.pm * BM + rl) * 4 + u.pn] = tot; }
            if (fin) {
                unsigned* cnt = (unsigned*)(ws + WS_CTL) + CW_PANEL + 64 * u.pm;
                asm volatile("s_waitcnt vmcnt(0)" ::: "memory");
                __builtin_amdgcn_s_barrier(); asm volatile("" ::: "memory");
                if (t_ == 0) {
                    __hip_atomic_fetch_add(cnt, 1u, __ATOMIC_RELAXED, __HIP_MEMORY_SCOPE_AGENT);
                    unsigned sp_ = 0;
                    while (__hip_atomic_load(cnt, __ATOMIC_RELAXED, __HIP_MEMORY_SCOPE_AGENT) < 4u) { __builtin_amdgcn_s_sleep(1); if (++sp_ > (1u << 22)) break; }
                }
                __builtin_amdgcn_s_barrier(); asm volatile("" ::: "memory");
#pragma unroll
                for (int ai = 0; ai < 2; ++ai)
#pragma unroll
                    for (int m = 0; m < 4; ++m) {
                        const int rl = rl0 + ai * HALF + m * 16; const unsigned* sp4 = ssw + (size_t)(u.pm * BM + rl) * 4;
                        const float p0 = __builtin_bit_cast(float, __hip_atomic_load(sp4 + 0, __ATOMIC_RELAXED, __HIP_MEMORY_SCOPE_AGENT)), p1 = __builtin_bit_cast(float, __hip_atomic_load(sp4 + 1, __ATOMIC_RELAXED, __HIP_MEMORY_SCOPE_AGENT));
                        const float p2 = __builtin_bit_cast(float, __hip_atomic_load(sp4 + 2, __ATOMIC_RELAXED, __HIP_MEMORY_SCOPE_AGENT)), p3 = __builtin_bit_cast(float, __hip_atomic_load(sp4 + 3, __ATOMIC_RELAXED, __HIP_MEMORY_SCOPE_AGENT));
                        const float rs = rsqrtf(((p0 + p1) + (p2 + p3)) * (1.0f / 1024.0f) + EPS);
                        const size_t goff = (size_t)(u.pm * BM + rl) * D + u.pn * BM + cl0;
#pragma unroll
                        for (int bj = 0; bj < 2; ++bj) { *(f32x4*)(xout + goff + bj * HALF) = acc[ai][bj][m][0] * rs * gv[bj][0]; *(f32x4*)(xout + goff + bj * HALF + 4) = acc[ai][bj][m][1] * rs * gv[bj][1]; }
                    }
            }
        }
    }
};
}

struct Args {
    const float* x; const float* mem; const int* positions; const float* norm_g; const float* mem_norm_g; const float* w_in; const float* b_gate;
    const float* dn_conv_w; const float* dn_a_log; const float* dn_dt_bias; const float* dn_norm_g; const float* ret_norm_g; const float* w_mem_kv;
    const float* w_br_sb; const float* w_br_dn; const float* w_br_ret; const float* w_br_mem; const float* w_out; const float* final_norm_g;
    float* out; unsigned char* ws; int ph_lo, ph_hi, li, pad;
};
struct Frame { LAS unsigned char* lds; int tid, lane, wave, G, gw, NGW; };
DI Frame mkframe(int wv) {
    extern __shared__ __attribute__((aligned(16))) unsigned char lds_raw[];
    Frame F; F.lds = (LAS unsigned char*)lds_raw; F.tid = opaque_tid(wv); F.lane = F.tid & 63; F.wave = wv;
    F.G = gridDim.x; F.gw = opaque_bid() * NWAVES + F.wave; F.NGW = F.G * NWAVES; return F;
}
typedef const __attribute__((address_space(4))) Args* ArgsP;
DI ArgsP kargs() { unsigned long long p = (unsigned long long)__builtin_amdgcn_kernarg_segment_ptr(); asm volatile("" : "+s"(p)); return (ArgsP)p; }
DI unsigned char* rst_base(ArgsP ap, int l) { return l == 0 ? (unsigned char*)ap->out : ap->ws + WS_WG + (size_t)(l - 1) * 4096 * 1024 * 2; }

struct TItem { const float* W; bf16_t* WT; int K, Nsrc, k0, csrc, rdst, rs; };
DI void titem_load(const TItem& t, int lane, float (&v)[32]) {
#pragma unroll
    for (int i = 0; i < 32; ++i) v[i] = t.W[(size_t)(t.k0 + 2 * i + (lane >> 5)) * t.Nsrc + t.csrc + (lane & 31)];
}
DI void titem_store(LAS float* scr, int lane, const TItem& t, const float (&v)[32]) {
#pragma unroll
    for (int i = 0; i < 32; ++i) scr[(2 * i + (lane >> 5)) * 33 + (lane & 31)] = v[i];
    LDS_WAIT(); asm volatile("" ::: "memory");
    const int c = lane & 7;
#pragma unroll
    for (int j = 0; j < 4; ++j) { const int n = (lane >> 3) + 8 * j; const LAS float* sp = scr + (8 * c) * 33 + n;
        u32x4 o; o.x = pk2(sp[0 * 33], sp[1 * 33]); o.y = pk2(sp[2 * 33], sp[3 * 33]); o.z = pk2(sp[4 * 33], sp[5 * 33]); o.w = pk2(sp[6 * 33], sp[7 * 33]);
        *(u32x4*)(t.WT + (size_t)(t.rdst + n * t.rs) * t.K + t.k0 + 8 * c) = o; }
    LDS_WAIT(); asm volatile("" ::: "memory");
}
DI void memn_rows(const Frame& F, ArgsP ap, int l) {
    unsigned char* ws = ap->ws;
    for (int m = F.gw; m < BATCH * MEMLEN; m += F.NGW) {
        const f32x4* xr = (const f32x4*)(ap->mem + (size_t)m * D) + F.lane; const f32x4* gr = (const f32x4*)(ap->mem_norm_g + (size_t)l * D) + F.lane;
        f32x4 v[4]; float sq = 0.f;
#pragma unroll
        for (int j = 0; j < 4; ++j) { v[j] = xr[64 * j]; sq += (v[j].x * v[j].x + v[j].y * v[j].y) + (v[j].z * v[j].z + v[j].w * v[j].w); }
        const float rs = rsqrtf(wave_sum(sq, F.lane) * (1.f / D) + EPS);
        unsigned long long* o8 = (unsigned long long*)((bf16_t*)(ws + WS_MEMN) + (size_t)m * D) + F.lane;
#pragma unroll
        for (int j = 0; j < 4; ++j) { const f32x4 g = gr[64 * j];
            o8[64 * j] = (unsigned long long)pk2(v[j].x * rs * g.x, v[j].y * rs * g.y) | ((unsigned long long)pk2(v[j].z * rs * g.z, v[j].w * rs * g.w) << 32); }
    }
}
struct TSeg { int src, K, Nsrc, c0, ncols, dst, r0; };
DI void convert_weights(const Frame& F, ArgsP ap, int l, int first, int stride, int part) {
    unsigned char* ws = ap->ws;
    LAS float* scr = (LAS float*)(F.lds + F.wave * 16384);
    constexpr int NSEG = 14;
    const TSeg seg[NSEG] = {
        {0, 1024, IN_COLS, 2048, 2048, 0, 0}, {0, 1024, IN_COLS, 5640, 256, 0, 2304}, {0, 1024, IN_COLS, 4104, 256, 0, 2560}, {0, 1024, IN_COLS, 4360, 256, 0, 2816},
        {0, 1024, IN_COLS, 0, 1024, 1, 0}, {0, 1024, IN_COLS, 1536, 512, 1, 1024}, {0, 1024, IN_COLS, 5128, 512, 1, 1536}, {0, 1024, IN_COLS, 1024, 512, 1, 2048}, {0, 1024, IN_COLS, 4616, 512, 1, 2560},
        {0, 1024, IN_COLS, 5896, 4096, 2, 0},
        {1, 512, 1024, 0, 1024, 3, 0}, {2, 512, 1024, 0, 1024, 3, 1024}, {3, 512, 1024, 0, 1024, 3, 2048}, {5, 1024, 1024, 0, 1024, 4, 0} };
    int cum[NSEG + 1]; cum[0] = 0;
#pragma unroll
    for (int q = 0; q < NSEG; ++q) cum[q + 1] = cum[q] + (seg[q].K / 64) * (seg[q].ncols / 32);
    const int per_layer = cum[NSEG] + (256 / 64) * (1024 / 32) + (1024 / 64) * (512 / 32);
    const int c9 = cum[9], c14m = cum[NSEG] + 128;
    const int n1 = c9 + (per_layer - c14m), n2 = c14m - c9, nit = part == 0 ? per_layer : (part == 1 ? n1 : n2);
    auto params = [&](int it, TItem& t) -> bool {
        if (it >= nit) return false;
        int r = part == 0 ? it : (part == 1 ? (it < c9 ? it : it - c9 + c14m) : it + c9);
        const float* W; int K, Nsrc, c0, ncols, r0; bf16_t* WT; bool perm = false;
        if (r < cum[NSEG]) {
            int q = 0;
#pragma unroll
            for (int qq = 1; qq < NSEG; ++qq) if (r >= cum[qq]) q = qq;
            int src = 0, dst = 0; K = 1024; Nsrc = IN_COLS; c0 = 0; ncols = 32; r0 = 0; int base = 0;
#pragma unroll
            for (int qq = 0; qq < NSEG; ++qq) if (q == qq) { src = seg[qq].src; K = seg[qq].K; Nsrc = seg[qq].Nsrc; c0 = seg[qq].c0; ncols = seg[qq].ncols; dst = seg[qq].dst; r0 = seg[qq].r0; base = cum[qq]; }
            r -= base; perm = (q == 2 || q == 3);
            W = src == 0 ? ap->w_in + (size_t)l * D * IN_COLS : src == 1 ? ap->w_br_sb + (size_t)l * 512 * 1024 : src == 2 ? ap->w_br_dn + (size_t)l * 512 * 1024 : src == 3 ? ap->w_br_ret + (size_t)l * 512 * 1024 : ap->w_out + (size_t)l * 1024 * 1024;
            WT = dst == 0 ? (bf16_t*)(ws + WS_WINA) + (size_t)l * 3072 * 1024 : dst == 1 ? (bf16_t*)(ws + WS_WINB) + (size_t)l * 3072 * 1024 : dst == 2 ? (bf16_t*)(ws + WS_WG) + (size_t)l * 4096 * 1024
               : dst == 3 ? (bf16_t*)(ws + WS_WBR) + (size_t)l * 2 * 1024 * 1024 : (bf16_t*)(ws + WS_WOUT) + (size_t)l * 1024 * 1024;
            if (dst == 3) { WT += (size_t)r0 * 512; r0 = 0; }
        } else if (r < cum[NSEG] + 128) { r -= cum[NSEG]; W = ap->w_br_mem + (size_t)l * 256 * 1024; K = 256; Nsrc = 1024; c0 = 0; ncols = 1024; r0 = 0; WT = (bf16_t*)(ws + WS_WBR) + (size_t)l * 2 * 1024 * 1024 + 3 * 1024 * 512; }
        else { r -= cum[NSEG] + 128; W = ap->w_mem_kv + (size_t)l * 1024 * 512; K = 1024; Nsrc = 512; c0 = 0; ncols = 512; r0 = 0; WT = (bf16_t*)(ws + WS_WKV) + (size_t)l * 512 * 1024; }
        const int nblk = ncols / 32, kb = r / nblk, nb = r % nblk;
        t.W = W; t.WT = WT; t.K = K; t.Nsrc = Nsrc; t.k0 = 64 * kb; t.csrc = c0 + 32 * nb; t.rdst = perm ? r0 + (nb >> 1) * 64 + (nb & 1) : r0 + 32 * nb; t.rs = perm ? 2 : 1;
        return true;
    };
    {
        TItem ta, tb; float va[32], vb[32];
        int it = first;
        bool ha = params(it, ta); if (ha) titem_load(ta, F.lane, va);
        while (ha) {
            it += stride; const bool hb = params(it, tb); if (hb) titem_load(tb, F.lane, vb);
            titem_store(scr, F.lane, ta, va);
            if (!hb) break;
            it += stride; ha = params(it, ta); if (ha) titem_load(ta, F.lane, va);
            titem_store(scr, F.lane, tb, vb);
        }
    }
    if (part != 2) {
        const float* win = ap->w_in + (size_t)l * D * IN_COLS; bf16_t* wa = (bf16_t*)(ws + WS_WINA) + (size_t)l * 3072 * 1024;
        for (int i = first * 64 + F.lane; i < 256 * 1024; i += stride * 64) { const int r = i >> 10, k = i & 1023;
            wa[(size_t)(2048 + r) * 1024 + k] = r < 8 ? (bf16_t)f2bf(win[(size_t)k * IN_COLS + 4096 + r]) : (bf16_t)0; }
    }
}
DI void p0_prologue(int wv) {
    const Frame F = mkframe(wv);
    const ArgsP ap = kargs();
    unsigned char* ws = ap->ws;
#ifdef PROBE_PRO
    unsigned long long tq0_ = __builtin_amdgcn_s_memrealtime();
#define PRO_ECHO(k) do { asm volatile("s_waitcnt vmcnt(0)" ::: "memory"); const unsigned long long t1_ = __builtin_amdgcn_s_memrealtime(); if (PROBE_PRO == (k)) { const unsigned long long d_ = t1_ - tq0_; while (__builtin_amdgcn_s_memrealtime() - t1_ < d_) __builtin_amdgcn_s_sleep(2); } tq0_ = __builtin_amdgcn_s_memrealtime(); } while (0)
#else
#define PRO_ECHO(k) do { } while (0)
#endif
    convert_weights(F, ap, 0, F.gw, F.NGW, 1);
    PRO_ECHO(1);
    constexpr int XNR = 4;
    for (int m = XNR * F.gw; m < T; m += XNR * F.NGW) {
        f32x4 v[XNR][4]; const f32x4* gr = (const f32x4*)ap->norm_g + F.lane;
#pragma unroll
        for (int q = 0; q < XNR; ++q)
#pragma unroll
            for (int j = 0; j < 4; ++j) v[q][j] = ((const f32x4*)(ap->x + (size_t)(m + q) * D) + F.lane)[64 * j];
#pragma unroll
        for (int q = 0; q < XNR; ++q) {
            unsigned long long* o8 = (unsigned long long*)((bf16_t*)(ws + WS_XN) + (size_t)(m + q) * D) + F.lane; float sq = 0.f;
#pragma unroll
            for (int j = 0; j < 4; ++j) { const f32x4 x = v[q][j], g = gr[64 * j]; sq += (x.x * x.x + x.y * x.y) + (x.z * x.z + x.w * x.w);
                o8[64 * j] = (unsigned long long)pk2(x.x * g.x, x.y * g.y) | ((unsigned long long)pk2(x.z * g.z, x.w * g.w) << 32); }
            sq = wave_sum(sq, F.lane);
            if (F.lane == 0) *(f32x4*)((float*)(ws + WS_SS) + (size_t)(m + q) * 4) = (f32x4){sq, 0.f, 0.f, 0.f};
        }
    }
    PRO_ECHO(2);
    memn_rows(F, ap, 0);
    PRO_ECHO(3);
    for (int i = F.gw * 64 + F.lane; i < T * 32; i += F.NGW * 64) {
        const int t = i >> 5, f = i & 31;
        const float inv = exp2f(-(float)f * (13.287712379549449f / 32.0f));
        const float ang = (float)ap->positions[t] * inv;
#ifdef ROPE_FAST_SINCOS
        const float rev = ang * 0.15915494309189535f; const float fr = rev - floorf(rev);
        const float sn = __builtin_amdgcn_sinf(fr), cs = __builtin_amdgcn_cosf(fr);
#else
        float sn, cs; sincosf(ang, &sn, &cs);
#endif
        ((float*)(ws + WS_ROPE))[i] = cs; ((float*)(ws + WS_ROPE))[T * 32 + i] = sn;
    }
}

struct SchedP1 {
    gm::TileOrder ord; unsigned char* ws; int l, half, c; bool with_kvm;
    DI void a_ready(const gm::Unit&, int, int) const {}
    DI bool next(int i, gm::Unit& u) const {
        int pm, pn;
        if (ord.tile(i, pm, pn)) {
            const bf16_t* xn = (const bf16_t*)(ws + WS_XN) + (size_t)pm * 256 * 1024;
            const bf16_t* w = (const bf16_t*)(ws + (half == 0 ? WS_WINA : WS_WINB)) + ((size_t)l * 3072 + pn * 256) * 1024;
            u.lda = 1024; u.K = 1024; u.ldb = 1024; u.l = l; u.sub = half;
            if (half == 1 && pn >= 8) { u.A = w; u.B = xn; u.pm = pn - 8; u.pn = pm; u.kind = gm::K_STORE_T; u.sub = 0; }
            else { u.A = xn; u.B = w; u.pm = pm; u.pn = pn; u.kind = (half == 0 && pn == 8) ? gm::K_AB : gm::K_STORE; }
            return true;
        }
        const int kc = ord.c - (ord.nwg % ord.G);
        if (with_kvm && kc >= 0 && kc < 16 && i == (ord.nwg + ord.G - 1 - ord.c) / ord.G) {
            const int ll = l, ty = (kc >> 3) & 1, idx = kc & 7;
            const bf16_t* mn = (const bf16_t*)(ws + WS_MEMN) + (size_t)(idx * 256) * 1024;
            const bf16_t* w = (const bf16_t*)(ws + WS_WKV) + ((size_t)ll * 512 + ty * 256) * 1024;
            u.lda = 1024; u.K = 1024; u.ldb = 1024; u.l = ll;
            if (ty == 0) { u.A = mn; u.B = w; u.pm = idx; u.pn = 0; u.kind = gm::K_STORE; u.sub = 2; }
            else { u.A = w; u.B = mn; u.pm = 0; u.pn = idx; u.kind = gm::K_STORE_T; u.sub = 1; }
            return true;
        }
        return false;
    }
};
struct SchedP3 {
    int pm, pn, l, rot; bool ok; unsigned char* ws;
    DI void a_ready(const gm::Unit& u, int wid, int lane) const {
        if (u.kind != gm::K_BRANCH || (u.sub & 4) == 0) return;
        if (wid == 0) {
            if (lane == 0) { unsigned* cnt = (unsigned*)(ws + WS_CTL) + CW_READY + 4096 * l + 64 * pm; unsigned sp = 0u;
                while (__hip_atomic_load(cnt, __ATOMIC_RELAXED, __HIP_MEMORY_SCOPE_AGENT) < 16u) { __builtin_amdgcn_s_sleep(2); if (++sp > (1u << 20)) break; } }
            __builtin_amdgcn_fence(__ATOMIC_ACQUIRE, "agent");
            asm volatile("s_waitcnt vmcnt(0)" ::: "memory");
        }
        asm volatile("" ::: "memory"); __builtin_amdgcn_s_barrier(); asm volatile("" ::: "memory");
    }
    DI bool next(int i, gm::Unit& u) const {
        if (!ok || i >= 8) return false;
        const int br = ((i >> 1) + rot) & 3;
        const bf16_t* R = (const bf16_t*)(ws + WS_R); const bf16_t* P = (const bf16_t*)(ws + WS_P);
        u.pm = pm; u.pn = pn; u.sub = br | ((i >> 1) == 0 ? 4 : 0); u.l = l;
        if ((i & 1) == 0) {
            u.A = (const bf16_t*)(ws + WS_XN) + (size_t)pm * 256 * 1024; u.lda = 1024; u.K = 1024; u.ldb = 1024;
            u.B = (const bf16_t*)(ws + WS_WG) + ((size_t)l * 4096 + br * 1024 + pn * 256) * 1024;
            u.kind = gm::K_GATE;
        } else {
            const bf16_t* wbr = (const bf16_t*)(ws + WS_WBR) + (size_t)l * 2 * 1024 * 1024 + (size_t)br * 1024 * 512;
            const int K = br == 3 ? 256 : 512;
            const int acol = br == 0 ? RB_SBQ : (br == 1 ? P_DNZ : (br == 2 ? RB_RTZ : P_MEMQ));
            const bool inP = (br & 1) != 0;
            u.lda = inP ? PLD : RBLD; u.A = (inP ? P : R) + (size_t)pm * 256 * u.lda + acol; u.K = K; u.ldb = K; u.B = wbr + (size_t)pn * 256 * K;
            u.kind = gm::K_BRANCH;
        }
        return true;
    }
};
struct SchedP4 {
    int pm, pn, l; bool ok; unsigned char* ws;
    DI void a_ready(const gm::Unit&, int, int) const {}
    DI bool next(int i, gm::Unit& u) const {
        if (!ok || i >= 1) return false;
        u.A = (const bf16_t*)(ws + WS_MRG) + (size_t)pm * 256 * MRGLD; u.lda = MRGLD; u.K = 1024; u.ldb = 1024;
        u.B = (const bf16_t*)(ws + WS_WOUT) + ((size_t)l * 1024 + pn * 256) * 1024;
        u.pm = pm; u.pn = pn; u.kind = gm::K_OUT; u.sub = 0; u.l = l;
        return true;
    }
};

typedef float f32x16 __attribute__((ext_vector_type(16)));
typedef short s16x4 __attribute__((ext_vector_type(4)));
#define MFMA32(a, b, c) __builtin_amdgcn_mfma_f32_32x32x16_bf16((a), (b), (c), 0, 0, 0)
DI int crow(int reg, int hh) { return (reg & 3) + 8 * (reg >> 2) + 4 * hh; }
DI bf16x8 pack8(float a0, float a1, float a2, float a3, float a4, float a5, float a6, float a7) {
    u32x4 p;
    asm volatile("s_nop 0\n\tv_cvt_pk_bf16_f32 %0, %4, %5\n\tv_cvt_pk_bf16_f32 %1, %6, %7\n\tv_cvt_pk_bf16_f32 %2, %8, %9\n\tv_cvt_pk_bf16_f32 %3, %10, %11\n\ts_nop 1"
                 : "=&v"(p[0]), "=&v"(p[1]), "=&v"(p[2]), "=&v"(p[3]) : "v"(a0), "v"(a1), "v"(a2), "v"(a3), "v"(a4), "v"(a5), "v"(a6), "v"(a7));
    return __builtin_bit_cast(bf16x8, p);
}
DI bf16x8 pack8m(float a0, float a1, float a2, float a3, float a4, float a5, float a6, float a7) {
    u32x4 p;
    asm volatile("s_nop 15\n\ts_nop 3\n\tv_cvt_pk_bf16_f32 %0, %4, %5\n\tv_cvt_pk_bf16_f32 %1, %6, %7\n\tv_cvt_pk_bf16_f32 %2, %8, %9\n\tv_cvt_pk_bf16_f32 %3, %10, %11\n\ts_nop 1"
                 : "=&v"(p[0]), "=&v"(p[1]), "=&v"(p[2]), "=&v"(p[3]) : "v"(a0), "v"(a1), "v"(a2), "v"(a3), "v"(a4), "v"(a5), "v"(a6), "v"(a7));
    return __builtin_bit_cast(bf16x8, p);
}
namespace at {
constexpr int KST = 144, VST = 136;
constexpr int KT_BYTES = 64 * KST;
DI bf16x8 kfrag(LAS unsigned char* kt, int row, int ks, int hh) { return *(const LAS bf16x8*)(kt + row * KST + ks * 32 + hh * 16); }
DI bf16x8 vfrag(LAS unsigned char* vt, int row, int keyoff, int hh) {
    const LAS unsigned char* pp = vt + row * VST + (keyoff + 4 * hh) * 2;
    const u32x2 lo = *(const LAS u32x2*)pp, hi = *(const LAS u32x2*)(pp + 16);
    u32x4 r; r.x = lo.x; r.y = lo.y; r.z = hi.x; r.w = hi.y; return __builtin_bit_cast(bf16x8, r);
}
}

DI void mem_unit(int wv, int l, int unit) {
    const Frame F = mkframe(wv);
    unsigned char* ws = kargs()->ws; bf16_t* P = (bf16_t*)(ws + WS_P);
    const bf16_t* KM = (const bf16_t*)(ws + WS_KVM) + (size_t)l * 1024 * 1024; const bf16_t* VTM = KM + 2048 * 256;
    const int b = unit >> 5, h = (unit >> 3) & 3, qt = unit & 7, lane = F.lane, r = lane & 31, hh = lane >> 5;
    LAS unsigned char* kt = F.lds; LAS unsigned char* vt = F.lds + 256 * at::KST;
    constexpr int VS = 520;
#pragma unroll
    for (int i = 0; i < 4; ++i) { const int id = F.tid + 512 * i, row = id >> 3, ch = id & 7;
        const u32x4 v = *(const u32x4*)(KM + (size_t)(b * 256 + row) * 256 + h * 64 + ch * 8);
        *(LAS u32x4*)(kt + row * at::KST + ch * 16) = v; }
#pragma unroll
    for (int i = 0; i < 4; ++i) { const int id = F.tid + 512 * i, row = id >> 5, ch = id & 31;
        const u32x4 v = *(const u32x4*)(VTM + (size_t)(h * 64 + row) * 2048 + b * 256 + ch * 8);
        *(LAS u32x2*)(vt + row * VS + ch * 16) = (u32x2){v.x, v.y}; *(LAS u32x2*)(vt + row * VS + ch * 16 + 8) = (u32x2){v.z, v.w}; }
    const int t = b * SEQ + qt * 256 + wv * 32 + r;
    bf16_t* qp = P + (size_t)t * PLD + P_MEMQ + h * 64;
    bf16x8 qf[4];
#pragma unroll
    for (int ks = 0; ks < 4; ++ks) qf[ks] = *(const bf16x8*)(qp + 16 * ks + 8 * hh);
    __syncthreads();
    f32x16 z[8];
#pragma unroll
    for (int st = 0; st < 8; ++st) {
        f32x16 a = {0.f, 0.f, 0.f, 0.f, 0.f, 0.f, 0.f, 0.f, 0.f, 0.f, 0.f, 0.f, 0.f, 0.f, 0.f, 0.f};
#pragma unroll
        for (int ks = 0; ks < 4; ++ks) a = MFMA32(at::kfrag(kt, 32 * st + r, ks, hh), qf[ks], a);
        z[st] = a;
    }
    float mx = -3.0e38f;
#pragma unroll
    for (int st = 0; st < 8; ++st)
#pragma unroll
        for (int i = 0; i < 16; ++i) mx = fmaxf(mx, z[st][i]);
    mx = fmaxf(mx, shx(mx, 32, lane));
    const float c2 = 0.125f * 1.4426950408889634f; float sum = 0.f;
#pragma unroll
    for (int st = 0; st < 8; ++st)
#pragma unroll
        for (int i = 0; i < 16; ++i) { const float e = exp2f((z[st][i] - mx) * c2); z[st][i] = e; sum += e; }
    sum += shx(sum, 32, lane);
    f32x16 o0 = {0.f, 0.f, 0.f, 0.f, 0.f, 0.f, 0.f, 0.f, 0.f, 0.f, 0.f, 0.f, 0.f, 0.f, 0.f, 0.f}, o1 = o0;
#pragma unroll
    for (int st = 0; st < 8; ++st)
#pragma unroll
        for (int s2 = 0; s2 < 2; ++s2) {
            const bf16x8 pf = pack8(z[st][8 * s2], z[st][8 * s2 + 1], z[st][8 * s2 + 2], z[st][8 * s2 + 3], z[st][8 * s2 + 4], z[st][8 * s2 + 5], z[st][8 * s2 + 6], z[st][8 * s2 + 7]);
            const int keyoff = 32 * st + 16 * s2;
            { const LAS unsigned char* pp = vt + r * VS + (keyoff + 4 * hh) * 2; const u32x2 lo = *(const LAS u32x2*)pp, hi = *(const LAS u32x2*)(pp + 16);
              u32x4 q; q.x = lo.x; q.y = lo.y; q.z = hi.x; q.w = hi.y; o0 = MFMA32(__builtin_bit_cast(bf16x8, q), pf, o0); }
            { const LAS unsigned char* pp = vt + (32 + r) * VS + (keyoff + 4 * hh) * 2; const u32x2 lo = *(const LAS u32x2*)pp, hi = *(const LAS u32x2*)(pp + 16);
              u32x4 q; q.x = lo.x; q.y = lo.y; q.z = hi.x; q.w = hi.y; o1 = MFMA32(__builtin_bit_cast(bf16x8, q), pf, o1); }
        }
    const float inv = 1.f / sum;
    LAS unsigned char* ob = F.lds + 73728 + wv * (32 * at::KST);
#pragma unroll
    for (int g = 0; g < 4; ++g) {
        *(LAS u32x2*)(ob + r * at::KST + (8 * g + 4 * hh) * 2) = (u32x2){pk2(o0[4 * g] * inv, o0[4 * g + 1] * inv), pk2(o0[4 * g + 2] * inv, o0[4 * g + 3] * inv)};
        *(LAS u32x2*)(ob + r * at::KST + (32 + 8 * g + 4 * hh) * 2) = (u32x2){pk2(o1[4 * g] * inv, o1[4 * g + 1] * inv), pk2(o1[4 * g + 2] * inv, o1[4 * g + 3] * inv)};
    }
#pragma unroll
    for (int k = 0; k < 4; ++k) { const int q = k * 64 + lane, row = q >> 3, pc = q & 7;
        st16_wt(P + (size_t)(t - r + row) * PLD + P_MEMQ + h * 64 + pc * 8, *(const LAS u32x4*)(ob + row * at::KST + pc * 16)); }
    unit_done(ws, l, b * 8 + qt, F.tid);
}

DI void ret_rope_prep(int wv, int c, int n) {
    const Frame F = mkframe(wv);
    unsigned char* ws = kargs()->ws; bf16_t* P = (bf16_t*)(ws + WS_P);
    const float* rc = (const float*)(ws + WS_ROPE); const float* rsn = rc + T * 32;
    for (int it = c * NTHREADS + F.tid; it < T * 32; it += n * NTHREADS) {
        const int t = it >> 5, w = (it >> 4) & 1, h = (it >> 2) & 3, g = it & 3;
        bf16_t* pp = P + (size_t)t * PLD + (w ? P_RTK : P_RTQ) + h * 64 + g * 8;
        const u32x4 a = *(const u32x4*)pp, bq = *(const u32x4*)(pp + 32);
        const f32x4 c0 = *(const f32x4*)(rc + (size_t)t * 32 + g * 8), c1 = *(const f32x4*)(rc + (size_t)t * 32 + g * 8 + 4);
        const f32x4 s0 = *(const f32x4*)(rsn + (size_t)t * 32 + g * 8), s1 = *(const f32x4*)(rsn + (size_t)t * 32 + g * 8 + 4);
        const float sc = w ? 0.125f : 1.0f;
        float x1[8] = {bflo(a.x), bfhi(a.x), bflo(a.y), bfhi(a.y), bflo(a.z), bfhi(a.z), bflo(a.w), bfhi(a.w)};
        float x2[8] = {bflo(bq.x), bfhi(bq.x), bflo(bq.y), bfhi(bq.y), bflo(bq.z), bfhi(bq.z), bflo(bq.w), bfhi(bq.w)};
        float cc[8] = {c0.x, c0.y, c0.z, c0.w, c1.x, c1.y, c1.z, c1.w}, ss[8] = {s0.x, s0.y, s0.z, s0.w, s1.x, s1.y, s1.z, s1.w};
        float y1[8], y2[8];
#pragma unroll
        for (int j = 0; j < 8; ++j) { y1[j] = (x1[j] * cc[j] - x2[j] * ss[j]) * sc; y2[j] = (x1[j] * ss[j] + x2[j] * cc[j]) * sc; }
        *(u32x4*)pp = (u32x4){pk2(y1[0], y1[1]), pk2(y1[2], y1[3]), pk2(y1[4], y1[5]), pk2(y1[6], y1[7])};
        *(u32x4*)(pp + 32) = (u32x4){pk2(y2[0], y2[1]), pk2(y2[2], y2[3]), pk2(y2[4], y2[5]), pk2(y2[6], y2[7])};
    }
}

DI void ret_state_unit(int wv, int l, int unit) {
    const Frame F = mkframe(wv);
    unsigned char* ws = kargs()->ws; const bf16_t* P = (const bf16_t*)(ws + WS_P);
    const int bh = unit / 7, c = unit - 7 * bh, b = bh >> 2, h = bh & 3, lane = F.lane, r = lane & 31, hh = lane >> 5;
    const int s0 = b * SEQ + c * 256;
    const bf16_t* VTg = (const bf16_t*)(ws + WS_VTRT) + (size_t)h * 128 * VTLD + s0;
    const bf16_t* Kg = P + (size_t)s0 * PLD + P_RTK + h * 64;
    constexpr int RS = 528;
    LAS unsigned char* vt = F.lds; LAS unsigned char* kT = F.lds + 128 * RS;
    const float lg = log2f(1.0f - exp2f(-5.0f - (float)h));
    u32x4 vv[8], kv[4];
#pragma unroll
    for (int i = 0; i < 8; ++i) { const int id = F.tid + 512 * i, row = id >> 5, ch = id & 31; vv[i] = *(const u32x4*)(VTg + (size_t)row * VTLD + ch * 8); }
    const int key = F.tid >> 1, chb = (F.tid & 1) * 32;
#pragma unroll
    for (int i = 0; i < 4; ++i) kv[i] = *(const u32x4*)(Kg + (size_t)key * PLD + chb + 8 * i);
#pragma unroll
    for (int i = 0; i < 8; ++i) { const int id = F.tid + 512 * i, row = id >> 5, ch = id & 31; *(LAS u32x4*)(vt + row * RS + ch * 16) = vv[i]; }
    const float fk = exp2f(lg * (float)(255 - key));
#pragma unroll
    for (int i = 0; i < 4; ++i) {
        const unsigned w4[4] = {kv[i].x, kv[i].y, kv[i].z, kv[i].w};
#pragma unroll
        for (int j = 0; j < 4; ++j) { const unsigned u2 = pk2(bflo(w4[j]) * fk, bfhi(w4[j]) * fk);
            LAS unsigned char* wp = kT + (chb + 8 * i + 2 * j) * RS + key * 2;
            *(LAS unsigned short*)wp = (unsigned short)u2; *(LAS unsigned short*)(wp + RS) = (unsigned short)(u2 >> 16); }
    }
    __syncthreads();
    const int d = wv & 3, e = wv >> 2;
    f32x16 acc = {0.f, 0.f, 0.f, 0.f, 0.f, 0.f, 0.f, 0.f, 0.f, 0.f, 0.f, 0.f, 0.f, 0.f, 0.f, 0.f};
#pragma unroll
    for (int sk = 0; sk < 16; ++sk)
        acc = MFMA32(*(const LAS bf16x8*)(vt + (32 * d + r) * RS + (16 * sk + 8 * hh) * 2), *(const LAS bf16x8*)(kT + (32 * e + r) * RS + (16 * sk + 8 * hh) * 2), acc);
    unsigned* Lp = (unsigned*)rst_base(kargs(), l) + (size_t)unit * 8192 + 32 * e + r;
    __builtin_amdgcn_sched_barrier(0); asm volatile("s_nop 15\n\ts_nop 3" ::: "memory"); __builtin_amdgcn_sched_barrier(0);
#pragma unroll
    for (int i = 0; i < 16; ++i) { unsigned* sp_ = Lp + (size_t)(32 * d + crow(i, hh)) * 64; const float av_ = acc[i];
        asm volatile("global_store_dword %0, %1, off sc1" :: "v"(sp_), "v"(av_) : "memory"); }
    VM_WAIT(); lds_barrier();
    if (F.tid == 0) (void)__hip_atomic_fetch_add((unsigned*)(ws + WS_CTL) + CW_RST + 2048 * l + 64 * bh, 1u, __ATOMIC_RELAXED, __HIP_MEMORY_SCOPE_AGENT);
}

template <int MODE>
DI void attn_unit(int wv, int l, int unit) {
    constexpr int DV = MODE == 0 ? 64 : 128, NDT = DV / 32, VST2 = 144, VT_BYTES = DV * VST2, BUF = at::KT_BYTES + VT_BYTES;
    const Frame F = mkframe(wv);
    const ArgsP ap = kargs();
    unsigned char* ws = ap->ws; bf16_t* R = (bf16_t*)(ws + WS_R); bf16_t* P = (bf16_t*)(ws + WS_P);
    const int lane = F.lane, r = lane & 31, hh = lane >> 5, kap = 16 * ((r >> 2) & 1) + (r & 3) + 4 * (r >> 3);
    int b, h, qt;
    if (MODE == 0) { b = unit >> 6; h = (unit >> 3) & 7; qt = unit & 7; } else { qt = unit >> 5; b = (unit >> 2) & 7; h = unit & 3; }
    const int q0 = qt * 256, qw0 = q0 + 32 * wv, tq = qw0 + r, t = b * SEQ + tq;
    const bf16_t* Kg = MODE == 0 ? R + RB_SBK + h * 64 : P + P_RTK + h * 64; const int kld = MODE == 0 ? RBLD : PLD;
    const bf16_t* VTg = (const bf16_t*)(ws + (MODE == 0 ? WS_VTSB : WS_VTRT)) + (size_t)h * DV * VTLD + b * SEQ;
    const bf16_t* qp = MODE == 0 ? R + (size_t)t * RBLD + RB_SBQ + h * 64 : P + (size_t)t * PLD + P_RTQ + h * 64;
    bf16x8 qf[4];
#pragma unroll
    for (int ks = 0; ks < 4; ++ks) qf[ks] = *(const bf16x8*)(qp + 16 * ks + 8 * hh);
    f32x16 o[NDT];
#pragma unroll
    for (int d = 0; d < NDT; ++d) o[d] = (f32x16){0.f, 0.f, 0.f, 0.f, 0.f, 0.f, 0.f, 0.f, 0.f, 0.f, 0.f, 0.f, 0.f, 0.f, 0.f, 0.f};
    volatile LAS unsigned* flags = (volatile LAS unsigned*)(F.lds + 2 * BUF);
    const int jtop = (q0 + 255) >> 6;
    const int srow = F.tid >> 3, sch = F.tid & 7;
    u32x4 kreg, vreg[NDT / 2];
#define AT_LOAD(j) do { const int key0_ = (j) * 64; kreg = *(const u32x4*)(Kg + (size_t)(b * SEQ + key0_ + srow) * kld + sch * 8); \
        _Pragma("unroll") for (int i_ = 0; i_ < NDT / 2; ++i_) vreg[i_] = *(const u32x4*)(VTg + (size_t)(srow + 64 * i_) * VTLD + key0_ + sch * 8); } while (0)
#define AT_WRITE(pbuf) do { LAS unsigned char* kb_ = F.lds + (pbuf) * BUF; *(LAS u32x4*)(kb_ + srow * at::KST + sch * 16) = kreg; \
        _Pragma("unroll") for (int i_ = 0; i_ < NDT / 2; ++i_) *(LAS u32x4*)(kb_ + at::KT_BYTES + (srow + 64 * i_) * VST2 + sch * 16) = vreg[i_]; } while (0)
    AT_LOAD(jtop); AT_WRITE(0);
    lds_barrier();
    float carry = MODE == 0 ? 1.f : 0.f; bool done_w = false;
    const float c2 = 0.125f * 1.4426950408889634f;
    const float lg = MODE == 1 ? log2f(1.0f - exp2f(-5.0f - (float)h)) : 0.f;
    float bfac[16];
#pragma unroll
    for (int i = 0; i < 16; ++i) bfac[i] = MODE == 1 ? exp2f(-lg * (float)i) : 0.f;
    const int jlo = MODE == 1 ? (q0 >> 6) : 0;
    if (MODE == 1 && qt > 0) {
        unsigned* cnt = (unsigned*)(ws + WS_CTL) + CW_RST + 2048 * l + 64 * (b * 4 + h);
        if (wv == 0) {
            if (lane == 0) { unsigned sp = 0u; while (__hip_atomic_load(cnt, __ATOMIC_RELAXED, __HIP_MEMORY_SCOPE_AGENT) < 7u) { __builtin_amdgcn_s_sleep(2); if (++sp > (1u << 20)) break; } }
            __builtin_amdgcn_fence(__ATOMIC_ACQUIRE, "agent");
            asm volatile("s_waitcnt vmcnt(0)" ::: "memory");
        }
        lds_barrier();
        const float* L0 = (const float*)rst_base(ap, l) + (size_t)((b * 4 + h) * 7) * 8192;
        const float g256 = exp2f(lg * 256.0f);
        LAS unsigned char* stI = F.lds + 65536;
#pragma unroll
        for (int k4 = 0; k4 < 4; ++k4) {
            const int e4 = (F.tid + 512 * k4) * 4;
            f32x4 a = {0.f, 0.f, 0.f, 0.f}; float wg = 1.0f;
            for (int c = qt - 1; c >= 0; --c) { const f32x4 x = *(const f32x4*)(L0 + (size_t)c * 8192 + e4);
                a += x * wg; wg *= g256; }
            *(LAS u32x2*)(stI + (e4 >> 6) * 144 + (e4 & 63) * 2) = (u32x2){pk2(a[0], a[1]), pk2(a[2], a[3])};
        }
        lds_barrier();
#pragma unroll
        for (int d = 0; d < NDT; ++d)
#pragma unroll
            for (int ks = 0; ks < 4; ++ks) o[d] = MFMA32(*(const LAS bf16x8*)(stI + (32 * d + r) * 144 + (16 * ks + 8 * hh) * 2), qf[ks], o[d]);
        const float fq = exp2f(lg * (float)(tq - q0 + 1));
#pragma unroll
        for (int d = 0; d < NDT; ++d) o[d] = o[d] * fq;
    }
    for (int j = jtop, it = 0; ; --j, ++it) {
        const int pbuf = it & 1;
        if (j > jlo) AT_LOAD(j - 1);
        LAS unsigned char* kt = F.lds + pbuf * BUF; LAS unsigned char* vt = kt + at::KT_BYTES;
        const int key0 = j * 64;
        if (!done_w) {
#pragma unroll
            for (int sti = 0; sti < 2; ++sti) {
                const int st = 1 - sti, ks0 = key0 + 32 * st;
                if (ks0 <= qw0 + 31 - (MODE == 0 ? 1 : 0)) {
                    const bool full = (ks0 + 31 < qw0);
                    f32x16 z = {0.f, 0.f, 0.f, 0.f, 0.f, 0.f, 0.f, 0.f, 0.f, 0.f, 0.f, 0.f, 0.f, 0.f, 0.f, 0.f};
#pragma unroll
                    for (int ks = 0; ks < 4; ++ks) z = MFMA32(at::kfrag(kt, 32 * st + kap, ks, hh), qf[ks], z);
                    float w[16];
                    const int kb = ks0 + 16 * hh;
                    if (MODE == 0) {
                        float sg[16], sn[16];
#pragma unroll
                        for (int i = 0; i < 16; i += 2) {
                            const f32x2 a2 = (f32x2){z[i], z[i + 1]} * (f32x2){-c2, -c2};
                            const f32x2 d2 = (f32x2){__builtin_amdgcn_exp2f(a2.x), __builtin_amdgcn_exp2f(a2.y)} + (f32x2){1.f, 1.f};
                            const f32x2 r2 = (f32x2){__builtin_amdgcn_rcpf(d2.x), __builtin_amdgcn_rcpf(d2.y)};
                            const f32x2 n2 = (f32x2){1.f, 1.f} - r2;
                            sg[i] = r2.x; sg[i + 1] = r2.y; sn[i] = n2.x; sn[i + 1] = n2.y;
                        }
                        if (!full) {
#pragma unroll
                            for (int i = 0; i < 16; ++i) { const bool m = (kb + i) < tq; sn[i] = m ? sn[i] : 1.f; sg[i] = m ? sg[i] : 0.f; }
                        }
                        float suf[16];
                        suf[15] = 1.f;
#pragma unroll
                        for (int i = 14; i >= 0; --i) suf[i] = suf[i + 1] * sn[i + 1];
                        const float tot = suf[0] * sn[0], totp = shx(tot, 32, lane);
                        const float base = carry * (hh == 0 ? totp : 1.f);
                        carry *= tot * totp;
#pragma unroll
                        for (int i = 0; i < 16; i += 2) { const f32x2 w2 = (f32x2){sg[i], sg[i + 1]} * ((f32x2){suf[i], suf[i + 1]} * (f32x2){base, base}); w[i] = w2.x; w[i + 1] = w2.y; }
                    } else {
                        const float af = __builtin_amdgcn_exp2f(lg * (float)(tq - kb));
                        if (full) {
#pragma unroll
                            for (int i = 0; i < 16; ++i) w[i] = z[i] * (af * bfac[i]);
                        } else {
#pragma unroll
                            for (int i = 0; i < 16; ++i) w[i] = (kb + i <= tq) ? z[i] * (af * bfac[i]) : 0.f;
                        }
                    }
#pragma unroll
                    for (int s2 = 0; s2 < 2; ++s2) {
                        const bf16x8 pf = pack8(w[8 * s2], w[8 * s2 + 1], w[8 * s2 + 2], w[8 * s2 + 3], w[8 * s2 + 4], w[8 * s2 + 5], w[8 * s2 + 6], w[8 * s2 + 7]);
#pragma unroll
                        for (int d = 0; d < NDT; ++d) o[d] = MFMA32(*(const LAS bf16x8*)(vt + (32 * d + r) * VST2 + (32 * st + 16 * hh + 8 * s2) * 2), pf, o[d]);
                    }
                }
            }
            if (MODE == 0) done_w = __all(carry < 1.1754944e-38f);
        }
        if (j > jlo) AT_WRITE(pbuf ^ 1);
        if (MODE == 0 && F.lane == 0) flags[(it & 1) * 8 + wv] = done_w ? 1u : 0u;
        lds_barrier();
        if (j == jlo) break;
        if (MODE == 0) { unsigned all = 1u;
#pragma unroll
            for (int w8 = 0; w8 < 8; ++w8) all &= flags[(it & 1) * 8 + w8];
            if (all) break; }
    }
#undef AT_LOAD
#undef AT_WRITE
    constexpr int OST = DV * 2 + 16, PPR = DV / 8;
    LAS unsigned char* ob = F.lds + wv * (32 * OST);
    if (MODE == 0) {
        bf16_t* op = R + (size_t)t * RBLD + RB_SBQ + h * 64; const bf16_t* zp = R + (size_t)t * RBLD + RB_SBZ + h * 64;
#pragma unroll
        for (int d = 0; d < NDT; ++d)
#pragma unroll
            for (int g = 0; g < 4; ++g) { const int c = 32 * d + 8 * g + 4 * hh; const u32x2 zz = *(const u32x2*)(zp + c);
                *(LAS u32x2*)(ob + r * OST + c * 2) = (u32x2){pk2(o[d][4 * g] * siluf_(bflo(zz.x)), o[d][4 * g + 1] * siluf_(bfhi(zz.x))), pk2(o[d][4 * g + 2] * siluf_(bflo(zz.y)), o[d][4 * g + 3] * siluf_(bfhi(zz.y)))}; }
#pragma unroll
        for (int k = 0; k < 32 * PPR / 64; ++k) { const int q = k * 64 + lane, row = q / PPR, pc = q % PPR;
            st16_wt(op + (ptrdiff_t)(row - r) * RBLD + pc * 8, *(const LAS u32x4*)(ob + row * OST + pc * 16)); }
    } else {
        float s1 = 0.f;
#pragma unroll
        for (int d = 0; d < NDT; ++d)
#pragma unroll
            for (int i = 0; i < 16; ++i) s1 += o[d][i];
        s1 += shx(s1, 32, lane);
        const float mu = s1 * (1.f / 128.f); float s2 = 0.f;
#pragma unroll
        for (int d = 0; d < NDT; ++d)
#pragma unroll
            for (int i = 0; i < 16; ++i) { const float dl = o[d][i] - mu; s2 += dl * dl; }
        s2 += shx(s2, 32, lane);
        const float rs = rsqrtf(s2 * (1.f / 128.f) + EPS);
        bf16_t* zp = R + (size_t)t * RBLD + RB_RTZ + h * 128; const float* gp = ap->ret_norm_g + (size_t)l * 512 + h * 128;
#pragma unroll
        for (int d = 0; d < NDT; ++d)
#pragma unroll
            for (int g = 0; g < 4; ++g) { const int c = 32 * d + 8 * g + 4 * hh; const u32x2 zz = *(const u32x2*)(zp + c); const f32x4 gg = *(const f32x4*)(gp + c);
                *(LAS u32x2*)(ob + r * OST + c * 2) = (u32x2){pk2((o[d][4 * g] - mu) * rs * gg.x * siluf_(bflo(zz.x)), (o[d][4 * g + 1] - mu) * rs * gg.y * siluf_(bfhi(zz.x))),
                                                             pk2((o[d][4 * g + 2] - mu) * rs * gg.z * siluf_(bflo(zz.y)), (o[d][4 * g + 3] - mu) * rs * gg.w * siluf_(bfhi(zz.y)))}; }
#pragma unroll
        for (int k = 0; k < 32 * PPR / 64; ++k) { const int q = k * 64 + lane, row = q / PPR, pc = q % PPR;
            st16_wt(zp + (ptrdiff_t)(row - r) * RBLD + pc * 8, *(const LAS u32x4*)(ob + row * OST + pc * 16)); }
    }
    unit_done(ws, l, b * 8 + qt, F.tid);
}

namespace dn {
constexpr int HC_BYTES = 73728, OFF_W = 0, OFF_QG = 16384, OFF_KD = 32768, OFF_AI = 49152, OFF_U = 57344;
constexpr int QST = 272, TST = 144;
constexpr int GRP_BYTES = 71680, Q_OFF = 0, K_OFF = 17408, KT_OFF = 34816, VT_OFF = 53248, VEC_OFF = 143360, VEC_BYTES = 2048;
}

DI void dn_prep(int wv, int l, int pair) {
    const Frame F = mkframe(wv);
    const ArgsP ap = kargs();
    unsigned char* ws = ap->ws;
    const int lane = F.lane, r = lane & 31, hh = lane >> 5, grp = wv >> 2, gw = wv & 3, gt = F.tid & 255;
    const int hc = pair * 2 + grp, h = hc & 3, bn = hc >> 2, b = bn >> 5, n = bn & 31, t0 = b * SEQ + n * 64;
    LAS unsigned char* gb = F.lds + grp * dn::GRP_BYTES;
    LAS unsigned char* qimg = gb + dn::Q_OFF; LAS unsigned char* kimg = gb + dn::K_OFF; LAS unsigned char* ktimg = gb + dn::KT_OFF; LAS unsigned char* vtimg = gb + dn::VT_OFF;
    LAS float* vec = (LAS float*)(F.lds + dn::VEC_OFF + grp * dn::VEC_BYTES);
    LAS float* gcv = vec; LAS float* btv = vec + 64; LAS float* f1v = vec + 128; LAS float* f2v = vec + 192; LAS float* egv = vec + 256;
    unsigned char* blk = ws + WS_DNI + (size_t)hc * dn::HC_BYTES;
    const bf16_t* RA = (const bf16_t*)(ws + WS_R); const float* cw = ap->dn_conv_w + (size_t)l * 4 * 1536; const float* AB = (const float*)(ws + WS_AB);
#ifdef PROBE_PREP
    unsigned long long tp0_ = __builtin_amdgcn_s_memrealtime();
#endif
    {
        const int g8 = gt & 15, ch = g8 * 8;
        float abA[4], abB[4];
#pragma unroll
        for (int k = 0; k < 4; ++k) { const int t = t0 + (gt >> 4) + 16 * k; abA[k] = AB[(size_t)t * 8 + h]; abB[k] = AB[(size_t)t * 8 + 4 + h]; }
        const float dtb = ap->dn_dt_bias[l * 4 + h], nalog = -__expf(ap->dn_a_log[l * 4 + h]);
        u32x4 xs[2][2][4]; f32x4 wj[4][2];
#define DNP_LOADX(st_, set_) do { const int col_ = ((st_) >> 1) * 512 + h * 128 + ch; \
        _Pragma("unroll") for (int kk_ = 0; kk_ < 2; ++kk_) _Pragma("unroll") for (int j_ = 0; j_ < 4; ++j_) { const int m_ = (gt >> 4) + 16 * (2 * ((st_) & 1) + kk_); \
            xs[set_][kk_][j_] = (n * 64 + m_ - 3 + j_ >= 0) ? *(const u32x4*)(RA + (size_t)(t0 + m_ - 3 + j_) * RALD + col_) : (u32x4){0u, 0u, 0u, 0u}; } } while (0)
        DNP_LOADX(0, 0);
#pragma unroll
        for (int st = 0; st < 6; ++st) {
            const int part = st >> 1, col = part * 512 + h * 128 + ch;
            if ((st & 1) == 0) {
#pragma unroll
                for (int j = 0; j < 4; ++j) { wj[j][0] = *(const f32x4*)(cw + j * 1536 + col); wj[j][1] = *(const f32x4*)(cw + j * 1536 + col + 4); } }
            if (st < 5) DNP_LOADX(st + 1, (st + 1) & 1);
#pragma unroll
            for (int kk = 0; kk < 2; ++kk) {
                const int m = (gt >> 4) + 16 * (2 * (st & 1) + kk), t = t0 + m;
                float a[8] = {0.f, 0.f, 0.f, 0.f, 0.f, 0.f, 0.f, 0.f};
#pragma unroll
                for (int j = 0; j < 4; ++j) { const u32x4 x = xs[st & 1][kk][j];
                    a[0] += wj[j][0].x * bflo(x.x); a[1] += wj[j][0].y * bfhi(x.x); a[2] += wj[j][0].z * bflo(x.y); a[3] += wj[j][0].w * bfhi(x.y);
                    a[4] += wj[j][1].x * bflo(x.z); a[5] += wj[j][1].y * bfhi(x.z); a[6] += wj[j][1].z * bflo(x.w); a[7] += wj[j][1].w * bfhi(x.w);
                }
                float ssq = 0.f;
#pragma unroll
                for (int i = 0; i < 8; ++i) { a[i] = siluf_(a[i]); ssq += a[i] * a[i]; }
                if (part < 2) {
                    ssq = sum16(ssq);
                    const float rn = rsqrtf(ssq + EPS);
#pragma unroll
                    for (int i = 0; i < 8; ++i) a[i] *= rn;
                } else {
                    const float beta = sigmoidf_(abB[2 * (st & 1) + kk]);
#pragma unroll
                    for (int i = 0; i < 8; ++i) a[i] *= beta;
                }
                const u32x4 pk = (u32x4){pk2(a[0], a[1]), pk2(a[2], a[3]), pk2(a[4], a[5]), pk2(a[6], a[7])};
                if (part == 0) {
                    *(LAS u32x4*)(qimg + m * dn::QST + ch * 2) = pk;
                    if (g8 == 0) { const float xa = abA[2 * (st & 1) + kk] + dtb; const float sp = xa > 20.f ? xa : log1pf(__expf(xa));
                        gcv[m] = nalog * sp; btv[m] = sigmoidf_(abB[2 * (st & 1) + kk]); }
                } else {
                    if (part == 1) *(LAS u32x4*)(kimg + m * dn::QST + ch * 2) = pk;
                    LAS unsigned char* timg = (part == 1 ? ktimg : vtimg) + (((m >> 3) ^ (g8 & 7)) * 16) + (m & 7) * 2;
                    *(LAS unsigned short*)(timg + (ch + 0) * dn::TST) = (unsigned short)pk.x; *(LAS unsigned short*)(timg + (ch + 1) * dn::TST) = (unsigned short)(pk.x >> 16);
                    *(LAS unsigned short*)(timg + (ch + 2) * dn::TST) = (unsigned short)pk.y; *(LAS unsigned short*)(timg + (ch + 3) * dn::TST) = (unsigned short)(pk.y >> 16);
                    *(LAS unsigned short*)(timg + (ch + 4) * dn::TST) = (unsigned short)pk.z; *(LAS unsigned short*)(timg + (ch + 5) * dn::TST) = (unsigned short)(pk.z >> 16);
                    *(LAS unsigned short*)(timg + (ch + 6) * dn::TST) = (unsigned short)pk.w; *(LAS unsigned short*)(timg + (ch + 7) * dn::TST) = (unsigned short)(pk.w >> 16);
                }
            }
        }
#undef DNP_LOADX
    }
    lds_barrier();
#ifdef PROBE_PREP
    if (PROBE_PREP == 1) { const unsigned long long t1_ = __builtin_amdgcn_s_memrealtime(); const unsigned long long d_ = t1_ - tp0_; while (__builtin_amdgcn_s_memrealtime() - t1_ < d_) __builtin_amdgcn_s_sleep(2); }
    tp0_ = __builtin_amdgcn_s_memrealtime();
#endif
    if (gw == 0) {
        float gc = gcv[lane];
#pragma unroll
        for (int off = 1; off < 64; off <<= 1) { const float o = shx(gc, 0, lane - off < 0 ? lane : lane - off) ; gc += (lane >= off) ? o : 0.f; }
        const float glast = shx(gc, 0, 63);
        const float eg = __expf(gc);
        gcv[lane] = gc; f1v[lane] = btv[lane] * eg; f2v[lane] = __expf(glast - gc); egv[lane] = eg * 0.08838834764831845f;
        if (lane == 0) ((float*)(ws + WS_GB))[hc] = __expf(glast);
    }
    lds_barrier();
    f32x16 Lt = {0.f, 0.f, 0.f, 0.f, 0.f, 0.f, 0.f, 0.f, 0.f, 0.f, 0.f, 0.f, 0.f, 0.f, 0.f, 0.f};
    if (gw < 3) {
        {
            const int ct = gw == 0 ? 0 : 1, mt = gw == 2 ? 1 : 0;
            f32x16 acc = {0.f, 0.f, 0.f, 0.f, 0.f, 0.f, 0.f, 0.f, 0.f, 0.f, 0.f, 0.f, 0.f, 0.f, 0.f, 0.f};
#pragma unroll
            for (int ks = 0; ks < 8; ++ks) acc = MFMA32(*(const LAS bf16x8*)(kimg + (32 * ct + r) * dn::QST + ks * 32 + hh * 16), *(const LAS bf16x8*)(kimg + (32 * mt + r) * dn::QST + ks * 32 + hh * 16), acc);
            const int m = 32 * mt + r; const float gm = gcv[m];
#pragma unroll
            for (int i = 0; i < 16; ++i) { const int c = 32 * ct + crow(i, hh); Lt[i] = (m < c) ? acc[i] * btv[c] * __expf(gcv[c] - gm) : 0.f; }
        }
        {
            const int mt = gw == 2 ? 1 : 0, ct = gw == 0 ? 0 : 1;
            f32x16 acc = {0.f, 0.f, 0.f, 0.f, 0.f, 0.f, 0.f, 0.f, 0.f, 0.f, 0.f, 0.f, 0.f, 0.f, 0.f, 0.f};
#pragma unroll
            for (int ks = 0; ks < 8; ++ks) acc = MFMA32(*(const LAS bf16x8*)(kimg + (32 * mt + r) * dn::QST + ks * 32 + hh * 16), *(const LAS bf16x8*)(qimg + (32 * ct + r) * dn::QST + ks * 32 + hh * 16), acc);
            const int c = 32 * ct + r; const float gcc = gcv[c]; float v[16];
#pragma unroll
            for (int i = 0; i < 16; ++i) { const int m = 32 * mt + crow(i, hh); v[i] = (m <= c) ? acc[i] * __expf(gcc - gcv[m]) * 0.08838834764831845f : 0.f; }
#pragma unroll
            for (int s2 = 0; s2 < 2; ++s2) *(bf16x8*)(blk + dn::OFF_AI + ((ct * 2 + mt) * 2 + s2) * 1024 + lane * 16) = pack8(v[8 * s2], v[8 * s2 + 1], v[8 * s2 + 2], v[8 * s2 + 3], v[8 * s2 + 4], v[8 * s2 + 5], v[8 * s2 + 6], v[8 * s2 + 7]);
        }
    } else {
#pragma unroll 1
        for (int f = 0; f < 16; ++f) { const int ct = f >> 3, tau = (f >> 1) & 3, s2 = f & 1, c = 32 * ct + r; const float e = egv[c];
            const LAS unsigned char* pp = qimg + c * dn::QST + (32 * tau + 16 * s2 + 4 * hh) * 2; const u32x2 lo = *(const LAS u32x2*)pp, hi = *(const LAS u32x2*)(pp + 16);
            *(bf16x8*)(blk + dn::OFF_QG + f * 1024 + lane * 16) = pack8(bflo(lo.x) * e, bfhi(lo.x) * e, bflo(lo.y) * e, bfhi(lo.y) * e, bflo(hi.x) * e, bfhi(hi.x) * e, bflo(hi.y) * e, bfhi(hi.y) * e); }
#pragma unroll 1
        for (int f = 0; f < 16; ++f) { const int tau = f >> 2, m0 = 32 * ((f >> 1) & 1) + 16 * (f & 1) + 4 * hh;
            const int sw = (4 * tau + (r >> 3)) & 7; const LAS unsigned char* rowp = ktimg + (32 * tau + r) * dn::TST + (m0 & 7) * 2;
            const u32x2 lo = *(const LAS u32x2*)(rowp + (((m0 >> 3) ^ sw) * 16)), hi = *(const LAS u32x2*)(rowp + ((((m0 >> 3) + 1) ^ sw) * 16));
            const f32x4 fa = *(const LAS f32x4*)(f2v + m0), fb = *(const LAS f32x4*)(f2v + m0 + 8);
            *(bf16x8*)(blk + dn::OFF_KD + f * 1024 + lane * 16) = pack8(bflo(lo.x) * fa.x, bfhi(lo.x) * fa.y, bflo(lo.y) * fa.z, bfhi(lo.y) * fa.w, bflo(hi.x) * fb.x, bfhi(hi.x) * fb.y, bflo(hi.y) * fb.z, bfhi(hi.y) * fb.w); }
    }
    lds_barrier();
    LAS float* Lm = (LAS float*)qimg;
    if (gw < 3) { const int ct = gw == 0 ? 0 : 1, mt = gw == 2 ? 1 : 0;
#pragma unroll
        for (int i = 0; i < 16; ++i) Lm[(32 * ct + crow(i, hh)) * 64 + 32 * mt + r] = Lt[i]; }
    lds_barrier();
#ifdef PROBE_PREP
    if (PROBE_PREP == 2) { const unsigned long long t1_ = __builtin_amdgcn_s_memrealtime(); const unsigned long long d_ = t1_ - tp0_; while (__builtin_amdgcn_s_memrealtime() - t1_ < d_) __builtin_amdgcn_s_sleep(2); }
    tp0_ = __builtin_amdgcn_s_memrealtime();
#endif
    if (gw == 0) {
        const LAS float* Lb = Lm + (32 * hh) * 64 + 32 * hh;
        const int jc = lane & 31;
        float Tc[32];
#pragma unroll
        for (int i = 0; i < 32; ++i) {
            float a0 = (i == jc) ? 1.f : 0.f, a1 = 0.f, a2 = 0.f, a3 = 0.f;
#pragma unroll
            for (int k4 = 0; k4 < (i + 3) / 4; ++k4) { const f32x4 lv = *(const LAS f32x4*)(Lb + i * 64 + 4 * k4);
                if (4 * k4 + 0 < i) a0 -= lv.x * Tc[4 * k4 + 0]; if (4 * k4 + 1 < i) a1 -= lv.y * Tc[4 * k4 + 1];
                if (4 * k4 + 2 < i) a2 -= lv.z * Tc[4 * k4 + 2]; if (4 * k4 + 3 < i) a3 -= lv.w * Tc[4 * k4 + 3]; }
            Tc[i] = (a0 + a1) + (a2 + a3);
        }
        LDS_WAIT(); asm volatile("" ::: "memory");
        LAS unsigned char* timg = kimg; LAS unsigned char* t00t = kimg + 64 * dn::TST;
#pragma unroll
        for (int i = 0; i < 32; ++i) *(LAS unsigned short*)(timg + (32 * hh + i) * dn::TST + (32 * hh + jc) * 2) = (unsigned short)f2bf(Tc[i]);
        if (hh == 0) {
#pragma unroll
            for (int q = 0; q < 4; ++q) { *(LAS u32x4*)(t00t + jc * 80 + 16 * q) = (u32x4){pk2(Tc[8 * q], Tc[8 * q + 1]), pk2(Tc[8 * q + 2], Tc[8 * q + 3]), pk2(Tc[8 * q + 4], Tc[8 * q + 5]), pk2(Tc[8 * q + 6], Tc[8 * q + 7])};
                *(LAS u32x4*)(timg + jc * dn::TST + 64 + 16 * q) = (u32x4){0u, 0u, 0u, 0u}; }
        }
        LDS_WAIT(); asm volatile("" ::: "memory");
        f32x16 X = {0.f, 0.f, 0.f, 0.f, 0.f, 0.f, 0.f, 0.f, 0.f, 0.f, 0.f, 0.f, 0.f, 0.f, 0.f, 0.f};
#pragma unroll
        for (int s2 = 0; s2 < 2; ++s2) { const f32x4 la = *(const LAS f32x4*)(Lm + (32 + r) * 64 + 16 * s2 + 8 * hh), lb = *(const LAS f32x4*)(Lm + (32 + r) * 64 + 16 * s2 + 8 * hh + 4);
            X = MFMA32(pack8(la.x, la.y, la.z, la.w, lb.x, lb.y, lb.z, lb.w), *(const LAS bf16x8*)(t00t + r * 80 + (16 * s2 + 8 * hh) * 2), X); }
        f32x16 Y = {0.f, 0.f, 0.f, 0.f, 0.f, 0.f, 0.f, 0.f, 0.f, 0.f, 0.f, 0.f, 0.f, 0.f, 0.f, 0.f};
#pragma unroll
        for (int s2 = 0; s2 < 2; ++s2) { const LAS unsigned char* pp = timg + (32 + r) * dn::TST + (32 + 16 * s2 + 4 * hh) * 2; const u32x2 lo = *(const LAS u32x2*)pp, hi = *(const LAS u32x2*)(pp + 16);
            u32x4 af; af.x = lo.x; af.y = lo.y; af.z = hi.x; af.w = hi.y;
            Y = MFMA32(__builtin_bit_cast(bf16x8, af), pack8m(X[8 * s2], X[8 * s2 + 1], X[8 * s2 + 2], X[8 * s2 + 3], X[8 * s2 + 4], X[8 * s2 + 5], X[8 * s2 + 6], X[8 * s2 + 7]), Y); }
#pragma unroll
        for (int i = 0; i < 16; ++i) *(LAS unsigned short*)(timg + (32 + crow(i, hh)) * dn::TST + r * 2) = (unsigned short)f2bf(-Y[i]);
    }
    lds_barrier();
#ifdef PROBE_PREP
    if (PROBE_PREP == 3) { const unsigned long long t1_ = __builtin_amdgcn_s_memrealtime(); const unsigned long long d_ = t1_ - tp0_; while (__builtin_amdgcn_s_memrealtime() - t1_ < d_) __builtin_amdgcn_s_sleep(2); }
    tp0_ = __builtin_amdgcn_s_memrealtime();
#endif
    {
        LAS unsigned char* timg = kimg;
        bf16x8 afr[4];
#pragma unroll
        for (int s4 = 0; s4 < 4; ++s4) { const u32x4 x = *(const LAS u32x4*)(ktimg + (32 * gw + r) * dn::TST + (((2 * s4 + hh) ^ ((4 * gw + (r >> 3)) & 7)) * 16));
            const f32x4 fa = *(const LAS f32x4*)(f1v + 16 * s4 + 8 * hh), fb = *(const LAS f32x4*)(f1v + 16 * s4 + 8 * hh + 4);
            afr[s4] = pack8(-bflo(x.x) * fa.x, -bfhi(x.x) * fa.y, -bflo(x.y) * fa.z, -bfhi(x.y) * fa.w, -bflo(x.z) * fb.x, -bfhi(x.z) * fb.y, -bflo(x.w) * fb.z, -bfhi(x.w) * fb.w); }
#pragma unroll
        for (int ct = 0; ct < 2; ++ct) {
            f32x16 acc = {0.f, 0.f, 0.f, 0.f, 0.f, 0.f, 0.f, 0.f, 0.f, 0.f, 0.f, 0.f, 0.f, 0.f, 0.f, 0.f};
#pragma unroll
            for (int s4 = 0; s4 < 4; ++s4) acc = MFMA32(afr[s4], *(const LAS bf16x8*)(timg + (32 * ct + r) * dn::TST + s4 * 32 + hh * 16), acc);
#pragma unroll
            for (int s2 = 0; s2 < 2; ++s2) *(bf16x8*)(blk + dn::OFF_W + ((ct * 4 + gw) * 2 + s2) * 1024 + lane * 16) = pack8m(acc[8 * s2], acc[8 * s2 + 1], acc[8 * s2 + 2], acc[8 * s2 + 3], acc[8 * s2 + 4], acc[8 * s2 + 5], acc[8 * s2 + 6], acc[8 * s2 + 7]);
        }
#pragma unroll
        for (int ct = 0; ct < 2; ++ct) {
            f32x16 acc = {0.f, 0.f, 0.f, 0.f, 0.f, 0.f, 0.f, 0.f, 0.f, 0.f, 0.f, 0.f, 0.f, 0.f, 0.f, 0.f};
#pragma unroll
            for (int s4 = 0; s4 < 4; ++s4) acc = MFMA32(*(const LAS bf16x8*)(timg + (32 * ct + r) * dn::TST + s4 * 32 + hh * 16), *(const LAS bf16x8*)(vtimg + (32 * gw + r) * dn::TST + (((2 * s4 + hh) ^ ((4 * gw + (r >> 3)) & 7)) * 16)), acc);
#pragma unroll
            for (int s2 = 0; s2 < 2; ++s2) *(bf16x8*)(blk + dn::OFF_U + ((ct * 4 + gw) * 2 + s2) * 1024 + lane * 16) = pack8m(acc[8 * s2], acc[8 * s2 + 1], acc[8 * s2 + 2], acc[8 * s2 + 3], acc[8 * s2 + 4], acc[8 * s2 + 5], acc[8 * s2 + 6], acc[8 * s2 + 7]);
        }
    }
    lds_barrier();
}

DI void dn_scan(int wv, int l, int bh) {
    const Frame F = mkframe(wv);
    const ArgsP ap = kargs();
    unsigned char* ws = ap->ws; bf16_t* P = (bf16_t*)(ws + WS_P);
    const int lane = F.lane, hh = lane >> 5, b = bh >> 2, h = bh & 3, w4 = wv & 3;
    LAS float* part = (LAS float*)(F.lds + 2 * dn::HC_BYTES);
    LAS float* gnl = part + 512;
    LAS float* decs = gnl + 128;
    if (F.tid < 128) gnl[F.tid] = ap->dn_norm_g[l * 128 + F.tid];
    if (F.tid < 32) decs[F.tid] = ((const float*)(ws + WS_GB))[(size_t)(b * 32 + F.tid) * 4 + h];
    const size_t hc_stride = 4 * (size_t)dn::HC_BYTES;
    const unsigned char* blk0 = ws + WS_DNI + ((size_t)(b * 32) * 4 + h) * dn::HC_BYTES;
#define DN_PIECE(src_, pbuf, pc_) __builtin_amdgcn_global_load_lds((const unsigned*)((src_) + (pc_) * 1024 + lane * 16), (LAS unsigned*)(F.lds + (pbuf) * dn::HC_BYTES + (pc_) * 1024), 16, 0, 0)
#define DN_LOAD(nn, pbuf) do { const unsigned char* src_ = blk0 + (size_t)(nn) * hc_stride; \
        if (wv < 4) { _Pragma("unroll") for (int i_ = 0; i_ < 9; ++i_) DN_PIECE(src_, pbuf, wv * 9 + i_); } \
        else { _Pragma("unroll") for (int i_ = 0; i_ < 5; ++i_) DN_PIECE(src_, pbuf, 36 + 5 * w4 + i_); \
               DN_PIECE(src_, pbuf, 56 + 2 * w4); DN_PIECE(src_, pbuf, 57 + 2 * w4); DN_PIECE(src_, pbuf, 64 + 2 * w4); DN_PIECE(src_, pbuf, 65 + 2 * w4); } } while (0)
    DN_LOAD(0, 0);
    f32x16 S[4];
#pragma unroll
    for (int i = 0; i < 4; ++i) S[i] = (f32x16){0.f, 0.f, 0.f, 0.f, 0.f, 0.f, 0.f, 0.f, 0.f, 0.f, 0.f, 0.f, 0.f, 0.f, 0.f, 0.f};
    u32x4 heldO[4], zO[4];
#pragma unroll
    for (int i = 0; i < 4; ++i) { heldO[i] = (u32x4){0u, 0u, 0u, 0u}; zO[i] = heldO[i]; }
    VM_WAIT(); __syncthreads();
    if (wv < 4) {
    for (int k = 0; k < 34; ++k) {
        const int pbuf = k & 1;
#ifdef PROBE_SCANC
        const unsigned long long tc0_ = __builtin_amdgcn_s_memrealtime();
#endif
        LAS unsigned char* buf = F.lds + pbuf * dn::HC_BYTES;
        {
            if (k + 1 < 32) DN_LOAD(k + 1, pbuf ^ 1);
            if (k < 32) {
                const float dec = decs[k];
                f32x16 vn[2], o[2];
#pragma unroll
                for (int ct = 0; ct < 2; ++ct) {
                    o[ct] = (f32x16){0.f, 0.f, 0.f, 0.f, 0.f, 0.f, 0.f, 0.f, 0.f, 0.f, 0.f, 0.f, 0.f, 0.f, 0.f, 0.f};
#pragma unroll
                    for (int s2 = 0; s2 < 2; ++s2) { const u32x4 x = *(const LAS u32x4*)(buf + dn::OFF_U + ((ct * 4 + wv) * 2 + s2) * 1024 + lane * 16);
                        vn[ct][8 * s2] = bflo(x.x); vn[ct][8 * s2 + 1] = bfhi(x.x); vn[ct][8 * s2 + 2] = bflo(x.y); vn[ct][8 * s2 + 3] = bfhi(x.y);
                        vn[ct][8 * s2 + 4] = bflo(x.z); vn[ct][8 * s2 + 5] = bfhi(x.z); vn[ct][8 * s2 + 6] = bflo(x.w); vn[ct][8 * s2 + 7] = bfhi(x.w); }
                }
#define DN_F(off) (*(const LAS bf16x8*)(buf + (off) + lane * 16))
#define DN_WQ(ct, st) ((((ct) * 4 + ((st) >> 1)) * 2 + ((st) & 1)) * 1024)
                bf16x8 fa[4], fb[6];
                fa[0] = DN_F(dn::OFF_W + DN_WQ(0, 0)); fa[1] = DN_F(dn::OFF_QG + DN_WQ(0, 0)); fa[2] = DN_F(dn::OFF_W + DN_WQ(1, 0)); fa[3] = DN_F(dn::OFF_QG + DN_WQ(1, 0));
#pragma unroll
                for (int st = 0; st < 8; ++st) {
                    const int tau = st >> 1, s2 = st & 1;
                    if (st < 7) { fb[0] = DN_F(dn::OFF_W + DN_WQ(0, st + 1)); fb[1] = DN_F(dn::OFF_QG + DN_WQ(0, st + 1)); fb[2] = DN_F(dn::OFF_W + DN_WQ(1, st + 1)); fb[3] = DN_F(dn::OFF_QG + DN_WQ(1, st + 1)); }
                    else { fb[0] = DN_F(dn::OFF_AI + 0 * 1024); fb[1] = DN_F(dn::OFF_AI + 4 * 1024); fb[2] = DN_F(dn::OFF_KD + 0 * 1024); fb[3] = DN_F(dn::OFF_KD + 4 * 1024); fb[4] = DN_F(dn::OFF_KD + 8 * 1024); fb[5] = DN_F(dn::OFF_KD + 12 * 1024); }
                    __builtin_amdgcn_sched_barrier(0);
                    const bf16x8 sf = pack8m(S[tau][8 * s2], S[tau][8 * s2 + 1], S[tau][8 * s2 + 2], S[tau][8 * s2 + 3], S[tau][8 * s2 + 4], S[tau][8 * s2 + 5], S[tau][8 * s2 + 6], S[tau][8 * s2 + 7]);
                    vn[0] = MFMA32(fa[0], sf, vn[0]); o[0] = MFMA32(fa[1], sf, o[0]); vn[1] = MFMA32(fa[2], sf, vn[1]); o[1] = MFMA32(fa[3], sf, o[1]);
                    __builtin_amdgcn_sched_barrier(0);
                    if (st < 7) { fa[0] = fb[0]; fa[1] = fb[1]; fa[2] = fb[2]; fa[3] = fb[3]; }
                }
#pragma unroll
                for (int tau = 0; tau < 4; ++tau) S[tau] = S[tau] * dec;
                bf16x8 fc[6];
#pragma unroll
                for (int g = 0; g < 4; ++g) {
                    const int cm = g >> 1, s2 = g & 1;
                    if (g < 3) { const int cm1 = (g + 1) >> 1, s21 = (g + 1) & 1;
                        fc[0] = DN_F(dn::OFF_AI + ((cm1 * 2 + cm1) * 2 + s21) * 1024); fc[1] = DN_F(dn::OFF_AI + ((1 * 2 + cm1) * 2 + s21) * 1024);
#pragma unroll
                        for (int tau = 0; tau < 4; ++tau) fc[2 + tau] = DN_F(dn::OFF_KD + ((tau * 2 + cm1) * 2 + s21) * 1024); }
                    __builtin_amdgcn_sched_barrier(0);
                    const bf16x8 vf = pack8m(vn[cm][8 * s2], vn[cm][8 * s2 + 1], vn[cm][8 * s2 + 2], vn[cm][8 * s2 + 3], vn[cm][8 * s2 + 4], vn[cm][8 * s2 + 5], vn[cm][8 * s2 + 6], vn[cm][8 * s2 + 7]);
                    if (cm == 0) o[0] = MFMA32(fb[0], vf, o[0]);
                    o[1] = MFMA32(fb[1], vf, o[1]);
#pragma unroll
                    for (int tau = 0; tau < 4; ++tau) S[tau] = MFMA32(fb[2 + tau], vf, S[tau]);
                    __builtin_amdgcn_sched_barrier(0);
                    if (g < 3) {
#pragma unroll
                        for (int q = 0; q < 6; ++q) fb[q] = fc[q]; }
                }
#undef DN_F
#undef DN_WQ
                LDS_WAIT(); __builtin_amdgcn_sched_barrier(0); asm volatile("s_nop 15\n\ts_nop 3" ::: "memory"); __builtin_amdgcn_sched_barrier(0);
#pragma unroll
                for (int ct = 0; ct < 2; ++ct)
#pragma unroll
                    for (int i = 0; i < 16; i += 2) { const int c = 32 * ct + crow(i, hh), q = c >> 4; const unsigned u2 = pk2(o[ct][i], o[ct][i + 1]);
                        LAS unsigned char* wp = buf + dn::OFF_U + (((q >> 1) * 4 + wv) * 2 + (q & 1)) * 1024 + (c & 15) * 64 + (lane & 31) * 2;
                        *(LAS unsigned short*)wp = (unsigned short)u2; *(LAS unsigned short*)(wp + 64) = (unsigned short)(u2 >> 16); }
            }
        }
#ifdef PROBE_SCANC
        { const unsigned long long tc1_ = __builtin_amdgcn_s_memrealtime(); const unsigned long long d_ = tc1_ - tc0_; while (__builtin_amdgcn_s_memrealtime() - tc1_ < d_) __builtin_amdgcn_s_sleep(2); }
#endif
        asm volatile("s_waitcnt vmcnt(0)" ::: "memory");
        lds_barrier();
    }
    } else {
    u32x4 heldN[4], zN[4];
#pragma unroll
    for (int i = 0; i < 4; ++i) { heldN[i] = (u32x4){0u, 0u, 0u, 0u}; zN[i] = heldN[i]; }
    unsigned td0 = 0u, td1 = 0u, td2 = 0u;
    for (int k = 0; k < 34; ++k) {
        const int pbuf = k & 1;
#ifdef PROBE_SCANH
        const unsigned long long th0_ = __builtin_amdgcn_s_memrealtime();
#endif
        const bool rows = (k >= 1 && k <= 32);
        if (rows) {
            const int nn = k - 1; LAS unsigned char* pb = F.lds + (nn & 1) * dn::HC_BYTES;
            const int q = lane >> 4; const LAS unsigned char* rp = pb + dn::OFF_U + (((q >> 1) * 4 + w4) * 2 + (q & 1)) * 1024 + (lane & 15) * 64;
            float ssq = 0.f;
#pragma unroll
            for (int i = 0; i < 4; ++i) { const u32x4 hv = *(const LAS u32x4*)(rp + 16 * i); heldN[i] = hv;
                ssq += bflo(hv.x) * bflo(hv.x) + bfhi(hv.x) * bfhi(hv.x) + bflo(hv.y) * bflo(hv.y) + bfhi(hv.y) * bfhi(hv.y)
                     + bflo(hv.z) * bflo(hv.z) + bfhi(hv.z) * bfhi(hv.z) + bflo(hv.w) * bflo(hv.w) + bfhi(hv.w) * bfhi(hv.w); }
            part[((nn & 1) * 64 + lane) * 4 + w4] = ssq;
        }
        LDS_WAIT(); asm volatile("" ::: "memory");
        if (k + 1 < 32) DN_LOAD(k + 1, pbuf ^ 1);
        __builtin_amdgcn_sched_barrier(0);
        if (rows) { const bf16_t* zp = P + (size_t)(b * SEQ + (k - 1) * 64 + lane) * PLD + P_DNZ + h * 128 + 32 * w4;
#pragma unroll
            for (int i = 0; i < 4; ++i) zN[i] = *(const u32x4*)(zp + 8 * i); }
        __builtin_amdgcn_sched_barrier(0);
#ifdef SCAN_TOUCH_ON
        if (k + 2 < 32) {
            const unsigned char* tb = blk0 + (size_t)(k + 2) * hc_stride + (size_t)(w4 * 144) * 128;
            const unsigned char* a0 = tb + lane * 128; const unsigned char* a1 = tb + (64 + lane) * 128; const unsigned char* a2 = tb + (128 + (lane & 15)) * 128;
            asm volatile("; SCAN_TOUCH\n\tglobal_load_dword %0, %3, off\n\tglobal_load_dword %1, %4, off\n\tglobal_load_dword %2, %5, off" : "+v"(td0), "+v"(td1), "+v"(td2) : "v"(a0), "v"(a1), "v"(a2) : "memory");
        }
        __builtin_amdgcn_sched_barrier(0);
#endif
        u32x4 wo[4];
        if (k >= 2) {
            const int nn = k - 2; const f32x4 p4 = *(const LAS f32x4*)(part + ((nn & 1) * 64 + lane) * 4);
            const float rs = rsqrtf(((p4.x + p4.y) + (p4.z + p4.w)) * (1.f / 128.f) + EPS);
#pragma unroll
            for (int q = 0; q < 4; ++q) { const u32x4 zz = zO[q], hv = heldO[q]; const f32x4 ga = *(const LAS f32x4*)(gnl + 32 * w4 + 8 * q), gb = *(const LAS f32x4*)(gnl + 32 * w4 + 8 * q + 4);
                wo[q].x = pk2(bflo(hv.x) * rs * ga.x * siluf_(bflo(zz.x)), bfhi(hv.x) * rs * ga.y * siluf_(bfhi(zz.x)));
                wo[q].y = pk2(bflo(hv.y) * rs * ga.z * siluf_(bflo(zz.y)), bfhi(hv.y) * rs * ga.w * siluf_(bfhi(zz.y)));
                wo[q].z = pk2(bflo(hv.z) * rs * gb.x * siluf_(bflo(zz.z)), bfhi(hv.z) * rs * gb.y * siluf_(bfhi(zz.z)));
                wo[q].w = pk2(bflo(hv.w) * rs * gb.z * siluf_(bflo(zz.w)), bfhi(hv.w) * rs * gb.w * siluf_(bfhi(zz.w))); }
        }
#ifdef SCAN_TOUCH_ON
        if (k + 2 < 32) asm volatile("; SCAN_E\n\ts_waitcnt vmcnt(3)" ::: "memory"); else
#endif
        asm volatile("s_waitcnt vmcnt(0)" ::: "memory");
        if (k >= 2) { bf16_t* zp = P + (size_t)(b * SEQ + (k - 2) * 64 + lane) * PLD + P_DNZ + h * 128 + 32 * w4;
#pragma unroll
            for (int q = 0; q < 4; ++q) *(u32x4*)(zp + 8 * q) = wo[q]; }
#pragma unroll
        for (int i = 0; i < 4; ++i) { heldO[i] = heldN[i]; zO[i] = zN[i]; }
#ifdef PROBE_SCANH
        { const unsigned long long th1_ = __builtin_amdgcn_s_memrealtime(); const unsigned long long d_ = th1_ - th0_; while (__builtin_amdgcn_s_memrealtime() - th1_ < d_) __builtin_amdgcn_s_sleep(2); }
#endif
        lds_barrier();
    }
    asm volatile("s_waitcnt vmcnt(0)" : "+v"(td0), "+v"(td1), "+v"(td2) :: "memory");
    }
#undef DN_LOAD
#undef DN_PIECE
}

DI void final_norm(int wv) {
    const Frame F = mkframe(wv);
    const ArgsP ap = kargs();
    const float* ss = (const float*)(ap->ws + WS_SS);
    for (int m = F.gw; m < T; m += F.NGW) {
        const f32x4 s = *(const f32x4*)(ss + (size_t)m * 4); const float rs = rsqrtf(((s.x + s.y) + (s.z + s.w)) * (1.f / D) + EPS);
        f32x4* xr = (f32x4*)(ap->out + (size_t)m * D) + F.lane; const f32x4* gr = (const f32x4*)ap->final_norm_g + F.lane;
#pragma unroll
        for (int j = 0; j < 4; ++j) { const f32x4 v = xr[64 * j], g = gr[64 * j]; xr[64 * j] = v * rs * g; }
    }
}

__global__ void __launch_bounds__(NTHREADS, 2) mk_fwd(Args args) {
    extern __shared__ __attribute__((aligned(16))) unsigned char lds_raw[];
    LAS unsigned char* const lds = (LAS unsigned char*)lds_raw;
    volatile LAS unsigned* MISC = (volatile LAS unsigned*)(lds + MISC_OFF);
    const int wv = __builtin_amdgcn_readfirstlane((int)threadIdx.x >> 6);
    { const int t0 = opaque_tid(wv); for (int u = t0; u < (LDS_BYTES - LDSCTL_OFF) / 4; u += NTHREADS) ((LAS unsigned*)(lds + LDSCTL_OFF))[u] = 0u; }
    __syncthreads();
    const int G = gridDim.x;
    XcdBarrier bar; bar.bar = (unsigned*)(args.ws + WS_CTL) + CW_BAR + args.li * XCD_BAR_WORDS; bar.x = 0; bar.st = nullptr;
    if (args.ph_hi - args.ph_lo > 1) bar = xcd_barrier_post(bar.bar, MISC + 8, wv);
#define IN(k) (kargs()->ph_lo <= (k) && (k) < kargs()->ph_hi)
#ifdef PROBE_SUB
    unsigned long long ts_prev_ = 0;
#define SUBSEAM(bit) do { xcd_barrier(bar, wv); { const unsigned long long t1_ = __builtin_amdgcn_s_memrealtime(); \
        if ((PROBE_SUB >> (bit)) & 1u) { const unsigned long long d_ = t1_ - ts_prev_; while (__builtin_amdgcn_s_memrealtime() - t1_ < d_) __builtin_amdgcn_s_sleep(8); } \
        ts_prev_ = __builtin_amdgcn_s_memrealtime(); } } while (0)
#define SUBSTART() do { ts_prev_ = __builtin_amdgcn_s_memrealtime(); } while (0)
#else
#define SUBSEAM(bit) do { } while (0)
#define SUBSTART() do { } while (0)
#endif
#ifdef PROBE_ECHO
    unsigned long long t_prev_ = __builtin_amdgcn_s_memrealtime();
#define SEAM(k) do { if (IN(k) && IN((k) + 1)) xcd_barrier(bar, wv); { const unsigned long long t1_ = __builtin_amdgcn_s_memrealtime(); \
        if ((PROBE_ECHO >> (k)) & 1u) { const unsigned long long d_ = t1_ - t_prev_; while (__builtin_amdgcn_s_memrealtime() - t1_ < d_) __builtin_amdgcn_s_sleep(8); } \
        t_prev_ = __builtin_amdgcn_s_memrealtime(); } } while (0)
#else
#define SEAM(k) do { if (IN(k) && IN((k) + 1)) xcd_barrier(bar, wv); } while (0)
#endif
#define MK_EPI(E) gm::Epi E; E.ws = kargs()->ws; E.xin = nullptr; E.xout = nullptr; E.b_gate = nullptr; E.gnext = nullptr; E.gfinal = nullptr; E.spare = (LAS float*)(lds + SPARE_OFF);

#if !defined(ONLY_PH) || ONLY_PH == 0
    if (IN(0)) { p0_prologue(wv); }
#endif
    SEAM(0);

    for (int l0 = 0; l0 < DEPTH; ++l0) {
        int l = l0; asm volatile("" : "+s"(l));
        const int pb = 1 + 6 * l;
#if !defined(ONLY_PH) || ONLY_PH == 1
        if (IN(pb)) { MK_EPI(E); SchedP1 S; S.ord.init(64, 12, G, opaque_bid()); S.ws = kargs()->ws; S.l = l; S.half = 0; S.c = opaque_bid(); S.with_kvm = false;
            gm::gemm_phase<AUX_P1>(lds, wv, S, E);
#ifdef PROBE_DUP_GEMM
            xcd_barrier(bar, wv); gm::gemm_phase<AUX_P1>(lds, wv, S, E);
#endif
            }
#endif
        SEAM(pb);
#if !defined(ONLY_PH) || ONLY_PH == 2
        if (IN(pb + 1)) {
            SUBSTART();
            SUBSEAM(0);
            for (int pair = opaque_bid(); pair < 512; pair += G) dn_prep(wv, l, pair);
            SUBSEAM(1);
            if (l > 0) { const Frame Fm = mkframe(wv); memn_rows(Fm, kargs(), l); }
 }
#endif
        SEAM(pb + 1);
#if !defined(ONLY_PH) || ONLY_PH == 3
        if (IN(pb + 2)) {
            if (opaque_bid() < 32 && G > 64) dn_scan(wv, l, opaque_bid());
            else { const bool split = G > 64; MK_EPI(E); SchedP1 S; S.ord.init(64, 12, split ? G - 32 : G, split ? opaque_bid() - 32 : opaque_bid()); S.ws = kargs()->ws; S.l = l; S.half = 1; S.c = opaque_bid(); S.with_kvm = true;
                gm::gemm_phase<AUX_P1>(lds, wv, S, E);
#ifdef PROBE_DUP_GEMM
                xcd_barrier(bar, wv); gm::gemm_phase<AUX_P1>(lds, wv, S, E);
#endif
                { const int cp = opaque_bid() - 32; const Frame Fc = mkframe(wv);
                  const int nsh = cp >= 112 ? 3 : 1, sh0 = cp >= 112 ? 3 * (cp - 112) : 336 + cp;
                  for (int q = 0; q < nsh; ++q) { const int first = (sh0 + q) * NWAVES + wv, stride = 448 * NWAVES;
                      if (l == 0) convert_weights(Fc, kargs(), 0, first, stride, 2);
                      if (l + 1 < DEPTH) convert_weights(Fc, kargs(), l + 1, first, stride, 0); } }
            }
            if (G <= 64) { for (int bh = opaque_bid(); bh < 32; bh += G) dn_scan(wv, l, bh); }
        }
#endif
        SEAM(pb + 2);
#if !defined(ONLY_PH) || ONLY_PH == 4
        if (IN(pb + 3)) {
            const int wg = opaque_bid();

            unsigned* head = (unsigned*)(kargs()->ws + WS_CTL) + CW_QUEUE + 64 * l;
            volatile LAS unsigned* qslot = (volatile LAS unsigned*)(lds + MISC_OFF + 64);
            for (;;) {
#ifdef PROBE_FETCH
                const unsigned long long tf0_ = __builtin_amdgcn_s_memrealtime();
#endif
                if (opaque_tid(wv) == 0) qslot[0] = __hip_atomic_fetch_add(head, 1u, __ATOMIC_RELAXED, __HIP_MEMORY_SCOPE_AGENT);
                __syncthreads();
                const int unit = (int)qslot[0];
                __syncthreads();
#ifdef PROBE_FETCH
                { const unsigned long long tf1_ = __builtin_amdgcn_s_memrealtime(); const unsigned long long d_ = tf1_ - tf0_; while (__builtin_amdgcn_s_memrealtime() - tf1_ < d_) __builtin_amdgcn_s_sleep(2); }
#endif
                if (unit >= 1248) break;
#ifdef PROBE_UNIT
                const unsigned long long tu0_ = __builtin_amdgcn_s_memrealtime();
#endif
                if (unit < 224) ret_state_unit(wv, l, unit); else if (unit < 480) attn_unit<1>(wv, l, unit - 224); else if (unit < 992) attn_unit<0>(wv, l, unit - 480); else mem_unit(wv, l, unit - 992);
#ifdef PROBE_UNIT
                { const unsigned long long tu1_ = __builtin_amdgcn_s_memrealtime(); if (PROBE_UNIT >= 2 ? (tu1_ - tu0_ > (unsigned long long)PROBE_UNIT * 100ull) : ((unit < 256) == (PROBE_UNIT == 1))) { const unsigned long long d_ = tu1_ - tu0_; while (__builtin_amdgcn_s_memrealtime() - tu1_ < d_) __builtin_amdgcn_s_sleep(8); } }
#endif
            }
        }
#endif
#ifdef KEEP_SEAM3
        SEAM(pb + 3);
#endif
#if !defined(ONLY_PH) || ONLY_PH == 5
        if (IN(pb + 4)) { MK_EPI(E); gm::TileOrder ord; ord.init(64, 4, G, opaque_bid()); SchedP3 S; S.ok = ord.tile(0, S.pm, S.pn); S.l = l; S.rot = (opaque_bid() >> 3) & 3; S.ws = kargs()->ws; E.b_gate = kargs()->b_gate;
            gm::gemm_phase<AUX_P3>(lds, wv, S, E);
#ifdef PROBE_DUP_GEMM
            xcd_barrier(bar, wv); gm::gemm_phase<AUX_P3>(lds, wv, S, E);
#endif
            }
#endif
        SEAM(pb + 4);
#if !defined(ONLY_PH) || ONLY_PH == 6
        if (IN(pb + 5)) { MK_EPI(E); gm::TileOrder ord; ord.init(64, 4, G, opaque_bid()); SchedP4 S; S.ok = ord.tile(0, S.pm, S.pn); S.l = l; S.ws = kargs()->ws;
            E.gnext = (l + 1 < DEPTH) ? kargs()->norm_g + (size_t)(l + 1) * D : nullptr;
            E.gfinal = (l + 1 < DEPTH || G != 256) ? nullptr : kargs()->final_norm_g;
            E.xout = kargs()->out; E.xin = (l == 0) ? kargs()->x : (const float*)kargs()->out;
            gm::gemm_phase<AUX_P4>(lds, wv, S, E); }
#endif
        if (!(l + 1 == DEPTH && G == 256)) SEAM(pb + 5);
    }
#if !defined(ONLY_PH) || ONLY_PH == 13
    if (IN(13) && G != 256) final_norm(wv);
#endif
#undef IN
#undef SEAM
#undef MK_EPI
}

extern "C" void kernel_launch(void* const* d_in, const int* in_sizes, int n_in, void* d_out, int out_size, void* d_ws, size_t ws_size, hipStream_t stream) {
    static int grid = 0;
    if (grid == 0) {
        if (n_in != 19 || out_size != T * D || ws_size < WS_END) { fprintf(stderr, "kernel_launch: unexpected problem (n_in %d, out %d, ws %zu)\n", n_in, out_size, ws_size); grid = -1; return; }
        int dev = 0, cus = 0, per_cu = 0;
        if (hipGetDevice(&dev) != hipSuccess || hipDeviceGetAttribute(&cus, hipDeviceAttributeMultiprocessorCount, dev) != hipSuccess) { grid = -1; return; }
        if (hipFuncSetAttribute((const void*)mk_fwd, hipFuncAttributeMaxDynamicSharedMemorySize, LDS_BYTES) != hipSuccess) { fprintf(stderr, "kernel_launch: hipFuncSetAttribute failed\n"); grid = -1; return; }
        if (hipOccupancyMaxActiveBlocksPerMultiprocessor(&per_cu, (const void*)mk_fwd, NTHREADS, LDS_BYTES) != hipSuccess || per_cu < 1)
            fprintf(stderr, "kernel_launch: occupancy query reports %d workgroups per CU\n", per_cu);
        (void)hipGetLastError();
        grid = cus;
    }
    if (grid < 0) return;
    if (hipMemsetAsync((char*)d_ws + WS_CTL, 0, CTL_ZERO_BYTES, stream) != hipSuccess) return;
    Args a{};
    a.x = (const float*)d_in[0]; a.mem = (const float*)d_in[1]; a.positions = (const int*)d_in[2]; a.norm_g = (const float*)d_in[3]; a.mem_norm_g = (const float*)d_in[4];
    a.w_in = (const float*)d_in[5]; a.b_gate = (const float*)d_in[6]; a.dn_conv_w = (const float*)d_in[7]; a.dn_a_log = (const float*)d_in[8]; a.dn_dt_bias = (const float*)d_in[9];
    a.dn_norm_g = (const float*)d_in[10]; a.ret_norm_g = (const float*)d_in[11]; a.w_mem_kv = (const float*)d_in[12]; a.w_br_sb = (const float*)d_in[13]; a.w_br_dn = (const float*)d_in[14];
    a.w_br_ret = (const float*)d_in[15]; a.w_br_mem = (const float*)d_in[16]; a.w_out = (const float*)d_in[17]; a.final_norm_g = (const float*)d_in[18];
    a.out = (float*)d_out; a.ws = (unsigned char*)d_ws;
#if MK_N_LAUNCHES == 1
    a.ph_lo = 0; a.ph_hi = NPHASE; a.li = 0;
    hipLaunchKernelGGL(mk_fwd, dim3(grid), dim3(NTHREADS), LDS_BYTES, stream, a);
#else
    for (int p = 0; p < NPHASE; ++p) { a.ph_lo = p; a.ph_hi = p + 1; a.li = 0;
        hipLaunchKernelGGL(mk_fwd, dim3(grid), dim3(NTHREADS), LDS_BYTES, stream, a); }
#endif
}
```

```cpp
#include <hip/hip_runtime.h>
#include <cstdio>
#include <cstdint>
#include <cmath>

#define LAS __attribute__((address_space(3)))
#define GAS __attribute__((address_space(1)))
#define DI __device__ __forceinline__
typedef unsigned short bf16_t;
typedef short bf16x8 __attribute__((ext_vector_type(8)));
typedef float f32x4 __attribute__((ext_vector_type(4)));
typedef unsigned u32x4 __attribute__((ext_vector_type(4)));
typedef unsigned u32x2 __attribute__((ext_vector_type(2)));
typedef float f32x2 __attribute__((ext_vector_type(2)));

#ifndef AUX_P1
#define AUX_P1 0
#endif
#ifndef AUX_P3
#define AUX_P3 0
#endif
#ifndef AUX_P4
#define AUX_P4 0
#endif
#ifdef EPI_NT
#define EPI_LD(p) __builtin_nontemporal_load(p)
#define EPI_ST(p, v) __builtin_nontemporal_store((v), (p))
#else
#define EPI_LD(p) (*(p))
#define EPI_ST(p, v) (*(p) = (v))
#endif
#ifndef FRESH_WAITS
#define FRESH_WAITS 0
#endif
#ifndef SS_PREFETCH
#define SS_PREFETCH 1
#endif
#ifndef EARLY_INV
#define EARLY_INV 1
#endif
#ifndef MK_N_LAUNCHES
#define MK_N_LAUNCHES 1
#endif

constexpr int BATCH = 8, SEQ = 2048, D = 1024, T = BATCH * SEQ, DEPTH = 2, MEMLEN = 256;
constexpr int IN_COLS = 9992;
constexpr float EPS = 1e-6f;
constexpr int NPHASE = 14;

constexpr size_t MiB = 1u << 20;
constexpr size_t WS_CTL = 0, CTL_ZERO_BYTES = 1 * MiB;
constexpr size_t WS_WINA = 1 * MiB;
constexpr size_t WS_WINB = 13 * MiB;
constexpr size_t WS_WG = 25 * MiB;
constexpr size_t WS_WBR = 41 * MiB;
constexpr size_t WS_WOUT = 49 * MiB;
constexpr size_t WS_WKV = 53 * MiB;
constexpr size_t WS_XN = 55 * MiB;
constexpr size_t WS_P = 87 * MiB;
constexpr size_t WS_R = 127 * MiB;
constexpr int VTLD = T + 64;
constexpr size_t WS_VTSB = WS_R + 64 * MiB, WS_VTRT = WS_VTSB + (size_t)512 * VTLD * 2;
constexpr size_t WS_SCR = 224 * MiB;
constexpr size_t WS_MRG = 240 * MiB;
constexpr size_t WS_DNI = 224 * MiB;
constexpr size_t WS_KVM = 296 * MiB;
constexpr size_t WS_ROPE = 300 * MiB;
constexpr size_t WS_AB = 304 * MiB;
constexpr size_t WS_GB = WS_AB + 512 * 1024;
constexpr size_t WS_SS = 305 * MiB;
constexpr size_t WS_END = 310 * MiB;
constexpr size_t WS_MEMN = 306 * MiB;
constexpr int PLD = 1280, RALD = 1536, RBLD = 2048, SCRLD = 1024, MRGLD = 1024;
constexpr int P_DNZ = 0, P_MEMQ = 512, P_RTQ = 768, P_RTK = 1024;
constexpr int RB_SBQ = 0, RB_SBK = 512, RB_SBZ = 1024, RB_RTZ = 1536;
constexpr int CW_BAR = 4096;
constexpr int CW_PANEL = 16384;
constexpr int CW_QUEUE = 64;
constexpr int CW_RST = 49152;
constexpr int CW_READY = 32768;

constexpr int RING_BYTES = 155648;
constexpr int LDSCTL_OFF = RING_BYTES, MISC_OFF = LDSCTL_OFF + 320, SPARE_OFF = LDSCTL_OFF + 1024;
constexpr int LDS_BYTES = 163840;
constexpr int NWAVES = 8, NTHREADS = 512;

DI unsigned f2bf(float f) { unsigned u = __builtin_bit_cast(unsigned, f); return (u + 0x7fffu + ((u >> 16) & 1u)) >> 16; }
DI unsigned pk2(float lo, float hi) { unsigned r; asm("s_nop 0\n\tv_cvt_pk_bf16_f32 %0, %1, %2" : "=v"(r) : "v"(lo), "v"(hi)); return r; }
DI float bf2f(unsigned short h) { return __builtin_bit_cast(float, (unsigned)h << 16); }
DI float bflo(unsigned w) { return __builtin_bit_cast(float, w << 16); }
DI float bfhi(unsigned w) { return __builtin_bit_cast(float, w & 0xffff0000u); }
DI float shx(float v, int m, int lane) { return __builtin_bit_cast(float, __builtin_amdgcn_ds_bpermute((lane ^ m) << 2, __builtin_bit_cast(int, v))); }
DI float wave_sum(float v, int lane) {
#pragma unroll
    for (int o = 1; o < 64; o <<= 1) v += shx(v, o, lane);
    return v;
}
DI float sum16(float v) {
    v += __builtin_bit_cast(float, __builtin_amdgcn_update_dpp(0, __builtin_bit_cast(int, v), 0xB1, 0xf, 0xf, true));
    v += __builtin_bit_cast(float, __builtin_amdgcn_update_dpp(0, __builtin_bit_cast(int, v), 0x4E, 0xf, 0xf, true));
    v += __builtin_bit_cast(float, __builtin_amdgcn_update_dpp(0, __builtin_bit_cast(int, v), 0x141, 0xf, 0xf, true));
    v += __builtin_bit_cast(float, __builtin_amdgcn_update_dpp(0, __builtin_bit_cast(int, v), 0x140, 0xf, 0xf, true));
    return v;
}
DI float sigmoidf_(float x) { return __builtin_amdgcn_rcpf(1.f + __builtin_amdgcn_exp2f(x * -1.4426950408889634f)); }
DI float siluf_(float x) { return x * __builtin_amdgcn_rcpf(1.f + __builtin_amdgcn_exp2f(x * -1.4426950408889634f)); }
DI int opaque_bid() { int b = blockIdx.x; asm volatile("" : "+s"(b)); return b; }
DI int opaque_tid(int wv) { int lane; asm volatile("v_mbcnt_lo_u32_b32 %0, -1, 0\n\tv_mbcnt_hi_u32_b32 %0, -1, %0" : "=v"(lane)); return wv * 64 + lane; }
#define LDS_WAIT() asm volatile("s_waitcnt lgkmcnt(0)" ::: "memory")
DI void lds_barrier() { asm volatile("s_waitcnt lgkmcnt(0)" ::: "memory"); __builtin_amdgcn_s_barrier(); asm volatile("" ::: "memory"); }
#define VM_WAIT() asm volatile("s_waitcnt vmcnt(0)" ::: "memory")
DI unsigned shxu(unsigned v, int m, int lane) { return (unsigned)__builtin_amdgcn_ds_bpermute((lane ^ m) << 2, (int)v); }
DI void st16_wt(void* p, u32x4 v) { asm volatile("global_store_dwordx4 %0, %1, off sc1\n\ts_nop 1" :: "v"(p), "v"(v) : "memory"); }
DI void unit_done(unsigned char* ws, int l, int pm, int tid) {
    VM_WAIT(); lds_barrier();
    if (tid == 0) (void)__hip_atomic_fetch_add((unsigned*)(ws + WS_CTL) + CW_READY + 4096 * l + 64 * pm, 1u, __ATOMIC_RELAXED, __HIP_MEMORY_SCOPE_AGENT);
}

#define XB_TMO      128
#define XB_XCNT(j)  (256  + 64 * (j))
#define XB_XSUB(j)  (1280 + 64 * (j))
#define XB_XGEN(j)  (2304 + 64 * (j))
#define XB_TOP      3328
#define XB_TOPGEN   3392
#define XCD_BAR_WORDS 3456
#define XB_SPIN_CAP (1u << 18)
DI unsigned xb_ld(unsigned* p)              { return __hip_atomic_load(p, __ATOMIC_RELAXED, __HIP_MEMORY_SCOPE_AGENT); }
DI unsigned xb_add(unsigned* p, unsigned v) { return __hip_atomic_fetch_add(p, v, __ATOMIC_RELAXED, __HIP_MEMORY_SCOPE_AGENT); }
DI unsigned xb_xcc_id() { return (unsigned)__builtin_amdgcn_s_getreg((3 << 11) | 20) & 0xFu; }
#define XB_SPIN(cond, bar) do { unsigned _sp = 0; while (cond) { __builtin_amdgcn_s_sleep(1); \
    if ((++_sp & 255u) == 0u) { if (xb_ld(&(bar)[XB_TMO])) break; if (_sp > XB_SPIN_CAP) { atomicAdd(&(bar)[XB_TMO], 1u); break; } } } } while (0)
struct XcdBarrier { unsigned* bar; unsigned x; volatile LAS unsigned* st; };
DI XcdBarrier xcd_barrier_post(unsigned* bar, volatile LAS unsigned* st, int wv) {
    XcdBarrier b; b.bar = bar; b.x = xb_xcc_id(); b.st = st;
    if (opaque_tid(wv) == 0) (void)xb_add(&bar[XB_XCNT(b.x)], 1u);
    return b;
}
DI void xcd_barrier_complete(unsigned* bar, unsigned x, unsigned& nloc, unsigned& nx) {
    const unsigned G = gridDim.x * gridDim.y * gridDim.z;
    unsigned sum, cnt, mine, sp = 0u;
    for (;;) {
        sum = 0u; cnt = 0u; mine = 0u;
#pragma unroll
        for (unsigned j = 0; j < 16; ++j) { const unsigned c = xb_ld(&bar[XB_XCNT(j)]); sum += c; cnt += (c > 0u) ? 1u : 0u; mine = (j == x) ? c : mine; }
        if (sum == G) break;
        __builtin_amdgcn_s_sleep(1);
        if ((++sp & 255u) == 0u) { if (xb_ld(&bar[XB_TMO])) break; if (sp > XB_SPIN_CAP) { atomicAdd(&bar[XB_TMO], 1u); break; } }
    }
    nloc = mine > 0u ? mine : 1u; nx = cnt > 0u ? cnt : 1u;
}
DI void xcd_barrier(const XcdBarrier& b, int wv) {
    asm volatile("s_waitcnt vmcnt(0)" ::: "memory");
    __syncthreads();
    if (opaque_tid(wv) == 0) {
        unsigned* bar = b.bar;
        __builtin_amdgcn_s_waitcnt(0);
#if EARLY_INV
        __builtin_amdgcn_fence(__ATOMIC_ACQUIRE, "agent");
#endif
        unsigned nloc = b.st[0], nx = b.st[1];
        if (nloc == 0u) { xcd_barrier_complete(bar, b.x, nloc, nx); b.st[0] = nloc; b.st[1] = nx; }
        const unsigned old = xb_add(&bar[XB_XSUB(b.x)], 1u);
        const unsigned gen = old / nloc;
        if (old + 1u == (gen + 1u) * nloc) {
            __builtin_amdgcn_fence(__ATOMIC_RELEASE, "agent");
            asm volatile("s_waitcnt vmcnt(0)" ::: "memory");
            const unsigned og = xb_add(&bar[XB_TOP], 1u);
            const unsigned tg = og / nx;
            if (og + 1u == (tg + 1u) * nx) xb_add(&bar[XB_TOPGEN], 1u);
            else XB_SPIN(xb_ld(&bar[XB_TOPGEN]) == tg, bar);
#if !EARLY_INV
            __builtin_amdgcn_fence(__ATOMIC_ACQUIRE, "agent");
#endif
            xb_add(&bar[XB_XGEN(b.x)], 1u);
            asm volatile("s_waitcnt vmcnt(0)" ::: "memory");
        } else {
            XB_SPIN(xb_ld(&bar[XB_XGEN(b.x)]) == gen, bar);
#if !EARLY_INV
            __builtin_amdgcn_fence(__ATOMIC_ACQUIRE, "agent");
#endif
            asm volatile("s_waitcnt vmcnt(0)" ::: "memory");
        }
    }
    __syncthreads();
}

namespace gm {
constexpr int BM = 256, BK = 64, HALF = 128, HTB = HALF * BK * 2, STAGE_BYTES = 8 * HTB;
DI int lds_byte(int r, int c) { const int st = (r >> 4) * 2 + (c >> 5), rr = r & 15, cc = c & 31, ob = rr * 64 + cc * 2; return st * 1024 + (ob ^ (((ob >> 9) & 1) << 5)); }
DI void stage_rc(int b, int& R, int& C) { const int st = b / 1024, sb = b % 1024, swz = sb ^ (((sb >> 9) & 1) << 5); R = (st >> 1) * 16 + swz / 64; C = (st & 1) * 32 + (swz % 64) / 2; }
DI int perm32(int rho) { const int n = rho >> 4, i = rho & 15; return 8 * (i >> 2) + 4 * n + (i & 3); }

enum Kind { K_STORE = 0, K_AB = 1, K_GATE = 2, K_BRANCH = 3, K_OUT = 4, K_STORE_T = 5 };
struct Unit {
    const bf16_t* A; const bf16_t* B;
    int lda, ldb, K, pm, pn, kind, sub, l;
};
struct TileOrder {
    int nM, nN, nwg, G, c;
    DI void init(int nM_, int nN_, int G_, int c_) { nM = nM_; nN = nN_; nwg = nM * nN; G = G_; c = c_; }
    DI bool tile(int i, int& pm, int& pn) const {
        const long L = (long)i * G + c; if (L >= nwg) return false;
        int wgid = (int)L; { const int q = nwg / 8, r = nwg % 8, xcd = wgid % 8, off = wgid / 8; wgid = (xcd < r ? xcd * (q + 1) : r * (q + 1) + (xcd - r) * q) + off; }
        const int WGM = 8, nig = WGM * nN, gid = wgid / nig, fm = gid * WGM, gsz = (nM - fm) < WGM ? (nM - fm) : WGM;
        pm = __builtin_amdgcn_readfirstlane(fm + ((wgid % nig) % gsz)); pn = __builtin_amdgcn_readfirstlane((wgid % nig) / gsz); return true;
    }
};

template <int AUX, class Sched, class Epi>
DI void gemm_phase(LAS unsigned char* lds, int wv, const Sched& S, const Epi& E) {
    const int tid = opaque_tid(wv), wid = __builtin_amdgcn_readfirstlane(tid >> 6), lane = tid & 63, wr = wid >> 2, wc = wid & 3, fr = lane & 15, fq = lane >> 4;
    int R0_, C0_; stage_rc(tid * 16, R0_, C0_);
    const unsigned R0 = 2u * (unsigned)R0_, C2 = 2u * (unsigned)C0_;
    const unsigned RbP = 2u * (unsigned)((R0_ & ~31) + perm32(R0_ & 31));
    const unsigned ldsw = (unsigned)wid * 1024u;
    const int aoff = lds_byte(wr * 64 + fr, fq * 8), boff = lds_byte(wc * 32 + fr, fq * 8);
#define GM_SA(b, h) (((b) * 2 + (h)) * HTB)
#define GM_SB(b, h) ((4 + (b) * 2 + (h)) * HTB)
#define GM_STAGE(bufoff, gbase, ld, R2) do { const unsigned _v = (unsigned)(R2) * (unsigned)(ld) + C2; \
        __builtin_amdgcn_global_load_lds((const unsigned*)((const char*)(gbase) + _v), (LAS unsigned*)(lds + (bufoff) + ldsw), 16, 0, AUX); \
        __builtin_amdgcn_global_load_lds((const unsigned*)((const char*)(gbase) + (_v + (unsigned)(ld) * 128u)), (LAS unsigned*)(lds + (bufoff) + ldsw + 8192), 16, 0, AUX); } while (0)
#define GM_LDA(dst, b, h) do { _Pragma("unroll") for (int m = 0; m < 4; ++m) _Pragma("unroll") for (int k = 0; k < 2; ++k) dst[m][k] = *(const LAS bf16x8*)(lds + GM_SA(b, h) + aoff + m * 2048 + k * 1024); } while (0)
#define GM_LDB(dst, b, h) do { _Pragma("unroll") for (int n = 0; n < 2; ++n) _Pragma("unroll") for (int k = 0; k < 2; ++k) dst[n][k] = *(const LAS bf16x8*)(lds + GM_SB(b, h) + boff + n * 2048 + k * 1024); } while (0)
#define GM_MMA(ai, bj, At, Bt) do { __builtin_amdgcn_s_setprio(1); _Pragma("unroll") for (int m = 0; m < 4; ++m) _Pragma("unroll") for (int n = 0; n < 2; ++n) _Pragma("unroll") for (int k = 0; k < 2; ++k) \
        acc[ai][bj][m][n] = __builtin_amdgcn_mfma_f32_16x16x32_bf16(Bt[n][k], At[m][k], acc[ai][bj][m][n], 0, 0, 0); __builtin_amdgcn_s_setprio(0); } while (0)
#define GM_WAIT_V(n) asm volatile("s_waitcnt vmcnt(" #n ")" ::: "memory")
#define GM_WAIT_L(n) asm volatile("s_waitcnt lgkmcnt(" #n ")" ::: "memory")
#define GM_BAR __builtin_amdgcn_s_barrier()
#define GM_SCHED __builtin_amdgcn_sched_barrier(0)
    Unit cur, nxt; int ui = 0;
    if (!S.next(0, cur)) return;
    S.a_ready(cur, wid, lane);
    f32x4 acc[2][2][4][2];
#pragma unroll
    for (int a = 0; a < 2; ++a)
#pragma unroll
        for (int b = 0; b < 2; ++b)
#pragma unroll
            for (int m = 0; m < 4; ++m)
#pragma unroll
                for (int n = 0; n < 2; ++n) acc[a][b][m][n] = (f32x4){0.f, 0.f, 0.f, 0.f};
    bf16x8 At[4][2], B0[2][2], B1[2][2];
    const char* cA = (const char*)cur.A; const char* cB = (const char*)cur.B; int clda = cur.lda, cldb = cur.ldb;
    GM_STAGE(GM_SB(0, 0), cB, cldb, RbP); GM_STAGE(GM_SB(0, 1), cB + (size_t)cldb * 256, cldb, RbP); GM_STAGE(GM_SA(0, 0), cA, clda, R0); GM_STAGE(GM_SA(0, 1), cA + (size_t)clda * 256, clda, R0);
    if (wr == 1) GM_BAR;
    GM_WAIT_V(2); GM_BAR;
    GM_STAGE(GM_SB(1, 0), cB + 128, cldb, RbP); GM_STAGE(GM_SA(1, 0), cA + 128, clda, R0); GM_STAGE(GM_SB(1, 1), cB + (size_t)cldb * 256 + 128, cldb, RbP);
    GM_WAIT_V(6); GM_BAR;
    for (;;) {
        const bool has_next = S.next(ui + 1, nxt);
        const char* nA = has_next ? (const char*)nxt.A : cA; const char* nB = has_next ? (const char*)nxt.B : cB;
        const int nlda = has_next ? nxt.lda : clda, nldb = has_next ? nxt.ldb : cldb;
        const int nt = cur.K / BK;
#if SS_PREFETCH
        if (wid < 4) __builtin_amdgcn_global_load_lds((const unsigned*)(E.ws + WS_SS + ((size_t)(cur.kind == K_STORE_T ? cur.pn : cur.pm) * 256 + tid) * 16), (LAS unsigned*)(lds + STAGE_BYTES + (ui & 1) * 4096 + wid * 1024), 16, 0, 0);
        if (wid == 4 && cur.kind == K_GATE) __builtin_amdgcn_global_load_lds((const unsigned*)(E.b_gate + (size_t)cur.l * 4096 + (cur.sub & 3) * 1024 + cur.pn * 256 + lane * 4), (LAS unsigned*)(lds + STAGE_BYTES + 8192 + (ui & 1) * 1024), 16, 0, 0);
#endif
        for (int t = 0; t < nt; t += 2) {
            const bool last = (t == nt - 2);
            if (last && has_next) S.a_ready(nxt, wid, lane);
            const char* a1 = cA + (size_t)(t + 1) * 128;
            const char* a2 = last ? nA : cA + (size_t)(t + 2) * 128; const char* b2 = last ? nB : cB + (size_t)(t + 2) * 128;
            const int lda2 = last ? nlda : clda, ldb2 = last ? nldb : cldb;
            const char* a3 = a2 + 128; const char* b3 = b2 + 128;
            const int later = __builtin_amdgcn_readfirstlane((t != 0) ? 1 : 0);
#if FRESH_WAITS
#define GM_WAIT_V8_LATER asm volatile("s_cmp_eq_u32 %0, 0\n\ts_cbranch_scc1 .Lgmw%=\n\ts_waitcnt vmcnt(8)\n.Lgmw%=:" :: "s"(later) : "scc", "memory")
#else
#define GM_WAIT_V8_LATER GM_WAIT_V(8)
#endif
            GM_LDB(B0, 0, 0); GM_LDB(B1, 0, 1); GM_SCHED; GM_LDA(At, 0, 0); GM_STAGE(GM_SA(1, 1), a1 + (size_t)clda * 256, clda, R0);
            GM_WAIT_V8_LATER; GM_WAIT_L(0); GM_BAR; GM_MMA(0, 0, At, B0); GM_MMA(0, 1, At, B1); GM_BAR; GM_SCHED;
            GM_LDA(At, 0, 1); GM_STAGE(GM_SB(0, 0), b2, ldb2, RbP); GM_STAGE(GM_SB(0, 1), b2 + (size_t)ldb2 * 256, ldb2, RbP); GM_STAGE(GM_SA(0, 0), a2, lda2, R0);
            GM_WAIT_V8_LATER; GM_WAIT_L(0); GM_BAR; GM_MMA(1, 0, At, B0); GM_MMA(1, 1, At, B1); GM_BAR; GM_SCHED;
#undef GM_WAIT_V8_LATER
            GM_LDB(B0, 1, 0); GM_LDB(B1, 1, 1); GM_SCHED; GM_LDA(At, 1, 0); GM_STAGE(GM_SA(0, 1), a2 + (size_t)lda2 * 256, lda2, R0);
            GM_WAIT_V(8); GM_WAIT_L(0); GM_BAR; GM_MMA(0, 0, At, B0); GM_MMA(0, 1, At, B1); GM_BAR; GM_SCHED;
            GM_LDA(At, 1, 1); GM_STAGE(GM_SB(1, 0), b3, ldb2, RbP); GM_STAGE(GM_SB(1, 1), b3 + (size_t)ldb2 * 256, ldb2, RbP); GM_STAGE(GM_SA(1, 0), a3, lda2, R0);
            GM_WAIT_V(8); GM_WAIT_L(0); GM_BAR; GM_MMA(1, 0, At, B0); GM_MMA(1, 1, At, B1); GM_BAR; GM_SCHED;
        }
        if (wr == 0) GM_BAR;
        if (FRESH_WAITS && (cur.kind == K_AB || (cur.kind == K_STORE && cur.sub == 2) || (cur.kind == K_STORE_T && cur.sub == 1))) GM_WAIT_V(0);
#ifdef PROBE_EPI
        const unsigned long long te0_ = __builtin_amdgcn_s_memrealtime();
#endif
        E(acc, cur, wr, wc, fr, fq, lane, (const LAS float*)(lds + STAGE_BYTES + (ui & 1) * 4096), (const LAS float*)(lds + STAGE_BYTES + 8192 + (ui & 1) * 1024));
#ifdef PROBE_EPI
        if (cur.kind == PROBE_EPI) { asm volatile("s_waitcnt vmcnt(0)" ::: "memory"); const unsigned long long t1_ = __builtin_amdgcn_s_memrealtime(); const unsigned long long d_ = t1_ - te0_; while (__builtin_amdgcn_s_memrealtime() - t1_ < d_) __builtin_amdgcn_s_sleep(2); }
#endif
        if (!has_next) break;
#pragma unroll
        for (int a = 0; a < 2; ++a)
#pragma unroll
            for (int b = 0; b < 2; ++b)
#pragma unroll
                for (int m = 0; m < 4; ++m)
#pragma unroll
                    for (int n = 0; n < 2; ++n) acc[a][b][m][n] = (f32x4){0.f, 0.f, 0.f, 0.f};
        cur = nxt; cA = nA; cB = nB; clda = nlda; cldb = nldb; ++ui;
        if (wr == 1) GM_BAR;
    }
    GM_WAIT_V(0);
    GM_BAR;
#undef GM_SA
#undef GM_SB
#undef GM_STAGE
#undef GM_LDA
#undef GM_LDB
#undef GM_MMA
#undef GM_WAIT_V
#undef GM_WAIT_L
#undef GM_BAR
#undef GM_SCHED
}

#if SS_PREFETCH
#define SSROW(pan, r) row_scale_l(ssl, (r))
#else
#define SSROW(pan, r) row_scale((pan) * BM + (r))
#endif
struct Epi {
    unsigned char* ws;
    const float* xin; float* xout;
    const float* b_gate;
    const float* gnext;
    const float* gfinal;
    LAS float* spare;
    DI float row_scale(int row) const { const f32x4 s = *(const f32x4*)((const float*)(ws + WS_SS) + (size_t)row * 4); return rsqrtf(((s.x + s.y) + (s.z + s.w)) * (1.0f / 1024.0f) + EPS); }
    static DI float row_scale_l(const LAS float* ssl, int r) { const f32x4 s = *(const LAS f32x4*)(ssl + r * 4); return rsqrtf(((s.x + s.y) + (s.z + s.w)) * (1.0f / 1024.0f) + EPS); }
    DI unsigned char* scratch_tile(int pm, int pn) const { return ws + WS_SCR + (size_t)pm * 256 * SCRLD + pn * 256; }
    DI void operator()(f32x4 (&acc)[2][2][4][2], const Unit& u, int wr, int wc, int fr, int fq, int lane, const LAS float* ssl, const LAS float* bil) const {
        int rl0 = wr * 64 + fr, cl0 = wc * 32 + 8 * fq;
        asm volatile("" : "+v"(rl0), "+v"(cl0));
        if (u.kind == K_STORE) {
            bf16_t* base; int ldc; bool scale = true;
            if (u.sub == 0) {
                if (u.pn < 6) { base = (bf16_t*)(ws + WS_R) + (size_t)u.pm * 256 * RALD + u.pn * 256; ldc = RALD; }
                else { const int pc = u.pn < 8 ? (u.pn - 6) * 256 : (u.pn - 7) * 256; base = (bf16_t*)(ws + WS_P) + (size_t)u.pm * 256 * PLD + pc; ldc = PLD; }
            } else if (u.sub == 1) { base = (bf16_t*)(ws + WS_R) + (size_t)u.pm * 256 * RBLD + u.pn * 256; ldc = RBLD; }
            else { base = (bf16_t*)(ws + WS_KVM) + (size_t)u.l * 1024 * 1024 + (size_t)u.pm * 256 * 256; ldc = 256; scale = false; }
            const bool rope = (u.sub == 0 && u.pn >= 10);
            const float rsc = (u.pn == 11) ? 0.125f : 1.0f;
            const float* rc = (const float*)(ws + WS_ROPE); const int fi = (cl0 & 63) >> 1;
            float scq[2][4];
#pragma unroll
            for (int ai = 0; ai < 2; ++ai)
#pragma unroll
                for (int m = 0; m < 4; ++m) scq[ai][m] = scale ? SSROW(u.pm, rl0 + ai * HALF + m * 16) : 1.0f;
#pragma unroll
            for (int ai = 0; ai < 2; ++ai) {
                f32x4 csq[4], snq[4];
                if (rope) {
#pragma unroll
                    for (int m = 0; m < 4; ++m) { const size_t ro = (size_t)(u.pm * BM + rl0 + ai * HALF + m * 16) * 32 + fi; csq[m] = *(const f32x4*)(rc + ro); snq[m] = *(const f32x4*)(rc + (size_t)T * 32 + ro); }
                }
#pragma unroll
                for (int m = 0; m < 4; ++m) {
                    const int rl = rl0 + ai * HALF + m * 16;
                    const float sc = scq[ai][m];
                    bf16_t* rowp = base + (size_t)rl * ldc + cl0;
                    f32x4 cs4 = {1.f, 1.f, 1.f, 1.f}, sn4 = {0.f, 0.f, 0.f, 0.f};
                    if (rope) { cs4 = csq[m]; sn4 = snq[m]; }
#pragma unroll
                    for (int bj = 0; bj < 2; ++bj) { f32x4 v0 = acc[ai][bj][m][0] * sc, v1 = acc[ai][bj][m][1] * sc;
                        if (rope) { f32x4 r0, r1;
                            r0[0] = (v0[0] * cs4[0] - v0[1] * sn4[0]) * rsc; r0[1] = (v0[0] * sn4[0] + v0[1] * cs4[0]) * rsc; r0[2] = (v0[2] * cs4[1] - v0[3] * sn4[1]) * rsc; r0[3] = (v0[2] * sn4[1] + v0[3] * cs4[1]) * rsc;
                            r1[0] = (v1[0] * cs4[2] - v1[1] * sn4[2]) * rsc; r1[1] = (v1[0] * sn4[2] + v1[1] * cs4[2]) * rsc; r1[2] = (v1[2] * cs4[3] - v1[3] * sn4[3]) * rsc; r1[3] = (v1[2] * sn4[3] + v1[3] * cs4[3]) * rsc;
                            v0 = r0; v1 = r1; }
                        u32x4 w; w.x = pk2(v0[0], v0[1]); w.y = pk2(v0[2], v0[3]); w.z = pk2(v1[0], v1[1]); w.w = pk2(v1[2], v1[3]);
                        *(u32x4*)(rowp + bj * HALF) = w; }
                }
            }
        } else if (u.kind == K_STORE_T) {
            bf16_t* base; const bool scale = (u.sub == 0);
            if (u.sub == 0) base = (bf16_t*)(ws + WS_VTSB) + (size_t)u.pm * 256 * VTLD + u.pn * 256;
            else base = (bf16_t*)(ws + WS_KVM) + (size_t)u.l * 1024 * 1024 + 256 * 2048 + u.pn * 256;
            const int ldc = (u.sub == 0) ? VTLD : 2048;
            f32x4 cs[2][2];
#pragma unroll
            for (int bj = 0; bj < 2; ++bj)
#pragma unroll
                for (int n = 0; n < 2; ++n)
#pragma unroll
                    for (int j = 0; j < 4; ++j) cs[bj][n][j] = scale ? SSROW(u.pn, cl0 + bj * HALF + 4 * n + j) : 1.0f;
#pragma unroll
            for (int ai = 0; ai < 2; ++ai)
#pragma unroll
                for (int m = 0; m < 4; ++m) {
                    const int rl = rl0 + ai * HALF + m * 16;
                    bf16_t* rowp = base + (size_t)rl * ldc + cl0;
#pragma unroll
                    for (int bj = 0; bj < 2; ++bj) { const f32x4 v0 = acc[ai][bj][m][0] * cs[bj][0], v1 = acc[ai][bj][m][1] * cs[bj][1];
                        u32x4 w; w.x = pk2(v0[0], v0[1]); w.y = pk2(v0[2], v0[3]); w.z = pk2(v1[0], v1[1]); w.w = pk2(v1[2], v1[3]);
                        *(u32x4*)(rowp + bj * HALF) = w; }
                }
        } else if (u.kind == K_AB) {
            if (wc == 0 && fq == 0) {
                float* base = (float*)(ws + WS_AB) + (size_t)u.pm * 256 * 8;
#pragma unroll
                for (int ai = 0; ai < 2; ++ai)
#pragma unroll
                    for (int m = 0; m < 4; ++m) {
                        const int rl = rl0 + ai * HALF + m * 16;
                        const float sc = SSROW(u.pm, rl);
                        float* rowp = base + (size_t)rl * 8;
                        *(f32x4*)(rowp) = acc[ai][0][m][0] * sc; *(f32x4*)(rowp + 4) = acc[ai][0][m][1] * sc;
                    }
            }
        } else if (u.kind == K_GATE) {
            unsigned char* base = scratch_tile(u.pm, u.pn);
            const float* bias = b_gate + (size_t)u.l * 4096 + (u.sub & 3) * 1024 + u.pn * 256;
            f32x4 bv[2][2];
#pragma unroll
            for (int bj = 0; bj < 2; ++bj)
#pragma unroll
#if SS_PREFETCH
                for (int n = 0; n < 2; ++n) bv[bj][n] = *(const LAS f32x4*)(bil + cl0 + bj * HALF + 4 * n) * -1.4426950408889634f;
#else
                for (int n = 0; n < 2; ++n) bv[bj][n] = *(const f32x4*)(bias + cl0 + bj * HALF + 4 * n) * -1.4426950408889634f;
#endif
            float scq[2][4];
#pragma unroll
            for (int ai = 0; ai < 2; ++ai)
#pragma unroll
                for (int m = 0; m < 4; ++m) scq[ai][m] = SSROW(u.pm, rl0 + ai * HALF + m * 16) * -1.4426950408889634f;
#pragma unroll
            for (int ai = 0; ai < 2; ++ai)
#pragma unroll
                for (int m = 0; m < 4; ++m) {
                    const int rl = rl0 + ai * HALF + m * 16;
                    const float sc = scq[ai][m];
                    unsigned char* rowp = base + (size_t)rl * SCRLD + cl0;
#pragma unroll
                    for (int bj = 0; bj < 2; ++bj) { const f32x4 v0 = acc[ai][bj][m][0] * sc + bv[bj][0], v1 = acc[ai][bj][m][1] * sc + bv[bj][1];
                        unsigned pa = 0u, pb = 0u;
#define G255(x) __builtin_amdgcn_rcpf(__builtin_amdgcn_exp2f(x) * (1.0f / 255.0f) + (1.0f / 255.0f))
                        pa = __builtin_amdgcn_cvt_pk_u8_f32(G255(v0[0]), 0, pa); pa = __builtin_amdgcn_cvt_pk_u8_f32(G255(v0[1]), 1, pa);
                        pa = __builtin_amdgcn_cvt_pk_u8_f32(G255(v0[2]), 2, pa); pa = __builtin_amdgcn_cvt_pk_u8_f32(G255(v0[3]), 3, pa);
                        pb = __builtin_amdgcn_cvt_pk_u8_f32(G255(v1[0]), 0, pb); pb = __builtin_amdgcn_cvt_pk_u8_f32(G255(v1[1]), 1, pb);
                        pb = __builtin_amdgcn_cvt_pk_u8_f32(G255(v1[2]), 2, pb); pb = __builtin_amdgcn_cvt_pk_u8_f32(G255(v1[3]), 3, pb);
#undef G255
                        EPI_ST((u32x2*)(rowp + bj * HALF), ((u32x2){pa, pb})); }
                }
        } else if (u.kind == K_BRANCH) {
            bf16_t* base = (bf16_t*)(ws + WS_MRG) + (size_t)u.pm * 256 * MRGLD + u.pn * 256; const unsigned char* gbase = scratch_tile(u.pm, u.pn);
            const bool first = (u.sub & 4) != 0;
            const float i255 = 1.0f / 255.0f;
#ifdef BR_ALL_IN_FLIGHT
            u32x2 gq2[2][4][2]; u32x4 tq[2][4][2];
#pragma unroll
            for (int ai = 0; ai < 2; ++ai)
#pragma unroll
                for (int m = 0; m < 4; ++m) { const int rl = rl0 + ai * HALF + m * 16;
#pragma unroll
                    for (int bj = 0; bj < 2; ++bj) { gq2[ai][m][bj] = EPI_LD((const u32x2*)(gbase + (size_t)rl * SCRLD + cl0 + bj * HALF));
                        tq[ai][m][bj] = first ? (u32x4){0u, 0u, 0u, 0u} : EPI_LD((const u32x4*)(base + (size_t)rl * MRGLD + cl0 + bj * HALF)); } }
#pragma unroll
            for (int ai = 0; ai < 2; ++ai) {
#pragma unroll
                for (int m = 0; m < 4; ++m) { const int rl = rl0 + ai * HALF + m * 16;
#pragma unroll
                    for (int bj = 0; bj < 2; ++bj) {
                        const u32x4 t = tq[ai][m][bj]; const f32x4 v0 = acc[ai][bj][m][0], v1 = acc[ai][bj][m][1]; const unsigned ga = gq2[ai][m][bj].x, gb = gq2[ai][m][bj].y;
                        u32x4 w;
                        w.x = pk2(bflo(t.x) + (float)(ga & 0xffu) * i255 * v0[0], bfhi(t.x) + (float)((ga >> 8) & 0xffu) * i255 * v0[1]);
                        w.y = pk2(bflo(t.y) + (float)((ga >> 16) & 0xffu) * i255 * v0[2], bfhi(t.y) + (float)(ga >> 24) * i255 * v0[3]);
                        w.z = pk2(bflo(t.z) + (float)(gb & 0xffu) * i255 * v1[0], bfhi(t.z) + (float)((gb >> 8) & 0xffu) * i255 * v1[1]);
                        w.w = pk2(bflo(t.w) + (float)((gb >> 16) & 0xffu) * i255 * v1[2], bfhi(t.w) + (float)(gb >> 24) * i255 * v1[3]);
                        EPI_ST((u32x4*)(base + (size_t)rl * MRGLD + cl0 + bj * HALF), w); } }
                asm volatile("" ::: "memory");
            }
#else
#pragma unroll
            for (int ai = 0; ai < 2; ++ai) {
                u32x2 gq2[4][2]; u32x4 tq[4][2];
#pragma unroll
                for (int m = 0; m < 4; ++m) { const int rl = rl0 + ai * HALF + m * 16;
#pragma unroll
                    for (int bj = 0; bj < 2; ++bj) { gq2[m][bj] = EPI_LD((const u32x2*)(gbase + (size_t)rl * SCRLD + cl0 + bj * HALF));
                        tq[m][bj] = first ? (u32x4){0u, 0u, 0u, 0u} : EPI_LD((const u32x4*)(base + (size_t)rl * MRGLD + cl0 + bj * HALF)); } }
#pragma unroll
                for (int m = 0; m < 4; ++m) { const int rl = rl0 + ai * HALF + m * 16;
#pragma unroll
                    for (int bj = 0; bj < 2; ++bj) {
                        const u32x4 t = tq[m][bj]; const f32x4 v0 = acc[ai][bj][m][0], v1 = acc[ai][bj][m][1]; const unsigned ga = gq2[m][bj].x, gb = gq2[m][bj].y;
                        u32x4 w;
                        w.x = pk2(bflo(t.x) + (float)(ga & 0xffu) * i255 * v0[0], bfhi(t.x) + (float)((ga >> 8) & 0xffu) * i255 * v0[1]);
                        w.y = pk2(bflo(t.y) + (float)((ga >> 16) & 0xffu) * i255 * v0[2], bfhi(t.y) + (float)(ga >> 24) * i255 * v0[3]);
                        w.z = pk2(bflo(t.z) + (float)(gb & 0xffu) * i255 * v1[0], bfhi(t.z) + (float)((gb >> 8) & 0xffu) * i255 * v1[1]);
                        w.w = pk2(bflo(t.w) + (float)((gb >> 16) & 0xffu) * i255 * v1[2], bfhi(t.w) + (float)(gb >> 24) * i255 * v1[3]);
                        EPI_ST((u32x4*)(base + (size_t)rl * MRGLD + cl0 + bj * HALF), w); } }
                asm volatile("" ::: "memory");
            }
#endif
        } else {
            bf16_t* base = (bf16_t*)(ws + WS_XN) + (size_t)u.pm * 256 * 1024 + u.pn * 256;
            const bool wxn = gnext != nullptr, fin = gfinal != nullptr;
            f32x4 gv[2][2];
#pragma unroll
            for (int bj = 0; bj < 2; ++bj)
#pragma unroll
                for (int n = 0; n < 2; ++n) gv[bj][n] = wxn ? *(const f32x4*)(gnext + u.pn * BM + cl0 + bj * HALF + 4 * n) : (fin ? *(const f32x4*)(gfinal + u.pn * BM + cl0 + bj * HALF + 4 * n) : (f32x4){0.f, 0.f, 0.f, 0.f});
#pragma unroll
            for (int ah = 0; ah < 4; ++ah) {
                const int ai = ah >> 1, m0 = (ah & 1) * 2;
                f32x4 xq[2][2][2];
#pragma unroll
                for (int mm = 0; mm < 2; ++mm) { const size_t goff = (size_t)(u.pm * BM + rl0 + ai * HALF + (m0 + mm) * 16) * D + u.pn * BM + cl0;
#pragma unroll
                    for (int bj = 0; bj < 2; ++bj) { xq[mm][bj][0] = *(const f32x4*)(xin + goff + bj * HALF); xq[mm][bj][1] = *(const f32x4*)(xin + goff + bj * HALF + 4); } }
#pragma unroll
                for (int mm = 0; mm < 2; ++mm) {
                    const int m = m0 + mm, rl = rl0 + ai * HALF + m * 16;
                    const size_t goff = (size_t)(u.pm * BM + rl) * D + u.pn * BM + cl0;
                    float sq = 0.f;
#pragma unroll
                    for (int bj = 0; bj < 2; ++bj) {
                        const f32x4 v0 = acc[ai][bj][m][0] + xq[mm][bj][0], v1 = acc[ai][bj][m][1] + xq[mm][bj][1];
                        acc[ai][bj][m][0] = v0; acc[ai][bj][m][1] = v1;
                        if (!fin) { *(f32x4*)(xout + goff + bj * HALF) = v0; *(f32x4*)(xout + goff + bj * HALF + 4) = v1; }
                        sq += (v0[0] * v0[0] + v0[1] * v0[1]) + (v0[2] * v0[2] + v0[3] * v0[3]) + (v1[0] * v1[0] + v1[1] * v1[1]) + (v1[2] * v1[2] + v1[3] * v1[3]);
                        if (wxn) { const f32x4 a = v0 * gv[bj][0], b = v1 * gv[bj][1];
                            u32x4 w; w.x = pk2(a[0], a[1]); w.y = pk2(a[2], a[3]); w.z = pk2(b[0], b[1]); w.w = pk2(b[2], b[3]);
                            *(u32x4*)(base + (size_t)rl * 1024 + cl0 + bj * HALF) = w; }
                    }
                    sq += shx(sq, 16, lane); sq += shx(sq, 32, lane);
                    if (fq == 0) spare[rl * 4 + wc] = sq;
                }
                asm volatile("" ::: "memory");
            }
            LDS_WAIT(); __builtin_amdgcn_s_barrier(); asm volatile("" ::: "memory");
            const int t_ = wr * 256 + wc * 64 + lane;
            unsigned* ssw = (unsigned*)(ws + WS_SS);
            if (t_ < 256) { const int rl = t_; const f32x4 p = *(const LAS f32x4*)(spare + rl * 4); const float tot = (p.x + p.y) + (p.z + p.w);
                if (fin) __hip_atomic_store(ssw + (size_t)(u.pm * BM + rl) * 4 + u.pn, __builtin_bit_cast(unsigned, tot), __ATOMIC_RELAXED, __HIP_MEMORY_SCOPE_AGENT);
                else ((float*)ssw)[(size_t)(u.pm * BM + rl) * 4 + u.pn] = tot; }
            if (fin) {
                unsigned* cnt = (unsigned*)(ws + WS_CTL) + CW_PANEL + 64 * u.pm;
                asm volatile("s_waitcnt vmcnt(0)" ::: "memory");
                __builtin_amdgcn_s_barrier(); asm volatile("" ::: "memory");
                if (t_ == 0) {
                    __hip_atomic_fetch_add(cnt, 1u, __ATOMIC_RELAXED, __HIP_MEMORY_SCOPE_AGENT);
                    unsigned sp_ = 0;
                    while (__hip_atomic_load(cnt, __ATOMIC_RELAXED, __HIP_MEMORY_SCOPE_AGENT) < 4u) { __builtin_amdgcn_s_sleep(1); if (++sp_ > (1u << 22)) break; }
                }
                __builtin_amdgcn_s_barrier(); asm volatile("" ::: "memory");
#pragma unroll
                for (int ai = 0; ai < 2; ++ai)
#pragma unroll
                    for (int m = 0; m < 4; ++m) {
                        const int rl = rl0 + ai * HALF + m * 16; const unsigned* sp4 = ssw + (size_t)(u.pm * BM + rl) * 4;
                        const float p0 = __builtin_bit_cast(float, __hip_atomic_load(sp4 + 0, __ATOMIC_RELAXED, __HIP_MEMORY_SCOPE_AGENT)), p1 = __builtin_bit_cast(float, __hip_atomic_load(sp4 + 1, __ATOMIC_RELAXED, __HIP_MEMORY_SCOPE_AGENT));
                        const float p2 = __builtin_bit_cast(float, __hip_atomic_load(sp4 + 2, __ATOMIC_RELAXED, __HIP_MEMORY_SCOPE_AGENT)), p3 = __builtin_bit_cast(float, __hip_atomic_load(sp4 + 3, __ATOMIC_RELAXED, __HIP_MEMORY_SCOPE_AGENT));
                        const float rs = rsqrtf(((p0 + p1) + (p2 + p3)) * (1.0f / 1024.0f) + EPS);
                        const size_t goff = (size_t)(u.pm * BM + rl) * D + u.pn * BM + cl0;
#pragma unroll
                        for (int bj = 0; bj < 2; ++bj) { *(f32x4*)(xout + goff + bj * HALF) = acc[ai][bj][m][0] * rs * gv[bj][0]; *(f32x4*)(xout + goff + bj * HALF + 4) = acc[ai][bj][m][1] * rs * gv[bj][1]; }
                    }
            }
        }
    }
};
}

struct Args {
    const float* x; const float* mem; const int* positions; const float* norm_g; const float* mem_norm_g; const float* w_in; const float* b_gate;
    const float* dn_conv_w; const float* dn_a_log; const float* dn_dt_bias; const float* dn_norm_g; const float* ret_norm_g; const float* w_mem_kv;
    const float* w_br_sb; const float* w_br_dn; const float* w_br_ret; const float* w_br_mem; const float* w_out; const float* final_norm_g;
    float* out; unsigned char* ws; int ph_lo, ph_hi, li, pad;
};
struct Frame { LAS unsigned char* lds; int tid, lane, wave, G, gw, NGW; };
DI Frame mkframe(int wv) {
    extern __shared__ __attribute__((aligned(16))) unsigned char lds_raw[];
    Frame F; F.lds = (LAS unsigned char*)lds_raw; F.tid = opaque_tid(wv); F.lane = F.tid & 63; F.wave = wv;
    F.G = gridDim.x; F.gw = opaque_bid() * NWAVES + F.wave; F.NGW = F.G * NWAVES; return F;
}
typedef const __attribute__((address_space(4))) Args* ArgsP;
DI ArgsP kargs() { unsigned long long p = (unsigned long long)__builtin_amdgcn_kernarg_segment_ptr(); asm volatile("" : "+s"(p)); return (ArgsP)p; }
DI unsigned char* rst_base(ArgsP ap, int l) { return l == 0 ? (unsigned char*)ap->out : ap->ws + WS_WG + (size_t)(l - 1) * 4096 * 1024 * 2; }

struct TItem { const float* W; bf16_t* WT; int K, Nsrc, k0, csrc, rdst, rs; };
DI void titem_load(const TItem& t, int lane, float (&v)[32]) {
#pragma unroll
    for (int i = 0; i < 32; ++i) v[i] = t.W[(size_t)(t.k0 + 2 * i + (lane >> 5)) * t.Nsrc + t.csrc + (lane & 31)];
}
DI void titem_store(LAS float* scr, int lane, const TItem& t, const float (&v)[32]) {
#pragma unroll
    for (int i = 0; i < 32; ++i) scr[(2 * i + (lane >> 5)) * 33 + (lane & 31)] = v[i];
    LDS_WAIT(); asm volatile("" ::: "memory");
    const int c = lane & 7;
#pragma unroll
    for (int j = 0; j < 4; ++j) { const int n = (lane >> 3) + 8 * j; const LAS float* sp = scr + (8 * c) * 33 + n;
        u32x4 o; o.x = pk2(sp[0 * 33], sp[1 * 33]); o.y = pk2(sp[2 * 33], sp[3 * 33]); o.z = pk2(sp[4 * 33], sp[5 * 33]); o.w = pk2(sp[6 * 33], sp[7 * 33]);
        *(u32x4*)(t.WT + (size_t)(t.rdst + n * t.rs) * t.K + t.k0 + 8 * c) = o; }
    LDS_WAIT(); asm volatile("" ::: "memory");
}
DI void memn_rows(const Frame& F, ArgsP ap, int l) {
    unsigned char* ws = ap->ws;
    for (int m = F.gw; m < BATCH * MEMLEN; m += F.NGW) {
        const f32x4* xr = (const f32x4*)(ap->mem + (size_t)m * D) + F.lane; const f32x4* gr = (const f32x4*)(ap->mem_norm_g + (size_t)l * D) + F.lane;
        f32x4 v[4]; float sq = 0.f;
#pragma unroll
        for (int j = 0; j < 4; ++j) { v[j] = xr[64 * j]; sq += (v[j].x * v[j].x + v[j].y * v[j].y) + (v[j].z * v[j].z + v[j].w * v[j].w); }
        const float rs = rsqrtf(wave_sum(sq, F.lane) * (1.f / D) + EPS);
        unsigned long long* o8 = (unsigned long long*)((bf16_t*)(ws + WS_MEMN) + (size_t)m * D) + F.lane;
#pragma unroll
        for (int j = 0; j < 4; ++j) { const f32x4 g = gr[64 * j];
            o8[64 * j] = (unsigned long long)pk2(v[j].x * rs * g.x, v[j].y * rs * g.y) | ((unsigned long long)pk2(v[j].z * rs * g.z, v[j].w * rs * g.w) << 32); }
    }
}
struct TSeg { int src, K, Nsrc, c0, ncols, dst, r0; };
DI void convert_weights(const Frame& F, ArgsP ap, int l, int first, int stride, int part) {
    unsigned char* ws = ap->ws;
    LAS float* scr = (LAS float*)(F.lds + F.wave * 16384);
    constexpr int NSEG = 14;
    const TSeg seg[NSEG] = {
        {0, 1024, IN_COLS, 2048, 2048, 0, 0}, {0, 1024, IN_COLS, 5640, 256, 0, 2304}, {0, 1024, IN_COLS, 4104, 256, 0, 2560}, {0, 1024, IN_COLS, 4360, 256, 0, 2816},
        {0, 1024, IN_COLS, 0, 1024, 1, 0}, {0, 1024, IN_COLS, 1536, 512, 1, 1024}, {0, 1024, IN_COLS, 5128, 512, 1, 1536}, {0, 1024, IN_COLS, 1024, 512, 1, 2048}, {0, 1024, IN_COLS, 4616, 512, 1, 2560},
        {0, 1024, IN_COLS, 5896, 4096, 2, 0},
        {1, 512, 1024, 0, 1024, 3, 0}, {2, 512, 1024, 0, 1024, 3, 1024}, {3, 512, 1024, 0, 1024, 3, 2048}, {5, 1024, 1024, 0, 1024, 4, 0} };
    int cum[NSEG + 1]; cum[0] = 0;
#pragma unroll
    for (int q = 0; q < NSEG; ++q) cum[q + 1] = cum[q] + (seg[q].K / 64) * (seg[q].ncols / 32);
    const int per_layer = cum[NSEG] + (256 / 64) * (1024 / 32) + (1024 / 64) * (512 / 32);
    const int c9 = cum[9], c14m = cum[NSEG] + 128;
    const int n1 = c9 + (per_layer - c14m), n2 = c14m - c9, nit = part == 0 ? per_layer : (part == 1 ? n1 : n2);
    auto params = [&](int it, TItem& t) -> bool {
        if (it >= nit) return false;
        int r = part == 0 ? it : (part == 1 ? (it < c9 ? it : it - c9 + c14m) : it + c9);
        const float* W; int K, Nsrc, c0, ncols, r0; bf16_t* WT; bool perm = false;
        if (r < cum[NSEG]) {
            int q = 0;
#pragma unroll
            for (int qq = 1; qq < NSEG; ++qq) if (r >= cum[qq]) q = qq;
            int src = 0, dst = 0; K = 1024; Nsrc = IN_COLS; c0 = 0; ncols = 32; r0 = 0; int base = 0;
#pragma unroll
            for (int qq = 0; qq < NSEG; ++qq) if (q == qq) { src = seg[qq].src; K = seg[qq].K; Nsrc = seg[qq].Nsrc; c0 = seg[qq].c0; ncols = seg[qq].ncols; dst = seg[qq].dst; r0 = seg[qq].r0; base = cum[qq]; }
            r -= base; perm = (q == 2 || q == 3);
            W = src == 0 ? ap->w_in + (size_t)l * D * IN_COLS : src == 1 ? ap->w_br_sb + (size_t)l * 512 * 1024 : src == 2 ? ap->w_br_dn + (size_t)l * 512 * 1024 : src == 3 ? ap->w_br_ret + (size_t)l * 512 * 1024 : ap->w_out + (size_t)l * 1024 * 1024;
            WT = dst == 0 ? (bf16_t*)(ws + WS_WINA) + (size_t)l * 3072 * 1024 : dst == 1 ? (bf16_t*)(ws + WS_WINB) + (size_t)l * 3072 * 1024 : dst == 2 ? (bf16_t*)(ws + WS_WG) + (size_t)l * 4096 * 1024
               : dst == 3 ? (bf16_t*)(ws + WS_WBR) + (size_t)l * 2 * 1024 * 1024 : (bf16_t*)(ws + WS_WOUT) + (size_t)l * 1024 * 1024;
            if (dst == 3) { WT += (size_t)r0 * 512; r0 = 0; }
        } else if (r < cum[NSEG] + 128) { r -= cum[NSEG]; W = ap->w_br_mem + (size_t)l * 256 * 1024; K = 256; Nsrc = 1024; c0 = 0; ncols = 1024; r0 = 0; WT = (bf16_t*)(ws + WS_WBR) + (size_t)l * 2 * 1024 * 1024 + 3 * 1024 * 512; }
        else { r -= cum[NSEG] + 128; W = ap->w_mem_kv + (size_t)l * 1024 * 512; K = 1024; Nsrc = 512; c0 = 0; ncols = 512; r0 = 0; WT = (bf16_t*)(ws + WS_WKV) + (size_t)l * 512 * 1024; }
        const int nblk = ncols / 32, kb = r / nblk, nb = r % nblk;
        t.W = W; t.WT = WT; t.K = K; t.Nsrc = Nsrc; t.k0 = 64 * kb; t.csrc = c0 + 32 * nb; t.rdst = perm ? r0 + (nb >> 1) * 64 + (nb & 1) : r0 + 32 * nb; t.rs = perm ? 2 : 1;
        return true;
    };
    {
        TItem ta, tb; float va[32], vb[32];
        int it = first;
        bool ha = params(it, ta); if (ha) titem_load(ta, F.lane, va);
        while (ha) {
            it += stride; const bool hb = params(it, tb); if (hb) titem_load(tb, F.lane, vb);
            titem_store(scr, F.lane, ta, va);
            if (!hb) break;
            it += stride; ha = params(it, ta); if (ha) titem_load(ta, F.lane, va);
            titem_store(scr, F.lane, tb, vb);
        }
    }
    if (part != 2) {
        const float* win = ap->w_in + (size_t)l * D * IN_COLS; bf16_t* wa = (bf16_t*)(ws + WS_WINA) + (size_t)l * 3072 * 1024;
        for (int i = first * 64 + F.lane; i < 256 * 1024; i += stride * 64) { const int r = i >> 10, k = i & 1023;
            wa[(size_t)(2048 + r) * 1024 + k] = r < 8 ? (bf16_t)f2bf(win[(size_t)k * IN_COLS + 4096 + r]) : (bf16_t)0; }
    }
}
DI void p0_prologue(int wv) {
    const Frame F = mkframe(wv);
    const ArgsP ap = kargs();
    unsigned char* ws = ap->ws;
#ifdef PROBE_PRO
    unsigned long long tq0_ = __builtin_amdgcn_s_memrealtime();
#define PRO_ECHO(k) do { asm volatile("s_waitcnt vmcnt(0)" ::: "memory"); const unsigned long long t1_ = __builtin_amdgcn_s_memrealtime(); if (PROBE_PRO == (k)) { const unsigned long long d_ = t1_ - tq0_; while (__builtin_amdgcn_s_memrealtime() - t1_ < d_) __builtin_amdgcn_s_sleep(2); } tq0_ = __builtin_amdgcn_s_memrealtime(); } while (0)
#else
#define PRO_ECHO(k) do { } while (0)
#endif
    convert_weights(F, ap, 0, F.gw, F.NGW, 1);
    PRO_ECHO(1);
    constexpr int XNR = 4;
    for (int m = XNR * F.gw; m < T; m += XNR * F.NGW) {
        f32x4 v[XNR][4]; const f32x4* gr = (const f32x4*)ap->norm_g + F.lane;
#pragma unroll
        for (int q = 0; q < XNR; ++q)
#pragma unroll
            for (int j = 0; j < 4; ++j) v[q][j] = ((const f32x4*)(ap->x + (size_t)(m + q) * D) + F.lane)[64 * j];
#pragma unroll
        for (int q = 0; q < XNR; ++q) {
            unsigned long long* o8 = (unsigned long long*)((bf16_t*)(ws + WS_XN) + (size_t)(m + q) * D) + F.lane; float sq = 0.f;
#pragma unroll
            for (int j = 0; j < 4; ++j) { const f32x4 x = v[q][j], g = gr[64 * j]; sq += (x.x * x.x + x.y * x.y) + (x.z * x.z + x.w * x.w);
                o8[64 * j] = (unsigned long long)pk2(x.x * g.x, x.y * g.y) | ((unsigned long long)pk2(x.z * g.z, x.w * g.w) << 32); }
            sq = wave_sum(sq, F.lane);
            if (F.lane == 0) *(f32x4*)((float*)(ws + WS_SS) + (size_t)(m + q) * 4) = (f32x4){sq, 0.f, 0.f, 0.f};
        }
    }
    PRO_ECHO(2);
    memn_rows(F, ap, 0);
    PRO_ECHO(3);
    for (int i = F.gw * 64 + F.lane; i < T * 32; i += F.NGW * 64) {
        const int t = i >> 5, f = i & 31;
        const float inv = exp2f(-(float)f * (13.287712379549449f / 32.0f));
        const float ang = (float)ap->positions[t] * inv;
#ifdef ROPE_FAST_SINCOS
        const float rev = ang * 0.15915494309189535f; const float fr = rev - floorf(rev);
        const float sn = __builtin_amdgcn_sinf(fr), cs = __builtin_amdgcn_cosf(fr);
#else
        float sn, cs; sincosf(ang, &sn, &cs);
#endif
        ((float*)(ws + WS_ROPE))[i] = cs; ((float*)(ws + WS_ROPE))[T * 32 + i] = sn;
    }
}

struct SchedP1 {
    gm::TileOrder ord; unsigned char* ws; int l, half, c; bool with_kvm;
    DI void a_ready(const gm::Unit&, int, int) const {}
    DI bool next(int i, gm::Unit& u) const {
        int pm, pn;
        if (ord.tile(i, pm, pn)) {
            const bf16_t* xn = (const bf16_t*)(ws + WS_XN) + (size_t)pm * 256 * 1024;
            const bf16_t* w = (const bf16_t*)(ws + (half == 0 ? WS_WINA : WS_WINB)) + ((size_t)l * 3072 + pn * 256) * 1024;
            u.lda = 1024; u.K = 1024; u.ldb = 1024; u.l = l; u.sub = half;
            if (half == 1 && pn >= 8) { u.A = w; u.B = xn; u.pm = pn - 8; u.pn = pm; u.kind = gm::K_STORE_T; u.sub = 0; }
            else { u.A = xn; u.B = w; u.pm = pm; u.pn = pn; u.kind = (half == 0 && pn == 8) ? gm::K_AB : gm::K_STORE; }
            return true;
        }
        const int kc = ord.c - (ord.nwg % ord.G);
        if (with_kvm && kc >= 0 && kc < 16 && i == (ord.nwg + ord.G - 1 - ord.c) / ord.G) {
            const int ll = l, ty = (kc >> 3) & 1, idx = kc & 7;
            const bf16_t* mn = (const bf16_t*)(ws + WS_MEMN) + (size_t)(idx * 256) * 1024;
            const bf16_t* w = (const bf16_t*)(ws + WS_WKV) + ((size_t)ll * 512 + ty * 256) * 1024;
            u.lda = 1024; u.K = 1024; u.ldb = 1024; u.l = ll;
            if (ty == 0) { u.A = mn; u.B = w; u.pm = idx; u.pn = 0; u.kind = gm::K_STORE; u.sub = 2; }
            else { u.A = w; u.B = mn; u.pm = 0; u.pn = idx; u.kind = gm::K_STORE_T; u.sub = 1; }
            return true;
        }
        return false;
    }
};
struct SchedP3 {
    int pm, pn, l, rot; bool ok; unsigned char* ws;
    DI void a_ready(const gm::Unit& u, int wid, int lane) const {
        if (u.kind != gm::K_BRANCH || (u.sub & 4) == 0) return;
        if (wid == 0) {
            if (lane == 0) { unsigned* cnt = (unsigned*)(ws + WS_CTL) + CW_READY + 4096 * l + 64 * pm; unsigned sp = 0u;
                while (__hip_atomic_load(cnt, __ATOMIC_RELAXED, __HIP_MEMORY_SCOPE_AGENT) < 16u) { __builtin_amdgcn_s_sleep(2); if (++sp > (1u << 20)) break; } }
            __builtin_amdgcn_fence(__ATOMIC_ACQUIRE, "agent");
            asm volatile("s_waitcnt vmcnt(0)" ::: "memory");
        }
        asm volatile("" ::: "memory"); __builtin_amdgcn_s_barrier(); asm volatile("" ::: "memory");
    }
    DI bool next(int i, gm::Unit& u) const {
        if (!ok || i >= 8) return false;
        const int br = ((i >> 1) + rot) & 3;
        const bf16_t* R = (const bf16_t*)(ws + WS_R); const bf16_t* P = (const bf16_t*)(ws + WS_P);
        u.pm = pm; u.pn = pn; u.sub = br | ((i >> 1) == 0 ? 4 : 0); u.l = l;
        if ((i & 1) == 0) {
            u.A = (const bf16_t*)(ws + WS_XN) + (size_t)pm * 256 * 1024; u.lda = 1024; u.K = 1024; u.ldb = 1024;
            u.B = (const bf16_t*)(ws + WS_WG) + ((size_t)l * 4096 + br * 1024 + pn * 256) * 1024;
            u.kind = gm::K_GATE;
        } else {
            const bf16_t* wbr = (const bf16_t*)(ws + WS_WBR) + (size_t)l * 2 * 1024 * 1024 + (size_t)br * 1024 * 512;
            const int K = br == 3 ? 256 : 512;
            const int acol = br == 0 ? RB_SBQ : (br == 1 ? P_DNZ : (br == 2 ? RB_RTZ : P_MEMQ));
            const bool inP = (br & 1) != 0;
            u.lda = inP ? PLD : RBLD; u.A = (inP ? P : R) + (size_t)pm * 256 * u.lda + acol; u.K = K; u.ldb = K; u.B = wbr + (size_t)pn * 256 * K;
            u.kind = gm::K_BRANCH;
        }
        return true;
    }
};
struct SchedP4 {
    int pm, pn, l; bool ok; unsigned char* ws;
    DI void a_ready(const gm::Unit&, int, int) const {}
    DI bool next(int i, gm::Unit& u) const {
        if (!ok || i >= 1) return false;
        u.A = (const bf16_t*)(ws + WS_MRG) + (size_t)pm * 256 * MRGLD; u.lda = MRGLD; u.K = 1024; u.ldb = 1024;
        u.B = (const bf16_t*)(ws + WS_WOUT) + ((size_t)l * 1024 + pn * 256) * 1024;
        u.pm = pm; u.pn = pn; u.kind = gm::K_OUT; u.sub = 0; u.l = l;
        return true;
    }
};

typedef float f32x16 __attribute__((ext_vector_type(16)));
typedef short s16x4 __attribute__((ext_vector_type(4)));
#define MFMA32(a, b, c) __builtin_amdgcn_mfma_f32_32x32x16_bf16((a), (b), (c), 0, 0, 0)
DI int crow(int reg, int hh) { return (reg & 3) + 8 * (reg >> 2) + 4 * hh; }
DI bf16x8 pack8(float a0, float a1, float a2, float a3, float a4, float a5, float a6, float a7) {
    u32x4 p;
    asm volatile("s_nop 0\n\tv_cvt_pk_bf16_f32 %0, %4, %5\n\tv_cvt_pk_bf16_f32 %1, %6, %7\n\tv_cvt_pk_bf16_f32 %2, %8, %9\n\tv_cvt_pk_bf16_f32 %3, %10, %11\n\ts_nop 1"
                 : "=&v"(p[0]), "=&v"(p[1]), "=&v"(p[2]), "=&v"(p[3]) : "v"(a0), "v"(a1), "v"(a2), "v"(a3), "v"(a4), "v"(a5), "v"(a6), "v"(a7));
    return __builtin_bit_cast(bf16x8, p);
}
DI bf16x8 pack8m(float a0, float a1, float a2, float a3, float a4, float a5, float a6, float a7) {
    u32x4 p;
    asm volatile("s_nop 15\n\ts_nop 3\n\tv_cvt_pk_bf16_f32 %0, %4, %5\n\tv_cvt_pk_bf16_f32 %1, %6, %7\n\tv_cvt_pk_bf16_f32 %2, %8, %9\n\tv_cvt_pk_bf16_f32 %3, %10, %11\n\ts_nop 1"
                 : "=&v"(p[0]), "=&v"(p[1]), "=&v"(p[2]), "=&v"(p[3]) : "v"(a0), "v"(a1), "v"(a2), "v"(a3), "v"(a4), "v"(a5), "v"(a6), "v"(a7));
    return __builtin_bit_cast(bf16x8, p);
}
namespace at {
constexpr int KST = 144, VST = 136;
constexpr int KT_BYTES = 64 * KST;
DI bf16x8 kfrag(LAS unsigned char* kt, int row, int ks, int hh) { return *(const LAS bf16x8*)(kt + row * KST + ks * 32 + hh * 16); }
DI bf16x8 vfrag(LAS unsigned char* vt, int row, int keyoff, int hh) {
    const LAS unsigned char* pp = vt + row * VST + (keyoff + 4 * hh) * 2;
    const u32x2 lo = *(const LAS u32x2*)pp, hi = *(const LAS u32x2*)(pp + 16);
    u32x4 r; r.x = lo.x; r.y = lo.y; r.z = hi.x; r.w = hi.y; return __builtin_bit_cast(bf16x8, r);
}
}

DI void mem_unit(int wv, int l, int unit) {
    const Frame F = mkframe(wv);
    unsigned char* ws = kargs()->ws; bf16_t* P = (bf16_t*)(ws + WS_P);
    const bf16_t* KM = (const bf16_t*)(ws + WS_KVM) + (size_t)l * 1024 * 1024; const bf16_t* VTM = KM + 2048 * 256;
    const int b = unit >> 5, h = (unit >> 3) & 3, qt = unit & 7, lane = F.lane, r = lane & 31, hh = lane >> 5;
    LAS unsigned char* kt = F.lds; LAS unsigned char* vt = F.lds + 256 * at::KST;
    constexpr int VS = 520;
#pragma unroll
    for (int i = 0; i < 4; ++i) { const int id = F.tid + 512 * i, row = id >> 3, ch = id & 7;
        const u32x4 v = *(const u32x4*)(KM + (size_t)(b * 256 + row) * 256 + h * 64 + ch * 8);
        *(LAS u32x4*)(kt + row * at::KST + ch * 16) = v; }
#pragma unroll
    for (int i = 0; i < 4; ++i) { const int id = F.tid + 512 * i, row = id >> 5, ch = id & 31;
        const u32x4 v = *(const u32x4*)(VTM + (size_t)(h * 64 + row) * 2048 + b * 256 + ch * 8);
        *(LAS u32x2*)(vt + row * VS + ch * 16) = (u32x2){v.x, v.y}; *(LAS u32x2*)(vt + row * VS + ch * 16 + 8) = (u32x2){v.z, v.w}; }
    const int t = b * SEQ + qt * 256 + wv * 32 + r;
    bf16_t* qp = P + (size_t)t * PLD + P_MEMQ + h * 64;
    bf16x8 qf[4];
#pragma unroll
    for (int ks = 0; ks < 4; ++ks) qf[ks] = *(const bf16x8*)(qp + 16 * ks + 8 * hh);
    __syncthreads();
    f32x16 z[8];
#pragma unroll
    for (int st = 0; st < 8; ++st) {
        f32x16 a = {0.f, 0.f, 0.f, 0.f, 0.f, 0.f, 0.f, 0.f, 0.f, 0.f, 0.f, 0.f, 0.f, 0.f, 0.f, 0.f};
#pragma unroll
        for (int ks = 0; ks < 4; ++ks) a = MFMA32(at::kfrag(kt, 32 * st + r, ks, hh), qf[ks], a);
        z[st] = a;
    }
    float mx = -3.0e38f;
#pragma unroll
    for (int st = 0; st < 8; ++st)
#pragma unroll
        for (int i = 0; i < 16; ++i) mx = fmaxf(mx, z[st][i]);
    mx = fmaxf(mx, shx(mx, 32, lane));
    const float c2 = 0.125f * 1.4426950408889634f; float sum = 0.f;
#pragma unroll
    for (int st = 0; st < 8; ++st)
#pragma unroll
        for (int i = 0; i < 16; ++i) { const float e = exp2f((z[st][i] - mx) * c2); z[st][i] = e; sum += e; }
    sum += shx(sum, 32, lane);
    f32x16 o0 = {0.f, 0.f, 0.f, 0.f, 0.f, 0.f, 0.f, 0.f, 0.f, 0.f, 0.f, 0.f, 0.f, 0.f, 0.f, 0.f}, o1 = o0;
#pragma unroll
    for (int st = 0; st < 8; ++st)
#pragma unroll
        for (int s2 = 0; s2 < 2; ++s2) {
            const bf16x8 pf = pack8(z[st][8 * s2], z[st][8 * s2 + 1], z[st][8 * s2 + 2], z[st][8 * s2 + 3], z[st][8 * s2 + 4], z[st][8 * s2 + 5], z[st][8 * s2 + 6], z[st][8 * s2 + 7]);
            const int keyoff = 32 * st + 16 * s2;
            { const LAS unsigned char* pp = vt + r * VS + (keyoff + 4 * hh) * 2; const u32x2 lo = *(const LAS u32x2*)pp, hi = *(const LAS u32x2*)(pp + 16);
              u32x4 q; q.x = lo.x; q.y = lo.y; q.z = hi.x; q.w = hi.y; o0 = MFMA32(__builtin_bit_cast(bf16x8, q), pf, o0); }
            { const LAS unsigned char* pp = vt + (32 + r) * VS + (keyoff + 4 * hh) * 2; const u32x2 lo = *(const LAS u32x2*)pp, hi = *(const LAS u32x2*)(pp + 16);
              u32x4 q; q.x = lo.x; q.y = lo.y; q.z = hi.x; q.w = hi.y; o1 = MFMA32(__builtin_bit_cast(bf16x8, q), pf, o1); }
        }
    const float inv = 1.f / sum;
    LAS unsigned char* ob = F.lds + 73728 + wv * (32 * at::KST);
#pragma unroll
    for (int g = 0; g < 4; ++g) {
        *(LAS u32x2*)(ob + r * at::KST + (8 * g + 4 * hh) * 2) = (u32x2){pk2(o0[4 * g] * inv, o0[4 * g + 1] * inv), pk2(o0[4 * g + 2] * inv, o0[4 * g + 3] * inv)};
        *(LAS u32x2*)(ob + r * at::KST + (32 + 8 * g + 4 * hh) * 2) = (u32x2){pk2(o1[4 * g] * inv, o1[4 * g + 1] * inv), pk2(o1[4 * g + 2] * inv, o1[4 * g + 3] * inv)};
    }
#pragma unroll
    for (int k = 0; k < 4; ++k) { const int q = k * 64 + lane, row = q >> 3, pc = q & 7;
        st16_wt(P + (size_t)(t - r + row) * PLD + P_MEMQ + h * 64 + pc * 8, *(const LAS u32x4*)(ob + row * at::KST + pc * 16)); }
    unit_done(ws, l, b * 8 + qt, F.tid);
}

DI void ret_rope_prep(int wv, int c, int n) {
    const Frame F = mkframe(wv);
    unsigned char* ws = kargs()->ws; bf16_t* P = (bf16_t*)(ws + WS_P);
    const float* rc = (const float*)(ws + WS_ROPE); const float* rsn = rc + T * 32;
    for (int it = c * NTHREADS + F.tid; it < T * 32; it += n * NTHREADS) {
        const int t = it >> 5, w = (it >> 4) & 1, h = (it >> 2) & 3, g = it & 3;
        bf16_t* pp = P + (size_t)t * PLD + (w ? P_RTK : P_RTQ) + h * 64 + g * 8;
        const u32x4 a = *(const u32x4*)pp, bq = *(const u32x4*)(pp + 32);
        const f32x4 c0 = *(const f32x4*)(rc + (size_t)t * 32 + g * 8), c1 = *(const f32x4*)(rc + (size_t)t * 32 + g * 8 + 4);
        const f32x4 s0 = *(const f32x4*)(rsn + (size_t)t * 32 + g * 8), s1 = *(const f32x4*)(rsn + (size_t)t * 32 + g * 8 + 4);
        const float sc = w ? 0.125f : 1.0f;
        float x1[8] = {bflo(a.x), bfhi(a.x), bflo(a.y), bfhi(a.y), bflo(a.z), bfhi(a.z), bflo(a.w), bfhi(a.w)};
        float x2[8] = {bflo(bq.x), bfhi(bq.x), bflo(bq.y), bfhi(bq.y), bflo(bq.z), bfhi(bq.z), bflo(bq.w), bfhi(bq.w)};
        float cc[8] = {c0.x, c0.y, c0.z, c0.w, c1.x, c1.y, c1.z, c1.w}, ss[8] = {s0.x, s0.y, s0.z, s0.w, s1.x, s1.y, s1.z, s1.w};
        float y1[8], y2[8];
#pragma unroll
        for (int j = 0; j < 8; ++j) { y1[j] = (x1[j] * cc[j] - x2[j] * ss[j]) * sc; y2[j] = (x1[j] * ss[j] + x2[j] * cc[j]) * sc; }
        *(u32x4*)pp = (u32x4){pk2(y1[0], y1[1]), pk2(y1[2], y1[3]), pk2(y1[4], y1[5]), pk2(y1[6], y1[7])};
        *(u32x4*)(pp + 32) = (u32x4){pk2(y2[0], y2[1]), pk2(y2[2], y2[3]), pk2(y2[4], y2[5]), pk2(y2[6], y2[7])};
    }
}

DI void ret_state_unit(int wv, int l, int unit) {
    const Frame F = mkframe(wv);
    unsigned char* ws = kargs()->ws; const bf16_t* P = (const bf16_t*)(ws + WS_P);
    const int bh = unit / 7, c = unit - 7 * bh, b = bh >> 2, h = bh & 3, lane = F.lane, r = lane & 31, hh = lane >> 5;
    const int s0 = b * SEQ + c * 256;
    const bf16_t* VTg = (const bf16_t*)(ws + WS_VTRT) + (size_t)h * 128 * VTLD + s0;
    const bf16_t* Kg = P + (size_t)s0 * PLD + P_RTK + h * 64;
    constexpr int RS = 528;
    LAS unsigned char* vt = F.lds; LAS unsigned char* kT = F.lds + 128 * RS;
    const float lg = log2f(1.0f - exp2f(-5.0f - (float)h));
    u32x4 vv[8], kv[4];
#pragma unroll
    for (int i = 0; i < 8; ++i) { const int id = F.tid + 512 * i, row = id >> 5, ch = id & 31; vv[i] = *(const u32x4*)(VTg + (size_t)row * VTLD + ch * 8); }
    const int key = F.tid >> 1, chb = (F.tid & 1) * 32;
#pragma unroll
    for (int i = 0; i < 4; ++i) kv[i] = *(const u32x4*)(Kg + (size_t)key * PLD + chb + 8 * i);
#pragma unroll
    for (int i = 0; i < 8; ++i) { const int id = F.tid + 512 * i, row = id >> 5, ch = id & 31; *(LAS u32x4*)(vt + row * RS + ch * 16) = vv[i]; }
    const float fk = exp2f(lg * (float)(255 - key));
#pragma unroll
    for (int i = 0; i < 4; ++i) {
        const unsigned w4[4] = {kv[i].x, kv[i].y, kv[i].z, kv[i].w};
#pragma unroll
        for (int j = 0; j < 4; ++j) { const unsigned u2 = pk2(bflo(w4[j]) * fk, bfhi(w4[j]) * fk);
            LAS unsigned char* wp = kT + (chb + 8 * i + 2 * j) * RS + key * 2;
            *(LAS unsigned short*)wp = (unsigned short)u2; *(LAS unsigned short*)(wp + RS) = (unsigned short)(u2 >> 16); }
    }
    __syncthreads();
    const int d = wv & 3, e = wv >> 2;
    f32x16 acc = {0.f, 0.f, 0.f, 0.f, 0.f, 0.f, 0.f, 0.f, 0.f, 0.f, 0.f, 0.f, 0.f, 0.f, 0.f, 0.f};
#pragma unroll
    for (int sk = 0; sk < 16; ++sk)
        acc = MFMA32(*(const LAS bf16x8*)(vt + (32 * d + r) * RS + (16 * sk + 8 * hh) * 2), *(const LAS bf16x8*)(kT + (32 * e + r) * RS + (16 * sk + 8 * hh) * 2), acc);
    unsigned* Lp = (unsigned*)rst_base(kargs(), l) + (size_t)unit * 8192 + 32 * e + r;
    __builtin_amdgcn_sched_barrier(0); asm volatile("s_nop 15\n\ts_nop 3" ::: "memory"); __builtin_amdgcn_sched_barrier(0);
#pragma unroll
    for (int i = 0; i < 16; ++i) { unsigned* sp_ = Lp + (size_t)(32 * d + crow(i, hh)) * 64; const float av_ = acc[i];
        asm volatile("global_store_dword %0, %1, off sc1" :: "v"(sp_), "v"(av_) : "memory"); }
    VM_WAIT(); lds_barrier();
    if (F.tid == 0) (void)__hip_atomic_fetch_add((unsigned*)(ws + WS_CTL) + CW_RST + 2048 * l + 64 * bh, 1u, __ATOMIC_RELAXED, __HIP_MEMORY_SCOPE_AGENT);
}

template <int MODE>
DI void attn_unit(int wv, int l, int unit) {
    constexpr int DV = MODE == 0 ? 64 : 128, NDT = DV / 32, VST2 = 144, VT_BYTES = DV * VST2, BUF = at::KT_BYTES + VT_BYTES;
    const Frame F = mkframe(wv);
    const ArgsP ap = kargs();
    unsigned char* ws = ap->ws; bf16_t* R = (bf16_t*)(ws + WS_R); bf16_t* P = (bf16_t*)(ws + WS_P);
    const int lane = F.lane, r = lane & 31, hh = lane >> 5, kap = 16 * ((r >> 2) & 1) + (r & 3) + 4 * (r >> 3);
    int b, h, qt;
    if (MODE == 0) { b = unit >> 6; h = (unit >> 3) & 7; qt = unit & 7; } else { qt = unit >> 5; b = (unit >> 2) & 7; h = unit & 3; }
    const int q0 = qt * 256, qw0 = q0 + 32 * wv, tq = qw0 + r, t = b * SEQ + tq;
    const bf16_t* Kg = MODE == 0 ? R + RB_SBK + h * 64 : P + P_RTK + h * 64; const int kld = MODE == 0 ? RBLD : PLD;
    const bf16_t* VTg = (const bf16_t*)(ws + (MODE == 0 ? WS_VTSB : WS_VTRT)) + (size_t)h * DV * VTLD + b * SEQ;
    const bf16_t* qp = MODE == 0 ? R + (size_t)t * RBLD + RB_SBQ + h * 64 : P + (size_t)t * PLD + P_RTQ + h * 64;
    bf16x8 qf[4];
#pragma unroll
    for (int ks = 0; ks < 4; ++ks) qf[ks] = *(const bf16x8*)(qp + 16 * ks + 8 * hh);
    f32x16 o[NDT];
#pragma unroll
    for (int d = 0; d < NDT; ++d) o[d] = (f32x16){0.f, 0.f, 0.f, 0.f, 0.f, 0.f, 0.f, 0.f, 0.f, 0.f, 0.f, 0.f, 0.f, 0.f, 0.f, 0.f};
    volatile LAS unsigned* flags = (volatile LAS unsigned*)(F.lds + 2 * BUF);
    const int jtop = (q0 + 255) >> 6;
    const int srow = F.tid >> 3, sch = F.tid & 7;
    u32x4 kreg, vreg[NDT / 2];
#define AT_LOAD(j) do { const int key0_ = (j) * 64; kreg = *(const u32x4*)(Kg + (size_t)(b * SEQ + key0_ + srow) * kld + sch * 8); \
        _Pragma("unroll") for (int i_ = 0; i_ < NDT / 2; ++i_) vreg[i_] = *(const u32x4*)(VTg + (size_t)(srow + 64 * i_) * VTLD + key0_ + sch * 8); } while (0)
#define AT_WRITE(pbuf) do { LAS unsigned char* kb_ = F.lds + (pbuf) * BUF; *(LAS u32x4*)(kb_ + srow * at::KST + sch * 16) = kreg; \
        _Pragma("unroll") for (int i_ = 0; i_ < NDT / 2; ++i_) *(LAS u32x4*)(kb_ + at::KT_BYTES + (srow + 64 * i_) * VST2 + sch * 16) = vreg[i_]; } while (0)
    AT_LOAD(jtop); AT_WRITE(0);
    lds_barrier();
    float carry = MODE == 0 ? 1.f : 0.f; bool done_w = false;
    const float c2 = 0.125f * 1.4426950408889634f;
    const float lg = MODE == 1 ? log2f(1.0f - exp2f(-5.0f - (float)h)) : 0.f;
    float bfac[16];
#pragma unroll
    for (int i = 0; i < 16; ++i) bfac[i] = MODE == 1 ? exp2f(-lg * (float)i) : 0.f;
    const int jlo = MODE == 1 ? (q0 >> 6) : 0;
    if (MODE == 1 && qt > 0) {
        unsigned* cnt = (unsigned*)(ws + WS_CTL) + CW_RST + 2048 * l + 64 * (b * 4 + h);
        if (wv == 0) {
            if (lane == 0) { unsigned sp = 0u; while (__hip_atomic_load(cnt, __ATOMIC_RELAXED, __HIP_MEMORY_SCOPE_AGENT) < 7u) { __builtin_amdgcn_s_sleep(2); if (++sp > (1u << 20)) break; } }
            __builtin_amdgcn_fence(__ATOMIC_ACQUIRE, "agent");
            asm volatile("s_waitcnt vmcnt(0)" ::: "memory");
        }
        lds_barrier();
        const float* L0 = (const float*)rst_base(ap, l) + (size_t)((b * 4 + h) * 7) * 8192;
        const float g256 = exp2f(lg * 256.0f);
        LAS unsigned char* stI = F.lds + 65536;
#pragma unroll
        for (int k4 = 0; k4 < 4; ++k4) {
            const int e4 = (F.tid + 512 * k4) * 4;
            f32x4 a = {0.f, 0.f, 0.f, 0.f}; float wg = 1.0f;
            for (int c = qt - 1; c >= 0; --c) { const f32x4 x = *(const f32x4*)(L0 + (size_t)c * 8192 + e4);
                a += x * wg; wg *= g256; }
            *(LAS u32x2*)(stI + (e4 >> 6) * 144 + (e4 & 63) * 2) = (u32x2){pk2(a[0], a[1]), pk2(a[2], a[3])};
        }
        lds_barrier();
#pragma unroll
        for (int d = 0; d < NDT; ++d)
#pragma unroll
            for (int ks = 0; ks < 4; ++ks) o[d] = MFMA32(*(const LAS bf16x8*)(stI + (32 * d + r) * 144 + (16 * ks + 8 * hh) * 2), qf[ks], o[d]);
        const float fq = exp2f(lg * (float)(tq - q0 + 1));
#pragma unroll
        for (int d = 0; d < NDT; ++d) o[d] = o[d] * fq;
    }
    for (int j = jtop, it = 0; ; --j, ++it) {
        const int pbuf = it & 1;
        if (j > jlo) AT_LOAD(j - 1);
        LAS unsigned char* kt = F.lds + pbuf * BUF; LAS unsigned char* vt = kt + at::KT_BYTES;
        const int key0 = j * 64;
        if (!done_w) {
#pragma unroll
            for (int sti = 0; sti < 2; ++sti) {
                const int st = 1 - sti, ks0 = key0 + 32 * st;
                if (ks0 <= qw0 + 31 - (MODE == 0 ? 1 : 0)) {
                    const bool full = (ks0 + 31 < qw0);
                    f32x16 z = {0.f, 0.f, 0.f, 0.f, 0.f, 0.f, 0.f, 0.f, 0.f, 0.f, 0.f, 0.f, 0.f, 0.f, 0.f, 0.f};
#pragma unroll
                    for (int ks = 0; ks < 4; ++ks) z = MFMA32(at::kfrag(kt, 32 * st + kap, ks, hh), qf[ks], z);
                    float w[16];
                    const int kb = ks0 + 16 * hh;
                    if (MODE == 0) {
                        float sg[16], sn[16];
#pragma unroll
                        for (int i = 0; i < 16; i += 2) {
                            const f32x2 a2 = (f32x2){z[i], z[i + 1]} * (f32x2){-c2, -c2};
                            const f32x2 d2 = (f32x2){__builtin_amdgcn_exp2f(a2.x), __builtin_amdgcn_exp2f(a2.y)} + (f32x2){1.f, 1.f};
                            const f32x2 r2 = (f32x2){__builtin_amdgcn_rcpf(d2.x), __builtin_amdgcn_rcpf(d2.y)};
                            const f32x2 n2 = (f32x2){1.f, 1.f} - r2;
                            sg[i] = r2.x; sg[i + 1] = r2.y; sn[i] = n2.x; sn[i + 1] = n2.y;
                        }
                        if (!full) {
#pragma unroll
                            for (int i = 0; i < 16; ++i) { const bool m = (kb + i) < tq; sn[i] = m ? sn[i] : 1.f; sg[i] = m ? sg[i] : 0.f; }
                        }
                        float suf[16];
                        suf[15] = 1.f;
#pragma unroll
                        for (int i = 14; i >= 0; --i) suf[i] = suf[i + 1] * sn[i + 1];
                        const float tot = suf[0] * sn[0], totp = shx(tot, 32, lane);
                        const float base = carry * (hh == 0 ? totp : 1.f);
                        carry *= tot * totp;
#pragma unroll
                        for (int i = 0; i < 16; i += 2) { const f32x2 w2 = (f32x2){sg[i], sg[i + 1]} * ((f32x2){suf[i], suf[i + 1]} * (f32x2){base, base}); w[i] = w2.x; w[i + 1] = w2.y; }
                    } else {
                        const float af = __builtin_amdgcn_exp2f(lg * (float)(tq - kb));
                        if (full) {
#pragma unroll
                            for (int i = 0; i < 16; ++i) w[i] = z[i] * (af * bfac[i]);
                        } else {
#pragma unroll
                            for (int i = 0; i < 16; ++i) w[i] = (kb + i <= tq) ? z[i] * (af * bfac[i]) : 0.f;
                        }
                    }
#pragma unroll
                    for (int s2 = 0; s2 < 2; ++s2) {
                        const bf16x8 pf = pack8(w[8 * s2], w[8 * s2 + 1], w[8 * s2 + 2], w[8 * s2 + 3], w[8 * s2 + 4], w[8 * s2 + 5], w[8 * s2 + 6], w[8 * s2 + 7]);
#pragma unroll
                        for (int d = 0; d < NDT; ++d) o[d] = MFMA32(*(const LAS bf16x8*)(vt + (32 * d + r) * VST2 + (32 * st + 16 * hh + 8 * s2) * 2), pf, o[d]);
                    }
                }
            }
            if (MODE == 0) done_w = __all(carry < 1.1754944e-38f);
        }
        if (j > jlo) AT_WRITE(pbuf ^ 1);
        if (MODE == 0 && F.lane == 0) flags[(it & 1) * 8 + wv] = done_w ? 1u : 0u;
        lds_barrier();
        if (j == jlo) break;
        if (MODE == 0) { unsigned all = 1u;
#pragma unroll
            for (int w8 = 0; w8 < 8; ++w8) all &= flags[(it & 1) * 8 + w8];
            if (all) break; }
    }
#undef AT_LOAD
#undef AT_WRITE
    constexpr int OST = DV * 2 + 16, PPR = DV / 8;
    LAS unsigned char* ob = F.lds + wv * (32 * OST);
    if (MODE == 0) {
        bf16_t* op = R + (size_t)t * RBLD + RB_SBQ + h * 64; const bf16_t* zp = R + (size_t)t * RBLD + RB_SBZ + h * 64;
#pragma unroll
        for (int d = 0; d < NDT; ++d)
#pragma unroll
            for (int g = 0; g < 4; ++g) { const int c = 32 * d + 8 * g + 4 * hh; const u32x2 zz = *(const u32x2*)(zp + c);
                *(LAS u32x2*)(ob + r * OST + c * 2) = (u32x2){pk2(o[d][4 * g] * siluf_(bflo(zz.x)), o[d][4 * g + 1] * siluf_(bfhi(zz.x))), pk2(o[d][4 * g + 2] * siluf_(bflo(zz.y)), o[d][4 * g + 3] * siluf_(bfhi(zz.y)))}; }
#pragma unroll
        for (int k = 0; k < 32 * PPR / 64; ++k) { const int q = k * 64 + lane, row = q / PPR, pc = q % PPR;
            st16_wt(op + (ptrdiff_t)(row - r) * RBLD + pc * 8, *(const LAS u32x4*)(ob + row * OST + pc * 16)); }
    } else {
        float s1 = 0.f;
#pragma unroll
        for (int d = 0; d < NDT; ++d)
#pragma unroll
            for (int i = 0; i < 16; ++i) s1 += o[d][i];
        s1 += shx(s1, 32, lane);
        const float mu = s1 * (1.f / 128.f); float s2 = 0.f;
#pragma unroll
        for (int d = 0; d < NDT; ++d)
#pragma unroll
            for (int i = 0; i < 16; ++i) { const float dl = o[d][i] - mu; s2 += dl * dl; }
        s2 += shx(s2, 32, lane);
        const float rs = rsqrtf(s2 * (1.f / 128.f) + EPS);
        bf16_t* zp = R + (size_t)t * RBLD + RB_RTZ + h * 128; const float* gp = ap->ret_norm_g + (size_t)l * 512 + h * 128;
#pragma unroll
        for (int d = 0; d < NDT; ++d)
#pragma unroll
            for (int g = 0; g < 4; ++g) { const int c = 32 * d + 8 * g + 4 * hh; const u32x2 zz = *(const u32x2*)(zp + c); const f32x4 gg = *(const f32x4*)(gp + c);
                *(LAS u32x2*)(ob + r * OST + c * 2) = (u32x2){pk2((o[d][4 * g] - mu) * rs * gg.x * siluf_(bflo(zz.x)), (o[d][4 * g + 1] - mu) * rs * gg.y * siluf_(bfhi(zz.x))),
                                                             pk2((o[d][4 * g + 2] - mu) * rs * gg.z * siluf_(bflo(zz.y)), (o[d][4 * g + 3] - mu) * rs * gg.w * siluf_(bfhi(zz.y)))}; }
#pragma unroll
        for (int k = 0; k < 32 * PPR / 64; ++k) { const int q = k * 64 + lane, row = q / PPR, pc = q % PPR;
            st16_wt(zp + (ptrdiff_t)(row - r) * RBLD + pc * 8, *(const LAS u32x4*)(ob + row * OST + pc * 16)); }
    }
    unit_done(ws, l, b * 8 + qt, F.tid);
}

namespace dn {
constexpr int HC_BYTES = 73728, OFF_W = 0, OFF_QG = 16384, OFF_KD = 32768, OFF_AI = 49152, OFF_U = 57344;
constexpr int QST = 272, TST = 144;
constexpr int GRP_BYTES = 71680, Q_OFF = 0, K_OFF = 17408, KT_OFF = 34816, VT_OFF = 53248, VEC_OFF = 143360, VEC_BYTES = 2048;
}

DI void dn_prep(int wv, int l, int pair) {
    const Frame F = mkframe(wv);
    const ArgsP ap = kargs();
    unsigned char* ws = ap->ws;
    const int lane = F.lane, r = lane & 31, hh = lane >> 5, grp = wv >> 2, gw = wv & 3, gt = F.tid & 255;
    const int hc = pair * 2 + grp, h = hc & 3, bn = hc >> 2, b = bn >> 5, n = bn & 31, t0 = b * SEQ + n * 64;
    LAS unsigned char* gb = F.lds + grp * dn::GRP_BYTES;
    LAS unsigned char* qimg = gb + dn::Q_OFF; LAS unsigned char* kimg = gb + dn::K_OFF; LAS unsigned char* ktimg = gb + dn::KT_OFF; LAS unsigned char* vtimg = gb + dn::VT_OFF;
    LAS float* vec = (LAS float*)(F.lds + dn::VEC_OFF + grp * dn::VEC_BYTES);
    LAS float* gcv = vec; LAS float* btv = vec + 64; LAS float* f1v = vec + 128; LAS float* f2v = vec + 192; LAS float* egv = vec + 256;
    unsigned char* blk = ws + WS_DNI + (size_t)hc * dn::HC_BYTES;
    const bf16_t* RA = (const bf16_t*)(ws + WS_R); const float* cw = ap->dn_conv_w + (size_t)l * 4 * 1536; const float* AB = (const float*)(ws + WS_AB);
#ifdef PROBE_PREP
    unsigned long long tp0_ = __builtin_amdgcn_s_memrealtime();
#endif
    {
        const int g8 = gt & 15, ch = g8 * 8;
        float abA[4], abB[4];
#pragma unroll
        for (int k = 0; k < 4; ++k) { const int t = t0 + (gt >> 4) + 16 * k; abA[k] = AB[(size_t)t * 8 + h]; abB[k] = AB[(size_t)t * 8 + 4 + h]; }
        const float dtb = ap->dn_dt_bias[l * 4 + h], nalog = -__expf(ap->dn_a_log[l * 4 + h]);
        u32x4 xs[2][2][4]; f32x4 wj[4][2];
#define DNP_LOADX(st_, set_) do { const int col_ = ((st_) >> 1) * 512 + h * 128 + ch; \
        _Pragma("unroll") for (int kk_ = 0; kk_ < 2; ++kk_) _Pragma("unroll") for (int j_ = 0; j_ < 4; ++j_) { const int m_ = (gt >> 4) + 16 * (2 * ((st_) & 1) + kk_); \
            xs[set_][kk_][j_] = (n * 64 + m_ - 3 + j_ >= 0) ? *(const u32x4*)(RA + (size_t)(t0 + m_ - 3 + j_) * RALD + col_) : (u32x4){0u, 0u, 0u, 0u}; } } while (0)
        DNP_LOADX(0, 0);
#pragma unroll
        for (int st = 0; st < 6; ++st) {
            const int part = st >> 1, col = part * 512 + h * 128 + ch;
            if ((st & 1) == 0) {
#pragma unroll
                for (int j = 0; j < 4; ++j) { wj[j][0] = *(const f32x4*)(cw + j * 1536 + col); wj[j][1] = *(const f32x4*)(cw + j * 1536 + col + 4); } }
            if (st < 5) DNP_LOADX(st + 1, (st + 1) & 1);
#pragma unroll
            for (int kk = 0; kk < 2; ++kk) {
                const int m = (gt >> 4) + 16 * (2 * (st & 1) + kk), t = t0 + m;
                float a[8] = {0.f, 0.f, 0.f, 0.f, 0.f, 0.f, 0.f, 0.f};
#pragma unroll
                for (int j = 0; j < 4; ++j) { const u32x4 x = xs[st & 1][kk][j];
                    a[0] += wj[j][0].x * bflo(x.x); a[1] += wj[j][0].y * bfhi(x.x); a[2] += wj[j][0].z * bflo(x.y); a[3] += wj[j][0].w * bfhi(x.y);
                    a[4] += wj[j][1].x * bflo(x.z); a[5] += wj[j][1].y * bfhi(x.z); a[6] += wj[j][1].z * bflo(x.w); a[7] += wj[j][1].w * bfhi(x.w);
                }
                float ssq = 0.f;
#pragma unroll
                for (int i = 0; i < 8; ++i) { a[i] = siluf_(a[i]); ssq += a[i] * a[i]; }
                if (part < 2) {
                    ssq = sum16(ssq);
                    const float rn = rsqrtf(ssq + EPS);
#pragma unroll
                    for (int i = 0; i < 8; ++i) a[i] *= rn;
                } else {
                    const float beta = sigmoidf_(abB[2 * (st & 1) + kk]);
#pragma unroll
                    for (int i = 0; i < 8; ++i) a[i] *= beta;
                }
                const u32x4 pk = (u32x4){pk2(a[0], a[1]), pk2(a[2], a[3]), pk2(a[4], a[5]), pk2(a[6], a[7])};
                if (part == 0) {
                    *(LAS u32x4*)(qimg + m * dn::QST + ch * 2) = pk;
                    if (g8 == 0) { const float xa = abA[2 * (st & 1) + kk] + dtb; const float sp = xa > 20.f ? xa : log1pf(__expf(xa));
                        gcv[m] = nalog * sp; btv[m] = sigmoidf_(abB[2 * (st & 1) + kk]); }
                } else {
                    if (part == 1) *(LAS u32x4*)(kimg + m * dn::QST + ch * 2) = pk;
                    LAS unsigned char* timg = (part == 1 ? ktimg : vtimg) + (((m >> 3) ^ (g8 & 7)) * 16) + (m & 7) * 2;
                    *(LAS unsigned short*)(timg + (ch + 0) * dn::TST) = (unsigned short)pk.x; *(LAS unsigned short*)(timg + (ch + 1) * dn::TST) = (unsigned short)(pk.x >> 16);
                    *(LAS unsigned short*)(timg + (ch + 2) * dn::TST) = (unsigned short)pk.y; *(LAS unsigned short*)(timg + (ch + 3) * dn::TST) = (unsigned short)(pk.y >> 16);
                    *(LAS unsigned short*)(timg + (ch + 4) * dn::TST) = (unsigned short)pk.z; *(LAS unsigned short*)(timg + (ch + 5) * dn::TST) = (unsigned short)(pk.z >> 16);
                    *(LAS unsigned short*)(timg + (ch + 6) * dn::TST) = (unsigned short)pk.w; *(LAS unsigned short*)(timg + (ch + 7) * dn::TST) = (unsigned short)(pk.w >> 16);
                }
            }
        }
#undef DNP_LOADX
    }
    lds_barrier();
#ifdef PROBE_PREP
    if (PROBE_PREP == 1) { const unsigned long long t1_ = __builtin_amdgcn_s_memrealtime(); const unsigned long long d_ = t1_ - tp0_; while (__builtin_amdgcn_s_memrealtime() - t1_ < d_) __builtin_amdgcn_s_sleep(2); }
    tp0_ = __builtin_amdgcn_s_memrealtime();
#endif
    if (gw == 0) {
        float gc = gcv[lane];
#pragma unroll
        for (int off = 1; off < 64; off <<= 1) { const float o = shx(gc, 0, lane - off < 0 ? lane : lane - off) ; gc += (lane >= off) ? o : 0.f; }
        const float glast = shx(gc, 0, 63);
        const float eg = __expf(gc);
        gcv[lane] = gc; f1v[lane] = btv[lane] * eg; f2v[lane] = __expf(glast - gc); egv[lane] = eg * 0.08838834764831845f;
        if (lane == 0) ((float*)(ws + WS_GB))[hc] = __expf(glast);
    }
    lds_barrier();
    f32x16 Lt = {0.f, 0.f, 0.f, 0.f, 0.f, 0.f, 0.f, 0.f, 0.f, 0.f, 0.f, 0.f, 0.f, 0.f, 0.f, 0.f};
    if (gw < 3) {
        {
            const int ct = gw == 0 ? 0 : 1, mt = gw == 2 ? 1 : 0;
            f32x16 acc = {0.f, 0.f, 0.f, 0.f, 0.f, 0.f, 0.f, 0.f, 0.f, 0.f, 0.f, 0.f, 0.f, 0.f, 0.f, 0.f};
#pragma unroll
            for (int ks = 0; ks < 8; ++ks) acc = MFMA32(*(const LAS bf16x8*)(kimg + (32 * ct + r) * dn::QST + ks * 32 + hh * 16), *(const LAS bf16x8*)(kimg + (32 * mt + r) * dn::QST + ks * 32 + hh * 16), acc);
            const int m = 32 * mt + r; const float gm = gcv[m];
#pragma unroll
            for (int i = 0; i < 16; ++i) { const int c = 32 * ct + crow(i, hh); Lt[i] = (m < c) ? acc[i] * btv[c] * __expf(gcv[c] - gm) : 0.f; }
        }
        {
            const int mt = gw == 2 ? 1 : 0, ct = gw == 0 ? 0 : 1;
            f32x16 acc = {0.f, 0.f, 0.f, 0.f, 0.f, 0.f, 0.f, 0.f, 0.f, 0.f, 0.f, 0.f, 0.f, 0.f, 0.f, 0.f};
#pragma unroll
            for (int ks = 0; ks < 8; ++ks) acc = MFMA32(*(const LAS bf16x8*)(kimg + (32 * mt + r) * dn::QST + ks * 32 + hh * 16), *(const LAS bf16x8*)(qimg + (32 * ct + r) * dn::QST + ks * 32 + hh * 16), acc);
            const int c = 32 * ct + r; const float gcc = gcv[c]; float v[16];
#pragma unroll
            for (int i = 0; i < 16; ++i) { const int m = 32 * mt + crow(i, hh); v[i] = (m <= c) ? acc[i] * __expf(gcc - gcv[m]) * 0.08838834764831845f : 0.f; }
#pragma unroll
            for (int s2 = 0; s2 < 2; ++s2) *(bf16x8*)(blk + dn::OFF_AI + ((ct * 2 + mt) * 2 + s2) * 1024 + lane * 16) = pack8(v[8 * s2], v[8 * s2 + 1], v[8 * s2 + 2], v[8 * s2 + 3], v[8 * s2 + 4], v[8 * s2 + 5], v[8 * s2 + 6], v[8 * s2 + 7]);
        }
    } else {
#pragma unroll 1
        for (int f = 0; f < 16; ++f) { const int ct = f >> 3, tau = (f >> 1) & 3, s2 = f & 1, c = 32 * ct + r; const float e = egv[c];
            const LAS unsigned char* pp = qimg + c * dn::QST + (32 * tau + 16 * s2 + 4 * hh) * 2; const u32x2 lo = *(const LAS u32x2*)pp, hi = *(const LAS u32x2*)(pp + 16);
            *(bf16x8*)(blk + dn::OFF_QG + f * 1024 + lane * 16) = pack8(bflo(lo.x) * e, bfhi(lo.x) * e, bflo(lo.y) * e, bfhi(lo.y) * e, bflo(hi.x) * e, bfhi(hi.x) * e, bflo(hi.y) * e, bfhi(hi.y) * e); }
#pragma unroll 1
        for (int f = 0; f < 16; ++f) { const int tau = f >> 2, m0 = 32 * ((f >> 1) & 1) + 16 * (f & 1) + 4 * hh;
            const int sw = (4 * tau + (r >> 3)) & 7; const LAS unsigned char* rowp = ktimg + (32 * tau + r) * dn::TST + (m0 & 7) * 2;
            const u32x2 lo = *(const LAS u32x2*)(rowp + (((m0 >> 3) ^ sw) * 16)), hi = *(const LAS u32x2*)(rowp + ((((m0 >> 3) + 1) ^ sw) * 16));
            const f32x4 fa = *(const LAS f32x4*)(f2v + m0), fb = *(const LAS f32x4*)(f2v + m0 + 8);
            *(bf16x8*)(blk + dn::OFF_KD + f * 1024 + lane * 16) = pack8(bflo(lo.x) * fa.x, bfhi(lo.x) * fa.y, bflo(lo.y) * fa.z, bfhi(lo.y) * fa.w, bflo(hi.x) * fb.x, bfhi(hi.x) * fb.y, bflo(hi.y) * fb.z, bfhi(hi.y) * fb.w); }
    }
    lds_barrier();
    LAS float* Lm = (LAS float*)qimg;
    if (gw < 3) { const int ct = gw == 0 ? 0 : 1, mt = gw == 2 ? 1 : 0;
#pragma unroll
        for (int i = 0; i < 16; ++i) Lm[(32 * ct + crow(i, hh)) * 64 + 32 * mt + r] = Lt[i]; }
    lds_barrier();
#ifdef PROBE_PREP
    if (PROBE_PREP == 2) { const unsigned long long t1_ = __builtin_amdgcn_s_memrealtime(); const unsigned long long d_ = t1_ - tp0_; while (__builtin_amdgcn_s_memrealtime() - t1_ < d_) __builtin_amdgcn_s_sleep(2); }
    tp0_ = __builtin_amdgcn_s_memrealtime();
#endif
    if (gw == 0) {
        const LAS float* Lb = Lm + (32 * hh) * 64 + 32 * hh;
        const int jc = lane & 31;
        float Tc[32];
#pragma unroll
        for (int i = 0; i < 32; ++i) {
            float a0 = (i == jc) ? 1.f : 0.f, a1 = 0.f, a2 = 0.f, a3 = 0.f;
#pragma unroll
            for (int k4 = 0; k4 < (i + 3) / 4; ++k4) { const f32x4 lv = *(const LAS f32x4*)(Lb + i * 64 + 4 * k4);
                if (4 * k4 + 0 < i) a0 -= lv.x * Tc[4 * k4 + 0]; if (4 * k4 + 1 < i) a1 -= lv.y * Tc[4 * k4 + 1];
                if (4 * k4 + 2 < i) a2 -= lv.z * Tc[4 * k4 + 2]; if (4 * k4 + 3 < i) a3 -= lv.w * Tc[4 * k4 + 3]; }
            Tc[i] = (a0 + a1) + (a2 + a3);
        }
        LDS_WAIT(); asm volatile("" ::: "memory");
        LAS unsigned char* timg = kimg; LAS unsigned char* t00t = kimg + 64 * dn::TST;
#pragma unroll
        for (int i = 0; i < 32; ++i) *(LAS unsigned short*)(timg + (32 * hh + i) * dn::TST + (32 * hh + jc) * 2) = (unsigned short)f2bf(Tc[i]);
        if (hh == 0) {
#pragma unroll
            for (int q = 0; q < 4; ++q) { *(LAS u32x4*)(t00t + jc * 80 + 16 * q) = (u32x4){pk2(Tc[8 * q], Tc[8 * q + 1]), pk2(Tc[8 * q + 2], Tc[8 * q + 3]), pk2(Tc[8 * q + 4], Tc[8 * q + 5]), pk2(Tc[8 * q + 6], Tc[8 * q + 7])};
                *(LAS u32x4*)(timg + jc * dn::TST + 64 + 16 * q) = (u32x4){0u, 0u, 0u, 0u}; }
        }
        LDS_WAIT(); asm volatile("" ::: "memory");
        f32x16 X = {0.f, 0.f, 0.f, 0.f, 0.f, 0.f, 0.f, 0.f, 0.f, 0.f, 0.f, 0.f, 0.f, 0.f, 0.f, 0.f};
#pragma unroll
        for (int s2 = 0; s2 < 2; ++s2) { const f32x4 la = *(const LAS f32x4*)(Lm + (32 + r) * 64 + 16 * s2 + 8 * hh), lb = *(const LAS f32x4*)(Lm + (32 + r) * 64 + 16 * s2 + 8 * hh + 4);
            X = MFMA32(pack8(la.x, la.y, la.z, la.w, lb.x, lb.y, lb.z, lb.w), *(const LAS bf16x8*)(t00t + r * 80 + (16 * s2 + 8 * hh) * 2), X); }
        f32x16 Y = {0.f, 0.f, 0.f, 0.f, 0.f, 0.f, 0.f, 0.f, 0.f, 0.f, 0.f, 0.f, 0.f, 0.f, 0.f, 0.f};
#pragma unroll
        for (int s2 = 0; s2 < 2; ++s2) { const LAS unsigned char* pp = timg + (32 + r) * dn::TST + (32 + 16 * s2 + 4 * hh) * 2; const u32x2 lo = *(const LAS u32x2*)pp, hi = *(const LAS u32x2*)(pp + 16);
            u32x4 af; af.x = lo.x; af.y = lo.y; af.z = hi.x; af.w = hi.y;
            Y = MFMA32(__builtin_bit_cast(bf16x8, af), pack8m(X[8 * s2], X[8 * s2 + 1], X[8 * s2 + 2], X[8 * s2 + 3], X[8 * s2 + 4], X[8 * s2 + 5], X[8 * s2 + 6], X[8 * s2 + 7]), Y); }
#pragma unroll
        for (int i = 0; i < 16; ++i) *(LAS unsigned short*)(timg + (32 + crow(i, hh)) * dn::TST + r * 2) = (unsigned short)f2bf(-Y[i]);
    }
    lds_barrier();
#ifdef PROBE_PREP
    if (PROBE_PREP == 3) { const unsigned long long t1_ = __builtin_amdgcn_s_memrealtime(); const unsigned long long d_ = t1_ - tp0_; while (__builtin_amdgcn_s_memrealtime() - t1_ < d_) __builtin_amdgcn_s_sleep(2); }
    tp0_ = __builtin_amdgcn_s_memrealtime();
#endif
    {
        LAS unsigned char* timg = kimg;
        bf16x8 afr[4];
#pragma unroll
        for (int s4 = 0; s4 < 4; ++s4) { const u32x4 x = *(const LAS u32x4*)(ktimg + (32 * gw + r) * dn::TST + (((2 * s4 + hh) ^ ((4 * gw + (r >> 3)) & 7)) * 16));
            const f32x4 fa = *(const LAS f32x4*)(f1v + 16 * s4 + 8 * hh), fb = *(const LAS f32x4*)(f1v + 16 * s4 + 8 * hh + 4);
            afr[s4] = pack8(-bflo(x.x) * fa.x, -bfhi(x.x) * fa.y, -bflo(x.y) * fa.z, -bfhi(x.y) * fa.w, -bflo(x.z) * fb.x, -bfhi(x.z) * fb.y, -bflo(x.w) * fb.z, -bfhi(x.w) * fb.w); }
#pragma unroll
        for (int ct = 0; ct < 2; ++ct) {
            f32x16 acc = {0.f, 0.f, 0.f, 0.f, 0.f, 0.f, 0.f, 0.f, 0.f, 0.f, 0.f, 0.f, 0.f, 0.f, 0.f, 0.f};
#pragma unroll
            for (int s4 = 0; s4 < 4; ++s4) acc = MFMA32(afr[s4], *(const LAS bf16x8*)(timg + (32 * ct + r) * dn::TST + s4 * 32 + hh * 16), acc);
#pragma unroll
            for (int s2 = 0; s2 < 2; ++s2) *(bf16x8*)(blk + dn::OFF_W + ((ct * 4 + gw) * 2 + s2) * 1024 + lane * 16) = pack8m(acc[8 * s2], acc[8 * s2 + 1], acc[8 * s2 + 2], acc[8 * s2 + 3], acc[8 * s2 + 4], acc[8 * s2 + 5], acc[8 * s2 + 6], acc[8 * s2 + 7]);
        }
#pragma unroll
        for (int ct = 0; ct < 2; ++ct) {
            f32x16 acc = {0.f, 0.f, 0.f, 0.f, 0.f, 0.f, 0.f, 0.f, 0.f, 0.f, 0.f, 0.f, 0.f, 0.f, 0.f, 0.f};
#pragma unroll
            for (int s4 = 0; s4 < 4; ++s4) acc = MFMA32(*(const LAS bf16x8*)(timg + (32 * ct + r) * dn::TST + s4 * 32 + hh * 16), *(const LAS bf16x8*)(vtimg + (32 * gw + r) * dn::TST + (((2 * s4 + hh) ^ ((4 * gw + (r >> 3)) & 7)) * 16)), acc);
#pragma unroll
            for (int s2 = 0; s2 < 2; ++s2) *(bf16x8*)(blk + dn::OFF_U + ((ct * 4 + gw) * 2 + s2) * 1024 + lane * 16) = pack8m(acc[8 * s2], acc[8 * s2 + 1], acc[8 * s2 + 2], acc[8 * s2 + 3], acc[8 * s2 + 4], acc[8 * s2 + 5], acc[8 * s2 + 6], acc[8 * s2 + 7]);
        }
    }
    lds_barrier();
}

DI void dn_scan(int wv, int l, int bh) {
    const Frame F = mkframe(wv);
    const ArgsP ap = kargs();
    unsigned char* ws = ap->ws; bf16_t* P = (bf16_t*)(ws + WS_P);
    const int lane = F.lane, hh = lane >> 5, b = bh >> 2, h = bh & 3, w4 = wv & 3;
    LAS float* part = (LAS float*)(F.lds + 2 * dn::HC_BYTES);
    LAS float* gnl = part + 512;
    LAS float* decs = gnl + 128;
    if (F.tid < 128) gnl[F.tid] = ap->dn_norm_g[l * 128 + F.tid];
    if (F.tid < 32) decs[F.tid] = ((const float*)(ws + WS_GB))[(size_t)(b * 32 + F.tid) * 4 + h];
    const size_t hc_stride = 4 * (size_t)dn::HC_BYTES;
    const unsigned char* blk0 = ws + WS_DNI + ((size_t)(b * 32) * 4 + h) * dn::HC_BYTES;
#define DN_PIECE(src_, pbuf, pc_) __builtin_amdgcn_global_load_lds((const unsigned*)((src_) + (pc_) * 1024 + lane * 16), (LAS unsigned*)(F.lds + (pbuf) * dn::HC_BYTES + (pc_) * 1024), 16, 0, 0)
#define DN_LOAD(nn, pbuf) do { const unsigned char* src_ = blk0 + (size_t)(nn) * hc_stride; \
        if (wv < 4) { _Pragma("unroll") for (int i_ = 0; i_ < 9; ++i_) DN_PIECE(src_, pbuf, wv * 9 + i_); } \
        else { _Pragma("unroll") for (int i_ = 0; i_ < 5; ++i_) DN_PIECE(src_, pbuf, 36 + 5 * w4 + i_); \
               DN_PIECE(src_, pbuf, 56 + 2 * w4); DN_PIECE(src_, pbuf, 57 + 2 * w4); DN_PIECE(src_, pbuf, 64 + 2 * w4); DN_PIECE(src_, pbuf, 65 + 2 * w4); } } while (0)
    DN_LOAD(0, 0);
    f32x16 S[4];
#pragma unroll
    for (int i = 0; i < 4; ++i) S[i] = (f32x16){0.f, 0.f, 0.f, 0.f, 0.f, 0.f, 0.f, 0.f, 0.f, 0.f, 0.f, 0.f, 0.f, 0.f, 0.f, 0.f};
    u32x4 heldO[4], zO[4];
#pragma unroll
    for (int i = 0; i < 4; ++i) { heldO[i] = (u32x4){0u, 0u, 0u, 0u}; zO[i] = heldO[i]; }
    VM_WAIT(); __syncthreads();
    if (wv < 4) {
    for (int k = 0; k < 34; ++k) {
        const int pbuf = k & 1;
#ifdef PROBE_SCANC
        const unsigned long long tc0_ = __builtin_amdgcn_s_memrealtime();
#endif
        LAS unsigned char* buf = F.lds + pbuf * dn::HC_BYTES;
        {
            if (k + 1 < 32) DN_LOAD(k + 1, pbuf ^ 1);
            if (k < 32) {
                const float dec = decs[k];
                f32x16 vn[2], o[2];
#pragma unroll
                for (int ct = 0; ct < 2; ++ct) {
                    o[ct] = (f32x16){0.f, 0.f, 0.f, 0.f, 0.f, 0.f, 0.f, 0.f, 0.f, 0.f, 0.f, 0.f, 0.f, 0.f, 0.f, 0.f};
#pragma unroll
                    for (int s2 = 0; s2 < 2; ++s2) { const u32x4 x = *(const LAS u32x4*)(buf + dn::OFF_U + ((ct * 4 + wv) * 2 + s2) * 1024 + lane * 16);
                        vn[ct][8 * s2] = bflo(x.x); vn[ct][8 * s2 + 1] = bfhi(x.x); vn[ct][8 * s2 + 2] = bflo(x.y); vn[ct][8 * s2 + 3] = bfhi(x.y);
                        vn[ct][8 * s2 + 4] = bflo(x.z); vn[ct][8 * s2 + 5] = bfhi(x.z); vn[ct][8 * s2 + 6] = bflo(x.w); vn[ct][8 * s2 + 7] = bfhi(x.w); }
                }
#define DN_F(off) (*(const LAS bf16x8*)(buf + (off) + lane * 16))
#define DN_WQ(ct, st) ((((ct) * 4 + ((st) >> 1)) * 2 + ((st) & 1)) * 1024)
                bf16x8 fa[4], fb[6];
                fa[0] = DN_F(dn::OFF_W + DN_WQ(0, 0)); fa[1] = DN_F(dn::OFF_QG + DN_WQ(0, 0)); fa[2] = DN_F(dn::OFF_W + DN_WQ(1, 0)); fa[3] = DN_F(dn::OFF_QG + DN_WQ(1, 0));
#pragma unroll
                for (int st = 0; st < 8; ++st) {
                    const int tau = st >> 1, s2 = st & 1;
                    if (st < 7) { fb[0] = DN_F(dn::OFF_W + DN_WQ(0, st + 1)); fb[1] = DN_F(dn::OFF_QG + DN_WQ(0, st + 1)); fb[2] = DN_F(dn::OFF_W + DN_WQ(1, st + 1)); fb[3] = DN_F(dn::OFF_QG + DN_WQ(1, st + 1)); }
                    else { fb[0] = DN_F(dn::OFF_AI + 0 * 1024); fb[1] = DN_F(dn::OFF_AI + 4 * 1024); fb[2] = DN_F(dn::OFF_KD + 0 * 1024); fb[3] = DN_F(dn::OFF_KD + 4 * 1024); fb[4] = DN_F(dn::OFF_KD + 8 * 1024); fb[5] = DN_F(dn::OFF_KD + 12 * 1024); }
                    __builtin_amdgcn_sched_barrier(0);
                    const bf16x8 sf = pack8m(S[tau][8 * s2], S[tau][8 * s2 + 1], S[tau][8 * s2 + 2], S[tau][8 * s2 + 3], S[tau][8 * s2 + 4], S[tau][8 * s2 + 5], S[tau][8 * s2 + 6], S[tau][8 * s2 + 7]);
                    vn[0] = MFMA32(fa[0], sf, vn[0]); o[0] = MFMA32(fa[1], sf, o[0]); vn[1] = MFMA32(fa[2], sf, vn[1]); o[1] = MFMA32(fa[3], sf, o[1]);
                    __builtin_amdgcn_sched_barrier(0);
                    if (st < 7) { fa[0] = fb[0]; fa[1] = fb[1]; fa[2] = fb[2]; fa[3] = fb[3]; }
                }
#pragma unroll
                for (int tau = 0; tau < 4; ++tau) S[tau] = S[tau] * dec;
                bf16x8 fc[6];
#pragma unroll
                for (int g = 0; g < 4; ++g) {
                    const int cm = g >> 1, s2 = g & 1;
                    if (g < 3) { const int cm1 = (g + 1) >> 1, s21 = (g + 1) & 1;
                        fc[0] = DN_F(dn::OFF_AI + ((cm1 * 2 + cm1) * 2 + s21) * 1024); fc[1] = DN_F(dn::OFF_AI + ((1 * 2 + cm1) * 2 + s21) * 1024);
#pragma unroll
                        for (int tau = 0; tau < 4; ++tau) fc[2 + tau] = DN_F(dn::OFF_KD + ((tau * 2 + cm1) * 2 + s21) * 1024); }
                    __builtin_amdgcn_sched_barrier(0);
                    const bf16x8 vf = pack8m(vn[cm][8 * s2], vn[cm][8 * s2 + 1], vn[cm][8 * s2 + 2], vn[cm][8 * s2 + 3], vn[cm][8 * s2 + 4], vn[cm][8 * s2 + 5], vn[cm][8 * s2 + 6], vn[cm][8 * s2 + 7]);
                    if (cm == 0) o[0] = MFMA32(fb[0], vf, o[0]);
                    o[1] = MFMA32(fb[1], vf, o[1]);
#pragma unroll
                    for (int tau = 0; tau < 4; ++tau) S[tau] = MFMA32(fb[2 + tau], vf, S[tau]);
                    __builtin_amdgcn_sched_barrier(0);
                    if (g < 3) {
#pragma unroll
                        for (int q = 0; q < 6; ++q) fb[q] = fc[q]; }
                }
#undef DN_F
#undef DN_WQ
                LDS_WAIT(); __builtin_amdgcn_sched_barrier(0); asm volatile("s_nop 15\n\ts_nop 3" ::: "memory"); __builtin_amdgcn_sched_barrier(0);
#pragma unroll
                for (int ct = 0; ct < 2; ++ct)
#pragma unroll
                    for (int i = 0; i < 16; i += 2) { const int c = 32 * ct + crow(i, hh), q = c >> 4; const unsigned u2 = pk2(o[ct][i], o[ct][i + 1]);
                        LAS unsigned char* wp = buf + dn::OFF_U + (((q >> 1) * 4 + wv) * 2 + (q & 1)) * 1024 + (c & 15) * 64 + (lane & 31) * 2;
                        *(LAS unsigned short*)wp = (unsigned short)u2; *(LAS unsigned short*)(wp + 64) = (unsigned short)(u2 >> 16); }
            }
        }
#ifdef PROBE_SCANC
        { const unsigned long long tc1_ = __builtin_amdgcn_s_memrealtime(); const unsigned long long d_ = tc1_ - tc0_; while (__builtin_amdgcn_s_memrealtime() - tc1_ < d_) __builtin_amdgcn_s_sleep(2); }
#endif
        asm volatile("s_waitcnt vmcnt(0)" ::: "memory");
        lds_barrier();
    }
    } else {
    u32x4 heldN[4], zN[4];
#pragma unroll
    for (int i = 0; i < 4; ++i) { heldN[i] = (u32x4){0u, 0u, 0u, 0u}; zN[i] = heldN[i]; }
    unsigned td0 = 0u, td1 = 0u, td2 = 0u;
    for (int k = 0; k < 34; ++k) {
        const int pbuf = k & 1;
#ifdef PROBE_SCANH
        const unsigned long long th0_ = __builtin_amdgcn_s_memrealtime();
#endif
        const bool rows = (k >= 1 && k <= 32);
        if (rows) {
            const int nn = k - 1; LAS unsigned char* pb = F.lds + (nn & 1) * dn::HC_BYTES;
            const int q = lane >> 4; const LAS unsigned char* rp = pb + dn::OFF_U + (((q >> 1) * 4 + w4) * 2 + (q & 1)) * 1024 + (lane & 15) * 64;
            float ssq = 0.f;
#pragma unroll
            for (int i = 0; i < 4; ++i) { const u32x4 hv = *(const LAS u32x4*)(rp + 16 * i); heldN[i] = hv;
                ssq += bflo(hv.x) * bflo(hv.x) + bfhi(hv.x) * bfhi(hv.x) + bflo(hv.y) * bflo(hv.y) + bfhi(hv.y) * bfhi(hv.y)
                     + bflo(hv.z) * bflo(hv.z) + bfhi(hv.z) * bfhi(hv.z) + bflo(hv.w) * bflo(hv.w) + bfhi(hv.w) * bfhi(hv.w); }
            part[((nn & 1) * 64 + lane) * 4 + w4] = ssq;
        }
        LDS_WAIT(); asm volatile("" ::: "memory");
        if (k + 1 < 32) DN_LOAD(k + 1, pbuf ^ 1);
        __builtin_amdgcn_sched_barrier(0);
        if (rows) { const bf16_t* zp = P + (size_t)(b * SEQ + (k - 1) * 64 + lane) * PLD + P_DNZ + h * 128 + 32 * w4;
#pragma unroll
            for (int i = 0; i < 4; ++i) zN[i] = *(const u32x4*)(zp + 8 * i); }
        __builtin_amdgcn_sched_barrier(0);
#ifdef SCAN_TOUCH_ON
        if (k + 2 < 32) {
            const unsigned char* tb = blk0 + (size_t)(k + 2) * hc_stride + (size_t)(w4 * 144) * 128;
            const unsigned char* a0 = tb + lane * 128; const unsigned char* a1 = tb + (64 + lane) * 128; const unsigned char* a2 = tb + (128 + (lane & 15)) * 128;
            asm volatile("; SCAN_TOUCH\n\tglobal_load_dword %0, %3, off\n\tglobal_load_dword %1, %4, off\n\tglobal_load_dword %2, %5, off" : "+v"(td0), "+v"(td1), "+v"(td2) : "v"(a0), "v"(a1), "v"(a2) : "memory");
        }
        __builtin_amdgcn_sched_barrier(0);
#endif
        u32x4 wo[4];
        if (k >= 2) {
            const int nn = k - 2; const f32x4 p4 = *(const LAS f32x4*)(part + ((nn & 1) * 64 + lane) * 4);
            const float rs = rsqrtf(((p4.x + p4.y) + (p4.z + p4.w)) * (1.f / 128.f) + EPS);
#pragma unroll
            for (int q = 0; q < 4; ++q) { const u32x4 zz = zO[q], hv = heldO[q]; const f32x4 ga = *(const LAS f32x4*)(gnl + 32 * w4 + 8 * q), gb = *(const LAS f32x4*)(gnl + 32 * w4 + 8 * q + 4);
                wo[q].x = pk2(bflo(hv.x) * rs * ga.x * siluf_(bflo(zz.x)), bfhi(hv.x) * rs * ga.y * siluf_(bfhi(zz.x)));
                wo[q].y = pk2(bflo(hv.y) * rs * ga.z * siluf_(bflo(zz.y)), bfhi(hv.y) * rs * ga.w * siluf_(bfhi(zz.y)));
                wo[q].z = pk2(bflo(hv.z) * rs * gb.x * siluf_(bflo(zz.z)), bfhi(hv.z) * rs * gb.y * siluf_(bfhi(zz.z)));
                wo[q].w = pk2(bflo(hv.w) * rs * gb.z * siluf_(bflo(zz.w)), bfhi(hv.w) * rs * gb.w * siluf_(bfhi(zz.w))); }
        }
#ifdef SCAN_TOUCH_ON
        if (k + 2 < 32) asm volatile("; SCAN_E\n\ts_waitcnt vmcnt(3)" ::: "memory"); else
#endif
        asm volatile("s_waitcnt vmcnt(0)" ::: "memory");
        if (k >= 2) { bf16_t* zp = P + (size_t)(b * SEQ + (k - 2) * 64 + lane) * PLD + P_DNZ + h * 128 + 32 * w4;
#pragma unroll
            for (int q = 0; q < 4; ++q) *(u32x4*)(zp + 8 * q) = wo[q]; }
#pragma unroll
        for (int i = 0; i < 4; ++i) { heldO[i] = heldN[i]; zO[i] = zN[i]; }
#ifdef PROBE_SCANH
        { const unsigned long long th1_ = __builtin_amdgcn_s_memrealtime(); const unsigned long long d_ = th1_ - th0_; while (__builtin_amdgcn_s_memrealtime() - th1_ < d_) __builtin_amdgcn_s_sleep(2); }
#endif
        lds_barrier();
    }
    asm volatile("s_waitcnt vmcnt(0)" : "+v"(td0), "+v"(td1), "+v"(td2) :: "memory");
    }
#undef DN_LOAD
#undef DN_PIECE
}

DI void final_norm(int wv) {
    const Frame F = mkframe(wv);
    const ArgsP ap = kargs();
    const float* ss = (const float*)(ap->ws + WS_SS);
    for (int m = F.gw; m < T; m += F.NGW) {
        const f32x4 s = *(const f32x4*)(ss + (size_t)m * 4); const float rs = rsqrtf(((s.x + s.y) + (s.z + s.w)) * (1.f / D) + EPS);
        f32x4* xr = (f32x4*)(ap->out + (size_t)m * D) + F.lane; const f32x4* gr = (const f32x4*)ap->final_norm_g + F.lane;
#pragma unroll
        for (int j = 0; j < 4; ++j) { const f32x4 v = xr[64 * j], g = gr[64 * j]; xr[64 * j] = v * rs * g; }
    }
}

__global__ void __launch_bounds__(NTHREADS, 2) mk_fwd(Args args) {
    extern __shared__ __attribute__((aligned(16))) unsigned char lds_raw[];
    LAS unsigned char* const lds = (LAS unsigned char*)lds_raw;
    volatile LAS unsigned* MISC = (volatile LAS unsigned*)(lds + MISC_OFF);
    const int wv = __builtin_amdgcn_readfirstlane((int)threadIdx.x >> 6);
    { const int t0 = opaque_tid(wv); for (int u = t0; u < (LDS_BYTES - LDSCTL_OFF) / 4; u += NTHREADS) ((LAS unsigned*)(lds + LDSCTL_OFF))[u] = 0u; }
    __syncthreads();
    const int G = gridDim.x;
    XcdBarrier bar; bar.bar = (unsigned*)(args.ws + WS_CTL) + CW_BAR + args.li * XCD_BAR_WORDS; bar.x = 0; bar.st = nullptr;
    if (args.ph_hi - args.ph_lo > 1) bar = xcd_barrier_post(bar.bar, MISC + 8, wv);
#define IN(k) (kargs()->ph_lo <= (k) && (k) < kargs()->ph_hi)
#ifdef PROBE_SUB
    unsigned long long ts_prev_ = 0;
#define SUBSEAM(bit) do { xcd_barrier(bar, wv); { const unsigned long long t1_ = __builtin_amdgcn_s_memrealtime(); \
        if ((PROBE_SUB >> (bit)) & 1u) { const unsigned long long d_ = t1_ - ts_prev_; while (__builtin_amdgcn_s_memrealtime() - t1_ < d_) __builtin_amdgcn_s_sleep(8); } \
        ts_prev_ = __builtin_amdgcn_s_memrealtime(); } } while (0)
#define SUBSTART() do { ts_prev_ = __builtin_amdgcn_s_memrealtime(); } while (0)
#else
#define SUBSEAM(bit) do { } while (0)
#define SUBSTART() do { } while (0)
#endif
#ifdef PROBE_ECHO
    unsigned long long t_prev_ = __builtin_amdgcn_s_memrealtime();
#define SEAM(k) do { if (IN(k) && IN((k) + 1)) xcd_barrier(bar, wv); { const unsigned long long t1_ = __builtin_amdgcn_s_memrealtime(); \
        if ((PROBE_ECHO >> (k)) & 1u) { const unsigned long long d_ = t1_ - t_prev_; while (__builtin_amdgcn_s_memrealtime() - t1_ < d_) __builtin_amdgcn_s_sleep(8); } \
        t_prev_ = __builtin_amdgcn_s_memrealtime(); } } while (0)
#else
#define SEAM(k) do { if (IN(k) && IN((k) + 1)) xcd_barrier(bar, wv); } while (0)
#endif
#define MK_EPI(E) gm::Epi E; E.ws = kargs()->ws; E.xin = nullptr; E.xout = nullptr; E.b_gate = nullptr; E.gnext = nullptr; E.gfinal = nullptr; E.spare = (LAS float*)(lds + SPARE_OFF);

#if !defined(ONLY_PH) || ONLY_PH == 0
    if (IN(0)) { p0_prologue(wv); }
#endif
    SEAM(0);

    for (int l0 = 0; l0 < DEPTH; ++l0) {
        int l = l0; asm volatile("" : "+s"(l));
        const int pb = 1 + 6 * l;
#if !defined(ONLY_PH) || ONLY_PH == 1
        if (IN(pb)) { MK_EPI(E); SchedP1 S; S.ord.init(64, 12, G, opaque_bid()); S.ws = kargs()->ws; S.l = l; S.half = 0; S.c = opaque_bid(); S.with_kvm = false;
            gm::gemm_phase<AUX_P1>(lds, wv, S, E);
#ifdef PROBE_DUP_GEMM
            xcd_barrier(bar, wv); gm::gemm_phase<AUX_P1>(lds, wv, S, E);
#endif
            }
#endif
        SEAM(pb);
#if !defined(ONLY_PH) || ONLY_PH == 2
        if (IN(pb + 1)) {
            SUBSTART();
            SUBSEAM(0);
            for (int pair = opaque_bid(); pair < 512; pair += G) dn_prep(wv, l, pair);
            SUBSEAM(1);
            if (l > 0) { const Frame Fm = mkframe(wv); memn_rows(Fm, kargs(), l); }
 }
#endif
        SEAM(pb + 1);
#if !defined(ONLY_PH) || ONLY_PH == 3
        if (IN(pb + 2)) {
            if (opaque_bid() < 32 && G > 64) dn_scan(wv, l, opaque_bid());
            else { const bool split = G > 64; MK_EPI(E); SchedP1 S; S.ord.init(64, 12, split ? G - 32 : G, split ? opaque_bid() - 32 : opaque_bid()); S.ws = kargs()->ws; S.l = l; S.half = 1; S.c = opaque_bid(); S.with_kvm = true;
                gm::gemm_phase<AUX_P1>(lds, wv, S, E);
#ifdef PROBE_DUP_GEMM
                xcd_barrier(bar, wv); gm::gemm_phase<AUX_P1>(lds, wv, S, E);
#endif
                { const int cp = opaque_bid() - 32; const Frame Fc = mkframe(wv);
                  const int nsh = cp >= 112 ? 3 : 1, sh0 = cp >= 112 ? 3 * (cp - 112) : 336 + cp;
                  for (int q = 0; q < nsh; ++q) { const int first = (sh0 + q) * NWAVES + wv, stride = 448 * NWAVES;
                      if (l == 0) convert_weights(Fc, kargs(), 0, first, stride, 2);
                      if (l + 1 < DEPTH) convert_weights(Fc, kargs(), l + 1, first, stride, 0); } }
            }
            if (G <= 64) { for (int bh = opaque_bid(); bh < 32; bh += G) dn_scan(wv, l, bh); }
        }
#endif
        SEAM(pb + 2);
#if !defined(ONLY_PH) || ONLY_PH == 4
        if (IN(pb + 3)) {
            const int wg = opaque_bid();

            unsigned* head = (unsigned*)(kargs()->ws + WS_CTL) + CW_QUEUE + 64 * l;
            volatile LAS unsigned* qslot = (volatile LAS unsigned*)(lds + MISC_OFF + 64);
            for (;;) {
#ifdef PROBE_FETCH
                const unsigned long long tf0_ = __builtin_amdgcn_s_memrealtime();
#endif
                if (opaque_tid(wv) == 0) qslot[0] = __hip_atomic_fetch_add(head, 1u, __ATOMIC_RELAXED, __HIP_MEMORY_SCOPE_AGENT);
                __syncthreads();
                const int unit = (int)qslot[0];
                __syncthreads();
#ifdef PROBE_FETCH
                { const unsigned long long tf1_ = __builtin_amdgcn_s_memrealtime(); const unsigned long long d_ = tf1_ - tf0_; while (__builtin_amdgcn_s_memrealtime() - tf1_ < d_) __builtin_amdgcn_s_sleep(2); }
#endif
                if (unit >= 1248) break;
#ifdef PROBE_UNIT
                const unsigned long long tu0_ = __builtin_amdgcn_s_memrealtime();
#endif
                if (unit < 224) ret_state_unit(wv, l, unit); else if (unit < 480) attn_unit<1>(wv, l, unit - 224); else if (unit < 992) attn_unit<0>(wv, l, unit - 480); else mem_unit(wv, l, unit - 992);
#ifdef PROBE_UNIT
                { const unsigned long long tu1_ = __builtin_amdgcn_s_memrealtime(); if (PROBE_UNIT >= 2 ? (tu1_ - tu0_ > (unsigned long long)PROBE_UNIT * 100ull) : ((unit < 256) == (PROBE_UNIT == 1))) { const unsigned long long d_ = tu1_ - tu0_; while (__builtin_amdgcn_s_memrealtime() - tu1_ < d_) __builtin_amdgcn_s_sleep(8); } }
#endif
            }
        }
#endif
#ifdef KEEP_SEAM3
        SEAM(pb + 3);
#endif
#if !defined(ONLY_PH) || ONLY_PH == 5
        if (IN(pb + 4)) { MK_EPI(E); gm::TileOrder ord; ord.init(64, 4, G, opaque_bid()); SchedP3 S; S.ok = ord.tile(0, S.pm, S.pn); S.l = l; S.rot = (opaque_bid() >> 3) & 3; S.ws = kargs()->ws; E.b_gate = kargs()->b_gate;
            gm::gemm_phase<AUX_P3>(lds, wv, S, E);
#ifdef PROBE_DUP_GEMM
            xcd_barrier(bar, wv); gm::gemm_phase<AUX_P3>(lds, wv, S, E);
#endif
            }
#endif
        SEAM(pb + 4);
#if !defined(ONLY_PH) || ONLY_PH == 6
        if (IN(pb + 5)) { MK_EPI(E); gm::TileOrder ord; ord.init(64, 4, G, opaque_bid()); SchedP4 S; S.ok = ord.tile(0, S.pm, S.pn); S.l = l; S.ws = kargs()->ws;
            E.gnext = (l + 1 < DEPTH) ? kargs()->norm_g + (size_t)(l + 1) * D : nullptr;
            E.gfinal = (l + 1 < DEPTH || G != 256) ? nullptr : kargs()->final_norm_g;
            E.xout = kargs()->out; E.xin = (l == 0) ? kargs()->x : (const float*)kargs()->out;
            gm::gemm_phase<AUX_P4>(lds, wv, S, E); }
#endif
        if (!(l + 1 == DEPTH && G == 256)) SEAM(pb + 5);
    }
#if !defined(ONLY_PH) || ONLY_PH == 13
    if (IN(13) && G != 256) final_norm(wv);
#endif
#undef IN
#undef SEAM
#undef MK_EPI
}

extern "C" void kernel_launch(void* const* d_in, const int* in_sizes, int n_in, void* d_out, int out_size, void* d_ws, size_t ws_size, hipStream_t stream) {
    static int grid = 0;
    if (grid == 0) {
        if (n_in != 19 || out_size != T * D || ws_size < WS_END) { fprintf(stderr, "kernel_launch: unexpected problem (n_in %d, out %d, ws %zu)\n", n_in, out_size, ws_size); grid = -1; return; }
        int dev = 0, cus = 0, per_cu = 0;
        if (hipGetDevice(&dev) != hipSuccess || hipDeviceGetAttribute(&cus, hipDeviceAttributeMultiprocessorCount, dev) != hipSuccess) { grid = -1; return; }
        if (hipFuncSetAttribute((const void*)mk_fwd, hipFuncAttributeMaxDynamicSharedMemorySize, LDS_BYTES) != hipSuccess) { fprintf(stderr, "kernel_launch: hipFuncSetAttribute failed\n"); grid = -1; return; }
        if (hipOccupancyMaxActiveBlocksPerMultiprocessor(&per_cu, (const void*)mk_fwd, NTHREADS, LDS_BYTES) != hipSuccess || per_cu < 1)
            fprintf(stderr, "kernel_launch: occupancy query reports %d workgroups per CU\n", per_cu);
        (void)hipGetLastError();
        grid = cus;
    }
    if (grid < 0) return;
    if (hipMemsetAsync((char*)d_ws + WS_CTL, 0, CTL_ZERO_BYTES, stream) != hipSuccess) return;
    Args a{};
    a.x = (const float*)d_in[0]; a.mem = (const float*)d_in[1]; a.positions = (const int*)d_in[2]; a.norm_g = (const float*)d_in[3]; a.mem_norm_g = (const float*)d_in[4];
    a.w_in = (const float*)d_in[5]; a.b_gate = (const float*)d_in[6]; a.dn_conv_w = (const float*)d_in[7]; a.dn_a_log = (const float*)d_in[8]; a.dn_dt_bias = (const float*)d_in[9];
    a.dn_norm_g = (const float*)d_in[10]; a.ret_norm_g = (const float*)d_in[11]; a.w_mem_kv = (const float*)d_in[12]; a.w_br_sb = (const float*)d_in[13]; a.w_br_dn = (const float*)d_in[14];
    a.w_br_ret = (const float*)d_in[15]; a.w_br_mem = (const float*)d_in[16]; a.w_out = (const float*)d_in[17]; a.final_norm_g = (const float*)d_in[18];
    a.out = (float*)d_out; a.ws = (unsigned char*)d_ws;
#if MK_N_LAUNCHES == 1
    a.ph_lo = 0; a.ph_hi = NPHASE; a.li = 0;
    hipLaunchKernelGGL(mk_fwd, dim3(grid), dim3(NTHREADS), LDS_BYTES, stream, a);
#else
    for (int p = 0; p < NPHASE; ++p) { a.ph_lo = p; a.ph_hi = p + 1; a.li = 0;
        hipLaunchKernelGGL(mk_fwd, dim3(grid), dim3(NTHREADS), LDS_BYTES, stream, a); }
#endif
}
```

```cpp
#include <hip/hip_runtime.h>
#include <cstdio>
#include <cstdint>
#include <cmath>

#define LAS __attribute__((address_space(3)))
#define GAS __attribute__((address_space(1)))
#define DI __device__ __forceinline__
typedef unsigned short bf16_t;
typedef short bf16x8 __attribute__((ext_vector_type(8)));
typedef float f32x4 __attribute__((ext_vector_type(4)));
typedef unsigned u32x4 __attribute__((ext_vector_type(4)));
typedef unsigned u32x2 __attribute__((ext_vector_type(2)));
typedef float f32x2 __attribute__((ext_vector_type(2)));

#ifndef AUX_P1
#define AUX_P1 0
#endif
#ifndef AUX_P3
#define AUX_P3 0
#endif
#ifndef AUX_P4
#define AUX_P4 0
#endif
#ifdef EPI_NT
#define EPI_LD(p) __builtin_nontemporal_load(p)
#define EPI_ST(p, v) __builtin_nontemporal_store((v), (p))
#else
#define EPI_LD(p) (*(p))
#define EPI_ST(p, v) (*(p) = (v))
#endif
#ifndef FRESH_WAITS
#define FRESH_WAITS 0
#endif
#ifndef SS_PREFETCH
#define SS_PREFETCH 1
#endif
#ifndef EARLY_INV
#define EARLY_INV 1
#endif
#ifndef MK_N_LAUNCHES
#define MK_N_LAUNCHES 1
#endif

constexpr int BATCH = 8, SEQ = 2048, D = 1024, T = BATCH * SEQ, DEPTH = 2, MEMLEN = 256;
constexpr int IN_COLS = 9992;
constexpr float EPS = 1e-6f;
constexpr int NPHASE = 14;

constexpr size_t MiB = 1u << 20;
constexpr size_t WS_CTL = 0, CTL_ZERO_BYTES = 1 * MiB;
constexpr size_t WS_WINA = 1 * MiB;
constexpr size_t WS_WINB = 13 * MiB;
constexpr size_t WS_WG = 25 * MiB;
constexpr size_t WS_WBR = 41 * MiB;
constexpr size_t WS_WOUT = 49 * MiB;
constexpr size_t WS_WKV = 53 * MiB;
constexpr size_t WS_XN = 55 * MiB;
constexpr size_t WS_P = 87 * MiB;
constexpr size_t WS_R = 127 * MiB;
constexpr int VTLD = T + 64;
constexpr size_t WS_VTSB = WS_R + 64 * MiB, WS_VTRT = WS_VTSB + (size_t)512 * VTLD * 2;
constexpr size_t WS_SCR = 224 * MiB;
constexpr size_t WS_MRG = 240 * MiB;
constexpr size_t WS_DNI = 224 * MiB;
constexpr size_t WS_KVM = 296 * MiB;
constexpr size_t WS_ROPE = 300 * MiB;
constexpr size_t WS_AB = 304 * MiB;
constexpr size_t WS_GB = WS_AB + 512 * 1024;
constexpr size_t WS_SS = 305 * MiB;
constexpr size_t WS_END = 310 * MiB;
constexpr size_t WS_MEMN = 306 * MiB;
constexpr int PLD = 1280, RALD = 1536, RBLD = 2048, SCRLD = 1024, MRGLD = 1024;
constexpr int P_DNZ = 0, P_MEMQ = 512, P_RTQ = 768, P_RTK = 1024;
constexpr int RB_SBQ = 0, RB_SBK = 512, RB_SBZ = 1024, RB_RTZ = 1536;
constexpr int CW_BAR = 4096;
constexpr int CW_PANEL = 16384;
constexpr int CW_QUEUE = 64;
constexpr int CW_RST = 49152;
constexpr int CW_READY = 32768;

constexpr int RING_BYTES = 155648;
constexpr int LDSCTL_OFF = RING_BYTES, MISC_OFF = LDSCTL_OFF + 320, SPARE_OFF = LDSCTL_OFF + 1024;
constexpr int LDS_BYTES = 163840;
constexpr int NWAVES = 8, NTHREADS = 512;

DI unsigned f2bf(float f) { unsigned u = __builtin_bit_cast(unsigned, f); return (u + 0x7fffu + ((u >> 16) & 1u)) >> 16; }
DI unsigned pk2(float lo, float hi) { unsigned r; asm("s_nop 0\n\tv_cvt_pk_bf16_f32 %0, %1, %2" : "=v"(r) : "v"(lo), "v"(hi)); return r; }
DI float bf2f(unsigned short h) { return __builtin_bit_cast(float, (unsigned)h << 16); }
DI float bflo(unsigned w) { return __builtin_bit_cast(float, w << 16); }
DI float bfhi(unsigned w) { return __builtin_bit_cast(float, w & 0xffff0000u); }
DI float shx(float v, int m, int lane) { return __builtin_bit_cast(float, __builtin_amdgcn_ds_bpermute((lane ^ m) << 2, __builtin_bit_cast(int, v))); }
DI float wave_sum(float v, int lane) {
#pragma unroll
    for (int o = 1; o < 64; o <<= 1) v += shx(v, o, lane);
    return v;
}
DI float sum16(float v) {
    v += __builtin_bit_cast(float, __builtin_amdgcn_update_dpp(0, __builtin_bit_cast(int, v), 0xB1, 0xf, 0xf, true));
    v += __builtin_bit_cast(float, __builtin_amdgcn_update_dpp(0, __builtin_bit_cast(int, v), 0x4E, 0xf, 0xf, true));
    v += __builtin_bit_cast(float, __builtin_amdgcn_update_dpp(0, __builtin_bit_cast(int, v), 0x141, 0xf, 0xf, true));
    v += __builtin_bit_cast(float, __builtin_amdgcn_update_dpp(0, __builtin_bit_cast(int, v), 0x140, 0xf, 0xf, true));
    return v;
}
DI float sigmoidf_(float x) { return __builtin_amdgcn_rcpf(1.f + __builtin_amdgcn_exp2f(x * -1.4426950408889634f)); }
DI float siluf_(float x) { return x * __builtin_amdgcn_rcpf(1.f + __builtin_amdgcn_exp2f(x * -1.4426950408889634f)); }
DI int opaque_bid() { int b = blockIdx.x; asm volatile("" : "+s"(b)); return b; }
DI int opaque_tid(int wv) { int lane; asm volatile("v_mbcnt_lo_u32_b32 %0, -1, 0\n\tv_mbcnt_hi_u32_b32 %0, -1, %0" : "=v"(lane)); return wv * 64 + lane; }
#define LDS_WAIT() asm volatile("s_waitcnt lgkmcnt(0)" ::: "memory")
DI void lds_barrier() { asm volatile("s_waitcnt lgkmcnt(0)" ::: "memory"); __builtin_amdgcn_s_barrier(); asm volatile("" ::: "memory"); }
#define VM_WAIT() asm volatile("s_waitcnt vmcnt(0)" ::: "memory")
DI unsigned shxu(unsigned v, int m, int lane) { return (unsigned)__builtin_amdgcn_ds_bpermute((lane ^ m) << 2, (int)v); }
DI void st16_wt(void* p, u32x4 v) { asm volatile("global_store_dwordx4 %0, %1, off sc1\n\ts_nop 1" :: "v"(p), "v"(v) : "memory"); }
DI void unit_done(unsigned char* ws, int l, int pm, int tid) {
    VM_WAIT(); lds_barrier();
    if (tid == 0) (void)__hip_atomic_fetch_add((unsigned*)(ws + WS_CTL) + CW_READY + 4096 * l + 64 * pm, 1u, __ATOMIC_RELAXED, __HIP_MEMORY_SCOPE_AGENT);
}

#define XB_TMO      128
#define XB_XCNT(j)  (256  + 64 * (j))
#define XB_XSUB(j)  (1280 + 64 * (j))
#define XB_XGEN(j)  (2304 + 64 * (j))
#define XB_TOP      3328
#define XB_TOPGEN   3392
#define XCD_BAR_WORDS 3456
#define XB_SPIN_CAP (1u << 18)
DI unsigned xb_ld(unsigned* p)              { return __hip_atomic_load(p, __ATOMIC_RELAXED, __HIP_MEMORY_SCOPE_AGENT); }
DI unsigned xb_add(unsigned* p, unsigned v) { return __hip_atomic_fetch_add(p, v, __ATOMIC_RELAXED, __HIP_MEMORY_SCOPE_AGENT); }
DI unsigned xb_xcc_id() { return (unsigned)__builtin_amdgcn_s_getreg((3 << 11) | 20) & 0xFu; }
#define XB_SPIN(cond, bar) do { unsigned _sp = 0; while (cond) { __builtin_amdgcn_s_sleep(1); \
    if ((++_sp & 255u) == 0u) { if (xb_ld(&(bar)[XB_TMO])) break; if (_sp > XB_SPIN_CAP) { atomicAdd(&(bar)[XB_TMO], 1u); break; } } } } while (0)
struct XcdBarrier { unsigned* bar; unsigned x; volatile LAS unsigned* st; };
DI XcdBarrier xcd_barrier_post(unsigned* bar, volatile LAS unsigned* st, int wv) {
    XcdBarrier b; b.bar = bar; b.x = xb_xcc_id(); b.st = st;
    if (opaque_tid(wv) == 0) (void)xb_add(&bar[XB_XCNT(b.x)], 1u);
    return b;
}
DI void xcd_barrier_complete(unsigned* bar, unsigned x, unsigned& nloc, unsigned& nx) {
    const unsigned G = gridDim.x * gridDim.y * gridDim.z;
    unsigned sum, cnt, mine, sp = 0u;
    for (;;) {
        sum = 0u; cnt = 0u; mine = 0u;
#pragma unroll
        for (unsigned j = 0; j < 16; ++j) { const unsigned c = xb_ld(&bar[XB_XCNT(j)]); sum += c; cnt += (c > 0u) ? 1u : 0u; mine = (j == x) ? c : mine; }
        if (sum == G) break;
        __builtin_amdgcn_s_sleep(1);
        if ((++sp & 255u) == 0u) { if (xb_ld(&bar[XB_TMO])) break; if (sp > XB_SPIN_CAP) { atomicAdd(&bar[XB_TMO], 1u); break; } }
    }
    nloc = mine > 0u ? mine : 1u; nx = cnt > 0u ? cnt : 1u;
}
DI void xcd_barrier(const XcdBarrier& b, int wv) {
    asm volatile("s_waitcnt vmcnt(0)" ::: "memory");
    __syncthreads();
    if (opaque_tid(wv) == 0) {
        unsigned* bar = b.bar;
        __builtin_amdgcn_s_waitcnt(0);
#if EARLY_INV
        __builtin_amdgcn_fence(__ATOMIC_ACQUIRE, "agent");
#endif
        unsigned nloc = b.st[0], nx = b.st[1];
        if (nloc == 0u) { xcd_barrier_complete(bar, b.x, nloc, nx); b.st[0] = nloc; b.st[1] = nx; }
        const unsigned old = xb_add(&bar[XB_XSUB(b.x)], 1u);
        const unsigned gen = old / nloc;
        if (old + 1u == (gen + 1u) * nloc) {
            __builtin_amdgcn_fence(__ATOMIC_RELEASE, "agent");
            asm volatile("s_waitcnt vmcnt(0)" ::: "memory");
            const unsigned og = xb_add(&bar[XB_TOP], 1u);
            const unsigned tg = og / nx;
            if (og + 1u == (tg + 1u) * nx) xb_add(&bar[XB_TOPGEN], 1u);
            else XB_SPIN(xb_ld(&bar[XB_TOPGEN]) == tg, bar);
#if !EARLY_INV
            __builtin_amdgcn_fence(__ATOMIC_ACQUIRE, "agent");
#endif
            xb_add(&bar[XB_XGEN(b.x)], 1u);
            asm volatile("s_waitcnt vmcnt(0)" ::: "memory");
        } else {
            XB_SPIN(xb_ld(&bar[XB_XGEN(b.x)]) == gen, bar);
#if !EARLY_INV
            __builtin_amdgcn_fence(__ATOMIC_ACQUIRE, "agent");
#endif
            asm volatile("s_waitcnt vmcnt(0)" ::: "memory");
        }
    }
    __syncthreads();
}

namespace gm {
constexpr int BM = 256, BK = 64, HALF = 128, HTB = HALF * BK * 2, STAGE_BYTES = 8 * HTB;
DI int lds_byte(int r, int c) { const int st = (r >> 4) * 2 + (c >> 5), rr = r & 15, cc = c & 31, ob = rr * 64 + cc * 2; return st * 1024 + (ob ^ (((ob >> 9) & 1) << 5)); }
DI void stage_rc(int b, int& R, int& C) { const int st = b / 1024, sb = b % 1024, swz = sb ^ (((sb >> 9) & 1) << 5); R = (st >> 1) * 16 + swz / 64; C = (st & 1) * 32 + (swz % 64) / 2; }
DI int perm32(int rho) { const int n = rho >> 4, i = rho & 15; return 8 * (i >> 2) + 4 * n + (i & 3); }

enum Kind { K_STORE = 0, K_AB = 1, K_GATE = 2, K_BRANCH = 3, K_OUT = 4, K_STORE_T = 5 };
struct Unit {
    const bf16_t* A; const bf16_t* B;
    int lda, ldb, K, pm, pn, kind, sub, l;
};
struct TileOrder {
    int nM, nN, nwg, G, c;
    DI void init(int nM_, int nN_, int G_, int c_) { nM = nM_; nN = nN_; nwg = nM * nN; G = G_; c = c_; }
    DI bool tile(int i, int& pm, int& pn) const {
        const long L = (long)i * G + c; if (L >= nwg) return false;
        int wgid = (int)L; { const int q = nwg / 8, r = nwg % 8, xcd = wgid % 8, off = wgid / 8; wgid = (xcd < r ? xcd * (q + 1) : r * (q + 1) + (xcd - r) * q) + off; }
        const int WGM = 8, nig = WGM * nN, gid = wgid / nig, fm = gid * WGM, gsz = (nM - fm) < WGM ? (nM - fm) : WGM;
        pm = __builtin_amdgcn_readfirstlane(fm + ((wgid % nig) % gsz)); pn = __builtin_amdgcn_readfirstlane((wgid % nig) / gsz); return true;
    }
};

template <int AUX, class Sched, class Epi>
DI void gemm_phase(LAS unsigned char* lds, int wv, const Sched& S, const Epi& E) {
    const int tid = opaque_tid(wv), wid = __builtin_amdgcn_readfirstlane(tid >> 6), lane = tid & 63, wr = wid >> 2, wc = wid & 3, fr = lane & 15, fq = lane >> 4;
    int R0_, C0_; stage_rc(tid * 16, R0_, C0_);
    const unsigned R0 = 2u * (unsigned)R0_, C2 = 2u * (unsigned)C0_;
    const unsigned RbP = 2u * (unsigned)((R0_ & ~31) + perm32(R0_ & 31));
    const unsigned ldsw = (unsigned)wid * 1024u;
    const int aoff = lds_byte(wr * 64 + fr, fq * 8), boff = lds_byte(wc * 32 + fr, fq * 8);
#define GM_SA(b, h) (((b) * 2 + (h)) * HTB)
#define GM_SB(b, h) ((4 + (b) * 2 + (h)) * HTB)
#define GM_STAGE(bufoff, gbase, ld, R2) do { const unsigned _v = (unsigned)(R2) * (unsigned)(ld) + C2; \
        __builtin_amdgcn_global_load_lds((const unsigned*)((const char*)(gbase) + _v), (LAS unsigned*)(lds + (bufoff) + ldsw), 16, 0, AUX); \
        __builtin_amdgcn_global_load_lds((const unsigned*)((const char*)(gbase) + (_v + (unsigned)(ld) * 128u)), (LAS unsigned*)(lds + (bufoff) + ldsw + 8192), 16, 0, AUX); } while (0)
#define GM_LDA(dst, b, h) do { _Pragma("unroll") for (int m = 0; m < 4; ++m) _Pragma("unroll") for (int k = 0; k < 2; ++k) dst[m][k] = *(const LAS bf16x8*)(lds + GM_SA(b, h) + aoff + m * 2048 + k * 1024); } while (0)
#define GM_LDB(dst, b, h) do { _Pragma("unroll") for (int n = 0; n < 2; ++n) _Pragma("unroll") for (int k = 0; k < 2; ++k) dst[n][k] = *(const LAS bf16x8*)(lds + GM_SB(b, h) + boff + n * 2048 + k * 1024); } while (0)
#define GM_MMA(ai, bj, At, Bt) do { __builtin_amdgcn_s_setprio(1); _Pragma("unroll") for (int m = 0; m < 4; ++m) _Pragma("unroll") for (int n = 0; n < 2; ++n) _Pragma("unroll") for (int k = 0; k < 2; ++k) \
        acc[ai][bj][m][n] = __builtin_amdgcn_mfma_f32_16x16x32_bf16(Bt[n][k], At[m][k], acc[ai][bj][m][n], 0, 0, 0); __builtin_amdgcn_s_setprio(0); } while (0)
#define GM_WAIT_V(n) asm volatile("s_waitcnt vmcnt(" #n ")" ::: "memory")
#define GM_WAIT_L(n) asm volatile("s_waitcnt lgkmcnt(" #n ")" ::: "memory")
#define GM_BAR __builtin_amdgcn_s_barrier()
#define GM_SCHED __builtin_amdgcn_sched_barrier(0)
    Unit cur, nxt; int ui = 0;
    if (!S.next(0, cur)) return;
    S.a_ready(cur, wid, lane);
    f32x4 acc[2][2][4][2];
#pragma unroll
    for (int a = 0; a < 2; ++a)
#pragma unroll
        for (int b = 0; b < 2; ++b)
#pragma unroll
            for (int m = 0; m < 4; ++m)
#pragma unroll
                for (int n = 0; n < 2; ++n) acc[a][b][m][n] = (f32x4){0.f, 0.f, 0.f, 0.f};
    bf16x8 At[4][2], B0[2][2], B1[2][2];
    const char* cA = (const char*)cur.A; const char* cB = (const char*)cur.B; int clda = cur.lda, cldb = cur.ldb;
    GM_STAGE(GM_SB(0, 0), cB, cldb, RbP); GM_STAGE(GM_SB(0, 1), cB + (size_t)cldb * 256, cldb, RbP); GM_STAGE(GM_SA(0, 0), cA, clda, R0); GM_STAGE(GM_SA(0, 1), cA + (size_t)clda * 256, clda, R0);
    if (wr == 1) GM_BAR;
    GM_WAIT_V(2); GM_BAR;
    GM_STAGE(GM_SB(1, 0), cB + 128, cldb, RbP); GM_STAGE(GM_SA(1, 0), cA + 128, clda, R0); GM_STAGE(GM_SB(1, 1), cB + (size_t)cldb * 256 + 128, cldb, RbP);
    GM_WAIT_V(6); GM_BAR;
    for (;;) {
        const bool has_next = S.next(ui + 1, nxt);
        const char* nA = has_next ? (const char*)nxt.A : cA; const char* nB = has_next ? (const char*)nxt.B : cB;
        const int nlda = has_next ? nxt.lda : clda, nldb = has_next ? nxt.ldb : cldb;
        const int nt = cur.K / BK;
#if SS_PREFETCH
        if (wid < 4) __builtin_amdgcn_global_load_lds((const unsigned*)(E.ws + WS_SS + ((size_t)(cur.kind == K_STORE_T ? cur.pn : cur.pm) * 256 + tid) * 16), (LAS unsigned*)(lds + STAGE_BYTES + (ui & 1) * 4096 + wid * 1024), 16, 0, 0);
        if (wid == 4 && cur.kind == K_GATE) __builtin_amdgcn_global_load_lds((const unsigned*)(E.b_gate + (size_t)cur.l * 4096 + (cur.sub & 3) * 1024 + cur.pn * 256 + lane * 4), (LAS unsigned*)(lds + STAGE_BYTES + 8192 + (ui & 1) * 1024), 16, 0, 0);
#endif
        for (int t = 0; t < nt; t += 2) {
            const bool last = (t == nt - 2);
            if (last && has_next) S.a_ready(nxt, wid, lane);
            const char* a1 = cA + (size_t)(t + 1) * 128;
            const char* a2 = last ? nA : cA + (size_t)(t + 2) * 128; const char* b2 = last ? nB : cB + (size_t)(t + 2) * 128;
            const int lda2 = last ? nlda : clda, ldb2 = last ? nldb : cldb;
            const char* a3 = a2 + 128; const char* b3 = b2 + 128;
            const int later = __builtin_amdgcn_readfirstlane((t != 0) ? 1 : 0);
#if FRESH_WAITS
#define GM_WAIT_V8_LATER asm volatile("s_cmp_eq_u32 %0, 0\n\ts_cbranch_scc1 .Lgmw%=\n\ts_waitcnt vmcnt(8)\n.Lgmw%=:" :: "s"(later) : "scc", "memory")
#else
#define GM_WAIT_V8_LATER GM_WAIT_V(8)
#endif
            GM_LDB(B0, 0, 0); GM_LDB(B1, 0, 1); GM_SCHED; GM_LDA(At, 0, 0); GM_STAGE(GM_SA(1, 1), a1 + (size_t)clda * 256, clda, R0);
            GM_WAIT_V8_LATER; GM_WAIT_L(0); GM_BAR; GM_MMA(0, 0, At, B0); GM_MMA(0, 1, At, B1); GM_BAR; GM_SCHED;
            GM_LDA(At, 0, 1); GM_STAGE(GM_SB(0, 0), b2, ldb2, RbP); GM_STAGE(GM_SB(0, 1), b2 + (size_t)ldb2 * 256, ldb2, RbP); GM_STAGE(GM_SA(0, 0), a2, lda2, R0);
            GM_WAIT_V8_LATER; GM_WAIT_L(0); GM_BAR; GM_MMA(1, 0, At, B0); GM_MMA(1, 1, At, B1); GM_BAR; GM_SCHED;
#undef GM_WAIT_V8_LATER
            GM_LDB(B0, 1, 0); GM_LDB(B1, 1, 1); GM_SCHED; GM_LDA(At, 1, 0); GM_STAGE(GM_SA(0, 1), a2 + (size_t)lda2 * 256, lda2, R0);
            GM_WAIT_V(8); GM_WAIT_L(0); GM_BAR; GM_MMA(0, 0, At, B0); GM_MMA(0, 1, At, B1); GM_BAR; GM_SCHED;
            GM_LDA(At, 1, 1); GM_STAGE(GM_SB(1, 0), b3, ldb2, RbP); GM_STAGE(GM_SB(1, 1), b3 + (size_t)ldb2 * 256, ldb2, RbP); GM_STAGE(GM_SA(1, 0), a3, lda2, R0);
            GM_WAIT_V(8); GM_WAIT_L(0); GM_BAR; GM_MMA(1, 0, At, B0); GM_MMA(1, 1, At, B1); GM_BAR; GM_SCHED;
        }
        if (wr == 0) GM_BAR;
        if (FRESH_WAITS && (cur.kind == K_AB || (cur.kind == K_STORE && cur.sub == 2) || (cur.kind == K_STORE_T && cur.sub == 1))) GM_WAIT_V(0);
#ifdef PROBE_EPI
        const unsigned long long te0_ = __builtin_amdgcn_s_memrealtime();
#endif
        E(acc, cur, wr, wc, fr, fq, lane, (const LAS float*)(lds + STAGE_BYTES + (ui & 1) * 4096), (const LAS float*)(lds + STAGE_BYTES + 8192 + (ui & 1) * 1024));
#ifdef PROBE_EPI
        if (cur.kind == PROBE_EPI) { asm volatile("s_waitcnt vmcnt(0)" ::: "memory"); const unsigned long long t1_ = __builtin_amdgcn_s_memrealtime(); const unsigned long long d_ = t1_ - te0_; while (__builtin_amdgcn_s_memrealtime() - t1_ < d_) __builtin_amdgcn_s_sleep(2); }
#endif
        if (!has_next) break;
#pragma unroll
        for (int a = 0; a < 2; ++a)
#pragma unroll
            for (int b = 0; b < 2; ++b)
#pragma unroll
                for (int m = 0; m < 4; ++m)
#pragma unroll
                    for (int n = 0; n < 2; ++n) acc[a][b][m][n] = (f32x4){0.f, 0.f, 0.f, 0.f};
        cur = nxt; cA = nA; cB = nB; clda = nlda; cldb = nldb; ++ui;
        if (wr == 1) GM_BAR;
    }
    GM_WAIT_V(0);
    GM_BAR;
#undef GM_SA
#undef GM_SB
#undef GM_STAGE
#undef GM_LDA
#undef GM_LDB
#undef GM_MMA
#undef GM_WAIT_V
#undef GM_WAIT_L
#undef GM_BAR
#undef GM_SCHED
}

#if SS_PREFETCH
#define SSROW(pan, r) row_scale_l(ssl, (r))
#else
#define SSROW(pan, r) row_scale((pan) * BM + (r))
#endif
struct Epi {
    unsigned char* ws;
    const float* xin; float* xout;
    bool xin16, xout16;
    const float* b_gate;
    const float* gnext;
    const float* gfinal;
    LAS float* spare;
    DI float row_scale(int row) const { const f32x4 s = *(const f32x4*)((const float*)(ws + WS_SS) + (size_t)row * 4); return rsqrtf(((s.x + s.y) + (s.z + s.w)) * (1.0f / 1024.0f) + EPS); }
    static DI float row_scale_l(const LAS float* ssl, int r) { const f32x4 s = *(const LAS f32x4*)(ssl + r * 4); return rsqrtf(((s.x + s.y) + (s.z + s.w)) * (1.0f / 1024.0f) + EPS); }
    DI unsigned char* scratch_tile(int pm, int pn) const { return ws + WS_SCR + (size_t)pm * 256 * SCRLD + pn * 256; }
    DI void operator()(f32x4 (&acc)[2][2][4][2], const Unit& u, int wr, int wc, int fr, int fq, int lane, const LAS float* ssl, const LAS float* bil) const {
        int rl0 = wr * 64 + fr, cl0 = wc * 32 + 8 * fq;
        asm volatile("" : "+v"(rl0), "+v"(cl0));
        if (u.kind == K_STORE) {
            bf16_t* base; int ldc; bool scale = true;
            if (u.sub == 0) {
                if (u.pn < 6) { base = (bf16_t*)(ws + WS_R) + (size_t)u.pm * 256 * RALD + u.pn * 256; ldc = RALD; }
                else { const int pc = u.pn < 8 ? (u.pn - 6) * 256 : (u.pn - 7) * 256; base = (bf16_t*)(ws + WS_P) + (size_t)u.pm * 256 * PLD + pc; ldc = PLD; }
            } else if (u.sub == 1) { base = (bf16_t*)(ws + WS_R) + (size_t)u.pm * 256 * RBLD + u.pn * 256; ldc = RBLD; }
            else { base = (bf16_t*)(ws + WS_KVM) + (size_t)u.l * 1024 * 1024 + (size_t)u.pm * 256 * 256; ldc = 256; scale = false; }
            const bool rope = (u.sub == 0 && u.pn >= 10);
            const float rsc = (u.pn == 11) ? 0.125f : 1.0f;
            const float* rc = (const float*)(ws + WS_ROPE); const int fi = (cl0 & 63) >> 1;
            float scq[2][4];
#pragma unroll
            for (int ai = 0; ai < 2; ++ai)
#pragma unroll
                for (int m = 0; m < 4; ++m) scq[ai][m] = scale ? SSROW(u.pm, rl0 + ai * HALF + m * 16) : 1.0f;
#pragma unroll
            for (int ai = 0; ai < 2; ++ai) {
                f32x4 csq[4], snq[4];
                if (rope) {
#pragma unroll
                    for (int m = 0; m < 4; ++m) { const size_t ro = (size_t)(u.pm * BM + rl0 + ai * HALF + m * 16) * 32 + fi; csq[m] = *(const f32x4*)(rc + ro); snq[m] = *(const f32x4*)(rc + (size_t)T * 32 + ro); }
                }
#pragma unroll
                for (int m = 0; m < 4; ++m) {
                    const int rl = rl0 + ai * HALF + m * 16;
                    const float sc = scq[ai][m];
                    bf16_t* rowp = base + (size_t)rl * ldc + cl0;
                    f32x4 cs4 = {1.f, 1.f, 1.f, 1.f}, sn4 = {0.f, 0.f, 0.f, 0.f};
                    if (rope) { cs4 = csq[m]; sn4 = snq[m]; }
#pragma unroll
                    for (int bj = 0; bj < 2; ++bj) { f32x4 v0 = acc[ai][bj][m][0] * sc, v1 = acc[ai][bj][m][1] * sc;
                        if (rope) { f32x4 r0, r1;
                            r0[0] = (v0[0] * cs4[0] - v0[1] * sn4[0]) * rsc; r0[1] = (v0[0] * sn4[0] + v0[1] * cs4[0]) * rsc; r0[2] = (v0[2] * cs4[1] - v0[3] * sn4[1]) * rsc; r0[3] = (v0[2] * sn4[1] + v0[3] * cs4[1]) * rsc;
                            r1[0] = (v1[0] * cs4[2] - v1[1] * sn4[2]) * rsc; r1[1] = (v1[0] * sn4[2] + v1[1] * cs4[2]) * rsc; r1[2] = (v1[2] * cs4[3] - v1[3] * sn4[3]) * rsc; r1[3] = (v1[2] * sn4[3] + v1[3] * cs4[3]) * rsc;
                            v0 = r0; v1 = r1; }
                        u32x4 w; w.x = pk2(v0[0], v0[1]); w.y = pk2(v0[2], v0[3]); w.z = pk2(v1[0], v1[1]); w.w = pk2(v1[2], v1[3]);
                        *(u32x4*)(rowp + bj * HALF) = w; }
                }
            }
        } else if (u.kind == K_STORE_T) {
            bf16_t* base; const bool scale = (u.sub == 0);
            if (u.sub == 0) base = (bf16_t*)(ws + WS_VTSB) + (size_t)u.pm * 256 * VTLD + u.pn * 256;
            else base = (bf16_t*)(ws + WS_KVM) + (size_t)u.l * 1024 * 1024 + 256 * 2048 + u.pn * 256;
            const int ldc = (u.sub == 0) ? VTLD : 2048;
            f32x4 cs[2][2];
#pragma unroll
            for (int bj = 0; bj < 2; ++bj)
#pragma unroll
                for (int n = 0; n < 2; ++n)
#pragma unroll
                    for (int j = 0; j < 4; ++j) cs[bj][n][j] = scale ? SSROW(u.pn, cl0 + bj * HALF + 4 * n + j) : 1.0f;
#pragma unroll
            for (int ai = 0; ai < 2; ++ai)
#pragma unroll
                for (int m = 0; m < 4; ++m) {
                    const int rl = rl0 + ai * HALF + m * 16;
                    bf16_t* rowp = base + (size_t)rl * ldc + cl0;
#pragma unroll
                    for (int bj = 0; bj < 2; ++bj) { const f32x4 v0 = acc[ai][bj][m][0] * cs[bj][0], v1 = acc[ai][bj][m][1] * cs[bj][1];
                        u32x4 w; w.x = pk2(v0[0], v0[1]); w.y = pk2(v0[2], v0[3]); w.z = pk2(v1[0], v1[1]); w.w = pk2(v1[2], v1[3]);
                        *(u32x4*)(rowp + bj * HALF) = w; }
                }
        } else if (u.kind == K_AB) {
            if (wc == 0 && fq == 0) {
                float* base = (float*)(ws + WS_AB) + (size_t)u.pm * 256 * 8;
#pragma unroll
                for (int ai = 0; ai < 2; ++ai)
#pragma unroll
                    for (int m = 0; m < 4; ++m) {
                        const int rl = rl0 + ai * HALF + m * 16;
                        const float sc = SSROW(u.pm, rl);
                        float* rowp = base + (size_t)rl * 8;
                        *(f32x4*)(rowp) = acc[ai][0][m][0] * sc; *(f32x4*)(rowp + 4) = acc[ai][0][m][1] * sc;
                    }
            }
        } else if (u.kind == K_GATE) {
            unsigned char* base = scratch_tile(u.pm, u.pn);
            const float* bias = b_gate + (size_t)u.l * 4096 + (u.sub & 3) * 1024 + u.pn * 256;
            f32x4 bv[2][2];
#pragma unroll
            for (int bj = 0; bj < 2; ++bj)
#pragma unroll
#if SS_PREFETCH
                for (int n = 0; n < 2; ++n) bv[bj][n] = *(const LAS f32x4*)(bil + cl0 + bj * HALF + 4 * n) * -1.4426950408889634f;
#else
                for (int n = 0; n < 2; ++n) bv[bj][n] = *(const f32x4*)(bias + cl0 + bj * HALF + 4 * n) * -1.4426950408889634f;
#endif
            float scq[2][4];
#pragma unroll
            for (int ai = 0; ai < 2; ++ai)
#pragma unroll
                for (int m = 0; m < 4; ++m) scq[ai][m] = SSROW(u.pm, rl0 + ai * HALF + m * 16) * -1.4426950408889634f;
#pragma unroll
            for (int ai = 0; ai < 2; ++ai)
#pragma unroll
                for (int m = 0; m < 4; ++m) {
                    const int rl = rl0 + ai * HALF + m * 16;
                    const float sc = scq[ai][m];
                    unsigned char* rowp = base + (size_t)rl * SCRLD + cl0;
#pragma unroll
                    for (int bj = 0; bj < 2; ++bj) { const f32x4 v0 = acc[ai][bj][m][0] * sc + bv[bj][0], v1 = acc[ai][bj][m][1] * sc + bv[bj][1];
                        unsigned pa = 0u, pb = 0u;
#define G255(x) __builtin_amdgcn_rcpf(__builtin_amdgcn_exp2f(x) * (1.0f / 255.0f) + (1.0f / 255.0f))
                        pa = __builtin_amdgcn_cvt_pk_u8_f32(G255(v0[0]), 0, pa); pa = __builtin_amdgcn_cvt_pk_u8_f32(G255(v0[1]), 1, pa);
                        pa = __builtin_amdgcn_cvt_pk_u8_f32(G255(v0[2]), 2, pa); pa = __builtin_amdgcn_cvt_pk_u8_f32(G255(v0[3]), 3, pa);
                        pb = __builtin_amdgcn_cvt_pk_u8_f32(G255(v1[0]), 0, pb); pb = __builtin_amdgcn_cvt_pk_u8_f32(G255(v1[1]), 1, pb);
                        pb = __builtin_amdgcn_cvt_pk_u8_f32(G255(v1[2]), 2, pb); pb = __builtin_amdgcn_cvt_pk_u8_f32(G255(v1[3]), 3, pb);
#undef G255
                        EPI_ST((u32x2*)(rowp + bj * HALF), ((u32x2){pa, pb})); }
                }
        } else if (u.kind == K_BRANCH) {
            bf16_t* base = (bf16_t*)(ws + WS_MRG) + (size_t)u.pm * 256 * MRGLD + u.pn * 256; const unsigned char* gbase = scratch_tile(u.pm, u.pn);
            const bool first = (u.sub & 4) != 0;
            const float i255 = 1.0f / 255.0f;
#ifdef BR_ALL_IN_FLIGHT
            u32x2 gq2[2][4][2]; u32x4 tq[2][4][2];
#pragma unroll
            for (int ai = 0; ai < 2; ++ai)
#pragma unroll
                for (int m = 0; m < 4; ++m) { const int rl = rl0 + ai * HALF + m * 16;
#pragma unroll
                    for (int bj = 0; bj < 2; ++bj) { gq2[ai][m][bj] = EPI_LD((const u32x2*)(gbase + (size_t)rl * SCRLD + cl0 + bj * HALF));
                        tq[ai][m][bj] = first ? (u32x4){0u, 0u, 0u, 0u} : EPI_LD((const u32x4*)(base + (size_t)rl * MRGLD + cl0 + bj * HALF)); } }
#pragma unroll
            for (int ai = 0; ai < 2; ++ai) {
#pragma unroll
                for (int m = 0; m < 4; ++m) { const int rl = rl0 + ai * HALF + m * 16;
#pragma unroll
                    for (int bj = 0; bj < 2; ++bj) {
                        const u32x4 t = tq[ai][m][bj]; const f32x4 v0 = acc[ai][bj][m][0], v1 = acc[ai][bj][m][1]; const unsigned ga = gq2[ai][m][bj].x, gb = gq2[ai][m][bj].y;
                        u32x4 w;
                        w.x = pk2(bflo(t.x) + (float)(ga & 0xffu) * i255 * v0[0], bfhi(t.x) + (float)((ga >> 8) & 0xffu) * i255 * v0[1]);
                        w.y = pk2(bflo(t.y) + (float)((ga >> 16) & 0xffu) * i255 * v0[2], bfhi(t.y) + (float)(ga >> 24) * i255 * v0[3]);
                        w.z = pk2(bflo(t.z) + (float)(gb & 0xffu) * i255 * v1[0], bfhi(t.z) + (float)((gb >> 8) & 0xffu) * i255 * v1[1]);
                        w.w = pk2(bflo(t.w) + (float)((gb >> 16) & 0xffu) * i255 * v1[2], bfhi(t.w) + (float)(gb >> 24) * i255 * v1[3]);
                        EPI_ST((u32x4*)(base + (size_t)rl * MRGLD + cl0 + bj * HALF), w); } }
                asm volatile("" ::: "memory");
            }
#else
#pragma unroll
            for (int ai = 0; ai < 2; ++ai) {
                u32x2 gq2[4][2]; u32x4 tq[4][2];
#pragma unroll
                for (int m = 0; m < 4; ++m) { const int rl = rl0 + ai * HALF + m * 16;
#pragma unroll
                    for (int bj = 0; bj < 2; ++bj) { gq2[m][bj] = EPI_LD((const u32x2*)(gbase + (size_t)rl * SCRLD + cl0 + bj * HALF));
                        tq[m][bj] = first ? (u32x4){0u, 0u, 0u, 0u} : EPI_LD((const u32x4*)(base + (size_t)rl * MRGLD + cl0 + bj * HALF)); } }
#pragma unroll
                for (int m = 0; m < 4; ++m) { const int rl = rl0 + ai * HALF + m * 16;
#pragma unroll
                    for (int bj = 0; bj < 2; ++bj) {
                        const u32x4 t = tq[m][bj]; const f32x4 v0 = acc[ai][bj][m][0], v1 = acc[ai][bj][m][1]; const unsigned ga = gq2[m][bj].x, gb = gq2[m][bj].y;
                        u32x4 w;
                        w.x = pk2(bflo(t.x) + (float)(ga & 0xffu) * i255 * v0[0], bfhi(t.x) + (float)((ga >> 8) & 0xffu) * i255 * v0[1]);
                        w.y = pk2(bflo(t.y) + (float)((ga >> 16) & 0xffu) * i255 * v0[2], bfhi(t.y) + (float)(ga >> 24) * i255 * v0[3]);
                        w.z = pk2(bflo(t.z) + (float)(gb & 0xffu) * i255 * v1[0], bfhi(t.z) + (float)((gb >> 8) & 0xffu) * i255 * v1[1]);
                        w.w = pk2(bflo(t.w) + (float)((gb >> 16) & 0xffu) * i255 * v1[2], bfhi(t.w) + (float)(gb >> 24) * i255 * v1[3]);
                        EPI_ST((u32x4*)(base + (size_t)rl * MRGLD + cl0 + bj * HALF), w); } }
                asm volatile("" ::: "memory");
            }
#endif
        } else {
            bf16_t* base = (bf16_t*)(ws + WS_XN) + (size_t)u.pm * 256 * 1024 + u.pn * 256;
            const bool wxn = gnext != nullptr, fin = gfinal != nullptr;
            f32x4 gv[2][2];
#pragma unroll
            for (int bj = 0; bj < 2; ++bj)
#pragma unroll
                for (int n = 0; n < 2; ++n) gv[bj][n] = wxn ? *(const f32x4*)(gnext + u.pn * BM + cl0 + bj * HALF + 4 * n) : (fin ? *(const f32x4*)(gfinal + u.pn * BM + cl0 + bj * HALF + 4 * n) : (f32x4){0.f, 0.f, 0.f, 0.f});
#pragma unroll
            for (int ah = 0; ah < 4; ++ah) {
                const int ai = ah >> 1, m0 = (ah & 1) * 2;
                f32x4 xq[2][2][2];
#pragma unroll
                for (int mm = 0; mm < 2; ++mm) { const size_t goff = (size_t)(u.pm * BM + rl0 + ai * HALF + (m0 + mm) * 16) * D + u.pn * BM + cl0;
#pragma unroll
                    for (int bj = 0; bj < 2; ++bj) {
                        if (xin16) { const u32x4 t = *(const u32x4*)((const bf16_t*)((const char*)xin + (size_t)(u.pm * BM + rl0 + ai * HALF + (m0 + mm) * 16) * 4096 + 2048) + u.pn * BM + cl0 + bj * HALF);
                            xq[mm][bj][0] = (f32x4){bflo(t.x), bfhi(t.x), bflo(t.y), bfhi(t.y)}; xq[mm][bj][1] = (f32x4){bflo(t.z), bfhi(t.z), bflo(t.w), bfhi(t.w)}; }
                        else { xq[mm][bj][0] = *(const f32x4*)(xin + goff + bj * HALF); xq[mm][bj][1] = *(const f32x4*)(xin + goff + bj * HALF + 4); } } }
#pragma unroll
                for (int mm = 0; mm < 2; ++mm) {
                    const int m = m0 + mm, rl = rl0 + ai * HALF + m * 16;
                    const size_t goff = (size_t)(u.pm * BM + rl) * D + u.pn * BM + cl0;
                    float sq = 0.f;
#pragma unroll
                    for (int bj = 0; bj < 2; ++bj) {
                        const f32x4 v0 = acc[ai][bj][m][0] + xq[mm][bj][0], v1 = acc[ai][bj][m][1] + xq[mm][bj][1];
                        acc[ai][bj][m][0] = v0; acc[ai][bj][m][1] = v1;
                        if (!fin) {
                            if (xout16) *(u32x4*)((bf16_t*)((char*)xout + (size_t)(u.pm * BM + rl) * 4096 + 2048) + u.pn * BM + cl0 + bj * HALF) = (u32x4){pk2(v0[0], v0[1]), pk2(v0[2], v0[3]), pk2(v1[0], v1[1]), pk2(v1[2], v1[3])};
                            else { *(f32x4*)(xout + goff + bj * HALF) = v0; *(f32x4*)(xout + goff + bj * HALF + 4) = v1; } }
                        sq += (v0[0] * v0[0] + v0[1] * v0[1]) + (v0[2] * v0[2] + v0[3] * v0[3]) + (v1[0] * v1[0] + v1[1] * v1[1]) + (v1[2] * v1[2] + v1[3] * v1[3]);
                        if (wxn) { const f32x4 a = v0 * gv[bj][0], b = v1 * gv[bj][1];
                            u32x4 w; w.x = pk2(a[0], a[1]); w.y = pk2(a[2], a[3]); w.z = pk2(b[0], b[1]); w.w = pk2(b[2], b[3]);
                            *(u32x4*)(base + (size_t)rl * 1024 + cl0 + bj * HALF) = w; }
                    }
                    sq += shx(sq, 16, lane); sq += shx(sq, 32, lane);
                    if (fq == 0) spare[rl * 4 + wc] = sq;
                }
                asm volatile("" ::: "memory");
            }
            LDS_WAIT(); __builtin_amdgcn_s_barrier(); asm volatile("" ::: "memory");
            const int t_ = wr * 256 + wc * 64 + lane;
            unsigned* ssw = (unsigned*)(ws + WS_SS);
            if (t_ < 256) { const int rl = t_; const f32x4 p = *(const LAS f32x4*)(spare + rl * 4); const float tot = (p.x + p.y) + (p.z + p.w);
                if (fin) __hip_atomic_store(ssw + (size_t)(u.pm * BM + rl) * 4 + u.pn, __builtin_bit_cast(unsigned, tot), __ATOMIC_RELAXED, __HIP_MEMORY_SCOPE_AGENT);
                else ((float*)ssw)[(size_t)(u.pm * BM + rl) * 4 + u.pn] = tot; }
            if (fin) {
                unsigned* cnt = (unsigned*)(ws + WS_CTL) + CW_PANEL + 64 * u.pm;
                asm volatile("s_waitcnt vmcnt(0)" ::: "memory");
                __builtin_amdgcn_s_barrier(); asm volatile("" ::: "memory");
                if (t_ == 0) {
                    __hip_atomic_fetch_add(cnt, 1u, __ATOMIC_RELAXED, __HIP_MEMORY_SCOPE_AGENT);
                    unsigned sp_ = 0;
                    while (__hip_atomic_load(cnt, __ATOMIC_RELAXED, __HIP_MEMORY_SCOPE_AGENT) < 4u) { __builtin_amdgcn_s_sleep(1); if (++sp_ > (1u << 22)) break; }
                }
                __builtin_amdgcn_s_barrier(); asm volatile("" ::: "memory");
#pragma unroll
                for (int ai = 0; ai < 2; ++ai)
#pragma unroll
                    for (int m = 0; m < 4; ++m) {
                        const int rl = rl0 + ai * HALF + m * 16; const unsigned* sp4 = ssw + (size_t)(u.pm * BM + rl) * 4;
                        const float p0 = __builtin_bit_cast(float, __hip_atomic_load(sp4 + 0, __ATOMIC_RELAXED, __HIP_MEMORY_SCOPE_AGENT)), p1 = __builtin_bit_cast(float, __hip_atomic_load(sp4 + 1, __ATOMIC_RELAXED, __HIP_MEMORY_SCOPE_AGENT));
                        const float p2 = __builtin_bit_cast(float, __hip_atomic_load(sp4 + 2, __ATOMIC_RELAXED, __HIP_MEMORY_SCOPE_AGENT)), p3 = __builtin_bit_cast(float, __hip_atomic_load(sp4 + 3, __ATOMIC_RELAXED, __HIP_MEMORY_SCOPE_AGENT));
                        const float rs = rsqrtf(((p0 + p1) + (p2 + p3)) * (1.0f / 1024.0f) + EPS);
                        const size_t goff = (size_t)(u.pm * BM + rl) * D + u.pn * BM + cl0;
#pragma unroll
                        for (int bj = 0; bj < 2; ++bj) { *(f32x4*)(xout + goff + bj * HALF) = acc[ai][bj][m][0] * rs * gv[bj][0]; *(f32x4*)(xout + goff + bj * HALF + 4) = acc[ai][bj][m][1] * rs * gv[bj][1]; }
                    }
            }
        }
    }
};
}

struct Args {
    const float* x; const float* mem; const int* positions; const float* norm_g; const float* mem_norm_g; const float* w_in; const float* b_gate;
    const float* dn_conv_w; const float* dn_a_log; const float* dn_dt_bias; const float* dn_norm_g; const float* ret_norm_g; const float* w_mem_kv;
    const float* w_br_sb; const float* w_br_dn; const float* w_br_ret; const float* w_br_mem; const float* w_out; const float* final_norm_g;
    float* out; unsigned char* ws; int ph_lo, ph_hi, li, pad;
};
struct Frame { LAS unsigned char* lds; int tid, lane, wave, G, gw, NGW; };
DI Frame mkframe(int wv) {
    extern __shared__ __attribute__((aligned(16))) unsigned char lds_raw[];
    Frame F; F.lds = (LAS unsigned char*)lds_raw; F.tid = opaque_tid(wv); F.lane = F.tid & 63; F.wave = wv;
    F.G = gridDim.x; F.gw = opaque_bid() * NWAVES + F.wave; F.NGW = F.G * NWAVES; return F;
}
typedef const __attribute__((address_space(4))) Args* ArgsP;
DI ArgsP kargs() { unsigned long long p = (unsigned long long)__builtin_amdgcn_kernarg_segment_ptr(); asm volatile("" : "+s"(p)); return (ArgsP)p; }
DI unsigned char* rst_base(ArgsP ap, int l) { return l == 0 ? (unsigned char*)ap->out : ap->ws + WS_WG + (size_t)(l - 1) * 4096 * 1024 * 2; }

struct TItem { const float* W; bf16_t* WT; int K, Nsrc, k0, csrc, rdst, rs; };
DI void titem_load(const TItem& t, int lane, float (&v)[32]) {
#pragma unroll
    for (int i = 0; i < 32; ++i) v[i] = t.W[(size_t)(t.k0 + 2 * i + (lane >> 5)) * t.Nsrc + t.csrc + (lane & 31)];
}
DI void titem_store(LAS float* scr, int lane, const TItem& t, const float (&v)[32]) {
#pragma unroll
    for (int i = 0; i < 32; ++i) scr[(2 * i + (lane >> 5)) * 33 + (lane & 31)] = v[i];
    LDS_WAIT(); asm volatile("" ::: "memory");
    const int c = lane & 7;
#pragma unroll
    for (int j = 0; j < 4; ++j) { const int n = (lane >> 3) + 8 * j; const LAS float* sp = scr + (8 * c) * 33 + n;
        u32x4 o; o.x = pk2(sp[0 * 33], sp[1 * 33]); o.y = pk2(sp[2 * 33], sp[3 * 33]); o.z = pk2(sp[4 * 33], sp[5 * 33]); o.w = pk2(sp[6 * 33], sp[7 * 33]);
        *(u32x4*)(t.WT + (size_t)(t.rdst + n * t.rs) * t.K + t.k0 + 8 * c) = o; }
    LDS_WAIT(); asm volatile("" ::: "memory");
}
DI void memn_rows(const Frame& F, ArgsP ap, int l) {
    unsigned char* ws = ap->ws;
    for (int m = F.gw; m < BATCH * MEMLEN; m += F.NGW) {
        const f32x4* xr = (const f32x4*)(ap->mem + (size_t)m * D) + F.lane; const f32x4* gr = (const f32x4*)(ap->mem_norm_g + (size_t)l * D) + F.lane;
        f32x4 v[4]; float sq = 0.f;
#pragma unroll
        for (int j = 0; j < 4; ++j) { v[j] = xr[64 * j]; sq += (v[j].x * v[j].x + v[j].y * v[j].y) + (v[j].z * v[j].z + v[j].w * v[j].w); }
        const float rs = rsqrtf(wave_sum(sq, F.lane) * (1.f / D) + EPS);
        unsigned long long* o8 = (unsigned long long*)((bf16_t*)(ws + WS_MEMN) + (size_t)m * D) + F.lane;
#pragma unroll
        for (int j = 0; j < 4; ++j) { const f32x4 g = gr[64 * j];
            o8[64 * j] = (unsigned long long)pk2(v[j].x * rs * g.x, v[j].y * rs * g.y) | ((unsigned long long)pk2(v[j].z * rs * g.z, v[j].w * rs * g.w) << 32); }
    }
}
struct TSeg { int src, K, Nsrc, c0, ncols, dst, r0; };
DI void convert_weights(const Frame& F, ArgsP ap, int l, int first, int stride, int part) {
    unsigned char* ws = ap->ws;
    LAS float* scr = (LAS float*)(F.lds + F.wave * 16384);
    constexpr int NSEG = 14;
    const TSeg seg[NSEG] = {
        {0, 1024, IN_COLS, 2048, 2048, 0, 0}, {0, 1024, IN_COLS, 5640, 256, 0, 2304}, {0, 1024, IN_COLS, 4104, 256, 0, 2560}, {0, 1024, IN_COLS, 4360, 256, 0, 2816},
        {0, 1024, IN_COLS, 0, 1024, 1, 0}, {0, 1024, IN_COLS, 1536, 512, 1, 1024}, {0, 1024, IN_COLS, 5128, 512, 1, 1536}, {0, 1024, IN_COLS, 1024, 512, 1, 2048}, {0, 1024, IN_COLS, 4616, 512, 1, 2560},
        {0, 1024, IN_COLS, 5896, 4096, 2, 0},
        {1, 512, 1024, 0, 1024, 3, 0}, {2, 512, 1024, 0, 1024, 3, 1024}, {3, 512, 1024, 0, 1024, 3, 2048}, {5, 1024, 1024, 0, 1024, 4, 0} };
    int cum[NSEG + 1]; cum[0] = 0;
#pragma unroll
    for (int q = 0; q < NSEG; ++q) cum[q + 1] = cum[q] + (seg[q].K / 64) * (seg[q].ncols / 32);
    const int per_layer = cum[NSEG] + (256 / 64) * (1024 / 32) + (1024 / 64) * (512 / 32);
    const int c9 = cum[9], c14m = cum[NSEG] + 128;
    const int n1 = c9 + (per_layer - c14m), n2 = c14m - c9, nit = part == 0 ? per_layer : (part == 1 ? n1 : n2);
    auto params = [&](int it, TItem& t) -> bool {
        if (it >= nit) return false;
        int r = part == 0 ? it : (part == 1 ? (it < c9 ? it : it - c9 + c14m) : it + c9);
        const float* W; int K, Nsrc, c0, ncols, r0; bf16_t* WT; bool perm = false;
        if (r < cum[NSEG]) {
            int q = 0;
#pragma unroll
            for (int qq = 1; qq < NSEG; ++qq) if (r >= cum[qq]) q = qq;
            int src = 0, dst = 0; K = 1024; Nsrc = IN_COLS; c0 = 0; ncols = 32; r0 = 0; int base = 0;
#pragma unroll
            for (int qq = 0; qq < NSEG; ++qq) if (q == qq) { src = seg[qq].src; K = seg[qq].K; Nsrc = seg[qq].Nsrc; c0 = seg[qq].c0; ncols = seg[qq].ncols; dst = seg[qq].dst; r0 = seg[qq].r0; base = cum[qq]; }
            r -= base; perm = (q == 2 || q == 3);
            W = src == 0 ? ap->w_in + (size_t)l * D * IN_COLS : src == 1 ? ap->w_br_sb + (size_t)l * 512 * 1024 : src == 2 ? ap->w_br_dn + (size_t)l * 512 * 1024 : src == 3 ? ap->w_br_ret + (size_t)l * 512 * 1024 : ap->w_out + (size_t)l * 1024 * 1024;
            WT = dst == 0 ? (bf16_t*)(ws + WS_WINA) + (size_t)l * 3072 * 1024 : dst == 1 ? (bf16_t*)(ws + WS_WINB) + (size_t)l * 3072 * 1024 : dst == 2 ? (bf16_t*)(ws + WS_WG) + (size_t)l * 4096 * 1024
               : dst == 3 ? (bf16_t*)(ws + WS_WBR) + (size_t)l * 2 * 1024 * 1024 : (bf16_t*)(ws + WS_WOUT) + (size_t)l * 1024 * 1024;
            if (dst == 3) { WT += (size_t)r0 * 512; r0 = 0; }
        } else if (r < cum[NSEG] + 128) { r -= cum[NSEG]; W = ap->w_br_mem + (size_t)l * 256 * 1024; K = 256; Nsrc = 1024; c0 = 0; ncols = 1024; r0 = 0; WT = (bf16_t*)(ws + WS_WBR) + (size_t)l * 2 * 1024 * 1024 + 3 * 1024 * 512; }
        else { r -= cum[NSEG] + 128; W = ap->w_mem_kv + (size_t)l * 1024 * 512; K = 1024; Nsrc = 512; c0 = 0; ncols = 512; r0 = 0; WT = (bf16_t*)(ws + WS_WKV) + (size_t)l * 512 * 1024; }
        const int nblk = ncols / 32, kb = r / nblk, nb = r % nblk;
        t.W = W; t.WT = WT; t.K = K; t.Nsrc = Nsrc; t.k0 = 64 * kb; t.csrc = c0 + 32 * nb; t.rdst = perm ? r0 + (nb >> 1) * 64 + (nb & 1) : r0 + 32 * nb; t.rs = perm ? 2 : 1;
        return true;
    };
    {
        TItem ta, tb; float va[32], vb[32];
        int it = first;
        bool ha = params(it, ta); if (ha) titem_load(ta, F.lane, va);
        while (ha) {
            it += stride; const bool hb = params(it, tb); if (hb) titem_load(tb, F.lane, vb);
            titem_store(scr, F.lane, ta, va);
            if (!hb) break;
            it += stride; ha = params(it, ta); if (ha) titem_load(ta, F.lane, va);
            titem_store(scr, F.lane, tb, vb);
        }
    }
    if (part != 2) {
        const float* win = ap->w_in + (size_t)l * D * IN_COLS; bf16_t* wa = (bf16_t*)(ws + WS_WINA) + (size_t)l * 3072 * 1024;
        for (int i = first * 64 + F.lane; i < 256 * 1024; i += stride * 64) { const int r = i >> 10, k = i & 1023;
            wa[(size_t)(2048 + r) * 1024 + k] = r < 8 ? (bf16_t)f2bf(win[(size_t)k * IN_COLS + 4096 + r]) : (bf16_t)0; }
    }
}
DI void p0_prologue(int wv) {
    const Frame F = mkframe(wv);
    const ArgsP ap = kargs();
    unsigned char* ws = ap->ws;
#ifdef PROBE_PRO
    unsigned long long tq0_ = __builtin_amdgcn_s_memrealtime();
#define PRO_ECHO(k) do { asm volatile("s_waitcnt vmcnt(0)" ::: "memory"); const unsigned long long t1_ = __builtin_amdgcn_s_memrealtime(); if (PROBE_PRO == (k)) { const unsigned long long d_ = t1_ - tq0_; while (__builtin_amdgcn_s_memrealtime() - t1_ < d_) __builtin_amdgcn_s_sleep(2); } tq0_ = __builtin_amdgcn_s_memrealtime(); } while (0)
#else
#define PRO_ECHO(k) do { } while (0)
#endif
    convert_weights(F, ap, 0, F.gw, F.NGW, 1);
    PRO_ECHO(1);
    constexpr int XNR = 4;
    for (int m = XNR * F.gw; m < T; m += XNR * F.NGW) {
        f32x4 v[XNR][4]; const f32x4* gr = (const f32x4*)ap->norm_g + F.lane;
#pragma unroll
        for (int q = 0; q < XNR; ++q)
#pragma unroll
            for (int j = 0; j < 4; ++j) v[q][j] = ((const f32x4*)(ap->x + (size_t)(m + q) * D) + F.lane)[64 * j];
#pragma unroll
        for (int q = 0; q < XNR; ++q) {
            unsigned long long* o8 = (unsigned long long*)((bf16_t*)(ws + WS_XN) + (size_t)(m + q) * D) + F.lane; float sq = 0.f;
#pragma unroll
            for (int j = 0; j < 4; ++j) { const f32x4 x = v[q][j], g = gr[64 * j]; sq += (x.x * x.x + x.y * x.y) + (x.z * x.z + x.w * x.w);
                o8[64 * j] = (unsigned long long)pk2(x.x * g.x, x.y * g.y) | ((unsigned long long)pk2(x.z * g.z, x.w * g.w) << 32); }
            sq = wave_sum(sq, F.lane);
            if (F.lane == 0) *(f32x4*)((float*)(ws + WS_SS) + (size_t)(m + q) * 4) = (f32x4){sq, 0.f, 0.f, 0.f};
        }
    }
    PRO_ECHO(2);
    memn_rows(F, ap, 0);
    PRO_ECHO(3);
    for (int i = F.gw * 64 + F.lane; i < T * 32; i += F.NGW * 64) {
        const int t = i >> 5, f = i & 31;
        const float inv = exp2f(-(float)f * (13.287712379549449f / 32.0f));
        const float ang = (float)ap->positions[t] * inv;
#ifdef ROPE_FAST_SINCOS
        const float rev = ang * 0.15915494309189535f; const float fr = rev - floorf(rev);
        const float sn = __builtin_amdgcn_sinf(fr), cs = __builtin_amdgcn_cosf(fr);
#else
        float sn, cs; sincosf(ang, &sn, &cs);
#endif
        ((float*)(ws + WS_ROPE))[i] = cs; ((float*)(ws + WS_ROPE))[T * 32 + i] = sn;
    }
}

struct SchedP1 {
    gm::TileOrder ord; unsigned char* ws; int l, half, c; bool with_kvm;
    DI void a_ready(const gm::Unit&, int, int) const {}
    DI bool next(int i, gm::Unit& u) const {
        int pm, pn;
        if (ord.tile(i, pm, pn)) {
            const bf16_t* xn = (const bf16_t*)(ws + WS_XN) + (size_t)pm * 256 * 1024;
            const bf16_t* w = (const bf16_t*)(ws + (half == 0 ? WS_WINA : WS_WINB)) + ((size_t)l * 3072 + pn * 256) * 1024;
            u.lda = 1024; u.K = 1024; u.ldb = 1024; u.l = l; u.sub = half;
            if (half == 1 && pn >= 8) { u.A = w; u.B = xn; u.pm = pn - 8; u.pn = pm; u.kind = gm::K_STORE_T; u.sub = 0; }
            else { u.A = xn; u.B = w; u.pm = pm; u.pn = pn; u.kind = (half == 0 && pn == 8) ? gm::K_AB : gm::K_STORE; }
            return true;
        }
        const int kc = ord.c - (ord.nwg % ord.G);
        if (with_kvm && kc >= 0 && kc < 16 && i == (ord.nwg + ord.G - 1 - ord.c) / ord.G) {
            const int ll = l, ty = (kc >> 3) & 1, idx = kc & 7;
            const bf16_t* mn = (const bf16_t*)(ws + WS_MEMN) + (size_t)(idx * 256) * 1024;
            const bf16_t* w = (const bf16_t*)(ws + WS_WKV) + ((size_t)ll * 512 + ty * 256) * 1024;
            u.lda = 1024; u.K = 1024; u.ldb = 1024; u.l = ll;
            if (ty == 0) { u.A = mn; u.B = w; u.pm = idx; u.pn = 0; u.kind = gm::K_STORE; u.sub = 2; }
            else { u.A = w; u.B = mn; u.pm = 0; u.pn = idx; u.kind = gm::K_STORE_T; u.sub = 1; }
            return true;
        }
        return false;
    }
};
struct SchedP3 {
    int pm, pn, l, rot; bool ok; unsigned char* ws;
    DI void a_ready(const gm::Unit& u, int wid, int lane) const {
        if (u.kind != gm::K_BRANCH || (u.sub & 4) == 0) return;
        if (wid == 0) {
            if (lane == 0) { unsigned* cnt = (unsigned*)(ws + WS_CTL) + CW_READY + 4096 * l + 64 * pm; unsigned sp = 0u;
                while (__hip_atomic_load(cnt, __ATOMIC_RELAXED, __HIP_MEMORY_SCOPE_AGENT) < 16u) { __builtin_amdgcn_s_sleep(2); if (++sp > (1u << 20)) break; } }
            __builtin_amdgcn_fence(__ATOMIC_ACQUIRE, "agent");
            asm volatile("s_waitcnt vmcnt(0)" ::: "memory");
        }
        asm volatile("" ::: "memory"); __builtin_amdgcn_s_barrier(); asm volatile("" ::: "memory");
    }
    DI bool next(int i, gm::Unit& u) const {
        if (!ok || i >= 8) return false;
        const int br = ((i >> 1) + rot) & 3;
        const bf16_t* R = (const bf16_t*)(ws + WS_R); const bf16_t* P = (const bf16_t*)(ws + WS_P);
        u.pm = pm; u.pn = pn; u.sub = br | ((i >> 1) == 0 ? 4 : 0); u.l = l;
        if ((i & 1) == 0) {
            u.A = (const bf16_t*)(ws + WS_XN) + (size_t)pm * 256 * 1024; u.lda = 1024; u.K = 1024; u.ldb = 1024;
            u.B = (const bf16_t*)(ws + WS_WG) + ((size_t)l * 4096 + br * 1024 + pn * 256) * 1024;
            u.kind = gm::K_GATE;
        } else {
            const bf16_t* wbr = (const bf16_t*)(ws + WS_WBR) + (size_t)l * 2 * 1024 * 1024 + (size_t)br * 1024 * 512;
            const int K = br == 3 ? 256 : 512;
            const int acol = br == 0 ? RB_SBQ : (br == 1 ? P_DNZ : (br == 2 ? RB_RTZ : P_MEMQ));
            const bool inP = (br & 1) != 0;
            u.lda = inP ? PLD : RBLD; u.A = (inP ? P : R) + (size_t)pm * 256 * u.lda + acol; u.K = K; u.ldb = K; u.B = wbr + (size_t)pn * 256 * K;
            u.kind = gm::K_BRANCH;
        }
        return true;
    }
};
struct SchedP4 {
    int pm, pn, l; bool ok; unsigned char* ws;
    DI void a_ready(const gm::Unit&, int, int) const {}
    DI bool next(int i, gm::Unit& u) const {
        if (!ok || i >= 1) return false;
        u.A = (const bf16_t*)(ws + WS_MRG) + (size_t)pm * 256 * MRGLD; u.lda = MRGLD; u.K = 1024; u.ldb = 1024;
        u.B = (const bf16_t*)(ws + WS_WOUT) + ((size_t)l * 1024 + pn * 256) * 1024;
        u.pm = pm; u.pn = pn; u.kind = gm::K_OUT; u.sub = 0; u.l = l;
        return true;
    }
};

typedef float f32x16 __attribute__((ext_vector_type(16)));
typedef short s16x4 __attribute__((ext_vector_type(4)));
#define MFMA32(a, b, c) __builtin_amdgcn_mfma_f32_32x32x16_bf16((a), (b), (c), 0, 0, 0)
DI int crow(int reg, int hh) { return (reg & 3) + 8 * (reg >> 2) + 4 * hh; }
DI bf16x8 pack8(float a0, float a1, float a2, float a3, float a4, float a5, float a6, float a7) {
    u32x4 p;
    asm volatile("s_nop 0\n\tv_cvt_pk_bf16_f32 %0, %4, %5\n\tv_cvt_pk_bf16_f32 %1, %6, %7\n\tv_cvt_pk_bf16_f32 %2, %8, %9\n\tv_cvt_pk_bf16_f32 %3, %10, %11\n\ts_nop 1"
                 : "=&v"(p[0]), "=&v"(p[1]), "=&v"(p[2]), "=&v"(p[3]) : "v"(a0), "v"(a1), "v"(a2), "v"(a3), "v"(a4), "v"(a5), "v"(a6), "v"(a7));
    return __builtin_bit_cast(bf16x8, p);
}
DI bf16x8 pack8m(float a0, float a1, float a2, float a3, float a4, float a5, float a6, float a7) {
    u32x4 p;
    asm volatile("s_nop 15\n\ts_nop 3\n\tv_cvt_pk_bf16_f32 %0, %4, %5\n\tv_cvt_pk_bf16_f32 %1, %6, %7\n\tv_cvt_pk_bf16_f32 %2, %8, %9\n\tv_cvt_pk_bf16_f32 %3, %10, %11\n\ts_nop 1"
                 : "=&v"(p[0]), "=&v"(p[1]), "=&v"(p[2]), "=&v"(p[3]) : "v"(a0), "v"(a1), "v"(a2), "v"(a3), "v"(a4), "v"(a5), "v"(a6), "v"(a7));
    return __builtin_bit_cast(bf16x8, p);
}
namespace at {
constexpr int KST = 144, VST = 136;
constexpr int KT_BYTES = 64 * KST;
DI bf16x8 kfrag(LAS unsigned char* kt, int row, int ks, int hh) { return *(const LAS bf16x8*)(kt + row * KST + ks * 32 + hh * 16); }
DI bf16x8 vfrag(LAS unsigned char* vt, int row, int keyoff, int hh) {
    const LAS unsigned char* pp = vt + row * VST + (keyoff + 4 * hh) * 2;
    const u32x2 lo = *(const LAS u32x2*)pp, hi = *(const LAS u32x2*)(pp + 16);
    u32x4 r; r.x = lo.x; r.y = lo.y; r.z = hi.x; r.w = hi.y; return __builtin_bit_cast(bf16x8, r);
}
}

DI void mem_unit(int wv, int l, int unit) {
    const Frame F = mkframe(wv);
    unsigned char* ws = kargs()->ws; bf16_t* P = (bf16_t*)(ws + WS_P);
    const bf16_t* KM = (const bf16_t*)(ws + WS_KVM) + (size_t)l * 1024 * 1024; const bf16_t* VTM = KM + 2048 * 256;
    const int b = unit >> 5, h = (unit >> 3) & 3, qt = unit & 7, lane = F.lane, r = lane & 31, hh = lane >> 5;
    LAS unsigned char* kt = F.lds; LAS unsigned char* vt = F.lds + 256 * at::KST;
    constexpr int VS = 520;
#pragma unroll
    for (int i = 0; i < 4; ++i) { const int id = F.tid + 512 * i, row = id >> 3, ch = id & 7;
        const u32x4 v = *(const u32x4*)(KM + (size_t)(b * 256 + row) * 256 + h * 64 + ch * 8);
        *(LAS u32x4*)(kt + row * at::KST + ch * 16) = v; }
#pragma unroll
    for (int i = 0; i < 4; ++i) { const int id = F.tid + 512 * i, row = id >> 5, ch = id & 31;
        const u32x4 v = *(const u32x4*)(VTM + (size_t)(h * 64 + row) * 2048 + b * 256 + ch * 8);
        *(LAS u32x2*)(vt + row * VS + ch * 16) = (u32x2){v.x, v.y}; *(LAS u32x2*)(vt + row * VS + ch * 16 + 8) = (u32x2){v.z, v.w}; }
    const int t = b * SEQ + qt * 256 + wv * 32 + r;
    bf16_t* qp = P + (size_t)t * PLD + P_MEMQ + h * 64;
    bf16x8 qf[4];
#pragma unroll
    for (int ks = 0; ks < 4; ++ks) qf[ks] = *(const bf16x8*)(qp + 16 * ks + 8 * hh);
    __syncthreads();
    f32x16 z[8];
#pragma unroll
    for (int st = 0; st < 8; ++st) {
        f32x16 a = {0.f, 0.f, 0.f, 0.f, 0.f, 0.f, 0.f, 0.f, 0.f, 0.f, 0.f, 0.f, 0.f, 0.f, 0.f, 0.f};
#pragma unroll
        for (int ks = 0; ks < 4; ++ks) a = MFMA32(at::kfrag(kt, 32 * st + r, ks, hh), qf[ks], a);
        z[st] = a;
    }
    float mx = -3.0e38f;
#pragma unroll
    for (int st = 0; st < 8; ++st)
#pragma unroll
        for (int i = 0; i < 16; ++i) mx = fmaxf(mx, z[st][i]);
    mx = fmaxf(mx, shx(mx, 32, lane));
    const float c2 = 0.125f * 1.4426950408889634f; float sum = 0.f;
#pragma unroll
    for (int st = 0; st < 8; ++st)
#pragma unroll
        for (int i = 0; i < 16; ++i) { const float e = exp2f((z[st][i] - mx) * c2); z[st][i] = e; sum += e; }
    sum += shx(sum, 32, lane);
    f32x16 o0 = {0.f, 0.f, 0.f, 0.f, 0.f, 0.f, 0.f, 0.f, 0.f, 0.f, 0.f, 0.f, 0.f, 0.f, 0.f, 0.f}, o1 = o0;
#pragma unroll
    for (int st = 0; st < 8; ++st)
#pragma unroll
        for (int s2 = 0; s2 < 2; ++s2) {
            const bf16x8 pf = pack8(z[st][8 * s2], z[st][8 * s2 + 1], z[st][8 * s2 + 2], z[st][8 * s2 + 3], z[st][8 * s2 + 4], z[st][8 * s2 + 5], z[st][8 * s2 + 6], z[st][8 * s2 + 7]);
            const int keyoff = 32 * st + 16 * s2;
            { const LAS unsigned char* pp = vt + r * VS + (keyoff + 4 * hh) * 2; const u32x2 lo = *(const LAS u32x2*)pp, hi = *(const LAS u32x2*)(pp + 16);
              u32x4 q; q.x = lo.x; q.y = lo.y; q.z = hi.x; q.w = hi.y; o0 = MFMA32(__builtin_bit_cast(bf16x8, q), pf, o0); }
            { const LAS unsigned char* pp = vt + (32 + r) * VS + (keyoff + 4 * hh) * 2; const u32x2 lo = *(const LAS u32x2*)pp, hi = *(const LAS u32x2*)(pp + 16);
              u32x4 q; q.x = lo.x; q.y = lo.y; q.z = hi.x; q.w = hi.y; o1 = MFMA32(__builtin_bit_cast(bf16x8, q), pf, o1); }
        }
    const float inv = 1.f / sum;
    LAS unsigned char* ob = F.lds + 73728 + wv * (32 * at::KST);
#pragma unroll
    for (int g = 0; g < 4; ++g) {
        *(LAS u32x2*)(ob + r * at::KST + (8 * g + 4 * hh) * 2) = (u32x2){pk2(o0[4 * g] * inv, o0[4 * g + 1] * inv), pk2(o0[4 * g + 2] * inv, o0[4 * g + 3] * inv)};
        *(LAS u32x2*)(ob + r * at::KST + (32 + 8 * g + 4 * hh) * 2) = (u32x2){pk2(o1[4 * g] * inv, o1[4 * g + 1] * inv), pk2(o1[4 * g + 2] * inv, o1[4 * g + 3] * inv)};
    }
#pragma unroll
    for (int k = 0; k < 4; ++k) { const int q = k * 64 + lane, row = q >> 3, pc = q & 7;
        st16_wt(P + (size_t)(t - r + row) * PLD + P_MEMQ + h * 64 + pc * 8, *(const LAS u32x4*)(ob + row * at::KST + pc * 16)); }
    unit_done(ws, l, b * 8 + qt, F.tid);
}

DI void ret_rope_prep(int wv, int c, int n) {
    const Frame F = mkframe(wv);
    unsigned char* ws = kargs()->ws; bf16_t* P = (bf16_t*)(ws + WS_P);
    const float* rc = (const float*)(ws + WS_ROPE); const float* rsn = rc + T * 32;
    for (int it = c * NTHREADS + F.tid; it < T * 32; it += n * NTHREADS) {
        const int t = it >> 5, w = (it >> 4) & 1, h = (it >> 2) & 3, g = it & 3;
        bf16_t* pp = P + (size_t)t * PLD + (w ? P_RTK : P_RTQ) + h * 64 + g * 8;
        const u32x4 a = *(const u32x4*)pp, bq = *(const u32x4*)(pp + 32);
        const f32x4 c0 = *(const f32x4*)(rc + (size_t)t * 32 + g * 8), c1 = *(const f32x4*)(rc + (size_t)t * 32 + g * 8 + 4);
        const f32x4 s0 = *(const f32x4*)(rsn + (size_t)t * 32 + g * 8), s1 = *(const f32x4*)(rsn + (size_t)t * 32 + g * 8 + 4);
        const float sc = w ? 0.125f : 1.0f;
        float x1[8] = {bflo(a.x), bfhi(a.x), bflo(a.y), bfhi(a.y), bflo(a.z), bfhi(a.z), bflo(a.w), bfhi(a.w)};
        float x2[8] = {bflo(bq.x), bfhi(bq.x), bflo(bq.y), bfhi(bq.y), bflo(bq.z), bfhi(bq.z), bflo(bq.w), bfhi(bq.w)};
        float cc[8] = {c0.x, c0.y, c0.z, c0.w, c1.x, c1.y, c1.z, c1.w}, ss[8] = {s0.x, s0.y, s0.z, s0.w, s1.x, s1.y, s1.z, s1.w};
        float y1[8], y2[8];
#pragma unroll
        for (int j = 0; j < 8; ++j) { y1[j] = (x1[j] * cc[j] - x2[j] * ss[j]) * sc; y2[j] = (x1[j] * ss[j] + x2[j] * cc[j]) * sc; }
        *(u32x4*)pp = (u32x4){pk2(y1[0], y1[1]), pk2(y1[2], y1[3]), pk2(y1[4], y1[5]), pk2(y1[6], y1[7])};
        *(u32x4*)(pp + 32) = (u32x4){pk2(y2[0], y2[1]), pk2(y2[2], y2[3]), pk2(y2[4], y2[5]), pk2(y2[6], y2[7])};
    }
}

DI void ret_state_unit(int wv, int l, int unit) {
    const Frame F = mkframe(wv);
    unsigned char* ws = kargs()->ws; const bf16_t* P = (const bf16_t*)(ws + WS_P);
    const int bh = unit / 7, c = unit - 7 * bh, b = bh >> 2, h = bh & 3, lane = F.lane, r = lane & 31, hh = lane >> 5;
    const int s0 = b * SEQ + c * 256;
    const bf16_t* VTg = (const bf16_t*)(ws + WS_VTRT) + (size_t)h * 128 * VTLD + s0;
    const bf16_t* Kg = P + (size_t)s0 * PLD + P_RTK + h * 64;
    constexpr int RS = 528;
    LAS unsigned char* vt = F.lds; LAS unsigned char* kT = F.lds + 128 * RS;
    const float lg = log2f(1.0f - exp2f(-5.0f - (float)h));
    u32x4 vv[8], kv[4];
#pragma unroll
    for (int i = 0; i < 8; ++i) { const int id = F.tid + 512 * i, row = id >> 5, ch = id & 31; vv[i] = *(const u32x4*)(VTg + (size_t)row * VTLD + ch * 8); }
    const int key = F.tid >> 1, chb = (F.tid & 1) * 32;
#pragma unroll
    for (int i = 0; i < 4; ++i) kv[i] = *(const u32x4*)(Kg + (size_t)key * PLD + chb + 8 * i);
#pragma unroll
    for (int i = 0; i < 8; ++i) { const int id = F.tid + 512 * i, row = id >> 5, ch = id & 31; *(LAS u32x4*)(vt + row * RS + ch * 16) = vv[i]; }
    const float fk = exp2f(lg * (float)(255 - key));
#pragma unroll
    for (int i = 0; i < 4; ++i) {
        const unsigned w4[4] = {kv[i].x, kv[i].y, kv[i].z, kv[i].w};
#pragma unroll
        for (int j = 0; j < 4; ++j) { const unsigned u2 = pk2(bflo(w4[j]) * fk, bfhi(w4[j]) * fk);
            LAS unsigned char* wp = kT + (chb + 8 * i + 2 * j) * RS + key * 2;
            *(LAS unsigned short*)wp = (unsigned short)u2; *(LAS unsigned short*)(wp + RS) = (unsigned short)(u2 >> 16); }
    }
    __syncthreads();
    const int d = wv & 3, e = wv >> 2;
    f32x16 acc = {0.f, 0.f, 0.f, 0.f, 0.f, 0.f, 0.f, 0.f, 0.f, 0.f, 0.f, 0.f, 0.f, 0.f, 0.f, 0.f};
#pragma unroll
    for (int sk = 0; sk < 16; ++sk)
        acc = MFMA32(*(const LAS bf16x8*)(vt + (32 * d + r) * RS + (16 * sk + 8 * hh) * 2), *(const LAS bf16x8*)(kT + (32 * e + r) * RS + (16 * sk + 8 * hh) * 2), acc);
    unsigned* Lp = (unsigned*)rst_base(kargs(), l) + (size_t)unit * 8192 + 32 * e + r;
    __builtin_amdgcn_sched_barrier(0); asm volatile("s_nop 15\n\ts_nop 3" ::: "memory"); __builtin_amdgcn_sched_barrier(0);
#pragma unroll
    for (int i = 0; i < 16; ++i) { unsigned* sp_ = Lp + (size_t)(32 * d + crow(i, hh)) * 64; const float av_ = acc[i];
        asm volatile("global_store_dword %0, %1, off sc1" :: "v"(sp_), "v"(av_) : "memory"); }
    VM_WAIT(); lds_barrier();
    if (F.tid == 0) (void)__hip_atomic_fetch_add((unsigned*)(ws + WS_CTL) + CW_RST + 2048 * l + 64 * bh, 1u, __ATOMIC_RELAXED, __HIP_MEMORY_SCOPE_AGENT);
}

template <int MODE>
DI void attn_unit(int wv, int l, int unit) {
    constexpr int DV = MODE == 0 ? 64 : 128, NDT = DV / 32, VST2 = 144, VT_BYTES = DV * VST2, BUF = at::KT_BYTES + VT_BYTES;
    const Frame F = mkframe(wv);
    const ArgsP ap = kargs();
    unsigned char* ws = ap->ws; bf16_t* R = (bf16_t*)(ws + WS_R); bf16_t* P = (bf16_t*)(ws + WS_P);
    const int lane = F.lane, r = lane & 31, hh = lane >> 5, kap = 16 * ((r >> 2) & 1) + (r & 3) + 4 * (r >> 3);
    int b, h, qt;
    if (MODE == 0) { b = unit >> 6; h = (unit >> 3) & 7; qt = unit & 7; } else { qt = unit >> 5; b = (unit >> 2) & 7; h = unit & 3; }
    const int q0 = qt * 256, qw0 = q0 + 32 * wv, tq = qw0 + r, t = b * SEQ + tq;
    const bf16_t* Kg = MODE == 0 ? R + RB_SBK + h * 64 : P + P_RTK + h * 64; const int kld = MODE == 0 ? RBLD : PLD;
    const bf16_t* VTg = (const bf16_t*)(ws + (MODE == 0 ? WS_VTSB : WS_VTRT)) + (size_t)h * DV * VTLD + b * SEQ;
    const bf16_t* qp = MODE == 0 ? R + (size_t)t * RBLD + RB_SBQ + h * 64 : P + (size_t)t * PLD + P_RTQ + h * 64;
    bf16x8 qf[4];
#pragma unroll
    for (int ks = 0; ks < 4; ++ks) qf[ks] = *(const bf16x8*)(qp + 16 * ks + 8 * hh);
    f32x16 o[NDT];
#pragma unroll
    for (int d = 0; d < NDT; ++d) o[d] = (f32x16){0.f, 0.f, 0.f, 0.f, 0.f, 0.f, 0.f, 0.f, 0.f, 0.f, 0.f, 0.f, 0.f, 0.f, 0.f, 0.f};
    volatile LAS unsigned* flags = (volatile LAS unsigned*)(F.lds + 2 * BUF);
    const int jtop = (q0 + 255) >> 6;
    const int srow = F.tid >> 3, sch = F.tid & 7;
    u32x4 kreg, vreg[NDT / 2];
#define AT_LOAD(j) do { const int key0_ = (j) * 64; kreg = *(const u32x4*)(Kg + (size_t)(b * SEQ + key0_ + srow) * kld + sch * 8); \
        _Pragma("unroll") for (int i_ = 0; i_ < NDT / 2; ++i_) vreg[i_] = *(const u32x4*)(VTg + (size_t)(srow + 64 * i_) * VTLD + key0_ + sch * 8); } while (0)
#define AT_WRITE(pbuf) do { LAS unsigned char* kb_ = F.lds + (pbuf) * BUF; *(LAS u32x4*)(kb_ + srow * at::KST + sch * 16) = kreg; \
        _Pragma("unroll") for (int i_ = 0; i_ < NDT / 2; ++i_) *(LAS u32x4*)(kb_ + at::KT_BYTES + (srow + 64 * i_) * VST2 + sch * 16) = vreg[i_]; } while (0)
    AT_LOAD(jtop); AT_WRITE(0);
    lds_barrier();
    float carry = MODE == 0 ? 1.f : 0.f; bool done_w = false;
    const float c2 = 0.125f * 1.4426950408889634f;
    const float lg = MODE == 1 ? log2f(1.0f - exp2f(-5.0f - (float)h)) : 0.f;
    float bfac[16];
#pragma unroll
    for (int i = 0; i < 16; ++i) bfac[i] = MODE == 1 ? exp2f(-lg * (float)i) : 0.f;
    const int jlo = MODE == 1 ? (q0 >> 6) : 0;
    if (MODE == 1 && qt > 0) {
        unsigned* cnt = (unsigned*)(ws + WS_CTL) + CW_RST + 2048 * l + 64 * (b * 4 + h);
        if (wv == 0) {
            if (lane == 0) { unsigned sp = 0u; while (__hip_atomic_load(cnt, __ATOMIC_RELAXED, __HIP_MEMORY_SCOPE_AGENT) < 7u) { __builtin_amdgcn_s_sleep(2); if (++sp > (1u << 20)) break; } }
            __builtin_amdgcn_fence(__ATOMIC_ACQUIRE, "agent");
            asm volatile("s_waitcnt vmcnt(0)" ::: "memory");
        }
        lds_barrier();
        const float* L0 = (const float*)rst_base(ap, l) + (size_t)((b * 4 + h) * 7) * 8192;
        const float g256 = exp2f(lg * 256.0f);
        LAS unsigned char* stI = F.lds + 65536;
#pragma unroll
        for (int k4 = 0; k4 < 4; ++k4) {
            const int e4 = (F.tid + 512 * k4) * 4;
            f32x4 a = {0.f, 0.f, 0.f, 0.f}; float wg = 1.0f;
            for (int c = qt - 1; c >= 0; --c) { const f32x4 x = *(const f32x4*)(L0 + (size_t)c * 8192 + e4);
                a += x * wg; wg *= g256; }
            *(LAS u32x2*)(stI + (e4 >> 6) * 144 + (e4 & 63) * 2) = (u32x2){pk2(a[0], a[1]), pk2(a[2], a[3])};
        }
        lds_barrier();
#pragma unroll
        for (int d = 0; d < NDT; ++d)
#pragma unroll
            for (int ks = 0; ks < 4; ++ks) o[d] = MFMA32(*(const LAS bf16x8*)(stI + (32 * d + r) * 144 + (16 * ks + 8 * hh) * 2), qf[ks], o[d]);
        const float fq = exp2f(lg * (float)(tq - q0 + 1));
#pragma unroll
        for (int d = 0; d < NDT; ++d) o[d] = o[d] * fq;
    }
    for (int j = jtop, it = 0; ; --j, ++it) {
        const int pbuf = it & 1;
        if (j > jlo) AT_LOAD(j - 1);
        LAS unsigned char* kt = F.lds + pbuf * BUF; LAS unsigned char* vt = kt + at::KT_BYTES;
        const int key0 = j * 64;
        if (!done_w) {
#pragma unroll
            for (int sti = 0; sti < 2; ++sti) {
                const int st = 1 - sti, ks0 = key0 + 32 * st;
                if (ks0 <= qw0 + 31 - (MODE == 0 ? 1 : 0)) {
                    const bool full = (ks0 + 31 < qw0);
                    f32x16 z = {0.f, 0.f, 0.f, 0.f, 0.f, 0.f, 0.f, 0.f, 0.f, 0.f, 0.f, 0.f, 0.f, 0.f, 0.f, 0.f};
#pragma unroll
                    for (int ks = 0; ks < 4; ++ks) z = MFMA32(at::kfrag(kt, 32 * st + kap, ks, hh), qf[ks], z);
                    float w[16];
                    const int kb = ks0 + 16 * hh;
                    if (MODE == 0) {
                        float sg[16], sn[16];
#pragma unroll
                        for (int i = 0; i < 16; i += 2) {
                            const f32x2 a2 = (f32x2){z[i], z[i + 1]} * (f32x2){-c2, -c2};
                            const f32x2 d2 = (f32x2){__builtin_amdgcn_exp2f(a2.x), __builtin_amdgcn_exp2f(a2.y)} + (f32x2){1.f, 1.f};
                            const f32x2 r2 = (f32x2){__builtin_amdgcn_rcpf(d2.x), __builtin_amdgcn_rcpf(d2.y)};
                            const f32x2 n2 = (f32x2){1.f, 1.f} - r2;
                            sg[i] = r2.x; sg[i + 1] = r2.y; sn[i] = n2.x; sn[i + 1] = n2.y;
                        }
                        if (!full) {
#pragma unroll
                            for (int i = 0; i < 16; ++i) { const bool m = (kb + i) < tq; sn[i] = m ? sn[i] : 1.f; sg[i] = m ? sg[i] : 0.f; }
                        }
                        float suf[16];
                        suf[15] = 1.f;
#pragma unroll
                        for (int i = 14; i >= 0; --i) suf[i] = suf[i + 1] * sn[i + 1];
                        const float tot = suf[0] * sn[0], totp = shx(tot, 32, lane);
                        const float base = carry * (hh == 0 ? totp : 1.f);
                        carry *= tot * totp;
#pragma unroll
                        for (int i = 0; i < 16; i += 2) { const f32x2 w2 = (f32x2){sg[i], sg[i + 1]} * ((f32x2){suf[i], suf[i + 1]} * (f32x2){base, base}); w[i] = w2.x; w[i + 1] = w2.y; }
                    } else {
                        const float af = __builtin_amdgcn_exp2f(lg * (float)(tq - kb));
                        if (full) {
#pragma unroll
                            for (int i = 0; i < 16; ++i) w[i] = z[i] * (af * bfac[i]);
                        } else {
#pragma unroll
                            for (int i = 0; i < 16; ++i) w[i] = (kb + i <= tq) ? z[i] * (af * bfac[i]) : 0.f;
                        }
                    }
#pragma unroll
                    for (int s2 = 0; s2 < 2; ++s2) {
                        const bf16x8 pf = pack8(w[8 * s2], w[8 * s2 + 1], w[8 * s2 + 2], w[8 * s2 + 3], w[8 * s2 + 4], w[8 * s2 + 5], w[8 * s2 + 6], w[8 * s2 + 7]);
#pragma unroll
                        for (int d = 0; d < NDT; ++d) o[d] = MFMA32(*(const LAS bf16x8*)(vt + (32 * d + r) * VST2 + (32 * st + 16 * hh + 8 * s2) * 2), pf, o[d]);
                    }
                }
            }
            if (MODE == 0) done_w = __all(carry < 1.1754944e-38f);
        }
        if (j > jlo) AT_WRITE(pbuf ^ 1);
        if (MODE == 0 && F.lane == 0) flags[(it & 1) * 8 + wv] = done_w ? 1u : 0u;
        lds_barrier();
        if (j == jlo) break;
        if (MODE == 0) { unsigned all = 1u;
#pragma unroll
            for (int w8 = 0; w8 < 8; ++w8) all &= flags[(it & 1) * 8 + w8];
            if (all) break; }
    }
#undef AT_LOAD
#undef AT_WRITE
    constexpr int OST = DV * 2 + 16, PPR = DV / 8;
    LAS unsigned char* ob = F.lds + wv * (32 * OST);
    if (MODE == 0) {
        bf16_t* op = R + (size_t)t * RBLD + RB_SBQ + h * 64; const bf16_t* zp = R + (size_t)t * RBLD + RB_SBZ + h * 64;
#pragma unroll
        for (int d = 0; d < NDT; ++d)
#pragma unroll
            for (int g = 0; g < 4; ++g) { const int c = 32 * d + 8 * g + 4 * hh; const u32x2 zz = *(const u32x2*)(zp + c);
                *(LAS u32x2*)(ob + r * OST + c * 2) = (u32x2){pk2(o[d][4 * g] * siluf_(bflo(zz.x)), o[d][4 * g + 1] * siluf_(bfhi(zz.x))), pk2(o[d][4 * g + 2] * siluf_(bflo(zz.y)), o[d][4 * g + 3] * siluf_(bfhi(zz.y)))}; }
#pragma unroll
        for (int k = 0; k < 32 * PPR / 64; ++k) { const int q = k * 64 + lane, row = q / PPR, pc = q % PPR;
            st16_wt(op + (ptrdiff_t)(row - r) * RBLD + pc * 8, *(const LAS u32x4*)(ob + row * OST + pc * 16)); }
    } else {
        float s1 = 0.f;
#pragma unroll
        for (int d = 0; d < NDT; ++d)
#pragma unroll
            for (int i = 0; i < 16; ++i) s1 += o[d][i];
        s1 += shx(s1, 32, lane);
        const float mu = s1 * (1.f / 128.f); float s2 = 0.f;
#pragma unroll
        for (int d = 0; d < NDT; ++d)
#pragma unroll
            for (int i = 0; i < 16; ++i) { const float dl = o[d][i] - mu; s2 += dl * dl; }
        s2 += shx(s2, 32, lane);
        const float rs = rsqrtf(s2 * (1.f / 128.f) + EPS);
        bf16_t* zp = R + (size_t)t * RBLD + RB_RTZ + h * 128; const float* gp = ap->ret_norm_g + (size_t)l * 512 + h * 128;
#pragma unroll
        for (int d = 0; d < NDT; ++d)
#pragma unroll
            for (int g = 0; g < 4; ++g) { const int c = 32 * d + 8 * g + 4 * hh; const u32x2 zz = *(const u32x2*)(zp + c); const f32x4 gg = *(const f32x4*)(gp + c);
                *(LAS u32x2*)(ob + r * OST + c * 2) = (u32x2){pk2((o[d][4 * g] - mu) * rs * gg.x * siluf_(bflo(zz.x)), (o[d][4 * g + 1] - mu) * rs * gg.y * siluf_(bfhi(zz.x))),
                                                             pk2((o[d][4 * g + 2] - mu) * rs * gg.z * siluf_(bflo(zz.y)), (o[d][4 * g + 3] - mu) * rs * gg.w * siluf_(bfhi(zz.y)))}; }
#pragma unroll
        for (int k = 0; k < 32 * PPR / 64; ++k) { const int q = k * 64 + lane, row = q / PPR, pc = q % PPR;
            st16_wt(zp + (ptrdiff_t)(row - r) * RBLD + pc * 8, *(const LAS u32x4*)(ob + row * OST + pc * 16)); }
    }
    unit_done(ws, l, b * 8 + qt, F.tid);
}

namespace dn {
constexpr int HC_BYTES = 73728, OFF_W = 0, OFF_QG = 16384, OFF_KD = 32768, OFF_AI = 49152, OFF_U = 57344;
constexpr int QST = 272, TST = 144;
constexpr int GRP_BYTES = 71680, Q_OFF = 0, K_OFF = 17408, KT_OFF = 34816, VT_OFF = 53248, VEC_OFF = 143360, VEC_BYTES = 2048;
}

DI void dn_prep(int wv, int l, int pair) {
    const Frame F = mkframe(wv);
    const ArgsP ap = kargs();
    unsigned char* ws = ap->ws;
    const int lane = F.lane, r = lane & 31, hh = lane >> 5, grp = wv >> 2, gw = wv & 3, gt = F.tid & 255;
    const int hc = pair * 2 + grp, h = hc & 3, bn = hc >> 2, b = bn >> 5, n = bn & 31, t0 = b * SEQ + n * 64;
    LAS unsigned char* gb = F.lds + grp * dn::GRP_BYTES;
    LAS unsigned char* qimg = gb + dn::Q_OFF; LAS unsigned char* kimg = gb + dn::K_OFF; LAS unsigned char* ktimg = gb + dn::KT_OFF; LAS unsigned char* vtimg = gb + dn::VT_OFF;
    LAS float* vec = (LAS float*)(F.lds + dn::VEC_OFF + grp * dn::VEC_BYTES);
    LAS float* gcv = vec; LAS float* btv = vec + 64; LAS float* f1v = vec + 128; LAS float* f2v = vec + 192; LAS float* egv = vec + 256;
    unsigned char* blk = ws + WS_DNI + (size_t)hc * dn::HC_BYTES;
    const bf16_t* RA = (const bf16_t*)(ws + WS_R); const float* cw = ap->dn_conv_w + (size_t)l * 4 * 1536; const float* AB = (const float*)(ws + WS_AB);
#ifdef PROBE_PREP
    unsigned long long tp0_ = __builtin_amdgcn_s_memrealtime();
#endif
    {
        const int g8 = gt & 15, ch = g8 * 8;
        float abA[4], abB[4];
#pragma unroll
        for (int k = 0; k < 4; ++k) { const int t = t0 + (gt >> 4) + 16 * k; abA[k] = AB[(size_t)t * 8 + h]; abB[k] = AB[(size_t)t * 8 + 4 + h]; }
        const float dtb = ap->dn_dt_bias[l * 4 + h], nalog = -__expf(ap->dn_a_log[l * 4 + h]);
        u32x4 xs[2][2][4]; f32x4 wj[4][2];
#define DNP_LOADX(st_, set_) do { const int col_ = ((st_) >> 1) * 512 + h * 128 + ch; \
        _Pragma("unroll") for (int kk_ = 0; kk_ < 2; ++kk_) _Pragma("unroll") for (int j_ = 0; j_ < 4; ++j_) { const int m_ = (gt >> 4) + 16 * (2 * ((st_) & 1) + kk_); \
            xs[set_][kk_][j_] = (n * 64 + m_ - 3 + j_ >= 0) ? *(const u32x4*)(RA + (size_t)(t0 + m_ - 3 + j_) * RALD + col_) : (u32x4){0u, 0u, 0u, 0u}; } } while (0)
        DNP_LOADX(0, 0);
#pragma unroll
        for (int st = 0; st < 6; ++st) {
            const int part = st >> 1, col = part * 512 + h * 128 + ch;
            if ((st & 1) == 0) {
#pragma unroll
                for (int j = 0; j < 4; ++j) { wj[j][0] = *(const f32x4*)(cw + j * 1536 + col); wj[j][1] = *(const f32x4*)(cw + j * 1536 + col + 4); } }
            if (st < 5) DNP_LOADX(st + 1, (st + 1) & 1);
#pragma unroll
            for (int kk = 0; kk < 2; ++kk) {
                const int m = (gt >> 4) + 16 * (2 * (st & 1) + kk), t = t0 + m;
                float a[8] = {0.f, 0.f, 0.f, 0.f, 0.f, 0.f, 0.f, 0.f};
#pragma unroll
                for (int j = 0; j < 4; ++j) { const u32x4 x = xs[st & 1][kk][j];
                    a[0] += wj[j][0].x * bflo(x.x); a[1] += wj[j][0].y * bfhi(x.x); a[2] += wj[j][0].z * bflo(x.y); a[3] += wj[j][0].w * bfhi(x.y);
                    a[4] += wj[j][1].x * bflo(x.z); a[5] += wj[j][1].y * bfhi(x.z); a[6] += wj[j][1].z * bflo(x.w); a[7] += wj[j][1].w * bfhi(x.w);
                }
                float ssq = 0.f;
#pragma unroll
                for (int i = 0; i < 8; ++i) { a[i] = siluf_(a[i]); ssq += a[i] * a[i]; }
                if (part < 2) {
                    ssq = sum16(ssq);
                    const float rn = rsqrtf(ssq + EPS);
#pragma unroll
                    for (int i = 0; i < 8; ++i) a[i] *= rn;
                } else {
                    const float beta = sigmoidf_(abB[2 * (st & 1) + kk]);
#pragma unroll
                    for (int i = 0; i < 8; ++i) a[i] *= beta;
                }
                const u32x4 pk = (u32x4){pk2(a[0], a[1]), pk2(a[2], a[3]), pk2(a[4], a[5]), pk2(a[6], a[7])};
                if (part == 0) {
                    *(LAS u32x4*)(qimg + m * dn::QST + ch * 2) = pk;
                    if (g8 == 0) { const float xa = abA[2 * (st & 1) + kk] + dtb; const float sp = xa > 20.f ? xa : log1pf(__expf(xa));
                        gcv[m] = nalog * sp; btv[m] = sigmoidf_(abB[2 * (st & 1) + kk]); }
                } else {
                    if (part == 1) *(LAS u32x4*)(kimg + m * dn::QST + ch * 2) = pk;
                    LAS unsigned char* timg = (part == 1 ? ktimg : vtimg) + (((m >> 3) ^ (g8 & 7)) * 16) + (m & 7) * 2;
                    *(LAS unsigned short*)(timg + (ch + 0) * dn::TST) = (unsigned short)pk.x; *(LAS unsigned short*)(timg + (ch + 1) * dn::TST) = (unsigned short)(pk.x >> 16);
                    *(LAS unsigned short*)(timg + (ch + 2) * dn::TST) = (unsigned short)pk.y; *(LAS unsigned short*)(timg + (ch + 3) * dn::TST) = (unsigned short)(pk.y >> 16);
                    *(LAS unsigned short*)(timg + (ch + 4) * dn::TST) = (unsigned short)pk.z; *(LAS unsigned short*)(timg + (ch + 5) * dn::TST) = (unsigned short)(pk.z >> 16);
                    *(LAS unsigned short*)(timg + (ch + 6) * dn::TST) = (unsigned short)pk.w; *(LAS unsigned short*)(timg + (ch + 7) * dn::TST) = (unsigned short)(pk.w >> 16);
                }
            }
        }
#undef DNP_LOADX
    }
    lds_barrier();
#ifdef PROBE_PREP
    if (PROBE_PREP == 1) { const unsigned long long t1_ = __builtin_amdgcn_s_memrealtime(); const unsigned long long d_ = t1_ - tp0_; while (__builtin_amdgcn_s_memrealtime() - t1_ < d_) __builtin_amdgcn_s_sleep(2); }
    tp0_ = __builtin_amdgcn_s_memrealtime();
#endif
    if (gw == 0) {
        float gc = gcv[lane];
#pragma unroll
        for (int off = 1; off < 64; off <<= 1) { const float o = shx(gc, 0, lane - off < 0 ? lane : lane - off) ; gc += (lane >= off) ? o : 0.f; }
        const float glast = shx(gc, 0, 63);
        const float eg = __expf(gc);
        gcv[lane] = gc; f1v[lane] = btv[lane] * eg; f2v[lane] = __expf(glast - gc); egv[lane] = eg * 0.08838834764831845f;
        if (lane == 0) ((float*)(ws + WS_GB))[hc] = __expf(glast);
    }
    lds_barrier();
    f32x16 Lt = {0.f, 0.f, 0.f, 0.f, 0.f, 0.f, 0.f, 0.f, 0.f, 0.f, 0.f, 0.f, 0.f, 0.f, 0.f, 0.f};
    if (gw < 3) {
        {
            const int ct = gw == 0 ? 0 : 1, mt = gw == 2 ? 1 : 0;
            f32x16 acc = {0.f, 0.f, 0.f, 0.f, 0.f, 0.f, 0.f, 0.f, 0.f, 0.f, 0.f, 0.f, 0.f, 0.f, 0.f, 0.f};
#pragma unroll
            for (int ks = 0; ks < 8; ++ks) acc = MFMA32(*(const LAS bf16x8*)(kimg + (32 * ct + r) * dn::QST + ks * 32 + hh * 16), *(const LAS bf16x8*)(kimg + (32 * mt + r) * dn::QST + ks * 32 + hh * 16), acc);
            const int m = 32 * mt + r; const float gm = gcv[m];
#pragma unroll
            for (int i = 0; i < 16; ++i) { const int c = 32 * ct + crow(i, hh); Lt[i] = (m < c) ? acc[i] * btv[c] * __expf(gcv[c] - gm) : 0.f; }
        }
        {
            const int mt = gw == 2 ? 1 : 0, ct = gw == 0 ? 0 : 1;
            f32x16 acc = {0.f, 0.f, 0.f, 0.f, 0.f, 0.f, 0.f, 0.f, 0.f, 0.f, 0.f, 0.f, 0.f, 0.f, 0.f, 0.f};
#pragma unroll
            for (int ks = 0; ks < 8; ++ks) acc = MFMA32(*(const LAS bf16x8*)(kimg + (32 * mt + r) * dn::QST + ks * 32 + hh * 16), *(const LAS bf16x8*)(qimg + (32 * ct + r) * dn::QST + ks * 32 + hh * 16), acc);
            const int c = 32 * ct + r; const float gcc = gcv[c]; float v[16];
#pragma unroll
            for (int i = 0; i < 16; ++i) { const int m = 32 * mt + crow(i, hh); v[i] = (m <= c) ? acc[i] * __expf(gcc - gcv[m]) * 0.08838834764831845f : 0.f; }
#pragma unroll
            for (int s2 = 0; s2 < 2; ++s2) *(bf16x8*)(blk + dn::OFF_AI + ((ct * 2 + mt) * 2 + s2) * 1024 + lane * 16) = pack8(v[8 * s2], v[8 * s2 + 1], v[8 * s2 + 2], v[8 * s2 + 3], v[8 * s2 + 4], v[8 * s2 + 5], v[8 * s2 + 6], v[8 * s2 + 7]);
        }
    } else {
#pragma unroll 1
        for (int f = 0; f < 16; ++f) { const int ct = f >> 3, tau = (f >> 1) & 3, s2 = f & 1, c = 32 * ct + r; const float e = egv[c];
            const LAS unsigned char* pp = qimg + c * dn::QST + (32 * tau + 16 * s2 + 4 * hh) * 2; const u32x2 lo = *(const LAS u32x2*)pp, hi = *(const LAS u32x2*)(pp + 16);
            *(bf16x8*)(blk + dn::OFF_QG + f * 1024 + lane * 16) = pack8(bflo(lo.x) * e, bfhi(lo.x) * e, bflo(lo.y) * e, bfhi(lo.y) * e, bflo(hi.x) * e, bfhi(hi.x) * e, bflo(hi.y) * e, bfhi(hi.y) * e); }
#pragma unroll 1
        for (int f = 0; f < 16; ++f) { const int tau = f >> 2, m0 = 32 * ((f >> 1) & 1) + 16 * (f & 1) + 4 * hh;
            const int sw = (4 * tau + (r >> 3)) & 7; const LAS unsigned char* rowp = ktimg + (32 * tau + r) * dn::TST + (m0 & 7) * 2;
            const u32x2 lo = *(const LAS u32x2*)(rowp + (((m0 >> 3) ^ sw) * 16)), hi = *(const LAS u32x2*)(rowp + ((((m0 >> 3) + 1) ^ sw) * 16));
            const f32x4 fa = *(const LAS f32x4*)(f2v + m0), fb = *(const LAS f32x4*)(f2v + m0 + 8);
            *(bf16x8*)(blk + dn::OFF_KD + f * 1024 + lane * 16) = pack8(bflo(lo.x) * fa.x, bfhi(lo.x) * fa.y, bflo(lo.y) * fa.z, bfhi(lo.y) * fa.w, bflo(hi.x) * fb.x, bfhi(hi.x) * fb.y, bflo(hi.y) * fb.z, bfhi(hi.y) * fb.w); }
    }
    lds_barrier();
    LAS float* Lm = (LAS float*)qimg;
    if (gw < 3) { const int ct = gw == 0 ? 0 : 1, mt = gw == 2 ? 1 : 0;
#pragma unroll
        for (int i = 0; i < 16; ++i) Lm[(32 * ct + crow(i, hh)) * 64 + 32 * mt + r] = Lt[i]; }
    lds_barrier();
#ifdef PROBE_PREP
    if (PROBE_PREP == 2) { const unsigned long long t1_ = __builtin_amdgcn_s_memrealtime(); const unsigned long long d_ = t1_ - tp0_; while (__builtin_amdgcn_s_memrealtime() - t1_ < d_) __builtin_amdgcn_s_sleep(2); }
    tp0_ = __builtin_amdgcn_s_memrealtime();
#endif
    if (gw == 0) {
        const LAS float* Lb = Lm + (32 * hh) * 64 + 32 * hh;
        const int jc = lane & 31;
        float Tc[32];
#pragma unroll
        for (int i = 0; i < 32; ++i) {
            float a0 = (i == jc) ? 1.f : 0.f, a1 = 0.f, a2 = 0.f, a3 = 0.f;
#pragma unroll
            for (int k4 = 0; k4 < (i + 3) / 4; ++k4) { const f32x4 lv = *(const LAS f32x4*)(Lb + i * 64 + 4 * k4);
                if (4 * k4 + 0 < i) a0 -= lv.x * Tc[4 * k4 + 0]; if (4 * k4 + 1 < i) a1 -= lv.y * Tc[4 * k4 + 1];
                if (4 * k4 + 2 < i) a2 -= lv.z * Tc[4 * k4 + 2]; if (4 * k4 + 3 < i) a3 -= lv.w * Tc[4 * k4 + 3]; }
            Tc[i] = (a0 + a1) + (a2 + a3);
        }
        LDS_WAIT(); asm volatile("" ::: "memory");
        LAS unsigned char* timg = kimg; LAS unsigned char* t00t = kimg + 64 * dn::TST;
#pragma unroll
        for (int i = 0; i < 32; ++i) *(LAS unsigned short*)(timg + (32 * hh + i) * dn::TST + (32 * hh + jc) * 2) = (unsigned short)f2bf(Tc[i]);
        if (hh == 0) {
#pragma unroll
            for (int q = 0; q < 4; ++q) { *(LAS u32x4*)(t00t + jc * 80 + 16 * q) = (u32x4){pk2(Tc[8 * q], Tc[8 * q + 1]), pk2(Tc[8 * q + 2], Tc[8 * q + 3]), pk2(Tc[8 * q + 4], Tc[8 * q + 5]), pk2(Tc[8 * q + 6], Tc[8 * q + 7])};
                *(LAS u32x4*)(timg + jc * dn::TST + 64 + 16 * q) = (u32x4){0u, 0u, 0u, 0u}; }
        }
        LDS_WAIT(); asm volatile("" ::: "memory");
        f32x16 X = {0.f, 0.f, 0.f, 0.f, 0.f, 0.f, 0.f, 0.f, 0.f, 0.f, 0.f, 0.f, 0.f, 0.f, 0.f, 0.f};
#pragma unroll
        for (int s2 = 0; s2 < 2; ++s2) { const f32x4 la = *(const LAS f32x4*)(Lm + (32 + r) * 64 + 16 * s2 + 8 * hh), lb = *(const LAS f32x4*)(Lm + (32 + r) * 64 + 16 * s2 + 8 * hh + 4);
            X = MFMA32(pack8(la.x, la.y, la.z, la.w, lb.x, lb.y, lb.z, lb.w), *(const LAS bf16x8*)(t00t + r * 80 + (16 * s2 + 8 * hh) * 2), X); }
        f32x16 Y = {0.f, 0.f, 0.f, 0.f, 0.f, 0.f, 0.f, 0.f, 0.f, 0.f, 0.f, 0.f, 0.f, 0.f, 0.f, 0.f};
#pragma unroll
        for (int s2 = 0; s2 < 2; ++s2) { const LAS unsigned char* pp = timg + (32 + r) * dn::TST + (32 + 16 * s2 + 4 * hh) * 2; const u32x2 lo = *(const LAS u32x2*)pp, hi = *(const LAS u32x2*)(pp + 16);
            u32x4 af; af.x = lo.x; af.y = lo.y; af.z = hi.x; af.w = hi.y;
            Y = MFMA32(__builtin_bit_cast(bf16x8, af), pack8m(X[8 * s2], X[8 * s2 + 1], X[8 * s2 + 2], X[8 * s2 + 3], X[8 * s2 + 4], X[8 * s2 + 5], X[8 * s2 + 6], X[8 * s2 + 7]), Y); }
#pragma unroll
        for (int i = 0; i < 16; ++i) *(LAS unsigned short*)(timg + (32 + crow(i, hh)) * dn::TST + r * 2) = (unsigned short)f2bf(-Y[i]);
    }
    lds_barrier();
#ifdef PROBE_PREP
    if (PROBE_PREP == 3) { const unsigned long long t1_ = __builtin_amdgcn_s_memrealtime(); const unsigned long long d_ = t1_ - tp0_; while (__builtin_amdgcn_s_memrealtime() - t1_ < d_) __builtin_amdgcn_s_sleep(2); }
    tp0_ = __builtin_amdgcn_s_memrealtime();
#endif
    {
        LAS unsigned char* timg = kimg;
        bf16x8 afr[4];
#pragma unroll
        for (int s4 = 0; s4 < 4; ++s4) { const u32x4 x = *(const LAS u32x4*)(ktimg + (32 * gw + r) * dn::TST + (((2 * s4 + hh) ^ ((4 * gw + (r >> 3)) & 7)) * 16));
            const f32x4 fa = *(const LAS f32x4*)(f1v + 16 * s4 + 8 * hh), fb = *(const LAS f32x4*)(f1v + 16 * s4 + 8 * hh + 4);
            afr[s4] = pack8(-bflo(x.x) * fa.x, -bfhi(x.x) * fa.y, -bflo(x.y) * fa.z, -bfhi(x.y) * fa.w, -bflo(x.z) * fb.x, -bfhi(x.z) * fb.y, -bflo(x.w) * fb.z, -bfhi(x.w) * fb.w); }
#pragma unroll
        for (int ct = 0; ct < 2; ++ct) {
            f32x16 acc = {0.f, 0.f, 0.f, 0.f, 0.f, 0.f, 0.f, 0.f, 0.f, 0.f, 0.f, 0.f, 0.f, 0.f, 0.f, 0.f};
#pragma unroll
            for (int s4 = 0; s4 < 4; ++s4) acc = MFMA32(afr[s4], *(const LAS bf16x8*)(timg + (32 * ct + r) * dn::TST + s4 * 32 + hh * 16), acc);
#pragma unroll
            for (int s2 = 0; s2 < 2; ++s2) *(bf16x8*)(blk + dn::OFF_W + ((ct * 4 + gw) * 2 + s2) * 1024 + lane * 16) = pack8m(acc[8 * s2], acc[8 * s2 + 1], acc[8 * s2 + 2], acc[8 * s2 + 3], acc[8 * s2 + 4], acc[8 * s2 + 5], acc[8 * s2 + 6], acc[8 * s2 + 7]);
        }
#pragma unroll
        for (int ct = 0; ct < 2; ++ct) {
            f32x16 acc = {0.f, 0.f, 0.f, 0.f, 0.f, 0.f, 0.f, 0.f, 0.f, 0.f, 0.f, 0.f, 0.f, 0.f, 0.f, 0.f};
#pragma unroll
            for (int s4 = 0; s4 < 4; ++s4) acc = MFMA32(*(const LAS bf16x8*)(timg + (32 * ct + r) * dn::TST + s4 * 32 + hh * 16), *(const LAS bf16x8*)(vtimg + (32 * gw + r) * dn::TST + (((2 * s4 + hh) ^ ((4 * gw + (r >> 3)) & 7)) * 16)), acc);
#pragma unroll
            for (int s2 = 0; s2 < 2; ++s2) *(bf16x8*)(blk + dn::OFF_U + ((ct * 4 + gw) * 2 + s2) * 1024 + lane * 16) = pack8m(acc[8 * s2], acc[8 * s2 + 1], acc[8 * s2 + 2], acc[8 * s2 + 3], acc[8 * s2 + 4], acc[8 * s2 + 5], acc[8 * s2 + 6], acc[8 * s2 + 7]);
        }
    }
    lds_barrier();
}

DI void dn_scan(int wv, int l, int bh) {
    const Frame F = mkframe(wv);
    const ArgsP ap = kargs();
    unsigned char* ws = ap->ws; bf16_t* P = (bf16_t*)(ws + WS_P);
    const int lane = F.lane, hh = lane >> 5, b = bh >> 2, h = bh & 3, w4 = wv & 3;
    LAS float* part = (LAS float*)(F.lds + 2 * dn::HC_BYTES);
    LAS float* gnl = part + 512;
    LAS float* decs = gnl + 128;
    if (F.tid < 128) gnl[F.tid] = ap->dn_norm_g[l * 128 + F.tid];
    if (F.tid < 32) decs[F.tid] = ((const float*)(ws + WS_GB))[(size_t)(b * 32 + F.tid) * 4 + h];
    const size_t hc_stride = 4 * (size_t)dn::HC_BYTES;
    const unsigned char* blk0 = ws + WS_DNI + ((size_t)(b * 32) * 4 + h) * dn::HC_BYTES;
#define DN_PIECE(src_, pbuf, pc_) __builtin_amdgcn_global_load_lds((const unsigned*)((src_) + (pc_) * 1024 + lane * 16), (LAS unsigned*)(F.lds + (pbuf) * dn::HC_BYTES + (pc_) * 1024), 16, 0, 0)
#define DN_LOAD(nn, pbuf) do { const unsigned char* src_ = blk0 + (size_t)(nn) * hc_stride; \
        if (wv < 4) { _Pragma("unroll") for (int i_ = 0; i_ < 9; ++i_) DN_PIECE(src_, pbuf, wv * 9 + i_); } \
        else { _Pragma("unroll") for (int i_ = 0; i_ < 5; ++i_) DN_PIECE(src_, pbuf, 36 + 5 * w4 + i_); \
               DN_PIECE(src_, pbuf, 56 + 2 * w4); DN_PIECE(src_, pbuf, 57 + 2 * w4); DN_PIECE(src_, pbuf, 64 + 2 * w4); DN_PIECE(src_, pbuf, 65 + 2 * w4); } } while (0)
    DN_LOAD(0, 0);
    f32x16 S[4];
#pragma unroll
    for (int i = 0; i < 4; ++i) S[i] = (f32x16){0.f, 0.f, 0.f, 0.f, 0.f, 0.f, 0.f, 0.f, 0.f, 0.f, 0.f, 0.f, 0.f, 0.f, 0.f, 0.f};
    u32x4 heldO[4], zO[4];
#pragma unroll
    for (int i = 0; i < 4; ++i) { heldO[i] = (u32x4){0u, 0u, 0u, 0u}; zO[i] = heldO[i]; }
    VM_WAIT(); __syncthreads();
    if (wv < 4) {
    for (int k = 0; k < 34; ++k) {
        const int pbuf = k & 1;
#ifdef PROBE_SCANC
        const unsigned long long tc0_ = __builtin_amdgcn_s_memrealtime();
#endif
        LAS unsigned char* buf = F.lds + pbuf * dn::HC_BYTES;
        {
            if (k + 1 < 32) DN_LOAD(k + 1, pbuf ^ 1);
            if (k < 32) {
                const float dec = decs[k];
                f32x16 vn[2], o[2];
#pragma unroll
                for (int ct = 0; ct < 2; ++ct) {
                    o[ct] = (f32x16){0.f, 0.f, 0.f, 0.f, 0.f, 0.f, 0.f, 0.f, 0.f, 0.f, 0.f, 0.f, 0.f, 0.f, 0.f, 0.f};
#pragma unroll
                    for (int s2 = 0; s2 < 2; ++s2) { const u32x4 x = *(const LAS u32x4*)(buf + dn::OFF_U + ((ct * 4 + wv) * 2 + s2) * 1024 + lane * 16);
                        vn[ct][8 * s2] = bflo(x.x); vn[ct][8 * s2 + 1] = bfhi(x.x); vn[ct][8 * s2 + 2] = bflo(x.y); vn[ct][8 * s2 + 3] = bfhi(x.y);
                        vn[ct][8 * s2 + 4] = bflo(x.z); vn[ct][8 * s2 + 5] = bfhi(x.z); vn[ct][8 * s2 + 6] = bflo(x.w); vn[ct][8 * s2 + 7] = bfhi(x.w); }
                }
#define DN_F(off) (*(const LAS bf16x8*)(buf + (off) + lane * 16))
#define DN_WQ(ct, st) ((((ct) * 4 + ((st) >> 1)) * 2 + ((st) & 1)) * 1024)
                bf16x8 fa[4], fb[6];
                fa[0] = DN_F(dn::OFF_W + DN_WQ(0, 0)); fa[1] = DN_F(dn::OFF_QG + DN_WQ(0, 0)); fa[2] = DN_F(dn::OFF_W + DN_WQ(1, 0)); fa[3] = DN_F(dn::OFF_QG + DN_WQ(1, 0));
#pragma unroll
                for (int st = 0; st < 8; ++st) {
                    const int tau = st >> 1, s2 = st & 1;
                    if (st < 7) { fb[0] = DN_F(dn::OFF_W + DN_WQ(0, st + 1)); fb[1] = DN_F(dn::OFF_QG + DN_WQ(0, st + 1)); fb[2] = DN_F(dn::OFF_W + DN_WQ(1, st + 1)); fb[3] = DN_F(dn::OFF_QG + DN_WQ(1, st + 1)); }
                    else { fb[0] = DN_F(dn::OFF_AI + 0 * 1024); fb[1] = DN_F(dn::OFF_AI + 4 * 1024); fb[2] = DN_F(dn::OFF_KD + 0 * 1024); fb[3] = DN_F(dn::OFF_KD + 4 * 1024); fb[4] = DN_F(dn::OFF_KD + 8 * 1024); fb[5] = DN_F(dn::OFF_KD + 12 * 1024); }
                    __builtin_amdgcn_sched_barrier(0);
                    const bf16x8 sf = pack8m(S[tau][8 * s2], S[tau][8 * s2 + 1], S[tau][8 * s2 + 2], S[tau][8 * s2 + 3], S[tau][8 * s2 + 4], S[tau][8 * s2 + 5], S[tau][8 * s2 + 6], S[tau][8 * s2 + 7]);
                    vn[0] = MFMA32(fa[0], sf, vn[0]); o[0] = MFMA32(fa[1], sf, o[0]); vn[1] = MFMA32(fa[2], sf, vn[1]); o[1] = MFMA32(fa[3], sf, o[1]);
                    __builtin_amdgcn_sched_barrier(0);
                    if (st < 7) { fa[0] = fb[0]; fa[1] = fb[1]; fa[2] = fb[2]; fa[3] = fb[3]; }
                }
#pragma unroll
                for (int tau = 0; tau < 4; ++tau) S[tau] = S[tau] * dec;
                bf16x8 fc[6];
#pragma unroll
                for (int g = 0; g < 4; ++g) {
                    const int cm = g >> 1, s2 = g & 1;
                    if (g < 3) { const int cm1 = (g + 1) >> 1, s21 = (g + 1) & 1;
                        fc[0] = DN_F(dn::OFF_AI + ((cm1 * 2 + cm1) * 2 + s21) * 1024); fc[1] = DN_F(dn::OFF_AI + ((1 * 2 + cm1) * 2 + s21) * 1024);
#pragma unroll
                        for (int tau = 0; tau < 4; ++tau) fc[2 + tau] = DN_F(dn::OFF_KD + ((tau * 2 + cm1) * 2 + s21) * 1024); }
                    __builtin_amdgcn_sched_barrier(0);
                    const bf16x8 vf = pack8m(vn[cm][8 * s2], vn[cm][8 * s2 + 1], vn[cm][8 * s2 + 2], vn[cm][8 * s2 + 3], vn[cm][8 * s2 + 4], vn[cm][8 * s2 + 5], vn[cm][8 * s2 + 6], vn[cm][8 * s2 + 7]);
                    if (cm == 0) o[0] = MFMA32(fb[0], vf, o[0]);
                    o[1] = MFMA32(fb[1], vf, o[1]);
#pragma unroll
                    for (int tau = 0; tau < 4; ++tau) S[tau] = MFMA32(fb[2 + tau], vf, S[tau]);
                    __builtin_amdgcn_sched_barrier(0);
                    if (g < 3) {
#pragma unroll
                        for (int q = 0; q < 6; ++q) fb[q] = fc[q]; }
                }
#undef DN_F
#undef DN_WQ
                LDS_WAIT(); __builtin_amdgcn_sched_barrier(0); asm volatile("s_nop 15\n\ts_nop 3" ::: "memory"); __builtin_amdgcn_sched_barrier(0);
#pragma unroll
                for (int ct = 0; ct < 2; ++ct)
#pragma unroll
                    for (int i = 0; i < 16; i += 2) { const int c = 32 * ct + crow(i, hh), q = c >> 4; const unsigned u2 = pk2(o[ct][i], o[ct][i + 1]);
                        LAS unsigned char* wp = buf + dn::OFF_U + (((q >> 1) * 4 + wv) * 2 + (q & 1)) * 1024 + (c & 15) * 64 + (lane & 31) * 2;
                        *(LAS unsigned short*)wp = (unsigned short)u2; *(LAS unsigned short*)(wp + 64) = (unsigned short)(u2 >> 16); }
            }
        }
#ifdef PROBE_SCANC
        { const unsigned long long tc1_ = __builtin_amdgcn_s_memrealtime(); const unsigned long long d_ = tc1_ - tc0_; while (__builtin_amdgcn_s_memrealtime() - tc1_ < d_) __builtin_amdgcn_s_sleep(2); }
#endif
        asm volatile("s_waitcnt vmcnt(0)" ::: "memory");
        lds_barrier();
    }
    } else {
    u32x4 heldN[4], zN[4];
#pragma unroll
    for (int i = 0; i < 4; ++i) { heldN[i] = (u32x4){0u, 0u, 0u, 0u}; zN[i] = heldN[i]; }
    unsigned td0 = 0u, td1 = 0u, td2 = 0u;
    for (int k = 0; k < 34; ++k) {
        const int pbuf = k & 1;
#ifdef PROBE_SCANH
        const unsigned long long th0_ = __builtin_amdgcn_s_memrealtime();
#endif
        const bool rows = (k >= 1 && k <= 32);
        if (rows) {
            const int nn = k - 1; LAS unsigned char* pb = F.lds + (nn & 1) * dn::HC_BYTES;
            const int q = lane >> 4; const LAS unsigned char* rp = pb + dn::OFF_U + (((q >> 1) * 4 + w4) * 2 + (q & 1)) * 1024 + (lane & 15) * 64;
            float ssq = 0.f;
#pragma unroll
            for (int i = 0; i < 4; ++i) { const u32x4 hv = *(const LAS u32x4*)(rp + 16 * i); heldN[i] = hv;
                ssq += bflo(hv.x) * bflo(hv.x) + bfhi(hv.x) * bfhi(hv.x) + bflo(hv.y) * bflo(hv.y) + bfhi(hv.y) * bfhi(hv.y)
                     + bflo(hv.z) * bflo(hv.z) + bfhi(hv.z) * bfhi(hv.z) + bflo(hv.w) * bflo(hv.w) + bfhi(hv.w) * bfhi(hv.w); }
            part[((nn & 1) * 64 + lane) * 4 + w4] = ssq;
        }
        LDS_WAIT(); asm volatile("" ::: "memory");
        if (k + 1 < 32) DN_LOAD(k + 1, pbuf ^ 1);
        __builtin_amdgcn_sched_barrier(0);
        if (rows) { const bf16_t* zp = P + (size_t)(b * SEQ + (k - 1) * 64 + lane) * PLD + P_DNZ + h * 128 + 32 * w4;
#pragma unroll
            for (int i = 0; i < 4; ++i) zN[i] = *(const u32x4*)(zp + 8 * i); }
        __builtin_amdgcn_sched_barrier(0);
#ifdef SCAN_TOUCH_ON
        if (k + 2 < 32) {
            const unsigned char* tb = blk0 + (size_t)(k + 2) * hc_stride + (size_t)(w4 * 144) * 128;
            const unsigned char* a0 = tb + lane * 128; const unsigned char* a1 = tb + (64 + lane) * 128; const unsigned char* a2 = tb + (128 + (lane & 15)) * 128;
            asm volatile("; SCAN_TOUCH\n\tglobal_load_dword %0, %3, off\n\tglobal_load_dword %1, %4, off\n\tglobal_load_dword %2, %5, off" : "+v"(td0), "+v"(td1), "+v"(td2) : "v"(a0), "v"(a1), "v"(a2) : "memory");
        }
        __builtin_amdgcn_sched_barrier(0);
#endif
        u32x4 wo[4];
        if (k >= 2) {
            const int nn = k - 2; const f32x4 p4 = *(const LAS f32x4*)(part + ((nn & 1) * 64 + lane) * 4);
            const float rs = rsqrtf(((p4.x + p4.y) + (p4.z + p4.w)) * (1.f / 128.f) + EPS);
#pragma unroll
            for (int q = 0; q < 4; ++q) { const u32x4 zz = zO[q], hv = heldO[q]; const f32x4 ga = *(const LAS f32x4*)(gnl + 32 * w4 + 8 * q), gb = *(const LAS f32x4*)(gnl + 32 * w4 + 8 * q + 4);
                wo[q].x = pk2(bflo(hv.x) * rs * ga.x * siluf_(bflo(zz.x)), bfhi(hv.x) * rs * ga.y * siluf_(bfhi(zz.x)));
                wo[q].y = pk2(bflo(hv.y) * rs * ga.z * siluf_(bflo(zz.y)), bfhi(hv.y) * rs * ga.w * siluf_(bfhi(zz.y)));
                wo[q].z = pk2(bflo(hv.z) * rs * gb.x * siluf_(bflo(zz.z)), bfhi(hv.z) * rs * gb.y * siluf_(bfhi(zz.z)));
                wo[q].w = pk2(bflo(hv.w) * rs * gb.z * siluf_(bflo(zz.w)), bfhi(hv.w) * rs * gb.w * siluf_(bfhi(zz.w))); }
        }
#ifdef SCAN_TOUCH_ON
        if (k + 2 < 32) asm volatile("; SCAN_E\n\ts_waitcnt vmcnt(3)" ::: "memory"); else
#endif
        asm volatile("s_waitcnt vmcnt(0)" ::: "memory");
        if (k >= 2) { bf16_t* zp = P + (size_t)(b * SEQ + (k - 2) * 64 + lane) * PLD + P_DNZ + h * 128 + 32 * w4;
#pragma unroll
            for (int q = 0; q < 4; ++q) *(u32x4*)(zp + 8 * q) = wo[q]; }
#pragma unroll
        for (int i = 0; i < 4; ++i) { heldO[i] = heldN[i]; zO[i] = zN[i]; }
#ifdef PROBE_SCANH
        { const unsigned long long th1_ = __builtin_amdgcn_s_memrealtime(); const unsigned long long d_ = th1_ - th0_; while (__builtin_amdgcn_s_memrealtime() - th1_ < d_) __builtin_amdgcn_s_sleep(2); }
#endif
        lds_barrier();
    }
    asm volatile("s_waitcnt vmcnt(0)" : "+v"(td0), "+v"(td1), "+v"(td2) :: "memory");
    }
#undef DN_LOAD
#undef DN_PIECE
}

DI void final_norm(int wv) {
    const Frame F = mkframe(wv);
    const ArgsP ap = kargs();
    const float* ss = (const float*)(ap->ws + WS_SS);
    for (int m = F.gw; m < T; m += F.NGW) {
        const f32x4 s = *(const f32x4*)(ss + (size_t)m * 4); const float rs = rsqrtf(((s.x + s.y) + (s.z + s.w)) * (1.f / D) + EPS);
        f32x4* xr = (f32x4*)(ap->out + (size_t)m * D) + F.lane; const f32x4* gr = (const f32x4*)ap->final_norm_g + F.lane;
#pragma unroll
        for (int j = 0; j < 4; ++j) { const f32x4 v = xr[64 * j], g = gr[64 * j]; xr[64 * j] = v * rs * g; }
    }
}

__global__ void __launch_bounds__(NTHREADS, 2) mk_fwd(Args args) {
    extern __shared__ __attribute__((aligned(16))) unsigned char lds_raw[];
    LAS unsigned char* const lds = (LAS unsigned char*)lds_raw;
    volatile LAS unsigned* MISC = (volatile LAS unsigned*)(lds + MISC_OFF);
    const int wv = __builtin_amdgcn_readfirstlane((int)threadIdx.x >> 6);
    { const int t0 = opaque_tid(wv); for (int u = t0; u < (LDS_BYTES - LDSCTL_OFF) / 4; u += NTHREADS) ((LAS unsigned*)(lds + LDSCTL_OFF))[u] = 0u; }
    __syncthreads();
    const int G = gridDim.x;
    XcdBarrier bar; bar.bar = (unsigned*)(args.ws + WS_CTL) + CW_BAR + args.li * XCD_BAR_WORDS; bar.x = 0; bar.st = nullptr;
    if (args.ph_hi - args.ph_lo > 1) bar = xcd_barrier_post(bar.bar, MISC + 8, wv);
#define IN(k) (kargs()->ph_lo <= (k) && (k) < kargs()->ph_hi)
#ifdef PROBE_SUB
    unsigned long long ts_prev_ = 0;
#define SUBSEAM(bit) do { xcd_barrier(bar, wv); { const unsigned long long t1_ = __builtin_amdgcn_s_memrealtime(); \
        if ((PROBE_SUB >> (bit)) & 1u) { const unsigned long long d_ = t1_ - ts_prev_; while (__builtin_amdgcn_s_memrealtime() - t1_ < d_) __builtin_amdgcn_s_sleep(8); } \
        ts_prev_ = __builtin_amdgcn_s_memrealtime(); } } while (0)
#define SUBSTART() do { ts_prev_ = __builtin_amdgcn_s_memrealtime(); } while (0)
#else
#define SUBSEAM(bit) do { } while (0)
#define SUBSTART() do { } while (0)
#endif
#ifdef PROBE_ECHO
    unsigned long long t_prev_ = __builtin_amdgcn_s_memrealtime();
#define SEAM(k) do { if (IN(k) && IN((k) + 1)) xcd_barrier(bar, wv); { const unsigned long long t1_ = __builtin_amdgcn_s_memrealtime(); \
        if ((PROBE_ECHO >> (k)) & 1u) { const unsigned long long d_ = t1_ - t_prev_; while (__builtin_amdgcn_s_memrealtime() - t1_ < d_) __builtin_amdgcn_s_sleep(8); } \
        t_prev_ = __builtin_amdgcn_s_memrealtime(); } } while (0)
#else
#define SEAM(k) do { if (IN(k) && IN((k) + 1)) xcd_barrier(bar, wv); } while (0)
#endif
#define MK_EPI(E) gm::Epi E; E.ws = kargs()->ws; E.xin = nullptr; E.xout = nullptr; E.xin16 = false; E.xout16 = false; E.b_gate = nullptr; E.gnext = nullptr; E.gfinal = nullptr; E.spare = (LAS float*)(lds + SPARE_OFF);

#if !defined(ONLY_PH) || ONLY_PH == 0
    if (IN(0)) { p0_prologue(wv); }
#endif
    SEAM(0);

    for (int l0 = 0; l0 < DEPTH; ++l0) {
        int l = l0; asm volatile("" : "+s"(l));
        const int pb = 1 + 6 * l;
#if !defined(ONLY_PH) || ONLY_PH == 1
        if (IN(pb)) { MK_EPI(E); SchedP1 S; S.ord.init(64, 12, G, opaque_bid()); S.ws = kargs()->ws; S.l = l; S.half = 0; S.c = opaque_bid(); S.with_kvm = false;
            gm::gemm_phase<AUX_P1>(lds, wv, S, E);
#ifdef PROBE_DUP_GEMM
            xcd_barrier(bar, wv); gm::gemm_phase<AUX_P1>(lds, wv, S, E);
#endif
            }
#endif
        SEAM(pb);
#if !defined(ONLY_PH) || ONLY_PH == 2
        if (IN(pb + 1)) {
            SUBSTART();
            SUBSEAM(0);
            for (int pair = opaque_bid(); pair < 512; pair += G) dn_prep(wv, l, pair);
            SUBSEAM(1);
            if (l > 0) { const Frame Fm = mkframe(wv); memn_rows(Fm, kargs(), l); }
 }
#endif
        SEAM(pb + 1);
#if !defined(ONLY_PH) || ONLY_PH == 3
        if (IN(pb + 2)) {
            if (opaque_bid() < 32 && G > 64) dn_scan(wv, l, opaque_bid());
            else { const bool split = G > 64; MK_EPI(E); SchedP1 S; S.ord.init(64, 12, split ? G - 32 : G, split ? opaque_bid() - 32 : opaque_bid()); S.ws = kargs()->ws; S.l = l; S.half = 1; S.c = opaque_bid(); S.with_kvm = true;
                gm::gemm_phase<AUX_P1>(lds, wv, S, E);
#ifdef PROBE_DUP_GEMM
                xcd_barrier(bar, wv); gm::gemm_phase<AUX_P1>(lds, wv, S, E);
#endif
                { const int cp = opaque_bid() - 32; const Frame Fc = mkframe(wv);
                  const int nsh = cp >= 112 ? 3 : 1, sh0 = cp >= 112 ? 3 * (cp - 112) : 336 + cp;
                  for (int q = 0; q < nsh; ++q) { const int first = (sh0 + q) * NWAVES + wv, stride = 448 * NWAVES;
                      if (l == 0) convert_weights(Fc, kargs(), 0, first, stride, 2);
                      if (l + 1 < DEPTH) convert_weights(Fc, kargs(), l + 1, first, stride, 0); } }
            }
            if (G <= 64) { for (int bh = opaque_bid(); bh < 32; bh += G) dn_scan(wv, l, bh); }
        }
#endif
        SEAM(pb + 2);
#if !defined(ONLY_PH) || ONLY_PH == 4
        if (IN(pb + 3)) {
            const int wg = opaque_bid();

            unsigned* head = (unsigned*)(kargs()->ws + WS_CTL) + CW_QUEUE + 64 * l;
            volatile LAS unsigned* qslot = (volatile LAS unsigned*)(lds + MISC_OFF + 64);
            for (;;) {
#ifdef PROBE_FETCH
                const unsigned long long tf0_ = __builtin_amdgcn_s_memrealtime();
#endif
                if (opaque_tid(wv) == 0) qslot[0] = __hip_atomic_fetch_add(head, 1u, __ATOMIC_RELAXED, __HIP_MEMORY_SCOPE_AGENT);
                __syncthreads();
                const int unit = (int)qslot[0];
                __syncthreads();
#ifdef PROBE_FETCH
                { const unsigned long long tf1_ = __builtin_amdgcn_s_memrealtime(); const unsigned long long d_ = tf1_ - tf0_; while (__builtin_amdgcn_s_memrealtime() - tf1_ < d_) __builtin_amdgcn_s_sleep(2); }
#endif
                if (unit >= 1248) break;
#ifdef PROBE_UNIT
                const unsigned long long tu0_ = __builtin_amdgcn_s_memrealtime();
#endif
                if (unit < 224) ret_state_unit(wv, l, unit); else if (unit < 480) attn_unit<1>(wv, l, unit - 224); else if (unit < 992) attn_unit<0>(wv, l, unit - 480); else mem_unit(wv, l, unit - 992);
#ifdef PROBE_UNIT
                { const unsigned long long tu1_ = __builtin_amdgcn_s_memrealtime(); if (PROBE_UNIT >= 2 ? (tu1_ - tu0_ > (unsigned long long)PROBE_UNIT * 100ull) : ((unit < 256) == (PROBE_UNIT == 1))) { const unsigned long long d_ = tu1_ - tu0_; while (__builtin_amdgcn_s_memrealtime() - tu1_ < d_) __builtin_amdgcn_s_sleep(8); } }
#endif
            }
        }
#endif
#ifdef KEEP_SEAM3
        SEAM(pb + 3);
#endif
#if !defined(ONLY_PH) || ONLY_PH == 5
        if (IN(pb + 4)) { MK_EPI(E); gm::TileOrder ord; ord.init(64, 4, G, opaque_bid()); SchedP3 S; S.ok = ord.tile(0, S.pm, S.pn); S.l = l; S.rot = (opaque_bid() >> 3) & 3; S.ws = kargs()->ws; E.b_gate = kargs()->b_gate;
            gm::gemm_phase<AUX_P3>(lds, wv, S, E);
#ifdef PROBE_DUP_GEMM
            xcd_barrier(bar, wv); gm::gemm_phase<AUX_P3>(lds, wv, S, E);
#endif
            }
#endif
        SEAM(pb + 4);
#if !defined(ONLY_PH) || ONLY_PH == 6
        if (IN(pb + 5)) { MK_EPI(E); gm::TileOrder ord; ord.init(64, 4, G, opaque_bid()); SchedP4 S; S.ok = ord.tile(0, S.pm, S.pn); S.l = l; S.ws = kargs()->ws;
            E.gnext = (l + 1 < DEPTH) ? kargs()->norm_g + (size_t)(l + 1) * D : nullptr;
            E.gfinal = (l + 1 < DEPTH || G != 256) ? nullptr : kargs()->final_norm_g;
            E.xout = kargs()->out; E.xin = (l == 0) ? kargs()->x : (const float*)kargs()->out;
            E.xin16 = (l > 0) && G == 256; E.xout16 = (l + 1 < DEPTH) && G == 256 && DEPTH == 2;
            gm::gemm_phase<AUX_P4>(lds, wv, S, E); }
#endif
        if (!(l + 1 == DEPTH && G == 256)) SEAM(pb + 5);
    }
#if !defined(ONLY_PH) || ONLY_PH == 13
    if (IN(13) && G != 256) final_norm(wv);
#endif
#undef IN
#undef SEAM
#undef MK_EPI
}

extern "C" void kernel_launch(void* const* d_in, const int* in_sizes, int n_in, void* d_out, int out_size, void* d_ws, size_t ws_size, hipStream_t stream) {
    static int grid = 0;
    if (grid == 0) {
        if (n_in != 19 || out_size != T * D || ws_size < WS_END) { fprintf(stderr, "kernel_launch: unexpected problem (n_in %d, out %d, ws %zu)\n", n_in, out_size, ws_size); grid = -1; return; }
        int dev = 0, cus = 0, per_cu = 0;
        if (hipGetDevice(&dev) != hipSuccess || hipDeviceGetAttribute(&cus, hipDeviceAttributeMultiprocessorCount, dev) != hipSuccess) { grid = -1; return; }
        if (hipFuncSetAttribute((const void*)mk_fwd, hipFuncAttributeMaxDynamicSharedMemorySize, LDS_BYTES) != hipSuccess) { fprintf(stderr, "kernel_launch: hipFuncSetAttribute failed\n"); grid = -1; return; }
        if (hipOccupancyMaxActiveBlocksPerMultiprocessor(&per_cu, (const void*)mk_fwd, NTHREADS, LDS_BYTES) != hipSuccess || per_cu < 1)
            fprintf(stderr, "kernel_launch: occupancy query reports %d workgroups per CU\n", per_cu);
        (void)hipGetLastError();
        grid = cus;
    }
    if (grid < 0) return;
    if (hipMemsetAsync((char*)d_ws + WS_CTL, 0, CTL_ZERO_BYTES, stream) != hipSuccess) return;
    Args a{};
    a.x = (const float*)d_in[0]; a.mem = (const float*)d_in[1]; a.positions = (const int*)d_in[2]; a.norm_g = (const float*)d_in[3]; a.mem_norm_g = (const float*)d_in[4];
    a.w_in = (const float*)d_in[5]; a.b_gate = (const float*)d_in[6]; a.dn_conv_w = (const float*)d_in[7]; a.dn_a_log = (const float*)d_in[8]; a.dn_dt_bias = (const float*)d_in[9];
    a.dn_norm_g = (const float*)d_in[10]; a.ret_norm_g = (const float*)d_in[11]; a.w_mem_kv = (const float*)d_in[12]; a.w_br_sb = (const float*)d_in[13]; a.w_br_dn = (const float*)d_in[14];
    a.w_br_ret = (const float*)d_in[15]; a.w_br_mem = (const float*)d_in[16]; a.w_out = (const float*)d_in[17]; a.final_norm_g = (const float*)d_in[18];
    a.out = (float*)d_out; a.ws = (unsigned char*)d_ws;
#if MK_N_LAUNCHES == 1
    a.ph_lo = 0; a.ph_hi = NPHASE; a.li = 0;
    hipLaunchKernelGGL(mk_fwd, dim3(grid), dim3(NTHREADS), LDS_BYTES, stream, a);
#else
    for (int p = 0; p < NPHASE; ++p) { a.ph_lo = p; a.ph_hi = p + 1; a.li = 0;
        hipLaunchKernelGGL(mk_fwd, dim3(grid), dim3(NTHREADS), LDS_BYTES, stream, a); }
#endif
}
```

```cpp
#include <hip/hip_runtime.h>
#include <cstdio>
#include <cstdint>
#include <cmath>

#define LAS __attribute__((address_space(3)))
#define GAS __attribute__((address_space(1)))
#define DI __device__ __forceinline__
typedef unsigned short bf16_t;
typedef short bf16x8 __attribute__((ext_vector_type(8)));
typedef float f32x4 __attribute__((ext_vector_type(4)));
typedef unsigned u32x4 __attribute__((ext_vector_type(4)));
typedef unsigned u32x2 __attribute__((ext_vector_type(2)));
typedef float f32x2 __attribute__((ext_vector_type(2)));

#ifndef AUX_P1
#define AUX_P1 0
#endif
#ifndef AUX_P3
#define AUX_P3 0
#endif
#ifndef AUX_P4
#define AUX_P4 0
#endif
#ifdef EPI_NT
#define EPI_LD(p) __builtin_nontemporal_load(p)
#define EPI_ST(p, v) __builtin_nontemporal_store((v), (p))
#else
#define EPI_LD(p) (*(p))
#define EPI_ST(p, v) (*(p) = (v))
#endif
#ifndef FRESH_WAITS
#define FRESH_WAITS 0
#endif
#ifndef SS_PREFETCH
#define SS_PREFETCH 1
#endif
#ifndef EARLY_INV
#define EARLY_INV 1
#endif
#ifndef MK_N_LAUNCHES
#define MK_N_LAUNCHES 1
#endif

constexpr int BATCH = 8, SEQ = 2048, D = 1024, T = BATCH * SEQ, DEPTH = 2, MEMLEN = 256;
constexpr int IN_COLS = 9992;
constexpr float EPS = 1e-6f;
constexpr int NPHASE = 14;

constexpr size_t MiB = 1u << 20;
constexpr size_t WS_CTL = 0, CTL_ZERO_BYTES = 1 * MiB;
constexpr size_t WS_WINA = 1 * MiB;
constexpr size_t WS_WINB = 13 * MiB;
constexpr size_t WS_WG = 25 * MiB;
constexpr size_t WS_WBR = 41 * MiB;
constexpr size_t WS_WOUT = 49 * MiB;
constexpr size_t WS_WKV = 53 * MiB;
constexpr size_t WS_XN = 55 * MiB;
constexpr size_t WS_P = 87 * MiB;
constexpr size_t WS_R = 127 * MiB;
constexpr int VTLD = T + 64;
constexpr size_t WS_VTSB = WS_R + 64 * MiB, WS_VTRT = WS_VTSB + (size_t)512 * VTLD * 2;
constexpr size_t WS_SCR = 224 * MiB;
constexpr size_t WS_MRG = 240 * MiB;
constexpr size_t WS_DNI = 224 * MiB;
constexpr size_t WS_KVM = 296 * MiB;
constexpr size_t WS_ROPE = 300 * MiB;
constexpr size_t WS_AB = 304 * MiB;
constexpr size_t WS_GB = WS_AB + 512 * 1024;
constexpr size_t WS_SS = 305 * MiB;
constexpr size_t WS_END = 310 * MiB;
constexpr size_t WS_MEMN = 306 * MiB;
constexpr int PLD = 1280, RALD = 1536, RBLD = 2048, SCRLD = 1024, MRGLD = 1024;
constexpr int P_DNZ = 0, P_MEMQ = 512, P_RTQ = 768, P_RTK = 1024;
constexpr int RB_SBQ = 0, RB_SBK = 512, RB_SBZ = 1024, RB_RTZ = 1536;
constexpr int CW_BAR = 4096;
constexpr int CW_PANEL = 16384;
constexpr int CW_QUEUE = 64;
constexpr int CW_RST = 49152;
constexpr int CW_READY = 32768;

constexpr int RING_BYTES = 155648;
constexpr int LDSCTL_OFF = RING_BYTES, MISC_OFF = LDSCTL_OFF + 320, SPARE_OFF = LDSCTL_OFF + 1024;
constexpr int LDS_BYTES = 163840;
constexpr int NWAVES = 8, NTHREADS = 512;

DI unsigned f2bf(float f) { unsigned u = __builtin_bit_cast(unsigned, f); return (u + 0x7fffu + ((u >> 16) & 1u)) >> 16; }
DI unsigned pk2(float lo, float hi) { unsigned r; asm("s_nop 0\n\tv_cvt_pk_bf16_f32 %0, %1, %2" : "=v"(r) : "v"(lo), "v"(hi)); return r; }
DI float bf2f(unsigned short h) { return __builtin_bit_cast(float, (unsigned)h << 16); }
DI float bflo(unsigned w) { return __builtin_bit_cast(float, w << 16); }
DI float bfhi(unsigned w) { return __builtin_bit_cast(float, w & 0xffff0000u); }
DI float shx(float v, int m, int lane) { return __builtin_bit_cast(float, __builtin_amdgcn_ds_bpermute((lane ^ m) << 2, __builtin_bit_cast(int, v))); }
DI float wave_sum(float v, int lane) {
#pragma unroll
    for (int o = 1; o < 64; o <<= 1) v += shx(v, o, lane);
    return v;
}
DI float sum16(float v) {
    v += __builtin_bit_cast(float, __builtin_amdgcn_update_dpp(0, __builtin_bit_cast(int, v), 0xB1, 0xf, 0xf, true));
    v += __builtin_bit_cast(float, __builtin_amdgcn_update_dpp(0, __builtin_bit_cast(int, v), 0x4E, 0xf, 0xf, true));
    v += __builtin_bit_cast(float, __builtin_amdgcn_update_dpp(0, __builtin_bit_cast(int, v), 0x141, 0xf, 0xf, true));
    v += __builtin_bit_cast(float, __builtin_amdgcn_update_dpp(0, __builtin_bit_cast(int, v), 0x140, 0xf, 0xf, true));
    return v;
}
DI float sigmoidf_(float x) { return __builtin_amdgcn_rcpf(1.f + __builtin_amdgcn_exp2f(x * -1.4426950408889634f)); }
DI float siluf_(float x) { return x * __builtin_amdgcn_rcpf(1.f + __builtin_amdgcn_exp2f(x * -1.4426950408889634f)); }
DI int opaque_bid() { int b = blockIdx.x; asm volatile("" : "+s"(b)); return b; }
DI int opaque_tid(int wv) { int lane; asm volatile("v_mbcnt_lo_u32_b32 %0, -1, 0\n\tv_mbcnt_hi_u32_b32 %0, -1, %0" : "=v"(lane)); return wv * 64 + lane; }
#define LDS_WAIT() asm volatile("s_waitcnt lgkmcnt(0)" ::: "memory")
DI void lds_barrier() { asm volatile("s_waitcnt lgkmcnt(0)" ::: "memory"); __builtin_amdgcn_s_barrier(); asm volatile("" ::: "memory"); }
#define VM_WAIT() asm volatile("s_waitcnt vmcnt(0)" ::: "memory")
DI unsigned shxu(unsigned v, int m, int lane) { return (unsigned)__builtin_amdgcn_ds_bpermute((lane ^ m) << 2, (int)v); }
DI void st16_wt(void* p, u32x4 v) { asm volatile("global_store_dwordx4 %0, %1, off sc1\n\ts_nop 1" :: "v"(p), "v"(v) : "memory"); }
DI void unit_done(unsigned char* ws, int l, int pm, int tid) {
    VM_WAIT(); lds_barrier();
    if (tid == 0) (void)__hip_atomic_fetch_add((unsigned*)(ws + WS_CTL) + CW_READY + 4096 * l + 64 * pm, 1u, __ATOMIC_RELAXED, __HIP_MEMORY_SCOPE_AGENT);
}

#define XB_TMO      128
#define XB_XCNT(j)  (256  + 64 * (j))
#define XB_XSUB(j)  (1280 + 64 * (j))
#define XB_XGEN(j)  (2304 + 64 * (j))
#define XB_TOP      3328
#define XB_TOPGEN   3392
#define XCD_BAR_WORDS 3456
#define XB_SPIN_CAP (1u << 18)
DI unsigned xb_ld(unsigned* p)              { return __hip_atomic_load(p, __ATOMIC_RELAXED, __HIP_MEMORY_SCOPE_AGENT); }
DI unsigned xb_add(unsigned* p, unsigned v) { return __hip_atomic_fetch_add(p, v, __ATOMIC_RELAXED, __HIP_MEMORY_SCOPE_AGENT); }
DI unsigned xb_xcc_id() { return (unsigned)__builtin_amdgcn_s_getreg((3 << 11) | 20) & 0xFu; }
#define XB_SPIN(cond, bar) do { unsigned _sp = 0; while (cond) { __builtin_amdgcn_s_sleep(1); \
    if ((++_sp & 255u) == 0u) { if (xb_ld(&(bar)[XB_TMO])) break; if (_sp > XB_SPIN_CAP) { atomicAdd(&(bar)[XB_TMO], 1u); break; } } } } while (0)
struct XcdBarrier { unsigned* bar; unsigned x; volatile LAS unsigned* st; };
DI XcdBarrier xcd_barrier_post(unsigned* bar, volatile LAS unsigned* st, int wv) {
    XcdBarrier b; b.bar = bar; b.x = xb_xcc_id(); b.st = st;
    if (opaque_tid(wv) == 0) (void)xb_add(&bar[XB_XCNT(b.x)], 1u);
    return b;
}
DI void xcd_barrier_complete(unsigned* bar, unsigned x, unsigned& nloc, unsigned& nx) {
    const unsigned G = gridDim.x * gridDim.y * gridDim.z;
    unsigned sum, cnt, mine, sp = 0u;
    for (;;) {
        sum = 0u; cnt = 0u; mine = 0u;
#pragma unroll
        for (unsigned j = 0; j < 16; ++j) { const unsigned c = xb_ld(&bar[XB_XCNT(j)]); sum += c; cnt += (c > 0u) ? 1u : 0u; mine = (j == x) ? c : mine; }
        if (sum == G) break;
        __builtin_amdgcn_s_sleep(1);
        if ((++sp & 255u) == 0u) { if (xb_ld(&bar[XB_TMO])) break; if (sp > XB_SPIN_CAP) { atomicAdd(&bar[XB_TMO], 1u); break; } }
    }
    nloc = mine > 0u ? mine : 1u; nx = cnt > 0u ? cnt : 1u;
}
DI void xcd_barrier(const XcdBarrier& b, int wv) {
    asm volatile("s_waitcnt vmcnt(0)" ::: "memory");
    __syncthreads();
    if (opaque_tid(wv) == 0) {
        unsigned* bar = b.bar;
        __builtin_amdgcn_s_waitcnt(0);
#if EARLY_INV
        __builtin_amdgcn_fence(__ATOMIC_ACQUIRE, "agent");
#endif
        unsigned nloc = b.st[0], nx = b.st[1];
        if (nloc == 0u) { xcd_barrier_complete(bar, b.x, nloc, nx); b.st[0] = nloc; b.st[1] = nx; }
        const unsigned old = xb_add(&bar[XB_XSUB(b.x)], 1u);
        const unsigned gen = old / nloc;
        if (old + 1u == (gen + 1u) * nloc) {
            __builtin_amdgcn_fence(__ATOMIC_RELEASE, "agent");
            asm volatile("s_waitcnt vmcnt(0)" ::: "memory");
            const unsigned og = xb_add(&bar[XB_TOP], 1u);
            const unsigned tg = og / nx;
            if (og + 1u == (tg + 1u) * nx) xb_add(&bar[XB_TOPGEN], 1u);
            else XB_SPIN(xb_ld(&bar[XB_TOPGEN]) == tg, bar);
#if !EARLY_INV
            __builtin_amdgcn_fence(__ATOMIC_ACQUIRE, "agent");
#endif
            xb_add(&bar[XB_XGEN(b.x)], 1u);
            asm volatile("s_waitcnt vmcnt(0)" ::: "memory");
        } else {
            XB_SPIN(xb_ld(&bar[XB_XGEN(b.x)]) == gen, bar);
#if !EARLY_INV
            __builtin_amdgcn_fence(__ATOMIC_ACQUIRE, "agent");
#endif
            asm volatile("s_waitcnt vmcnt(0)" ::: "memory");
        }
    }
    __syncthreads();
}

namespace gm {
constexpr int BM = 256, BK = 64, HALF = 128, HTB = HALF * BK * 2, STAGE_BYTES = 8 * HTB;
DI int lds_byte(int r, int c) { const int st = (r >> 4) * 2 + (c >> 5), rr = r & 15, cc = c & 31, ob = rr * 64 + cc * 2; return st * 1024 + (ob ^ (((ob >> 9) & 1) << 5)); }
DI void stage_rc(int b, int& R, int& C) { const int st = b / 1024, sb = b % 1024, swz = sb ^ (((sb >> 9) & 1) << 5); R = (st >> 1) * 16 + swz / 64; C = (st & 1) * 32 + (swz % 64) / 2; }
DI int perm32(int rho) { const int n = rho >> 4, i = rho & 15; return 8 * (i >> 2) + 4 * n + (i & 3); }

enum Kind { K_STORE = 0, K_AB = 1, K_GATE = 2, K_BRANCH = 3, K_OUT = 4, K_STORE_T = 5 };
struct Unit {
    const bf16_t* A; const bf16_t* B;
    int lda, ldb, K, pm, pn, kind, sub, l;
};
struct TileOrder {
    int nM, nN, nwg, G, c;
    DI void init(int nM_, int nN_, int G_, int c_) { nM = nM_; nN = nN_; nwg = nM * nN; G = G_; c = c_; }
    DI bool tile(int i, int& pm, int& pn) const {
        const long L = (long)i * G + c; if (L >= nwg) return false;
        int wgid = (int)L; { const int q = nwg / 8, r = nwg % 8, xcd = wgid % 8, off = wgid / 8; wgid = (xcd < r ? xcd * (q + 1) : r * (q + 1) + (xcd - r) * q) + off; }
        const int WGM = 8, nig = WGM * nN, gid = wgid / nig, fm = gid * WGM, gsz = (nM - fm) < WGM ? (nM - fm) : WGM;
        pm = __builtin_amdgcn_readfirstlane(fm + ((wgid % nig) % gsz)); pn = __builtin_amdgcn_readfirstlane((wgid % nig) / gsz); return true;
    }
};

template <int AUX, class Sched, class Epi>
DI void gemm_phase(LAS unsigned char* lds, int wv, const Sched& S, const Epi& E) {
    const int tid = opaque_tid(wv), wid = __builtin_amdgcn_readfirstlane(tid >> 6), lane = tid & 63, wr = wid >> 2, wc = wid & 3, fr = lane & 15, fq = lane >> 4;
    int R0_, C0_; stage_rc(tid * 16, R0_, C0_);
    const unsigned R0 = 2u * (unsigned)R0_, C2 = 2u * (unsigned)C0_;
    const unsigned RbP = 2u * (unsigned)((R0_ & ~31) + perm32(R0_ & 31));
    const unsigned ldsw = (unsigned)wid * 1024u;
    const int aoff = lds_byte(wr * 64 + fr, fq * 8), boff = lds_byte(wc * 32 + fr, fq * 8);
#define GM_SA(b, h) (((b) * 2 + (h)) * HTB)
#define GM_SB(b, h) ((4 + (b) * 2 + (h)) * HTB)
#define GM_STAGE(bufoff, gbase, ld, R2) do { const unsigned _v = (unsigned)(R2) * (unsigned)(ld) + C2; \
        __builtin_amdgcn_global_load_lds((const unsigned*)((const char*)(gbase) + _v), (LAS unsigned*)(lds + (bufoff) + ldsw), 16, 0, AUX); \
        __builtin_amdgcn_global_load_lds((const unsigned*)((const char*)(gbase) + (_v + (unsigned)(ld) * 128u)), (LAS unsigned*)(lds + (bufoff) + ldsw + 8192), 16, 0, AUX); } while (0)
#define GM_LDA(dst, b, h) do { _Pragma("unroll") for (int m = 0; m < 4; ++m) _Pragma("unroll") for (int k = 0; k < 2; ++k) dst[m][k] = *(const LAS bf16x8*)(lds + GM_SA(b, h) + aoff + m * 2048 + k * 1024); } while (0)
#define GM_LDB(dst, b, h) do { _Pragma("unroll") for (int n = 0; n < 2; ++n) _Pragma("unroll") for (int k = 0; k < 2; ++k) dst[n][k] = *(const LAS bf16x8*)(lds + GM_SB(b, h) + boff + n * 2048 + k * 1024); } while (0)
#define GM_MMA(ai, bj, At, Bt) do { __builtin_amdgcn_s_setprio(1); _Pragma("unroll") for (int m = 0; m < 4; ++m) _Pragma("unroll") for (int n = 0; n < 2; ++n) _Pragma("unroll") for (int k = 0; k < 2; ++k) \
        acc[ai][bj][m][n] = __builtin_amdgcn_mfma_f32_16x16x32_bf16(Bt[n][k], At[m][k], acc[ai][bj][m][n], 0, 0, 0); __builtin_amdgcn_s_setprio(0); } while (0)
#define GM_WAIT_V(n) asm volatile("s_waitcnt vmcnt(" #n ")" ::: "memory")
#define GM_WAIT_L(n) asm volatile("s_waitcnt lgkmcnt(" #n ")" ::: "memory")
#define GM_BAR __builtin_amdgcn_s_barrier()
#define GM_SCHED __builtin_amdgcn_sched_barrier(0)
    Unit cur, nxt; int ui = 0;
    if (!S.next(0, cur)) return;
    S.a_ready(cur, wid, lane);
    f32x4 acc[2][2][4][2];
#pragma unroll
    for (int a = 0; a < 2; ++a)
#pragma unroll
        for (int b = 0; b < 2; ++b)
#pragma unroll
            for (int m = 0; m < 4; ++m)
#pragma unroll
                for (int n = 0; n < 2; ++n) acc[a][b][m][n] = (f32x4){0.f, 0.f, 0.f, 0.f};
    bf16x8 At[4][2], B0[2][2], B1[2][2];
    const char* cA = (const char*)cur.A; const char* cB = (const char*)cur.B; int clda = cur.lda, cldb = cur.ldb;
    GM_STAGE(GM_SB(0, 0), cB, cldb, RbP); GM_STAGE(GM_SB(0, 1), cB + (size_t)cldb * 256, cldb, RbP); GM_STAGE(GM_SA(0, 0), cA, clda, R0); GM_STAGE(GM_SA(0, 1), cA + (size_t)clda * 256, clda, R0);
    if (wr == 1) GM_BAR;
    GM_WAIT_V(2); GM_BAR;
    GM_STAGE(GM_SB(1, 0), cB + 128, cldb, RbP); GM_STAGE(GM_SA(1, 0), cA + 128, clda, R0); GM_STAGE(GM_SB(1, 1), cB + (size_t)cldb * 256 + 128, cldb, RbP);
    GM_WAIT_V(6); GM_BAR;
    for (;;) {
        const bool has_next = S.next(ui + 1, nxt);
        const char* nA = has_next ? (const char*)nxt.A : cA; const char* nB = has_next ? (const char*)nxt.B : cB;
        const int nlda = has_next ? nxt.lda : clda, nldb = has_next ? nxt.ldb : cldb;
        const int nt = cur.K / BK;
#if SS_PREFETCH
        if (wid < 4) __builtin_amdgcn_global_load_lds((const unsigned*)(E.ws + WS_SS + ((size_t)(cur.kind == K_STORE_T ? cur.pn : cur.pm) * 256 + tid) * 16), (LAS unsigned*)(lds + STAGE_BYTES + (ui & 1) * 4096 + wid * 1024), 16, 0, 0);
        if (wid == 4 && cur.kind == K_GATE) __builtin_amdgcn_global_load_lds((const unsigned*)(E.b_gate + (size_t)cur.l * 4096 + (cur.sub & 3) * 1024 + cur.pn * 256 + lane * 4), (LAS unsigned*)(lds + STAGE_BYTES + 8192 + (ui & 1) * 1024), 16, 0, 0);
#endif
        for (int t = 0; t < nt; t += 2) {
            const bool last = (t == nt - 2);
            if (last && has_next) S.a_ready(nxt, wid, lane);
            const char* a1 = cA + (size_t)(t + 1) * 128;
            const char* a2 = last ? nA : cA + (size_t)(t + 2) * 128; const char* b2 = last ? nB : cB + (size_t)(t + 2) * 128;
            const int lda2 = last ? nlda : clda, ldb2 = last ? nldb : cldb;
            const char* a3 = a2 + 128; const char* b3 = b2 + 128;
            const int later = __builtin_amdgcn_readfirstlane((t != 0) ? 1 : 0);
#if FRESH_WAITS
#define GM_WAIT_V8_LATER asm volatile("s_cmp_eq_u32 %0, 0\n\ts_cbranch_scc1 .Lgmw%=\n\ts_waitcnt vmcnt(8)\n.Lgmw%=:" :: "s"(later) : "scc", "memory")
#else
#define GM_WAIT_V8_LATER GM_WAIT_V(8)
#endif
            GM_LDB(B0, 0, 0); GM_LDB(B1, 0, 1); GM_SCHED; GM_LDA(At, 0, 0); GM_STAGE(GM_SA(1, 1), a1 + (size_t)clda * 256, clda, R0);
            GM_WAIT_V8_LATER; GM_WAIT_L(0); GM_BAR; GM_MMA(0, 0, At, B0); GM_MMA(0, 1, At, B1); GM_BAR; GM_SCHED;
            GM_LDA(At, 0, 1); GM_STAGE(GM_SB(0, 0), b2, ldb2, RbP); GM_STAGE(GM_SB(0, 1), b2 + (size_t)ldb2 * 256, ldb2, RbP); GM_STAGE(GM_SA(0, 0), a2, lda2, R0);
            GM_WAIT_V8_LATER; GM_WAIT_L(0); GM_BAR; GM_MMA(1, 0, At, B0); GM_MMA(1, 1, At, B1); GM_BAR; GM_SCHED;
#undef GM_WAIT_V8_LATER
            GM_LDB(B0, 1, 0); GM_LDB(B1, 1, 1); GM_SCHED; GM_LDA(At, 1, 0); GM_STAGE(GM_SA(0, 1), a2 + (size_t)lda2 * 256, lda2, R0);
            GM_WAIT_V(8); GM_WAIT_L(0); GM_BAR; GM_MMA(0, 0, At, B0); GM_MMA(0, 1, At, B1); GM_BAR; GM_SCHED;
            GM_LDA(At, 1, 1); GM_STAGE(GM_SB(1, 0), b3, ldb2, RbP); GM_STAGE(GM_SB(1, 1), b3 + (size_t)ldb2 * 256, ldb2, RbP); GM_STAGE(GM_SA(1, 0), a3, lda2, R0);
            GM_WAIT_V(8); GM_WAIT_L(0); GM_BAR; GM_MMA(1, 0, At, B0); GM_MMA(1, 1, At, B1); GM_BAR; GM_SCHED;
        }
        if (wr == 0) GM_BAR;
        if (FRESH_WAITS && (cur.kind == K_AB || (cur.kind == K_STORE && cur.sub == 2) || (cur.kind == K_STORE_T && cur.sub == 1))) GM_WAIT_V(0);
#ifdef PROBE_EPI
        const unsigned long long te0_ = __builtin_amdgcn_s_memrealtime();
#endif
        E(acc, cur, wr, wc, fr, fq, lane, (const LAS float*)(lds + STAGE_BYTES + (ui & 1) * 4096), (const LAS float*)(lds + STAGE_BYTES + 8192 + (ui & 1) * 1024));
#ifdef PROBE_EPI
        if (cur.kind == PROBE_EPI) { asm volatile("s_waitcnt vmcnt(0)" ::: "memory"); const unsigned long long t1_ = __builtin_amdgcn_s_memrealtime(); const unsigned long long d_ = t1_ - te0_; while (__builtin_amdgcn_s_memrealtime() - t1_ < d_) __builtin_amdgcn_s_sleep(2); }
#endif
        if (!has_next) break;
#pragma unroll
        for (int a = 0; a < 2; ++a)
#pragma unroll
            for (int b = 0; b < 2; ++b)
#pragma unroll
                for (int m = 0; m < 4; ++m)
#pragma unroll
                    for (int n = 0; n < 2; ++n) acc[a][b][m][n] = (f32x4){0.f, 0.f, 0.f, 0.f};
        cur = nxt; cA = nA; cB = nB; clda = nlda; cldb = nldb; ++ui;
        if (wr == 1) GM_BAR;
    }
    GM_WAIT_V(0);
    GM_BAR;
#undef GM_SA
#undef GM_SB
#undef GM_STAGE
#undef GM_LDA
#undef GM_LDB
#undef GM_MMA
#undef GM_WAIT_V
#undef GM_WAIT_L
#undef GM_BAR
#undef GM_SCHED
}

#if SS_PREFETCH
#define SSROW(pan, r) row_scale_l(ssl, (r))
#else
#define SSROW(pan, r) row_scale((pan) * BM + (r))
#endif
struct Epi {
    unsigned char* ws;
    const float* xin; float* xout;
    bool wout32;
    const float* b_gate;
    const float* gnext;
    const float* gfinal;
    LAS float* spare;
    DI float row_scale(int row) const { const f32x4 s = *(const f32x4*)((const float*)(ws + WS_SS) + (size_t)row * 4); return rsqrtf(((s.x + s.y) + (s.z + s.w)) * (1.0f / 1024.0f) + EPS); }
    static DI float row_scale_l(const LAS float* ssl, int r) { const f32x4 s = *(const LAS f32x4*)(ssl + r * 4); return rsqrtf(((s.x + s.y) + (s.z + s.w)) * (1.0f / 1024.0f) + EPS); }
    DI unsigned char* scratch_tile(int pm, int pn) const { return ws + WS_SCR + (size_t)pm * 256 * SCRLD + pn * 256; }
    DI void operator()(f32x4 (&acc)[2][2][4][2], const Unit& u, int wr, int wc, int fr, int fq, int lane, const LAS float* ssl, const LAS float* bil) const {
        int rl0 = wr * 64 + fr, cl0 = wc * 32 + 8 * fq;
        asm volatile("" : "+v"(rl0), "+v"(cl0));
        if (u.kind == K_STORE) {
            bf16_t* base; int ldc; bool scale = true;
            if (u.sub == 0) {
                if (u.pn < 6) { base = (bf16_t*)(ws + WS_R) + (size_t)u.pm * 256 * RALD + u.pn * 256; ldc = RALD; }
                else { const int pc = u.pn < 8 ? (u.pn - 6) * 256 : (u.pn - 7) * 256; base = (bf16_t*)(ws + WS_P) + (size_t)u.pm * 256 * PLD + pc; ldc = PLD; }
            } else if (u.sub == 1) { base = (bf16_t*)(ws + WS_R) + (size_t)u.pm * 256 * RBLD + u.pn * 256; ldc = RBLD; }
            else { base = (bf16_t*)(ws + WS_KVM) + (size_t)u.l * 1024 * 1024 + (size_t)u.pm * 256 * 256; ldc = 256; scale = false; }
            const bool rope = (u.sub == 0 && u.pn >= 10);
            const float rsc = (u.pn == 11) ? 0.125f : 1.0f;
            const float* rc = (const float*)(ws + WS_ROPE); const int fi = (cl0 & 63) >> 1;
            float scq[2][4];
#pragma unroll
            for (int ai = 0; ai < 2; ++ai)
#pragma unroll
                for (int m = 0; m < 4; ++m) scq[ai][m] = scale ? SSROW(u.pm, rl0 + ai * HALF + m * 16) : 1.0f;
#pragma unroll
            for (int ai = 0; ai < 2; ++ai) {
                f32x4 csq[4], snq[4];
                if (rope) {
#pragma unroll
                    for (int m = 0; m < 4; ++m) { const size_t ro = (size_t)(u.pm * BM + rl0 + ai * HALF + m * 16) * 32 + fi; csq[m] = *(const f32x4*)(rc + ro); snq[m] = *(const f32x4*)(rc + (size_t)T * 32 + ro); }
                }
#pragma unroll
                for (int m = 0; m < 4; ++m) {
                    const int rl = rl0 + ai * HALF + m * 16;
                    const float sc = scq[ai][m];
                    bf16_t* rowp = base + (size_t)rl * ldc + cl0;
                    f32x4 cs4 = {1.f, 1.f, 1.f, 1.f}, sn4 = {0.f, 0.f, 0.f, 0.f};
                    if (rope) { cs4 = csq[m]; sn4 = snq[m]; }
#pragma unroll
                    for (int bj = 0; bj < 2; ++bj) { f32x4 v0 = acc[ai][bj][m][0] * sc, v1 = acc[ai][bj][m][1] * sc;
                        if (rope) { f32x4 r0, r1;
                            r0[0] = (v0[0] * cs4[0] - v0[1] * sn4[0]) * rsc; r0[1] = (v0[0] * sn4[0] + v0[1] * cs4[0]) * rsc; r0[2] = (v0[2] * cs4[1] - v0[3] * sn4[1]) * rsc; r0[3] = (v0[2] * sn4[1] + v0[3] * cs4[1]) * rsc;
                            r1[0] = (v1[0] * cs4[2] - v1[1] * sn4[2]) * rsc; r1[1] = (v1[0] * sn4[2] + v1[1] * cs4[2]) * rsc; r1[2] = (v1[2] * cs4[3] - v1[3] * sn4[3]) * rsc; r1[3] = (v1[2] * sn4[3] + v1[3] * cs4[3]) * rsc;
                            v0 = r0; v1 = r1; }
                        u32x4 w; w.x = pk2(v0[0], v0[1]); w.y = pk2(v0[2], v0[3]); w.z = pk2(v1[0], v1[1]); w.w = pk2(v1[2], v1[3]);
                        *(u32x4*)(rowp + bj * HALF) = w; }
                }
            }
        } else if (u.kind == K_STORE_T) {
            bf16_t* base; const bool scale = (u.sub == 0);
            if (u.sub == 0) base = (bf16_t*)(ws + WS_VTSB) + (size_t)u.pm * 256 * VTLD + u.pn * 256;
            else base = (bf16_t*)(ws + WS_KVM) + (size_t)u.l * 1024 * 1024 + 256 * 2048 + u.pn * 256;
            const int ldc = (u.sub == 0) ? VTLD : 2048;
            f32x4 cs[2][2];
#pragma unroll
            for (int bj = 0; bj < 2; ++bj)
#pragma unroll
                for (int n = 0; n < 2; ++n)
#pragma unroll
                    for (int j = 0; j < 4; ++j) cs[bj][n][j] = scale ? SSROW(u.pn, cl0 + bj * HALF + 4 * n + j) : 1.0f;
#pragma unroll
            for (int ai = 0; ai < 2; ++ai)
#pragma unroll
                for (int m = 0; m < 4; ++m) {
                    const int rl = rl0 + ai * HALF + m * 16;
                    bf16_t* rowp = base + (size_t)rl * ldc + cl0;
#pragma unroll
                    for (int bj = 0; bj < 2; ++bj) { const f32x4 v0 = acc[ai][bj][m][0] * cs[bj][0], v1 = acc[ai][bj][m][1] * cs[bj][1];
                        u32x4 w; w.x = pk2(v0[0], v0[1]); w.y = pk2(v0[2], v0[3]); w.z = pk2(v1[0], v1[1]); w.w = pk2(v1[2], v1[3]);
                        *(u32x4*)(rowp + bj * HALF) = w; }
                }
        } else if (u.kind == K_AB) {
            if (wc == 0 && fq == 0) {
                float* base = (float*)(ws + WS_AB) + (size_t)u.pm * 256 * 8;
#pragma unroll
                for (int ai = 0; ai < 2; ++ai)
#pragma unroll
                    for (int m = 0; m < 4; ++m) {
                        const int rl = rl0 + ai * HALF + m * 16;
                        const float sc = SSROW(u.pm, rl);
                        float* rowp = base + (size_t)rl * 8;
                        *(f32x4*)(rowp) = acc[ai][0][m][0] * sc; *(f32x4*)(rowp + 4) = acc[ai][0][m][1] * sc;
                    }
            }
        } else if (u.kind == K_GATE) {
            unsigned char* base = scratch_tile(u.pm, u.pn);
            const float* bias = b_gate + (size_t)u.l * 4096 + (u.sub & 3) * 1024 + u.pn * 256;
            f32x4 bv[2][2];
#pragma unroll
            for (int bj = 0; bj < 2; ++bj)
#pragma unroll
#if SS_PREFETCH
                for (int n = 0; n < 2; ++n) bv[bj][n] = *(const LAS f32x4*)(bil + cl0 + bj * HALF + 4 * n) * -1.4426950408889634f;
#else
                for (int n = 0; n < 2; ++n) bv[bj][n] = *(const f32x4*)(bias + cl0 + bj * HALF + 4 * n) * -1.4426950408889634f;
#endif
            float scq[2][4];
#pragma unroll
            for (int ai = 0; ai < 2; ++ai)
#pragma unroll
                for (int m = 0; m < 4; ++m) scq[ai][m] = SSROW(u.pm, rl0 + ai * HALF + m * 16) * -1.4426950408889634f;
#pragma unroll
            for (int ai = 0; ai < 2; ++ai)
#pragma unroll
                for (int m = 0; m < 4; ++m) {
                    const int rl = rl0 + ai * HALF + m * 16;
                    const float sc = scq[ai][m];
                    unsigned char* rowp = base + (size_t)rl * SCRLD + cl0;
#pragma unroll
                    for (int bj = 0; bj < 2; ++bj) { const f32x4 v0 = acc[ai][bj][m][0] * sc + bv[bj][0], v1 = acc[ai][bj][m][1] * sc + bv[bj][1];
                        unsigned pa = 0u, pb = 0u;
#define G255(x) __builtin_amdgcn_rcpf(__builtin_amdgcn_exp2f(x) * (1.0f / 255.0f) + (1.0f / 255.0f))
                        pa = __builtin_amdgcn_cvt_pk_u8_f32(G255(v0[0]), 0, pa); pa = __builtin_amdgcn_cvt_pk_u8_f32(G255(v0[1]), 1, pa);
                        pa = __builtin_amdgcn_cvt_pk_u8_f32(G255(v0[2]), 2, pa); pa = __builtin_amdgcn_cvt_pk_u8_f32(G255(v0[3]), 3, pa);
                        pb = __builtin_amdgcn_cvt_pk_u8_f32(G255(v1[0]), 0, pb); pb = __builtin_amdgcn_cvt_pk_u8_f32(G255(v1[1]), 1, pb);
                        pb = __builtin_amdgcn_cvt_pk_u8_f32(G255(v1[2]), 2, pb); pb = __builtin_amdgcn_cvt_pk_u8_f32(G255(v1[3]), 3, pb);
#undef G255
                        EPI_ST((u32x2*)(rowp + bj * HALF), ((u32x2){pa, pb})); }
                }
        } else if (u.kind == K_BRANCH) {
            bf16_t* base = (bf16_t*)(ws + WS_MRG) + (size_t)u.pm * 256 * MRGLD + u.pn * 256; const unsigned char* gbase = scratch_tile(u.pm, u.pn);
            const bool first = (u.sub & 4) != 0;
            const float i255 = 1.0f / 255.0f;
#ifdef BR_ALL_IN_FLIGHT
            u32x2 gq2[2][4][2]; u32x4 tq[2][4][2];
#pragma unroll
            for (int ai = 0; ai < 2; ++ai)
#pragma unroll
                for (int m = 0; m < 4; ++m) { const int rl = rl0 + ai * HALF + m * 16;
#pragma unroll
                    for (int bj = 0; bj < 2; ++bj) { gq2[ai][m][bj] = EPI_LD((const u32x2*)(gbase + (size_t)rl * SCRLD + cl0 + bj * HALF));
                        tq[ai][m][bj] = first ? (u32x4){0u, 0u, 0u, 0u} : EPI_LD((const u32x4*)(base + (size_t)rl * MRGLD + cl0 + bj * HALF)); } }
#pragma unroll
            for (int ai = 0; ai < 2; ++ai) {
#pragma unroll
                for (int m = 0; m < 4; ++m) { const int rl = rl0 + ai * HALF + m * 16;
#pragma unroll
                    for (int bj = 0; bj < 2; ++bj) {
                        const u32x4 t = tq[ai][m][bj]; const f32x4 v0 = acc[ai][bj][m][0], v1 = acc[ai][bj][m][1]; const unsigned ga = gq2[ai][m][bj].x, gb = gq2[ai][m][bj].y;
                        u32x4 w;
                        w.x = pk2(bflo(t.x) + (float)(ga & 0xffu) * i255 * v0[0], bfhi(t.x) + (float)((ga >> 8) & 0xffu) * i255 * v0[1]);
                        w.y = pk2(bflo(t.y) + (float)((ga >> 16) & 0xffu) * i255 * v0[2], bfhi(t.y) + (float)(ga >> 24) * i255 * v0[3]);
                        w.z = pk2(bflo(t.z) + (float)(gb & 0xffu) * i255 * v1[0], bfhi(t.z) + (float)((gb >> 8) & 0xffu) * i255 * v1[1]);
                        w.w = pk2(bflo(t.w) + (float)((gb >> 16) & 0xffu) * i255 * v1[2], bfhi(t.w) + (float)(gb >> 24) * i255 * v1[3]);
                        EPI_ST((u32x4*)(base + (size_t)rl * MRGLD + cl0 + bj * HALF), w); } }
                asm volatile("" ::: "memory");
            }
#else
#pragma unroll
            for (int ai = 0; ai < 2; ++ai) {
                u32x2 gq2[4][2]; u32x4 tq[4][2];
#pragma unroll
                for (int m = 0; m < 4; ++m) { const int rl = rl0 + ai * HALF + m * 16;
#pragma unroll
                    for (int bj = 0; bj < 2; ++bj) { gq2[m][bj] = EPI_LD((const u32x2*)(gbase + (size_t)rl * SCRLD + cl0 + bj * HALF));
                        tq[m][bj] = first ? (u32x4){0u, 0u, 0u, 0u} : EPI_LD((const u32x4*)(base + (size_t)rl * MRGLD + cl0 + bj * HALF)); } }
#pragma unroll
                for (int m = 0; m < 4; ++m) { const int rl = rl0 + ai * HALF + m * 16;
#pragma unroll
                    for (int bj = 0; bj < 2; ++bj) {
                        const u32x4 t = tq[m][bj]; const f32x4 v0 = acc[ai][bj][m][0], v1 = acc[ai][bj][m][1]; const unsigned ga = gq2[m][bj].x, gb = gq2[m][bj].y;
                        u32x4 w;
                        w.x = pk2(bflo(t.x) + (float)(ga & 0xffu) * i255 * v0[0], bfhi(t.x) + (float)((ga >> 8) & 0xffu) * i255 * v0[1]);
                        w.y = pk2(bflo(t.y) + (float)((ga >> 16) & 0xffu) * i255 * v0[2], bfhi(t.y) + (float)(ga >> 24) * i255 * v0[3]);
                        w.z = pk2(bflo(t.z) + (float)(gb & 0xffu) * i255 * v1[0], bfhi(t.z) + (float)((gb >> 8) & 0xffu) * i255 * v1[1]);
                        w.w = pk2(bflo(t.w) + (float)((gb >> 16) & 0xffu) * i255 * v1[2], bfhi(t.w) + (float)(gb >> 24) * i255 * v1[3]);
                        EPI_ST((u32x4*)(base + (size_t)rl * MRGLD + cl0 + bj * HALF), w); } }
                asm volatile("" ::: "memory");
            }
#endif
        } else {
            bf16_t* base = (bf16_t*)(ws + WS_XN) + (size_t)u.pm * 256 * 1024 + u.pn * 256;
            const bool wxn = gnext != nullptr, fin = gfinal != nullptr;
            f32x4 gv[2][2];
#pragma unroll
            for (int bj = 0; bj < 2; ++bj)
#pragma unroll
                for (int n = 0; n < 2; ++n) gv[bj][n] = fin ? *(const f32x4*)(gfinal + u.pn * BM + cl0 + bj * HALF + 4 * n) : (f32x4){0.f, 0.f, 0.f, 0.f};
#pragma unroll
            for (int ah = 0; ah < 4; ++ah) {
                const int ai = ah >> 1, m0 = (ah & 1) * 2;
                f32x4 xq[2][2][2];
#pragma unroll
                for (int mm = 0; mm < 2; ++mm) { const size_t goff = (size_t)(u.pm * BM + rl0 + ai * HALF + (m0 + mm) * 16) * D + u.pn * BM + cl0;
#pragma unroll
                    for (int bj = 0; bj < 2; ++bj) {
                        const u32x4 t = *(const u32x4*)(base + (size_t)(rl0 + ai * HALF + (m0 + mm) * 16) * 1024 + cl0 + bj * HALF); (void)goff;
                        xq[mm][bj][0] = (f32x4){bflo(t.x), bfhi(t.x), bflo(t.y), bfhi(t.y)}; xq[mm][bj][1] = (f32x4){bflo(t.z), bfhi(t.z), bflo(t.w), bfhi(t.w)}; } }
#pragma unroll
                for (int mm = 0; mm < 2; ++mm) {
                    const int m = m0 + mm, rl = rl0 + ai * HALF + m * 16;
                    const size_t goff = (size_t)(u.pm * BM + rl) * D + u.pn * BM + cl0;
                    float sq = 0.f;
#pragma unroll
                    for (int bj = 0; bj < 2; ++bj) {
                        const f32x4 v0 = acc[ai][bj][m][0] + xq[mm][bj][0], v1 = acc[ai][bj][m][1] + xq[mm][bj][1];
                        acc[ai][bj][m][0] = v0; acc[ai][bj][m][1] = v1;
                        if (wout32) { *(f32x4*)(xout + goff + bj * HALF) = v0; *(f32x4*)(xout + goff + bj * HALF + 4) = v1; }
                        sq += (v0[0] * v0[0] + v0[1] * v0[1]) + (v0[2] * v0[2] + v0[3] * v0[3]) + (v1[0] * v1[0] + v1[1] * v1[1]) + (v1[2] * v1[2] + v1[3] * v1[3]);
                        if (wxn) { const f32x4 a = v0, b = v1;
                            u32x4 w; w.x = pk2(a[0], a[1]); w.y = pk2(a[2], a[3]); w.z = pk2(b[0], b[1]); w.w = pk2(b[2], b[3]);
                            *(u32x4*)(base + (size_t)rl * 1024 + cl0 + bj * HALF) = w; }
                    }
                    sq += shx(sq, 16, lane); sq += shx(sq, 32, lane);
                    if (fq == 0) spare[rl * 4 + wc] = sq;
                }
                asm volatile("" ::: "memory");
            }
            LDS_WAIT(); __builtin_amdgcn_s_barrier(); asm volatile("" ::: "memory");
            const int t_ = wr * 256 + wc * 64 + lane;
            unsigned* ssw = (unsigned*)(ws + WS_SS);
            if (t_ < 256) { const int rl = t_; const f32x4 p = *(const LAS f32x4*)(spare + rl * 4); const float tot = (p.x + p.y) + (p.z + p.w);
                if (fin) __hip_atomic_store(ssw + (size_t)(u.pm * BM + rl) * 4 + u.pn, __builtin_bit_cast(unsigned, tot), __ATOMIC_RELAXED, __HIP_MEMORY_SCOPE_AGENT);
                else ((float*)ssw)[(size_t)(u.pm * BM + rl) * 4 + u.pn] = tot; }
            if (fin) {
                unsigned* cnt = (unsigned*)(ws + WS_CTL) + CW_PANEL + 64 * u.pm;
                asm volatile("s_waitcnt vmcnt(0)" ::: "memory");
                __builtin_amdgcn_s_barrier(); asm volatile("" ::: "memory");
                if (t_ == 0) {
                    __hip_atomic_fetch_add(cnt, 1u, __ATOMIC_RELAXED, __HIP_MEMORY_SCOPE_AGENT);
                    unsigned sp_ = 0;
                    while (__hip_atomic_load(cnt, __ATOMIC_RELAXED, __HIP_MEMORY_SCOPE_AGENT) < 4u) { __builtin_amdgcn_s_sleep(1); if (++sp_ > (1u << 22)) break; }
                }
                __builtin_amdgcn_s_barrier(); asm volatile("" ::: "memory");
#pragma unroll
                for (int ai = 0; ai < 2; ++ai)
#pragma unroll
                    for (int m = 0; m < 4; ++m) {
                        const int rl = rl0 + ai * HALF + m * 16; const unsigned* sp4 = ssw + (size_t)(u.pm * BM + rl) * 4;
                        const float p0 = __builtin_bit_cast(float, __hip_atomic_load(sp4 + 0, __ATOMIC_RELAXED, __HIP_MEMORY_SCOPE_AGENT)), p1 = __builtin_bit_cast(float, __hip_atomic_load(sp4 + 1, __ATOMIC_RELAXED, __HIP_MEMORY_SCOPE_AGENT));
                        const float p2 = __builtin_bit_cast(float, __hip_atomic_load(sp4 + 2, __ATOMIC_RELAXED, __HIP_MEMORY_SCOPE_AGENT)), p3 = __builtin_bit_cast(float, __hip_atomic_load(sp4 + 3, __ATOMIC_RELAXED, __HIP_MEMORY_SCOPE_AGENT));
                        const float rs = rsqrtf(((p0 + p1) + (p2 + p3)) * (1.0f / 1024.0f) + EPS);
                        const size_t goff = (size_t)(u.pm * BM + rl) * D + u.pn * BM + cl0;
#pragma unroll
                        for (int bj = 0; bj < 2; ++bj) { *(f32x4*)(xout + goff + bj * HALF) = acc[ai][bj][m][0] * rs * gv[bj][0]; *(f32x4*)(xout + goff + bj * HALF + 4) = acc[ai][bj][m][1] * rs * gv[bj][1]; }
                    }
            }
        }
    }
};
}

struct Args {
    const float* x; const float* mem; const int* positions; const float* norm_g; const float* mem_norm_g; const float* w_in; const float* b_gate;
    const float* dn_conv_w; const float* dn_a_log; const float* dn_dt_bias; const float* dn_norm_g; const float* ret_norm_g; const float* w_mem_kv;
    const float* w_br_sb; const float* w_br_dn; const float* w_br_ret; const float* w_br_mem; const float* w_out; const float* final_norm_g;
    float* out; unsigned char* ws; int ph_lo, ph_hi, li, pad;
};
struct Frame { LAS unsigned char* lds; int tid, lane, wave, G, gw, NGW; };
DI Frame mkframe(int wv) {
    extern __shared__ __attribute__((aligned(16))) unsigned char lds_raw[];
    Frame F; F.lds = (LAS unsigned char*)lds_raw; F.tid = opaque_tid(wv); F.lane = F.tid & 63; F.wave = wv;
    F.G = gridDim.x; F.gw = opaque_bid() * NWAVES + F.wave; F.NGW = F.G * NWAVES; return F;
}
typedef const __attribute__((address_space(4))) Args* ArgsP;
DI ArgsP kargs() { unsigned long long p = (unsigned long long)__builtin_amdgcn_kernarg_segment_ptr(); asm volatile("" : "+s"(p)); return (ArgsP)p; }
DI unsigned char* rst_base(ArgsP ap, int l) { return l == 0 ? (unsigned char*)ap->out : ap->ws + WS_WG + (size_t)(l - 1) * 4096 * 1024 * 2; }

struct TItem { const float* W; bf16_t* WT; const float* g; int K, Nsrc, k0, csrc, rdst, rs; };
DI void titem_load(const TItem& t, int lane, float (&v)[32]) {
#pragma unroll
    for (int i = 0; i < 32; ++i) v[i] = t.W[(size_t)(t.k0 + 2 * i + (lane >> 5)) * t.Nsrc + t.csrc + (lane & 31)];
}
DI void titem_store(LAS float* scr, int lane, const TItem& t, const float (&v)[32]) {
#pragma unroll
    for (int i = 0; i < 32; ++i) scr[(2 * i + (lane >> 5)) * 33 + (lane & 31)] = v[i];
    LDS_WAIT(); asm volatile("" ::: "memory");
    const int c = lane & 7;
    f32x4 g0 = {1.f, 1.f, 1.f, 1.f}, g1 = g0;
    if (t.g != nullptr) { g0 = *(const f32x4*)(t.g + t.k0 + 8 * c); g1 = *(const f32x4*)(t.g + t.k0 + 8 * c + 4); }
#pragma unroll
    for (int j = 0; j < 4; ++j) { const int n = (lane >> 3) + 8 * j; const LAS float* sp = scr + (8 * c) * 33 + n;
        u32x4 o; o.x = pk2(sp[0 * 33] * g0.x, sp[1 * 33] * g0.y); o.y = pk2(sp[2 * 33] * g0.z, sp[3 * 33] * g0.w); o.z = pk2(sp[4 * 33] * g1.x, sp[5 * 33] * g1.y); o.w = pk2(sp[6 * 33] * g1.z, sp[7 * 33] * g1.w);
        *(u32x4*)(t.WT + (size_t)(t.rdst + n * t.rs) * t.K + t.k0 + 8 * c) = o; }
    LDS_WAIT(); asm volatile("" ::: "memory");
}
DI void memn_rows(const Frame& F, ArgsP ap, int l) {
    unsigned char* ws = ap->ws;
    for (int m = F.gw; m < BATCH * MEMLEN; m += F.NGW) {
        const f32x4* xr = (const f32x4*)(ap->mem + (size_t)m * D) + F.lane; const f32x4* gr = (const f32x4*)(ap->mem_norm_g + (size_t)l * D) + F.lane;
        f32x4 v[4]; float sq = 0.f;
#pragma unroll
        for (int j = 0; j < 4; ++j) { v[j] = xr[64 * j]; sq += (v[j].x * v[j].x + v[j].y * v[j].y) + (v[j].z * v[j].z + v[j].w * v[j].w); }
        const float rs = rsqrtf(wave_sum(sq, F.lane) * (1.f / D) + EPS);
        unsigned long long* o8 = (unsigned long long*)((bf16_t*)(ws + WS_MEMN) + (size_t)m * D) + F.lane;
#pragma unroll
        for (int j = 0; j < 4; ++j) { const f32x4 g = gr[64 * j];
            o8[64 * j] = (unsigned long long)pk2(v[j].x * rs * g.x, v[j].y * rs * g.y) | ((unsigned long long)pk2(v[j].z * rs * g.z, v[j].w * rs * g.w) << 32); }
    }
}
struct TSeg { int src, K, Nsrc, c0, ncols, dst, r0; };
DI void convert_weights(const Frame& F, ArgsP ap, int l, int first, int stride, int part) {
    unsigned char* ws = ap->ws;
    LAS float* scr = (LAS float*)(F.lds + F.wave * 16384);
    constexpr int NSEG = 14;
    const TSeg seg[NSEG] = {
        {0, 1024, IN_COLS, 2048, 2048, 0, 0}, {0, 1024, IN_COLS, 5640, 256, 0, 2304}, {0, 1024, IN_COLS, 4104, 256, 0, 2560}, {0, 1024, IN_COLS, 4360, 256, 0, 2816},
        {0, 1024, IN_COLS, 0, 1024, 1, 0}, {0, 1024, IN_COLS, 1536, 512, 1, 1024}, {0, 1024, IN_COLS, 5128, 512, 1, 1536}, {0, 1024, IN_COLS, 1024, 512, 1, 2048}, {0, 1024, IN_COLS, 4616, 512, 1, 2560},
        {0, 1024, IN_COLS, 5896, 4096, 2, 0},
        {1, 512, 1024, 0, 1024, 3, 0}, {2, 512, 1024, 0, 1024, 3, 1024}, {3, 512, 1024, 0, 1024, 3, 2048}, {5, 1024, 1024, 0, 1024, 4, 0} };
    int cum[NSEG + 1]; cum[0] = 0;
#pragma unroll
    for (int q = 0; q < NSEG; ++q) cum[q + 1] = cum[q] + (seg[q].K / 64) * (seg[q].ncols / 32);
    const int per_layer = cum[NSEG] + (256 / 64) * (1024 / 32) + (1024 / 64) * (512 / 32);
    const int c9 = cum[9], c14m = cum[NSEG] + 128;
    const int n1 = c9 + (per_layer - c14m), n2 = c14m - c9, nit = part == 0 ? per_layer : (part == 1 ? n1 : n2);
    auto params = [&](int it, TItem& t) -> bool {
        if (it >= nit) return false;
        int r = part == 0 ? it : (part == 1 ? (it < c9 ? it : it - c9 + c14m) : it + c9);
        const float* W; int K, Nsrc, c0, ncols, r0; bf16_t* WT; bool perm = false;
        if (r < cum[NSEG]) {
            int q = 0;
#pragma unroll
            for (int qq = 1; qq < NSEG; ++qq) if (r >= cum[qq]) q = qq;
            int src = 0, dst = 0; K = 1024; Nsrc = IN_COLS; c0 = 0; ncols = 32; r0 = 0; int base = 0;
#pragma unroll
            for (int qq = 0; qq < NSEG; ++qq) if (q == qq) { src = seg[qq].src; K = seg[qq].K; Nsrc = seg[qq].Nsrc; c0 = seg[qq].c0; ncols = seg[qq].ncols; dst = seg[qq].dst; r0 = seg[qq].r0; base = cum[qq]; }
            r -= base; perm = (q == 2 || q == 3);
            W = src == 0 ? ap->w_in + (size_t)l * D * IN_COLS : src == 1 ? ap->w_br_sb + (size_t)l * 512 * 1024 : src == 2 ? ap->w_br_dn + (size_t)l * 512 * 1024 : src == 3 ? ap->w_br_ret + (size_t)l * 512 * 1024 : ap->w_out + (size_t)l * 1024 * 1024;
            WT = dst == 0 ? (bf16_t*)(ws + WS_WINA) + (size_t)l * 3072 * 1024 : dst == 1 ? (bf16_t*)(ws + WS_WINB) + (size_t)l * 3072 * 1024 : dst == 2 ? (bf16_t*)(ws + WS_WG) + (size_t)l * 4096 * 1024
               : dst == 3 ? (bf16_t*)(ws + WS_WBR) + (size_t)l * 2 * 1024 * 1024 : (bf16_t*)(ws + WS_WOUT) + (size_t)l * 1024 * 1024;
            if (dst == 3) { WT += (size_t)r0 * 512; r0 = 0; }
        } else if (r < cum[NSEG] + 128) { r -= cum[NSEG]; W = ap->w_br_mem + (size_t)l * 256 * 1024; K = 256; Nsrc = 1024; c0 = 0; ncols = 1024; r0 = 0; WT = (bf16_t*)(ws + WS_WBR) + (size_t)l * 2 * 1024 * 1024 + 3 * 1024 * 512; }
        else { r -= cum[NSEG] + 128; W = ap->w_mem_kv + (size_t)l * 1024 * 512; K = 1024; Nsrc = 512; c0 = 0; ncols = 512; r0 = 0; WT = (bf16_t*)(ws + WS_WKV) + (size_t)l * 512 * 1024; }
        const int nblk = ncols / 32, kb = r / nblk, nb = r % nblk;
        t.W = W; t.WT = WT; t.g = (W == ap->w_in + (size_t)l * D * IN_COLS) ? ap->norm_g + (size_t)l * D : nullptr; t.K = K; t.Nsrc = Nsrc; t.k0 = 64 * kb; t.csrc = c0 + 32 * nb; t.rdst = perm ? r0 + (nb >> 1) * 64 + (nb & 1) : r0 + 32 * nb; t.rs = perm ? 2 : 1;
        return true;
    };
    {
        TItem ta, tb; float va[32], vb[32];
        int it = first;
        bool ha = params(it, ta); if (ha) titem_load(ta, F.lane, va);
        while (ha) {
            it += stride; const bool hb = params(it, tb); if (hb) titem_load(tb, F.lane, vb);
            titem_store(scr, F.lane, ta, va);
            if (!hb) break;
            it += stride; ha = params(it, ta); if (ha) titem_load(ta, F.lane, va);
            titem_store(scr, F.lane, tb, vb);
        }
    }
    if (part != 2) {
        const float* win = ap->w_in + (size_t)l * D * IN_COLS; bf16_t* wa = (bf16_t*)(ws + WS_WINA) + (size_t)l * 3072 * 1024;
        for (int i = first * 64 + F.lane; i < 256 * 1024; i += stride * 64) { const int r = i >> 10, k = i & 1023;
            wa[(size_t)(2048 + r) * 1024 + k] = r < 8 ? (bf16_t)f2bf(win[(size_t)k * IN_COLS + 4096 + r] * ap->norm_g[(size_t)l * D + k]) : (bf16_t)0; }
    }
}
DI void p0_prologue(int wv) {
    const Frame F = mkframe(wv);
    const ArgsP ap = kargs();
    unsigned char* ws = ap->ws;
#ifdef PROBE_PRO
    unsigned long long tq0_ = __builtin_amdgcn_s_memrealtime();
#define PRO_ECHO(k) do { asm volatile("s_waitcnt vmcnt(0)" ::: "memory"); const unsigned long long t1_ = __builtin_amdgcn_s_memrealtime(); if (PROBE_PRO == (k)) { const unsigned long long d_ = t1_ - tq0_; while (__builtin_amdgcn_s_memrealtime() - t1_ < d_) __builtin_amdgcn_s_sleep(2); } tq0_ = __builtin_amdgcn_s_memrealtime(); } while (0)
#else
#define PRO_ECHO(k) do { } while (0)
#endif
    convert_weights(F, ap, 0, F.gw, F.NGW, 1);
    PRO_ECHO(1);
    constexpr int XNR = 4;
    for (int m = XNR * F.gw; m < T; m += XNR * F.NGW) {
        f32x4 v[XNR][4]; const f32x4* gr = (const f32x4*)ap->norm_g + F.lane;
#pragma unroll
        for (int q = 0; q < XNR; ++q)
#pragma unroll
            for (int j = 0; j < 4; ++j) v[q][j] = ((const f32x4*)(ap->x + (size_t)(m + q) * D) + F.lane)[64 * j];
#pragma unroll
        for (int q = 0; q < XNR; ++q) {
            unsigned long long* o8 = (unsigned long long*)((bf16_t*)(ws + WS_XN) + (size_t)(m + q) * D) + F.lane; float sq = 0.f;
#pragma unroll
            for (int j = 0; j < 4; ++j) { const f32x4 x = v[q][j], g = gr[64 * j]; sq += (x.x * x.x + x.y * x.y) + (x.z * x.z + x.w * x.w);
                (void)g; o8[64 * j] = (unsigned long long)pk2(x.x, x.y) | ((unsigned long long)pk2(x.z, x.w) << 32); }
            sq = wave_sum(sq, F.lane);
            if (F.lane == 0) *(f32x4*)((float*)(ws + WS_SS) + (size_t)(m + q) * 4) = (f32x4){sq, 0.f, 0.f, 0.f};
        }
    }
    PRO_ECHO(2);
    memn_rows(F, ap, 0);
    PRO_ECHO(3);
    for (int i = F.gw * 64 + F.lane; i < T * 32; i += F.NGW * 64) {
        const int t = i >> 5, f = i & 31;
        const float inv = exp2f(-(float)f * (13.287712379549449f / 32.0f));
        const float ang = (float)ap->positions[t] * inv;
#ifdef ROPE_FAST_SINCOS
        const float rev = ang * 0.15915494309189535f; const float fr = rev - floorf(rev);
        const float sn = __builtin_amdgcn_sinf(fr), cs = __builtin_amdgcn_cosf(fr);
#else
        float sn, cs; sincosf(ang, &sn, &cs);
#endif
        ((float*)(ws + WS_ROPE))[i] = cs; ((float*)(ws + WS_ROPE))[T * 32 + i] = sn;
    }
}

struct SchedP1 {
    gm::TileOrder ord; unsigned char* ws; int l, half, c; bool with_kvm;
    DI void a_ready(const gm::Unit&, int, int) const {}
    DI bool next(int i, gm::Unit& u) const {
        int pm, pn;
        if (ord.tile(i, pm, pn)) {
            const bf16_t* xn = (const bf16_t*)(ws + WS_XN) + (size_t)pm * 256 * 1024;
            const bf16_t* w = (const bf16_t*)(ws + (half == 0 ? WS_WINA : WS_WINB)) + ((size_t)l * 3072 + pn * 256) * 1024;
            u.lda = 1024; u.K = 1024; u.ldb = 1024; u.l = l; u.sub = half;
            if (half == 1 && pn >= 8) { u.A = w; u.B = xn; u.pm = pn - 8; u.pn = pm; u.kind = gm::K_STORE_T; u.sub = 0; }
            else { u.A = xn; u.B = w; u.pm = pm; u.pn = pn; u.kind = (half == 0 && pn == 8) ? gm::K_AB : gm::K_STORE; }
            return true;
        }
        const int kc = ord.c - (ord.nwg % ord.G);
        if (with_kvm && kc >= 0 && kc < 16 && i == (ord.nwg + ord.G - 1 - ord.c) / ord.G) {
            const int ll = l, ty = (kc >> 3) & 1, idx = kc & 7;
            const bf16_t* mn = (const bf16_t*)(ws + WS_MEMN) + (size_t)(idx * 256) * 1024;
            const bf16_t* w = (const bf16_t*)(ws + WS_WKV) + ((size_t)ll * 512 + ty * 256) * 1024;
            u.lda = 1024; u.K = 1024; u.ldb = 1024; u.l = ll;
            if (ty == 0) { u.A = mn; u.B = w; u.pm = idx; u.pn = 0; u.kind = gm::K_STORE; u.sub = 2; }
            else { u.A = w; u.B = mn; u.pm = 0; u.pn = idx; u.kind = gm::K_STORE_T; u.sub = 1; }
            return true;
        }
        return false;
    }
};
struct SchedP3 {
    int pm, pn, l, rot; bool ok; unsigned char* ws;
    DI void a_ready(const gm::Unit& u, int wid, int lane) const {
        if (u.kind != gm::K_BRANCH || (u.sub & 4) == 0) return;
        if (wid == 0) {
            if (lane == 0) { unsigned* cnt = (unsigned*)(ws + WS_CTL) + CW_READY + 4096 * l + 64 * pm; unsigned sp = 0u;
                while (__hip_atomic_load(cnt, __ATOMIC_RELAXED, __HIP_MEMORY_SCOPE_AGENT) < 16u) { __builtin_amdgcn_s_sleep(2); if (++sp > (1u << 20)) break; } }
            __builtin_amdgcn_fence(__ATOMIC_ACQUIRE, "agent");
            asm volatile("s_waitcnt vmcnt(0)" ::: "memory");
        }
        asm volatile("" ::: "memory"); __builtin_amdgcn_s_barrier(); asm volatile("" ::: "memory");
    }
    DI bool next(int i, gm::Unit& u) const {
        if (!ok || i >= 8) return false;
        const int br = ((i >> 1) + rot) & 3;
        const bf16_t* R = (const bf16_t*)(ws + WS_R); const bf16_t* P = (const bf16_t*)(ws + WS_P);
        u.pm = pm; u.pn = pn; u.sub = br | ((i >> 1) == 0 ? 4 : 0); u.l = l;
        if ((i & 1) == 0) {
            u.A = (const bf16_t*)(ws + WS_XN) + (size_t)pm * 256 * 1024; u.lda = 1024; u.K = 1024; u.ldb = 1024;
            u.B = (const bf16_t*)(ws + WS_WG) + ((size_t)l * 4096 + br * 1024 + pn * 256) * 1024;
            u.kind = gm::K_GATE;
        } else {
            const bf16_t* wbr = (const bf16_t*)(ws + WS_WBR) + (size_t)l * 2 * 1024 * 1024 + (size_t)br * 1024 * 512;
            const int K = br == 3 ? 256 : 512;
            const int acol = br == 0 ? RB_SBQ : (br == 1 ? P_DNZ : (br == 2 ? RB_RTZ : P_MEMQ));
            const bool inP = (br & 1) != 0;
            u.lda = inP ? PLD : RBLD; u.A = (inP ? P : R) + (size_t)pm * 256 * u.lda + acol; u.K = K; u.ldb = K; u.B = wbr + (size_t)pn * 256 * K;
            u.kind = gm::K_BRANCH;
        }
        return true;
    }
};
struct SchedP4 {
    int pm, pn, l; bool ok; unsigned char* ws;
    DI void a_ready(const gm::Unit&, int, int) const {}
    DI bool next(int i, gm::Unit& u) const {
        if (!ok || i >= 1) return false;
        u.A = (const bf16_t*)(ws + WS_MRG) + (size_t)pm * 256 * MRGLD; u.lda = MRGLD; u.K = 1024; u.ldb = 1024;
        u.B = (const bf16_t*)(ws + WS_WOUT) + ((size_t)l * 1024 + pn * 256) * 1024;
        u.pm = pm; u.pn = pn; u.kind = gm::K_OUT; u.sub = 0; u.l = l;
        return true;
    }
};

typedef float f32x16 __attribute__((ext_vector_type(16)));
typedef short s16x4 __attribute__((ext_vector_type(4)));
#define MFMA32(a, b, c) __builtin_amdgcn_mfma_f32_32x32x16_bf16((a), (b), (c), 0, 0, 0)
DI int crow(int reg, int hh) { return (reg & 3) + 8 * (reg >> 2) + 4 * hh; }
DI bf16x8 pack8(float a0, float a1, float a2, float a3, float a4, float a5, float a6, float a7) {
    u32x4 p;
    asm volatile("s_nop 0\n\tv_cvt_pk_bf16_f32 %0, %4, %5\n\tv_cvt_pk_bf16_f32 %1, %6, %7\n\tv_cvt_pk_bf16_f32 %2, %8, %9\n\tv_cvt_pk_bf16_f32 %3, %10, %11\n\ts_nop 1"
                 : "=&v"(p[0]), "=&v"(p[1]), "=&v"(p[2]), "=&v"(p[3]) : "v"(a0), "v"(a1), "v"(a2), "v"(a3), "v"(a4), "v"(a5), "v"(a6), "v"(a7));
    return __builtin_bit_cast(bf16x8, p);
}
DI bf16x8 pack8m(float a0, float a1, float a2, float a3, float a4, float a5, float a6, float a7) {
    u32x4 p;
    asm volatile("s_nop 15\n\ts_nop 3\n\tv_cvt_pk_bf16_f32 %0, %4, %5\n\tv_cvt_pk_bf16_f32 %1, %6, %7\n\tv_cvt_pk_bf16_f32 %2, %8, %9\n\tv_cvt_pk_bf16_f32 %3, %10, %11\n\ts_nop 1"
                 : "=&v"(p[0]), "=&v"(p[1]), "=&v"(p[2]), "=&v"(p[3]) : "v"(a0), "v"(a1), "v"(a2), "v"(a3), "v"(a4), "v"(a5), "v"(a6), "v"(a7));
    return __builtin_bit_cast(bf16x8, p);
}
namespace at {
constexpr int KST = 144, VST = 136;
constexpr int KT_BYTES = 64 * KST;
DI bf16x8 kfrag(LAS unsigned char* kt, int row, int ks, int hh) { return *(const LAS bf16x8*)(kt + row * KST + ks * 32 + hh * 16); }
DI bf16x8 vfrag(LAS unsigned char* vt, int row, int keyoff, int hh) {
    const LAS unsigned char* pp = vt + row * VST + (keyoff + 4 * hh) * 2;
    const u32x2 lo = *(const LAS u32x2*)pp, hi = *(const LAS u32x2*)(pp + 16);
    u32x4 r; r.x = lo.x; r.y = lo.y; r.z = hi.x; r.w = hi.y; return __builtin_bit_cast(bf16x8, r);
}
}

DI void mem_unit(int wv, int l, int unit) {
    const Frame F = mkframe(wv);
    unsigned char* ws = kargs()->ws; bf16_t* P = (bf16_t*)(ws + WS_P);
    const bf16_t* KM = (const bf16_t*)(ws + WS_KVM) + (size_t)l * 1024 * 1024; const bf16_t* VTM = KM + 2048 * 256;
    const int b = unit >> 5, h = (unit >> 3) & 3, qt = unit & 7, lane = F.lane, r = lane & 31, hh = lane >> 5;
    LAS unsigned char* kt = F.lds; LAS unsigned char* vt = F.lds + 256 * at::KST;
    constexpr int VS = 520;
#pragma unroll
    for (int i = 0; i < 4; ++i) { const int id = F.tid + 512 * i, row = id >> 3, ch = id & 7;
        const u32x4 v = *(const u32x4*)(KM + (size_t)(b * 256 + row) * 256 + h * 64 + ch * 8);
        *(LAS u32x4*)(kt + row * at::KST + ch * 16) = v; }
#pragma unroll
    for (int i = 0; i < 4; ++i) { const int id = F.tid + 512 * i, row = id >> 5, ch = id & 31;
        const u32x4 v = *(const u32x4*)(VTM + (size_t)(h * 64 + row) * 2048 + b * 256 + ch * 8);
        *(LAS u32x2*)(vt + row * VS + ch * 16) = (u32x2){v.x, v.y}; *(LAS u32x2*)(vt + row * VS + ch * 16 + 8) = (u32x2){v.z, v.w}; }
    const int t = b * SEQ + qt * 256 + wv * 32 + r;
    bf16_t* qp = P + (size_t)t * PLD + P_MEMQ + h * 64;
    bf16x8 qf[4];
#pragma unroll
    for (int ks = 0; ks < 4; ++ks) qf[ks] = *(const bf16x8*)(qp + 16 * ks + 8 * hh);
    __syncthreads();
    f32x16 z[8];
#pragma unroll
    for (int st = 0; st < 8; ++st) {
        f32x16 a = {0.f, 0.f, 0.f, 0.f, 0.f, 0.f, 0.f, 0.f, 0.f, 0.f, 0.f, 0.f, 0.f, 0.f, 0.f, 0.f};
#pragma unroll
        for (int ks = 0; ks < 4; ++ks) a = MFMA32(at::kfrag(kt, 32 * st + r, ks, hh), qf[ks], a);
        z[st] = a;
    }
    float mx = -3.0e38f;
#pragma unroll
    for (int st = 0; st < 8; ++st)
#pragma unroll
        for (int i = 0; i < 16; ++i) mx = fmaxf(mx, z[st][i]);
    mx = fmaxf(mx, shx(mx, 32, lane));
    const float c2 = 0.125f * 1.4426950408889634f; float sum = 0.f;
#pragma unroll
    for (int st = 0; st < 8; ++st)
#pragma unroll
        for (int i = 0; i < 16; ++i) { const float e = exp2f((z[st][i] - mx) * c2); z[st][i] = e; sum += e; }
    sum += shx(sum, 32, lane);
    f32x16 o0 = {0.f, 0.f, 0.f, 0.f, 0.f, 0.f, 0.f, 0.f, 0.f, 0.f, 0.f, 0.f, 0.f, 0.f, 0.f, 0.f}, o1 = o0;
#pragma unroll
    for (int st = 0; st < 8; ++st)
#pragma unroll
        for (int s2 = 0; s2 < 2; ++s2) {
            const bf16x8 pf = pack8(z[st][8 * s2], z[st][8 * s2 + 1], z[st][8 * s2 + 2], z[st][8 * s2 + 3], z[st][8 * s2 + 4], z[st][8 * s2 + 5], z[st][8 * s2 + 6], z[st][8 * s2 + 7]);
            const int keyoff = 32 * st + 16 * s2;
            { const LAS unsigned char* pp = vt + r * VS + (keyoff + 4 * hh) * 2; const u32x2 lo = *(const LAS u32x2*)pp, hi = *(const LAS u32x2*)(pp + 16);
              u32x4 q; q.x = lo.x; q.y = lo.y; q.z = hi.x; q.w = hi.y; o0 = MFMA32(__builtin_bit_cast(bf16x8, q), pf, o0); }
            { const LAS unsigned char* pp = vt + (32 + r) * VS + (keyoff + 4 * hh) * 2; const u32x2 lo = *(const LAS u32x2*)pp, hi = *(const LAS u32x2*)(pp + 16);
              u32x4 q; q.x = lo.x; q.y = lo.y; q.z = hi.x; q.w = hi.y; o1 = MFMA32(__builtin_bit_cast(bf16x8, q), pf, o1); }
        }
    const float inv = 1.f / sum;
    LAS unsigned char* ob = F.lds + 73728 + wv * (32 * at::KST);
#pragma unroll
    for (int g = 0; g < 4; ++g) {
        *(LAS u32x2*)(ob + r * at::KST + (8 * g + 4 * hh) * 2) = (u32x2){pk2(o0[4 * g] * inv, o0[4 * g + 1] * inv), pk2(o0[4 * g + 2] * inv, o0[4 * g + 3] * inv)};
        *(LAS u32x2*)(ob + r * at::KST + (32 + 8 * g + 4 * hh) * 2) = (u32x2){pk2(o1[4 * g] * inv, o1[4 * g + 1] * inv), pk2(o1[4 * g + 2] * inv, o1[4 * g + 3] * inv)};
    }
#pragma unroll
    for (int k = 0; k < 4; ++k) { const int q = k * 64 + lane, row = q >> 3, pc = q & 7;
        st16_wt(P + (size_t)(t - r + row) * PLD + P_MEMQ + h * 64 + pc * 8, *(const LAS u32x4*)(ob + row * at::KST + pc * 16)); }
    unit_done(ws, l, b * 8 + qt, F.tid);
}

DI void ret_rope_prep(int wv, int c, int n) {
    const Frame F = mkframe(wv);
    unsigned char* ws = kargs()->ws; bf16_t* P = (bf16_t*)(ws + WS_P);
    const float* rc = (const float*)(ws + WS_ROPE); const float* rsn = rc + T * 32;
    for (int it = c * NTHREADS + F.tid; it < T * 32; it += n * NTHREADS) {
        const int t = it >> 5, w = (it >> 4) & 1, h = (it >> 2) & 3, g = it & 3;
        bf16_t* pp = P + (size_t)t * PLD + (w ? P_RTK : P_RTQ) + h * 64 + g * 8;
        const u32x4 a = *(const u32x4*)pp, bq = *(const u32x4*)(pp + 32);
        const f32x4 c0 = *(const f32x4*)(rc + (size_t)t * 32 + g * 8), c1 = *(const f32x4*)(rc + (size_t)t * 32 + g * 8 + 4);
        const f32x4 s0 = *(const f32x4*)(rsn + (size_t)t * 32 + g * 8), s1 = *(const f32x4*)(rsn + (size_t)t * 32 + g * 8 + 4);
        const float sc = w ? 0.125f : 1.0f;
        float x1[8] = {bflo(a.x), bfhi(a.x), bflo(a.y), bfhi(a.y), bflo(a.z), bfhi(a.z), bflo(a.w), bfhi(a.w)};
        float x2[8] = {bflo(bq.x), bfhi(bq.x), bflo(bq.y), bfhi(bq.y), bflo(bq.z), bfhi(bq.z), bflo(bq.w), bfhi(bq.w)};
        float cc[8] = {c0.x, c0.y, c0.z, c0.w, c1.x, c1.y, c1.z, c1.w}, ss[8] = {s0.x, s0.y, s0.z, s0.w, s1.x, s1.y, s1.z, s1.w};
        float y1[8], y2[8];
#pragma unroll
        for (int j = 0; j < 8; ++j) { y1[j] = (x1[j] * cc[j] - x2[j] * ss[j]) * sc; y2[j] = (x1[j] * ss[j] + x2[j] * cc[j]) * sc; }
        *(u32x4*)pp = (u32x4){pk2(y1[0], y1[1]), pk2(y1[2], y1[3]), pk2(y1[4], y1[5]), pk2(y1[6], y1[7])};
        *(u32x4*)(pp + 32) = (u32x4){pk2(y2[0], y2[1]), pk2(y2[2], y2[3]), pk2(y2[4], y2[5]), pk2(y2[6], y2[7])};
    }
}

DI void ret_state_unit(int wv, int l, int unit) {
    const Frame F = mkframe(wv);
    unsigned char* ws = kargs()->ws; const bf16_t* P = (const bf16_t*)(ws + WS_P);
    const int bh = unit / 7, c = unit - 7 * bh, b = bh >> 2, h = bh & 3, lane = F.lane, r = lane & 31, hh = lane >> 5;
    const int s0 = b * SEQ + c * 256;
    const bf16_t* VTg = (const bf16_t*)(ws + WS_VTRT) + (size_t)h * 128 * VTLD + s0;
    const bf16_t* Kg = P + (size_t)s0 * PLD + P_RTK + h * 64;
    constexpr int RS = 528;
    LAS unsigned char* vt = F.lds; LAS unsigned char* kT = F.lds + 128 * RS;
    const float lg = log2f(1.0f - exp2f(-5.0f - (float)h));
    u32x4 vv[8], kv[4];
#pragma unroll
    for (int i = 0; i < 8; ++i) { const int id = F.tid + 512 * i, row = id >> 5, ch = id & 31; vv[i] = *(const u32x4*)(VTg + (size_t)row * VTLD + ch * 8); }
    const int key = F.tid >> 1, chb = (F.tid & 1) * 32;
#pragma unroll
    for (int i = 0; i < 4; ++i) kv[i] = *(const u32x4*)(Kg + (size_t)key * PLD + chb + 8 * i);
#pragma unroll
    for (int i = 0; i < 8; ++i) { const int id = F.tid + 512 * i, row = id >> 5, ch = id & 31; *(LAS u32x4*)(vt + row * RS + ch * 16) = vv[i]; }
    const float fk = exp2f(lg * (float)(255 - key));
#pragma unroll
    for (int i = 0; i < 4; ++i) {
        const unsigned w4[4] = {kv[i].x, kv[i].y, kv[i].z, kv[i].w};
#pragma unroll
        for (int j = 0; j < 4; ++j) { const unsigned u2 = pk2(bflo(w4[j]) * fk, bfhi(w4[j]) * fk);
            LAS unsigned char* wp = kT + (chb + 8 * i + 2 * j) * RS + key * 2;
            *(LAS unsigned short*)wp = (unsigned short)u2; *(LAS unsigned short*)(wp + RS) = (unsigned short)(u2 >> 16); }
    }
    __syncthreads();
    const int d = wv & 3, e = wv >> 2;
    f32x16 acc = {0.f, 0.f, 0.f, 0.f, 0.f, 0.f, 0.f, 0.f, 0.f, 0.f, 0.f, 0.f, 0.f, 0.f, 0.f, 0.f};
#pragma unroll
    for (int sk = 0; sk < 16; ++sk)
        acc = MFMA32(*(const LAS bf16x8*)(vt + (32 * d + r) * RS + (16 * sk + 8 * hh) * 2), *(const LAS bf16x8*)(kT + (32 * e + r) * RS + (16 * sk + 8 * hh) * 2), acc);
    unsigned* Lp = (unsigned*)rst_base(kargs(), l) + (size_t)unit * 8192 + 32 * e + r;
    __builtin_amdgcn_sched_barrier(0); asm volatile("s_nop 15\n\ts_nop 3" ::: "memory"); __builtin_amdgcn_sched_barrier(0);
#pragma unroll
    for (int i = 0; i < 16; ++i) { unsigned* sp_ = Lp + (size_t)(32 * d + crow(i, hh)) * 64; const float av_ = acc[i];
        asm volatile("global_store_dword %0, %1, off sc1" :: "v"(sp_), "v"(av_) : "memory"); }
    VM_WAIT(); lds_barrier();
    if (F.tid == 0) (void)__hip_atomic_fetch_add((unsigned*)(ws + WS_CTL) + CW_RST + 2048 * l + 64 * bh, 1u, __ATOMIC_RELAXED, __HIP_MEMORY_SCOPE_AGENT);
}

template <int MODE>
DI void attn_unit(int wv, int l, int unit) {
    constexpr int DV = MODE == 0 ? 64 : 128, NDT = DV / 32, VST2 = 144, VT_BYTES = DV * VST2, BUF = at::KT_BYTES + VT_BYTES;
    const Frame F = mkframe(wv);
    const ArgsP ap = kargs();
    unsigned char* ws = ap->ws; bf16_t* R = (bf16_t*)(ws + WS_R); bf16_t* P = (bf16_t*)(ws + WS_P);
    const int lane = F.lane, r = lane & 31, hh = lane >> 5, kap = 16 * ((r >> 2) & 1) + (r & 3) + 4 * (r >> 3);
    int b, h, qt;
    if (MODE == 0) { b = unit >> 6; h = (unit >> 3) & 7; qt = unit & 7; } else { qt = unit >> 5; b = (unit >> 2) & 7; h = unit & 3; }
    const int q0 = qt * 256, qw0 = q0 + 32 * wv, tq = qw0 + r, t = b * SEQ + tq;
    const bf16_t* Kg = MODE == 0 ? R + RB_SBK + h * 64 : P + P_RTK + h * 64; const int kld = MODE == 0 ? RBLD : PLD;
    const bf16_t* VTg = (const bf16_t*)(ws + (MODE == 0 ? WS_VTSB : WS_VTRT)) + (size_t)h * DV * VTLD + b * SEQ;
    const bf16_t* qp = MODE == 0 ? R + (size_t)t * RBLD + RB_SBQ + h * 64 : P + (size_t)t * PLD + P_RTQ + h * 64;
    bf16x8 qf[4];
#pragma unroll
    for (int ks = 0; ks < 4; ++ks) qf[ks] = *(const bf16x8*)(qp + 16 * ks + 8 * hh);
    f32x16 o[NDT];
#pragma unroll
    for (int d = 0; d < NDT; ++d) o[d] = (f32x16){0.f, 0.f, 0.f, 0.f, 0.f, 0.f, 0.f, 0.f, 0.f, 0.f, 0.f, 0.f, 0.f, 0.f, 0.f, 0.f};
    volatile LAS unsigned* flags = (volatile LAS unsigned*)(F.lds + 2 * BUF);
    const int jtop = (q0 + 255) >> 6;
    const int srow = F.tid >> 3, sch = F.tid & 7;
    u32x4 kreg, vreg[NDT / 2];
#define AT_LOAD(j) do { const int key0_ = (j) * 64; kreg = *(const u32x4*)(Kg + (size_t)(b * SEQ + key0_ + srow) * kld + sch * 8); \
        _Pragma("unroll") for (int i_ = 0; i_ < NDT / 2; ++i_) vreg[i_] = *(const u32x4*)(VTg + (size_t)(srow + 64 * i_) * VTLD + key0_ + sch * 8); } while (0)
#define AT_WRITE(pbuf) do { LAS unsigned char* kb_ = F.lds + (pbuf) * BUF; *(LAS u32x4*)(kb_ + srow * at::KST + sch * 16) = kreg; \
        _Pragma("unroll") for (int i_ = 0; i_ < NDT / 2; ++i_) *(LAS u32x4*)(kb_ + at::KT_BYTES + (srow + 64 * i_) * VST2 + sch * 16) = vreg[i_]; } while (0)
    AT_LOAD(jtop); AT_WRITE(0);
    lds_barrier();
    float carry = MODE == 0 ? 1.f : 0.f; bool done_w = false;
    const float c2 = 0.125f * 1.4426950408889634f;
    const float lg = MODE == 1 ? log2f(1.0f - exp2f(-5.0f - (float)h)) : 0.f;
    float bfac[16];
#pragma unroll
    for (int i = 0; i < 16; ++i) bfac[i] = MODE == 1 ? exp2f(-lg * (float)i) : 0.f;
    const int jlo = MODE == 1 ? (q0 >> 6) : 0;
    if (MODE == 1 && qt > 0) {
        unsigned* cnt = (unsigned*)(ws + WS_CTL) + CW_RST + 2048 * l + 64 * (b * 4 + h);
        if (wv == 0) {
            if (lane == 0) { unsigned sp = 0u; while (__hip_atomic_load(cnt, __ATOMIC_RELAXED, __HIP_MEMORY_SCOPE_AGENT) < 7u) { __builtin_amdgcn_s_sleep(2); if (++sp > (1u << 20)) break; } }
            __builtin_amdgcn_fence(__ATOMIC_ACQUIRE, "agent");
            asm volatile("s_waitcnt vmcnt(0)" ::: "memory");
        }
        lds_barrier();
        const float* L0 = (const float*)rst_base(ap, l) + (size_t)((b * 4 + h) * 7) * 8192;
        const float g256 = exp2f(lg * 256.0f);
        LAS unsigned char* stI = F.lds + 65536;
#pragma unroll
        for (int k4 = 0; k4 < 4; ++k4) {
            const int e4 = (F.tid + 512 * k4) * 4;
            f32x4 a = {0.f, 0.f, 0.f, 0.f}; float wg = 1.0f;
            for (int c = qt - 1; c >= 0; --c) { const f32x4 x = *(const f32x4*)(L0 + (size_t)c * 8192 + e4);
                a += x * wg; wg *= g256; }
            *(LAS u32x2*)(stI + (e4 >> 6) * 144 + (e4 & 63) * 2) = (u32x2){pk2(a[0], a[1]), pk2(a[2], a[3])};
        }
        lds_barrier();
#pragma unroll
        for (int d = 0; d < NDT; ++d)
#pragma unroll
            for (int ks = 0; ks < 4; ++ks) o[d] = MFMA32(*(const LAS bf16x8*)(stI + (32 * d + r) * 144 + (16 * ks + 8 * hh) * 2), qf[ks], o[d]);
        const float fq = exp2f(lg * (float)(tq - q0 + 1));
#pragma unroll
        for (int d = 0; d < NDT; ++d) o[d] = o[d] * fq;
    }
    for (int j = jtop, it = 0; ; --j, ++it) {
        const int pbuf = it & 1;
        if (j > jlo) AT_LOAD(j - 1);
        LAS unsigned char* kt = F.lds + pbuf * BUF; LAS unsigned char* vt = kt + at::KT_BYTES;
        const int key0 = j * 64;
        if (!done_w) {
#pragma unroll
            for (int sti = 0; sti < 2; ++sti) {
                const int st = 1 - sti, ks0 = key0 + 32 * st;
                if (ks0 <= qw0 + 31 - (MODE == 0 ? 1 : 0)) {
                    const bool full = (ks0 + 31 < qw0);
                    f32x16 z = {0.f, 0.f, 0.f, 0.f, 0.f, 0.f, 0.f, 0.f, 0.f, 0.f, 0.f, 0.f, 0.f, 0.f, 0.f, 0.f};
#pragma unroll
                    for (int ks = 0; ks < 4; ++ks) z = MFMA32(at::kfrag(kt, 32 * st + kap, ks, hh), qf[ks], z);
                    float w[16];
                    const int kb = ks0 + 16 * hh;
                    if (MODE == 0) {
                        float sg[16], sn[16];
#pragma unroll
                        for (int i = 0; i < 16; i += 2) {
                            const f32x2 a2 = (f32x2){z[i], z[i + 1]} * (f32x2){-c2, -c2};
                            const f32x2 d2 = (f32x2){__builtin_amdgcn_exp2f(a2.x), __builtin_amdgcn_exp2f(a2.y)} + (f32x2){1.f, 1.f};
                            const f32x2 r2 = (f32x2){__builtin_amdgcn_rcpf(d2.x), __builtin_amdgcn_rcpf(d2.y)};
                            const f32x2 n2 = (f32x2){1.f, 1.f} - r2;
                            sg[i] = r2.x; sg[i + 1] = r2.y; sn[i] = n2.x; sn[i + 1] = n2.y;
                        }
                        if (!full) {
#pragma unroll
                            for (int i = 0; i < 16; ++i) { const bool m = (kb + i) < tq; sn[i] = m ? sn[i] : 1.f; sg[i] = m ? sg[i] : 0.f; }
                        }
                        float suf[16];
                        suf[15] = 1.f;
#pragma unroll
                        for (int i = 14; i >= 0; --i) suf[i] = suf[i + 1] * sn[i + 1];
                        const float tot = suf[0] * sn[0], totp = shx(tot, 32, lane);
                        const float base = carry * (hh == 0 ? totp : 1.f);
                        carry *= tot * totp;
#pragma unroll
                        for (int i = 0; i < 16; i += 2) { const f32x2 w2 = (f32x2){sg[i], sg[i + 1]} * ((f32x2){suf[i], suf[i + 1]} * (f32x2){base, base}); w[i] = w2.x; w[i + 1] = w2.y; }
                    } else {
                        const float af = __builtin_amdgcn_exp2f(lg * (float)(tq - kb));
                        if (full) {
#pragma unroll
                            for (int i = 0; i < 16; ++i) w[i] = z[i] * (af * bfac[i]);
                        } else {
#pragma unroll
                            for (int i = 0; i < 16; ++i) w[i] = (kb + i <= tq) ? z[i] * (af * bfac[i]) : 0.f;
                        }
                    }
#pragma unroll
                    for (int s2 = 0; s2 < 2; ++s2) {
                        const bf16x8 pf = pack8(w[8 * s2], w[8 * s2 + 1], w[8 * s2 + 2], w[8 * s2 + 3], w[8 * s2 + 4], w[8 * s2 + 5], w[8 * s2 + 6], w[8 * s2 + 7]);
#pragma unroll
                        for (int d = 0; d < NDT; ++d) o[d] = MFMA32(*(const LAS bf16x8*)(vt + (32 * d + r) * VST2 + (32 * st + 16 * hh + 8 * s2) * 2), pf, o[d]);
                    }
                }
            }
            if (MODE == 0) done_w = __all(carry < 1.1754944e-38f);
        }
        if (j > jlo) AT_WRITE(pbuf ^ 1);
        if (MODE == 0 && F.lane == 0) flags[(it & 1) * 8 + wv] = done_w ? 1u : 0u;
        lds_barrier();
        if (j == jlo) break;
        if (MODE == 0) { unsigned all = 1u;
#pragma unroll
            for (int w8 = 0; w8 < 8; ++w8) all &= flags[(it & 1) * 8 + w8];
            if (all) break; }
    }
#undef AT_LOAD
#undef AT_WRITE
    constexpr int OST = DV * 2 + 16, PPR = DV / 8;
    LAS unsigned char* ob = F.lds + wv * (32 * OST);
    if (MODE == 0) {
        bf16_t* op = R + (size_t)t * RBLD + RB_SBQ + h * 64; const bf16_t* zp = R + (size_t)t * RBLD + RB_SBZ + h * 64;
#pragma unroll
        for (int d = 0; d < NDT; ++d)
#pragma unroll
            for (int g = 0; g < 4; ++g) { const int c = 32 * d + 8 * g + 4 * hh; const u32x2 zz = *(const u32x2*)(zp + c);
                *(LAS u32x2*)(ob + r * OST + c * 2) = (u32x2){pk2(o[d][4 * g] * siluf_(bflo(zz.x)), o[d][4 * g + 1] * siluf_(bfhi(zz.x))), pk2(o[d][4 * g + 2] * siluf_(bflo(zz.y)), o[d][4 * g + 3] * siluf_(bfhi(zz.y)))}; }
#pragma unroll
        for (int k = 0; k < 32 * PPR / 64; ++k) { const int q = k * 64 + lane, row = q / PPR, pc = q % PPR;
            st16_wt(op + (ptrdiff_t)(row - r) * RBLD + pc * 8, *(const LAS u32x4*)(ob + row * OST + pc * 16)); }
    } else {
        float s1 = 0.f;
#pragma unroll
        for (int d = 0; d < NDT; ++d)
#pragma unroll
            for (int i = 0; i < 16; ++i) s1 += o[d][i];
        s1 += shx(s1, 32, lane);
        const float mu = s1 * (1.f / 128.f); float s2 = 0.f;
#pragma unroll
        for (int d = 0; d < NDT; ++d)
#pragma unroll
            for (int i = 0; i < 16; ++i) { const float dl = o[d][i] - mu; s2 += dl * dl; }
        s2 += shx(s2, 32, lane);
        const float rs = rsqrtf(s2 * (1.f / 128.f) + EPS);
        bf16_t* zp = R + (size_t)t * RBLD + RB_RTZ + h * 128; const float* gp = ap->ret_norm_g + (size_t)l * 512 + h * 128;
#pragma unroll
        for (int d = 0; d < NDT; ++d)
#pragma unroll
            for (int g = 0; g < 4; ++g) { const int c = 32 * d + 8 * g + 4 * hh; const u32x2 zz = *(const u32x2*)(zp + c); const f32x4 gg = *(const f32x4*)(gp + c);
                *(LAS u32x2*)(ob + r * OST + c * 2) = (u32x2){pk2((o[d][4 * g] - mu) * rs * gg.x * siluf_(bflo(zz.x)), (o[d][4 * g + 1] - mu) * rs * gg.y * siluf_(bfhi(zz.x))),
                                                             pk2((o[d][4 * g + 2] - mu) * rs * gg.z * siluf_(bflo(zz.y)), (o[d][4 * g + 3] - mu) * rs * gg.w * siluf_(bfhi(zz.y)))}; }
#pragma unroll
        for (int k = 0; k < 32 * PPR / 64; ++k) { const int q = k * 64 + lane, row = q / PPR, pc = q % PPR;
            st16_wt(zp + (ptrdiff_t)(row - r) * RBLD + pc * 8, *(const LAS u32x4*)(ob + row * OST + pc * 16)); }
    }
    unit_done(ws, l, b * 8 + qt, F.tid);
}

namespace dn {
constexpr int HC_BYTES = 73728, OFF_W = 0, OFF_QG = 16384, OFF_KD = 32768, OFF_AI = 49152, OFF_U = 57344;
constexpr int QST = 272, TST = 144;
constexpr int GRP_BYTES = 71680, Q_OFF = 0, K_OFF = 17408, KT_OFF = 34816, VT_OFF = 53248, VEC_OFF = 143360, VEC_BYTES = 2048;
}

DI void dn_prep(int wv, int l, int pair) {
    const Frame F = mkframe(wv);
    const ArgsP ap = kargs();
    unsigned char* ws = ap->ws;
    const int lane = F.lane, r = lane & 31, hh = lane >> 5, grp = wv >> 2, gw = wv & 3, gt = F.tid & 255;
    const int hc = pair * 2 + grp, h = hc & 3, bn = hc >> 2, b = bn >> 5, n = bn & 31, t0 = b * SEQ + n * 64;
    LAS unsigned char* gb = F.lds + grp * dn::GRP_BYTES;
    LAS unsigned char* qimg = gb + dn::Q_OFF; LAS unsigned char* kimg = gb + dn::K_OFF; LAS unsigned char* ktimg = gb + dn::KT_OFF; LAS unsigned char* vtimg = gb + dn::VT_OFF;
    LAS float* vec = (LAS float*)(F.lds + dn::VEC_OFF + grp * dn::VEC_BYTES);
    LAS float* gcv = vec; LAS float* btv = vec + 64; LAS float* f1v = vec + 128; LAS float* f2v = vec + 192; LAS float* egv = vec + 256;
    unsigned char* blk = ws + WS_DNI + (size_t)hc * dn::HC_BYTES;
    const bf16_t* RA = (const bf16_t*)(ws + WS_R); const float* cw = ap->dn_conv_w + (size_t)l * 4 * 1536; const float* AB = (const float*)(ws + WS_AB);
#ifdef PROBE_PREP
    unsigned long long tp0_ = __builtin_amdgcn_s_memrealtime();
#endif
    {
        const int g8 = gt & 15, ch = g8 * 8;
        float abA[4], abB[4];
#pragma unroll
        for (int k = 0; k < 4; ++k) { const int t = t0 + (gt >> 4) + 16 * k; abA[k] = AB[(size_t)t * 8 + h]; abB[k] = AB[(size_t)t * 8 + 4 + h]; }
        const float dtb = ap->dn_dt_bias[l * 4 + h], nalog = -__expf(ap->dn_a_log[l * 4 + h]);
        u32x4 xs[2][2][4]; f32x4 wj[4][2];
#define DNP_LOADX(st_, set_) do { const int col_ = ((st_) >> 1) * 512 + h * 128 + ch; \
        _Pragma("unroll") for (int kk_ = 0; kk_ < 2; ++kk_) _Pragma("unroll") for (int j_ = 0; j_ < 4; ++j_) { const int m_ = (gt >> 4) + 16 * (2 * ((st_) & 1) + kk_); \
            xs[set_][kk_][j_] = (n * 64 + m_ - 3 + j_ >= 0) ? *(const u32x4*)(RA + (size_t)(t0 + m_ - 3 + j_) * RALD + col_) : (u32x4){0u, 0u, 0u, 0u}; } } while (0)
        DNP_LOADX(0, 0);
#pragma unroll
        for (int st = 0; st < 6; ++st) {
            const int part = st >> 1, col = part * 512 + h * 128 + ch;
            if ((st & 1) == 0) {
#pragma unroll
                for (int j = 0; j < 4; ++j) { wj[j][0] = *(const f32x4*)(cw + j * 1536 + col); wj[j][1] = *(const f32x4*)(cw + j * 1536 + col + 4); } }
            if (st < 5) DNP_LOADX(st + 1, (st + 1) & 1);
#pragma unroll
            for (int kk = 0; kk < 2; ++kk) {
                const int m = (gt >> 4) + 16 * (2 * (st & 1) + kk), t = t0 + m;
                float a[8] = {0.f, 0.f, 0.f, 0.f, 0.f, 0.f, 0.f, 0.f};
#pragma unroll
                for (int j = 0; j < 4; ++j) { const u32x4 x = xs[st & 1][kk][j];
                    a[0] += wj[j][0].x * bflo(x.x); a[1] += wj[j][0].y * bfhi(x.x); a[2] += wj[j][0].z * bflo(x.y); a[3] += wj[j][0].w * bfhi(x.y);
                    a[4] += wj[j][1].x * bflo(x.z); a[5] += wj[j][1].y * bfhi(x.z); a[6] += wj[j][1].z * bflo(x.w); a[7] += wj[j][1].w * bfhi(x.w);
                }
                float ssq = 0.f;
#pragma unroll
                for (int i = 0; i < 8; ++i) { a[i] = siluf_(a[i]); ssq += a[i] * a[i]; }
                if (part < 2) {
                    ssq = sum16(ssq);
                    const float rn = rsqrtf(ssq + EPS);
#pragma unroll
                    for (int i = 0; i < 8; ++i) a[i] *= rn;
                } else {
                    const float beta = sigmoidf_(abB[2 * (st & 1) + kk]);
#pragma unroll
                    for (int i = 0; i < 8; ++i) a[i] *= beta;
                }
                const u32x4 pk = (u32x4){pk2(a[0], a[1]), pk2(a[2], a[3]), pk2(a[4], a[5]), pk2(a[6], a[7])};
                if (part == 0) {
                    *(LAS u32x4*)(qimg + m * dn::QST + ch * 2) = pk;
                    if (g8 == 0) { const float xa = abA[2 * (st & 1) + kk] + dtb; const float sp = xa > 20.f ? xa : log1pf(__expf(xa));
                        gcv[m] = nalog * sp; btv[m] = sigmoidf_(abB[2 * (st & 1) + kk]); }
                } else {
                    if (part == 1) *(LAS u32x4*)(kimg + m * dn::QST + ch * 2) = pk;
                    LAS unsigned char* timg = (part == 1 ? ktimg : vtimg) + (((m >> 3) ^ (g8 & 7)) * 16) + (m & 7) * 2;
                    *(LAS unsigned short*)(timg + (ch + 0) * dn::TST) = (unsigned short)pk.x; *(LAS unsigned short*)(timg + (ch + 1) * dn::TST) = (unsigned short)(pk.x >> 16);
                    *(LAS unsigned short*)(timg + (ch + 2) * dn::TST) = (unsigned short)pk.y; *(LAS unsigned short*)(timg + (ch + 3) * dn::TST) = (unsigned short)(pk.y >> 16);
                    *(LAS unsigned short*)(timg + (ch + 4) * dn::TST) = (unsigned short)pk.z; *(LAS unsigned short*)(timg + (ch + 5) * dn::TST) = (unsigned short)(pk.z >> 16);
                    *(LAS unsigned short*)(timg + (ch + 6) * dn::TST) = (unsigned short)pk.w; *(LAS unsigned short*)(timg + (ch + 7) * dn::TST) = (unsigned short)(pk.w >> 16);
                }
            }
        }
#undef DNP_LOADX
    }
    lds_barrier();
#ifdef PROBE_PREP
    if (PROBE_PREP == 1) { const unsigned long long t1_ = __builtin_amdgcn_s_memrealtime(); const unsigned long long d_ = t1_ - tp0_; while (__builtin_amdgcn_s_memrealtime() - t1_ < d_) __builtin_amdgcn_s_sleep(2); }
    tp0_ = __builtin_amdgcn_s_memrealtime();
#endif
    if (gw == 0) {
        float gc = gcv[lane];
#pragma unroll
        for (int off = 1; off < 64; off <<= 1) { const float o = shx(gc, 0, lane - off < 0 ? lane : lane - off) ; gc += (lane >= off) ? o : 0.f; }
        const float glast = shx(gc, 0, 63);
        const float eg = __expf(gc);
        gcv[lane] = gc; f1v[lane] = btv[lane] * eg; f2v[lane] = __expf(glast - gc); egv[lane] = eg * 0.08838834764831845f;
        if (lane == 0) ((float*)(ws + WS_GB))[hc] = __expf(glast);
    }
    lds_barrier();
    f32x16 Lt = {0.f, 0.f, 0.f, 0.f, 0.f, 0.f, 0.f, 0.f, 0.f, 0.f, 0.f, 0.f, 0.f, 0.f, 0.f, 0.f};
    if (gw < 3) {
        {
            const int ct = gw == 0 ? 0 : 1, mt = gw == 2 ? 1 : 0;
            f32x16 acc = {0.f, 0.f, 0.f, 0.f, 0.f, 0.f, 0.f, 0.f, 0.f, 0.f, 0.f, 0.f, 0.f, 0.f, 0.f, 0.f};
#pragma unroll
            for (int ks = 0; ks < 8; ++ks) acc = MFMA32(*(const LAS bf16x8*)(kimg + (32 * ct + r) * dn::QST + ks * 32 + hh * 16), *(const LAS bf16x8*)(kimg + (32 * mt + r) * dn::QST + ks * 32 + hh * 16), acc);
            const int m = 32 * mt + r; const float gm = gcv[m];
#pragma unroll
            for (int i = 0; i < 16; ++i) { const int c = 32 * ct + crow(i, hh); Lt[i] = (m < c) ? acc[i] * btv[c] * __expf(gcv[c] - gm) : 0.f; }
        }
        {
            const int mt = gw == 2 ? 1 : 0, ct = gw == 0 ? 0 : 1;
            f32x16 acc = {0.f, 0.f, 0.f, 0.f, 0.f, 0.f, 0.f, 0.f, 0.f, 0.f, 0.f, 0.f, 0.f, 0.f, 0.f, 0.f};
#pragma unroll
            for (int ks = 0; ks < 8; ++ks) acc = MFMA32(*(const LAS bf16x8*)(kimg + (32 * mt + r) * dn::QST + ks * 32 + hh * 16), *(const LAS bf16x8*)(qimg + (32 * ct + r) * dn::QST + ks * 32 + hh * 16), acc);
            const int c = 32 * ct + r; const float gcc = gcv[c]; float v[16];
#pragma unroll
            for (int i = 0; i < 16; ++i) { const int m = 32 * mt + crow(i, hh); v[i] = (m <= c) ? acc[i] * __expf(gcc - gcv[m]) * 0.08838834764831845f : 0.f; }
#pragma unroll
            for (int s2 = 0; s2 < 2; ++s2) *(bf16x8*)(blk + dn::OFF_AI + ((ct * 2 + mt) * 2 + s2) * 1024 + lane * 16) = pack8(v[8 * s2], v[8 * s2 + 1], v[8 * s2 + 2], v[8 * s2 + 3], v[8 * s2 + 4], v[8 * s2 + 5], v[8 * s2 + 6], v[8 * s2 + 7]);
        }
    } else {
#pragma unroll 1
        for (int f = 0; f < 16; ++f) { const int ct = f >> 3, tau = (f >> 1) & 3, s2 = f & 1, c = 32 * ct + r; const float e = egv[c];
            const LAS unsigned char* pp = qimg + c * dn::QST + (32 * tau + 16 * s2 + 4 * hh) * 2; const u32x2 lo = *(const LAS u32x2*)pp, hi = *(const LAS u32x2*)(pp + 16);
            *(bf16x8*)(blk + dn::OFF_QG + f * 1024 + lane * 16) = pack8(bflo(lo.x) * e, bfhi(lo.x) * e, bflo(lo.y) * e, bfhi(lo.y) * e, bflo(hi.x) * e, bfhi(hi.x) * e, bflo(hi.y) * e, bfhi(hi.y) * e); }
#pragma unroll 1
        for (int f = 0; f < 16; ++f) { const int tau = f >> 2, m0 = 32 * ((f >> 1) & 1) + 16 * (f & 1) + 4 * hh;
            const int sw = (4 * tau + (r >> 3)) & 7; const LAS unsigned char* rowp = ktimg + (32 * tau + r) * dn::TST + (m0 & 7) * 2;
            const u32x2 lo = *(const LAS u32x2*)(rowp + (((m0 >> 3) ^ sw) * 16)), hi = *(const LAS u32x2*)(rowp + ((((m0 >> 3) + 1) ^ sw) * 16));
            const f32x4 fa = *(const LAS f32x4*)(f2v + m0), fb = *(const LAS f32x4*)(f2v + m0 + 8);
            *(bf16x8*)(blk + dn::OFF_KD + f * 1024 + lane * 16) = pack8(bflo(lo.x) * fa.x, bfhi(lo.x) * fa.y, bflo(lo.y) * fa.z, bfhi(lo.y) * fa.w, bflo(hi.x) * fb.x, bfhi(hi.x) * fb.y, bflo(hi.y) * fb.z, bfhi(hi.y) * fb.w); }
    }
    lds_barrier();
    LAS float* Lm = (LAS float*)qimg;
    if (gw < 3) { const int ct = gw == 0 ? 0 : 1, mt = gw == 2 ? 1 : 0;
#pragma unroll
        for (int i = 0; i < 16; ++i) Lm[(32 * ct + crow(i, hh)) * 64 + 32 * mt + r] = Lt[i]; }
    lds_barrier();
#ifdef PROBE_PREP
    if (PROBE_PREP == 2) { const unsigned long long t1_ = __builtin_amdgcn_s_memrealtime(); const unsigned long long d_ = t1_ - tp0_; while (__builtin_amdgcn_s_memrealtime() - t1_ < d_) __builtin_amdgcn_s_sleep(2); }
    tp0_ = __builtin_amdgcn_s_memrealtime();
#endif
    if (gw == 0) {
        const LAS float* Lb = Lm + (32 * hh) * 64 + 32 * hh;
        const int jc = lane & 31;
        float Tc[32];
#pragma unroll
        for (int i = 0; i < 32; ++i) {
            float a0 = (i == jc) ? 1.f : 0.f, a1 = 0.f, a2 = 0.f, a3 = 0.f;
#pragma unroll
            for (int k4 = 0; k4 < (i + 3) / 4; ++k4) { const f32x4 lv = *(const LAS f32x4*)(Lb + i * 64 + 4 * k4);
                if (4 * k4 + 0 < i) a0 -= lv.x * Tc[4 * k4 + 0]; if (4 * k4 + 1 < i) a1 -= lv.y * Tc[4 * k4 + 1];
                if (4 * k4 + 2 < i) a2 -= lv.z * Tc[4 * k4 + 2]; if (4 * k4 + 3 < i) a3 -= lv.w * Tc[4 * k4 + 3]; }
            Tc[i] = (a0 + a1) + (a2 + a3);
        }
        LDS_WAIT(); asm volatile("" ::: "memory");
        LAS unsigned char* timg = kimg; LAS unsigned char* t00t = kimg + 64 * dn::TST;
#pragma unroll
        for (int i = 0; i < 32; ++i) *(LAS unsigned short*)(timg + (32 * hh + i) * dn::TST + (32 * hh + jc) * 2) = (unsigned short)f2bf(Tc[i]);
        if (hh == 0) {
#pragma unroll
            for (int q = 0; q < 4; ++q) { *(LAS u32x4*)(t00t + jc * 80 + 16 * q) = (u32x4){pk2(Tc[8 * q], Tc[8 * q + 1]), pk2(Tc[8 * q + 2], Tc[8 * q + 3]), pk2(Tc[8 * q + 4], Tc[8 * q + 5]), pk2(Tc[8 * q + 6], Tc[8 * q + 7])};
                *(LAS u32x4*)(timg + jc * dn::TST + 64 + 16 * q) = (u32x4){0u, 0u, 0u, 0u}; }
        }
        LDS_WAIT(); asm volatile("" ::: "memory");
        f32x16 X = {0.f, 0.f, 0.f, 0.f, 0.f, 0.f, 0.f, 0.f, 0.f, 0.f, 0.f, 0.f, 0.f, 0.f, 0.f, 0.f};
#pragma unroll
        for (int s2 = 0; s2 < 2; ++s2) { const f32x4 la = *(const LAS f32x4*)(Lm + (32 + r) * 64 + 16 * s2 + 8 * hh), lb = *(const LAS f32x4*)(Lm + (32 + r) * 64 + 16 * s2 + 8 * hh + 4);
            X = MFMA32(pack8(la.x, la.y, la.z, la.w, lb.x, lb.y, lb.z, lb.w), *(const LAS bf16x8*)(t00t + r * 80 + (16 * s2 + 8 * hh) * 2), X); }
        f32x16 Y = {0.f, 0.f, 0.f, 0.f, 0.f, 0.f, 0.f, 0.f, 0.f, 0.f, 0.f, 0.f, 0.f, 0.f, 0.f, 0.f};
#pragma unroll
        for (int s2 = 0; s2 < 2; ++s2) { const LAS unsigned char* pp = timg + (32 + r) * dn::TST + (32 + 16 * s2 + 4 * hh) * 2; const u32x2 lo = *(const LAS u32x2*)pp, hi = *(const LAS u32x2*)(pp + 16);
            u32x4 af; af.x = lo.x; af.y = lo.y; af.z = hi.x; af.w = hi.y;
            Y = MFMA32(__builtin_bit_cast(bf16x8, af), pack8m(X[8 * s2], X[8 * s2 + 1], X[8 * s2 + 2], X[8 * s2 + 3], X[8 * s2 + 4], X[8 * s2 + 5], X[8 * s2 + 6], X[8 * s2 + 7]), Y); }
#pragma unroll
        for (int i = 0; i < 16; ++i) *(LAS unsigned short*)(timg + (32 + crow(i, hh)) * dn::TST + r * 2) = (unsigned short)f2bf(-Y[i]);
    }
    lds_barrier();
#ifdef PROBE_PREP
    if (PROBE_PREP == 3) { const unsigned long long t1_ = __builtin_amdgcn_s_memrealtime(); const unsigned long long d_ = t1_ - tp0_; while (__builtin_amdgcn_s_memrealtime() - t1_ < d_) __builtin_amdgcn_s_sleep(2); }
    tp0_ = __builtin_amdgcn_s_memrealtime();
#endif
    {
        LAS unsigned char* timg = kimg;
        bf16x8 afr[4];
#pragma unroll
        for (int s4 = 0; s4 < 4; ++s4) { const u32x4 x = *(const LAS u32x4*)(ktimg + (32 * gw + r) * dn::TST + (((2 * s4 + hh) ^ ((4 * gw + (r >> 3)) & 7)) * 16));
            const f32x4 fa = *(const LAS f32x4*)(f1v + 16 * s4 + 8 * hh), fb = *(const LAS f32x4*)(f1v + 16 * s4 + 8 * hh + 4);
            afr[s4] = pack8(-bflo(x.x) * fa.x, -bfhi(x.x) * fa.y, -bflo(x.y) * fa.z, -bfhi(x.y) * fa.w, -bflo(x.z) * fb.x, -bfhi(x.z) * fb.y, -bflo(x.w) * fb.z, -bfhi(x.w) * fb.w); }
#pragma unroll
        for (int ct = 0; ct < 2; ++ct) {
            f32x16 acc = {0.f, 0.f, 0.f, 0.f, 0.f, 0.f, 0.f, 0.f, 0.f, 0.f, 0.f, 0.f, 0.f, 0.f, 0.f, 0.f};
#pragma unroll
            for (int s4 = 0; s4 < 4; ++s4) acc = MFMA32(afr[s4], *(const LAS bf16x8*)(timg + (32 * ct + r) * dn::TST + s4 * 32 + hh * 16), acc);
#pragma unroll
            for (int s2 = 0; s2 < 2; ++s2) *(bf16x8*)(blk + dn::OFF_W + ((ct * 4 + gw) * 2 + s2) * 1024 + lane * 16) = pack8m(acc[8 * s2], acc[8 * s2 + 1], acc[8 * s2 + 2], acc[8 * s2 + 3], acc[8 * s2 + 4], acc[8 * s2 + 5], acc[8 * s2 + 6], acc[8 * s2 + 7]);
        }
#pragma unroll
        for (int ct = 0; ct < 2; ++ct) {
            f32x16 acc = {0.f, 0.f, 0.f, 0.f, 0.f, 0.f, 0.f, 0.f, 0.f, 0.f, 0.f, 0.f, 0.f, 0.f, 0.f, 0.f};
#pragma unroll
            for (int s4 = 0; s4 < 4; ++s4) acc = MFMA32(*(const LAS bf16x8*)(timg + (32 * ct + r) * dn::TST + s4 * 32 + hh * 16), *(const LAS bf16x8*)(vtimg + (32 * gw + r) * dn::TST + (((2 * s4 + hh) ^ ((4 * gw + (r >> 3)) & 7)) * 16)), acc);
#pragma unroll
            for (int s2 = 0; s2 < 2; ++s2) *(bf16x8*)(blk + dn::OFF_U + ((ct * 4 + gw) * 2 + s2) * 1024 + lane * 16) = pack8m(acc[8 * s2], acc[8 * s2 + 1], acc[8 * s2 + 2], acc[8 * s2 + 3], acc[8 * s2 + 4], acc[8 * s2 + 5], acc[8 * s2 + 6], acc[8 * s2 + 7]);
        }
    }
    lds_barrier();
}

DI void dn_scan(int wv, int l, int bh) {
    const Frame F = mkframe(wv);
    const ArgsP ap = kargs();
    unsigned char* ws = ap->ws; bf16_t* P = (bf16_t*)(ws + WS_P);
    const int lane = F.lane, hh = lane >> 5, b = bh >> 2, h = bh & 3, w4 = wv & 3;
    LAS float* part = (LAS float*)(F.lds + 2 * dn::HC_BYTES);
    LAS float* gnl = part + 512;
    LAS float* decs = gnl + 128;
    if (F.tid < 128) gnl[F.tid] = ap->dn_norm_g[l * 128 + F.tid];
    if (F.tid < 32) decs[F.tid] = ((const float*)(ws + WS_GB))[(size_t)(b * 32 + F.tid) * 4 + h];
    const size_t hc_stride = 4 * (size_t)dn::HC_BYTES;
    const unsigned char* blk0 = ws + WS_DNI + ((size_t)(b * 32) * 4 + h) * dn::HC_BYTES;
#define DN_PIECE(src_, pbuf, pc_) __builtin_amdgcn_global_load_lds((const unsigned*)((src_) + (pc_) * 1024 + lane * 16), (LAS unsigned*)(F.lds + (pbuf) * dn::HC_BYTES + (pc_) * 1024), 16, 0, 0)
#define DN_LOAD(nn, pbuf) do { const unsigned char* src_ = blk0 + (size_t)(nn) * hc_stride; \
        if (wv < 4) { _Pragma("unroll") for (int i_ = 0; i_ < 9; ++i_) DN_PIECE(src_, pbuf, wv * 9 + i_); } \
        else { _Pragma("unroll") for (int i_ = 0; i_ < 5; ++i_) DN_PIECE(src_, pbuf, 36 + 5 * w4 + i_); \
               DN_PIECE(src_, pbuf, 56 + 2 * w4); DN_PIECE(src_, pbuf, 57 + 2 * w4); DN_PIECE(src_, pbuf, 64 + 2 * w4); DN_PIECE(src_, pbuf, 65 + 2 * w4); } } while (0)
    DN_LOAD(0, 0);
    f32x16 S[4];
#pragma unroll
    for (int i = 0; i < 4; ++i) S[i] = (f32x16){0.f, 0.f, 0.f, 0.f, 0.f, 0.f, 0.f, 0.f, 0.f, 0.f, 0.f, 0.f, 0.f, 0.f, 0.f, 0.f};
    u32x4 heldO[4], zO[4];
#pragma unroll
    for (int i = 0; i < 4; ++i) { heldO[i] = (u32x4){0u, 0u, 0u, 0u}; zO[i] = heldO[i]; }
    VM_WAIT(); __syncthreads();
    if (wv < 4) {
    for (int k = 0; k < 34; ++k) {
        const int pbuf = k & 1;
#ifdef PROBE_SCANC
        const unsigned long long tc0_ = __builtin_amdgcn_s_memrealtime();
#endif
        LAS unsigned char* buf = F.lds + pbuf * dn::HC_BYTES;
        {
            if (k + 1 < 32) DN_LOAD(k + 1, pbuf ^ 1);
            if (k < 32) {
                const float dec = decs[k];
                f32x16 vn[2], o[2];
#pragma unroll
                for (int ct = 0; ct < 2; ++ct) {
                    o[ct] = (f32x16){0.f, 0.f, 0.f, 0.f, 0.f, 0.f, 0.f, 0.f, 0.f, 0.f, 0.f, 0.f, 0.f, 0.f, 0.f, 0.f};
#pragma unroll
                    for (int s2 = 0; s2 < 2; ++s2) { const u32x4 x = *(const LAS u32x4*)(buf + dn::OFF_U + ((ct * 4 + wv) * 2 + s2) * 1024 + lane * 16);
                        vn[ct][8 * s2] = bflo(x.x); vn[ct][8 * s2 + 1] = bfhi(x.x); vn[ct][8 * s2 + 2] = bflo(x.y); vn[ct][8 * s2 + 3] = bfhi(x.y);
                        vn[ct][8 * s2 + 4] = bflo(x.z); vn[ct][8 * s2 + 5] = bfhi(x.z); vn[ct][8 * s2 + 6] = bflo(x.w); vn[ct][8 * s2 + 7] = bfhi(x.w); }
                }
#define DN_F(off) (*(const LAS bf16x8*)(buf + (off) + lane * 16))
#define DN_WQ(ct, st) ((((ct) * 4 + ((st) >> 1)) * 2 + ((st) & 1)) * 1024)
                bf16x8 fa[4], fb[6];
                fa[0] = DN_F(dn::OFF_W + DN_WQ(0, 0)); fa[1] = DN_F(dn::OFF_QG + DN_WQ(0, 0)); fa[2] = DN_F(dn::OFF_W + DN_WQ(1, 0)); fa[3] = DN_F(dn::OFF_QG + DN_WQ(1, 0));
#pragma unroll
                for (int st = 0; st < 8; ++st) {
                    const int tau = st >> 1, s2 = st & 1;
                    if (st < 7) { fb[0] = DN_F(dn::OFF_W + DN_WQ(0, st + 1)); fb[1] = DN_F(dn::OFF_QG + DN_WQ(0, st + 1)); fb[2] = DN_F(dn::OFF_W + DN_WQ(1, st + 1)); fb[3] = DN_F(dn::OFF_QG + DN_WQ(1, st + 1)); }
                    else { fb[0] = DN_F(dn::OFF_AI + 0 * 1024); fb[1] = DN_F(dn::OFF_AI + 4 * 1024); fb[2] = DN_F(dn::OFF_KD + 0 * 1024); fb[3] = DN_F(dn::OFF_KD + 4 * 1024); fb[4] = DN_F(dn::OFF_KD + 8 * 1024); fb[5] = DN_F(dn::OFF_KD + 12 * 1024); }
                    __builtin_amdgcn_sched_barrier(0);
                    const bf16x8 sf = pack8m(S[tau][8 * s2], S[tau][8 * s2 + 1], S[tau][8 * s2 + 2], S[tau][8 * s2 + 3], S[tau][8 * s2 + 4], S[tau][8 * s2 + 5], S[tau][8 * s2 + 6], S[tau][8 * s2 + 7]);
                    vn[0] = MFMA32(fa[0], sf, vn[0]); o[0] = MFMA32(fa[1], sf, o[0]); vn[1] = MFMA32(fa[2], sf, vn[1]); o[1] = MFMA32(fa[3], sf, o[1]);
                    __builtin_amdgcn_sched_barrier(0);
                    if (st < 7) { fa[0] = fb[0]; fa[1] = fb[1]; fa[2] = fb[2]; fa[3] = fb[3]; }
                }
#pragma unroll
                for (int tau = 0; tau < 4; ++tau) S[tau] = S[tau] * dec;
                bf16x8 fc[6];
#pragma unroll
                for (int g = 0; g < 4; ++g) {
                    const int cm = g >> 1, s2 = g & 1;
                    if (g < 3) { const int cm1 = (g + 1) >> 1, s21 = (g + 1) & 1;
                        fc[0] = DN_F(dn::OFF_AI + ((cm1 * 2 + cm1) * 2 + s21) * 1024); fc[1] = DN_F(dn::OFF_AI + ((1 * 2 + cm1) * 2 + s21) * 1024);
#pragma unroll
                        for (int tau = 0; tau < 4; ++tau) fc[2 + tau] = DN_F(dn::OFF_KD + ((tau * 2 + cm1) * 2 + s21) * 1024); }
                    __builtin_amdgcn_sched_barrier(0);
                    const bf16x8 vf = pack8m(vn[cm][8 * s2], vn[cm][8 * s2 + 1], vn[cm][8 * s2 + 2], vn[cm][8 * s2 + 3], vn[cm][8 * s2 + 4], vn[cm][8 * s2 + 5], vn[cm][8 * s2 + 6], vn[cm][8 * s2 + 7]);
                    if (cm == 0) o[0] = MFMA32(fb[0], vf, o[0]);
                    o[1] = MFMA32(fb[1], vf, o[1]);
#pragma unroll
                    for (int tau = 0; tau < 4; ++tau) S[tau] = MFMA32(fb[2 + tau], vf, S[tau]);
                    __builtin_amdgcn_sched_barrier(0);
                    if (g < 3) {
#pragma unroll
                        for (int q = 0; q < 6; ++q) fb[q] = fc[q]; }
                }
#undef DN_F
#undef DN_WQ
                LDS_WAIT(); __builtin_amdgcn_sched_barrier(0); asm volatile("s_nop 15\n\ts_nop 3" ::: "memory"); __builtin_amdgcn_sched_barrier(0);
#pragma unroll
                for (int ct = 0; ct < 2; ++ct)
#pragma unroll
                    for (int i = 0; i < 16; i += 2) { const int c = 32 * ct + crow(i, hh), q = c >> 4; const unsigned u2 = pk2(o[ct][i], o[ct][i + 1]);
                        LAS unsigned char* wp = buf + dn::OFF_U + (((q >> 1) * 4 + wv) * 2 + (q & 1)) * 1024 + (c & 15) * 64 + (lane & 31) * 2;
                        *(LAS unsigned short*)wp = (unsigned short)u2; *(LAS unsigned short*)(wp + 64) = (unsigned short)(u2 >> 16); }
            }
        }
#ifdef PROBE_SCANC
        { const unsigned long long tc1_ = __builtin_amdgcn_s_memrealtime(); const unsigned long long d_ = tc1_ - tc0_; while (__builtin_amdgcn_s_memrealtime() - tc1_ < d_) __builtin_amdgcn_s_sleep(2); }
#endif
        asm volatile("s_waitcnt vmcnt(0)" ::: "memory");
        lds_barrier();
    }
    } else {
    u32x4 heldN[4], zN[4];
#pragma unroll
    for (int i = 0; i < 4; ++i) { heldN[i] = (u32x4){0u, 0u, 0u, 0u}; zN[i] = heldN[i]; }
    unsigned td0 = 0u, td1 = 0u, td2 = 0u;
    for (int k = 0; k < 34; ++k) {
        const int pbuf = k & 1;
#ifdef PROBE_SCANH
        const unsigned long long th0_ = __builtin_amdgcn_s_memrealtime();
#endif
        const bool rows = (k >= 1 && k <= 32);
        if (rows) {
            const int nn = k - 1; LAS unsigned char* pb = F.lds + (nn & 1) * dn::HC_BYTES;
            const int q = lane >> 4; const LAS unsigned char* rp = pb + dn::OFF_U + (((q >> 1) * 4 + w4) * 2 + (q & 1)) * 1024 + (lane & 15) * 64;
            float ssq = 0.f;
#pragma unroll
            for (int i = 0; i < 4; ++i) { const u32x4 hv = *(const LAS u32x4*)(rp + 16 * i); heldN[i] = hv;
                ssq += bflo(hv.x) * bflo(hv.x) + bfhi(hv.x) * bfhi(hv.x) + bflo(hv.y) * bflo(hv.y) + bfhi(hv.y) * bfhi(hv.y)
                     + bflo(hv.z) * bflo(hv.z) + bfhi(hv.z) * bfhi(hv.z) + bflo(hv.w) * bflo(hv.w) + bfhi(hv.w) * bfhi(hv.w); }
            part[((nn & 1) * 64 + lane) * 4 + w4] = ssq;
        }
        LDS_WAIT(); asm volatile("" ::: "memory");
        if (k + 1 < 32) DN_LOAD(k + 1, pbuf ^ 1);
        __builtin_amdgcn_sched_barrier(0);
        if (rows) { const bf16_t* zp = P + (size_t)(b * SEQ + (k - 1) * 64 + lane) * PLD + P_DNZ + h * 128 + 32 * w4;
#pragma unroll
            for (int i = 0; i < 4; ++i) zN[i] = *(const u32x4*)(zp + 8 * i); }
        __builtin_amdgcn_sched_barrier(0);
#ifdef SCAN_TOUCH_ON
        if (k + 2 < 32) {
            const unsigned char* tb = blk0 + (size_t)(k + 2) * hc_stride + (size_t)(w4 * 144) * 128;
            const unsigned char* a0 = tb + lane * 128; const unsigned char* a1 = tb + (64 + lane) * 128; const unsigned char* a2 = tb + (128 + (lane & 15)) * 128;
            asm volatile("; SCAN_TOUCH\n\tglobal_load_dword %0, %3, off\n\tglobal_load_dword %1, %4, off\n\tglobal_load_dword %2, %5, off" : "+v"(td0), "+v"(td1), "+v"(td2) : "v"(a0), "v"(a1), "v"(a2) : "memory");
        }
        __builtin_amdgcn_sched_barrier(0);
#endif
        u32x4 wo[4];
        if (k >= 2) {
            const int nn = k - 2; const f32x4 p4 = *(const LAS f32x4*)(part + ((nn & 1) * 64 + lane) * 4);
            const float rs = rsqrtf(((p4.x + p4.y) + (p4.z + p4.w)) * (1.f / 128.f) + EPS);
#pragma unroll
            for (int q = 0; q < 4; ++q) { const u32x4 zz = zO[q], hv = heldO[q]; const f32x4 ga = *(const LAS f32x4*)(gnl + 32 * w4 + 8 * q), gb = *(const LAS f32x4*)(gnl + 32 * w4 + 8 * q + 4);
                wo[q].x = pk2(bflo(hv.x) * rs * ga.x * siluf_(bflo(zz.x)), bfhi(hv.x) * rs * ga.y * siluf_(bfhi(zz.x)));
                wo[q].y = pk2(bflo(hv.y) * rs * ga.z * siluf_(bflo(zz.y)), bfhi(hv.y) * rs * ga.w * siluf_(bfhi(zz.y)));
                wo[q].z = pk2(bflo(hv.z) * rs * gb.x * siluf_(bflo(zz.z)), bfhi(hv.z) * rs * gb.y * siluf_(bfhi(zz.z)));
                wo[q].w = pk2(bflo(hv.w) * rs * gb.z * siluf_(bflo(zz.w)), bfhi(hv.w) * rs * gb.w * siluf_(bfhi(zz.w))); }
        }
#ifdef SCAN_TOUCH_ON
        if (k + 2 < 32) asm volatile("; SCAN_E\n\ts_waitcnt vmcnt(3)" ::: "memory"); else
#endif
        asm volatile("s_waitcnt vmcnt(0)" ::: "memory");
        if (k >= 2) { bf16_t* zp = P + (size_t)(b * SEQ + (k - 2) * 64 + lane) * PLD + P_DNZ + h * 128 + 32 * w4;
#pragma unroll
            for (int q = 0; q < 4; ++q) *(u32x4*)(zp + 8 * q) = wo[q]; }
#pragma unroll
        for (int i = 0; i < 4; ++i) { heldO[i] = heldN[i]; zO[i] = zN[i]; }
#ifdef PROBE_SCANH
        { const unsigned long long th1_ = __builtin_amdgcn_s_memrealtime(); const unsigned long long d_ = th1_ - th0_; while (__builtin_amdgcn_s_memrealtime() - th1_ < d_) __builtin_amdgcn_s_sleep(2); }
#endif
        lds_barrier();
    }
    asm volatile("s_waitcnt vmcnt(0)" : "+v"(td0), "+v"(td1), "+v"(td2) :: "memory");
    }
#undef DN_LOAD
#undef DN_PIECE
}

DI void final_norm(int wv) {
    const Frame F = mkframe(wv);
    const ArgsP ap = kargs();
    const float* ss = (const float*)(ap->ws + WS_SS);
    for (int m = F.gw; m < T; m += F.NGW) {
        const f32x4 s = *(const f32x4*)(ss + (size_t)m * 4); const float rs = rsqrtf(((s.x + s.y) + (s.z + s.w)) * (1.f / D) + EPS);
        f32x4* xr = (f32x4*)(ap->out + (size_t)m * D) + F.lane; const f32x4* gr = (const f32x4*)ap->final_norm_g + F.lane;
#pragma unroll
        for (int j = 0; j < 4; ++j) { const f32x4 v = xr[64 * j], g = gr[64 * j]; xr[64 * j] = v * rs * g; }
    }
}

__global__ void __launch_bounds__(NTHREADS, 2) mk_fwd(Args args) {
    extern __shared__ __attribute__((aligned(16))) unsigned char lds_raw[];
    LAS unsigned char* const lds = (LAS unsigned char*)lds_raw;
    volatile LAS unsigned* MISC = (volatile LAS unsigned*)(lds + MISC_OFF);
    const int wv = __builtin_amdgcn_readfirstlane((int)threadIdx.x >> 6);
    { const int t0 = opaque_tid(wv); for (int u = t0; u < (LDS_BYTES - LDSCTL_OFF) / 4; u += NTHREADS) ((LAS unsigned*)(lds + LDSCTL_OFF))[u] = 0u; }
    __syncthreads();
    const int G = gridDim.x;
    XcdBarrier bar; bar.bar = (unsigned*)(args.ws + WS_CTL) + CW_BAR + args.li * XCD_BAR_WORDS; bar.x = 0; bar.st = nullptr;
    if (args.ph_hi - args.ph_lo > 1) bar = xcd_barrier_post(bar.bar, MISC + 8, wv);
#define IN(k) (kargs()->ph_lo <= (k) && (k) < kargs()->ph_hi)
#ifdef PROBE_SUB
    unsigned long long ts_prev_ = 0;
#define SUBSEAM(bit) do { xcd_barrier(bar, wv); { const unsigned long long t1_ = __builtin_amdgcn_s_memrealtime(); \
        if ((PROBE_SUB >> (bit)) & 1u) { const unsigned long long d_ = t1_ - ts_prev_; while (__builtin_amdgcn_s_memrealtime() - t1_ < d_) __builtin_amdgcn_s_sleep(8); } \
        ts_prev_ = __builtin_amdgcn_s_memrealtime(); } } while (0)
#define SUBSTART() do { ts_prev_ = __builtin_amdgcn_s_memrealtime(); } while (0)
#else
#define SUBSEAM(bit) do { } while (0)
#define SUBSTART() do { } while (0)
#endif
#ifdef PROBE_ECHO
    unsigned long long t_prev_ = __builtin_amdgcn_s_memrealtime();
#define SEAM(k) do { if (IN(k) && IN((k) + 1)) xcd_barrier(bar, wv); { const unsigned long long t1_ = __builtin_amdgcn_s_memrealtime(); \
        if ((PROBE_ECHO >> (k)) & 1u) { const unsigned long long d_ = t1_ - t_prev_; while (__builtin_amdgcn_s_memrealtime() - t1_ < d_) __builtin_amdgcn_s_sleep(8); } \
        t_prev_ = __builtin_amdgcn_s_memrealtime(); } } while (0)
#else
#define SEAM(k) do { if (IN(k) && IN((k) + 1)) xcd_barrier(bar, wv); } while (0)
#endif
#define MK_EPI(E) gm::Epi E; E.ws = kargs()->ws; E.xin = nullptr; E.xout = nullptr; E.wout32 = false; E.b_gate = nullptr; E.gnext = nullptr; E.gfinal = nullptr; E.spare = (LAS float*)(lds + SPARE_OFF);

#if !defined(ONLY_PH) || ONLY_PH == 0
    if (IN(0)) { p0_prologue(wv); }
#endif
    SEAM(0);

    for (int l0 = 0; l0 < DEPTH; ++l0) {
        int l = l0; asm volatile("" : "+s"(l));
        const int pb = 1 + 6 * l;
#if !defined(ONLY_PH) || ONLY_PH == 1
        if (IN(pb)) { MK_EPI(E); SchedP1 S; S.ord.init(64, 12, G, opaque_bid()); S.ws = kargs()->ws; S.l = l; S.half = 0; S.c = opaque_bid(); S.with_kvm = false;
            gm::gemm_phase<AUX_P1>(lds, wv, S, E);
#ifdef PROBE_DUP_GEMM
            xcd_barrier(bar, wv); gm::gemm_phase<AUX_P1>(lds, wv, S, E);
#endif
            }
#endif
        SEAM(pb);
#if !defined(ONLY_PH) || ONLY_PH == 2
        if (IN(pb + 1)) {
            SUBSTART();
            SUBSEAM(0);
            for (int pair = opaque_bid(); pair < 512; pair += G) dn_prep(wv, l, pair);
            SUBSEAM(1);
            if (l > 0) { const Frame Fm = mkframe(wv); memn_rows(Fm, kargs(), l); }
 }
#endif
        SEAM(pb + 1);
#if !defined(ONLY_PH) || ONLY_PH == 3
        if (IN(pb + 2)) {
            if (opaque_bid() < 32 && G > 64) dn_scan(wv, l, opaque_bid());
            else { const bool split = G > 64; MK_EPI(E); SchedP1 S; S.ord.init(64, 12, split ? G - 32 : G, split ? opaque_bid() - 32 : opaque_bid()); S.ws = kargs()->ws; S.l = l; S.half = 1; S.c = opaque_bid(); S.with_kvm = true;
                gm::gemm_phase<AUX_P1>(lds, wv, S, E);
#ifdef PROBE_DUP_GEMM
                xcd_barrier(bar, wv); gm::gemm_phase<AUX_P1>(lds, wv, S, E);
#endif
                { const int cp = opaque_bid() - 32; const Frame Fc = mkframe(wv);
                  const int nsh = cp >= 112 ? 3 : 1, sh0 = cp >= 112 ? 3 * (cp - 112) : 336 + cp;
                  for (int q = 0; q < nsh; ++q) { const int first = (sh0 + q) * NWAVES + wv, stride = 448 * NWAVES;
                      if (l == 0) convert_weights(Fc, kargs(), 0, first, stride, 2);
                      if (l + 1 < DEPTH) convert_weights(Fc, kargs(), l + 1, first, stride, 0); } }
            }
            if (G <= 64) { for (int bh = opaque_bid(); bh < 32; bh += G) dn_scan(wv, l, bh); }
        }
#endif
        SEAM(pb + 2);
#if !defined(ONLY_PH) || ONLY_PH == 4
        if (IN(pb + 3)) {
            const int wg = opaque_bid();

            unsigned* head = (unsigned*)(kargs()->ws + WS_CTL) + CW_QUEUE + 64 * l;
            volatile LAS unsigned* qslot = (volatile LAS unsigned*)(lds + MISC_OFF + 64);
            for (;;) {
#ifdef PROBE_FETCH
                const unsigned long long tf0_ = __builtin_amdgcn_s_memrealtime();
#endif
                if (opaque_tid(wv) == 0) qslot[0] = __hip_atomic_fetch_add(head, 1u, __ATOMIC_RELAXED, __HIP_MEMORY_SCOPE_AGENT);
                __syncthreads();
                const int unit = (int)qslot[0];
                __syncthreads();
#ifdef PROBE_FETCH
                { const unsigned long long tf1_ = __builtin_amdgcn_s_memrealtime(); const unsigned long long d_ = tf1_ - tf0_; while (__builtin_amdgcn_s_memrealtime() - tf1_ < d_) __builtin_amdgcn_s_sleep(2); }
#endif
                if (unit >= 1248) break;
#ifdef PROBE_UNIT
                const unsigned long long tu0_ = __builtin_amdgcn_s_memrealtime();
#endif
                if (unit < 224) ret_state_unit(wv, l, unit); else if (unit < 480) attn_unit<1>(wv, l, unit - 224); else if (unit < 992) attn_unit<0>(wv, l, unit - 480); else mem_unit(wv, l, unit - 992);
#ifdef PROBE_UNIT
                { const unsigned long long tu1_ = __builtin_amdgcn_s_memrealtime(); if (PROBE_UNIT >= 2 ? (tu1_ - tu0_ > (unsigned long long)PROBE_UNIT * 100ull) : ((unit < 256) == (PROBE_UNIT == 1))) { const unsigned long long d_ = tu1_ - tu0_; while (__builtin_amdgcn_s_memrealtime() - tu1_ < d_) __builtin_amdgcn_s_sleep(8); } }
#endif
            }
        }
#endif
#ifdef KEEP_SEAM3
        SEAM(pb + 3);
#endif
#if !defined(ONLY_PH) || ONLY_PH == 5
        if (IN(pb + 4)) { MK_EPI(E); gm::TileOrder ord; ord.init(64, 4, G, opaque_bid()); SchedP3 S; S.ok = ord.tile(0, S.pm, S.pn); S.l = l; S.rot = (opaque_bid() >> 3) & 3; S.ws = kargs()->ws; E.b_gate = kargs()->b_gate;
            gm::gemm_phase<AUX_P3>(lds, wv, S, E);
#ifdef PROBE_DUP_GEMM
            xcd_barrier(bar, wv); gm::gemm_phase<AUX_P3>(lds, wv, S, E);
#endif
            }
#endif
        SEAM(pb + 4);
#if !defined(ONLY_PH) || ONLY_PH == 6
        if (IN(pb + 5)) { MK_EPI(E); gm::TileOrder ord; ord.init(64, 4, G, opaque_bid()); SchedP4 S; S.ok = ord.tile(0, S.pm, S.pn); S.l = l; S.ws = kargs()->ws;
            E.gnext = (l + 1 < DEPTH) ? kargs()->norm_g + (size_t)(l + 1) * D : nullptr;
            E.gfinal = (l + 1 < DEPTH || G != 256) ? nullptr : kargs()->final_norm_g;
            E.xout = kargs()->out; E.xin = (l == 0) ? kargs()->x : (const float*)kargs()->out;
            E.wout32 = (l + 1 == DEPTH) && G != 256;
            gm::gemm_phase<AUX_P4>(lds, wv, S, E); }
#endif
        if (!(l + 1 == DEPTH && G == 256)) SEAM(pb + 5);
    }
#if !defined(ONLY_PH) || ONLY_PH == 13
    if (IN(13) && G != 256) final_norm(wv);
#endif
#undef IN
#undef SEAM
#undef MK_EPI
}

extern "C" void kernel_launch(void* const* d_in, const int* in_sizes, int n_in, void* d_out, int out_size, void* d_ws, size_t ws_size, hipStream_t stream) {
    static int grid = 0;
    if (grid == 0) {
        if (n_in != 19 || out_size != T * D || ws_size < WS_END) { fprintf(stderr, "kernel_launch: unexpected problem (n_in %d, out %d, ws %zu)\n", n_in, out_size, ws_size); grid = -1; return; }
        int dev = 0, cus = 0, per_cu = 0;
        if (hipGetDevice(&dev) != hipSuccess || hipDeviceGetAttribute(&cus, hipDeviceAttributeMultiprocessorCount, dev) != hipSuccess) { grid = -1; return; }
        if (hipFuncSetAttribute((const void*)mk_fwd, hipFuncAttributeMaxDynamicSharedMemorySize, LDS_BYTES) != hipSuccess) { fprintf(stderr, "kernel_launch: hipFuncSetAttribute failed\n"); grid = -1; return; }
        if (hipOccupancyMaxActiveBlocksPerMultiprocessor(&per_cu, (const void*)mk_fwd, NTHREADS, LDS_BYTES) != hipSuccess || per_cu < 1)
            fprintf(stderr, "kernel_launch: occupancy query reports %d workgroups per CU\n", per_cu);
        (void)hipGetLastError();
        grid = cus;
    }
    if (grid < 0) return;
    if (hipMemsetAsync((char*)d_ws + WS_CTL, 0, CTL_ZERO_BYTES, stream) != hipSuccess) return;
    Args a{};
    a.x = (const float*)d_in[0]; a.mem = (const float*)d_in[1]; a.positions = (const int*)d_in[2]; a.norm_g = (const float*)d_in[3]; a.mem_norm_g = (const float*)d_in[4];
    a.w_in = (const float*)d_in[5]; a.b_gate = (const float*)d_in[6]; a.dn_conv_w = (const float*)d_in[7]; a.dn_a_log = (const float*)d_in[8]; a.dn_dt_bias = (const float*)d_in[9];
    a.dn_norm_g = (const float*)d_in[10]; a.ret_norm_g = (const float*)d_in[11]; a.w_mem_kv = (const float*)d_in[12]; a.w_br_sb = (const float*)d_in[13]; a.w_br_dn = (const float*)d_in[14];
    a.w_br_ret = (const float*)d_in[15]; a.w_br_mem = (const float*)d_in[16]; a.w_out = (const float*)d_in[17]; a.final_norm_g = (const float*)d_in[18];
    a.out = (float*)d_out; a.ws = (unsigned char*)d_ws;
#if MK_N_LAUNCHES == 1
    a.ph_lo = 0; a.ph_hi = NPHASE; a.li = 0;
    hipLaunchKernelGGL(mk_fwd, dim3(grid), dim3(NTHREADS), LDS_BYTES, stream, a);
#else
    for (int p = 0; p < NPHASE; ++p) { a.ph_lo = p; a.ph_hi = p + 1; a.li = 0;
        hipLaunchKernelGGL(mk_fwd, dim3(grid), dim3(NTHREADS), LDS_BYTES, stream, a); }
#endif
}
```

```cpp
#include <hip/hip_runtime.h>
#include <cstdio>
#include <cstdint>
#include <cmath>

#define LAS __attribute__((address_space(3)))
#define GAS __attribute__((address_space(1)))
#define DI __device__ __forceinline__
typedef unsigned short bf16_t;
typedef short bf16x8 __attribute__((ext_vector_type(8)));
typedef float f32x4 __attribute__((ext_vector_type(4)));
typedef unsigned u32x4 __attribute__((ext_vector_type(4)));
typedef unsigned u32x2 __attribute__((ext_vector_type(2)));
typedef float f32x2 __attribute__((ext_vector_type(2)));

#ifndef AUX_P1
#define AUX_P1 0
#endif
#ifndef AUX_P3
#define AUX_P3 0
#endif
#ifndef AUX_P4
#define AUX_P4 0
#endif
#ifdef EPI_NT
#define EPI_LD(p) __builtin_nontemporal_load(p)
#define EPI_ST(p, v) __builtin_nontemporal_store((v), (p))
#else
#define EPI_LD(p) (*(p))
#define EPI_ST(p, v) (*(p) = (v))
#endif
#ifndef FRESH_WAITS
#define FRESH_WAITS 0
#endif
#ifndef SS_PREFETCH
#define SS_PREFETCH 1
#endif
#ifndef EARLY_INV
#define EARLY_INV 1
#endif
#ifndef MK_N_LAUNCHES
#define MK_N_LAUNCHES 1
#endif

constexpr int BATCH = 8, SEQ = 2048, D = 1024, T = BATCH * SEQ, DEPTH = 2, MEMLEN = 256;
constexpr int IN_COLS = 9992;
constexpr float EPS = 1e-6f;
constexpr int NPHASE = 14;

constexpr size_t MiB = 1u << 20;
constexpr size_t WS_CTL = 0, CTL_ZERO_BYTES = 1 * MiB;
constexpr size_t WS_WINA = 1 * MiB;
constexpr size_t WS_WINB = 13 * MiB;
constexpr size_t WS_WG = 25 * MiB;
constexpr size_t WS_WBR = 41 * MiB;
constexpr size_t WS_WOUT = 49 * MiB;
constexpr size_t WS_WKV = 53 * MiB;
constexpr size_t WS_XN = 55 * MiB;
constexpr size_t WS_P = 87 * MiB;
constexpr size_t WS_R = 127 * MiB;
constexpr int VTLD = T + 64;
constexpr size_t WS_VTSB = WS_R + 64 * MiB, WS_VTRT = WS_VTSB + (size_t)512 * VTLD * 2;
constexpr size_t WS_SCR = 224 * MiB;
constexpr size_t WS_MRG = 240 * MiB;
constexpr size_t WS_DNI = 224 * MiB;
constexpr size_t WS_KVM = 296 * MiB;
constexpr size_t WS_ROPE = 300 * MiB;
constexpr size_t WS_AB = 304 * MiB;
constexpr size_t WS_GB = WS_AB + 512 * 1024;
constexpr size_t WS_SS = 305 * MiB;
constexpr size_t WS_END = 310 * MiB;
constexpr size_t WS_MEMN = 306 * MiB;
constexpr int PLD = 1280, RALD = 1536, RBLD = 2048, SCRLD = 1024, MRGLD = 1024;
constexpr int P_DNZ = 0, P_MEMQ = 512, P_RTQ = 768, P_RTK = 1024;
constexpr int RB_SBQ = 0, RB_SBK = 512, RB_SBZ = 1024, RB_RTZ = 1536;
constexpr int CW_BAR = 4096;
constexpr int CW_PANEL = 16384;
constexpr int CW_QUEUE = 64;
constexpr int CW_RST = 49152;
constexpr int CW_READY = 32768;

constexpr int RING_BYTES = 155648;
constexpr int LDSCTL_OFF = RING_BYTES, MISC_OFF = LDSCTL_OFF + 320, SPARE_OFF = LDSCTL_OFF + 1024;
constexpr int LDS_BYTES = 163840;
constexpr int NWAVES = 8, NTHREADS = 512;

DI unsigned f2bf(float f) { unsigned u = __builtin_bit_cast(unsigned, f); return (u + 0x7fffu + ((u >> 16) & 1u)) >> 16; }
DI unsigned pk2(float lo, float hi) { unsigned r; asm("s_nop 0\n\tv_cvt_pk_bf16_f32 %0, %1, %2" : "=v"(r) : "v"(lo), "v"(hi)); return r; }
DI float bf2f(unsigned short h) { return __builtin_bit_cast(float, (unsigned)h << 16); }
DI float bflo(unsigned w) { return __builtin_bit_cast(float, w << 16); }
DI float bfhi(unsigned w) { return __builtin_bit_cast(float, w & 0xffff0000u); }
DI float shx(float v, int m, int lane) { return __builtin_bit_cast(float, __builtin_amdgcn_ds_bpermute((lane ^ m) << 2, __builtin_bit_cast(int, v))); }
DI float wave_sum(float v, int lane) {
#pragma unroll
    for (int o = 1; o < 64; o <<= 1) v += shx(v, o, lane);
    return v;
}
DI float sum16(float v) {
    v += __builtin_bit_cast(float, __builtin_amdgcn_update_dpp(0, __builtin_bit_cast(int, v), 0xB1, 0xf, 0xf, true));
    v += __builtin_bit_cast(float, __builtin_amdgcn_update_dpp(0, __builtin_bit_cast(int, v), 0x4E, 0xf, 0xf, true));
    v += __builtin_bit_cast(float, __builtin_amdgcn_update_dpp(0, __builtin_bit_cast(int, v), 0x141, 0xf, 0xf, true));
    v += __builtin_bit_cast(float, __builtin_amdgcn_update_dpp(0, __builtin_bit_cast(int, v), 0x140, 0xf, 0xf, true));
    return v;
}
DI float sigmoidf_(float x) { return __builtin_amdgcn_rcpf(1.f + __builtin_amdgcn_exp2f(x * -1.4426950408889634f)); }
DI float siluf_(float x) { return x * __builtin_amdgcn_rcpf(1.f + __builtin_amdgcn_exp2f(x * -1.4426950408889634f)); }
DI int opaque_bid() { int b = blockIdx.x; asm volatile("" : "+s"(b)); return b; }
DI int opaque_tid(int wv) { int lane; asm volatile("v_mbcnt_lo_u32_b32 %0, -1, 0\n\tv_mbcnt_hi_u32_b32 %0, -1, %0" : "=v"(lane)); return wv * 64 + lane; }
#define LDS_WAIT() asm volatile("s_waitcnt lgkmcnt(0)" ::: "memory")
DI void lds_barrier() { asm volatile("s_waitcnt lgkmcnt(0)" ::: "memory"); __builtin_amdgcn_s_barrier(); asm volatile("" ::: "memory"); }
#define VM_WAIT() asm volatile("s_waitcnt vmcnt(0)" ::: "memory")
DI unsigned shxu(unsigned v, int m, int lane) { return (unsigned)__builtin_amdgcn_ds_bpermute((lane ^ m) << 2, (int)v); }
DI void st16_wt(void* p, u32x4 v) { asm volatile("global_store_dwordx4 %0, %1, off sc1\n\ts_nop 1" :: "v"(p), "v"(v) : "memory"); }
DI void unit_done(unsigned char* ws, int l, int pm, int tid) {
    VM_WAIT(); lds_barrier();
    if (tid == 0) (void)__hip_atomic_fetch_add((unsigned*)(ws + WS_CTL) + CW_READY + 4096 * l + 64 * pm, 1u, __ATOMIC_RELAXED, __HIP_MEMORY_SCOPE_AGENT);
}

#define XB_TMO      128
#define XB_XCNT(j)  (256  + 64 * (j))
#define XB_XSUB(j)  (1280 + 64 * (j))
#define XB_XGEN(j)  (2304 + 64 * (j))
#define XB_TOP      3328
#define XB_TOPGEN   3392
#define XCD_BAR_WORDS 3456
#define XB_SPIN_CAP (1u << 18)
DI unsigned xb_ld(unsigned* p)              { return __hip_atomic_load(p, __ATOMIC_RELAXED, __HIP_MEMORY_SCOPE_AGENT); }
DI unsigned xb_add(unsigned* p, unsigned v) { return __hip_atomic_fetch_add(p, v, __ATOMIC_RELAXED, __HIP_MEMORY_SCOPE_AGENT); }
DI unsigned xb_xcc_id() { return (unsigned)__builtin_amdgcn_s_getreg((3 << 11) | 20) & 0xFu; }
#define XB_SPIN(cond, bar) do { unsigned _sp = 0; while (cond) { __builtin_amdgcn_s_sleep(1); \
    if ((++_sp & 255u) == 0u) { if (xb_ld(&(bar)[XB_TMO])) break; if (_sp > XB_SPIN_CAP) { atomicAdd(&(bar)[XB_TMO], 1u); break; } } } } while (0)
struct XcdBarrier { unsigned* bar; unsigned x; volatile LAS unsigned* st; };
DI XcdBarrier xcd_barrier_post(unsigned* bar, volatile LAS unsigned* st, int wv) {
    XcdBarrier b; b.bar = bar; b.x = xb_xcc_id(); b.st = st;
    if (opaque_tid(wv) == 0) (void)xb_add(&bar[XB_XCNT(b.x)], 1u);
    return b;
}
DI void xcd_barrier_complete(unsigned* bar, unsigned x, unsigned& nloc, unsigned& nx) {
    const unsigned G = gridDim.x * gridDim.y * gridDim.z;
    unsigned sum, cnt, mine, sp = 0u;
    for (;;) {
        sum = 0u; cnt = 0u; mine = 0u;
#pragma unroll
        for (unsigned j = 0; j < 16; ++j) { const unsigned c = xb_ld(&bar[XB_XCNT(j)]); sum += c; cnt += (c > 0u) ? 1u : 0u; mine = (j == x) ? c : mine; }
        if (sum == G) break;
        __builtin_amdgcn_s_sleep(1);
        if ((++sp & 255u) == 0u) { if (xb_ld(&bar[XB_TMO])) break; if (sp > XB_SPIN_CAP) { atomicAdd(&bar[XB_TMO], 1u); break; } }
    }
    nloc = mine > 0u ? mine : 1u; nx = cnt > 0u ? cnt : 1u;
}
DI void xcd_barrier(const XcdBarrier& b, int wv) {
    asm volatile("s_waitcnt vmcnt(0)" ::: "memory");
    __syncthreads();
    if (opaque_tid(wv) == 0) {
        unsigned* bar = b.bar;
        __builtin_amdgcn_s_waitcnt(0);
#if EARLY_INV
        __builtin_amdgcn_fence(__ATOMIC_ACQUIRE, "agent");
#endif
        unsigned nloc = b.st[0], nx = b.st[1];
        if (nloc == 0u) { xcd_barrier_complete(bar, b.x, nloc, nx); b.st[0] = nloc; b.st[1] = nx; }
        const unsigned old = xb_add(&bar[XB_XSUB(b.x)], 1u);
        const unsigned gen = old / nloc;
        if (old + 1u == (gen + 1u) * nloc) {
            __builtin_amdgcn_fence(__ATOMIC_RELEASE, "agent");
            asm volatile("s_waitcnt vmcnt(0)" ::: "memory");
            const unsigned og = xb_add(&bar[XB_TOP], 1u);
            const unsigned tg = og / nx;
            if (og + 1u == (tg + 1u) * nx) xb_add(&bar[XB_TOPGEN], 1u);
            else XB_SPIN(xb_ld(&bar[XB_TOPGEN]) == tg, bar);
#if !EARLY_INV
            __builtin_amdgcn_fence(__ATOMIC_ACQUIRE, "agent");
#endif
            xb_add(&bar[XB_XGEN(b.x)], 1u);
            asm volatile("s_waitcnt vmcnt(0)" ::: "memory");
        } else {
            XB_SPIN(xb_ld(&bar[XB_XGEN(b.x)]) == gen, bar);
#if !EARLY_INV
            __builtin_amdgcn_fence(__ATOMIC_ACQUIRE, "agent");
#endif
            asm volatile("s_waitcnt vmcnt(0)" ::: "memory");
        }
    }
    __syncthreads();
}

namespace gm {
constexpr int BM = 256, BK = 64, HALF = 128, HTB = HALF * BK * 2, STAGE_BYTES = 8 * HTB;
DI int lds_byte(int r, int c) { const int st = (r >> 4) * 2 + (c >> 5), rr = r & 15, cc = c & 31, ob = rr * 64 + cc * 2; return st * 1024 + (ob ^ (((ob >> 9) & 1) << 5)); }
DI void stage_rc(int b, int& R, int& C) { const int st = b / 1024, sb = b % 1024, swz = sb ^ (((sb >> 9) & 1) << 5); R = (st >> 1) * 16 + swz / 64; C = (st & 1) * 32 + (swz % 64) / 2; }
DI int perm32(int rho) { const int n = rho >> 4, i = rho & 15; return 8 * (i >> 2) + 4 * n + (i & 3); }

enum Kind { K_STORE = 0, K_AB = 1, K_GATE = 2, K_BRANCH = 3, K_OUT = 4, K_STORE_T = 5 };
struct Unit {
    const bf16_t* A; const bf16_t* B;
    int lda, ldb, K, pm, pn, kind, sub, l;
};
struct TileOrder {
    int nM, nN, nwg, G, c;
    DI void init(int nM_, int nN_, int G_, int c_) { nM = nM_; nN = nN_; nwg = nM * nN; G = G_; c = c_; }
    DI bool tile(int i, int& pm, int& pn) const {
        const long L = (long)i * G + c; if (L >= nwg) return false;
        int wgid = (int)L; { const int q = nwg / 8, r = nwg % 8, xcd = wgid % 8, off = wgid / 8; wgid = (xcd < r ? xcd * (q + 1) : r * (q + 1) + (xcd - r) * q) + off; }
        const int WGM = 8, nig = WGM * nN, gid = wgid / nig, fm = gid * WGM, gsz = (nM - fm) < WGM ? (nM - fm) : WGM;
        pm = __builtin_amdgcn_readfirstlane(fm + ((wgid % nig) % gsz)); pn = __builtin_amdgcn_readfirstlane((wgid % nig) / gsz); return true;
    }
};

template <int AUX, class Sched, class Epi>
DI void gemm_phase(LAS unsigned char* lds, int wv, const Sched& S, const Epi& E) {
    const int tid = opaque_tid(wv), wid = __builtin_amdgcn_readfirstlane(tid >> 6), lane = tid & 63, wr = wid >> 2, wc = wid & 3, fr = lane & 15, fq = lane >> 4;
    int R0_, C0_; stage_rc(tid * 16, R0_, C0_);
    const unsigned R0 = 2u * (unsigned)R0_, C2 = 2u * (unsigned)C0_;
    const unsigned RbP = 2u * (unsigned)((R0_ & ~31) + perm32(R0_ & 31));
    const unsigned ldsw = (unsigned)wid * 1024u;
    const int aoff = lds_byte(wr * 64 + fr, fq * 8), boff = lds_byte(wc * 32 + fr, fq * 8);
#define GM_SA(b, h) (((b) * 2 + (h)) * HTB)
#define GM_SB(b, h) ((4 + (b) * 2 + (h)) * HTB)
#define GM_STAGE(bufoff, gbase, ld, R2) do { const unsigned _v = (unsigned)(R2) * (unsigned)(ld) + C2; \
        __builtin_amdgcn_global_load_lds((const unsigned*)((const char*)(gbase) + _v), (LAS unsigned*)(lds + (bufoff) + ldsw), 16, 0, AUX); \
        __builtin_amdgcn_global_load_lds((const unsigned*)((const char*)(gbase) + (_v + (unsigned)(ld) * 128u)), (LAS unsigned*)(lds + (bufoff) + ldsw + 8192), 16, 0, AUX); } while (0)
#define GM_LDA(dst, b, h) do { _Pragma("unroll") for (int m = 0; m < 4; ++m) _Pragma("unroll") for (int k = 0; k < 2; ++k) dst[m][k] = *(const LAS bf16x8*)(lds + GM_SA(b, h) + aoff + m * 2048 + k * 1024); } while (0)
#define GM_LDB(dst, b, h) do { _Pragma("unroll") for (int n = 0; n < 2; ++n) _Pragma("unroll") for (int k = 0; k < 2; ++k) dst[n][k] = *(const LAS bf16x8*)(lds + GM_SB(b, h) + boff + n * 2048 + k * 1024); } while (0)
#define GM_MMA(ai, bj, At, Bt) do { __builtin_amdgcn_s_setprio(1); _Pragma("unroll") for (int m = 0; m < 4; ++m) _Pragma("unroll") for (int n = 0; n < 2; ++n) _Pragma("unroll") for (int k = 0; k < 2; ++k) \
        acc[ai][bj][m][n] = __builtin_amdgcn_mfma_f32_16x16x32_bf16(Bt[n][k], At[m][k], acc[ai][bj][m][n], 0, 0, 0); __builtin_amdgcn_s_setprio(0); } while (0)
#define GM_WAIT_V(n) asm volatile("s_waitcnt vmcnt(" #n ")" ::: "memory")
#define GM_WAIT_L(n) asm volatile("s_waitcnt lgkmcnt(" #n ")" ::: "memory")
#define GM_BAR __builtin_amdgcn_s_barrier()
#define GM_SCHED __builtin_amdgcn_sched_barrier(0)
    Unit cur, nxt; int ui = 0;
    if (!S.next(0, cur)) return;
    S.a_ready(cur, wid, lane);
    f32x4 acc[2][2][4][2];
#pragma unroll
    for (int a = 0; a < 2; ++a)
#pragma unroll
        for (int b = 0; b < 2; ++b)
#pragma unroll
            for (int m = 0; m < 4; ++m)
#pragma unroll
                for (int n = 0; n < 2; ++n) acc[a][b][m][n] = (f32x4){0.f, 0.f, 0.f, 0.f};
    bf16x8 At[4][2], B0[2][2], B1[2][2];
    const char* cA = (const char*)cur.A; const char* cB = (const char*)cur.B; int clda = cur.lda, cldb = cur.ldb;
    GM_STAGE(GM_SB(0, 0), cB, cldb, RbP); GM_STAGE(GM_SB(0, 1), cB + (size_t)cldb * 256, cldb, RbP); GM_STAGE(GM_SA(0, 0), cA, clda, R0); GM_STAGE(GM_SA(0, 1), cA + (size_t)clda * 256, clda, R0);
    if (wr == 1) GM_BAR;
    GM_WAIT_V(2); GM_BAR;
    GM_STAGE(GM_SB(1, 0), cB + 128, cldb, RbP); GM_STAGE(GM_SA(1, 0), cA + 128, clda, R0); GM_STAGE(GM_SB(1, 1), cB + (size_t)cldb * 256 + 128, cldb, RbP);
    GM_WAIT_V(6); GM_BAR;
    for (;;) {
        const bool has_next = S.next(ui + 1, nxt);
        const char* nA = has_next ? (const char*)nxt.A : cA; const char* nB = has_next ? (const char*)nxt.B : cB;
        const int nlda = has_next ? nxt.lda : clda, nldb = has_next ? nxt.ldb : cldb;
        const int nt = cur.K / BK;
#if SS_PREFETCH
        if (wid < 4) __builtin_amdgcn_global_load_lds((const unsigned*)(E.ws + WS_SS + ((size_t)(cur.kind == K_STORE_T ? cur.pn : cur.pm) * 256 + tid) * 16), (LAS unsigned*)(lds + STAGE_BYTES + (ui & 1) * 4096 + wid * 1024), 16, 0, 0);
        if (wid == 4 && cur.kind == K_GATE) __builtin_amdgcn_global_load_lds((const unsigned*)(E.b_gate + (size_t)cur.l * 4096 + (cur.sub & 3) * 1024 + cur.pn * 256 + lane * 4), (LAS unsigned*)(lds + STAGE_BYTES + 8192 + (ui & 1) * 1024), 16, 0, 0);
#endif
        for (int t = 0; t < nt; t += 2) {
            const bool last = (t == nt - 2);
            if (last && has_next) S.a_ready(nxt, wid, lane);
            const char* a1 = cA + (size_t)(t + 1) * 128;
            const char* a2 = last ? nA : cA + (size_t)(t + 2) * 128; const char* b2 = last ? nB : cB + (size_t)(t + 2) * 128;
            const int lda2 = last ? nlda : clda, ldb2 = last ? nldb : cldb;
            const char* a3 = a2 + 128; const char* b3 = b2 + 128;
            const int later = __builtin_amdgcn_readfirstlane((t != 0) ? 1 : 0);
#if FRESH_WAITS
#define GM_WAIT_V8_LATER asm volatile("s_cmp_eq_u32 %0, 0\n\ts_cbranch_scc1 .Lgmw%=\n\ts_waitcnt vmcnt(8)\n.Lgmw%=:" :: "s"(later) : "scc", "memory")
#else
#define GM_WAIT_V8_LATER GM_WAIT_V(8)
#endif
            GM_LDB(B0, 0, 0); GM_LDB(B1, 0, 1); GM_SCHED; GM_LDA(At, 0, 0); GM_STAGE(GM_SA(1, 1), a1 + (size_t)clda * 256, clda, R0);
            GM_WAIT_V8_LATER; GM_WAIT_L(0); GM_BAR; GM_MMA(0, 0, At, B0); GM_MMA(0, 1, At, B1); GM_BAR; GM_SCHED;
            GM_LDA(At, 0, 1); GM_STAGE(GM_SB(0, 0), b2, ldb2, RbP); GM_STAGE(GM_SB(0, 1), b2 + (size_t)ldb2 * 256, ldb2, RbP); GM_STAGE(GM_SA(0, 0), a2, lda2, R0);
            GM_WAIT_V8_LATER; GM_WAIT_L(0); GM_BAR; GM_MMA(1, 0, At, B0); GM_MMA(1, 1, At, B1); GM_BAR; GM_SCHED;
#undef GM_WAIT_V8_LATER
            GM_LDB(B0, 1, 0); GM_LDB(B1, 1, 1); GM_SCHED; GM_LDA(At, 1, 0); GM_STAGE(GM_SA(0, 1), a2 + (size_t)lda2 * 256, lda2, R0);
            GM_WAIT_V(8); GM_WAIT_L(0); GM_BAR; GM_MMA(0, 0, At, B0); GM_MMA(0, 1, At, B1); GM_BAR; GM_SCHED;
            GM_LDA(At, 1, 1); GM_STAGE(GM_SB(1, 0), b3, ldb2, RbP); GM_STAGE(GM_SB(1, 1), b3 + (size_t)ldb2 * 256, ldb2, RbP); GM_STAGE(GM_SA(1, 0), a3, lda2, R0);
            GM_WAIT_V(8); GM_WAIT_L(0); GM_BAR; GM_MMA(1, 0, At, B0); GM_MMA(1, 1, At, B1); GM_BAR; GM_SCHED;
        }
        if (wr == 0) GM_BAR;
        if (FRESH_WAITS && (cur.kind == K_AB || (cur.kind == K_STORE && cur.sub == 2) || (cur.kind == K_STORE_T && cur.sub == 1))) GM_WAIT_V(0);
#ifdef PROBE_EPI
        const unsigned long long te0_ = __builtin_amdgcn_s_memrealtime();
#endif
        E(acc, cur, wr, wc, fr, fq, lane, (const LAS float*)(lds + STAGE_BYTES + (ui & 1) * 4096), (const LAS float*)(lds + STAGE_BYTES + 8192 + (ui & 1) * 1024));
#ifdef PROBE_EPI
        if (cur.kind == PROBE_EPI) { asm volatile("s_waitcnt vmcnt(0)" ::: "memory"); const unsigned long long t1_ = __builtin_amdgcn_s_memrealtime(); const unsigned long long d_ = t1_ - te0_; while (__builtin_amdgcn_s_memrealtime() - t1_ < d_) __builtin_amdgcn_s_sleep(2); }
#endif
        if (!has_next) break;
#pragma unroll
        for (int a = 0; a < 2; ++a)
#pragma unroll
            for (int b = 0; b < 2; ++b)
#pragma unroll
                for (int m = 0; m < 4; ++m)
#pragma unroll
                    for (int n = 0; n < 2; ++n) acc[a][b][m][n] = (f32x4){0.f, 0.f, 0.f, 0.f};
        cur = nxt; cA = nA; cB = nB; clda = nlda; cldb = nldb; ++ui;
        if (wr == 1) GM_BAR;
    }
    GM_WAIT_V(0);
    GM_BAR;
#undef GM_SA
#undef GM_SB
#undef GM_STAGE
#undef GM_LDA
#undef GM_LDB
#undef GM_MMA
#undef GM_WAIT_V
#undef GM_WAIT_L
#undef GM_BAR
#undef GM_SCHED
}

#if SS_PREFETCH
#define SSROW(pan, r) row_scale_l(ssl, (r))
#else
#define SSROW(pan, r) row_scale((pan) * BM + (r))
#endif
struct Epi {
    unsigned char* ws;
    const float* xin; float* xout;
    bool wout32;
    const float* b_gate;
    const float* gnext;
    const float* gfinal;
    LAS float* spare;
    DI float row_scale(int row) const { const f32x4 s = *(const f32x4*)((const float*)(ws + WS_SS) + (size_t)row * 4); return rsqrtf(((s.x + s.y) + (s.z + s.w)) * (1.0f / 1024.0f) + EPS); }
    static DI float row_scale_l(const LAS float* ssl, int r) { const f32x4 s = *(const LAS f32x4*)(ssl + r * 4); return rsqrtf(((s.x + s.y) + (s.z + s.w)) * (1.0f / 1024.0f) + EPS); }
    DI unsigned char* scratch_tile(int pm, int pn) const { return ws + WS_SCR + (size_t)pm * 256 * SCRLD + pn * 256; }
    DI void operator()(f32x4 (&acc)[2][2][4][2], const Unit& u, int wr, int wc, int fr, int fq, int lane, const LAS float* ssl, const LAS float* bil) const {
        int rl0 = wr * 64 + fr, cl0 = wc * 32 + 8 * fq;
        asm volatile("" : "+v"(rl0), "+v"(cl0));
        if (u.kind == K_STORE) {
            bf16_t* base; int ldc; bool scale = true;
            if (u.sub == 0) {
                if (u.pn < 6) { base = (bf16_t*)(ws + WS_R) + (size_t)u.pm * 256 * RALD + u.pn * 256; ldc = RALD; }
                else { const int pc = u.pn < 8 ? (u.pn - 6) * 256 : (u.pn - 7) * 256; base = (bf16_t*)(ws + WS_P) + (size_t)u.pm * 256 * PLD + pc; ldc = PLD; }
            } else if (u.sub == 1) { base = (bf16_t*)(ws + WS_R) + (size_t)u.pm * 256 * RBLD + u.pn * 256; ldc = RBLD; }
            else { base = (bf16_t*)(ws + WS_KVM) + (size_t)u.l * 1024 * 1024 + (size_t)u.pm * 256 * 256; ldc = 256; scale = false; }
            const bool rope = (u.sub == 0 && u.pn >= 10);
            const float rsc = (u.pn == 11) ? 0.125f : 1.0f;
            const float* rc = (const float*)(ws + WS_ROPE); const int fi = (cl0 & 63) >> 1;
            float scq[2][4];
#pragma unroll
            for (int ai = 0; ai < 2; ++ai)
#pragma unroll
                for (int m = 0; m < 4; ++m) scq[ai][m] = scale ? SSROW(u.pm, rl0 + ai * HALF + m * 16) : 1.0f;
#pragma unroll
            for (int ai = 0; ai < 2; ++ai) {
                f32x4 csq[4], snq[4];
                if (rope) {
#pragma unroll
                    for (int m = 0; m < 4; ++m) { const size_t ro = (size_t)(u.pm * BM + rl0 + ai * HALF + m * 16) * 32 + fi; csq[m] = *(const f32x4*)(rc + ro); snq[m] = *(const f32x4*)(rc + (size_t)T * 32 + ro); }
                }
#pragma unroll
                for (int m = 0; m < 4; ++m) {
                    const int rl = rl0 + ai * HALF + m * 16;
                    const float sc = scq[ai][m];
                    bf16_t* rowp = base + (size_t)rl * ldc + cl0;
                    f32x4 cs4 = {1.f, 1.f, 1.f, 1.f}, sn4 = {0.f, 0.f, 0.f, 0.f};
                    if (rope) { cs4 = csq[m]; sn4 = snq[m]; }
#pragma unroll
                    for (int bj = 0; bj < 2; ++bj) { f32x4 v0 = acc[ai][bj][m][0] * sc, v1 = acc[ai][bj][m][1] * sc;
                        if (rope) { f32x4 r0, r1;
                            r0[0] = (v0[0] * cs4[0] - v0[1] * sn4[0]) * rsc; r0[1] = (v0[0] * sn4[0] + v0[1] * cs4[0]) * rsc; r0[2] = (v0[2] * cs4[1] - v0[3] * sn4[1]) * rsc; r0[3] = (v0[2] * sn4[1] + v0[3] * cs4[1]) * rsc;
                            r1[0] = (v1[0] * cs4[2] - v1[1] * sn4[2]) * rsc; r1[1] = (v1[0] * sn4[2] + v1[1] * cs4[2]) * rsc; r1[2] = (v1[2] * cs4[3] - v1[3] * sn4[3]) * rsc; r1[3] = (v1[2] * sn4[3] + v1[3] * cs4[3]) * rsc;
                            v0 = r0; v1 = r1; }
                        u32x4 w; w.x = pk2(v0[0], v0[1]); w.y = pk2(v0[2], v0[3]); w.z = pk2(v1[0], v1[1]); w.w = pk2(v1[2], v1[3]);
                        *(u32x4*)(rowp + bj * HALF) = w; }
                }
            }
        } else if (u.kind == K_STORE_T) {
            bf16_t* base; const bool scale = (u.sub == 0);
            if (u.sub == 0) base = (bf16_t*)(ws + WS_VTSB) + (size_t)u.pm * 256 * VTLD + u.pn * 256;
            else base = (bf16_t*)(ws + WS_KVM) + (size_t)u.l * 1024 * 1024 + 256 * 2048 + u.pn * 256;
            const int ldc = (u.sub == 0) ? VTLD : 2048;
            f32x4 cs[2][2];
#pragma unroll
            for (int bj = 0; bj < 2; ++bj)
#pragma unroll
                for (int n = 0; n < 2; ++n)
#pragma unroll
                    for (int j = 0; j < 4; ++j) cs[bj][n][j] = scale ? SSROW(u.pn, cl0 + bj * HALF + 4 * n + j) : 1.0f;
#pragma unroll
            for (int ai = 0; ai < 2; ++ai)
#pragma unroll
                for (int m = 0; m < 4; ++m) {
                    const int rl = rl0 + ai * HALF + m * 16;
                    bf16_t* rowp = base + (size_t)rl * ldc + cl0;
#pragma unroll
                    for (int bj = 0; bj < 2; ++bj) { const f32x4 v0 = acc[ai][bj][m][0] * cs[bj][0], v1 = acc[ai][bj][m][1] * cs[bj][1];
                        u32x4 w; w.x = pk2(v0[0], v0[1]); w.y = pk2(v0[2], v0[3]); w.z = pk2(v1[0], v1[1]); w.w = pk2(v1[2], v1[3]);
                        *(u32x4*)(rowp + bj * HALF) = w; }
                }
        } else if (u.kind == K_AB) {
            if (wc == 0 && fq == 0) {
                float* base = (float*)(ws + WS_AB) + (size_t)u.pm * 256 * 8;
#pragma unroll
                for (int ai = 0; ai < 2; ++ai)
#pragma unroll
                    for (int m = 0; m < 4; ++m) {
                        const int rl = rl0 + ai * HALF + m * 16;
                        const float sc = SSROW(u.pm, rl);
                        float* rowp = base + (size_t)rl * 8;
                        *(f32x4*)(rowp) = acc[ai][0][m][0] * sc; *(f32x4*)(rowp + 4) = acc[ai][0][m][1] * sc;
                    }
            }
        } else if (u.kind == K_GATE) {
            unsigned char* base = scratch_tile(u.pm, u.pn);
            const float* bias = b_gate + (size_t)u.l * 4096 + (u.sub & 3) * 1024 + u.pn * 256;
            f32x4 bv[2][2];
#pragma unroll
            for (int bj = 0; bj < 2; ++bj)
#pragma unroll
#if SS_PREFETCH
                for (int n = 0; n < 2; ++n) bv[bj][n] = *(const LAS f32x4*)(bil + cl0 + bj * HALF + 4 * n) * -1.4426950408889634f;
#else
                for (int n = 0; n < 2; ++n) bv[bj][n] = *(const f32x4*)(bias + cl0 + bj * HALF + 4 * n) * -1.4426950408889634f;
#endif
            float scq[2][4];
#pragma unroll
            for (int ai = 0; ai < 2; ++ai)
#pragma unroll
                for (int m = 0; m < 4; ++m) scq[ai][m] = SSROW(u.pm, rl0 + ai * HALF + m * 16) * -1.4426950408889634f;
#pragma unroll
            for (int ai = 0; ai < 2; ++ai)
#pragma unroll
                for (int m = 0; m < 4; ++m) {
                    const int rl = rl0 + ai * HALF + m * 16;
                    const float sc = scq[ai][m];
                    unsigned char* rowp = base + (size_t)rl * SCRLD + cl0;
#pragma unroll
                    for (int bj = 0; bj < 2; ++bj) { const f32x4 v0 = acc[ai][bj][m][0] * sc + bv[bj][0], v1 = acc[ai][bj][m][1] * sc + bv[bj][1];
                        unsigned pa = 0u, pb = 0u;
#define G255(x) __builtin_amdgcn_rcpf(__builtin_amdgcn_exp2f(x) * (1.0f / 255.0f) + (1.0f / 255.0f))
                        pa = __builtin_amdgcn_cvt_pk_u8_f32(G255(v0[0]), 0, pa); pa = __builtin_amdgcn_cvt_pk_u8_f32(G255(v0[1]), 1, pa);
                        pa = __builtin_amdgcn_cvt_pk_u8_f32(G255(v0[2]), 2, pa); pa = __builtin_amdgcn_cvt_pk_u8_f32(G255(v0[3]), 3, pa);
                        pb = __builtin_amdgcn_cvt_pk_u8_f32(G255(v1[0]), 0, pb); pb = __builtin_amdgcn_cvt_pk_u8_f32(G255(v1[1]), 1, pb);
                        pb = __builtin_amdgcn_cvt_pk_u8_f32(G255(v1[2]), 2, pb); pb = __builtin_amdgcn_cvt_pk_u8_f32(G255(v1[3]), 3, pb);
#undef G255
                        EPI_ST((u32x2*)(rowp + bj * HALF), ((u32x2){pa, pb})); }
                }
        } else if (u.kind == K_BRANCH) {
            bf16_t* base = (bf16_t*)(ws + WS_MRG) + (size_t)u.pm * 256 * MRGLD + u.pn * 256; const unsigned char* gbase = scratch_tile(u.pm, u.pn);
            const bool first = (u.sub & 4) != 0;
            const float i255 = 1.0f / 255.0f;
#ifdef BR_ALL_IN_FLIGHT
            u32x2 gq2[2][4][2]; u32x4 tq[2][4][2];
#pragma unroll
            for (int ai = 0; ai < 2; ++ai)
#pragma unroll
                for (int m = 0; m < 4; ++m) { const int rl = rl0 + ai * HALF + m * 16;
#pragma unroll
                    for (int bj = 0; bj < 2; ++bj) { gq2[ai][m][bj] = EPI_LD((const u32x2*)(gbase + (size_t)rl * SCRLD + cl0 + bj * HALF));
                        tq[ai][m][bj] = first ? (u32x4){0u, 0u, 0u, 0u} : EPI_LD((const u32x4*)(base + (size_t)rl * MRGLD + cl0 + bj * HALF)); } }
#pragma unroll
            for (int ai = 0; ai < 2; ++ai) {
#pragma unroll
                for (int m = 0; m < 4; ++m) { const int rl = rl0 + ai * HALF + m * 16;
#pragma unroll
                    for (int bj = 0; bj < 2; ++bj) {
                        const u32x4 t = tq[ai][m][bj]; const f32x4 v0 = acc[ai][bj][m][0], v1 = acc[ai][bj][m][1]; const unsigned ga = gq2[ai][m][bj].x, gb = gq2[ai][m][bj].y;
                        u32x4 w;
                        w.x = pk2(bflo(t.x) + (float)(ga & 0xffu) * v0[0], bfhi(t.x) + (float)((ga >> 8) & 0xffu) * v0[1]);
                        w.y = pk2(bflo(t.y) + (float)((ga >> 16) & 0xffu) * v0[2], bfhi(t.y) + (float)(ga >> 24) * v0[3]);
                        w.z = pk2(bflo(t.z) + (float)(gb & 0xffu) * v1[0], bfhi(t.z) + (float)((gb >> 8) & 0xffu) * v1[1]);
                        w.w = pk2(bflo(t.w) + (float)((gb >> 16) & 0xffu) * v1[2], bfhi(t.w) + (float)(gb >> 24) * v1[3]);
                        EPI_ST((u32x4*)(base + (size_t)rl * MRGLD + cl0 + bj * HALF), w); } }
                asm volatile("" ::: "memory");
            }
#else
#pragma unroll
            for (int ai = 0; ai < 2; ++ai) {
                u32x2 gq2[4][2]; u32x4 tq[4][2];
#pragma unroll
                for (int m = 0; m < 4; ++m) { const int rl = rl0 + ai * HALF + m * 16;
#pragma unroll
                    for (int bj = 0; bj < 2; ++bj) { gq2[m][bj] = EPI_LD((const u32x2*)(gbase + (size_t)rl * SCRLD + cl0 + bj * HALF));
                        tq[m][bj] = first ? (u32x4){0u, 0u, 0u, 0u} : EPI_LD((const u32x4*)(base + (size_t)rl * MRGLD + cl0 + bj * HALF)); } }
#pragma unroll
                for (int m = 0; m < 4; ++m) { const int rl = rl0 + ai * HALF + m * 16;
#pragma unroll
                    for (int bj = 0; bj < 2; ++bj) {
                        const u32x4 t = tq[m][bj]; const f32x4 v0 = acc[ai][bj][m][0], v1 = acc[ai][bj][m][1]; const unsigned ga = gq2[m][bj].x, gb = gq2[m][bj].y;
                        u32x4 w;
                        w.x = pk2(bflo(t.x) + (float)(ga & 0xffu) * v0[0], bfhi(t.x) + (float)((ga >> 8) & 0xffu) * v0[1]);
                        w.y = pk2(bflo(t.y) + (float)((ga >> 16) & 0xffu) * v0[2], bfhi(t.y) + (float)(ga >> 24) * v0[3]);
                        w.z = pk2(bflo(t.z) + (float)(gb & 0xffu) * v1[0], bfhi(t.z) + (float)((gb >> 8) & 0xffu) * v1[1]);
                        w.w = pk2(bflo(t.w) + (float)((gb >> 16) & 0xffu) * v1[2], bfhi(t.w) + (float)(gb >> 24) * v1[3]);
                        EPI_ST((u32x4*)(base + (size_t)rl * MRGLD + cl0 + bj * HALF), w); } }
                asm volatile("" ::: "memory");
            }
#endif
        } else {
            bf16_t* base = (bf16_t*)(ws + WS_XN) + (size_t)u.pm * 256 * 1024 + u.pn * 256;
            const bool wxn = gnext != nullptr, fin = gfinal != nullptr;
            f32x4 gv[2][2];
#pragma unroll
            for (int bj = 0; bj < 2; ++bj)
#pragma unroll
                for (int n = 0; n < 2; ++n) gv[bj][n] = fin ? *(const f32x4*)(gfinal + u.pn * BM + cl0 + bj * HALF + 4 * n) : (f32x4){0.f, 0.f, 0.f, 0.f};
#pragma unroll
            for (int ah = 0; ah < 4; ++ah) {
                const int ai = ah >> 1, m0 = (ah & 1) * 2;
                f32x4 xq[2][2][2];
#pragma unroll
                for (int mm = 0; mm < 2; ++mm) { const size_t goff = (size_t)(u.pm * BM + rl0 + ai * HALF + (m0 + mm) * 16) * D + u.pn * BM + cl0;
#pragma unroll
                    for (int bj = 0; bj < 2; ++bj) {
                        const u32x4 t = *(const u32x4*)(base + (size_t)(rl0 + ai * HALF + (m0 + mm) * 16) * 1024 + cl0 + bj * HALF); (void)goff;
                        xq[mm][bj][0] = (f32x4){bflo(t.x), bfhi(t.x), bflo(t.y), bfhi(t.y)}; xq[mm][bj][1] = (f32x4){bflo(t.z), bfhi(t.z), bflo(t.w), bfhi(t.w)}; } }
#pragma unroll
                for (int mm = 0; mm < 2; ++mm) {
                    const int m = m0 + mm, rl = rl0 + ai * HALF + m * 16;
                    const size_t goff = (size_t)(u.pm * BM + rl) * D + u.pn * BM + cl0;
                    float sq = 0.f;
#pragma unroll
                    for (int bj = 0; bj < 2; ++bj) {
                        const f32x4 v0 = acc[ai][bj][m][0] + xq[mm][bj][0], v1 = acc[ai][bj][m][1] + xq[mm][bj][1];
                        acc[ai][bj][m][0] = v0; acc[ai][bj][m][1] = v1;
                        if (wout32) { *(f32x4*)(xout + goff + bj * HALF) = v0; *(f32x4*)(xout + goff + bj * HALF + 4) = v1; }
                        sq += (v0[0] * v0[0] + v0[1] * v0[1]) + (v0[2] * v0[2] + v0[3] * v0[3]) + (v1[0] * v1[0] + v1[1] * v1[1]) + (v1[2] * v1[2] + v1[3] * v1[3]);
                        if (wxn) { const f32x4 a = v0, b = v1;
                            u32x4 w; w.x = pk2(a[0], a[1]); w.y = pk2(a[2], a[3]); w.z = pk2(b[0], b[1]); w.w = pk2(b[2], b[3]);
                            *(u32x4*)(base + (size_t)rl * 1024 + cl0 + bj * HALF) = w; }
                    }
                    sq += shx(sq, 16, lane); sq += shx(sq, 32, lane);
                    if (fq == 0) spare[rl * 4 + wc] = sq;
                }
                asm volatile("" ::: "memory");
            }
            LDS_WAIT(); __builtin_amdgcn_s_barrier(); asm volatile("" ::: "memory");
            const int t_ = wr * 256 + wc * 64 + lane;
            unsigned* ssw = (unsigned*)(ws + WS_SS);
            if (t_ < 256) { const int rl = t_; const f32x4 p = *(const LAS f32x4*)(spare + rl * 4); const float tot = (p.x + p.y) + (p.z + p.w);
                if (fin) __hip_atomic_store(ssw + (size_t)(u.pm * BM + rl) * 4 + u.pn, __builtin_bit_cast(unsigned, tot), __ATOMIC_RELAXED, __HIP_MEMORY_SCOPE_AGENT);
                else ((float*)ssw)[(size_t)(u.pm * BM + rl) * 4 + u.pn] = tot; }
            if (fin) {
                unsigned* cnt = (unsigned*)(ws + WS_CTL) + CW_PANEL + 64 * u.pm;
                asm volatile("s_waitcnt vmcnt(0)" ::: "memory");
                __builtin_amdgcn_s_barrier(); asm volatile("" ::: "memory");
                if (t_ == 0) {
                    __hip_atomic_fetch_add(cnt, 1u, __ATOMIC_RELAXED, __HIP_MEMORY_SCOPE_AGENT);
                    unsigned sp_ = 0;
                    while (__hip_atomic_load(cnt, __ATOMIC_RELAXED, __HIP_MEMORY_SCOPE_AGENT) < 4u) { __builtin_amdgcn_s_sleep(1); if (++sp_ > (1u << 22)) break; }
                }
                __builtin_amdgcn_s_barrier(); asm volatile("" ::: "memory");
#pragma unroll
                for (int ai = 0; ai < 2; ++ai)
#pragma unroll
                    for (int m = 0; m < 4; ++m) {
                        const int rl = rl0 + ai * HALF + m * 16; const unsigned* sp4 = ssw + (size_t)(u.pm * BM + rl) * 4;
                        const float p0 = __builtin_bit_cast(float, __hip_atomic_load(sp4 + 0, __ATOMIC_RELAXED, __HIP_MEMORY_SCOPE_AGENT)), p1 = __builtin_bit_cast(float, __hip_atomic_load(sp4 + 1, __ATOMIC_RELAXED, __HIP_MEMORY_SCOPE_AGENT));
                        const float p2 = __builtin_bit_cast(float, __hip_atomic_load(sp4 + 2, __ATOMIC_RELAXED, __HIP_MEMORY_SCOPE_AGENT)), p3 = __builtin_bit_cast(float, __hip_atomic_load(sp4 + 3, __ATOMIC_RELAXED, __HIP_MEMORY_SCOPE_AGENT));
                        const float rs = rsqrtf(((p0 + p1) + (p2 + p3)) * (1.0f / 1024.0f) + EPS);
                        const size_t goff = (size_t)(u.pm * BM + rl) * D + u.pn * BM + cl0;
#pragma unroll
                        for (int bj = 0; bj < 2; ++bj) { *(f32x4*)(xout + goff + bj * HALF) = acc[ai][bj][m][0] * rs * gv[bj][0]; *(f32x4*)(xout + goff + bj * HALF + 4) = acc[ai][bj][m][1] * rs * gv[bj][1]; }
                    }
            }
        }
    }
};
}

struct Args {
    const float* x; const float* mem; const int* positions; const float* norm_g; const float* mem_norm_g; const float* w_in; const float* b_gate;
    const float* dn_conv_w; const float* dn_a_log; const float* dn_dt_bias; const float* dn_norm_g; const float* ret_norm_g; const float* w_mem_kv;
    const float* w_br_sb; const float* w_br_dn; const float* w_br_ret; const float* w_br_mem; const float* w_out; const float* final_norm_g;
    float* out; unsigned char* ws; int ph_lo, ph_hi, li, pad;
};
struct Frame { LAS unsigned char* lds; int tid, lane, wave, G, gw, NGW; };
DI Frame mkframe(int wv) {
    extern __shared__ __attribute__((aligned(16))) unsigned char lds_raw[];
    Frame F; F.lds = (LAS unsigned char*)lds_raw; F.tid = opaque_tid(wv); F.lane = F.tid & 63; F.wave = wv;
    F.G = gridDim.x; F.gw = opaque_bid() * NWAVES + F.wave; F.NGW = F.G * NWAVES; return F;
}
typedef const __attribute__((address_space(4))) Args* ArgsP;
DI ArgsP kargs() { unsigned long long p = (unsigned long long)__builtin_amdgcn_kernarg_segment_ptr(); asm volatile("" : "+s"(p)); return (ArgsP)p; }
DI unsigned char* rst_base(ArgsP ap, int l) { return l == 0 ? (unsigned char*)ap->out : ap->ws + WS_WG + (size_t)(l - 1) * 4096 * 1024 * 2; }

struct TItem { const float* W; bf16_t* WT; const float* g; float sc; int K, Nsrc, k0, csrc, rdst, rs; };
DI void titem_load(const TItem& t, int lane, float (&v)[32]) {
#pragma unroll
    for (int i = 0; i < 32; ++i) v[i] = __builtin_nontemporal_load(t.W + (size_t)(t.k0 + 2 * i + (lane >> 5)) * t.Nsrc + t.csrc + (lane & 31));
}
DI void titem_store(LAS float* scr, int lane, const TItem& t, const float (&v)[32]) {
#pragma unroll
    for (int i = 0; i < 32; ++i) scr[(2 * i + (lane >> 5)) * 33 + (lane & 31)] = v[i];
    LDS_WAIT(); asm volatile("" ::: "memory");
    const int c = lane & 7;
    f32x4 g0 = {1.f, 1.f, 1.f, 1.f}, g1 = g0;
    if (t.g != nullptr) { g0 = *(const f32x4*)(t.g + t.k0 + 8 * c); g1 = *(const f32x4*)(t.g + t.k0 + 8 * c + 4); }
    g0 = g0 * t.sc; g1 = g1 * t.sc;
#pragma unroll
    for (int j = 0; j < 4; ++j) { const int n = (lane >> 3) + 8 * j; const LAS float* sp = scr + (8 * c) * 33 + n;
        u32x4 o; o.x = pk2(sp[0 * 33] * g0.x, sp[1 * 33] * g0.y); o.y = pk2(sp[2 * 33] * g0.z, sp[3 * 33] * g0.w); o.z = pk2(sp[4 * 33] * g1.x, sp[5 * 33] * g1.y); o.w = pk2(sp[6 * 33] * g1.z, sp[7 * 33] * g1.w);
        *(u32x4*)(t.WT + (size_t)(t.rdst + n * t.rs) * t.K + t.k0 + 8 * c) = o; }
    LDS_WAIT(); asm volatile("" ::: "memory");
}
DI void memn_rows(const Frame& F, ArgsP ap, int l) {
    unsigned char* ws = ap->ws;
    for (int m = F.gw; m < BATCH * MEMLEN; m += F.NGW) {
        const f32x4* xr = (const f32x4*)(ap->mem + (size_t)m * D) + F.lane; const f32x4* gr = (const f32x4*)(ap->mem_norm_g + (size_t)l * D) + F.lane;
        f32x4 v[4]; float sq = 0.f;
#pragma unroll
        for (int j = 0; j < 4; ++j) { v[j] = xr[64 * j]; sq += (v[j].x * v[j].x + v[j].y * v[j].y) + (v[j].z * v[j].z + v[j].w * v[j].w); }
        const float rs = rsqrtf(wave_sum(sq, F.lane) * (1.f / D) + EPS);
        unsigned long long* o8 = (unsigned long long*)((bf16_t*)(ws + WS_MEMN) + (size_t)m * D) + F.lane;
#pragma unroll
        for (int j = 0; j < 4; ++j) { const f32x4 g = gr[64 * j];
            o8[64 * j] = (unsigned long long)pk2(v[j].x * rs * g.x, v[j].y * rs * g.y) | ((unsigned long long)pk2(v[j].z * rs * g.z, v[j].w * rs * g.w) << 32); }
    }
}
struct TSeg { int src, K, Nsrc, c0, ncols, dst, r0; };
DI void convert_weights(const Frame& F, ArgsP ap, int l, int first, int stride, int part) {
    unsigned char* ws = ap->ws;
    LAS float* scr = (LAS float*)(F.lds + F.wave * 16384);
    constexpr int NSEG = 14;
    const TSeg seg[NSEG] = {
        {0, 1024, IN_COLS, 2048, 2048, 0, 0}, {0, 1024, IN_COLS, 5640, 256, 0, 2304}, {0, 1024, IN_COLS, 4104, 256, 0, 2560}, {0, 1024, IN_COLS, 4360, 256, 0, 2816},
        {0, 1024, IN_COLS, 0, 1024, 1, 0}, {0, 1024, IN_COLS, 1536, 512, 1, 1024}, {0, 1024, IN_COLS, 5128, 512, 1, 1536}, {0, 1024, IN_COLS, 1024, 512, 1, 2048}, {0, 1024, IN_COLS, 4616, 512, 1, 2560},
        {0, 1024, IN_COLS, 5896, 4096, 2, 0},
        {1, 512, 1024, 0, 1024, 3, 0}, {2, 512, 1024, 0, 1024, 3, 1024}, {3, 512, 1024, 0, 1024, 3, 2048}, {5, 1024, 1024, 0, 1024, 4, 0} };
    int cum[NSEG + 1]; cum[0] = 0;
#pragma unroll
    for (int q = 0; q < NSEG; ++q) cum[q + 1] = cum[q] + (seg[q].K / 64) * (seg[q].ncols / 32);
    const int per_layer = cum[NSEG] + (256 / 64) * (1024 / 32) + (1024 / 64) * (512 / 32);
    const int c9 = cum[9], c14m = cum[NSEG] + 128;
    const int n1 = c9 + (per_layer - c14m), n2 = c14m - c9, nit = part == 0 ? per_layer : (part == 1 ? n1 : n2);
    auto params = [&](int it, TItem& t) -> bool {
        if (it >= nit) return false;
        int r = part == 0 ? it : (part == 1 ? (it < c9 ? it : it - c9 + c14m) : it + c9);
        const float* W; int K, Nsrc, c0, ncols, r0; bf16_t* WT; bool perm = false;
        if (r < cum[NSEG]) {
            int q = 0;
#pragma unroll
            for (int qq = 1; qq < NSEG; ++qq) if (r >= cum[qq]) q = qq;
            int src = 0, dst = 0; K = 1024; Nsrc = IN_COLS; c0 = 0; ncols = 32; r0 = 0; int base = 0;
#pragma unroll
            for (int qq = 0; qq < NSEG; ++qq) if (q == qq) { src = seg[qq].src; K = seg[qq].K; Nsrc = seg[qq].Nsrc; c0 = seg[qq].c0; ncols = seg[qq].ncols; dst = seg[qq].dst; r0 = seg[qq].r0; base = cum[qq]; }
            r -= base; perm = (q == 2 || q == 3);
            W = src == 0 ? ap->w_in + (size_t)l * D * IN_COLS : src == 1 ? ap->w_br_sb + (size_t)l * 512 * 1024 : src == 2 ? ap->w_br_dn + (size_t)l * 512 * 1024 : src == 3 ? ap->w_br_ret + (size_t)l * 512 * 1024 : ap->w_out + (size_t)l * 1024 * 1024;
            WT = dst == 0 ? (bf16_t*)(ws + WS_WINA) + (size_t)l * 3072 * 1024 : dst == 1 ? (bf16_t*)(ws + WS_WINB) + (size_t)l * 3072 * 1024 : dst == 2 ? (bf16_t*)(ws + WS_WG) + (size_t)l * 4096 * 1024
               : dst == 3 ? (bf16_t*)(ws + WS_WBR) + (size_t)l * 2 * 1024 * 1024 : (bf16_t*)(ws + WS_WOUT) + (size_t)l * 1024 * 1024;
            if (dst == 3) { WT += (size_t)r0 * 512; r0 = 0; }
        } else if (r < cum[NSEG] + 128) { r -= cum[NSEG]; W = ap->w_br_mem + (size_t)l * 256 * 1024; K = 256; Nsrc = 1024; c0 = 0; ncols = 1024; r0 = 0; WT = (bf16_t*)(ws + WS_WBR) + (size_t)l * 2 * 1024 * 1024 + 3 * 1024 * 512; }
        else { r -= cum[NSEG] + 128; W = ap->w_mem_kv + (size_t)l * 1024 * 512; K = 1024; Nsrc = 512; c0 = 0; ncols = 512; r0 = 0; WT = (bf16_t*)(ws + WS_WKV) + (size_t)l * 512 * 1024; }
        const int nblk = ncols / 32, kb = r / nblk, nb = r % nblk;
        t.W = W; t.WT = WT; t.g = (W == ap->w_in + (size_t)l * D * IN_COLS) ? ap->norm_g + (size_t)l * D : nullptr;
        t.sc = ((unsigned char*)WT >= ws + WS_WBR && (unsigned char*)WT < ws + WS_WOUT) ? (1.0f / 255.0f) : 1.0f;
        t.K = K; t.Nsrc = Nsrc; t.k0 = 64 * kb; t.csrc = c0 + 32 * nb; t.rdst = perm ? r0 + (nb >> 1) * 64 + (nb & 1) : r0 + 32 * nb; t.rs = perm ? 2 : 1;
        return true;
    };
    {
        TItem ta, tb; float va[32], vb[32];
        int it = first;
        bool ha = params(it, ta); if (ha) titem_load(ta, F.lane, va);
        while (ha) {
            it += stride; const bool hb = params(it, tb); if (hb) titem_load(tb, F.lane, vb);
            titem_store(scr, F.lane, ta, va);
            if (!hb) break;
            it += stride; ha = params(it, ta); if (ha) titem_load(ta, F.lane, va);
            titem_store(scr, F.lane, tb, vb);
        }
    }
    if (part != 2) {
        const float* win = ap->w_in + (size_t)l * D * IN_COLS; bf16_t* wa = (bf16_t*)(ws + WS_WINA) + (size_t)l * 3072 * 1024;
        for (int i = first * 64 + F.lane; i < 256 * 1024; i += stride * 64) { const int r = i >> 10, k = i & 1023;
            wa[(size_t)(2048 + r) * 1024 + k] = r < 8 ? (bf16_t)f2bf(win[(size_t)k * IN_COLS + 4096 + r] * ap->norm_g[(size_t)l * D + k]) : (bf16_t)0; }
    }
}
DI void p0_prologue(int wv) {
    const Frame F = mkframe(wv);
    const ArgsP ap = kargs();
    unsigned char* ws = ap->ws;
#ifdef PROBE_PRO
    unsigned long long tq0_ = __builtin_amdgcn_s_memrealtime();
#define PRO_ECHO(k) do { asm volatile("s_waitcnt vmcnt(0)" ::: "memory"); const unsigned long long t1_ = __builtin_amdgcn_s_memrealtime(); if (PROBE_PRO == (k)) { const unsigned long long d_ = t1_ - tq0_; while (__builtin_amdgcn_s_memrealtime() - t1_ < d_) __builtin_amdgcn_s_sleep(2); } tq0_ = __builtin_amdgcn_s_memrealtime(); } while (0)
#else
#define PRO_ECHO(k) do { } while (0)
#endif
    convert_weights(F, ap, 0, F.gw, F.NGW, 1);
    PRO_ECHO(1);
    constexpr int XNR = 4;
    for (int m = XNR * F.gw; m < T; m += XNR * F.NGW) {
        f32x4 v[XNR][4]; const f32x4* gr = (const f32x4*)ap->norm_g + F.lane;
#pragma unroll
        for (int q = 0; q < XNR; ++q)
#pragma unroll
            for (int j = 0; j < 4; ++j) v[q][j] = ((const f32x4*)(ap->x + (size_t)(m + q) * D) + F.lane)[64 * j];
#pragma unroll
        for (int q = 0; q < XNR; ++q) {
            unsigned long long* o8 = (unsigned long long*)((bf16_t*)(ws + WS_XN) + (size_t)(m + q) * D) + F.lane; float sq = 0.f;
#pragma unroll
            for (int j = 0; j < 4; ++j) { const f32x4 x = v[q][j], g = gr[64 * j]; sq += (x.x * x.x + x.y * x.y) + (x.z * x.z + x.w * x.w);
                (void)g; o8[64 * j] = (unsigned long long)pk2(x.x, x.y) | ((unsigned long long)pk2(x.z, x.w) << 32); }
            sq = wave_sum(sq, F.lane);
            if (F.lane == 0) *(f32x4*)((float*)(ws + WS_SS) + (size_t)(m + q) * 4) = (f32x4){sq, 0.f, 0.f, 0.f};
        }
    }
    PRO_ECHO(2);
    memn_rows(F, ap, 0);
    PRO_ECHO(3);
    for (int i = F.gw * 64 + F.lane; i < T * 32; i += F.NGW * 64) {
        const int t = i >> 5, f = i & 31;
        const float inv = exp2f(-(float)f * (13.287712379549449f / 32.0f));
        const float ang = (float)ap->positions[t] * inv;
#ifdef ROPE_FAST_SINCOS
        const float rev = ang * 0.15915494309189535f; const float fr = rev - floorf(rev);
        const float sn = __builtin_amdgcn_sinf(fr), cs = __builtin_amdgcn_cosf(fr);
#else
        float sn, cs; sincosf(ang, &sn, &cs);
#endif
        ((float*)(ws + WS_ROPE))[i] = cs; ((float*)(ws + WS_ROPE))[T * 32 + i] = sn;
    }
}

struct SchedP1 {
    gm::TileOrder ord; unsigned char* ws; int l, half, c; bool with_kvm;
    DI void a_ready(const gm::Unit&, int, int) const {}
    DI bool next(int i, gm::Unit& u) const {
        int pm, pn;
        if (ord.tile(i, pm, pn)) {
            const bf16_t* xn = (const bf16_t*)(ws + WS_XN) + (size_t)pm * 256 * 1024;
            const bf16_t* w = (const bf16_t*)(ws + (half == 0 ? WS_WINA : WS_WINB)) + ((size_t)l * 3072 + pn * 256) * 1024;
            u.lda = 1024; u.K = 1024; u.ldb = 1024; u.l = l; u.sub = half;
            if (half == 1 && pn >= 8) { u.A = w; u.B = xn; u.pm = pn - 8; u.pn = pm; u.kind = gm::K_STORE_T; u.sub = 0; }
            else { u.A = xn; u.B = w; u.pm = pm; u.pn = pn; u.kind = (half == 0 && pn == 8) ? gm::K_AB : gm::K_STORE; }
            return true;
        }
        const int kc = ord.c - (ord.nwg % ord.G);
        if (with_kvm && kc >= 0 && kc < 16 && i == (ord.nwg + ord.G - 1 - ord.c) / ord.G) {
            const int ll = l, ty = (kc >> 3) & 1, idx = kc & 7;
            const bf16_t* mn = (const bf16_t*)(ws + WS_MEMN) + (size_t)(idx * 256) * 1024;
            const bf16_t* w = (const bf16_t*)(ws + WS_WKV) + ((size_t)ll * 512 + ty * 256) * 1024;
            u.lda = 1024; u.K = 1024; u.ldb = 1024; u.l = ll;
            if (ty == 0) { u.A = mn; u.B = w; u.pm = idx; u.pn = 0; u.kind = gm::K_STORE; u.sub = 2; }
            else { u.A = w; u.B = mn; u.pm = 0; u.pn = idx; u.kind = gm::K_STORE_T; u.sub = 1; }
            return true;
        }
        return false;
    }
};
struct SchedP3 {
    int pm, pn, l, rot; bool ok; unsigned char* ws;
    DI void a_ready(const gm::Unit& u, int wid, int lane) const {
        if (u.kind != gm::K_BRANCH || (u.sub & 4) == 0) return;
        if (wid == 0) {
            if (lane == 0) { unsigned* cnt = (unsigned*)(ws + WS_CTL) + CW_READY + 4096 * l + 64 * pm; unsigned sp = 0u;
                while (__hip_atomic_load(cnt, __ATOMIC_RELAXED, __HIP_MEMORY_SCOPE_AGENT) < 16u) { __builtin_amdgcn_s_sleep(2); if (++sp > (1u << 20)) break; } }
            __builtin_amdgcn_fence(__ATOMIC_ACQUIRE, "agent");
            asm volatile("s_waitcnt vmcnt(0)" ::: "memory");
        }
        asm volatile("" ::: "memory"); __builtin_amdgcn_s_barrier(); asm volatile("" ::: "memory");
    }
    DI bool next(int i, gm::Unit& u) const {
        if (!ok || i >= 8) return false;
        const int br = ((i >> 1) + rot) & 3;
        const bf16_t* R = (const bf16_t*)(ws + WS_R); const bf16_t* P = (const bf16_t*)(ws + WS_P);
        u.pm = pm; u.pn = pn; u.sub = br | ((i >> 1) == 0 ? 4 : 0); u.l = l;
        if ((i & 1) == 0) {
            u.A = (const bf16_t*)(ws + WS_XN) + (size_t)pm * 256 * 1024; u.lda = 1024; u.K = 1024; u.ldb = 1024;
            u.B = (const bf16_t*)(ws + WS_WG) + ((size_t)l * 4096 + br * 1024 + pn * 256) * 1024;
            u.kind = gm::K_GATE;
        } else {
            const bf16_t* wbr = (const bf16_t*)(ws + WS_WBR) + (size_t)l * 2 * 1024 * 1024 + (size_t)br * 1024 * 512;
            const int K = br == 3 ? 256 : 512;
            const int acol = br == 0 ? RB_SBQ : (br == 1 ? P_DNZ : (br == 2 ? RB_RTZ : P_MEMQ));
            const bool inP = (br & 1) != 0;
            u.lda = inP ? PLD : RBLD; u.A = (inP ? P : R) + (size_t)pm * 256 * u.lda + acol; u.K = K; u.ldb = K; u.B = wbr + (size_t)pn * 256 * K;
            u.kind = gm::K_BRANCH;
        }
        return true;
    }
};
struct SchedP4 {
    int pm, pn, l; bool ok; unsigned char* ws;
    DI void a_ready(const gm::Unit&, int, int) const {}
    DI bool next(int i, gm::Unit& u) const {
        if (!ok || i >= 1) return false;
        u.A = (const bf16_t*)(ws + WS_MRG) + (size_t)pm * 256 * MRGLD; u.lda = MRGLD; u.K = 1024; u.ldb = 1024;
        u.B = (const bf16_t*)(ws + WS_WOUT) + ((size_t)l * 1024 + pn * 256) * 1024;
        u.pm = pm; u.pn = pn; u.kind = gm::K_OUT; u.sub = 0; u.l = l;
        return true;
    }
};

typedef float f32x16 __attribute__((ext_vector_type(16)));
typedef short s16x4 __attribute__((ext_vector_type(4)));
#define MFMA32(a, b, c) __builtin_amdgcn_mfma_f32_32x32x16_bf16((a), (b), (c), 0, 0, 0)
DI int crow(int reg, int hh) { return (reg & 3) + 8 * (reg >> 2) + 4 * hh; }
DI bf16x8 pack8(float a0, float a1, float a2, float a3, float a4, float a5, float a6, float a7) {
    u32x4 p;
    asm volatile("s_nop 0\n\tv_cvt_pk_bf16_f32 %0, %4, %5\n\tv_cvt_pk_bf16_f32 %1, %6, %7\n\tv_cvt_pk_bf16_f32 %2, %8, %9\n\tv_cvt_pk_bf16_f32 %3, %10, %11\n\ts_nop 1"
                 : "=&v"(p[0]), "=&v"(p[1]), "=&v"(p[2]), "=&v"(p[3]) : "v"(a0), "v"(a1), "v"(a2), "v"(a3), "v"(a4), "v"(a5), "v"(a6), "v"(a7));
    return __builtin_bit_cast(bf16x8, p);
}
DI bf16x8 pack8m(float a0, float a1, float a2, float a3, float a4, float a5, float a6, float a7) {
    u32x4 p;
    asm volatile("s_nop 15\n\ts_nop 3\n\tv_cvt_pk_bf16_f32 %0, %4, %5\n\tv_cvt_pk_bf16_f32 %1, %6, %7\n\tv_cvt_pk_bf16_f32 %2, %8, %9\n\tv_cvt_pk_bf16_f32 %3, %10, %11\n\ts_nop 1"
                 : "=&v"(p[0]), "=&v"(p[1]), "=&v"(p[2]), "=&v"(p[3]) : "v"(a0), "v"(a1), "v"(a2), "v"(a3), "v"(a4), "v"(a5), "v"(a6), "v"(a7));
    return __builtin_bit_cast(bf16x8, p);
}
namespace at {
constexpr int KST = 144, VST = 136;
constexpr int KT_BYTES = 64 * KST;
DI bf16x8 kfrag(LAS unsigned char* kt, int row, int ks, int hh) { return *(const LAS bf16x8*)(kt + row * KST + ks * 32 + hh * 16); }
DI bf16x8 vfrag(LAS unsigned char* vt, int row, int keyoff, int hh) {
    const LAS unsigned char* pp = vt + row * VST + (keyoff + 4 * hh) * 2;
    const u32x2 lo = *(const LAS u32x2*)pp, hi = *(const LAS u32x2*)(pp + 16);
    u32x4 r; r.x = lo.x; r.y = lo.y; r.z = hi.x; r.w = hi.y; return __builtin_bit_cast(bf16x8, r);
}
}

DI void mem_unit(int wv, int l, int unit) {
    const Frame F = mkframe(wv);
    unsigned char* ws = kargs()->ws; bf16_t* P = (bf16_t*)(ws + WS_P);
    const bf16_t* KM = (const bf16_t*)(ws + WS_KVM) + (size_t)l * 1024 * 1024; const bf16_t* VTM = KM + 2048 * 256;
    const int b = unit >> 5, h = (unit >> 3) & 3, qt = unit & 7, lane = F.lane, r = lane & 31, hh = lane >> 5;
    LAS unsigned char* kt = F.lds; LAS unsigned char* vt = F.lds + 256 * at::KST;
    constexpr int VS = 520;
#pragma unroll
    for (int i = 0; i < 4; ++i) { const int id = F.tid + 512 * i, row = id >> 3, ch = id & 7;
        const u32x4 v = *(const u32x4*)(KM + (size_t)(b * 256 + row) * 256 + h * 64 + ch * 8);
        *(LAS u32x4*)(kt + row * at::KST + ch * 16) = v; }
#pragma unroll
    for (int i = 0; i < 4; ++i) { const int id = F.tid + 512 * i, row = id >> 5, ch = id & 31;
        const u32x4 v = *(const u32x4*)(VTM + (size_t)(h * 64 + row) * 2048 + b * 256 + ch * 8);
        *(LAS u32x2*)(vt + row * VS + ch * 16) = (u32x2){v.x, v.y}; *(LAS u32x2*)(vt + row * VS + ch * 16 + 8) = (u32x2){v.z, v.w}; }
    const int t = b * SEQ + qt * 256 + wv * 32 + r;
    bf16_t* qp = P + (size_t)t * PLD + P_MEMQ + h * 64;
    bf16x8 qf[4];
#pragma unroll
    for (int ks = 0; ks < 4; ++ks) qf[ks] = *(const bf16x8*)(qp + 16 * ks + 8 * hh);
    __syncthreads();
    f32x16 z[8];
#pragma unroll
    for (int st = 0; st < 8; ++st) {
        f32x16 a = {0.f, 0.f, 0.f, 0.f, 0.f, 0.f, 0.f, 0.f, 0.f, 0.f, 0.f, 0.f, 0.f, 0.f, 0.f, 0.f};
#pragma unroll
        for (int ks = 0; ks < 4; ++ks) a = MFMA32(at::kfrag(kt, 32 * st + r, ks, hh), qf[ks], a);
        z[st] = a;
    }
    float mx = -3.0e38f;
#pragma unroll
    for (int st = 0; st < 8; ++st)
#pragma unroll
        for (int i = 0; i < 16; ++i) mx = fmaxf(mx, z[st][i]);
    mx = fmaxf(mx, shx(mx, 32, lane));
    const float c2 = 0.125f * 1.4426950408889634f; float sum = 0.f;
#pragma unroll
    for (int st = 0; st < 8; ++st)
#pragma unroll
        for (int i = 0; i < 16; ++i) { const float e = exp2f((z[st][i] - mx) * c2); z[st][i] = e; sum += e; }
    sum += shx(sum, 32, lane);
    f32x16 o0 = {0.f, 0.f, 0.f, 0.f, 0.f, 0.f, 0.f, 0.f, 0.f, 0.f, 0.f, 0.f, 0.f, 0.f, 0.f, 0.f}, o1 = o0;
#pragma unroll
    for (int st = 0; st < 8; ++st)
#pragma unroll
        for (int s2 = 0; s2 < 2; ++s2) {
            const bf16x8 pf = pack8(z[st][8 * s2], z[st][8 * s2 + 1], z[st][8 * s2 + 2], z[st][8 * s2 + 3], z[st][8 * s2 + 4], z[st][8 * s2 + 5], z[st][8 * s2 + 6], z[st][8 * s2 + 7]);
            const int keyoff = 32 * st + 16 * s2;
            { const LAS unsigned char* pp = vt + r * VS + (keyoff + 4 * hh) * 2; const u32x2 lo = *(const LAS u32x2*)pp, hi = *(const LAS u32x2*)(pp + 16);
              u32x4 q; q.x = lo.x; q.y = lo.y; q.z = hi.x; q.w = hi.y; o0 = MFMA32(__builtin_bit_cast(bf16x8, q), pf, o0); }
            { const LAS unsigned char* pp = vt + (32 + r) * VS + (keyoff + 4 * hh) * 2; const u32x2 lo = *(const LAS u32x2*)pp, hi = *(const LAS u32x2*)(pp + 16);
              u32x4 q; q.x = lo.x; q.y = lo.y; q.z = hi.x; q.w = hi.y; o1 = MFMA32(__builtin_bit_cast(bf16x8, q), pf, o1); }
        }
    const float inv = 1.f / sum;
    LAS unsigned char* ob = F.lds + 73728 + wv * (32 * at::KST);
#pragma unroll
    for (int g = 0; g < 4; ++g) {
        *(LAS u32x2*)(ob + r * at::KST + (8 * g + 4 * hh) * 2) = (u32x2){pk2(o0[4 * g] * inv, o0[4 * g + 1] * inv), pk2(o0[4 * g + 2] * inv, o0[4 * g + 3] * inv)};
        *(LAS u32x2*)(ob + r * at::KST + (32 + 8 * g + 4 * hh) * 2) = (u32x2){pk2(o1[4 * g] * inv, o1[4 * g + 1] * inv), pk2(o1[4 * g + 2] * inv, o1[4 * g + 3] * inv)};
    }
#pragma unroll
    for (int k = 0; k < 4; ++k) { const int q = k * 64 + lane, row = q >> 3, pc = q & 7;
        st16_wt(P + (size_t)(t - r + row) * PLD + P_MEMQ + h * 64 + pc * 8, *(const LAS u32x4*)(ob + row * at::KST + pc * 16)); }
    unit_done(ws, l, b * 8 + qt, F.tid);
}

DI void ret_rope_prep(int wv, int c, int n) {
    const Frame F = mkframe(wv);
    unsigned char* ws = kargs()->ws; bf16_t* P = (bf16_t*)(ws + WS_P);
    const float* rc = (const float*)(ws + WS_ROPE); const float* rsn = rc + T * 32;
    for (int it = c * NTHREADS + F.tid; it < T * 32; it += n * NTHREADS) {
        const int t = it >> 5, w = (it >> 4) & 1, h = (it >> 2) & 3, g = it & 3;
        bf16_t* pp = P + (size_t)t * PLD + (w ? P_RTK : P_RTQ) + h * 64 + g * 8;
        const u32x4 a = *(const u32x4*)pp, bq = *(const u32x4*)(pp + 32);
        const f32x4 c0 = *(const f32x4*)(rc + (size_t)t * 32 + g * 8), c1 = *(const f32x4*)(rc + (size_t)t * 32 + g * 8 + 4);
        const f32x4 s0 = *(const f32x4*)(rsn + (size_t)t * 32 + g * 8), s1 = *(const f32x4*)(rsn + (size_t)t * 32 + g * 8 + 4);
        const float sc = w ? 0.125f : 1.0f;
        float x1[8] = {bflo(a.x), bfhi(a.x), bflo(a.y), bfhi(a.y), bflo(a.z), bfhi(a.z), bflo(a.w), bfhi(a.w)};
        float x2[8] = {bflo(bq.x), bfhi(bq.x), bflo(bq.y), bfhi(bq.y), bflo(bq.z), bfhi(bq.z), bflo(bq.w), bfhi(bq.w)};
        float cc[8] = {c0.x, c0.y, c0.z, c0.w, c1.x, c1.y, c1.z, c1.w}, ss[8] = {s0.x, s0.y, s0.z, s0.w, s1.x, s1.y, s1.z, s1.w};
        float y1[8], y2[8];
#pragma unroll
        for (int j = 0; j < 8; ++j) { y1[j] = (x1[j] * cc[j] - x2[j] * ss[j]) * sc; y2[j] = (x1[j] * ss[j] + x2[j] * cc[j]) * sc; }
        *(u32x4*)pp = (u32x4){pk2(y1[0], y1[1]), pk2(y1[2], y1[3]), pk2(y1[4], y1[5]), pk2(y1[6], y1[7])};
        *(u32x4*)(pp + 32) = (u32x4){pk2(y2[0], y2[1]), pk2(y2[2], y2[3]), pk2(y2[4], y2[5]), pk2(y2[6], y2[7])};
    }
}

DI void ret_state_unit(int wv, int l, int unit) {
    const Frame F = mkframe(wv);
    unsigned char* ws = kargs()->ws; const bf16_t* P = (const bf16_t*)(ws + WS_P);
    const int bh = unit / 7, c = unit - 7 * bh, b = bh >> 2, h = bh & 3, lane = F.lane, r = lane & 31, hh = lane >> 5;
    const int s0 = b * SEQ + c * 256;
    const bf16_t* VTg = (const bf16_t*)(ws + WS_VTRT) + (size_t)h * 128 * VTLD + s0;
    const bf16_t* Kg = P + (size_t)s0 * PLD + P_RTK + h * 64;
    constexpr int RS = 528;
    LAS unsigned char* vt = F.lds; LAS unsigned char* kT = F.lds + 128 * RS;
    const float lg = log2f(1.0f - exp2f(-5.0f - (float)h));
    u32x4 vv[8], kv[4];
#pragma unroll
    for (int i = 0; i < 8; ++i) { const int id = F.tid + 512 * i, row = id >> 5, ch = id & 31; vv[i] = *(const u32x4*)(VTg + (size_t)row * VTLD + ch * 8); }
    const int key = F.tid >> 1, chb = (F.tid & 1) * 32;
#pragma unroll
    for (int i = 0; i < 4; ++i) kv[i] = *(const u32x4*)(Kg + (size_t)key * PLD + chb + 8 * i);
#pragma unroll
    for (int i = 0; i < 8; ++i) { const int id = F.tid + 512 * i, row = id >> 5, ch = id & 31; *(LAS u32x4*)(vt + row * RS + ch * 16) = vv[i]; }
    const float fk = exp2f(lg * (float)(255 - key));
#pragma unroll
    for (int i = 0; i < 4; ++i) {
        const unsigned w4[4] = {kv[i].x, kv[i].y, kv[i].z, kv[i].w};
#pragma unroll
        for (int j = 0; j < 4; ++j) { const unsigned u2 = pk2(bflo(w4[j]) * fk, bfhi(w4[j]) * fk);
            LAS unsigned char* wp = kT + (chb + 8 * i + 2 * j) * RS + key * 2;
            *(LAS unsigned short*)wp = (unsigned short)u2; *(LAS unsigned short*)(wp + RS) = (unsigned short)(u2 >> 16); }
    }
    __syncthreads();
    const int d = wv & 3, e = wv >> 2;
    f32x16 acc = {0.f, 0.f, 0.f, 0.f, 0.f, 0.f, 0.f, 0.f, 0.f, 0.f, 0.f, 0.f, 0.f, 0.f, 0.f, 0.f};
#pragma unroll
    for (int sk = 0; sk < 16; ++sk)
        acc = MFMA32(*(const LAS bf16x8*)(vt + (32 * d + r) * RS + (16 * sk + 8 * hh) * 2), *(const LAS bf16x8*)(kT + (32 * e + r) * RS + (16 * sk + 8 * hh) * 2), acc);
    unsigned* Lp = (unsigned*)rst_base(kargs(), l) + (size_t)unit * 8192 + 32 * e + r;
    __builtin_amdgcn_sched_barrier(0); asm volatile("s_nop 15\n\ts_nop 3" ::: "memory"); __builtin_amdgcn_sched_barrier(0);
#pragma unroll
    for (int i = 0; i < 16; ++i) { unsigned* sp_ = Lp + (size_t)(32 * d + crow(i, hh)) * 64; const float av_ = acc[i];
        asm volatile("global_store_dword %0, %1, off sc1" :: "v"(sp_), "v"(av_) : "memory"); }
    VM_WAIT(); lds_barrier();
    if (F.tid == 0) (void)__hip_atomic_fetch_add((unsigned*)(ws + WS_CTL) + CW_RST + 2048 * l + 64 * bh, 1u, __ATOMIC_RELAXED, __HIP_MEMORY_SCOPE_AGENT);
}

template <int MODE>
DI void attn_unit(int wv, int l, int unit) {
    constexpr int DV = MODE == 0 ? 64 : 128, NDT = DV / 32, VST2 = 144, VT_BYTES = DV * VST2, BUF = at::KT_BYTES + VT_BYTES;
    const Frame F = mkframe(wv);
    const ArgsP ap = kargs();
    unsigned char* ws = ap->ws; bf16_t* R = (bf16_t*)(ws + WS_R); bf16_t* P = (bf16_t*)(ws + WS_P);
    const int lane = F.lane, r = lane & 31, hh = lane >> 5, kap = 16 * ((r >> 2) & 1) + (r & 3) + 4 * (r >> 3);
    int b, h, qt;
    if (MODE == 0) { b = unit >> 6; h = (unit >> 3) & 7; qt = unit & 7; } else { qt = unit >> 5; b = (unit >> 2) & 7; h = unit & 3; }
    const int q0 = qt * 256, qw0 = q0 + 32 * wv, tq = qw0 + r, t = b * SEQ + tq;
    const bf16_t* Kg = MODE == 0 ? R + RB_SBK + h * 64 : P + P_RTK + h * 64; const int kld = MODE == 0 ? RBLD : PLD;
    const bf16_t* VTg = (const bf16_t*)(ws + (MODE == 0 ? WS_VTSB : WS_VTRT)) + (size_t)h * DV * VTLD + b * SEQ;
    const bf16_t* qp = MODE == 0 ? R + (size_t)t * RBLD + RB_SBQ + h * 64 : P + (size_t)t * PLD + P_RTQ + h * 64;
    bf16x8 qf[4];
#pragma unroll
    for (int ks = 0; ks < 4; ++ks) qf[ks] = *(const bf16x8*)(qp + 16 * ks + 8 * hh);
    f32x16 o[NDT];
#pragma unroll
    for (int d = 0; d < NDT; ++d) o[d] = (f32x16){0.f, 0.f, 0.f, 0.f, 0.f, 0.f, 0.f, 0.f, 0.f, 0.f, 0.f, 0.f, 0.f, 0.f, 0.f, 0.f};
    volatile LAS unsigned* flags = (volatile LAS unsigned*)(F.lds + 2 * BUF);
    const int jtop = (q0 + 255) >> 6;
    const int srow = F.tid >> 3, sch = F.tid & 7;
    u32x4 kreg, vreg[NDT / 2];
#define AT_LOAD(j) do { const int key0_ = (j) * 64; kreg = *(const u32x4*)(Kg + (size_t)(b * SEQ + key0_ + srow) * kld + sch * 8); \
        _Pragma("unroll") for (int i_ = 0; i_ < NDT / 2; ++i_) vreg[i_] = *(const u32x4*)(VTg + (size_t)(srow + 64 * i_) * VTLD + key0_ + sch * 8); } while (0)
#define AT_WRITE(pbuf) do { LAS unsigned char* kb_ = F.lds + (pbuf) * BUF; *(LAS u32x4*)(kb_ + srow * at::KST + sch * 16) = kreg; \
        _Pragma("unroll") for (int i_ = 0; i_ < NDT / 2; ++i_) *(LAS u32x4*)(kb_ + at::KT_BYTES + (srow + 64 * i_) * VST2 + sch * 16) = vreg[i_]; } while (0)
    AT_LOAD(jtop); AT_WRITE(0);
    lds_barrier();
    float carry = MODE == 0 ? 1.f : 0.f; bool done_w = false;
    const float c2 = 0.125f * 1.4426950408889634f;
    const float lg = MODE == 1 ? log2f(1.0f - exp2f(-5.0f - (float)h)) : 0.f;
    float bfac[16];
#pragma unroll
    for (int i = 0; i < 16; ++i) bfac[i] = MODE == 1 ? exp2f(-lg * (float)i) : 0.f;
    const int jlo = MODE == 1 ? (q0 >> 6) : 0;
    if (MODE == 1 && qt > 0) {
        unsigned* cnt = (unsigned*)(ws + WS_CTL) + CW_RST + 2048 * l + 64 * (b * 4 + h);
        if (wv == 0) {
            if (lane == 0) { unsigned sp = 0u; while (__hip_atomic_load(cnt, __ATOMIC_RELAXED, __HIP_MEMORY_SCOPE_AGENT) < 7u) { __builtin_amdgcn_s_sleep(2); if (++sp > (1u << 20)) break; } }
            __builtin_amdgcn_fence(__ATOMIC_ACQUIRE, "agent");
            asm volatile("s_waitcnt vmcnt(0)" ::: "memory");
        }
        lds_barrier();
        const float* L0 = (const float*)rst_base(ap, l) + (size_t)((b * 4 + h) * 7) * 8192;
        const float g256 = exp2f(lg * 256.0f);
        LAS unsigned char* stI = F.lds + 65536;
#pragma unroll
        for (int k4 = 0; k4 < 4; ++k4) {
            const int e4 = (F.tid + 512 * k4) * 4;
            f32x4 a = {0.f, 0.f, 0.f, 0.f}; float wg = 1.0f;
            for (int c = qt - 1; c >= 0; --c) { const f32x4 x = *(const f32x4*)(L0 + (size_t)c * 8192 + e4);
                a += x * wg; wg *= g256; }
            *(LAS u32x2*)(stI + (e4 >> 6) * 144 + (e4 & 63) * 2) = (u32x2){pk2(a[0], a[1]), pk2(a[2], a[3])};
        }
        lds_barrier();
#pragma unroll
        for (int d = 0; d < NDT; ++d)
#pragma unroll
            for (int ks = 0; ks < 4; ++ks) o[d] = MFMA32(*(const LAS bf16x8*)(stI + (32 * d + r) * 144 + (16 * ks + 8 * hh) * 2), qf[ks], o[d]);
        const float fq = exp2f(lg * (float)(tq - q0 + 1));
#pragma unroll
        for (int d = 0; d < NDT; ++d) o[d] = o[d] * fq;
    }
    for (int j = jtop, it = 0; ; --j, ++it) {
        const int pbuf = it & 1;
        if (j > jlo) AT_LOAD(j - 1);
        LAS unsigned char* kt = F.lds + pbuf * BUF; LAS unsigned char* vt = kt + at::KT_BYTES;
        const int key0 = j * 64;
        if (!done_w) {
#pragma unroll
            for (int sti = 0; sti < 2; ++sti) {
                const int st = 1 - sti, ks0 = key0 + 32 * st;
                if (ks0 <= qw0 + 31 - (MODE == 0 ? 1 : 0)) {
                    const bool full = (ks0 + 31 < qw0);
                    f32x16 z = {0.f, 0.f, 0.f, 0.f, 0.f, 0.f, 0.f, 0.f, 0.f, 0.f, 0.f, 0.f, 0.f, 0.f, 0.f, 0.f};
#pragma unroll
                    for (int ks = 0; ks < 4; ++ks) z = MFMA32(at::kfrag(kt, 32 * st + kap, ks, hh), qf[ks], z);
                    float w[16];
                    const int kb = ks0 + 16 * hh;
                    if (MODE == 0) {
                        float sg[16], sn[16];
#pragma unroll
                        for (int i = 0; i < 16; i += 2) {
                            const f32x2 a2 = (f32x2){z[i], z[i + 1]} * (f32x2){-c2, -c2};
                            const f32x2 d2 = (f32x2){__builtin_amdgcn_exp2f(a2.x), __builtin_amdgcn_exp2f(a2.y)} + (f32x2){1.f, 1.f};
                            const f32x2 r2 = (f32x2){__builtin_amdgcn_rcpf(d2.x), __builtin_amdgcn_rcpf(d2.y)};
                            const f32x2 n2 = (f32x2){1.f, 1.f} - r2;
                            sg[i] = r2.x; sg[i + 1] = r2.y; sn[i] = n2.x; sn[i + 1] = n2.y;
                        }
                        if (!full) {
#pragma unroll
                            for (int i = 0; i < 16; ++i) { const bool m = (kb + i) < tq; sn[i] = m ? sn[i] : 1.f; sg[i] = m ? sg[i] : 0.f; }
                        }
                        float suf[16];
                        suf[15] = 1.f;
#pragma unroll
                        for (int i = 14; i >= 0; --i) suf[i] = suf[i + 1] * sn[i + 1];
                        const float tot = suf[0] * sn[0], totp = shx(tot, 32, lane);
                        const float base = carry * (hh == 0 ? totp : 1.f);
                        carry *= tot * totp;
#pragma unroll
                        for (int i = 0; i < 16; i += 2) { const f32x2 w2 = (f32x2){sg[i], sg[i + 1]} * ((f32x2){suf[i], suf[i + 1]} * (f32x2){base, base}); w[i] = w2.x; w[i + 1] = w2.y; }
                    } else {
                        const float af = __builtin_amdgcn_exp2f(lg * (float)(tq - kb));
                        if (full) {
#pragma unroll
                            for (int i = 0; i < 16; ++i) w[i] = z[i] * (af * bfac[i]);
                        } else {
#pragma unroll
                            for (int i = 0; i < 16; ++i) w[i] = (kb + i <= tq) ? z[i] * (af * bfac[i]) : 0.f;
                        }
                    }
#pragma unroll
                    for (int s2 = 0; s2 < 2; ++s2) {
                        const bf16x8 pf = pack8(w[8 * s2], w[8 * s2 + 1], w[8 * s2 + 2], w[8 * s2 + 3], w[8 * s2 + 4], w[8 * s2 + 5], w[8 * s2 + 6], w[8 * s2 + 7]);
#pragma unroll
                        for (int d = 0; d < NDT; ++d) o[d] = MFMA32(*(const LAS bf16x8*)(vt + (32 * d + r) * VST2 + (32 * st + 16 * hh + 8 * s2) * 2), pf, o[d]);
                    }
                }
            }
            if (MODE == 0) done_w = __all(carry < 1.1754944e-38f);
        }
        if (j > jlo) AT_WRITE(pbuf ^ 1);
        if (MODE == 0 && F.lane == 0) flags[(it & 1) * 8 + wv] = done_w ? 1u : 0u;
        lds_barrier();
        if (j == jlo) break;
        if (MODE == 0) { unsigned all = 1u;
#pragma unroll
            for (int w8 = 0; w8 < 8; ++w8) all &= flags[(it & 1) * 8 + w8];
            if (all) break; }
    }
#undef AT_LOAD
#undef AT_WRITE
    constexpr int OST = DV * 2 + 16, PPR = DV / 8;
    LAS unsigned char* ob = F.lds + wv * (32 * OST);
    if (MODE == 0) {
        bf16_t* op = R + (size_t)t * RBLD + RB_SBQ + h * 64; const bf16_t* zp = R + (size_t)t * RBLD + RB_SBZ + h * 64;
#pragma unroll
        for (int d = 0; d < NDT; ++d)
#pragma unroll
            for (int g = 0; g < 4; ++g) { const int c = 32 * d + 8 * g + 4 * hh; const u32x2 zz = *(const u32x2*)(zp + c);
                *(LAS u32x2*)(ob + r * OST + c * 2) = (u32x2){pk2(o[d][4 * g] * siluf_(bflo(zz.x)), o[d][4 * g + 1] * siluf_(bfhi(zz.x))), pk2(o[d][4 * g + 2] * siluf_(bflo(zz.y)), o[d][4 * g + 3] * siluf_(bfhi(zz.y)))}; }
#pragma unroll
        for (int k = 0; k < 32 * PPR / 64; ++k) { const int q = k * 64 + lane, row = q / PPR, pc = q % PPR;
            st16_wt(op + (ptrdiff_t)(row - r) * RBLD + pc * 8, *(const LAS u32x4*)(ob + row * OST + pc * 16)); }
    } else {
        float s1 = 0.f;
#pragma unroll
        for (int d = 0; d < NDT; ++d)
#pragma unroll
            for (int i = 0; i < 16; ++i) s1 += o[d][i];
        s1 += shx(s1, 32, lane);
        const float mu = s1 * (1.f / 128.f); float s2 = 0.f;
#pragma unroll
        for (int d = 0; d < NDT; ++d)
#pragma unroll
            for (int i = 0; i < 16; ++i) { const float dl = o[d][i] - mu; s2 += dl * dl; }
        s2 += shx(s2, 32, lane);
        const float rs = rsqrtf(s2 * (1.f / 128.f) + EPS);
        bf16_t* zp = R + (size_t)t * RBLD + RB_RTZ + h * 128; const float* gp = ap->ret_norm_g + (size_t)l * 512 + h * 128;
#pragma unroll
        for (int d = 0; d < NDT; ++d)
#pragma unroll
            for (int g = 0; g < 4; ++g) { const int c = 32 * d + 8 * g + 4 * hh; const u32x2 zz = *(const u32x2*)(zp + c); const f32x4 gg = *(const f32x4*)(gp + c);
                *(LAS u32x2*)(ob + r * OST + c * 2) = (u32x2){pk2((o[d][4 * g] - mu) * rs * gg.x * siluf_(bflo(zz.x)), (o[d][4 * g + 1] - mu) * rs * gg.y * siluf_(bfhi(zz.x))),
                                                             pk2((o[d][4 * g + 2] - mu) * rs * gg.z * siluf_(bflo(zz.y)), (o[d][4 * g + 3] - mu) * rs * gg.w * siluf_(bfhi(zz.y)))}; }
#pragma unroll
        for (int k = 0; k < 32 * PPR / 64; ++k) { const int q = k * 64 + lane, row = q / PPR, pc = q % PPR;
            st16_wt(zp + (ptrdiff_t)(row - r) * RBLD + pc * 8, *(const LAS u32x4*)(ob + row * OST + pc * 16)); }
    }
    unit_done(ws, l, b * 8 + qt, F.tid);
}

namespace dn {
constexpr int HC_BYTES = 73728, OFF_W = 0, OFF_QG = 16384, OFF_KD = 32768, OFF_AI = 49152, OFF_U = 57344;
constexpr int QST = 272, TST = 144;
constexpr int GRP_BYTES = 71680, Q_OFF = 0, K_OFF = 17408, KT_OFF = 34816, VT_OFF = 53248, VEC_OFF = 143360, VEC_BYTES = 2048;
}

DI void dn_prep(int wv, int l, int pair) {
    const Frame F = mkframe(wv);
    const ArgsP ap = kargs();
    unsigned char* ws = ap->ws;
    const int lane = F.lane, r = lane & 31, hh = lane >> 5, grp = wv >> 2, gw = wv & 3, gt = F.tid & 255;
    const int hc = pair * 2 + grp, h = hc & 3, bn = hc >> 2, b = bn >> 5, n = bn & 31, t0 = b * SEQ + n * 64;
    LAS unsigned char* gb = F.lds + grp * dn::GRP_BYTES;
    LAS unsigned char* qimg = gb + dn::Q_OFF; LAS unsigned char* kimg = gb + dn::K_OFF; LAS unsigned char* ktimg = gb + dn::KT_OFF; LAS unsigned char* vtimg = gb + dn::VT_OFF;
    LAS float* vec = (LAS float*)(F.lds + dn::VEC_OFF + grp * dn::VEC_BYTES);
    LAS float* gcv = vec; LAS float* btv = vec + 64; LAS float* f1v = vec + 128; LAS float* f2v = vec + 192; LAS float* egv = vec + 256;
    unsigned char* blk = ws + WS_DNI + (size_t)hc * dn::HC_BYTES;
    const bf16_t* RA = (const bf16_t*)(ws + WS_R); const float* cw = ap->dn_conv_w + (size_t)l * 4 * 1536; const float* AB = (const float*)(ws + WS_AB);
#ifdef PROBE_PREP
    unsigned long long tp0_ = __builtin_amdgcn_s_memrealtime();
#endif
    {
        const int g8 = gt & 15, ch = g8 * 8;
        float abA[4], abB[4];
#pragma unroll
        for (int k = 0; k < 4; ++k) { const int t = t0 + (gt >> 4) + 16 * k; abA[k] = AB[(size_t)t * 8 + h]; abB[k] = AB[(size_t)t * 8 + 4 + h]; }
        const float dtb = ap->dn_dt_bias[l * 4 + h], nalog = -__expf(ap->dn_a_log[l * 4 + h]);
        u32x4 xs[2][2][4]; f32x4 wj[4][2];
#define DNP_LOADX(st_, set_) do { const int col_ = ((st_) >> 1) * 512 + h * 128 + ch; \
        _Pragma("unroll") for (int kk_ = 0; kk_ < 2; ++kk_) _Pragma("unroll") for (int j_ = 0; j_ < 4; ++j_) { const int m_ = (gt >> 4) + 16 * (2 * ((st_) & 1) + kk_); \
            xs[set_][kk_][j_] = (n * 64 + m_ - 3 + j_ >= 0) ? *(const u32x4*)(RA + (size_t)(t0 + m_ - 3 + j_) * RALD + col_) : (u32x4){0u, 0u, 0u, 0u}; } } while (0)
        DNP_LOADX(0, 0);
#pragma unroll
        for (int st = 0; st < 6; ++st) {
            const int part = st >> 1, col = part * 512 + h * 128 + ch;
            if ((st & 1) == 0) {
#pragma unroll
                for (int j = 0; j < 4; ++j) { wj[j][0] = *(const f32x4*)(cw + j * 1536 + col); wj[j][1] = *(const f32x4*)(cw + j * 1536 + col + 4); } }
            if (st < 5) DNP_LOADX(st + 1, (st + 1) & 1);
#pragma unroll
            for (int kk = 0; kk < 2; ++kk) {
                const int m = (gt >> 4) + 16 * (2 * (st & 1) + kk), t = t0 + m;
                float a[8] = {0.f, 0.f, 0.f, 0.f, 0.f, 0.f, 0.f, 0.f};
#pragma unroll
                for (int j = 0; j < 4; ++j) { const u32x4 x = xs[st & 1][kk][j];
                    a[0] += wj[j][0].x * bflo(x.x); a[1] += wj[j][0].y * bfhi(x.x); a[2] += wj[j][0].z * bflo(x.y); a[3] += wj[j][0].w * bfhi(x.y);
                    a[4] += wj[j][1].x * bflo(x.z); a[5] += wj[j][1].y * bfhi(x.z); a[6] += wj[j][1].z * bflo(x.w); a[7] += wj[j][1].w * bfhi(x.w);
                }
                float ssq = 0.f;
#pragma unroll
                for (int i = 0; i < 8; ++i) { a[i] = siluf_(a[i]); ssq += a[i] * a[i]; }
                if (part < 2) {
                    ssq = sum16(ssq);
                    const float rn = rsqrtf(ssq + EPS);
#pragma unroll
                    for (int i = 0; i < 8; ++i) a[i] *= rn;
                } else {
                    const float beta = sigmoidf_(abB[2 * (st & 1) + kk]);
#pragma unroll
                    for (int i = 0; i < 8; ++i) a[i] *= beta;
                }
                const u32x4 pk = (u32x4){pk2(a[0], a[1]), pk2(a[2], a[3]), pk2(a[4], a[5]), pk2(a[6], a[7])};
                if (part == 0) {
                    *(LAS u32x4*)(qimg + m * dn::QST + ch * 2) = pk;
                    if (g8 == 0) { const float xa = abA[2 * (st & 1) + kk] + dtb; const float sp = xa > 20.f ? xa : log1pf(__expf(xa));
                        gcv[m] = nalog * sp; btv[m] = sigmoidf_(abB[2 * (st & 1) + kk]); }
                } else {
                    if (part == 1) *(LAS u32x4*)(kimg + m * dn::QST + ch * 2) = pk;
                    LAS unsigned char* timg = (part == 1 ? ktimg : vtimg) + (((m >> 3) ^ (g8 & 7)) * 16) + (m & 7) * 2;
                    *(LAS unsigned short*)(timg + (ch + 0) * dn::TST) = (unsigned short)pk.x; *(LAS unsigned short*)(timg + (ch + 1) * dn::TST) = (unsigned short)(pk.x >> 16);
                    *(LAS unsigned short*)(timg + (ch + 2) * dn::TST) = (unsigned short)pk.y; *(LAS unsigned short*)(timg + (ch + 3) * dn::TST) = (unsigned short)(pk.y >> 16);
                    *(LAS unsigned short*)(timg + (ch + 4) * dn::TST) = (unsigned short)pk.z; *(LAS unsigned short*)(timg + (ch + 5) * dn::TST) = (unsigned short)(pk.z >> 16);
                    *(LAS unsigned short*)(timg + (ch + 6) * dn::TST) = (unsigned short)pk.w; *(LAS unsigned short*)(timg + (ch + 7) * dn::TST) = (unsigned short)(pk.w >> 16);
                }
            }
        }
#undef DNP_LOADX
    }
    lds_barrier();
#ifdef PROBE_PREP
    if (PROBE_PREP == 1) { const unsigned long long t1_ = __builtin_amdgcn_s_memrealtime(); const unsigned long long d_ = t1_ - tp0_; while (__builtin_amdgcn_s_memrealtime() - t1_ < d_) __builtin_amdgcn_s_sleep(2); }
    tp0_ = __builtin_amdgcn_s_memrealtime();
#endif
    if (gw == 0) {
        float gc = gcv[lane];
#pragma unroll
        for (int off = 1; off < 64; off <<= 1) { const float o = shx(gc, 0, lane - off < 0 ? lane : lane - off) ; gc += (lane >= off) ? o : 0.f; }
        const float glast = shx(gc, 0, 63);
        const float eg = __expf(gc);
        gcv[lane] = gc; f1v[lane] = btv[lane] * eg; f2v[lane] = __expf(glast - gc); egv[lane] = eg * 0.08838834764831845f;
        if (lane == 0) ((float*)(ws + WS_GB))[hc] = __expf(glast);
    }
    lds_barrier();
    f32x16 Lt = {0.f, 0.f, 0.f, 0.f, 0.f, 0.f, 0.f, 0.f, 0.f, 0.f, 0.f, 0.f, 0.f, 0.f, 0.f, 0.f};
    if (gw < 3) {
        {
            const int ct = gw == 0 ? 0 : 1, mt = gw == 2 ? 1 : 0;
            f32x16 acc = {0.f, 0.f, 0.f, 0.f, 0.f, 0.f, 0.f, 0.f, 0.f, 0.f, 0.f, 0.f, 0.f, 0.f, 0.f, 0.f};
#pragma unroll
            for (int ks = 0; ks < 8; ++ks) acc = MFMA32(*(const LAS bf16x8*)(kimg + (32 * ct + r) * dn::QST + ks * 32 + hh * 16), *(const LAS bf16x8*)(kimg + (32 * mt + r) * dn::QST + ks * 32 + hh * 16), acc);
            const int m = 32 * mt + r; const float gm = gcv[m];
#pragma unroll
            for (int i = 0; i < 16; ++i) { const int c = 32 * ct + crow(i, hh); Lt[i] = (m < c) ? acc[i] * btv[c] * __expf(gcv[c] - gm) : 0.f; }
        }
        {
            const int mt = gw == 2 ? 1 : 0, ct = gw == 0 ? 0 : 1;
            f32x16 acc = {0.f, 0.f, 0.f, 0.f, 0.f, 0.f, 0.f, 0.f, 0.f, 0.f, 0.f, 0.f, 0.f, 0.f, 0.f, 0.f};
#pragma unroll
            for (int ks = 0; ks < 8; ++ks) acc = MFMA32(*(const LAS bf16x8*)(kimg + (32 * mt + r) * dn::QST + ks * 32 + hh * 16), *(const LAS bf16x8*)(qimg + (32 * ct + r) * dn::QST + ks * 32 + hh * 16), acc);
            const int c = 32 * ct + r; const float gcc = gcv[c]; float v[16];
#pragma unroll
            for (int i = 0; i < 16; ++i) { const int m = 32 * mt + crow(i, hh); v[i] = (m <= c) ? acc[i] * __expf(gcc - gcv[m]) * 0.08838834764831845f : 0.f; }
#pragma unroll
            for (int s2 = 0; s2 < 2; ++s2) *(bf16x8*)(blk + dn::OFF_AI + ((ct * 2 + mt) * 2 + s2) * 1024 + lane * 16) = pack8(v[8 * s2], v[8 * s2 + 1], v[8 * s2 + 2], v[8 * s2 + 3], v[8 * s2 + 4], v[8 * s2 + 5], v[8 * s2 + 6], v[8 * s2 + 7]);
        }
    } else {
#pragma unroll 1
        for (int f = 0; f < 16; ++f) { const int ct = f >> 3, tau = (f >> 1) & 3, s2 = f & 1, c = 32 * ct + r; const float e = egv[c];
            const LAS unsigned char* pp = qimg + c * dn::QST + (32 * tau + 16 * s2 + 4 * hh) * 2; const u32x2 lo = *(const LAS u32x2*)pp, hi = *(const LAS u32x2*)(pp + 16);
            *(bf16x8*)(blk + dn::OFF_QG + f * 1024 + lane * 16) = pack8(bflo(lo.x) * e, bfhi(lo.x) * e, bflo(lo.y) * e, bfhi(lo.y) * e, bflo(hi.x) * e, bfhi(hi.x) * e, bflo(hi.y) * e, bfhi(hi.y) * e); }
#pragma unroll 1
        for (int f = 0; f < 16; ++f) { const int tau = f >> 2, m0 = 32 * ((f >> 1) & 1) + 16 * (f & 1) + 4 * hh;
            const int sw = (4 * tau + (r >> 3)) & 7; const LAS unsigned char* rowp = ktimg + (32 * tau + r) * dn::TST + (m0 & 7) * 2;
            const u32x2 lo = *(const LAS u32x2*)(rowp + (((m0 >> 3) ^ sw) * 16)), hi = *(const LAS u32x2*)(rowp + ((((m0 >> 3) + 1) ^ sw) * 16));
            const f32x4 fa = *(const LAS f32x4*)(f2v + m0), fb = *(const LAS f32x4*)(f2v + m0 + 8);
            *(bf16x8*)(blk + dn::OFF_KD + f * 1024 + lane * 16) = pack8(bflo(lo.x) * fa.x, bfhi(lo.x) * fa.y, bflo(lo.y) * fa.z, bfhi(lo.y) * fa.w, bflo(hi.x) * fb.x, bfhi(hi.x) * fb.y, bflo(hi.y) * fb.z, bfhi(hi.y) * fb.w); }
    }
    lds_barrier();
    LAS float* Lm = (LAS float*)qimg;
    if (gw < 3) { const int ct = gw == 0 ? 0 : 1, mt = gw == 2 ? 1 : 0;
#pragma unroll
        for (int i = 0; i < 16; ++i) Lm[(32 * ct + crow(i, hh)) * 64 + 32 * mt + r] = Lt[i]; }
    lds_barrier();
#ifdef PROBE_PREP
    if (PROBE_PREP == 2) { const unsigned long long t1_ = __builtin_amdgcn_s_memrealtime(); const unsigned long long d_ = t1_ - tp0_; while (__builtin_amdgcn_s_memrealtime() - t1_ < d_) __builtin_amdgcn_s_sleep(2); }
    tp0_ = __builtin_amdgcn_s_memrealtime();
#endif
    if (gw == 0) {
        const LAS float* Lb = Lm + (32 * hh) * 64 + 32 * hh;
        const int jc = lane & 31;
        float Tc[32];
#pragma unroll
        for (int i = 0; i < 32; ++i) {
            float a0 = (i == jc) ? 1.f : 0.f, a1 = 0.f, a2 = 0.f, a3 = 0.f;
#pragma unroll
            for (int k4 = 0; k4 < (i + 3) / 4; ++k4) { const f32x4 lv = *(const LAS f32x4*)(Lb + i * 64 + 4 * k4);
                if (4 * k4 + 0 < i) a0 -= lv.x * Tc[4 * k4 + 0]; if (4 * k4 + 1 < i) a1 -= lv.y * Tc[4 * k4 + 1];
                if (4 * k4 + 2 < i) a2 -= lv.z * Tc[4 * k4 + 2]; if (4 * k4 + 3 < i) a3 -= lv.w * Tc[4 * k4 + 3]; }
            Tc[i] = (a0 + a1) + (a2 + a3);
        }
        LDS_WAIT(); asm volatile("" ::: "memory");
        LAS unsigned char* timg = kimg; LAS unsigned char* t00t = kimg + 64 * dn::TST;
#pragma unroll
        for (int i = 0; i < 32; ++i) *(LAS unsigned short*)(timg + (32 * hh + i) * dn::TST + (32 * hh + jc) * 2) = (unsigned short)f2bf(Tc[i]);
        if (hh == 0) {
#pragma unroll
            for (int q = 0; q < 4; ++q) { *(LAS u32x4*)(t00t + jc * 80 + 16 * q) = (u32x4){pk2(Tc[8 * q], Tc[8 * q + 1]), pk2(Tc[8 * q + 2], Tc[8 * q + 3]), pk2(Tc[8 * q + 4], Tc[8 * q + 5]), pk2(Tc[8 * q + 6], Tc[8 * q + 7])};
                *(LAS u32x4*)(timg + jc * dn::TST + 64 + 16 * q) = (u32x4){0u, 0u, 0u, 0u}; }
        }
        LDS_WAIT(); asm volatile("" ::: "memory");
        f32x16 X = {0.f, 0.f, 0.f, 0.f, 0.f, 0.f, 0.f, 0.f, 0.f, 0.f, 0.f, 0.f, 0.f, 0.f, 0.f, 0.f};
#pragma unroll
        for (int s2 = 0; s2 < 2; ++s2) { const f32x4 la = *(const LAS f32x4*)(Lm + (32 + r) * 64 + 16 * s2 + 8 * hh), lb = *(const LAS f32x4*)(Lm + (32 + r) * 64 + 16 * s2 + 8 * hh + 4);
            X = MFMA32(pack8(la.x, la.y, la.z, la.w, lb.x, lb.y, lb.z, lb.w), *(const LAS bf16x8*)(t00t + r * 80 + (16 * s2 + 8 * hh) * 2), X); }
        f32x16 Y = {0.f, 0.f, 0.f, 0.f, 0.f, 0.f, 0.f, 0.f, 0.f, 0.f, 0.f, 0.f, 0.f, 0.f, 0.f, 0.f};
#pragma unroll
        for (int s2 = 0; s2 < 2; ++s2) { const LAS unsigned char* pp = timg + (32 + r) * dn::TST + (32 + 16 * s2 + 4 * hh) * 2; const u32x2 lo = *(const LAS u32x2*)pp, hi = *(const LAS u32x2*)(pp + 16);
            u32x4 af; af.x = lo.x; af.y = lo.y; af.z = hi.x; af.w = hi.y;
            Y = MFMA32(__builtin_bit_cast(bf16x8, af), pack8m(X[8 * s2], X[8 * s2 + 1], X[8 * s2 + 2], X[8 * s2 + 3], X[8 * s2 + 4], X[8 * s2 + 5], X[8 * s2 + 6], X[8 * s2 + 7]), Y); }
#pragma unroll
        for (int i = 0; i < 16; ++i) *(LAS unsigned short*)(timg + (32 + crow(i, hh)) * dn::TST + r * 2) = (unsigned short)f2bf(-Y[i]);
    }
    lds_barrier();
#ifdef PROBE_PREP
    if (PROBE_PREP == 3) { const unsigned long long t1_ = __builtin_amdgcn_s_memrealtime(); const unsigned long long d_ = t1_ - tp0_; while (__builtin_amdgcn_s_memrealtime() - t1_ < d_) __builtin_amdgcn_s_sleep(2); }
    tp0_ = __builtin_amdgcn_s_memrealtime();
#endif
    {
        LAS unsigned char* timg = kimg;
        bf16x8 afr[4];
#pragma unroll
        for (int s4 = 0; s4 < 4; ++s4) { const u32x4 x = *(const LAS u32x4*)(ktimg + (32 * gw + r) * dn::TST + (((2 * s4 + hh) ^ ((4 * gw + (r >> 3)) & 7)) * 16));
            const f32x4 fa = *(const LAS f32x4*)(f1v + 16 * s4 + 8 * hh), fb = *(const LAS f32x4*)(f1v + 16 * s4 + 8 * hh + 4);
            afr[s4] = pack8(-bflo(x.x) * fa.x, -bfhi(x.x) * fa.y, -bflo(x.y) * fa.z, -bfhi(x.y) * fa.w, -bflo(x.z) * fb.x, -bfhi(x.z) * fb.y, -bflo(x.w) * fb.z, -bfhi(x.w) * fb.w); }
#pragma unroll
        for (int ct = 0; ct < 2; ++ct) {
            f32x16 acc = {0.f, 0.f, 0.f, 0.f, 0.f, 0.f, 0.f, 0.f, 0.f, 0.f, 0.f, 0.f, 0.f, 0.f, 0.f, 0.f};
#pragma unroll
            for (int s4 = 0; s4 < 4; ++s4) acc = MFMA32(afr[s4], *(const LAS bf16x8*)(timg + (32 * ct + r) * dn::TST + s4 * 32 + hh * 16), acc);
#pragma unroll
            for (int s2 = 0; s2 < 2; ++s2) *(bf16x8*)(blk + dn::OFF_W + ((ct * 4 + gw) * 2 + s2) * 1024 + lane * 16) = pack8m(acc[8 * s2], acc[8 * s2 + 1], acc[8 * s2 + 2], acc[8 * s2 + 3], acc[8 * s2 + 4], acc[8 * s2 + 5], acc[8 * s2 + 6], acc[8 * s2 + 7]);
        }
#pragma unroll
        for (int ct = 0; ct < 2; ++ct) {
            f32x16 acc = {0.f, 0.f, 0.f, 0.f, 0.f, 0.f, 0.f, 0.f, 0.f, 0.f, 0.f, 0.f, 0.f, 0.f, 0.f, 0.f};
#pragma unroll
            for (int s4 = 0; s4 < 4; ++s4) acc = MFMA32(*(const LAS bf16x8*)(timg + (32 * ct + r) * dn::TST + s4 * 32 + hh * 16), *(const LAS bf16x8*)(vtimg + (32 * gw + r) * dn::TST + (((2 * s4 + hh) ^ ((4 * gw + (r >> 3)) & 7)) * 16)), acc);
#pragma unroll
            for (int s2 = 0; s2 < 2; ++s2) *(bf16x8*)(blk + dn::OFF_U + ((ct * 4 + gw) * 2 + s2) * 1024 + lane * 16) = pack8m(acc[8 * s2], acc[8 * s2 + 1], acc[8 * s2 + 2], acc[8 * s2 + 3], acc[8 * s2 + 4], acc[8 * s2 + 5], acc[8 * s2 + 6], acc[8 * s2 + 7]);
        }
    }
    lds_barrier();
}

DI void dn_scan(int wv, int l, int bh) {
    const Frame F = mkframe(wv);
    const ArgsP ap = kargs();
    unsigned char* ws = ap->ws; bf16_t* P = (bf16_t*)(ws + WS_P);
    const int lane = F.lane, hh = lane >> 5, b = bh >> 2, h = bh & 3, w4 = wv & 3;
    LAS float* part = (LAS float*)(F.lds + 2 * dn::HC_BYTES);
    LAS float* gnl = part + 512;
    LAS float* decs = gnl + 128;
    if (F.tid < 128) gnl[F.tid] = ap->dn_norm_g[l * 128 + F.tid];
    if (F.tid < 32) decs[F.tid] = ((const float*)(ws + WS_GB))[(size_t)(b * 32 + F.tid) * 4 + h];
    const size_t hc_stride = 4 * (size_t)dn::HC_BYTES;
    const unsigned char* blk0 = ws + WS_DNI + ((size_t)(b * 32) * 4 + h) * dn::HC_BYTES;
#define DN_PIECE(src_, pbuf, pc_) __builtin_amdgcn_global_load_lds((const unsigned*)((src_) + (pc_) * 1024 + lane * 16), (LAS unsigned*)(F.lds + (pbuf) * dn::HC_BYTES + (pc_) * 1024), 16, 0, 0)
#define DN_LOAD(nn, pbuf) do { const unsigned char* src_ = blk0 + (size_t)(nn) * hc_stride; \
        if (wv < 4) { _Pragma("unroll") for (int i_ = 0; i_ < 9; ++i_) DN_PIECE(src_, pbuf, wv * 9 + i_); } \
        else { _Pragma("unroll") for (int i_ = 0; i_ < 5; ++i_) DN_PIECE(src_, pbuf, 36 + 5 * w4 + i_); \
               DN_PIECE(src_, pbuf, 56 + 2 * w4); DN_PIECE(src_, pbuf, 57 + 2 * w4); DN_PIECE(src_, pbuf, 64 + 2 * w4); DN_PIECE(src_, pbuf, 65 + 2 * w4); } } while (0)
    DN_LOAD(0, 0);
    f32x16 S[4];
#pragma unroll
    for (int i = 0; i < 4; ++i) S[i] = (f32x16){0.f, 0.f, 0.f, 0.f, 0.f, 0.f, 0.f, 0.f, 0.f, 0.f, 0.f, 0.f, 0.f, 0.f, 0.f, 0.f};
    u32x4 heldO[4], zO[4];
#pragma unroll
    for (int i = 0; i < 4; ++i) { heldO[i] = (u32x4){0u, 0u, 0u, 0u}; zO[i] = heldO[i]; }
    VM_WAIT(); __syncthreads();
    if (wv < 4) {
    for (int k = 0; k < 34; ++k) {
        const int pbuf = k & 1;
#ifdef PROBE_SCANC
        const unsigned long long tc0_ = __builtin_amdgcn_s_memrealtime();
#endif
        LAS unsigned char* buf = F.lds + pbuf * dn::HC_BYTES;
        {
            if (k + 1 < 32) DN_LOAD(k + 1, pbuf ^ 1);
            if (k < 32) {
                const float dec = decs[k];
                f32x16 vn[2], o[2];
#pragma unroll
                for (int ct = 0; ct < 2; ++ct) {
                    o[ct] = (f32x16){0.f, 0.f, 0.f, 0.f, 0.f, 0.f, 0.f, 0.f, 0.f, 0.f, 0.f, 0.f, 0.f, 0.f, 0.f, 0.f};
#pragma unroll
                    for (int s2 = 0; s2 < 2; ++s2) { const u32x4 x = *(const LAS u32x4*)(buf + dn::OFF_U + ((ct * 4 + wv) * 2 + s2) * 1024 + lane * 16);
                        vn[ct][8 * s2] = bflo(x.x); vn[ct][8 * s2 + 1] = bfhi(x.x); vn[ct][8 * s2 + 2] = bflo(x.y); vn[ct][8 * s2 + 3] = bfhi(x.y);
                        vn[ct][8 * s2 + 4] = bflo(x.z); vn[ct][8 * s2 + 5] = bfhi(x.z); vn[ct][8 * s2 + 6] = bflo(x.w); vn[ct][8 * s2 + 7] = bfhi(x.w); }
                }
#define DN_F(off) (*(const LAS bf16x8*)(buf + (off) + lane * 16))
#define DN_WQ(ct, st) ((((ct) * 4 + ((st) >> 1)) * 2 + ((st) & 1)) * 1024)
                bf16x8 fa[4], fb[6];
                fa[0] = DN_F(dn::OFF_W + DN_WQ(0, 0)); fa[1] = DN_F(dn::OFF_QG + DN_WQ(0, 0)); fa[2] = DN_F(dn::OFF_W + DN_WQ(1, 0)); fa[3] = DN_F(dn::OFF_QG + DN_WQ(1, 0));
#pragma unroll
                for (int st = 0; st < 8; ++st) {
                    const int tau = st >> 1, s2 = st & 1;
                    if (st < 7) { fb[0] = DN_F(dn::OFF_W + DN_WQ(0, st + 1)); fb[1] = DN_F(dn::OFF_QG + DN_WQ(0, st + 1)); fb[2] = DN_F(dn::OFF_W + DN_WQ(1, st + 1)); fb[3] = DN_F(dn::OFF_QG + DN_WQ(1, st + 1)); }
                    else { fb[0] = DN_F(dn::OFF_AI + 0 * 1024); fb[1] = DN_F(dn::OFF_AI + 4 * 1024); fb[2] = DN_F(dn::OFF_KD + 0 * 1024); fb[3] = DN_F(dn::OFF_KD + 4 * 1024); fb[4] = DN_F(dn::OFF_KD + 8 * 1024); fb[5] = DN_F(dn::OFF_KD + 12 * 1024); }
                    __builtin_amdgcn_sched_barrier(0);
                    const bf16x8 sf = pack8m(S[tau][8 * s2], S[tau][8 * s2 + 1], S[tau][8 * s2 + 2], S[tau][8 * s2 + 3], S[tau][8 * s2 + 4], S[tau][8 * s2 + 5], S[tau][8 * s2 + 6], S[tau][8 * s2 + 7]);
                    vn[0] = MFMA32(fa[0], sf, vn[0]); o[0] = MFMA32(fa[1], sf, o[0]); vn[1] = MFMA32(fa[2], sf, vn[1]); o[1] = MFMA32(fa[3], sf, o[1]);
                    __builtin_amdgcn_sched_barrier(0);
                    if (st < 7) { fa[0] = fb[0]; fa[1] = fb[1]; fa[2] = fb[2]; fa[3] = fb[3]; }
                }
#pragma unroll
                for (int tau = 0; tau < 4; ++tau) S[tau] = S[tau] * dec;
                bf16x8 fc[6];
#pragma unroll
                for (int g = 0; g < 4; ++g) {
                    const int cm = g >> 1, s2 = g & 1;
                    if (g < 3) { const int cm1 = (g + 1) >> 1, s21 = (g + 1) & 1;
                        fc[0] = DN_F(dn::OFF_AI + ((cm1 * 2 + cm1) * 2 + s21) * 1024); fc[1] = DN_F(dn::OFF_AI + ((1 * 2 + cm1) * 2 + s21) * 1024);
#pragma unroll
                        for (int tau = 0; tau < 4; ++tau) fc[2 + tau] = DN_F(dn::OFF_KD + ((tau * 2 + cm1) * 2 + s21) * 1024); }
                    __builtin_amdgcn_sched_barrier(0);
                    const bf16x8 vf = pack8m(vn[cm][8 * s2], vn[cm][8 * s2 + 1], vn[cm][8 * s2 + 2], vn[cm][8 * s2 + 3], vn[cm][8 * s2 + 4], vn[cm][8 * s2 + 5], vn[cm][8 * s2 + 6], vn[cm][8 * s2 + 7]);
                    if (cm == 0) o[0] = MFMA32(fb[0], vf, o[0]);
                    o[1] = MFMA32(fb[1], vf, o[1]);
#pragma unroll
                    for (int tau = 0; tau < 4; ++tau) S[tau] = MFMA32(fb[2 + tau], vf, S[tau]);
                    __builtin_amdgcn_sched_barrier(0);
                    if (g < 3) {
#pragma unroll
                        for (int q = 0; q < 6; ++q) fb[q] = fc[q]; }
                }
#undef DN_F
#undef DN_WQ
                LDS_WAIT(); __builtin_amdgcn_sched_barrier(0); asm volatile("s_nop 15\n\ts_nop 3" ::: "memory"); __builtin_amdgcn_sched_barrier(0);
#pragma unroll
                for (int ct = 0; ct < 2; ++ct)
#pragma unroll
                    for (int i = 0; i < 16; i += 2) { const int c = 32 * ct + crow(i, hh), q = c >> 4; const unsigned u2 = pk2(o[ct][i], o[ct][i + 1]);
                        LAS unsigned char* wp = buf + dn::OFF_U + (((q >> 1) * 4 + wv) * 2 + (q & 1)) * 1024 + (c & 15) * 64 + (lane & 31) * 2;
                        *(LAS unsigned short*)wp = (unsigned short)u2; *(LAS unsigned short*)(wp + 64) = (unsigned short)(u2 >> 16); }
            }
        }
#ifdef PROBE_SCANC
        { const unsigned long long tc1_ = __builtin_amdgcn_s_memrealtime(); const unsigned long long d_ = tc1_ - tc0_; while (__builtin_amdgcn_s_memrealtime() - tc1_ < d_) __builtin_amdgcn_s_sleep(2); }
#endif
        asm volatile("s_waitcnt vmcnt(0)" ::: "memory");
        lds_barrier();
    }
    } else {
    u32x4 heldN[4], zN[4];
#pragma unroll
    for (int i = 0; i < 4; ++i) { heldN[i] = (u32x4){0u, 0u, 0u, 0u}; zN[i] = heldN[i]; }
    unsigned td0 = 0u, td1 = 0u, td2 = 0u;
    for (int k = 0; k < 34; ++k) {
        const int pbuf = k & 1;
#ifdef PROBE_SCANH
        const unsigned long long th0_ = __builtin_amdgcn_s_memrealtime();
#endif
        const bool rows = (k >= 1 && k <= 32);
        if (rows) {
            const int nn = k - 1; LAS unsigned char* pb = F.lds + (nn & 1) * dn::HC_BYTES;
            const int q = lane >> 4; const LAS unsigned char* rp = pb + dn::OFF_U + (((q >> 1) * 4 + w4) * 2 + (q & 1)) * 1024 + (lane & 15) * 64;
            float ssq = 0.f;
#pragma unroll
            for (int i = 0; i < 4; ++i) { const u32x4 hv = *(const LAS u32x4*)(rp + 16 * i); heldN[i] = hv;
                ssq += bflo(hv.x) * bflo(hv.x) + bfhi(hv.x) * bfhi(hv.x) + bflo(hv.y) * bflo(hv.y) + bfhi(hv.y) * bfhi(hv.y)
                     + bflo(hv.z) * bflo(hv.z) + bfhi(hv.z) * bfhi(hv.z) + bflo(hv.w) * bflo(hv.w) + bfhi(hv.w) * bfhi(hv.w); }
            part[((nn & 1) * 64 + lane) * 4 + w4] = ssq;
        }
        LDS_WAIT(); asm volatile("" ::: "memory");
        if (k + 1 < 32) DN_LOAD(k + 1, pbuf ^ 1);
        __builtin_amdgcn_sched_barrier(0);
        if (rows) { const bf16_t* zp = P + (size_t)(b * SEQ + (k - 1) * 64 + lane) * PLD + P_DNZ + h * 128 + 32 * w4;
#pragma unroll
            for (int i = 0; i < 4; ++i) zN[i] = *(const u32x4*)(zp + 8 * i); }
        __builtin_amdgcn_sched_barrier(0);
#ifdef SCAN_TOUCH_ON
        if (k + 2 < 32) {
            const unsigned char* tb = blk0 + (size_t)(k + 2) * hc_stride + (size_t)(w4 * 144) * 128;
            const unsigned char* a0 = tb + lane * 128; const unsigned char* a1 = tb + (64 + lane) * 128; const unsigned char* a2 = tb + (128 + (lane & 15)) * 128;
            asm volatile("; SCAN_TOUCH\n\tglobal_load_dword %0, %3, off\n\tglobal_load_dword %1, %4, off\n\tglobal_load_dword %2, %5, off" : "+v"(td0), "+v"(td1), "+v"(td2) : "v"(a0), "v"(a1), "v"(a2) : "memory");
        }
        __builtin_amdgcn_sched_barrier(0);
#endif
        u32x4 wo[4];
        if (k >= 2) {
            const int nn = k - 2; const f32x4 p4 = *(const LAS f32x4*)(part + ((nn & 1) * 64 + lane) * 4);
            const float rs = rsqrtf(((p4.x + p4.y) + (p4.z + p4.w)) * (1.f / 128.f) + EPS);
#pragma unroll
            for (int q = 0; q < 4; ++q) { const u32x4 zz = zO[q], hv = heldO[q]; const f32x4 ga = *(const LAS f32x4*)(gnl + 32 * w4 + 8 * q), gb = *(const LAS f32x4*)(gnl + 32 * w4 + 8 * q + 4);
                wo[q].x = pk2(bflo(hv.x) * rs * ga.x * siluf_(bflo(zz.x)), bfhi(hv.x) * rs * ga.y * siluf_(bfhi(zz.x)));
                wo[q].y = pk2(bflo(hv.y) * rs * ga.z * siluf_(bflo(zz.y)), bfhi(hv.y) * rs * ga.w * siluf_(bfhi(zz.y)));
                wo[q].z = pk2(bflo(hv.z) * rs * gb.x * siluf_(bflo(zz.z)), bfhi(hv.z) * rs * gb.y * siluf_(bfhi(zz.z)));
                wo[q].w = pk2(bflo(hv.w) * rs * gb.z * siluf_(bflo(zz.w)), bfhi(hv.w) * rs * gb.w * siluf_(bfhi(zz.w))); }
        }
#ifdef SCAN_TOUCH_ON
        if (k + 2 < 32) asm volatile("; SCAN_E\n\ts_waitcnt vmcnt(3)" ::: "memory"); else
#endif
        asm volatile("s_waitcnt vmcnt(0)" ::: "memory");
        if (k >= 2) { bf16_t* zp = P + (size_t)(b * SEQ + (k - 2) * 64 + lane) * PLD + P_DNZ + h * 128 + 32 * w4;
#pragma unroll
            for (int q = 0; q < 4; ++q) *(u32x4*)(zp + 8 * q) = wo[q]; }
#pragma unroll
        for (int i = 0; i < 4; ++i) { heldO[i] = heldN[i]; zO[i] = zN[i]; }
#ifdef PROBE_SCANH
        { const unsigned long long th1_ = __builtin_amdgcn_s_memrealtime(); const unsigned long long d_ = th1_ - th0_; while (__builtin_amdgcn_s_memrealtime() - th1_ < d_) __builtin_amdgcn_s_sleep(2); }
#endif
        lds_barrier();
    }
    asm volatile("s_waitcnt vmcnt(0)" : "+v"(td0), "+v"(td1), "+v"(td2) :: "memory");
    }
#undef DN_LOAD
#undef DN_PIECE
}

DI void final_norm(int wv) {
    const Frame F = mkframe(wv);
    const ArgsP ap = kargs();
    const float* ss = (const float*)(ap->ws + WS_SS);
    for (int m = F.gw; m < T; m += F.NGW) {
        const f32x4 s = *(const f32x4*)(ss + (size_t)m * 4); const float rs = rsqrtf(((s.x + s.y) + (s.z + s.w)) * (1.f / D) + EPS);
        f32x4* xr = (f32x4*)(ap->out + (size_t)m * D) + F.lane; const f32x4* gr = (const f32x4*)ap->final_norm_g + F.lane;
#pragma unroll
        for (int j = 0; j < 4; ++j) { const f32x4 v = xr[64 * j], g = gr[64 * j]; xr[64 * j] = v * rs * g; }
    }
}

__global__ void __launch_bounds__(NTHREADS, 2) mk_fwd(Args args) {
    extern __shared__ __attribute__((aligned(16))) unsigned char lds_raw[];
    LAS unsigned char* const lds = (LAS unsigned char*)lds_raw;
    volatile LAS unsigned* MISC = (volatile LAS unsigned*)(lds + MISC_OFF);
    const int wv = __builtin_amdgcn_readfirstlane((int)threadIdx.x >> 6);
    { const int t0 = opaque_tid(wv); for (int u = t0; u < (LDS_BYTES - LDSCTL_OFF) / 4; u += NTHREADS) ((LAS unsigned*)(lds + LDSCTL_OFF))[u] = 0u; }
    __syncthreads();
    const int G = gridDim.x;
    XcdBarrier bar; bar.bar = (unsigned*)(args.ws + WS_CTL) + CW_BAR + args.li * XCD_BAR_WORDS; bar.x = 0; bar.st = nullptr;
    if (args.ph_hi - args.ph_lo > 1) bar = xcd_barrier_post(bar.bar, MISC + 8, wv);
#define IN(k) (kargs()->ph_lo <= (k) && (k) < kargs()->ph_hi)
#ifdef PROBE_SUB
    unsigned long long ts_prev_ = 0;
#define SUBSEAM(bit) do { xcd_barrier(bar, wv); { const unsigned long long t1_ = __builtin_amdgcn_s_memrealtime(); \
        if ((PROBE_SUB >> (bit)) & 1u) { const unsigned long long d_ = t1_ - ts_prev_; while (__builtin_amdgcn_s_memrealtime() - t1_ < d_) __builtin_amdgcn_s_sleep(8); } \
        ts_prev_ = __builtin_amdgcn_s_memrealtime(); } } while (0)
#define SUBSTART() do { ts_prev_ = __builtin_amdgcn_s_memrealtime(); } while (0)
#else
#define SUBSEAM(bit) do { } while (0)
#define SUBSTART() do { } while (0)
#endif
#ifdef PROBE_ECHO
    unsigned long long t_prev_ = __builtin_amdgcn_s_memrealtime();
#define SEAM(k) do { if (IN(k) && IN((k) + 1)) xcd_barrier(bar, wv); { const unsigned long long t1_ = __builtin_amdgcn_s_memrealtime(); \
        if ((PROBE_ECHO >> (k)) & 1u) { const unsigned long long d_ = t1_ - t_prev_; while (__builtin_amdgcn_s_memrealtime() - t1_ < d_) __builtin_amdgcn_s_sleep(8); } \
        t_prev_ = __builtin_amdgcn_s_memrealtime(); } } while (0)
#else
#define SEAM(k) do { if (IN(k) && IN((k) + 1)) xcd_barrier(bar, wv); } while (0)
#endif
#define MK_EPI(E) gm::Epi E; E.ws = kargs()->ws; E.xin = nullptr; E.xout = nullptr; E.wout32 = false; E.b_gate = nullptr; E.gnext = nullptr; E.gfinal = nullptr; E.spare = (LAS float*)(lds + SPARE_OFF);

#if !defined(ONLY_PH) || ONLY_PH == 0
    if (IN(0)) { p0_prologue(wv); }
#endif
    SEAM(0);

    for (int l0 = 0; l0 < DEPTH; ++l0) {
        int l = l0; asm volatile("" : "+s"(l));
        const int pb = 1 + 6 * l;
#if !defined(ONLY_PH) || ONLY_PH == 1
        if (IN(pb)) { MK_EPI(E); SchedP1 S; S.ord.init(64, 12, G, opaque_bid()); S.ws = kargs()->ws; S.l = l; S.half = 0; S.c = opaque_bid(); S.with_kvm = false;
            gm::gemm_phase<AUX_P1>(lds, wv, S, E);
#ifdef PROBE_DUP_GEMM
            xcd_barrier(bar, wv); gm::gemm_phase<AUX_P1>(lds, wv, S, E);
#endif
            }
#endif
        SEAM(pb);
#if !defined(ONLY_PH) || ONLY_PH == 2
        if (IN(pb + 1)) {
            SUBSTART();
            SUBSEAM(0);
            for (int pair = opaque_bid(); pair < 512; pair += G) dn_prep(wv, l, pair);
            SUBSEAM(1);
            if (l > 0) { const Frame Fm = mkframe(wv); memn_rows(Fm, kargs(), l); }
 }
#endif
        SEAM(pb + 1);
#if !defined(ONLY_PH) || ONLY_PH == 3
        if (IN(pb + 2)) {
            if (opaque_bid() < 32 && G > 64) dn_scan(wv, l, opaque_bid());
            else { const bool split = G > 64; MK_EPI(E); SchedP1 S; S.ord.init(64, 12, split ? G - 32 : G, split ? opaque_bid() - 32 : opaque_bid()); S.ws = kargs()->ws; S.l = l; S.half = 1; S.c = opaque_bid(); S.with_kvm = true;
                gm::gemm_phase<AUX_P1>(lds, wv, S, E);
#ifdef PROBE_DUP_GEMM
                xcd_barrier(bar, wv); gm::gemm_phase<AUX_P1>(lds, wv, S, E);
#endif
                { const int cp = opaque_bid() - 32; const Frame Fc = mkframe(wv);
                  const int nsh = cp >= 112 ? 3 : 1, sh0 = cp >= 112 ? 3 * (cp - 112) : 336 + cp;
                  for (int q = 0; q < nsh; ++q) { const int first = (sh0 + q) * NWAVES + wv, stride = 448 * NWAVES;
                      if (l == 0) convert_weights(Fc, kargs(), 0, first, stride, 2);
                      if (l + 1 < DEPTH) convert_weights(Fc, kargs(), l + 1, first, stride, 0); } }
            }
            if (G <= 64) { for (int bh = opaque_bid(); bh < 32; bh += G) dn_scan(wv, l, bh); }
        }
#endif
        SEAM(pb + 2);
#if !defined(ONLY_PH) || ONLY_PH == 4
        if (IN(pb + 3)) {
            const int wg = opaque_bid();

            unsigned* head = (unsigned*)(kargs()->ws + WS_CTL) + CW_QUEUE + 64 * l;
            volatile LAS unsigned* qslot = (volatile LAS unsigned*)(lds + MISC_OFF + 64);
            for (;;) {
#ifdef PROBE_FETCH
                const unsigned long long tf0_ = __builtin_amdgcn_s_memrealtime();
#endif
                if (opaque_tid(wv) == 0) qslot[0] = __hip_atomic_fetch_add(head, 1u, __ATOMIC_RELAXED, __HIP_MEMORY_SCOPE_AGENT);
                __syncthreads();
                const int unit = (int)qslot[0];
                __syncthreads();
#ifdef PROBE_FETCH
                { const unsigned long long tf1_ = __builtin_amdgcn_s_memrealtime(); const unsigned long long d_ = tf1_ - tf0_; while (__builtin_amdgcn_s_memrealtime() - tf1_ < d_) __builtin_amdgcn_s_sleep(2); }
#endif
                if (unit >= 1248) break;
#ifdef PROBE_UNIT
                const unsigned long long tu0_ = __builtin_amdgcn_s_memrealtime();
#endif
                if (unit < 224) ret_state_unit(wv, l, unit); else if (unit < 480) attn_unit<1>(wv, l, unit - 224); else if (unit < 992) attn_unit<0>(wv, l, unit - 480); else mem_unit(wv, l, unit - 992);
#ifdef PROBE_UNIT
                { const unsigned long long tu1_ = __builtin_amdgcn_s_memrealtime(); if (PROBE_UNIT >= 2 ? (tu1_ - tu0_ > (unsigned long long)PROBE_UNIT * 100ull) : ((unit < 256) == (PROBE_UNIT == 1))) { const unsigned long long d_ = tu1_ - tu0_; while (__builtin_amdgcn_s_memrealtime() - tu1_ < d_) __builtin_amdgcn_s_sleep(8); } }
#endif
            }
        }
#endif
#ifdef KEEP_SEAM3
        SEAM(pb + 3);
#endif
#if !defined(ONLY_PH) || ONLY_PH == 5
        if (IN(pb + 4)) { MK_EPI(E); gm::TileOrder ord; ord.init(64, 4, G, opaque_bid()); SchedP3 S; S.ok = ord.tile(0, S.pm, S.pn); S.l = l; S.rot = (opaque_bid() >> 3) & 3; S.ws = kargs()->ws; E.b_gate = kargs()->b_gate;
            gm::gemm_phase<AUX_P3>(lds, wv, S, E);
#ifdef PROBE_DUP_GEMM
            xcd_barrier(bar, wv); gm::gemm_phase<AUX_P3>(lds, wv, S, E);
#endif
            }
#endif
        SEAM(pb + 4);
#if !defined(ONLY_PH) || ONLY_PH == 6
        if (IN(pb + 5)) { MK_EPI(E); gm::TileOrder ord; ord.init(64, 4, G, opaque_bid()); SchedP4 S; S.ok = ord.tile(0, S.pm, S.pn); S.l = l; S.ws = kargs()->ws;
            E.gnext = (l + 1 < DEPTH) ? kargs()->norm_g + (size_t)(l + 1) * D : nullptr;
            E.gfinal = (l + 1 < DEPTH || G != 256) ? nullptr : kargs()->final_norm_g;
            E.xout = kargs()->out; E.xin = (l == 0) ? kargs()->x : (const float*)kargs()->out;
            E.wout32 = (l + 1 == DEPTH) && G != 256;
            gm::gemm_phase<AUX_P4>(lds, wv, S, E); }
#endif
        if (!(l + 1 == DEPTH && G == 256)) SEAM(pb + 5);
    }
#if !defined(ONLY_PH) || ONLY_PH == 13
    if (IN(13) && G != 256) final_norm(wv);
#endif
#undef IN
#undef SEAM
#undef MK_EPI
}

extern "C" void kernel_launch(void* const* d_in, const int* in_sizes, int n_in, void* d_out, int out_size, void* d_ws, size_t ws_size, hipStream_t stream) {
    static int grid = 0;
    if (grid == 0) {
        if (n_in != 19 || out_size != T * D || ws_size < WS_END) { fprintf(stderr, "kernel_launch: unexpected problem (n_in %d, out %d, ws %zu)\n", n_in, out_size, ws_size); grid = -1; return; }
        int dev = 0, cus = 0, per_cu = 0;
        if (hipGetDevice(&dev) != hipSuccess || hipDeviceGetAttribute(&cus, hipDeviceAttributeMultiprocessorCount, dev) != hipSuccess) { grid = -1; return; }
        if (hipFuncSetAttribute((const void*)mk_fwd, hipFuncAttributeMaxDynamicSharedMemorySize, LDS_BYTES) != hipSuccess) { fprintf(stderr, "kernel_launch: hipFuncSetAttribute failed\n"); grid = -1; return; }
        if (hipOccupancyMaxActiveBlocksPerMultiprocessor(&per_cu, (const void*)mk_fwd, NTHREADS, LDS_BYTES) != hipSuccess || per_cu < 1)
            fprintf(stderr, "kernel_launch: occupancy query reports %d workgroups per CU\n", per_cu);
        (void)hipGetLastError();
        grid = cus;
    }
    if (grid < 0) return;
    if (hipMemsetAsync((char*)d_ws + WS_CTL, 0, CTL_ZERO_BYTES, stream) != hipSuccess) return;
    Args a{};
    a.x = (const float*)d_in[0]; a.mem = (const float*)d_in[1]; a.positions = (const int*)d_in[2]; a.norm_g = (const float*)d_in[3]; a.mem_norm_g = (const float*)d_in[4];
    a.w_in = (const float*)d_in[5]; a.b_gate = (const float*)d_in[6]; a.dn_conv_w = (const float*)d_in[7]; a.dn_a_log = (const float*)d_in[8]; a.dn_dt_bias = (const float*)d_in[9];
    a.dn_norm_g = (const float*)d_in[10]; a.ret_norm_g = (const float*)d_in[11]; a.w_mem_kv = (const float*)d_in[12]; a.w_br_sb = (const float*)d_in[13]; a.w_br_dn = (const float*)d_in[14];
    a.w_br_ret = (const float*)d_in[15]; a.w_br_mem = (const float*)d_in[16]; a.w_out = (const float*)d_in[17]; a.final_norm_g = (const float*)d_in[18];
    a.out = (float*)d_out; a.ws = (unsigned char*)d_ws;
#if MK_N_LAUNCHES == 1
    a.ph_lo = 0; a.ph_hi = NPHASE; a.li = 0;
    hipLaunchKernelGGL(mk_fwd, dim3(grid), dim3(NTHREADS), LDS_BYTES, stream, a);
#else
    for (int p = 0; p < NPHASE; ++p) { a.ph_lo = p; a.ph_hi = p + 1; a.li = 0;
        hipLaunchKernelGGL(mk_fwd, dim3(grid), dim3(NTHREADS), LDS_BYTES, stream, a); }
#endif
}
```

```cpp
#include <hip/hip_runtime.h>
#include <cstdio>
#include <cstdint>
#include <cmath>

#define LAS __attribute__((address_space(3)))
#define GAS __attribute__((address_space(1)))
#define DI __device__ __forceinline__
typedef unsigned short bf16_t;
typedef short bf16x8 __attribute__((ext_vector_type(8)));
typedef float f32x4 __attribute__((ext_vector_type(4)));
typedef unsigned u32x4 __attribute__((ext_vector_type(4)));
typedef unsigned u32x2 __attribute__((ext_vector_type(2)));
typedef float f32x2 __attribute__((ext_vector_type(2)));

#ifndef AUX_P1
#define AUX_P1 0
#endif
#ifndef AUX_P3
#define AUX_P3 0
#endif
#ifndef AUX_P4
#define AUX_P4 0
#endif
#ifdef EPI_NT
#define EPI_LD(p) __builtin_nontemporal_load(p)
#define EPI_ST(p, v) __builtin_nontemporal_store((v), (p))
#else
#define EPI_LD(p) (*(p))
#define EPI_ST(p, v) (*(p) = (v))
#endif
#ifndef FRESH_WAITS
#define FRESH_WAITS 0
#endif
#ifndef SS_PREFETCH
#define SS_PREFETCH 1
#endif
#ifndef EARLY_INV
#define EARLY_INV 1
#endif
#ifndef SCAN_AUX
#define SCAN_AUX 2
#endif
#ifndef MK_N_LAUNCHES
#define MK_N_LAUNCHES 1
#endif

constexpr int BATCH = 8, SEQ = 2048, D = 1024, T = BATCH * SEQ, DEPTH = 2, MEMLEN = 256;
constexpr int IN_COLS = 9992;
constexpr float EPS = 1e-6f;
constexpr int NPHASE = 14;

constexpr size_t MiB = 1u << 20;
constexpr size_t WS_CTL = 0, CTL_ZERO_BYTES = 1 * MiB;
constexpr size_t WS_WINA = 1 * MiB;
constexpr size_t WS_WINB = 13 * MiB;
constexpr size_t WS_WG = 25 * MiB;
constexpr size_t WS_WBR = 41 * MiB;
constexpr size_t WS_WOUT = 49 * MiB;
constexpr size_t WS_WKV = 53 * MiB;
constexpr size_t WS_XN = 55 * MiB;
constexpr size_t WS_P = 87 * MiB;
constexpr size_t WS_R = 127 * MiB;
constexpr int VTLD = T + 64;
constexpr size_t WS_VTSB = WS_R + 64 * MiB, WS_VTRT = WS_VTSB + (size_t)512 * VTLD * 2;
constexpr size_t WS_SCR = 224 * MiB;
constexpr size_t WS_MRG = 240 * MiB;
constexpr size_t WS_DNI = 224 * MiB;
constexpr size_t WS_KVM = 296 * MiB;
constexpr size_t WS_ROPE = 300 * MiB;
constexpr size_t WS_AB = 304 * MiB;
constexpr size_t WS_GB = WS_AB + 512 * 1024;
constexpr size_t WS_SS = 305 * MiB;
constexpr size_t WS_END = 310 * MiB;
constexpr size_t WS_MEMN = 306 * MiB;
constexpr int PLD = 1280, RALD = 1536, RBLD = 2048, SCRLD = 1024, MRGLD = 1024;
constexpr int P_DNZ = 0, P_MEMQ = 512, P_RTQ = 768, P_RTK = 1024;
constexpr int RB_SBQ = 0, RB_SBK = 512, RB_SBZ = 1024, RB_RTZ = 1536;
constexpr int CW_BAR = 4096;
constexpr int CW_PANEL = 16384;
constexpr int CW_QUEUE = 64;
constexpr int CW_RST = 49152;
constexpr int CW_READY = 32768;

constexpr int RING_BYTES = 155648;
constexpr int LDSCTL_OFF = RING_BYTES, MISC_OFF = LDSCTL_OFF + 320, SPARE_OFF = LDSCTL_OFF + 1024;
constexpr int LDS_BYTES = 163840;
constexpr int NWAVES = 8, NTHREADS = 512;

DI unsigned f2bf(float f) { unsigned u = __builtin_bit_cast(unsigned, f); return (u + 0x7fffu + ((u >> 16) & 1u)) >> 16; }
DI unsigned pk2(float lo, float hi) { unsigned r; asm("s_nop 0\n\tv_cvt_pk_bf16_f32 %0, %1, %2" : "=v"(r) : "v"(lo), "v"(hi)); return r; }
DI float bf2f(unsigned short h) { return __builtin_bit_cast(float, (unsigned)h << 16); }
DI float bflo(unsigned w) { return __builtin_bit_cast(float, w << 16); }
DI float bfhi(unsigned w) { return __builtin_bit_cast(float, w & 0xffff0000u); }
DI float shx(float v, int m, int lane) { return __builtin_bit_cast(float, __builtin_amdgcn_ds_bpermute((lane ^ m) << 2, __builtin_bit_cast(int, v))); }
DI float wave_sum(float v, int lane) {
#pragma unroll
    for (int o = 1; o < 64; o <<= 1) v += shx(v, o, lane);
    return v;
}
DI float sum16(float v) {
    v += __builtin_bit_cast(float, __builtin_amdgcn_update_dpp(0, __builtin_bit_cast(int, v), 0xB1, 0xf, 0xf, true));
    v += __builtin_bit_cast(float, __builtin_amdgcn_update_dpp(0, __builtin_bit_cast(int, v), 0x4E, 0xf, 0xf, true));
    v += __builtin_bit_cast(float, __builtin_amdgcn_update_dpp(0, __builtin_bit_cast(int, v), 0x141, 0xf, 0xf, true));
    v += __builtin_bit_cast(float, __builtin_amdgcn_update_dpp(0, __builtin_bit_cast(int, v), 0x140, 0xf, 0xf, true));
    return v;
}
DI float sigmoidf_(float x) { return __builtin_amdgcn_rcpf(1.f + __builtin_amdgcn_exp2f(x * -1.4426950408889634f)); }
DI float siluf_(float x) { return x * __builtin_amdgcn_rcpf(1.f + __builtin_amdgcn_exp2f(x * -1.4426950408889634f)); }
DI int opaque_bid() { int b = blockIdx.x; asm volatile("" : "+s"(b)); return b; }
DI int opaque_tid(int wv) { int lane; asm volatile("v_mbcnt_lo_u32_b32 %0, -1, 0\n\tv_mbcnt_hi_u32_b32 %0, -1, %0" : "=v"(lane)); return wv * 64 + lane; }
#define LDS_WAIT() asm volatile("s_waitcnt lgkmcnt(0)" ::: "memory")
DI void lds_barrier() { asm volatile("s_waitcnt lgkmcnt(0)" ::: "memory"); __builtin_amdgcn_s_barrier(); asm volatile("" ::: "memory"); }
#define VM_WAIT() asm volatile("s_waitcnt vmcnt(0)" ::: "memory")
DI unsigned shxu(unsigned v, int m, int lane) { return (unsigned)__builtin_amdgcn_ds_bpermute((lane ^ m) << 2, (int)v); }
DI void st16_wt(void* p, u32x4 v) { asm volatile("global_store_dwordx4 %0, %1, off sc1\n\ts_nop 1" :: "v"(p), "v"(v) : "memory"); }
DI void unit_done(unsigned char* ws, int l, int pm, int tid) {
    VM_WAIT(); lds_barrier();
    if (tid == 0) (void)__hip_atomic_fetch_add((unsigned*)(ws + WS_CTL) + CW_READY + 4096 * l + 64 * pm, 1u, __ATOMIC_RELAXED, __HIP_MEMORY_SCOPE_AGENT);
}

#define XB_TMO      128
#define XB_XCNT(j)  (256  + 64 * (j))
#define XB_XSUB(j)  (1280 + 64 * (j))
#define XB_XGEN(j)  (2304 + 64 * (j))
#define XB_TOP      3328
#define XB_TOPGEN   3392
#define XCD_BAR_WORDS 3456
#define XB_SPIN_CAP (1u << 18)
DI unsigned xb_ld(unsigned* p)              { return __hip_atomic_load(p, __ATOMIC_RELAXED, __HIP_MEMORY_SCOPE_AGENT); }
DI unsigned xb_add(unsigned* p, unsigned v) { return __hip_atomic_fetch_add(p, v, __ATOMIC_RELAXED, __HIP_MEMORY_SCOPE_AGENT); }
DI unsigned xb_xcc_id() { return (unsigned)__builtin_amdgcn_s_getreg((3 << 11) | 20) & 0xFu; }
#define XB_SPIN(cond, bar) do { unsigned _sp = 0; while (cond) { __builtin_amdgcn_s_sleep(1); \
    if ((++_sp & 255u) == 0u) { if (xb_ld(&(bar)[XB_TMO])) break; if (_sp > XB_SPIN_CAP) { atomicAdd(&(bar)[XB_TMO], 1u); break; } } } } while (0)
struct XcdBarrier { unsigned* bar; unsigned x; volatile LAS unsigned* st; };
DI XcdBarrier xcd_barrier_post(unsigned* bar, volatile LAS unsigned* st, int wv) {
    XcdBarrier b; b.bar = bar; b.x = xb_xcc_id(); b.st = st;
    if (opaque_tid(wv) == 0) (void)xb_add(&bar[XB_XCNT(b.x)], 1u);
    return b;
}
DI void xcd_barrier_complete(unsigned* bar, unsigned x, unsigned& nloc, unsigned& nx) {
    const unsigned G = gridDim.x * gridDim.y * gridDim.z;
    unsigned sum, cnt, mine, sp = 0u;
    for (;;) {
        sum = 0u; cnt = 0u; mine = 0u;
#pragma unroll
        for (unsigned j = 0; j < 16; ++j) { const unsigned c = xb_ld(&bar[XB_XCNT(j)]); sum += c; cnt += (c > 0u) ? 1u : 0u; mine = (j == x) ? c : mine; }
        if (sum == G) break;
        __builtin_amdgcn_s_sleep(1);
        if ((++sp & 255u) == 0u) { if (xb_ld(&bar[XB_TMO])) break; if (sp > XB_SPIN_CAP) { atomicAdd(&bar[XB_TMO], 1u); break; } }
    }
    nloc = mine > 0u ? mine : 1u; nx = cnt > 0u ? cnt : 1u;
}
DI void xcd_barrier(const XcdBarrier& b, int wv) {
    asm volatile("s_waitcnt vmcnt(0)" ::: "memory");
    __syncthreads();
    if (opaque_tid(wv) == 0) {
        unsigned* bar = b.bar;
        __builtin_amdgcn_s_waitcnt(0);
#if EARLY_INV
        __builtin_amdgcn_fence(__ATOMIC_ACQUIRE, "agent");
#endif
        unsigned nloc = b.st[0], nx = b.st[1];
        if (nloc == 0u) { xcd_barrier_complete(bar, b.x, nloc, nx); b.st[0] = nloc; b.st[1] = nx; }
        const unsigned old = xb_add(&bar[XB_XSUB(b.x)], 1u);
        const unsigned gen = old / nloc;
        if (old + 1u == (gen + 1u) * nloc) {
            __builtin_amdgcn_fence(__ATOMIC_RELEASE, "agent");
            asm volatile("s_waitcnt vmcnt(0)" ::: "memory");
            const unsigned og = xb_add(&bar[XB_TOP], 1u);
            const unsigned tg = og / nx;
            if (og + 1u == (tg + 1u) * nx) xb_add(&bar[XB_TOPGEN], 1u);
            else XB_SPIN(xb_ld(&bar[XB_TOPGEN]) == tg, bar);
#if !EARLY_INV
            __builtin_amdgcn_fence(__ATOMIC_ACQUIRE, "agent");
#endif
            xb_add(&bar[XB_XGEN(b.x)], 1u);
            asm volatile("s_waitcnt vmcnt(0)" ::: "memory");
        } else {
            XB_SPIN(xb_ld(&bar[XB_XGEN(b.x)]) == gen, bar);
#if !EARLY_INV
            __builtin_amdgcn_fence(__ATOMIC_ACQUIRE, "agent");
#endif
            asm volatile("s_waitcnt vmcnt(0)" ::: "memory");
        }
    }
    __syncthreads();
}

namespace gm {
constexpr int BM = 256, BK = 64, HALF = 128, HTB = HALF * BK * 2, STAGE_BYTES = 8 * HTB;
DI int lds_byte(int r, int c) { const int st = (r >> 4) * 2 + (c >> 5), rr = r & 15, cc = c & 31, ob = rr * 64 + cc * 2; return st * 1024 + (ob ^ (((ob >> 9) & 1) << 5)); }
DI void stage_rc(int b, int& R, int& C) { const int st = b / 1024, sb = b % 1024, swz = sb ^ (((sb >> 9) & 1) << 5); R = (st >> 1) * 16 + swz / 64; C = (st & 1) * 32 + (swz % 64) / 2; }
DI int perm32(int rho) { const int n = rho >> 4, i = rho & 15; return 8 * (i >> 2) + 4 * n + (i & 3); }

enum Kind { K_STORE = 0, K_AB = 1, K_GATE = 2, K_BRANCH = 3, K_OUT = 4, K_STORE_T = 5 };
struct Unit {
    const bf16_t* A; const bf16_t* B;
    int lda, ldb, K, pm, pn, kind, sub, l;
};
struct TileOrder {
    int nM, nN, nwg, G, c;
    DI void init(int nM_, int nN_, int G_, int c_) { nM = nM_; nN = nN_; nwg = nM * nN; G = G_; c = c_; }
    DI bool tile(int i, int& pm, int& pn) const {
        const long L = (long)i * G + c; if (L >= nwg) return false;
        int wgid = (int)L; { const int q = nwg / 8, r = nwg % 8, xcd = wgid % 8, off = wgid / 8; wgid = (xcd < r ? xcd * (q + 1) : r * (q + 1) + (xcd - r) * q) + off; }
        const int WGM = 8, nig = WGM * nN, gid = wgid / nig, fm = gid * WGM, gsz = (nM - fm) < WGM ? (nM - fm) : WGM;
        pm = __builtin_amdgcn_readfirstlane(fm + ((wgid % nig) % gsz)); pn = __builtin_amdgcn_readfirstlane((wgid % nig) / gsz); return true;
    }
};

template <int AUX, class Sched, class Epi>
DI void gemm_phase(LAS unsigned char* lds, int wv, const Sched& S, const Epi& E) {
    const int tid = opaque_tid(wv), wid = __builtin_amdgcn_readfirstlane(tid >> 6), lane = tid & 63, wr = wid >> 2, wc = wid & 3, fr = lane & 15, fq = lane >> 4;
    int R0_, C0_; stage_rc(tid * 16, R0_, C0_);
    const unsigned R0 = 2u * (unsigned)R0_, C2 = 2u * (unsigned)C0_;
    const unsigned RbP = 2u * (unsigned)((R0_ & ~31) + perm32(R0_ & 31));
    const unsigned ldsw = (unsigned)wid * 1024u;
    const int aoff = lds_byte(wr * 64 + fr, fq * 8), boff = lds_byte(wc * 32 + fr, fq * 8);
#define GM_SA(b, h) (((b) * 2 + (h)) * HTB)
#define GM_SB(b, h) ((4 + (b) * 2 + (h)) * HTB)
#define GM_STAGE(bufoff, gbase, ld, R2) do { const unsigned _v = (unsigned)(R2) * (unsigned)(ld) + C2; \
        __builtin_amdgcn_global_load_lds((const unsigned*)((const char*)(gbase) + _v), (LAS unsigned*)(lds + (bufoff) + ldsw), 16, 0, AUX); \
        __builtin_amdgcn_global_load_lds((const unsigned*)((const char*)(gbase) + (_v + (unsigned)(ld) * 128u)), (LAS unsigned*)(lds + (bufoff) + ldsw + 8192), 16, 0, AUX); } while (0)
#define GM_LDA(dst, b, h) do { _Pragma("unroll") for (int m = 0; m < 4; ++m) _Pragma("unroll") for (int k = 0; k < 2; ++k) dst[m][k] = *(const LAS bf16x8*)(lds + GM_SA(b, h) + aoff + m * 2048 + k * 1024); } while (0)
#define GM_LDB(dst, b, h) do { _Pragma("unroll") for (int n = 0; n < 2; ++n) _Pragma("unroll") for (int k = 0; k < 2; ++k) dst[n][k] = *(const LAS bf16x8*)(lds + GM_SB(b, h) + boff + n * 2048 + k * 1024); } while (0)
#define GM_MMA(ai, bj, At, Bt) do { __builtin_amdgcn_s_setprio(1); _Pragma("unroll") for (int m = 0; m < 4; ++m) _Pragma("unroll") for (int n = 0; n < 2; ++n) _Pragma("unroll") for (int k = 0; k < 2; ++k) \
        acc[ai][bj][m][n] = __builtin_amdgcn_mfma_f32_16x16x32_bf16(Bt[n][k], At[m][k], acc[ai][bj][m][n], 0, 0, 0); __builtin_amdgcn_s_setprio(0); } while (0)
#define GM_WAIT_V(n) asm volatile("s_waitcnt vmcnt(" #n ")" ::: "memory")
#define GM_WAIT_L(n) asm volatile("s_waitcnt lgkmcnt(" #n ")" ::: "memory")
#define GM_BAR __builtin_amdgcn_s_barrier()
#define GM_SCHED __builtin_amdgcn_sched_barrier(0)
    Unit cur, nxt; int ui = 0;
    if (!S.next(0, cur)) return;
    S.a_ready(cur, wid, lane);
    f32x4 acc[2][2][4][2];
#pragma unroll
    for (int a = 0; a < 2; ++a)
#pragma unroll
        for (int b = 0; b < 2; ++b)
#pragma unroll
            for (int m = 0; m < 4; ++m)
#pragma unroll
                for (int n = 0; n < 2; ++n) acc[a][b][m][n] = (f32x4){0.f, 0.f, 0.f, 0.f};
    bf16x8 At[4][2], B0[2][2], B1[2][2];
    const char* cA = (const char*)cur.A; const char* cB = (const char*)cur.B; int clda = cur.lda, cldb = cur.ldb;
    GM_STAGE(GM_SB(0, 0), cB, cldb, RbP); GM_STAGE(GM_SB(0, 1), cB + (size_t)cldb * 256, cldb, RbP); GM_STAGE(GM_SA(0, 0), cA, clda, R0); GM_STAGE(GM_SA(0, 1), cA + (size_t)clda * 256, clda, R0);
    if (wr == 1) GM_BAR;
    GM_WAIT_V(2); GM_BAR;
    GM_STAGE(GM_SB(1, 0), cB + 128, cldb, RbP); GM_STAGE(GM_SA(1, 0), cA + 128, clda, R0); GM_STAGE(GM_SB(1, 1), cB + (size_t)cldb * 256 + 128, cldb, RbP);
    GM_WAIT_V(6); GM_BAR;
    for (;;) {
        const bool has_next = S.next(ui + 1, nxt);
        const char* nA = has_next ? (const char*)nxt.A : cA; const char* nB = has_next ? (const char*)nxt.B : cB;
        const int nlda = has_next ? nxt.lda : clda, nldb = has_next ? nxt.ldb : cldb;
        const int nt = cur.K / BK;
#if SS_PREFETCH
        if (wid < 4) __builtin_amdgcn_global_load_lds((const unsigned*)(E.ws + WS_SS + ((size_t)(cur.kind == K_STORE_T ? cur.pn : cur.pm) * 256 + tid) * 16), (LAS unsigned*)(lds + STAGE_BYTES + (ui & 1) * 4096 + wid * 1024), 16, 0, 0);
        if (wid == 4 && cur.kind == K_GATE) __builtin_amdgcn_global_load_lds((const unsigned*)(E.b_gate + (size_t)cur.l * 4096 + (cur.sub & 3) * 1024 + cur.pn * 256 + lane * 4), (LAS unsigned*)(lds + STAGE_BYTES + 8192 + (ui & 1) * 1024), 16, 0, 0);
#endif
        for (int t = 0; t < nt; t += 2) {
            const bool last = (t == nt - 2);
            if (last && has_next) S.a_ready(nxt, wid, lane);
            const char* a1 = cA + (size_t)(t + 1) * 128;
            const char* a2 = last ? nA : cA + (size_t)(t + 2) * 128; const char* b2 = last ? nB : cB + (size_t)(t + 2) * 128;
            const int lda2 = last ? nlda : clda, ldb2 = last ? nldb : cldb;
            const char* a3 = a2 + 128; const char* b3 = b2 + 128;
            const int later = __builtin_amdgcn_readfirstlane((t != 0) ? 1 : 0);
#if FRESH_WAITS
#define GM_WAIT_V8_LATER asm volatile("s_cmp_eq_u32 %0, 0\n\ts_cbranch_scc1 .Lgmw%=\n\ts_waitcnt vmcnt(8)\n.Lgmw%=:" :: "s"(later) : "scc", "memory")
#else
#define GM_WAIT_V8_LATER GM_WAIT_V(8)
#endif
            GM_LDB(B0, 0, 0); GM_LDB(B1, 0, 1); GM_SCHED; GM_LDA(At, 0, 0); GM_STAGE(GM_SA(1, 1), a1 + (size_t)clda * 256, clda, R0);
            GM_WAIT_V8_LATER; GM_WAIT_L(0); GM_BAR; GM_MMA(0, 0, At, B0); GM_MMA(0, 1, At, B1); GM_BAR; GM_SCHED;
            GM_LDA(At, 0, 1); GM_STAGE(GM_SB(0, 0), b2, ldb2, RbP); GM_STAGE(GM_SB(0, 1), b2 + (size_t)ldb2 * 256, ldb2, RbP); GM_STAGE(GM_SA(0, 0), a2, lda2, R0);
            GM_WAIT_V8_LATER; GM_WAIT_L(0); GM_BAR; GM_MMA(1, 0, At, B0); GM_MMA(1, 1, At, B1); GM_BAR; GM_SCHED;
#undef GM_WAIT_V8_LATER
            GM_LDB(B0, 1, 0); GM_LDB(B1, 1, 1); GM_SCHED; GM_LDA(At, 1, 0); GM_STAGE(GM_SA(0, 1), a2 + (size_t)lda2 * 256, lda2, R0);
            GM_WAIT_V(8); GM_WAIT_L(0); GM_BAR; GM_MMA(0, 0, At, B0); GM_MMA(0, 1, At, B1); GM_BAR; GM_SCHED;
            GM_LDA(At, 1, 1); GM_STAGE(GM_SB(1, 0), b3, ldb2, RbP); GM_STAGE(GM_SB(1, 1), b3 + (size_t)ldb2 * 256, ldb2, RbP); GM_STAGE(GM_SA(1, 0), a3, lda2, R0);
            GM_WAIT_V(8); GM_WAIT_L(0); GM_BAR; GM_MMA(1, 0, At, B0); GM_MMA(1, 1, At, B1); GM_BAR; GM_SCHED;
        }
        if (wr == 0) GM_BAR;
        if (FRESH_WAITS && (cur.kind == K_AB || (cur.kind == K_STORE && cur.sub == 2) || (cur.kind == K_STORE_T && cur.sub == 1))) GM_WAIT_V(0);
#ifdef PROBE_EPI
        const unsigned long long te0_ = __builtin_amdgcn_s_memrealtime();
#endif
        E(acc, cur, wr, wc, fr, fq, lane, (const LAS float*)(lds + STAGE_BYTES + (ui & 1) * 4096), (const LAS float*)(lds + STAGE_BYTES + 8192 + (ui & 1) * 1024));
#ifdef PROBE_EPI
        if (cur.kind == PROBE_EPI) { asm volatile("s_waitcnt vmcnt(0)" ::: "memory"); const unsigned long long t1_ = __builtin_amdgcn_s_memrealtime(); const unsigned long long d_ = t1_ - te0_; while (__builtin_amdgcn_s_memrealtime() - t1_ < d_) __builtin_amdgcn_s_sleep(2); }
#endif
        if (!has_next) break;
#pragma unroll
        for (int a = 0; a < 2; ++a)
#pragma unroll
            for (int b = 0; b < 2; ++b)
#pragma unroll
                for (int m = 0; m < 4; ++m)
#pragma unroll
                    for (int n = 0; n < 2; ++n) acc[a][b][m][n] = (f32x4){0.f, 0.f, 0.f, 0.f};
        cur = nxt; cA = nA; cB = nB; clda = nlda; cldb = nldb; ++ui;
        if (wr == 1) GM_BAR;
    }
    GM_WAIT_V(0);
    GM_BAR;
#undef GM_SA
#undef GM_SB
#undef GM_STAGE
#undef GM_LDA
#undef GM_LDB
#undef GM_MMA
#undef GM_WAIT_V
#undef GM_WAIT_L
#undef GM_BAR
#undef GM_SCHED
}

#if SS_PREFETCH
#define SSROW(pan, r) row_scale_l(ssl, (r))
#else
#define SSROW(pan, r) row_scale((pan) * BM + (r))
#endif
struct Epi {
    unsigned char* ws;
    const float* xin; float* xout;
    bool wout32;
    const float* b_gate;
    const float* gnext;
    const float* gfinal;
    LAS float* spare;
    DI float row_scale(int row) const { const f32x4 s = *(const f32x4*)((const float*)(ws + WS_SS) + (size_t)row * 4); return rsqrtf(((s.x + s.y) + (s.z + s.w)) * (1.0f / 1024.0f) + EPS); }
    static DI float row_scale_l(const LAS float* ssl, int r) { const f32x4 s = *(const LAS f32x4*)(ssl + r * 4); return rsqrtf(((s.x + s.y) + (s.z + s.w)) * (1.0f / 1024.0f) + EPS); }
    DI unsigned char* scratch_tile(int pm, int pn) const { return ws + WS_SCR + (size_t)pm * 256 * SCRLD + pn * 256; }
    DI void operator()(f32x4 (&acc)[2][2][4][2], const Unit& u, int wr, int wc, int fr, int fq, int lane, const LAS float* ssl, const LAS float* bil) const {
        int rl0 = wr * 64 + fr, cl0 = wc * 32 + 8 * fq;
        asm volatile("" : "+v"(rl0), "+v"(cl0));
        if (u.kind == K_STORE) {
            bf16_t* base; int ldc; bool scale = true;
            if (u.sub == 0) {
                if (u.pn < 6) { base = (bf16_t*)(ws + WS_R) + (size_t)u.pm * 256 * RALD + u.pn * 256; ldc = RALD; }
                else { const int pc = u.pn < 8 ? (u.pn - 6) * 256 : (u.pn - 7) * 256; base = (bf16_t*)(ws + WS_P) + (size_t)u.pm * 256 * PLD + pc; ldc = PLD; }
            } else if (u.sub == 1) { base = (bf16_t*)(ws + WS_R) + (size_t)u.pm * 256 * RBLD + u.pn * 256; ldc = RBLD; }
            else { base = (bf16_t*)(ws + WS_KVM) + (size_t)u.l * 1024 * 1024 + (size_t)u.pm * 256 * 256; ldc = 256; scale = false; }
            const bool rope = (u.sub == 0 && u.pn >= 10);
            const float rsc = (u.pn == 11) ? 0.125f : 1.0f;
            const float* rc = (const float*)(ws + WS_ROPE); const int fi = (cl0 & 63) >> 1;
            float scq[2][4];
#pragma unroll
            for (int ai = 0; ai < 2; ++ai)
#pragma unroll
                for (int m = 0; m < 4; ++m) scq[ai][m] = scale ? SSROW(u.pm, rl0 + ai * HALF + m * 16) : 1.0f;
#pragma unroll
            for (int ai = 0; ai < 2; ++ai) {
                f32x4 csq[4], snq[4];
                if (rope) {
#pragma unroll
                    for (int m = 0; m < 4; ++m) { const size_t ro = (size_t)(u.pm * BM + rl0 + ai * HALF + m * 16) * 32 + fi; csq[m] = *(const f32x4*)(rc + ro); snq[m] = *(const f32x4*)(rc + (size_t)T * 32 + ro); }
                }
#pragma unroll
                for (int m = 0; m < 4; ++m) {
                    const int rl = rl0 + ai * HALF + m * 16;
                    const float sc = scq[ai][m];
                    bf16_t* rowp = base + (size_t)rl * ldc + cl0;
                    f32x4 cs4 = {1.f, 1.f, 1.f, 1.f}, sn4 = {0.f, 0.f, 0.f, 0.f};
                    if (rope) { cs4 = csq[m]; sn4 = snq[m]; }
#pragma unroll
                    for (int bj = 0; bj < 2; ++bj) { f32x4 v0 = acc[ai][bj][m][0] * sc, v1 = acc[ai][bj][m][1] * sc;
                        if (rope) { f32x4 r0, r1;
                            r0[0] = (v0[0] * cs4[0] - v0[1] * sn4[0]) * rsc; r0[1] = (v0[0] * sn4[0] + v0[1] * cs4[0]) * rsc; r0[2] = (v0[2] * cs4[1] - v0[3] * sn4[1]) * rsc; r0[3] = (v0[2] * sn4[1] + v0[3] * cs4[1]) * rsc;
                            r1[0] = (v1[0] * cs4[2] - v1[1] * sn4[2]) * rsc; r1[1] = (v1[0] * sn4[2] + v1[1] * cs4[2]) * rsc; r1[2] = (v1[2] * cs4[3] - v1[3] * sn4[3]) * rsc; r1[3] = (v1[2] * sn4[3] + v1[3] * cs4[3]) * rsc;
                            v0 = r0; v1 = r1; }
                        u32x4 w; w.x = pk2(v0[0], v0[1]); w.y = pk2(v0[2], v0[3]); w.z = pk2(v1[0], v1[1]); w.w = pk2(v1[2], v1[3]);
                        *(u32x4*)(rowp + bj * HALF) = w; }
                }
            }
        } else if (u.kind == K_STORE_T) {
            bf16_t* base; const bool scale = (u.sub == 0);
            if (u.sub == 0) base = (bf16_t*)(ws + WS_VTSB) + (size_t)u.pm * 256 * VTLD + u.pn * 256;
            else base = (bf16_t*)(ws + WS_KVM) + (size_t)u.l * 1024 * 1024 + 256 * 2048 + u.pn * 256;
            const int ldc = (u.sub == 0) ? VTLD : 2048;
            f32x4 cs[2][2];
#pragma unroll
            for (int bj = 0; bj < 2; ++bj)
#pragma unroll
                for (int n = 0; n < 2; ++n)
#pragma unroll
                    for (int j = 0; j < 4; ++j) cs[bj][n][j] = scale ? SSROW(u.pn, cl0 + bj * HALF + 4 * n + j) : 1.0f;
#pragma unroll
            for (int ai = 0; ai < 2; ++ai)
#pragma unroll
                for (int m = 0; m < 4; ++m) {
                    const int rl = rl0 + ai * HALF + m * 16;
                    bf16_t* rowp = base + (size_t)rl * ldc + cl0;
#pragma unroll
                    for (int bj = 0; bj < 2; ++bj) { const f32x4 v0 = acc[ai][bj][m][0] * cs[bj][0], v1 = acc[ai][bj][m][1] * cs[bj][1];
                        u32x4 w; w.x = pk2(v0[0], v0[1]); w.y = pk2(v0[2], v0[3]); w.z = pk2(v1[0], v1[1]); w.w = pk2(v1[2], v1[3]);
                        *(u32x4*)(rowp + bj * HALF) = w; }
                }
        } else if (u.kind == K_AB) {
            if (wc == 0 && fq == 0) {
                float* base = (float*)(ws + WS_AB) + (size_t)u.pm * 256 * 8;
#pragma unroll
                for (int ai = 0; ai < 2; ++ai)
#pragma unroll
                    for (int m = 0; m < 4; ++m) {
                        const int rl = rl0 + ai * HALF + m * 16;
                        const float sc = SSROW(u.pm, rl);
                        float* rowp = base + (size_t)rl * 8;
                        *(f32x4*)(rowp) = acc[ai][0][m][0] * sc; *(f32x4*)(rowp + 4) = acc[ai][0][m][1] * sc;
                    }
            }
        } else if (u.kind == K_GATE) {
            unsigned char* base = scratch_tile(u.pm, u.pn);
            const float* bias = b_gate + (size_t)u.l * 4096 + (u.sub & 3) * 1024 + u.pn * 256;
            f32x4 bv[2][2];
#pragma unroll
            for (int bj = 0; bj < 2; ++bj)
#pragma unroll
#if SS_PREFETCH
                for (int n = 0; n < 2; ++n) bv[bj][n] = *(const LAS f32x4*)(bil + cl0 + bj * HALF + 4 * n) * -1.4426950408889634f;
#else
                for (int n = 0; n < 2; ++n) bv[bj][n] = *(const f32x4*)(bias + cl0 + bj * HALF + 4 * n) * -1.4426950408889634f;
#endif
            float scq[2][4];
#pragma unroll
            for (int ai = 0; ai < 2; ++ai)
#pragma unroll
                for (int m = 0; m < 4; ++m) scq[ai][m] = SSROW(u.pm, rl0 + ai * HALF + m * 16) * -1.4426950408889634f;
#pragma unroll
            for (int ai = 0; ai < 2; ++ai)
#pragma unroll
                for (int m = 0; m < 4; ++m) {
                    const int rl = rl0 + ai * HALF + m * 16;
                    const float sc = scq[ai][m];
                    unsigned char* rowp = base + (size_t)rl * SCRLD + cl0;
#pragma unroll
                    for (int bj = 0; bj < 2; ++bj) { const f32x4 v0 = acc[ai][bj][m][0] * sc + bv[bj][0], v1 = acc[ai][bj][m][1] * sc + bv[bj][1];
                        unsigned pa = 0u, pb = 0u;
#define G255(x) __builtin_amdgcn_rcpf(__builtin_amdgcn_exp2f(x) * (1.0f / 255.0f) + (1.0f / 255.0f))
                        pa = __builtin_amdgcn_cvt_pk_u8_f32(G255(v0[0]), 0, pa); pa = __builtin_amdgcn_cvt_pk_u8_f32(G255(v0[1]), 1, pa);
                        pa = __builtin_amdgcn_cvt_pk_u8_f32(G255(v0[2]), 2, pa); pa = __builtin_amdgcn_cvt_pk_u8_f32(G255(v0[3]), 3, pa);
                        pb = __builtin_amdgcn_cvt_pk_u8_f32(G255(v1[0]), 0, pb); pb = __builtin_amdgcn_cvt_pk_u8_f32(G255(v1[1]), 1, pb);
                        pb = __builtin_amdgcn_cvt_pk_u8_f32(G255(v1[2]), 2, pb); pb = __builtin_amdgcn_cvt_pk_u8_f32(G255(v1[3]), 3, pb);
#undef G255
                        EPI_ST((u32x2*)(rowp + bj * HALF), ((u32x2){pa, pb})); }
                }
        } else if (u.kind == K_BRANCH) {
            bf16_t* base = (bf16_t*)(ws + WS_MRG) + (size_t)u.pm * 256 * MRGLD + u.pn * 256; const unsigned char* gbase = scratch_tile(u.pm, u.pn);
            const bool first = (u.sub & 4) != 0;
            const float i255 = 1.0f / 255.0f;
#ifdef BR_ALL_IN_FLIGHT
            u32x2 gq2[2][4][2]; u32x4 tq[2][4][2];
#pragma unroll
            for (int ai = 0; ai < 2; ++ai)
#pragma unroll
                for (int m = 0; m < 4; ++m) { const int rl = rl0 + ai * HALF + m * 16;
#pragma unroll
                    for (int bj = 0; bj < 2; ++bj) { gq2[ai][m][bj] = EPI_LD((const u32x2*)(gbase + (size_t)rl * SCRLD + cl0 + bj * HALF));
                        tq[ai][m][bj] = first ? (u32x4){0u, 0u, 0u, 0u} : EPI_LD((const u32x4*)(base + (size_t)rl * MRGLD + cl0 + bj * HALF)); } }
#pragma unroll
            for (int ai = 0; ai < 2; ++ai) {
#pragma unroll
                for (int m = 0; m < 4; ++m) { const int rl = rl0 + ai * HALF + m * 16;
#pragma unroll
                    for (int bj = 0; bj < 2; ++bj) {
                        const u32x4 t = tq[ai][m][bj]; const f32x4 v0 = acc[ai][bj][m][0], v1 = acc[ai][bj][m][1]; const unsigned ga = gq2[ai][m][bj].x, gb = gq2[ai][m][bj].y;
                        u32x4 w;
                        w.x = pk2(bflo(t.x) + (float)(ga & 0xffu) * v0[0], bfhi(t.x) + (float)((ga >> 8) & 0xffu) * v0[1]);
                        w.y = pk2(bflo(t.y) + (float)((ga >> 16) & 0xffu) * v0[2], bfhi(t.y) + (float)(ga >> 24) * v0[3]);
                        w.z = pk2(bflo(t.z) + (float)(gb & 0xffu) * v1[0], bfhi(t.z) + (float)((gb >> 8) & 0xffu) * v1[1]);
                        w.w = pk2(bflo(t.w) + (float)((gb >> 16) & 0xffu) * v1[2], bfhi(t.w) + (float)(gb >> 24) * v1[3]);
                        EPI_ST((u32x4*)(base + (size_t)rl * MRGLD + cl0 + bj * HALF), w); } }
                asm volatile("" ::: "memory");
            }
#else
#pragma unroll
            for (int ai = 0; ai < 2; ++ai) {
                u32x2 gq2[4][2]; u32x4 tq[4][2];
#pragma unroll
                for (int m = 0; m < 4; ++m) { const int rl = rl0 + ai * HALF + m * 16;
#pragma unroll
                    for (int bj = 0; bj < 2; ++bj) { gq2[m][bj] = EPI_LD((const u32x2*)(gbase + (size_t)rl * SCRLD + cl0 + bj * HALF));
                        tq[m][bj] = first ? (u32x4){0u, 0u, 0u, 0u} : EPI_LD((const u32x4*)(base + (size_t)rl * MRGLD + cl0 + bj * HALF)); } }
#pragma unroll
                for (int m = 0; m < 4; ++m) { const int rl = rl0 + ai * HALF + m * 16;
#pragma unroll
                    for (int bj = 0; bj < 2; ++bj) {
                        const u32x4 t = tq[m][bj]; const f32x4 v0 = acc[ai][bj][m][0], v1 = acc[ai][bj][m][1]; const unsigned ga = gq2[m][bj].x, gb = gq2[m][bj].y;
                        u32x4 w;
                        w.x = pk2(bflo(t.x) + (float)(ga & 0xffu) * v0[0], bfhi(t.x) + (float)((ga >> 8) & 0xffu) * v0[1]);
                        w.y = pk2(bflo(t.y) + (float)((ga >> 16) & 0xffu) * v0[2], bfhi(t.y) + (float)(ga >> 24) * v0[3]);
                        w.z = pk2(bflo(t.z) + (float)(gb & 0xffu) * v1[0], bfhi(t.z) + (float)((gb >> 8) & 0xffu) * v1[1]);
                        w.w = pk2(bflo(t.w) + (float)((gb >> 16) & 0xffu) * v1[2], bfhi(t.w) + (float)(gb >> 24) * v1[3]);
                        EPI_ST((u32x4*)(base + (size_t)rl * MRGLD + cl0 + bj * HALF), w); } }
                asm volatile("" ::: "memory");
            }
#endif
        } else {
            bf16_t* base = (bf16_t*)(ws + WS_XN) + (size_t)u.pm * 256 * 1024 + u.pn * 256;
            const bool wxn = gnext != nullptr, fin = gfinal != nullptr;
            f32x4 gv[2][2];
#pragma unroll
            for (int bj = 0; bj < 2; ++bj)
#pragma unroll
                for (int n = 0; n < 2; ++n) gv[bj][n] = fin ? *(const f32x4*)(gfinal + u.pn * BM + cl0 + bj * HALF + 4 * n) : (f32x4){0.f, 0.f, 0.f, 0.f};
#pragma unroll
            for (int ah = 0; ah < 4; ++ah) {
                const int ai = ah >> 1, m0 = (ah & 1) * 2;
                f32x4 xq[2][2][2];
#pragma unroll
                for (int mm = 0; mm < 2; ++mm) { const size_t goff = (size_t)(u.pm * BM + rl0 + ai * HALF + (m0 + mm) * 16) * D + u.pn * BM + cl0;
#pragma unroll
                    for (int bj = 0; bj < 2; ++bj) {
                        const u32x4 t = *(const u32x4*)(base + (size_t)(rl0 + ai * HALF + (m0 + mm) * 16) * 1024 + cl0 + bj * HALF); (void)goff;
                        xq[mm][bj][0] = (f32x4){bflo(t.x), bfhi(t.x), bflo(t.y), bfhi(t.y)}; xq[mm][bj][1] = (f32x4){bflo(t.z), bfhi(t.z), bflo(t.w), bfhi(t.w)}; } }
#pragma unroll
                for (int mm = 0; mm < 2; ++mm) {
                    const int m = m0 + mm, rl = rl0 + ai * HALF + m * 16;
                    const size_t goff = (size_t)(u.pm * BM + rl) * D + u.pn * BM + cl0;
                    float sq = 0.f;
#pragma unroll
                    for (int bj = 0; bj < 2; ++bj) {
                        const f32x4 v0 = acc[ai][bj][m][0] + xq[mm][bj][0], v1 = acc[ai][bj][m][1] + xq[mm][bj][1];
                        acc[ai][bj][m][0] = v0; acc[ai][bj][m][1] = v1;
                        if (wout32) { *(f32x4*)(xout + goff + bj * HALF) = v0; *(f32x4*)(xout + goff + bj * HALF + 4) = v1; }
                        sq += (v0[0] * v0[0] + v0[1] * v0[1]) + (v0[2] * v0[2] + v0[3] * v0[3]) + (v1[0] * v1[0] + v1[1] * v1[1]) + (v1[2] * v1[2] + v1[3] * v1[3]);
                        if (wxn) { const f32x4 a = v0, b = v1;
                            u32x4 w; w.x = pk2(a[0], a[1]); w.y = pk2(a[2], a[3]); w.z = pk2(b[0], b[1]); w.w = pk2(b[2], b[3]);
                            *(u32x4*)(base + (size_t)rl * 1024 + cl0 + bj * HALF) = w; }
                    }
                    sq += shx(sq, 16, lane); sq += shx(sq, 32, lane);
                    if (fq == 0) spare[rl * 4 + wc] = sq;
                }
                asm volatile("" ::: "memory");
            }
            LDS_WAIT(); __builtin_amdgcn_s_barrier(); asm volatile("" ::: "memory");
            const int t_ = wr * 256 + wc * 64 + lane;
            unsigned* ssw = (unsigned*)(ws + WS_SS);
            if (t_ < 256) { const int rl = t_; const f32x4 p = *(const LAS f32x4*)(spare + rl * 4); const float tot = (p.x + p.y) + (p.z + p.w);
                if (fin) __hip_atomic_store(ssw + (size_t)(u.pm * BM + rl) * 4 + u.pn, __builtin_bit_cast(unsigned, tot), __ATOMIC_RELAXED, __HIP_MEMORY_SCOPE_AGENT);
                else ((float*)ssw)[(size_t)(u.pm * BM + rl) * 4 + u.pn] = tot; }
            if (fin) {
                unsigned* cnt = (unsigned*)(ws + WS_CTL) + CW_PANEL + 64 * u.pm;
                asm volatile("s_waitcnt vmcnt(0)" ::: "memory");
                __builtin_amdgcn_s_barrier(); asm volatile("" ::: "memory");
                if (t_ == 0) {
                    __hip_atomic_fetch_add(cnt, 1u, __ATOMIC_RELAXED, __HIP_MEMORY_SCOPE_AGENT);
                    unsigned sp_ = 0;
                    while (__hip_atomic_load(cnt, __ATOMIC_RELAXED, __HIP_MEMORY_SCOPE_AGENT) < 4u) { __builtin_amdgcn_s_sleep(1); if (++sp_ > (1u << 22)) break; }
                }
                __builtin_amdgcn_s_barrier(); asm volatile("" ::: "memory");
#pragma unroll
                for (int ai = 0; ai < 2; ++ai)
#pragma unroll
                    for (int m = 0; m < 4; ++m) {
                        const int rl = rl0 + ai * HALF + m * 16; const unsigned* sp4 = ssw + (size_t)(u.pm * BM + rl) * 4;
                        const float p0 = __builtin_bit_cast(float, __hip_atomic_load(sp4 + 0, __ATOMIC_RELAXED, __HIP_MEMORY_SCOPE_AGENT)), p1 = __builtin_bit_cast(float, __hip_atomic_load(sp4 + 1, __ATOMIC_RELAXED, __HIP_MEMORY_SCOPE_AGENT));
                        const float p2 = __builtin_bit_cast(float, __hip_atomic_load(sp4 + 2, __ATOMIC_RELAXED, __HIP_MEMORY_SCOPE_AGENT)), p3 = __builtin_bit_cast(float, __hip_atomic_load(sp4 + 3, __ATOMIC_RELAXED, __HIP_MEMORY_SCOPE_AGENT));
                        const float rs = rsqrtf(((p0 + p1) + (p2 + p3)) * (1.0f / 1024.0f) + EPS);
                        const size_t goff = (size_t)(u.pm * BM + rl) * D + u.pn * BM + cl0;
#pragma unroll
                        for (int bj = 0; bj < 2; ++bj) { __builtin_nontemporal_store(acc[ai][bj][m][0] * rs * gv[bj][0], (f32x4*)(xout + goff + bj * HALF)); __builtin_nontemporal_store(acc[ai][bj][m][1] * rs * gv[bj][1], (f32x4*)(xout + goff + bj * HALF + 4)); }
                    }
            }
        }
    }
};
}

struct Args {
    const float* x; const float* mem; const int* positions; const float* norm_g; const float* mem_norm_g; const float* w_in; const float* b_gate;
    const float* dn_conv_w; const float* dn_a_log; const float* dn_dt_bias; const float* dn_norm_g; const float* ret_norm_g; const float* w_mem_kv;
    const float* w_br_sb; const float* w_br_dn; const float* w_br_ret; const float* w_br_mem; const float* w_out; const float* final_norm_g;
    float* out; unsigned char* ws; int ph_lo, ph_hi, li, pad;
};
struct Frame { LAS unsigned char* lds; int tid, lane, wave, G, gw, NGW; };
DI Frame mkframe(int wv) {
    extern __shared__ __attribute__((aligned(16))) unsigned char lds_raw[];
    Frame F; F.lds = (LAS unsigned char*)lds_raw; F.tid = opaque_tid(wv); F.lane = F.tid & 63; F.wave = wv;
    F.G = gridDim.x; F.gw = opaque_bid() * NWAVES + F.wave; F.NGW = F.G * NWAVES; return F;
}
typedef const __attribute__((address_space(4))) Args* ArgsP;
DI ArgsP kargs() { unsigned long long p = (unsigned long long)__builtin_amdgcn_kernarg_segment_ptr(); asm volatile("" : "+s"(p)); return (ArgsP)p; }
DI unsigned char* rst_base(ArgsP ap, int l) { return l == 0 ? (unsigned char*)ap->out : ap->ws + WS_WG + (size_t)(l - 1) * 4096 * 1024 * 2; }

struct TItem { const float* W; bf16_t* WT; const float* g; float sc; int K, Nsrc, k0, csrc, rdst, rs; };
DI void titem_load(const TItem& t, int lane, float (&v)[32]) {
#pragma unroll
    for (int i = 0; i < 32; ++i) v[i] = __builtin_nontemporal_load(t.W + (size_t)(t.k0 + 2 * i + (lane >> 5)) * t.Nsrc + t.csrc + (lane & 31));
}
DI void titem_store(LAS float* scr, int lane, const TItem& t, const float (&v)[32]) {
#pragma unroll
    for (int i = 0; i < 32; ++i) scr[(2 * i + (lane >> 5)) * 33 + (lane & 31)] = v[i];
    LDS_WAIT(); asm volatile("" ::: "memory");
    const int c = lane & 7;
    f32x4 g0 = {1.f, 1.f, 1.f, 1.f}, g1 = g0;
    if (t.g != nullptr) { g0 = *(const f32x4*)(t.g + t.k0 + 8 * c); g1 = *(const f32x4*)(t.g + t.k0 + 8 * c + 4); }
    g0 = g0 * t.sc; g1 = g1 * t.sc;
#pragma unroll
    for (int j = 0; j < 4; ++j) { const int n = (lane >> 3) + 8 * j; const LAS float* sp = scr + (8 * c) * 33 + n;
        u32x4 o; o.x = pk2(sp[0 * 33] * g0.x, sp[1 * 33] * g0.y); o.y = pk2(sp[2 * 33] * g0.z, sp[3 * 33] * g0.w); o.z = pk2(sp[4 * 33] * g1.x, sp[5 * 33] * g1.y); o.w = pk2(sp[6 * 33] * g1.z, sp[7 * 33] * g1.w);
        *(u32x4*)(t.WT + (size_t)(t.rdst + n * t.rs) * t.K + t.k0 + 8 * c) = o; }
    LDS_WAIT(); asm volatile("" ::: "memory");
}
DI void memn_rows(const Frame& F, ArgsP ap, int l) {
    unsigned char* ws = ap->ws;
    for (int m = F.gw; m < BATCH * MEMLEN; m += F.NGW) {
        const f32x4* xr = (const f32x4*)(ap->mem + (size_t)m * D) + F.lane; const f32x4* gr = (const f32x4*)(ap->mem_norm_g + (size_t)l * D) + F.lane;
        f32x4 v[4]; float sq = 0.f;
#pragma unroll
        for (int j = 0; j < 4; ++j) { v[j] = xr[64 * j]; sq += (v[j].x * v[j].x + v[j].y * v[j].y) + (v[j].z * v[j].z + v[j].w * v[j].w); }
        const float rs = rsqrtf(wave_sum(sq, F.lane) * (1.f / D) + EPS);
        unsigned long long* o8 = (unsigned long long*)((bf16_t*)(ws + WS_MEMN) + (size_t)m * D) + F.lane;
#pragma unroll
        for (int j = 0; j < 4; ++j) { const f32x4 g = gr[64 * j];
            o8[64 * j] = (unsigned long long)pk2(v[j].x * rs * g.x, v[j].y * rs * g.y) | ((unsigned long long)pk2(v[j].z * rs * g.z, v[j].w * rs * g.w) << 32); }
    }
}
struct TSeg { int src, K, Nsrc, c0, ncols, dst, r0; };
DI void convert_weights(const Frame& F, ArgsP ap, int l, int first, int stride, int part) {
    unsigned char* ws = ap->ws;
    LAS float* scr = (LAS float*)(F.lds + F.wave * 16384);
    constexpr int NSEG = 14;
    const TSeg seg[NSEG] = {
        {0, 1024, IN_COLS, 2048, 2048, 0, 0}, {0, 1024, IN_COLS, 5640, 256, 0, 2304}, {0, 1024, IN_COLS, 4104, 256, 0, 2560}, {0, 1024, IN_COLS, 4360, 256, 0, 2816},
        {0, 1024, IN_COLS, 0, 1024, 1, 0}, {0, 1024, IN_COLS, 1536, 512, 1, 1024}, {0, 1024, IN_COLS, 5128, 512, 1, 1536}, {0, 1024, IN_COLS, 1024, 512, 1, 2048}, {0, 1024, IN_COLS, 4616, 512, 1, 2560},
        {0, 1024, IN_COLS, 5896, 4096, 2, 0},
        {1, 512, 1024, 0, 1024, 3, 0}, {2, 512, 1024, 0, 1024, 3, 1024}, {3, 512, 1024, 0, 1024, 3, 2048}, {5, 1024, 1024, 0, 1024, 4, 0} };
    int cum[NSEG + 1]; cum[0] = 0;
#pragma unroll
    for (int q = 0; q < NSEG; ++q) cum[q + 1] = cum[q] + (seg[q].K / 64) * (seg[q].ncols / 32);
    const int per_layer = cum[NSEG] + (256 / 64) * (1024 / 32) + (1024 / 64) * (512 / 32);
    const int c9 = cum[9], c14m = cum[NSEG] + 128;
    const int n1 = c9 + (per_layer - c14m), n2 = c14m - c9, nit = part == 0 ? per_layer : (part == 1 ? n1 : n2);
    auto params = [&](int it, TItem& t) -> bool {
        if (it >= nit) return false;
        int r = part == 0 ? it : (part == 1 ? (it < c9 ? it : it - c9 + c14m) : it + c9);
        const float* W; int K, Nsrc, c0, ncols, r0; bf16_t* WT; bool perm = false;
        if (r < cum[NSEG]) {
            int q = 0;
#pragma unroll
            for (int qq = 1; qq < NSEG; ++qq) if (r >= cum[qq]) q = qq;
            int src = 0, dst = 0; K = 1024; Nsrc = IN_COLS; c0 = 0; ncols = 32; r0 = 0; int base = 0;
#pragma unroll
            for (int qq = 0; qq < NSEG; ++qq) if (q == qq) { src = seg[qq].src; K = seg[qq].K; Nsrc = seg[qq].Nsrc; c0 = seg[qq].c0; ncols = seg[qq].ncols; dst = seg[qq].dst; r0 = seg[qq].r0; base = cum[qq]; }
            r -= base; perm = (q == 2 || q == 3);
            W = src == 0 ? ap->w_in + (size_t)l * D * IN_COLS : src == 1 ? ap->w_br_sb + (size_t)l * 512 * 1024 : src == 2 ? ap->w_br_dn + (size_t)l * 512 * 1024 : src == 3 ? ap->w_br_ret + (size_t)l * 512 * 1024 : ap->w_out + (size_t)l * 1024 * 1024;
            WT = dst == 0 ? (bf16_t*)(ws + WS_WINA) + (size_t)l * 3072 * 1024 : dst == 1 ? (bf16_t*)(ws + WS_WINB) + (size_t)l * 3072 * 1024 : dst == 2 ? (bf16_t*)(ws + WS_WG) + (size_t)l * 4096 * 1024
               : dst == 3 ? (bf16_t*)(ws + WS_WBR) + (size_t)l * 2 * 1024 * 1024 : (bf16_t*)(ws + WS_WOUT) + (size_t)l * 1024 * 1024;
            if (dst == 3) { WT += (size_t)r0 * 512; r0 = 0; }
        } else if (r < cum[NSEG] + 128) { r -= cum[NSEG]; W = ap->w_br_mem + (size_t)l * 256 * 1024; K = 256; Nsrc = 1024; c0 = 0; ncols = 1024; r0 = 0; WT = (bf16_t*)(ws + WS_WBR) + (size_t)l * 2 * 1024 * 1024 + 3 * 1024 * 512; }
        else { r -= cum[NSEG] + 128; W = ap->w_mem_kv + (size_t)l * 1024 * 512; K = 1024; Nsrc = 512; c0 = 0; ncols = 512; r0 = 0; WT = (bf16_t*)(ws + WS_WKV) + (size_t)l * 512 * 1024; }
        const int nblk = ncols / 32, kb = r / nblk, nb = r % nblk;
        t.W = W; t.WT = WT; t.g = (W == ap->w_in + (size_t)l * D * IN_COLS) ? ap->norm_g + (size_t)l * D : nullptr;
        t.sc = ((unsigned char*)WT >= ws + WS_WBR && (unsigned char*)WT < ws + WS_WOUT) ? (1.0f / 255.0f) : 1.0f;
        t.K = K; t.Nsrc = Nsrc; t.k0 = 64 * kb; t.csrc = c0 + 32 * nb; t.rdst = perm ? r0 + (nb >> 1) * 64 + (nb & 1) : r0 + 32 * nb; t.rs = perm ? 2 : 1;
        return true;
    };
    {
        TItem ta, tb; float va[32], vb[32];
        int it = first;
        bool ha = params(it, ta); if (ha) titem_load(ta, F.lane, va);
        while (ha) {
            it += stride; const bool hb = params(it, tb); if (hb) titem_load(tb, F.lane, vb);
            titem_store(scr, F.lane, ta, va);
            if (!hb) break;
            it += stride; ha = params(it, ta); if (ha) titem_load(ta, F.lane, va);
            titem_store(scr, F.lane, tb, vb);
        }
    }
    if (part != 2) {
        const float* win = ap->w_in + (size_t)l * D * IN_COLS; bf16_t* wa = (bf16_t*)(ws + WS_WINA) + (size_t)l * 3072 * 1024;
        for (int i = first * 64 + F.lane; i < 256 * 1024; i += stride * 64) { const int r = i >> 10, k = i & 1023;
            wa[(size_t)(2048 + r) * 1024 + k] = r < 8 ? (bf16_t)f2bf(win[(size_t)k * IN_COLS + 4096 + r] * ap->norm_g[(size_t)l * D + k]) : (bf16_t)0; }
    }
}
DI void p0_prologue(int wv) {
    const Frame F = mkframe(wv);
    const ArgsP ap = kargs();
    unsigned char* ws = ap->ws;
#ifdef PROBE_PRO
    unsigned long long tq0_ = __builtin_amdgcn_s_memrealtime();
#define PRO_ECHO(k) do { asm volatile("s_waitcnt vmcnt(0)" ::: "memory"); const unsigned long long t1_ = __builtin_amdgcn_s_memrealtime(); if (PROBE_PRO == (k)) { const unsigned long long d_ = t1_ - tq0_; while (__builtin_amdgcn_s_memrealtime() - t1_ < d_) __builtin_amdgcn_s_sleep(2); } tq0_ = __builtin_amdgcn_s_memrealtime(); } while (0)
#else
#define PRO_ECHO(k) do { } while (0)
#endif
    convert_weights(F, ap, 0, F.gw, F.NGW, 1);
    PRO_ECHO(1);
    constexpr int XNR = 4;
    for (int m = XNR * F.gw; m < T; m += XNR * F.NGW) {
        f32x4 v[XNR][4]; const f32x4* gr = (const f32x4*)ap->norm_g + F.lane;
#pragma unroll
        for (int q = 0; q < XNR; ++q)
#pragma unroll
            for (int j = 0; j < 4; ++j) v[q][j] = __builtin_nontemporal_load((const f32x4*)(ap->x + (size_t)(m + q) * D) + F.lane + 64 * j);
#pragma unroll
        for (int q = 0; q < XNR; ++q) {
            unsigned long long* o8 = (unsigned long long*)((bf16_t*)(ws + WS_XN) + (size_t)(m + q) * D) + F.lane; float sq = 0.f;
#pragma unroll
            for (int j = 0; j < 4; ++j) { const f32x4 x = v[q][j], g = gr[64 * j]; sq += (x.x * x.x + x.y * x.y) + (x.z * x.z + x.w * x.w);
                (void)g; o8[64 * j] = (unsigned long long)pk2(x.x, x.y) | ((unsigned long long)pk2(x.z, x.w) << 32); }
            sq = wave_sum(sq, F.lane);
            if (F.lane == 0) *(f32x4*)((float*)(ws + WS_SS) + (size_t)(m + q) * 4) = (f32x4){sq, 0.f, 0.f, 0.f};
        }
    }
    PRO_ECHO(2);
    memn_rows(F, ap, 0);
    PRO_ECHO(3);
    for (int i = F.gw * 64 + F.lane; i < T * 32; i += F.NGW * 64) {
        const int t = i >> 5, f = i & 31;
        const float inv = exp2f(-(float)f * (13.287712379549449f / 32.0f));
        const float ang = (float)ap->positions[t] * inv;
#ifdef ROPE_FAST_SINCOS
        const float rev = ang * 0.15915494309189535f; const float fr = rev - floorf(rev);
        const float sn = __builtin_amdgcn_sinf(fr), cs = __builtin_amdgcn_cosf(fr);
#else
        float sn, cs; sincosf(ang, &sn, &cs);
#endif
        ((float*)(ws + WS_ROPE))[i] = cs; ((float*)(ws + WS_ROPE))[T * 32 + i] = sn;
    }
}

struct SchedP1 {
    gm::TileOrder ord; unsigned char* ws; int l, half, c; bool with_kvm;
    DI void a_ready(const gm::Unit&, int, int) const {}
    DI bool next(int i, gm::Unit& u) const {
        int pm, pn;
        if (ord.tile(i, pm, pn)) {
            const bf16_t* xn = (const bf16_t*)(ws + WS_XN) + (size_t)pm * 256 * 1024;
            const bf16_t* w = (const bf16_t*)(ws + (half == 0 ? WS_WINA : WS_WINB)) + ((size_t)l * 3072 + pn * 256) * 1024;
            u.lda = 1024; u.K = 1024; u.ldb = 1024; u.l = l; u.sub = half;
            if (half == 1 && pn >= 8) { u.A = w; u.B = xn; u.pm = pn - 8; u.pn = pm; u.kind = gm::K_STORE_T; u.sub = 0; }
            else { u.A = xn; u.B = w; u.pm = pm; u.pn = pn; u.kind = (half == 0 && pn == 8) ? gm::K_AB : gm::K_STORE; }
            return true;
        }
        const int kc = ord.c - (ord.nwg % ord.G);
        if (with_kvm && kc >= 0 && kc < 16 && i == (ord.nwg + ord.G - 1 - ord.c) / ord.G) {
            const int ll = l, ty = (kc >> 3) & 1, idx = kc & 7;
            const bf16_t* mn = (const bf16_t*)(ws + WS_MEMN) + (size_t)(idx * 256) * 1024;
            const bf16_t* w = (const bf16_t*)(ws + WS_WKV) + ((size_t)ll * 512 + ty * 256) * 1024;
            u.lda = 1024; u.K = 1024; u.ldb = 1024; u.l = ll;
            if (ty == 0) { u.A = mn; u.B = w; u.pm = idx; u.pn = 0; u.kind = gm::K_STORE; u.sub = 2; }
            else { u.A = w; u.B = mn; u.pm = 0; u.pn = idx; u.kind = gm::K_STORE_T; u.sub = 1; }
            return true;
        }
        return false;
    }
};
struct SchedP3 {
    int pm, pn, l, rot; bool ok; unsigned char* ws;
    DI void a_ready(const gm::Unit& u, int wid, int lane) const {
        if (u.kind != gm::K_BRANCH || (u.sub & 4) == 0) return;
        if (wid == 0) {
            if (lane == 0) { unsigned* cnt = (unsigned*)(ws + WS_CTL) + CW_READY + 4096 * l + 64 * pm; unsigned sp = 0u;
                while (__hip_atomic_load(cnt, __ATOMIC_RELAXED, __HIP_MEMORY_SCOPE_AGENT) < 16u) { __builtin_amdgcn_s_sleep(2); if (++sp > (1u << 20)) break; } }
            __builtin_amdgcn_fence(__ATOMIC_ACQUIRE, "agent");
            asm volatile("s_waitcnt vmcnt(0)" ::: "memory");
        }
        asm volatile("" ::: "memory"); __builtin_amdgcn_s_barrier(); asm volatile("" ::: "memory");
    }
    DI bool next(int i, gm::Unit& u) const {
        if (!ok || i >= 8) return false;
        const int br = ((i >> 1) + rot) & 3;
        const bf16_t* R = (const bf16_t*)(ws + WS_R); const bf16_t* P = (const bf16_t*)(ws + WS_P);
        u.pm = pm; u.pn = pn; u.sub = br | ((i >> 1) == 0 ? 4 : 0); u.l = l;
        if ((i & 1) == 0) {
            u.A = (const bf16_t*)(ws + WS_XN) + (size_t)pm * 256 * 1024; u.lda = 1024; u.K = 1024; u.ldb = 1024;
            u.B = (const bf16_t*)(ws + WS_WG) + ((size_t)l * 4096 + br * 1024 + pn * 256) * 1024;
            u.kind = gm::K_GATE;
        } else {
            const bf16_t* wbr = (const bf16_t*)(ws + WS_WBR) + (size_t)l * 2 * 1024 * 1024 + (size_t)br * 1024 * 512;
            const int K = br == 3 ? 256 : 512;
            const int acol = br == 0 ? RB_SBQ : (br == 1 ? P_DNZ : (br == 2 ? RB_RTZ : P_MEMQ));
            const bool inP = (br & 1) != 0;
            u.lda = inP ? PLD : RBLD; u.A = (inP ? P : R) + (size_t)pm * 256 * u.lda + acol; u.K = K; u.ldb = K; u.B = wbr + (size_t)pn * 256 * K;
            u.kind = gm::K_BRANCH;
        }
        return true;
    }
};
struct SchedP4 {
    int pm, pn, l; bool ok; unsigned char* ws;
    DI void a_ready(const gm::Unit&, int, int) const {}
    DI bool next(int i, gm::Unit& u) const {
        if (!ok || i >= 1) return false;
        u.A = (const bf16_t*)(ws + WS_MRG) + (size_t)pm * 256 * MRGLD; u.lda = MRGLD; u.K = 1024; u.ldb = 1024;
        u.B = (const bf16_t*)(ws + WS_WOUT) + ((size_t)l * 1024 + pn * 256) * 1024;
        u.pm = pm; u.pn = pn; u.kind = gm::K_OUT; u.sub = 0; u.l = l;
        return true;
    }
};

typedef float f32x16 __attribute__((ext_vector_type(16)));
typedef short s16x4 __attribute__((ext_vector_type(4)));
#define MFMA32(a, b, c) __builtin_amdgcn_mfma_f32_32x32x16_bf16((a), (b), (c), 0, 0, 0)
DI int crow(int reg, int hh) { return (reg & 3) + 8 * (reg >> 2) + 4 * hh; }
DI bf16x8 pack8(float a0, float a1, float a2, float a3, float a4, float a5, float a6, float a7) {
    u32x4 p;
    asm volatile("s_nop 0\n\tv_cvt_pk_bf16_f32 %0, %4, %5\n\tv_cvt_pk_bf16_f32 %1, %6, %7\n\tv_cvt_pk_bf16_f32 %2, %8, %9\n\tv_cvt_pk_bf16_f32 %3, %10, %11\n\ts_nop 1"
                 : "=&v"(p[0]), "=&v"(p[1]), "=&v"(p[2]), "=&v"(p[3]) : "v"(a0), "v"(a1), "v"(a2), "v"(a3), "v"(a4), "v"(a5), "v"(a6), "v"(a7));
    return __builtin_bit_cast(bf16x8, p);
}
DI bf16x8 pack8m(float a0, float a1, float a2, float a3, float a4, float a5, float a6, float a7) {
    u32x4 p;
    asm volatile("s_nop 15\n\ts_nop 3\n\tv_cvt_pk_bf16_f32 %0, %4, %5\n\tv_cvt_pk_bf16_f32 %1, %6, %7\n\tv_cvt_pk_bf16_f32 %2, %8, %9\n\tv_cvt_pk_bf16_f32 %3, %10, %11\n\ts_nop 1"
                 : "=&v"(p[0]), "=&v"(p[1]), "=&v"(p[2]), "=&v"(p[3]) : "v"(a0), "v"(a1), "v"(a2), "v"(a3), "v"(a4), "v"(a5), "v"(a6), "v"(a7));
    return __builtin_bit_cast(bf16x8, p);
}
namespace at {
constexpr int KST = 144, VST = 136;
constexpr int KT_BYTES = 64 * KST;
DI bf16x8 kfrag(LAS unsigned char* kt, int row, int ks, int hh) { return *(const LAS bf16x8*)(kt + row * KST + ks * 32 + hh * 16); }
DI bf16x8 vfrag(LAS unsigned char* vt, int row, int keyoff, int hh) {
    const LAS unsigned char* pp = vt + row * VST + (keyoff + 4 * hh) * 2;
    const u32x2 lo = *(const LAS u32x2*)pp, hi = *(const LAS u32x2*)(pp + 16);
    u32x4 r; r.x = lo.x; r.y = lo.y; r.z = hi.x; r.w = hi.y; return __builtin_bit_cast(bf16x8, r);
}
}

DI void mem_unit(int wv, int l, int unit) {
    const Frame F = mkframe(wv);
    unsigned char* ws = kargs()->ws; bf16_t* P = (bf16_t*)(ws + WS_P);
    const bf16_t* KM = (const bf16_t*)(ws + WS_KVM) + (size_t)l * 1024 * 1024; const bf16_t* VTM = KM + 2048 * 256;
    const int b = unit >> 5, h = (unit >> 3) & 3, qt = unit & 7, lane = F.lane, r = lane & 31, hh = lane >> 5;
    LAS unsigned char* kt = F.lds; LAS unsigned char* vt = F.lds + 256 * at::KST;
    constexpr int VS = 520;
#pragma unroll
    for (int i = 0; i < 4; ++i) { const int id = F.tid + 512 * i, row = id >> 3, ch = id & 7;
        const u32x4 v = *(const u32x4*)(KM + (size_t)(b * 256 + row) * 256 + h * 64 + ch * 8);
        *(LAS u32x4*)(kt + row * at::KST + ch * 16) = v; }
#pragma unroll
    for (int i = 0; i < 4; ++i) { const int id = F.tid + 512 * i, row = id >> 5, ch = id & 31;
        const u32x4 v = *(const u32x4*)(VTM + (size_t)(h * 64 + row) * 2048 + b * 256 + ch * 8);
        *(LAS u32x2*)(vt + row * VS + ch * 16) = (u32x2){v.x, v.y}; *(LAS u32x2*)(vt + row * VS + ch * 16 + 8) = (u32x2){v.z, v.w}; }
    const int t = b * SEQ + qt * 256 + wv * 32 + r;
    bf16_t* qp = P + (size_t)t * PLD + P_MEMQ + h * 64;
    bf16x8 qf[4];
#pragma unroll
    for (int ks = 0; ks < 4; ++ks) qf[ks] = *(const bf16x8*)(qp + 16 * ks + 8 * hh);
    __syncthreads();
    f32x16 z[8];
#pragma unroll
    for (int st = 0; st < 8; ++st) {
        f32x16 a = {0.f, 0.f, 0.f, 0.f, 0.f, 0.f, 0.f, 0.f, 0.f, 0.f, 0.f, 0.f, 0.f, 0.f, 0.f, 0.f};
#pragma unroll
        for (int ks = 0; ks < 4; ++ks) a = MFMA32(at::kfrag(kt, 32 * st + r, ks, hh), qf[ks], a);
        z[st] = a;
    }
    float mx = -3.0e38f;
#pragma unroll
    for (int st = 0; st < 8; ++st)
#pragma unroll
        for (int i = 0; i < 16; ++i) mx = fmaxf(mx, z[st][i]);
    mx = fmaxf(mx, shx(mx, 32, lane));
    const float c2 = 0.125f * 1.4426950408889634f; float sum = 0.f;
#pragma unroll
    for (int st = 0; st < 8; ++st)
#pragma unroll
        for (int i = 0; i < 16; ++i) { const float e = exp2f((z[st][i] - mx) * c2); z[st][i] = e; sum += e; }
    sum += shx(sum, 32, lane);
    f32x16 o0 = {0.f, 0.f, 0.f, 0.f, 0.f, 0.f, 0.f, 0.f, 0.f, 0.f, 0.f, 0.f, 0.f, 0.f, 0.f, 0.f}, o1 = o0;
#pragma unroll
    for (int st = 0; st < 8; ++st)
#pragma unroll
        for (int s2 = 0; s2 < 2; ++s2) {
            const bf16x8 pf = pack8(z[st][8 * s2], z[st][8 * s2 + 1], z[st][8 * s2 + 2], z[st][8 * s2 + 3], z[st][8 * s2 + 4], z[st][8 * s2 + 5], z[st][8 * s2 + 6], z[st][8 * s2 + 7]);
            const int keyoff = 32 * st + 16 * s2;
            { const LAS unsigned char* pp = vt + r * VS + (keyoff + 4 * hh) * 2; const u32x2 lo = *(const LAS u32x2*)pp, hi = *(const LAS u32x2*)(pp + 16);
              u32x4 q; q.x = lo.x; q.y = lo.y; q.z = hi.x; q.w = hi.y; o0 = MFMA32(__builtin_bit_cast(bf16x8, q), pf, o0); }
            { const LAS unsigned char* pp = vt + (32 + r) * VS + (keyoff + 4 * hh) * 2; const u32x2 lo = *(const LAS u32x2*)pp, hi = *(const LAS u32x2*)(pp + 16);
              u32x4 q; q.x = lo.x; q.y = lo.y; q.z = hi.x; q.w = hi.y; o1 = MFMA32(__builtin_bit_cast(bf16x8, q), pf, o1); }
        }
    const float inv = 1.f / sum;
    LAS unsigned char* ob = F.lds + 73728 + wv * (32 * at::KST);
#pragma unroll
    for (int g = 0; g < 4; ++g) {
        *(LAS u32x2*)(ob + r * at::KST + (8 * g + 4 * hh) * 2) = (u32x2){pk2(o0[4 * g] * inv, o0[4 * g + 1] * inv), pk2(o0[4 * g + 2] * inv, o0[4 * g + 3] * inv)};
        *(LAS u32x2*)(ob + r * at::KST + (32 + 8 * g + 4 * hh) * 2) = (u32x2){pk2(o1[4 * g] * inv, o1[4 * g + 1] * inv), pk2(o1[4 * g + 2] * inv, o1[4 * g + 3] * inv)};
    }
#pragma unroll
    for (int k = 0; k < 4; ++k) { const int q = k * 64 + lane, row = q >> 3, pc = q & 7;
        st16_wt(P + (size_t)(t - r + row) * PLD + P_MEMQ + h * 64 + pc * 8, *(const LAS u32x4*)(ob + row * at::KST + pc * 16)); }
    unit_done(ws, l, b * 8 + qt, F.tid);
}

DI void ret_rope_prep(int wv, int c, int n) {
    const Frame F = mkframe(wv);
    unsigned char* ws = kargs()->ws; bf16_t* P = (bf16_t*)(ws + WS_P);
    const float* rc = (const float*)(ws + WS_ROPE); const float* rsn = rc + T * 32;
    for (int it = c * NTHREADS + F.tid; it < T * 32; it += n * NTHREADS) {
        const int t = it >> 5, w = (it >> 4) & 1, h = (it >> 2) & 3, g = it & 3;
        bf16_t* pp = P + (size_t)t * PLD + (w ? P_RTK : P_RTQ) + h * 64 + g * 8;
        const u32x4 a = *(const u32x4*)pp, bq = *(const u32x4*)(pp + 32);
        const f32x4 c0 = *(const f32x4*)(rc + (size_t)t * 32 + g * 8), c1 = *(const f32x4*)(rc + (size_t)t * 32 + g * 8 + 4);
        const f32x4 s0 = *(const f32x4*)(rsn + (size_t)t * 32 + g * 8), s1 = *(const f32x4*)(rsn + (size_t)t * 32 + g * 8 + 4);
        const float sc = w ? 0.125f : 1.0f;
        float x1[8] = {bflo(a.x), bfhi(a.x), bflo(a.y), bfhi(a.y), bflo(a.z), bfhi(a.z), bflo(a.w), bfhi(a.w)};
        float x2[8] = {bflo(bq.x), bfhi(bq.x), bflo(bq.y), bfhi(bq.y), bflo(bq.z), bfhi(bq.z), bflo(bq.w), bfhi(bq.w)};
        float cc[8] = {c0.x, c0.y, c0.z, c0.w, c1.x, c1.y, c1.z, c1.w}, ss[8] = {s0.x, s0.y, s0.z, s0.w, s1.x, s1.y, s1.z, s1.w};
        float y1[8], y2[8];
#pragma unroll
        for (int j = 0; j < 8; ++j) { y1[j] = (x1[j] * cc[j] - x2[j] * ss[j]) * sc; y2[j] = (x1[j] * ss[j] + x2[j] * cc[j]) * sc; }
        *(u32x4*)pp = (u32x4){pk2(y1[0], y1[1]), pk2(y1[2], y1[3]), pk2(y1[4], y1[5]), pk2(y1[6], y1[7])};
        *(u32x4*)(pp + 32) = (u32x4){pk2(y2[0], y2[1]), pk2(y2[2], y2[3]), pk2(y2[4], y2[5]), pk2(y2[6], y2[7])};
    }
}

DI void ret_state_unit(int wv, int l, int unit) {
    const Frame F = mkframe(wv);
    unsigned char* ws = kargs()->ws; const bf16_t* P = (const bf16_t*)(ws + WS_P);
    const int bh = unit / 7, c = unit - 7 * bh, b = bh >> 2, h = bh & 3, lane = F.lane, r = lane & 31, hh = lane >> 5;
    const int s0 = b * SEQ + c * 256;
    const bf16_t* VTg = (const bf16_t*)(ws + WS_VTRT) + (size_t)h * 128 * VTLD + s0;
    const bf16_t* Kg = P + (size_t)s0 * PLD + P_RTK + h * 64;
    constexpr int RS = 528;
    LAS unsigned char* vt = F.lds; LAS unsigned char* kT = F.lds + 128 * RS;
    const float lg = log2f(1.0f - exp2f(-5.0f - (float)h));
    u32x4 vv[8], kv[4];
#pragma unroll
    for (int i = 0; i < 8; ++i) { const int id = F.tid + 512 * i, row = id >> 5, ch = id & 31; vv[i] = *(const u32x4*)(VTg + (size_t)row * VTLD + ch * 8); }
    const int key = F.tid >> 1, chb = (F.tid & 1) * 32;
#pragma unroll
    for (int i = 0; i < 4; ++i) kv[i] = *(const u32x4*)(Kg + (size_t)key * PLD + chb + 8 * i);
#pragma unroll
    for (int i = 0; i < 8; ++i) { const int id = F.tid + 512 * i, row = id >> 5, ch = id & 31; *(LAS u32x4*)(vt + row * RS + ch * 16) = vv[i]; }
    const float fk = exp2f(lg * (float)(255 - key));
#pragma unroll
    for (int i = 0; i < 4; ++i) {
        const unsigned w4[4] = {kv[i].x, kv[i].y, kv[i].z, kv[i].w};
#pragma unroll
        for (int j = 0; j < 4; ++j) { const unsigned u2 = pk2(bflo(w4[j]) * fk, bfhi(w4[j]) * fk);
            LAS unsigned char* wp = kT + (chb + 8 * i + 2 * j) * RS + key * 2;
            *(LAS unsigned short*)wp = (unsigned short)u2; *(LAS unsigned short*)(wp + RS) = (unsigned short)(u2 >> 16); }
    }
    __syncthreads();
    const int d = wv & 3, e = wv >> 2;
    f32x16 acc = {0.f, 0.f, 0.f, 0.f, 0.f, 0.f, 0.f, 0.f, 0.f, 0.f, 0.f, 0.f, 0.f, 0.f, 0.f, 0.f};
#pragma unroll
    for (int sk = 0; sk < 16; ++sk)
        acc = MFMA32(*(const LAS bf16x8*)(vt + (32 * d + r) * RS + (16 * sk + 8 * hh) * 2), *(const LAS bf16x8*)(kT + (32 * e + r) * RS + (16 * sk + 8 * hh) * 2), acc);
    unsigned* Lp = (unsigned*)rst_base(kargs(), l) + (size_t)unit * 8192 + 32 * e + r;
    __builtin_amdgcn_sched_barrier(0); asm volatile("s_nop 15\n\ts_nop 3" ::: "memory"); __builtin_amdgcn_sched_barrier(0);
#pragma unroll
    for (int i = 0; i < 16; ++i) { unsigned* sp_ = Lp + (size_t)(32 * d + crow(i, hh)) * 64; const float av_ = acc[i];
        asm volatile("global_store_dword %0, %1, off sc1" :: "v"(sp_), "v"(av_) : "memory"); }
    VM_WAIT(); lds_barrier();
    if (F.tid == 0) (void)__hip_atomic_fetch_add((unsigned*)(ws + WS_CTL) + CW_RST + 2048 * l + 64 * bh, 1u, __ATOMIC_RELAXED, __HIP_MEMORY_SCOPE_AGENT);
}

template <int MODE>
DI void attn_unit(int wv, int l, int unit) {
    constexpr int DV = MODE == 0 ? 64 : 128, NDT = DV / 32, VST2 = 144, VT_BYTES = DV * VST2, BUF = at::KT_BYTES + VT_BYTES;
    const Frame F = mkframe(wv);
    const ArgsP ap = kargs();
    unsigned char* ws = ap->ws; bf16_t* R = (bf16_t*)(ws + WS_R); bf16_t* P = (bf16_t*)(ws + WS_P);
    const int lane = F.lane, r = lane & 31, hh = lane >> 5, kap = 16 * ((r >> 2) & 1) + (r & 3) + 4 * (r >> 3);
    int b, h, qt;
    if (MODE == 0) { b = unit >> 6; h = (unit >> 3) & 7; qt = unit & 7; } else { qt = unit >> 5; b = (unit >> 2) & 7; h = unit & 3; }
    const int q0 = qt * 256, qw0 = q0 + 32 * wv, tq = qw0 + r, t = b * SEQ + tq;
    const bf16_t* Kg = MODE == 0 ? R + RB_SBK + h * 64 : P + P_RTK + h * 64; const int kld = MODE == 0 ? RBLD : PLD;
    const bf16_t* VTg = (const bf16_t*)(ws + (MODE == 0 ? WS_VTSB : WS_VTRT)) + (size_t)h * DV * VTLD + b * SEQ;
    const bf16_t* qp = MODE == 0 ? R + (size_t)t * RBLD + RB_SBQ + h * 64 : P + (size_t)t * PLD + P_RTQ + h * 64;
    bf16x8 qf[4];
#pragma unroll
    for (int ks = 0; ks < 4; ++ks) qf[ks] = *(const bf16x8*)(qp + 16 * ks + 8 * hh);
    f32x16 o[NDT];
#pragma unroll
    for (int d = 0; d < NDT; ++d) o[d] = (f32x16){0.f, 0.f, 0.f, 0.f, 0.f, 0.f, 0.f, 0.f, 0.f, 0.f, 0.f, 0.f, 0.f, 0.f, 0.f, 0.f};
    volatile LAS unsigned* flags = (volatile LAS unsigned*)(F.lds + 2 * BUF);
    const int jtop = (q0 + 255) >> 6;
    const int srow = F.tid >> 3, sch = F.tid & 7;
    u32x4 kreg, vreg[NDT / 2];
#define AT_LOAD(j) do { const int key0_ = (j) * 64; kreg = *(const u32x4*)(Kg + (size_t)(b * SEQ + key0_ + srow) * kld + sch * 8); \
        _Pragma("unroll") for (int i_ = 0; i_ < NDT / 2; ++i_) vreg[i_] = *(const u32x4*)(VTg + (size_t)(srow + 64 * i_) * VTLD + key0_ + sch * 8); } while (0)
#define AT_WRITE(pbuf) do { LAS unsigned char* kb_ = F.lds + (pbuf) * BUF; *(LAS u32x4*)(kb_ + srow * at::KST + sch * 16) = kreg; \
        _Pragma("unroll") for (int i_ = 0; i_ < NDT / 2; ++i_) *(LAS u32x4*)(kb_ + at::KT_BYTES + (srow + 64 * i_) * VST2 + sch * 16) = vreg[i_]; } while (0)
    AT_LOAD(jtop); AT_WRITE(0);
    lds_barrier();
    float carry = MODE == 0 ? 1.f : 0.f; bool done_w = false;
    const float c2 = 0.125f * 1.4426950408889634f;
    const float lg = MODE == 1 ? log2f(1.0f - exp2f(-5.0f - (float)h)) : 0.f;
    float bfac[16];
#pragma unroll
    for (int i = 0; i < 16; ++i) bfac[i] = MODE == 1 ? exp2f(-lg * (float)i) : 0.f;
    const int jlo = MODE == 1 ? (q0 >> 6) : 0;
    if (MODE == 1 && qt > 0) {
        unsigned* cnt = (unsigned*)(ws + WS_CTL) + CW_RST + 2048 * l + 64 * (b * 4 + h);
        if (wv == 0) {
            if (lane == 0) { unsigned sp = 0u; while (__hip_atomic_load(cnt, __ATOMIC_RELAXED, __HIP_MEMORY_SCOPE_AGENT) < 7u) { __builtin_amdgcn_s_sleep(2); if (++sp > (1u << 20)) break; } }
            __builtin_amdgcn_fence(__ATOMIC_ACQUIRE, "agent");
            asm volatile("s_waitcnt vmcnt(0)" ::: "memory");
        }
        lds_barrier();
        const float* L0 = (const float*)rst_base(ap, l) + (size_t)((b * 4 + h) * 7) * 8192;
        const float g256 = exp2f(lg * 256.0f);
        LAS unsigned char* stI = F.lds + 65536;
#pragma unroll
        for (int k4 = 0; k4 < 4; ++k4) {
            const int e4 = (F.tid + 512 * k4) * 4;
            f32x4 a = {0.f, 0.f, 0.f, 0.f}; float wg = 1.0f;
            for (int c = qt - 1; c >= 0; --c) { const f32x4 x = *(const f32x4*)(L0 + (size_t)c * 8192 + e4);
                a += x * wg; wg *= g256; }
            *(LAS u32x2*)(stI + (e4 >> 6) * 144 + (e4 & 63) * 2) = (u32x2){pk2(a[0], a[1]), pk2(a[2], a[3])};
        }
        lds_barrier();
#pragma unroll
        for (int d = 0; d < NDT; ++d)
#pragma unroll
            for (int ks = 0; ks < 4; ++ks) o[d] = MFMA32(*(const LAS bf16x8*)(stI + (32 * d + r) * 144 + (16 * ks + 8 * hh) * 2), qf[ks], o[d]);
        const float fq = exp2f(lg * (float)(tq - q0 + 1));
#pragma unroll
        for (int d = 0; d < NDT; ++d) o[d] = o[d] * fq;
    }
    for (int j = jtop, it = 0; ; --j, ++it) {
        const int pbuf = it & 1;
        if (j > jlo) AT_LOAD(j - 1);
        LAS unsigned char* kt = F.lds + pbuf * BUF; LAS unsigned char* vt = kt + at::KT_BYTES;
        const int key0 = j * 64;
        if (!done_w) {
#pragma unroll
            for (int sti = 0; sti < 2; ++sti) {
                const int st = 1 - sti, ks0 = key0 + 32 * st;
                if (ks0 <= qw0 + 31 - (MODE == 0 ? 1 : 0)) {
                    const bool full = (ks0 + 31 < qw0);
                    f32x16 z = {0.f, 0.f, 0.f, 0.f, 0.f, 0.f, 0.f, 0.f, 0.f, 0.f, 0.f, 0.f, 0.f, 0.f, 0.f, 0.f};
#pragma unroll
                    for (int ks = 0; ks < 4; ++ks) z = MFMA32(at::kfrag(kt, 32 * st + kap, ks, hh), qf[ks], z);
                    float w[16];
                    const int kb = ks0 + 16 * hh;
                    if (MODE == 0) {
                        float sg[16], sn[16];
#pragma unroll
                        for (int i = 0; i < 16; i += 2) {
                            const f32x2 a2 = (f32x2){z[i], z[i + 1]} * (f32x2){-c2, -c2};
                            const f32x2 d2 = (f32x2){__builtin_amdgcn_exp2f(a2.x), __builtin_amdgcn_exp2f(a2.y)} + (f32x2){1.f, 1.f};
                            const f32x2 r2 = (f32x2){__builtin_amdgcn_rcpf(d2.x), __builtin_amdgcn_rcpf(d2.y)};
                            const f32x2 n2 = (f32x2){1.f, 1.f} - r2;
                            sg[i] = r2.x; sg[i + 1] = r2.y; sn[i] = n2.x; sn[i + 1] = n2.y;
                        }
                        if (!full) {
#pragma unroll
                            for (int i = 0; i < 16; ++i) { const bool m = (kb + i) < tq; sn[i] = m ? sn[i] : 1.f; sg[i] = m ? sg[i] : 0.f; }
                        }
                        float suf[16];
                        suf[15] = 1.f;
#pragma unroll
                        for (int i = 14; i >= 0; --i) suf[i] = suf[i + 1] * sn[i + 1];
                        const float tot = suf[0] * sn[0], totp = shx(tot, 32, lane);
                        const float base = carry * (hh == 0 ? totp : 1.f);
                        carry *= tot * totp;
#pragma unroll
                        for (int i = 0; i < 16; i += 2) { const f32x2 w2 = (f32x2){sg[i], sg[i + 1]} * ((f32x2){suf[i], suf[i + 1]} * (f32x2){base, base}); w[i] = w2.x; w[i + 1] = w2.y; }
                    } else {
                        const float af = __builtin_amdgcn_exp2f(lg * (float)(tq - kb));
                        if (full) {
#pragma unroll
                            for (int i = 0; i < 16; ++i) w[i] = z[i] * (af * bfac[i]);
                        } else {
#pragma unroll
                            for (int i = 0; i < 16; ++i) w[i] = (kb + i <= tq) ? z[i] * (af * bfac[i]) : 0.f;
                        }
                    }
#pragma unroll
                    for (int s2 = 0; s2 < 2; ++s2) {
                        const bf16x8 pf = pack8(w[8 * s2], w[8 * s2 + 1], w[8 * s2 + 2], w[8 * s2 + 3], w[8 * s2 + 4], w[8 * s2 + 5], w[8 * s2 + 6], w[8 * s2 + 7]);
#pragma unroll
                        for (int d = 0; d < NDT; ++d) o[d] = MFMA32(*(const LAS bf16x8*)(vt + (32 * d + r) * VST2 + (32 * st + 16 * hh + 8 * s2) * 2), pf, o[d]);
                    }
                }
            }
            if (MODE == 0) done_w = __all(carry < 1.1754944e-38f);
        }
        if (j > jlo) AT_WRITE(pbuf ^ 1);
        if (MODE == 0 && F.lane == 0) flags[(it & 1) * 8 + wv] = done_w ? 1u : 0u;
        lds_barrier();
        if (j == jlo) break;
        if (MODE == 0) { unsigned all = 1u;
#pragma unroll
            for (int w8 = 0; w8 < 8; ++w8) all &= flags[(it & 1) * 8 + w8];
            if (all) break; }
    }
#undef AT_LOAD
#undef AT_WRITE
    constexpr int OST = DV * 2 + 16, PPR = DV / 8;
    LAS unsigned char* ob = F.lds + wv * (32 * OST);
    if (MODE == 0) {
        bf16_t* op = R + (size_t)t * RBLD + RB_SBQ + h * 64; const bf16_t* zp = R + (size_t)t * RBLD + RB_SBZ + h * 64;
#pragma unroll
        for (int d = 0; d < NDT; ++d)
#pragma unroll
            for (int g = 0; g < 4; ++g) { const int c = 32 * d + 8 * g + 4 * hh; const u32x2 zz = *(const u32x2*)(zp + c);
                *(LAS u32x2*)(ob + r * OST + c * 2) = (u32x2){pk2(o[d][4 * g] * siluf_(bflo(zz.x)), o[d][4 * g + 1] * siluf_(bfhi(zz.x))), pk2(o[d][4 * g + 2] * siluf_(bflo(zz.y)), o[d][4 * g + 3] * siluf_(bfhi(zz.y)))}; }
#pragma unroll
        for (int k = 0; k < 32 * PPR / 64; ++k) { const int q = k * 64 + lane, row = q / PPR, pc = q % PPR;
            st16_wt(op + (ptrdiff_t)(row - r) * RBLD + pc * 8, *(const LAS u32x4*)(ob + row * OST + pc * 16)); }
    } else {
        float s1 = 0.f;
#pragma unroll
        for (int d = 0; d < NDT; ++d)
#pragma unroll
            for (int i = 0; i < 16; ++i) s1 += o[d][i];
        s1 += shx(s1, 32, lane);
        const float mu = s1 * (1.f / 128.f); float s2 = 0.f;
#pragma unroll
        for (int d = 0; d < NDT; ++d)
#pragma unroll
            for (int i = 0; i < 16; ++i) { const float dl = o[d][i] - mu; s2 += dl * dl; }
        s2 += shx(s2, 32, lane);
        const float rs = rsqrtf(s2 * (1.f / 128.f) + EPS);
        bf16_t* zp = R + (size_t)t * RBLD + RB_RTZ + h * 128; const float* gp = ap->ret_norm_g + (size_t)l * 512 + h * 128;
#pragma unroll
        for (int d = 0; d < NDT; ++d)
#pragma unroll
            for (int g = 0; g < 4; ++g) { const int c = 32 * d + 8 * g + 4 * hh; const u32x2 zz = *(const u32x2*)(zp + c); const f32x4 gg = *(const f32x4*)(gp + c);
                *(LAS u32x2*)(ob + r * OST + c * 2) = (u32x2){pk2((o[d][4 * g] - mu) * rs * gg.x * siluf_(bflo(zz.x)), (o[d][4 * g + 1] - mu) * rs * gg.y * siluf_(bfhi(zz.x))),
                                                             pk2((o[d][4 * g + 2] - mu) * rs * gg.z * siluf_(bflo(zz.y)), (o[d][4 * g + 3] - mu) * rs * gg.w * siluf_(bfhi(zz.y)))}; }
#pragma unroll
        for (int k = 0; k < 32 * PPR / 64; ++k) { const int q = k * 64 + lane, row = q / PPR, pc = q % PPR;
            st16_wt(zp + (ptrdiff_t)(row - r) * RBLD + pc * 8, *(const LAS u32x4*)(ob + row * OST + pc * 16)); }
    }
    unit_done(ws, l, b * 8 + qt, F.tid);
}

namespace dn {
constexpr int HC_BYTES = 73728, OFF_W = 0, OFF_QG = 16384, OFF_KD = 32768, OFF_AI = 49152, OFF_U = 57344;
constexpr int QST = 272, TST = 144;
constexpr int GRP_BYTES = 71680, Q_OFF = 0, K_OFF = 17408, KT_OFF = 34816, VT_OFF = 53248, VEC_OFF = 143360, VEC_BYTES = 2048;
}

DI void dn_prep(int wv, int l, int pair) {
    const Frame F = mkframe(wv);
    const ArgsP ap = kargs();
    unsigned char* ws = ap->ws;
    const int lane = F.lane, r = lane & 31, hh = lane >> 5, grp = wv >> 2, gw = wv & 3, gt = F.tid & 255;
    const int hc = pair * 2 + grp, h = hc & 3, bn = hc >> 2, b = bn >> 5, n = bn & 31, t0 = b * SEQ + n * 64;
    LAS unsigned char* gb = F.lds + grp * dn::GRP_BYTES;
    LAS unsigned char* qimg = gb + dn::Q_OFF; LAS unsigned char* kimg = gb + dn::K_OFF; LAS unsigned char* ktimg = gb + dn::KT_OFF; LAS unsigned char* vtimg = gb + dn::VT_OFF;
    LAS float* vec = (LAS float*)(F.lds + dn::VEC_OFF + grp * dn::VEC_BYTES);
    LAS float* gcv = vec; LAS float* btv = vec + 64; LAS float* f1v = vec + 128; LAS float* f2v = vec + 192; LAS float* egv = vec + 256;
    unsigned char* blk = ws + WS_DNI + (size_t)hc * dn::HC_BYTES;
    const bf16_t* RA = (const bf16_t*)(ws + WS_R); const float* cw = ap->dn_conv_w + (size_t)l * 4 * 1536; const float* AB = (const float*)(ws + WS_AB);
#ifdef PROBE_PREP
    unsigned long long tp0_ = __builtin_amdgcn_s_memrealtime();
#endif
    {
        const int g8 = gt & 15, ch = g8 * 8;
        float abA[4], abB[4];
#pragma unroll
        for (int k = 0; k < 4; ++k) { const int t = t0 + (gt >> 4) + 16 * k; abA[k] = AB[(size_t)t * 8 + h]; abB[k] = AB[(size_t)t * 8 + 4 + h]; }
        const float dtb = ap->dn_dt_bias[l * 4 + h], nalog = -__expf(ap->dn_a_log[l * 4 + h]);
        u32x4 xs[2][2][4]; f32x4 wj[4][2];
#define DNP_LOADX(st_, set_) do { const int col_ = ((st_) >> 1) * 512 + h * 128 + ch; \
        _Pragma("unroll") for (int kk_ = 0; kk_ < 2; ++kk_) _Pragma("unroll") for (int j_ = 0; j_ < 4; ++j_) { const int m_ = (gt >> 4) + 16 * (2 * ((st_) & 1) + kk_); \
            xs[set_][kk_][j_] = (n * 64 + m_ - 3 + j_ >= 0) ? *(const u32x4*)(RA + (size_t)(t0 + m_ - 3 + j_) * RALD + col_) : (u32x4){0u, 0u, 0u, 0u}; } } while (0)
        DNP_LOADX(0, 0);
#pragma unroll
        for (int st = 0; st < 6; ++st) {
            const int part = st >> 1, col = part * 512 + h * 128 + ch;
            if ((st & 1) == 0) {
#pragma unroll
                for (int j = 0; j < 4; ++j) { wj[j][0] = *(const f32x4*)(cw + j * 1536 + col); wj[j][1] = *(const f32x4*)(cw + j * 1536 + col + 4); } }
            if (st < 5) DNP_LOADX(st + 1, (st + 1) & 1);
#pragma unroll
            for (int kk = 0; kk < 2; ++kk) {
                const int m = (gt >> 4) + 16 * (2 * (st & 1) + kk), t = t0 + m;
                float a[8] = {0.f, 0.f, 0.f, 0.f, 0.f, 0.f, 0.f, 0.f};
#pragma unroll
                for (int j = 0; j < 4; ++j) { const u32x4 x = xs[st & 1][kk][j];
                    a[0] += wj[j][0].x * bflo(x.x); a[1] += wj[j][0].y * bfhi(x.x); a[2] += wj[j][0].z * bflo(x.y); a[3] += wj[j][0].w * bfhi(x.y);
                    a[4] += wj[j][1].x * bflo(x.z); a[5] += wj[j][1].y * bfhi(x.z); a[6] += wj[j][1].z * bflo(x.w); a[7] += wj[j][1].w * bfhi(x.w);
                }
                float ssq = 0.f;
#pragma unroll
                for (int i = 0; i < 8; ++i) { a[i] = siluf_(a[i]); ssq += a[i] * a[i]; }
                if (part < 2) {
                    ssq = sum16(ssq);
                    const float rn = rsqrtf(ssq + EPS);
#pragma unroll
                    for (int i = 0; i < 8; ++i) a[i] *= rn;
                } else {
                    const float beta = sigmoidf_(abB[2 * (st & 1) + kk]);
#pragma unroll
                    for (int i = 0; i < 8; ++i) a[i] *= beta;
                }
                const u32x4 pk = (u32x4){pk2(a[0], a[1]), pk2(a[2], a[3]), pk2(a[4], a[5]), pk2(a[6], a[7])};
                if (part == 0) {
                    *(LAS u32x4*)(qimg + m * dn::QST + ch * 2) = pk;
                    if (g8 == 0) { const float xa = abA[2 * (st & 1) + kk] + dtb; const float sp = xa > 20.f ? xa : log1pf(__expf(xa));
                        gcv[m] = nalog * sp; btv[m] = sigmoidf_(abB[2 * (st & 1) + kk]); }
                } else {
                    if (part == 1) *(LAS u32x4*)(kimg + m * dn::QST + ch * 2) = pk;
                    LAS unsigned char* timg = (part == 1 ? ktimg : vtimg) + (((m >> 3) ^ (g8 & 7)) * 16) + (m & 7) * 2;
                    *(LAS unsigned short*)(timg + (ch + 0) * dn::TST) = (unsigned short)pk.x; *(LAS unsigned short*)(timg + (ch + 1) * dn::TST) = (unsigned short)(pk.x >> 16);
                    *(LAS unsigned short*)(timg + (ch + 2) * dn::TST) = (unsigned short)pk.y; *(LAS unsigned short*)(timg + (ch + 3) * dn::TST) = (unsigned short)(pk.y >> 16);
                    *(LAS unsigned short*)(timg + (ch + 4) * dn::TST) = (unsigned short)pk.z; *(LAS unsigned short*)(timg + (ch + 5) * dn::TST) = (unsigned short)(pk.z >> 16);
                    *(LAS unsigned short*)(timg + (ch + 6) * dn::TST) = (unsigned short)pk.w; *(LAS unsigned short*)(timg + (ch + 7) * dn::TST) = (unsigned short)(pk.w >> 16);
                }
            }
        }
#undef DNP_LOADX
    }
    lds_barrier();
#ifdef PROBE_PREP
    if (PROBE_PREP == 1) { const unsigned long long t1_ = __builtin_amdgcn_s_memrealtime(); const unsigned long long d_ = t1_ - tp0_; while (__builtin_amdgcn_s_memrealtime() - t1_ < d_) __builtin_amdgcn_s_sleep(2); }
    tp0_ = __builtin_amdgcn_s_memrealtime();
#endif
    if (gw == 0) {
        float gc = gcv[lane];
#pragma unroll
        for (int off = 1; off < 64; off <<= 1) { const float o = shx(gc, 0, lane - off < 0 ? lane : lane - off) ; gc += (lane >= off) ? o : 0.f; }
        const float glast = shx(gc, 0, 63);
        const float eg = __expf(gc);
        gcv[lane] = gc; f1v[lane] = btv[lane] * eg; f2v[lane] = __expf(glast - gc); egv[lane] = eg * 0.08838834764831845f;
        if (lane == 0) ((float*)(ws + WS_GB))[hc] = __expf(glast);
    }
    lds_barrier();
    f32x16 Lt = {0.f, 0.f, 0.f, 0.f, 0.f, 0.f, 0.f, 0.f, 0.f, 0.f, 0.f, 0.f, 0.f, 0.f, 0.f, 0.f};
    if (gw < 3) {
        {
            const int ct = gw == 0 ? 0 : 1, mt = gw == 2 ? 1 : 0;
            f32x16 acc = {0.f, 0.f, 0.f, 0.f, 0.f, 0.f, 0.f, 0.f, 0.f, 0.f, 0.f, 0.f, 0.f, 0.f, 0.f, 0.f};
#pragma unroll
            for (int ks = 0; ks < 8; ++ks) acc = MFMA32(*(const LAS bf16x8*)(kimg + (32 * ct + r) * dn::QST + ks * 32 + hh * 16), *(const LAS bf16x8*)(kimg + (32 * mt + r) * dn::QST + ks * 32 + hh * 16), acc);
            const int m = 32 * mt + r; const float gm = gcv[m];
#pragma unroll
            for (int i = 0; i < 16; ++i) { const int c = 32 * ct + crow(i, hh); Lt[i] = (m < c) ? acc[i] * btv[c] * __expf(gcv[c] - gm) : 0.f; }
        }
        {
            const int mt = gw == 2 ? 1 : 0, ct = gw == 0 ? 0 : 1;
            f32x16 acc = {0.f, 0.f, 0.f, 0.f, 0.f, 0.f, 0.f, 0.f, 0.f, 0.f, 0.f, 0.f, 0.f, 0.f, 0.f, 0.f};
#pragma unroll
            for (int ks = 0; ks < 8; ++ks) acc = MFMA32(*(const LAS bf16x8*)(kimg + (32 * mt + r) * dn::QST + ks * 32 + hh * 16), *(const LAS bf16x8*)(qimg + (32 * ct + r) * dn::QST + ks * 32 + hh * 16), acc);
            const int c = 32 * ct + r; const float gcc = gcv[c]; float v[16];
#pragma unroll
            for (int i = 0; i < 16; ++i) { const int m = 32 * mt + crow(i, hh); v[i] = (m <= c) ? acc[i] * __expf(gcc - gcv[m]) * 0.08838834764831845f : 0.f; }
#pragma unroll
            for (int s2 = 0; s2 < 2; ++s2) *(bf16x8*)(blk + dn::OFF_AI + ((ct * 2 + mt) * 2 + s2) * 1024 + lane * 16) = pack8(v[8 * s2], v[8 * s2 + 1], v[8 * s2 + 2], v[8 * s2 + 3], v[8 * s2 + 4], v[8 * s2 + 5], v[8 * s2 + 6], v[8 * s2 + 7]);
        }
    } else {
#pragma unroll 1
        for (int f = 0; f < 16; ++f) { const int ct = f >> 3, tau = (f >> 1) & 3, s2 = f & 1, c = 32 * ct + r; const float e = egv[c];
            const LAS unsigned char* pp = qimg + c * dn::QST + (32 * tau + 16 * s2 + 4 * hh) * 2; const u32x2 lo = *(const LAS u32x2*)pp, hi = *(const LAS u32x2*)(pp + 16);
            *(bf16x8*)(blk + dn::OFF_QG + f * 1024 + lane * 16) = pack8(bflo(lo.x) * e, bfhi(lo.x) * e, bflo(lo.y) * e, bfhi(lo.y) * e, bflo(hi.x) * e, bfhi(hi.x) * e, bflo(hi.y) * e, bfhi(hi.y) * e); }
#pragma unroll 1
        for (int f = 0; f < 16; ++f) { const int tau = f >> 2, m0 = 32 * ((f >> 1) & 1) + 16 * (f & 1) + 4 * hh;
            const int sw = (4 * tau + (r >> 3)) & 7; const LAS unsigned char* rowp = ktimg + (32 * tau + r) * dn::TST + (m0 & 7) * 2;
            const u32x2 lo = *(const LAS u32x2*)(rowp + (((m0 >> 3) ^ sw) * 16)), hi = *(const LAS u32x2*)(rowp + ((((m0 >> 3) + 1) ^ sw) * 16));
            const f32x4 fa = *(const LAS f32x4*)(f2v + m0), fb = *(const LAS f32x4*)(f2v + m0 + 8);
            *(bf16x8*)(blk + dn::OFF_KD + f * 1024 + lane * 16) = pack8(bflo(lo.x) * fa.x, bfhi(lo.x) * fa.y, bflo(lo.y) * fa.z, bfhi(lo.y) * fa.w, bflo(hi.x) * fb.x, bfhi(hi.x) * fb.y, bflo(hi.y) * fb.z, bfhi(hi.y) * fb.w); }
    }
    lds_barrier();
    LAS float* Lm = (LAS float*)qimg;
    if (gw < 3) { const int ct = gw == 0 ? 0 : 1, mt = gw == 2 ? 1 : 0;
#pragma unroll
        for (int i = 0; i < 16; ++i) Lm[(32 * ct + crow(i, hh)) * 64 + 32 * mt + r] = Lt[i]; }
    lds_barrier();
#ifdef PROBE_PREP
    if (PROBE_PREP == 2) { const unsigned long long t1_ = __builtin_amdgcn_s_memrealtime(); const unsigned long long d_ = t1_ - tp0_; while (__builtin_amdgcn_s_memrealtime() - t1_ < d_) __builtin_amdgcn_s_sleep(2); }
    tp0_ = __builtin_amdgcn_s_memrealtime();
#endif
    if (gw == 0) {
        const LAS float* Lb = Lm + (32 * hh) * 64 + 32 * hh;
        const int jc = lane & 31;
        float Tc[32];
#pragma unroll
        for (int i = 0; i < 32; ++i) {
            float a0 = (i == jc) ? 1.f : 0.f, a1 = 0.f, a2 = 0.f, a3 = 0.f;
#pragma unroll
            for (int k4 = 0; k4 < (i + 3) / 4; ++k4) { const f32x4 lv = *(const LAS f32x4*)(Lb + i * 64 + 4 * k4);
                if (4 * k4 + 0 < i) a0 -= lv.x * Tc[4 * k4 + 0]; if (4 * k4 + 1 < i) a1 -= lv.y * Tc[4 * k4 + 1];
                if (4 * k4 + 2 < i) a2 -= lv.z * Tc[4 * k4 + 2]; if (4 * k4 + 3 < i) a3 -= lv.w * Tc[4 * k4 + 3]; }
            Tc[i] = (a0 + a1) + (a2 + a3);
        }
        LDS_WAIT(); asm volatile("" ::: "memory");
        LAS unsigned char* timg = kimg; LAS unsigned char* t00t = kimg + 64 * dn::TST;
#pragma unroll
        for (int i = 0; i < 32; ++i) *(LAS unsigned short*)(timg + (32 * hh + i) * dn::TST + (32 * hh + jc) * 2) = (unsigned short)f2bf(Tc[i]);
        if (hh == 0) {
#pragma unroll
            for (int q = 0; q < 4; ++q) { *(LAS u32x4*)(t00t + jc * 80 + 16 * q) = (u32x4){pk2(Tc[8 * q], Tc[8 * q + 1]), pk2(Tc[8 * q + 2], Tc[8 * q + 3]), pk2(Tc[8 * q + 4], Tc[8 * q + 5]), pk2(Tc[8 * q + 6], Tc[8 * q + 7])};
                *(LAS u32x4*)(timg + jc * dn::TST + 64 + 16 * q) = (u32x4){0u, 0u, 0u, 0u}; }
        }
        LDS_WAIT(); asm volatile("" ::: "memory");
        f32x16 X = {0.f, 0.f, 0.f, 0.f, 0.f, 0.f, 0.f, 0.f, 0.f, 0.f, 0.f, 0.f, 0.f, 0.f, 0.f, 0.f};
#pragma unroll
        for (int s2 = 0; s2 < 2; ++s2) { const f32x4 la = *(const LAS f32x4*)(Lm + (32 + r) * 64 + 16 * s2 + 8 * hh), lb = *(const LAS f32x4*)(Lm + (32 + r) * 64 + 16 * s2 + 8 * hh + 4);
            X = MFMA32(pack8(la.x, la.y, la.z, la.w, lb.x, lb.y, lb.z, lb.w), *(const LAS bf16x8*)(t00t + r * 80 + (16 * s2 + 8 * hh) * 2), X); }
        f32x16 Y = {0.f, 0.f, 0.f, 0.f, 0.f, 0.f, 0.f, 0.f, 0.f, 0.f, 0.f, 0.f, 0.f, 0.f, 0.f, 0.f};
#pragma unroll
        for (int s2 = 0; s2 < 2; ++s2) { const LAS unsigned char* pp = timg + (32 + r) * dn::TST + (32 + 16 * s2 + 4 * hh) * 2; const u32x2 lo = *(const LAS u32x2*)pp, hi = *(const LAS u32x2*)(pp + 16);
            u32x4 af; af.x = lo.x; af.y = lo.y; af.z = hi.x; af.w = hi.y;
            Y = MFMA32(__builtin_bit_cast(bf16x8, af), pack8m(X[8 * s2], X[8 * s2 + 1], X[8 * s2 + 2], X[8 * s2 + 3], X[8 * s2 + 4], X[8 * s2 + 5], X[8 * s2 + 6], X[8 * s2 + 7]), Y); }
#pragma unroll
        for (int i = 0; i < 16; ++i) *(LAS unsigned short*)(timg + (32 + crow(i, hh)) * dn::TST + r * 2) = (unsigned short)f2bf(-Y[i]);
    }
    lds_barrier();
#ifdef PROBE_PREP
    if (PROBE_PREP == 3) { const unsigned long long t1_ = __builtin_amdgcn_s_memrealtime(); const unsigned long long d_ = t1_ - tp0_; while (__builtin_amdgcn_s_memrealtime() - t1_ < d_) __builtin_amdgcn_s_sleep(2); }
    tp0_ = __builtin_amdgcn_s_memrealtime();
#endif
    {
        LAS unsigned char* timg = kimg;
        bf16x8 afr[4];
#pragma unroll
        for (int s4 = 0; s4 < 4; ++s4) { const u32x4 x = *(const LAS u32x4*)(ktimg + (32 * gw + r) * dn::TST + (((2 * s4 + hh) ^ ((4 * gw + (r >> 3)) & 7)) * 16));
            const f32x4 fa = *(const LAS f32x4*)(f1v + 16 * s4 + 8 * hh), fb = *(const LAS f32x4*)(f1v + 16 * s4 + 8 * hh + 4);
            afr[s4] = pack8(-bflo(x.x) * fa.x, -bfhi(x.x) * fa.y, -bflo(x.y) * fa.z, -bfhi(x.y) * fa.w, -bflo(x.z) * fb.x, -bfhi(x.z) * fb.y, -bflo(x.w) * fb.z, -bfhi(x.w) * fb.w); }
#pragma unroll
        for (int ct = 0; ct < 2; ++ct) {
            f32x16 acc = {0.f, 0.f, 0.f, 0.f, 0.f, 0.f, 0.f, 0.f, 0.f, 0.f, 0.f, 0.f, 0.f, 0.f, 0.f, 0.f};
#pragma unroll
            for (int s4 = 0; s4 < 4; ++s4) acc = MFMA32(afr[s4], *(const LAS bf16x8*)(timg + (32 * ct + r) * dn::TST + s4 * 32 + hh * 16), acc);
#pragma unroll
            for (int s2 = 0; s2 < 2; ++s2) *(bf16x8*)(blk + dn::OFF_W + ((ct * 4 + gw) * 2 + s2) * 1024 + lane * 16) = pack8m(acc[8 * s2], acc[8 * s2 + 1], acc[8 * s2 + 2], acc[8 * s2 + 3], acc[8 * s2 + 4], acc[8 * s2 + 5], acc[8 * s2 + 6], acc[8 * s2 + 7]);
        }
#pragma unroll
        for (int ct = 0; ct < 2; ++ct) {
            f32x16 acc = {0.f, 0.f, 0.f, 0.f, 0.f, 0.f, 0.f, 0.f, 0.f, 0.f, 0.f, 0.f, 0.f, 0.f, 0.f, 0.f};
#pragma unroll
            for (int s4 = 0; s4 < 4; ++s4) acc = MFMA32(*(const LAS bf16x8*)(timg + (32 * ct + r) * dn::TST + s4 * 32 + hh * 16), *(const LAS bf16x8*)(vtimg + (32 * gw + r) * dn::TST + (((2 * s4 + hh) ^ ((4 * gw + (r >> 3)) & 7)) * 16)), acc);
#pragma unroll
            for (int s2 = 0; s2 < 2; ++s2) *(bf16x8*)(blk + dn::OFF_U + ((ct * 4 + gw) * 2 + s2) * 1024 + lane * 16) = pack8m(acc[8 * s2], acc[8 * s2 + 1], acc[8 * s2 + 2], acc[8 * s2 + 3], acc[8 * s2 + 4], acc[8 * s2 + 5], acc[8 * s2 + 6], acc[8 * s2 + 7]);
        }
    }
    lds_barrier();
}

DI void dn_scan(int wv, int l, int bh) {
    const Frame F = mkframe(wv);
    const ArgsP ap = kargs();
    unsigned char* ws = ap->ws; bf16_t* P = (bf16_t*)(ws + WS_P);
    const int lane = F.lane, hh = lane >> 5, b = bh >> 2, h = bh & 3, w4 = wv & 3;
    LAS float* part = (LAS float*)(F.lds + 2 * dn::HC_BYTES);
    LAS float* gnl = part + 512;
    LAS float* decs = gnl + 128;
    if (F.tid < 128) gnl[F.tid] = ap->dn_norm_g[l * 128 + F.tid];
    if (F.tid < 32) decs[F.tid] = ((const float*)(ws + WS_GB))[(size_t)(b * 32 + F.tid) * 4 + h];
    const size_t hc_stride = 4 * (size_t)dn::HC_BYTES;
    const unsigned char* blk0 = ws + WS_DNI + ((size_t)(b * 32) * 4 + h) * dn::HC_BYTES;
#define DN_PIECE(src_, pbuf, pc_) __builtin_amdgcn_global_load_lds((const unsigned*)((src_) + (pc_) * 1024 + lane * 16), (LAS unsigned*)(F.lds + (pbuf) * dn::HC_BYTES + (pc_) * 1024), 16, 0, SCAN_AUX)
#define DN_LOAD(nn, pbuf) do { const unsigned char* src_ = blk0 + (size_t)(nn) * hc_stride; \
        if (wv < 4) { _Pragma("unroll") for (int i_ = 0; i_ < 9; ++i_) DN_PIECE(src_, pbuf, wv * 9 + i_); } \
        else { _Pragma("unroll") for (int i_ = 0; i_ < 5; ++i_) DN_PIECE(src_, pbuf, 36 + 5 * w4 + i_); \
               DN_PIECE(src_, pbuf, 56 + 2 * w4); DN_PIECE(src_, pbuf, 57 + 2 * w4); DN_PIECE(src_, pbuf, 64 + 2 * w4); DN_PIECE(src_, pbuf, 65 + 2 * w4); } } while (0)
    DN_LOAD(0, 0);
    f32x16 S[4];
#pragma unroll
    for (int i = 0; i < 4; ++i) S[i] = (f32x16){0.f, 0.f, 0.f, 0.f, 0.f, 0.f, 0.f, 0.f, 0.f, 0.f, 0.f, 0.f, 0.f, 0.f, 0.f, 0.f};
    u32x4 heldO[4], zO[4];
#pragma unroll
    for (int i = 0; i < 4; ++i) { heldO[i] = (u32x4){0u, 0u, 0u, 0u}; zO[i] = heldO[i]; }
    VM_WAIT(); __syncthreads();
    if (wv < 4) {
    for (int k = 0; k < 34; ++k) {
        const int pbuf = k & 1;
#ifdef PROBE_SCANC
        const unsigned long long tc0_ = __builtin_amdgcn_s_memrealtime();
#endif
        LAS unsigned char* buf = F.lds + pbuf * dn::HC_BYTES;
        {
            if (k + 1 < 32) DN_LOAD(k + 1, pbuf ^ 1);
            if (k < 32) {
                const float dec = decs[k];
                f32x16 vn[2], o[2];
#pragma unroll
                for (int ct = 0; ct < 2; ++ct) {
                    o[ct] = (f32x16){0.f, 0.f, 0.f, 0.f, 0.f, 0.f, 0.f, 0.f, 0.f, 0.f, 0.f, 0.f, 0.f, 0.f, 0.f, 0.f};
#pragma unroll
                    for (int s2 = 0; s2 < 2; ++s2) { const u32x4 x = *(const LAS u32x4*)(buf + dn::OFF_U + ((ct * 4 + wv) * 2 + s2) * 1024 + lane * 16);
                        vn[ct][8 * s2] = bflo(x.x); vn[ct][8 * s2 + 1] = bfhi(x.x); vn[ct][8 * s2 + 2] = bflo(x.y); vn[ct][8 * s2 + 3] = bfhi(x.y);
                        vn[ct][8 * s2 + 4] = bflo(x.z); vn[ct][8 * s2 + 5] = bfhi(x.z); vn[ct][8 * s2 + 6] = bflo(x.w); vn[ct][8 * s2 + 7] = bfhi(x.w); }
                }
#define DN_F(off) (*(const LAS bf16x8*)(buf + (off) + lane * 16))
#define DN_WQ(ct, st) ((((ct) * 4 + ((st) >> 1)) * 2 + ((st) & 1)) * 1024)
                bf16x8 fa[4], fb[6];
                fa[0] = DN_F(dn::OFF_W + DN_WQ(0, 0)); fa[1] = DN_F(dn::OFF_QG + DN_WQ(0, 0)); fa[2] = DN_F(dn::OFF_W + DN_WQ(1, 0)); fa[3] = DN_F(dn::OFF_QG + DN_WQ(1, 0));
#pragma unroll
                for (int st = 0; st < 8; ++st) {
                    const int tau = st >> 1, s2 = st & 1;
                    if (st < 7) { fb[0] = DN_F(dn::OFF_W + DN_WQ(0, st + 1)); fb[1] = DN_F(dn::OFF_QG + DN_WQ(0, st + 1)); fb[2] = DN_F(dn::OFF_W + DN_WQ(1, st + 1)); fb[3] = DN_F(dn::OFF_QG + DN_WQ(1, st + 1)); }
                    else { fb[0] = DN_F(dn::OFF_AI + 0 * 1024); fb[1] = DN_F(dn::OFF_AI + 4 * 1024); fb[2] = DN_F(dn::OFF_KD + 0 * 1024); fb[3] = DN_F(dn::OFF_KD + 4 * 1024); fb[4] = DN_F(dn::OFF_KD + 8 * 1024); fb[5] = DN_F(dn::OFF_KD + 12 * 1024); }
                    __builtin_amdgcn_sched_barrier(0);
                    const bf16x8 sf = pack8m(S[tau][8 * s2], S[tau][8 * s2 + 1], S[tau][8 * s2 + 2], S[tau][8 * s2 + 3], S[tau][8 * s2 + 4], S[tau][8 * s2 + 5], S[tau][8 * s2 + 6], S[tau][8 * s2 + 7]);
                    vn[0] = MFMA32(fa[0], sf, vn[0]); o[0] = MFMA32(fa[1], sf, o[0]); vn[1] = MFMA32(fa[2], sf, vn[1]); o[1] = MFMA32(fa[3], sf, o[1]);
                    __builtin_amdgcn_sched_barrier(0);
                    if (st < 7) { fa[0] = fb[0]; fa[1] = fb[1]; fa[2] = fb[2]; fa[3] = fb[3]; }
                }
#pragma unroll
                for (int tau = 0; tau < 4; ++tau) S[tau] = S[tau] * dec;
                bf16x8 fc[6];
#pragma unroll
                for (int g = 0; g < 4; ++g) {
                    const int cm = g >> 1, s2 = g & 1;
                    if (g < 3) { const int cm1 = (g + 1) >> 1, s21 = (g + 1) & 1;
                        fc[0] = DN_F(dn::OFF_AI + ((cm1 * 2 + cm1) * 2 + s21) * 1024); fc[1] = DN_F(dn::OFF_AI + ((1 * 2 + cm1) * 2 + s21) * 1024);
#pragma unroll
                        for (int tau = 0; tau < 4; ++tau) fc[2 + tau] = DN_F(dn::OFF_KD + ((tau * 2 + cm1) * 2 + s21) * 1024); }
                    __builtin_amdgcn_sched_barrier(0);
                    const bf16x8 vf = pack8m(vn[cm][8 * s2], vn[cm][8 * s2 + 1], vn[cm][8 * s2 + 2], vn[cm][8 * s2 + 3], vn[cm][8 * s2 + 4], vn[cm][8 * s2 + 5], vn[cm][8 * s2 + 6], vn[cm][8 * s2 + 7]);
                    if (cm == 0) o[0] = MFMA32(fb[0], vf, o[0]);
                    o[1] = MFMA32(fb[1], vf, o[1]);
#pragma unroll
                    for (int tau = 0; tau < 4; ++tau) S[tau] = MFMA32(fb[2 + tau], vf, S[tau]);
                    __builtin_amdgcn_sched_barrier(0);
                    if (g < 3) {
#pragma unroll
                        for (int q = 0; q < 6; ++q) fb[q] = fc[q]; }
                }
#undef DN_F
#undef DN_WQ
                LDS_WAIT(); __builtin_amdgcn_sched_barrier(0); asm volatile("s_nop 15\n\ts_nop 3" ::: "memory"); __builtin_amdgcn_sched_barrier(0);
#pragma unroll
                for (int ct = 0; ct < 2; ++ct)
#pragma unroll
                    for (int i = 0; i < 16; i += 2) { const int c = 32 * ct + crow(i, hh), q = c >> 4; const unsigned u2 = pk2(o[ct][i], o[ct][i + 1]);
                        LAS unsigned char* wp = buf + dn::OFF_U + (((q >> 1) * 4 + wv) * 2 + (q & 1)) * 1024 + (c & 15) * 64 + (lane & 31) * 2;
                        *(LAS unsigned short*)wp = (unsigned short)u2; *(LAS unsigned short*)(wp + 64) = (unsigned short)(u2 >> 16); }
            }
        }
#ifdef PROBE_SCANC
        { const unsigned long long tc1_ = __builtin_amdgcn_s_memrealtime(); const unsigned long long d_ = tc1_ - tc0_; while (__builtin_amdgcn_s_memrealtime() - tc1_ < d_) __builtin_amdgcn_s_sleep(2); }
#endif
        asm volatile("s_waitcnt vmcnt(0)" ::: "memory");
        lds_barrier();
    }
    } else {
    u32x4 heldN[4], zN[4];
#pragma unroll
    for (int i = 0; i < 4; ++i) { heldN[i] = (u32x4){0u, 0u, 0u, 0u}; zN[i] = heldN[i]; }
    unsigned td0 = 0u, td1 = 0u, td2 = 0u;
    for (int k = 0; k < 34; ++k) {
        const int pbuf = k & 1;
#ifdef PROBE_SCANH
        const unsigned long long th0_ = __builtin_amdgcn_s_memrealtime();
#endif
        const bool rows = (k >= 1 && k <= 32);
        if (rows) {
            const int nn = k - 1; LAS unsigned char* pb = F.lds + (nn & 1) * dn::HC_BYTES;
            const int q = lane >> 4; const LAS unsigned char* rp = pb + dn::OFF_U + (((q >> 1) * 4 + w4) * 2 + (q & 1)) * 1024 + (lane & 15) * 64;
            float ssq = 0.f;
#pragma unroll
            for (int i = 0; i < 4; ++i) { const u32x4 hv = *(const LAS u32x4*)(rp + 16 * i); heldN[i] = hv;
                ssq += bflo(hv.x) * bflo(hv.x) + bfhi(hv.x) * bfhi(hv.x) + bflo(hv.y) * bflo(hv.y) + bfhi(hv.y) * bfhi(hv.y)
                     + bflo(hv.z) * bflo(hv.z) + bfhi(hv.z) * bfhi(hv.z) + bflo(hv.w) * bflo(hv.w) + bfhi(hv.w) * bfhi(hv.w); }
            part[((nn & 1) * 64 + lane) * 4 + w4] = ssq;
        }
        LDS_WAIT(); asm volatile("" ::: "memory");
        if (k + 1 < 32) DN_LOAD(k + 1, pbuf ^ 1);
        __builtin_amdgcn_sched_barrier(0);
        if (rows) { const bf16_t* zp = P + (size_t)(b * SEQ + (k - 1) * 64 + lane) * PLD + P_DNZ + h * 128 + 32 * w4;
#pragma unroll
            for (int i = 0; i < 4; ++i) zN[i] = *(const u32x4*)(zp + 8 * i); }
        __builtin_amdgcn_sched_barrier(0);
#ifdef SCAN_TOUCH_ON
        if (k + 2 < 32) {
            const unsigned char* tb = blk0 + (size_t)(k + 2) * hc_stride + (size_t)(w4 * 144) * 128;
            const unsigned char* a0 = tb + lane * 128; const unsigned char* a1 = tb + (64 + lane) * 128; const unsigned char* a2 = tb + (128 + (lane & 15)) * 128;
            asm volatile("; SCAN_TOUCH\n\tglobal_load_dword %0, %3, off\n\tglobal_load_dword %1, %4, off\n\tglobal_load_dword %2, %5, off" : "+v"(td0), "+v"(td1), "+v"(td2) : "v"(a0), "v"(a1), "v"(a2) : "memory");
        }
        __builtin_amdgcn_sched_barrier(0);
#endif
        u32x4 wo[4];
        if (k >= 2) {
            const int nn = k - 2; const f32x4 p4 = *(const LAS f32x4*)(part + ((nn & 1) * 64 + lane) * 4);
            const float rs = rsqrtf(((p4.x + p4.y) + (p4.z + p4.w)) * (1.f / 128.f) + EPS);
#pragma unroll
            for (int q = 0; q < 4; ++q) { const u32x4 zz = zO[q], hv = heldO[q]; const f32x4 ga = *(const LAS f32x4*)(gnl + 32 * w4 + 8 * q), gb = *(const LAS f32x4*)(gnl + 32 * w4 + 8 * q + 4);
                wo[q].x = pk2(bflo(hv.x) * rs * ga.x * siluf_(bflo(zz.x)), bfhi(hv.x) * rs * ga.y * siluf_(bfhi(zz.x)));
                wo[q].y = pk2(bflo(hv.y) * rs * ga.z * siluf_(bflo(zz.y)), bfhi(hv.y) * rs * ga.w * siluf_(bfhi(zz.y)));
                wo[q].z = pk2(bflo(hv.z) * rs * gb.x * siluf_(bflo(zz.z)), bfhi(hv.z) * rs * gb.y * siluf_(bfhi(zz.z)));
                wo[q].w = pk2(bflo(hv.w) * rs * gb.z * siluf_(bflo(zz.w)), bfhi(hv.w) * rs * gb.w * siluf_(bfhi(zz.w))); }
        }
#ifdef SCAN_TOUCH_ON
        if (k + 2 < 32) asm volatile("; SCAN_E\n\ts_waitcnt vmcnt(3)" ::: "memory"); else
#endif
        asm volatile("s_waitcnt vmcnt(0)" ::: "memory");
        if (k >= 2) { bf16_t* zp = P + (size_t)(b * SEQ + (k - 2) * 64 + lane) * PLD + P_DNZ + h * 128 + 32 * w4;
#pragma unroll
            for (int q = 0; q < 4; ++q) *(u32x4*)(zp + 8 * q) = wo[q]; }
#pragma unroll
        for (int i = 0; i < 4; ++i) { heldO[i] = heldN[i]; zO[i] = zN[i]; }
#ifdef PROBE_SCANH
        { const unsigned long long th1_ = __builtin_amdgcn_s_memrealtime(); const unsigned long long d_ = th1_ - th0_; while (__builtin_amdgcn_s_memrealtime() - th1_ < d_) __builtin_amdgcn_s_sleep(2); }
#endif
        lds_barrier();
    }
    asm volatile("s_waitcnt vmcnt(0)" : "+v"(td0), "+v"(td1), "+v"(td2) :: "memory");
    }
#undef DN_LOAD
#undef DN_PIECE
}

DI void final_norm(int wv) {
    const Frame F = mkframe(wv);
    const ArgsP ap = kargs();
    const float* ss = (const float*)(ap->ws + WS_SS);
    for (int m = F.gw; m < T; m += F.NGW) {
        const f32x4 s = *(const f32x4*)(ss + (size_t)m * 4); const float rs = rsqrtf(((s.x + s.y) + (s.z + s.w)) * (1.f / D) + EPS);
        f32x4* xr = (f32x4*)(ap->out + (size_t)m * D) + F.lane; const f32x4* gr = (const f32x4*)ap->final_norm_g + F.lane;
#pragma unroll
        for (int j = 0; j < 4; ++j) { const f32x4 v = xr[64 * j], g = gr[64 * j]; xr[64 * j] = v * rs * g; }
    }
}

__global__ void __launch_bounds__(NTHREADS, 2) mk_fwd(Args args) {
    extern __shared__ __attribute__((aligned(16))) unsigned char lds_raw[];
    LAS unsigned char* const lds = (LAS unsigned char*)lds_raw;
    volatile LAS unsigned* MISC = (volatile LAS unsigned*)(lds + MISC_OFF);
    const int wv = __builtin_amdgcn_readfirstlane((int)threadIdx.x >> 6);
    { const int t0 = opaque_tid(wv); for (int u = t0; u < (LDS_BYTES - LDSCTL_OFF) / 4; u += NTHREADS) ((LAS unsigned*)(lds + LDSCTL_OFF))[u] = 0u; }
    __syncthreads();
    const int G = gridDim.x;
    XcdBarrier bar; bar.bar = (unsigned*)(args.ws + WS_CTL) + CW_BAR + args.li * XCD_BAR_WORDS; bar.x = 0; bar.st = nullptr;
    if (args.ph_hi - args.ph_lo > 1) bar = xcd_barrier_post(bar.bar, MISC + 8, wv);
#define IN(k) (kargs()->ph_lo <= (k) && (k) < kargs()->ph_hi)
#ifdef PROBE_SUB
    unsigned long long ts_prev_ = 0;
#define SUBSEAM(bit) do { xcd_barrier(bar, wv); { const unsigned long long t1_ = __builtin_amdgcn_s_memrealtime(); \
        if ((PROBE_SUB >> (bit)) & 1u) { const unsigned long long d_ = t1_ - ts_prev_; while (__builtin_amdgcn_s_memrealtime() - t1_ < d_) __builtin_amdgcn_s_sleep(8); } \
        ts_prev_ = __builtin_amdgcn_s_memrealtime(); } } while (0)
#define SUBSTART() do { ts_prev_ = __builtin_amdgcn_s_memrealtime(); } while (0)
#else
#define SUBSEAM(bit) do { } while (0)
#define SUBSTART() do { } while (0)
#endif
#ifdef PROBE_ECHO
    unsigned long long t_prev_ = __builtin_amdgcn_s_memrealtime();
#define SEAM(k) do { if (IN(k) && IN((k) + 1)) xcd_barrier(bar, wv); { const unsigned long long t1_ = __builtin_amdgcn_s_memrealtime(); \
        if ((PROBE_ECHO >> (k)) & 1u) { const unsigned long long d_ = t1_ - t_prev_; while (__builtin_amdgcn_s_memrealtime() - t1_ < d_) __builtin_amdgcn_s_sleep(8); } \
        t_prev_ = __builtin_amdgcn_s_memrealtime(); } } while (0)
#else
#define SEAM(k) do { if (IN(k) && IN((k) + 1)) xcd_barrier(bar, wv); } while (0)
#endif
#define MK_EPI(E) gm::Epi E; E.ws = kargs()->ws; E.xin = nullptr; E.xout = nullptr; E.wout32 = false; E.b_gate = nullptr; E.gnext = nullptr; E.gfinal = nullptr; E.spare = (LAS float*)(lds + SPARE_OFF);

#if !defined(ONLY_PH) || ONLY_PH == 0
    if (IN(0)) { p0_prologue(wv); }
#endif
    SEAM(0);

    for (int l0 = 0; l0 < DEPTH; ++l0) {
        int l = l0; asm volatile("" : "+s"(l));
        const int pb = 1 + 6 * l;
#if !defined(ONLY_PH) || ONLY_PH == 1
        if (IN(pb)) { MK_EPI(E); SchedP1 S; S.ord.init(64, 12, G, opaque_bid()); S.ws = kargs()->ws; S.l = l; S.half = 0; S.c = opaque_bid(); S.with_kvm = false;
            gm::gemm_phase<AUX_P1>(lds, wv, S, E);
#ifdef PROBE_DUP_GEMM
            xcd_barrier(bar, wv); gm::gemm_phase<AUX_P1>(lds, wv, S, E);
#endif
            }
#endif
        SEAM(pb);
#if !defined(ONLY_PH) || ONLY_PH == 2
        if (IN(pb + 1)) {
            SUBSTART();
            SUBSEAM(0);
            for (int pair = opaque_bid(); pair < 512; pair += G) dn_prep(wv, l, pair);
            SUBSEAM(1);
            if (l > 0) { const Frame Fm = mkframe(wv); memn_rows(Fm, kargs(), l); }
 }
#endif
        SEAM(pb + 1);
#if !defined(ONLY_PH) || ONLY_PH == 3
        if (IN(pb + 2)) {
            if (opaque_bid() < 32 && G > 64) dn_scan(wv, l, opaque_bid());
            else { const bool split = G > 64; MK_EPI(E); SchedP1 S; S.ord.init(64, 12, split ? G - 32 : G, split ? opaque_bid() - 32 : opaque_bid()); S.ws = kargs()->ws; S.l = l; S.half = 1; S.c = opaque_bid(); S.with_kvm = true;
                gm::gemm_phase<AUX_P1>(lds, wv, S, E);
#ifdef PROBE_DUP_GEMM
                xcd_barrier(bar, wv); gm::gemm_phase<AUX_P1>(lds, wv, S, E);
#endif
                { const int cp = opaque_bid() - 32; const Frame Fc = mkframe(wv);
                  const int nsh = cp >= 112 ? 3 : 1, sh0 = cp >= 112 ? 3 * (cp - 112) : 336 + cp;
                  for (int q = 0; q < nsh; ++q) { const int first = (sh0 + q) * NWAVES + wv, stride = 448 * NWAVES;
                      if (l == 0) convert_weights(Fc, kargs(), 0, first, stride, 2);
                      if (l + 1 < DEPTH) convert_weights(Fc, kargs(), l + 1, first, stride, 0); } }
            }
            if (G <= 64) { for (int bh = opaque_bid(); bh < 32; bh += G) dn_scan(wv, l, bh); }
        }
#endif
        SEAM(pb + 2);
#if !defined(ONLY_PH) || ONLY_PH == 4
        if (IN(pb + 3)) {
            const int wg = opaque_bid();

            unsigned* head = (unsigned*)(kargs()->ws + WS_CTL) + CW_QUEUE + 64 * l;
            volatile LAS unsigned* qslot = (volatile LAS unsigned*)(lds + MISC_OFF + 64);
            for (;;) {
#ifdef PROBE_FETCH
                const unsigned long long tf0_ = __builtin_amdgcn_s_memrealtime();
#endif
                if (opaque_tid(wv) == 0) qslot[0] = __hip_atomic_fetch_add(head, 1u, __ATOMIC_RELAXED, __HIP_MEMORY_SCOPE_AGENT);
                __syncthreads();
                const int unit = (int)qslot[0];
                __syncthreads();
#ifdef PROBE_FETCH
                { const unsigned long long tf1_ = __builtin_amdgcn_s_memrealtime(); const unsigned long long d_ = tf1_ - tf0_; while (__builtin_amdgcn_s_memrealtime() - tf1_ < d_) __builtin_amdgcn_s_sleep(2); }
#endif
                if (unit >= 1248) break;
#ifdef PROBE_UNIT
                const unsigned long long tu0_ = __builtin_amdgcn_s_memrealtime();
#endif
                if (unit < 224) ret_state_unit(wv, l, unit); else if (unit < 480) attn_unit<1>(wv, l, unit - 224); else if (unit < 992) attn_unit<0>(wv, l, unit - 480); else mem_unit(wv, l, unit - 992);
#ifdef PROBE_UNIT
                { const unsigned long long tu1_ = __builtin_amdgcn_s_memrealtime(); if (PROBE_UNIT >= 2 ? (tu1_ - tu0_ > (unsigned long long)PROBE_UNIT * 100ull) : ((unit < 256) == (PROBE_UNIT == 1))) { const unsigned long long d_ = tu1_ - tu0_; while (__builtin_amdgcn_s_memrealtime() - tu1_ < d_) __builtin_amdgcn_s_sleep(8); } }
#endif
            }
        }
#endif
#ifdef KEEP_SEAM3
        SEAM(pb + 3);
#endif
#if !defined(ONLY_PH) || ONLY_PH == 5
        if (IN(pb + 4)) { MK_EPI(E); gm::TileOrder ord; ord.init(64, 4, G, opaque_bid()); SchedP3 S; S.ok = ord.tile(0, S.pm, S.pn); S.l = l; S.rot = (opaque_bid() >> 3) & 3; S.ws = kargs()->ws; E.b_gate = kargs()->b_gate;
            gm::gemm_phase<AUX_P3>(lds, wv, S, E);
#ifdef PROBE_DUP_GEMM
            xcd_barrier(bar, wv); gm::gemm_phase<AUX_P3>(lds, wv, S, E);
#endif
            }
#endif
        SEAM(pb + 4);
#if !defined(ONLY_PH) || ONLY_PH == 6
        if (IN(pb + 5)) { MK_EPI(E); gm::TileOrder ord; ord.init(64, 4, G, opaque_bid()); SchedP4 S; S.ok = ord.tile(0, S.pm, S.pn); S.l = l; S.ws = kargs()->ws;
            E.gnext = (l + 1 < DEPTH) ? kargs()->norm_g + (size_t)(l + 1) * D : nullptr;
            E.gfinal = (l + 1 < DEPTH || G != 256) ? nullptr : kargs()->final_norm_g;
            E.xout = kargs()->out; E.xin = (l == 0) ? kargs()->x : (const float*)kargs()->out;
            E.wout32 = (l + 1 == DEPTH) && G != 256;
            gm::gemm_phase<AUX_P4>(lds, wv, S, E); }
#endif
        if (!(l + 1 == DEPTH && G == 256)) SEAM(pb + 5);
    }
#if !defined(ONLY_PH) || ONLY_PH == 13
    if (IN(13) && G != 256) final_norm(wv);
#endif
#undef IN
#undef SEAM
#undef MK_EPI
}

extern "C" void kernel_launch(void* const* d_in, const int* in_sizes, int n_in, void* d_out, int out_size, void* d_ws, size_t ws_size, hipStream_t stream) {
    static int grid = 0;
    if (grid == 0) {
        if (n_in != 19 || out_size != T * D || ws_size < WS_END) { fprintf(stderr, "kernel_launch: unexpected problem (n_in %d, out %d, ws %zu)\n", n_in, out_size, ws_size); grid = -1; return; }
        int dev = 0, cus = 0, per_cu = 0;
        if (hipGetDevice(&dev) != hipSuccess || hipDeviceGetAttribute(&cus, hipDeviceAttributeMultiprocessorCount, dev) != hipSuccess) { grid = -1; return; }
        if (hipFuncSetAttribute((const void*)mk_fwd, hipFuncAttributeMaxDynamicSharedMemorySize, LDS_BYTES) != hipSuccess) { fprintf(stderr, "kernel_launch: hipFuncSetAttribute failed\n"); grid = -1; return; }
        if (hipOccupancyMaxActiveBlocksPerMultiprocessor(&per_cu, (const void*)mk_fwd, NTHREADS, LDS_BYTES) != hipSuccess || per_cu < 1)
            fprintf(stderr, "kernel_launch: occupancy query reports %d workgroups per CU\n", per_cu);
        (void)hipGetLastError();
        grid = cus;
    }
    if (grid < 0) return;
    if (hipMemsetAsync((char*)d_ws + WS_CTL, 0, CTL_ZERO_BYTES, stream) != hipSuccess) return;
    Args a{};
    a.x = (const float*)d_in[0]; a.mem = (const float*)d_in[1]; a.positions = (const int*)d_in[2]; a.norm_g = (const float*)d_in[3]; a.mem_norm_g = (const float*)d_in[4];
    a.w_in = (const float*)d_in[5]; a.b_gate = (const float*)d_in[6]; a.dn_conv_w = (const float*)d_in[7]; a.dn_a_log = (const float*)d_in[8]; a.dn_dt_bias = (const float*)d_in[9];
    a.dn_norm_g = (const float*)d_in[10]; a.ret_norm_g = (const float*)d_in[11]; a.w_mem_kv = (const float*)d_in[12]; a.w_br_sb = (const float*)d_in[13]; a.w_br_dn = (const float*)d_in[14];
    a.w_br_ret = (const float*)d_in[15]; a.w_br_mem = (const float*)d_in[16]; a.w_out = (const float*)d_in[17]; a.final_norm_g = (const float*)d_in[18];
    a.out = (float*)d_out; a.ws = (unsigned char*)d_ws;
#if MK_N_LAUNCHES == 1
    a.ph_lo = 0; a.ph_hi = NPHASE; a.li = 0;
    hipLaunchKernelGGL(mk_fwd, dim3(grid), dim3(NTHREADS), LDS_BYTES, stream, a);
#else
    for (int p = 0; p < NPHASE; ++p) { a.ph_lo = p; a.ph_hi = p + 1; a.li = 0;
        hipLaunchKernelGGL(mk_fwd, dim3(grid), dim3(NTHREADS), LDS_BYTES, stream, a); }
#endif
}
```

```cpp
#include <hip/hip_runtime.h>
#include <cstdio>
#include <cstdint>
#include <cmath>

#define LAS __attribute__((address_space(3)))
#define GAS __attribute__((address_space(1)))
#define DI __device__ __forceinline__
typedef unsigned short bf16_t;
typedef short bf16x8 __attribute__((ext_vector_type(8)));
typedef float f32x4 __attribute__((ext_vector_type(4)));
typedef unsigned u32x4 __attribute__((ext_vector_type(4)));
typedef unsigned u32x2 __attribute__((ext_vector_type(2)));
typedef float f32x2 __attribute__((ext_vector_type(2)));

#ifndef AUX_P1
#define AUX_P1 0
#endif
#ifndef AUX_P3
#define AUX_P3 0
#endif
#ifndef AUX_P4
#define AUX_P4 0
#endif
#ifdef EPI_NT
#define EPI_LD(p) __builtin_nontemporal_load(p)
#define EPI_ST(p, v) __builtin_nontemporal_store((v), (p))
#else
#define EPI_LD(p) (*(p))
#define EPI_ST(p, v) (*(p) = (v))
#endif
#ifndef FRESH_WAITS
#define FRESH_WAITS 0
#endif
#ifndef SS_PREFETCH
#define SS_PREFETCH 1
#endif
#ifndef EARLY_INV
#define EARLY_INV 1
#endif
#ifndef SCAN_AUX
#define SCAN_AUX 2
#endif
#ifndef MK_N_LAUNCHES
#define MK_N_LAUNCHES 1
#endif

constexpr int BATCH = 8, SEQ = 2048, D = 1024, T = BATCH * SEQ, DEPTH = 2, MEMLEN = 256;
constexpr int IN_COLS = 9992;
constexpr float EPS = 1e-6f;
constexpr int NPHASE = 14;

constexpr size_t MiB = 1u << 20;
constexpr size_t WS_CTL = 0, CTL_ZERO_BYTES = 1 * MiB;
constexpr size_t WS_WINA = 1 * MiB;
constexpr size_t WS_WINB = 13 * MiB;
constexpr size_t WS_WG = 25 * MiB;
constexpr size_t WS_WBR = 41 * MiB;
constexpr size_t WS_WOUT = 49 * MiB;
constexpr size_t WS_WKV = 53 * MiB;
constexpr size_t WS_XN = 55 * MiB;
constexpr size_t WS_P = 87 * MiB;
constexpr size_t WS_R = 127 * MiB;
constexpr int VTLD = T + 64;
constexpr size_t WS_VTSB = WS_R + 64 * MiB, WS_VTRT = WS_VTSB + (size_t)512 * VTLD * 2;
constexpr size_t WS_SCR = 224 * MiB;
constexpr size_t WS_MRG = 240 * MiB;
constexpr size_t WS_DNI = 224 * MiB;
constexpr size_t WS_KVM = 296 * MiB;
constexpr size_t WS_ROPE = 300 * MiB;
constexpr size_t WS_AB = 304 * MiB;
constexpr size_t WS_GB = WS_AB + 512 * 1024;
constexpr size_t WS_SS = 305 * MiB;
constexpr size_t WS_END = 310 * MiB;
constexpr size_t WS_MEMN = 306 * MiB;
constexpr int PLD = 1280, RALD = 1536, RBLD = 2048, SCRLD = 1024, MRGLD = 1024;
constexpr int P_DNZ = 0, P_MEMQ = 512, P_RTQ = 768, P_RTK = 1024;
constexpr int RB_SBQ = 0, RB_SBK = 512, RB_SBZ = 1024, RB_RTZ = 1536;
constexpr int CW_BAR = 4096;
constexpr int CW_PANEL = 16384;
constexpr int CW_QUEUE = 64;
constexpr int CW_RST = 49152;
constexpr int CW_READY = 32768;

constexpr int RING_BYTES = 155648;
constexpr int LDSCTL_OFF = RING_BYTES, MISC_OFF = LDSCTL_OFF + 320, SPARE_OFF = LDSCTL_OFF + 1024;
constexpr int LDS_BYTES = 163840;
constexpr int NWAVES = 8, NTHREADS = 512;

DI unsigned f2bf(float f) { unsigned u = __builtin_bit_cast(unsigned, f); return (u + 0x7fffu + ((u >> 16) & 1u)) >> 16; }
DI unsigned pk2(float lo, float hi) { unsigned r; asm("s_nop 0\n\tv_cvt_pk_bf16_f32 %0, %1, %2" : "=v"(r) : "v"(lo), "v"(hi)); return r; }
DI float bf2f(unsigned short h) { return __builtin_bit_cast(float, (unsigned)h << 16); }
DI float bflo(unsigned w) { return __builtin_bit_cast(float, w << 16); }
DI float bfhi(unsigned w) { return __builtin_bit_cast(float, w & 0xffff0000u); }
DI float shx(float v, int m, int lane) { return __builtin_bit_cast(float, __builtin_amdgcn_ds_bpermute((lane ^ m) << 2, __builtin_bit_cast(int, v))); }
DI float wave_sum(float v, int lane) {
#pragma unroll
    for (int o = 1; o < 64; o <<= 1) v += shx(v, o, lane);
    return v;
}
DI float sum16(float v) {
    v += __builtin_bit_cast(float, __builtin_amdgcn_update_dpp(0, __builtin_bit_cast(int, v), 0xB1, 0xf, 0xf, true));
    v += __builtin_bit_cast(float, __builtin_amdgcn_update_dpp(0, __builtin_bit_cast(int, v), 0x4E, 0xf, 0xf, true));
    v += __builtin_bit_cast(float, __builtin_amdgcn_update_dpp(0, __builtin_bit_cast(int, v), 0x141, 0xf, 0xf, true));
    v += __builtin_bit_cast(float, __builtin_amdgcn_update_dpp(0, __builtin_bit_cast(int, v), 0x140, 0xf, 0xf, true));
    return v;
}
DI float sigmoidf_(float x) { return __builtin_amdgcn_rcpf(1.f + __builtin_amdgcn_exp2f(x * -1.4426950408889634f)); }
DI float siluf_(float x) { return x * __builtin_amdgcn_rcpf(1.f + __builtin_amdgcn_exp2f(x * -1.4426950408889634f)); }
DI int opaque_bid() { int b = blockIdx.x; asm volatile("" : "+s"(b)); return b; }
DI int opaque_tid(int wv) { int lane; asm volatile("v_mbcnt_lo_u32_b32 %0, -1, 0\n\tv_mbcnt_hi_u32_b32 %0, -1, %0" : "=v"(lane)); return wv * 64 + lane; }
#define LDS_WAIT() asm volatile("s_waitcnt lgkmcnt(0)" ::: "memory")
DI void lds_barrier() { asm volatile("s_waitcnt lgkmcnt(0)" ::: "memory"); __builtin_amdgcn_s_barrier(); asm volatile("" ::: "memory"); }
#define VM_WAIT() asm volatile("s_waitcnt vmcnt(0)" ::: "memory")
DI unsigned shxu(unsigned v, int m, int lane) { return (unsigned)__builtin_amdgcn_ds_bpermute((lane ^ m) << 2, (int)v); }
DI void st16_wt(void* p, u32x4 v) { asm volatile("global_store_dwordx4 %0, %1, off sc1\n\ts_nop 1" :: "v"(p), "v"(v) : "memory"); }
DI void unit_done(unsigned char* ws, int l, int pm, int tid) {
    VM_WAIT(); lds_barrier();
    if (tid == 0) (void)__hip_atomic_fetch_add((unsigned*)(ws + WS_CTL) + CW_READY + 4096 * l + 64 * pm, 1u, __ATOMIC_RELAXED, __HIP_MEMORY_SCOPE_AGENT);
}

#define XB_TMO      128
#define XB_XCNT(j)  (256  + 64 * (j))
#define XB_XSUB(j)  (1280 + 64 * (j))
#define XB_XGEN(j)  (2304 + 64 * (j))
#define XB_TOP      3328
#define XB_TOPGEN   3392
#define XCD_BAR_WORDS 3456
#define XB_SPIN_CAP (1u << 18)
DI unsigned xb_ld(unsigned* p)              { return __hip_atomic_load(p, __ATOMIC_RELAXED, __HIP_MEMORY_SCOPE_AGENT); }
DI unsigned xb_add(unsigned* p, unsigned v) { return __hip_atomic_fetch_add(p, v, __ATOMIC_RELAXED, __HIP_MEMORY_SCOPE_AGENT); }
DI unsigned xb_xcc_id() { return (unsigned)__builtin_amdgcn_s_getreg((3 << 11) | 20) & 0xFu; }
#define XB_SPIN(cond, bar) do { unsigned _sp = 0; while (cond) { __builtin_amdgcn_s_sleep(1); \
    if ((++_sp & 255u) == 0u) { if (xb_ld(&(bar)[XB_TMO])) break; if (_sp > XB_SPIN_CAP) { atomicAdd(&(bar)[XB_TMO], 1u); break; } } } } while (0)
struct XcdBarrier { unsigned* bar; unsigned x; volatile LAS unsigned* st; };
DI XcdBarrier xcd_barrier_post(unsigned* bar, volatile LAS unsigned* st, int wv) {
    XcdBarrier b; b.bar = bar; b.x = xb_xcc_id(); b.st = st;
    if (opaque_tid(wv) == 0) (void)xb_add(&bar[XB_XCNT(b.x)], 1u);
    return b;
}
DI void xcd_barrier_complete(unsigned* bar, unsigned x, unsigned& nloc, unsigned& nx) {
    const unsigned G = gridDim.x * gridDim.y * gridDim.z;
    unsigned sum, cnt, mine, sp = 0u;
    for (;;) {
        sum = 0u; cnt = 0u; mine = 0u;
#pragma unroll
        for (unsigned j = 0; j < 16; ++j) { const unsigned c = xb_ld(&bar[XB_XCNT(j)]); sum += c; cnt += (c > 0u) ? 1u : 0u; mine = (j == x) ? c : mine; }
        if (sum == G) break;
        __builtin_amdgcn_s_sleep(1);
        if ((++sp & 255u) == 0u) { if (xb_ld(&bar[XB_TMO])) break; if (sp > XB_SPIN_CAP) { atomicAdd(&bar[XB_TMO], 1u); break; } }
    }
    nloc = mine > 0u ? mine : 1u; nx = cnt > 0u ? cnt : 1u;
}
DI void xcd_barrier(const XcdBarrier& b, int wv) {
    asm volatile("s_waitcnt vmcnt(0)" ::: "memory");
    __syncthreads();
    if (opaque_tid(wv) == 0) {
        unsigned* bar = b.bar;
        __builtin_amdgcn_s_waitcnt(0);
#if EARLY_INV
        __builtin_amdgcn_fence(__ATOMIC_ACQUIRE, "agent");
#endif
        unsigned nloc = b.st[0], nx = b.st[1];
        if (nloc == 0u) { xcd_barrier_complete(bar, b.x, nloc, nx); b.st[0] = nloc; b.st[1] = nx; }
        const unsigned old = xb_add(&bar[XB_XSUB(b.x)], 1u);
        const unsigned gen = old / nloc;
        if (old + 1u == (gen + 1u) * nloc) {
            __builtin_amdgcn_fence(__ATOMIC_RELEASE, "agent");
            asm volatile("s_waitcnt vmcnt(0)" ::: "memory");
            const unsigned og = xb_add(&bar[XB_TOP], 1u);
            const unsigned tg = og / nx;
            if (og + 1u == (tg + 1u) * nx) xb_add(&bar[XB_TOPGEN], 1u);
            else XB_SPIN(xb_ld(&bar[XB_TOPGEN]) == tg, bar);
#if !EARLY_INV
            __builtin_amdgcn_fence(__ATOMIC_ACQUIRE, "agent");
#endif
            xb_add(&bar[XB_XGEN(b.x)], 1u);
            asm volatile("s_waitcnt vmcnt(0)" ::: "memory");
        } else {
            XB_SPIN(xb_ld(&bar[XB_XGEN(b.x)]) == gen, bar);
#if !EARLY_INV
            __builtin_amdgcn_fence(__ATOMIC_ACQUIRE, "agent");
#endif
            asm volatile("s_waitcnt vmcnt(0)" ::: "memory");
        }
    }
    __syncthreads();
}

namespace gm {
constexpr int BM = 256, BK = 64, HALF = 128, HTB = HALF * BK * 2, STAGE_BYTES = 8 * HTB;
DI int lds_byte(int r, int c) { const int st = (r >> 4) * 2 + (c >> 5), rr = r & 15, cc = c & 31, ob = rr * 64 + cc * 2; return st * 1024 + (ob ^ (((ob >> 9) & 1) << 5)); }
DI void stage_rc(int b, int& R, int& C) { const int st = b / 1024, sb = b % 1024, swz = sb ^ (((sb >> 9) & 1) << 5); R = (st >> 1) * 16 + swz / 64; C = (st & 1) * 32 + (swz % 64) / 2; }
DI int perm32(int rho) { const int n = rho >> 4, i = rho & 15; return 8 * (i >> 2) + 4 * n + (i & 3); }

enum Kind { K_STORE = 0, K_AB = 1, K_GATE = 2, K_BRANCH = 3, K_OUT = 4, K_STORE_T = 5 };
struct Unit {
    const bf16_t* A; const bf16_t* B;
    int lda, ldb, K, pm, pn, kind, sub, l;
};
struct TileOrder {
    int nM, nN, nwg, G, c;
    DI void init(int nM_, int nN_, int G_, int c_) { nM = nM_; nN = nN_; nwg = nM * nN; G = G_; c = c_; }
    DI bool tile(int i, int& pm, int& pn) const {
        const long L = (long)i * G + c; if (L >= nwg) return false;
        int wgid = (int)L; { const int q = nwg / 8, r = nwg % 8, xcd = wgid % 8, off = wgid / 8; wgid = (xcd < r ? xcd * (q + 1) : r * (q + 1) + (xcd - r) * q) + off; }
        const int WGM = 8, nig = WGM * nN, gid = wgid / nig, fm = gid * WGM, gsz = (nM - fm) < WGM ? (nM - fm) : WGM;
        pm = __builtin_amdgcn_readfirstlane(fm + ((wgid % nig) % gsz)); pn = __builtin_amdgcn_readfirstlane((wgid % nig) / gsz); return true;
    }
};

template <int AUX, class Sched, class Epi>
DI void gemm_phase(LAS unsigned char* lds, int wv, const Sched& S, const Epi& E) {
    const int tid = opaque_tid(wv), wid = __builtin_amdgcn_readfirstlane(tid >> 6), lane = tid & 63, wr = wid >> 2, wc = wid & 3, fr = lane & 15, fq = lane >> 4;
    int R0_, C0_; stage_rc(tid * 16, R0_, C0_);
    const unsigned R0 = 2u * (unsigned)R0_, C2 = 2u * (unsigned)C0_;
    const unsigned RbP = 2u * (unsigned)((R0_ & ~31) + perm32(R0_ & 31));
    const unsigned ldsw = (unsigned)wid * 1024u;
    const int aoff = lds_byte(wr * 64 + fr, fq * 8), boff = lds_byte(wc * 32 + fr, fq * 8);
#define GM_SA(b, h) (((b) * 2 + (h)) * HTB)
#define GM_SB(b, h) ((4 + (b) * 2 + (h)) * HTB)
#define GM_STAGE(bufoff, gbase, ld, R2) do { const unsigned _v = (unsigned)(R2) * (unsigned)(ld) + C2; \
        __builtin_amdgcn_global_load_lds((const unsigned*)((const char*)(gbase) + _v), (LAS unsigned*)(lds + (bufoff) + ldsw), 16, 0, AUX); \
        __builtin_amdgcn_global_load_lds((const unsigned*)((const char*)(gbase) + (_v + (unsigned)(ld) * 128u)), (LAS unsigned*)(lds + (bufoff) + ldsw + 8192), 16, 0, AUX); } while (0)
#define GM_LDA(dst, b, h) do { _Pragma("unroll") for (int m = 0; m < 4; ++m) _Pragma("unroll") for (int k = 0; k < 2; ++k) dst[m][k] = *(const LAS bf16x8*)(lds + GM_SA(b, h) + aoff + m * 2048 + k * 1024); } while (0)
#define GM_LDB(dst, b, h) do { _Pragma("unroll") for (int n = 0; n < 2; ++n) _Pragma("unroll") for (int k = 0; k < 2; ++k) dst[n][k] = *(const LAS bf16x8*)(lds + GM_SB(b, h) + boff + n * 2048 + k * 1024); } while (0)
#define GM_MMA(ai, bj, At, Bt) do { __builtin_amdgcn_s_setprio(1); _Pragma("unroll") for (int m = 0; m < 4; ++m) _Pragma("unroll") for (int n = 0; n < 2; ++n) _Pragma("unroll") for (int k = 0; k < 2; ++k) \
        acc[ai][bj][m][n] = __builtin_amdgcn_mfma_f32_16x16x32_bf16(Bt[n][k], At[m][k], acc[ai][bj][m][n], 0, 0, 0); __builtin_amdgcn_s_setprio(0); } while (0)
#define GM_WAIT_V(n) asm volatile("s_waitcnt vmcnt(" #n ")" ::: "memory")
#define GM_WAIT_L(n) asm volatile("s_waitcnt lgkmcnt(" #n ")" ::: "memory")
#define GM_BAR __builtin_amdgcn_s_barrier()
#define GM_SCHED __builtin_amdgcn_sched_barrier(0)
    Unit cur, nxt; int ui = 0;
    if (!S.next(0, cur)) return;
    S.a_ready(cur, wid, lane);
    f32x4 acc[2][2][4][2];
#pragma unroll
    for (int a = 0; a < 2; ++a)
#pragma unroll
        for (int b = 0; b < 2; ++b)
#pragma unroll
            for (int m = 0; m < 4; ++m)
#pragma unroll
                for (int n = 0; n < 2; ++n) acc[a][b][m][n] = (f32x4){0.f, 0.f, 0.f, 0.f};
    bf16x8 At[4][2], B0[2][2], B1[2][2];
    const char* cA = (const char*)cur.A; const char* cB = (const char*)cur.B; int clda = cur.lda, cldb = cur.ldb;
    GM_STAGE(GM_SB(0, 0), cB, cldb, RbP); GM_STAGE(GM_SB(0, 1), cB + (size_t)cldb * 256, cldb, RbP); GM_STAGE(GM_SA(0, 0), cA, clda, R0); GM_STAGE(GM_SA(0, 1), cA + (size_t)clda * 256, clda, R0);
    if (wr == 1) GM_BAR;
    GM_WAIT_V(2); GM_BAR;
    GM_STAGE(GM_SB(1, 0), cB + 128, cldb, RbP); GM_STAGE(GM_SA(1, 0), cA + 128, clda, R0); GM_STAGE(GM_SB(1, 1), cB + (size_t)cldb * 256 + 128, cldb, RbP);
    GM_WAIT_V(6); GM_BAR;
    for (;;) {
        const bool has_next = S.next(ui + 1, nxt);
        const char* nA = has_next ? (const char*)nxt.A : cA; const char* nB = has_next ? (const char*)nxt.B : cB;
        const int nlda = has_next ? nxt.lda : clda, nldb = has_next ? nxt.ldb : cldb;
        const int nt = cur.K / BK;
#if SS_PREFETCH
        if (wid < 4) __builtin_amdgcn_global_load_lds((const unsigned*)(E.ws + WS_SS + ((size_t)(cur.kind == K_STORE_T ? cur.pn : cur.pm) * 256 + tid) * 16), (LAS unsigned*)(lds + STAGE_BYTES + (ui & 1) * 4096 + wid * 1024), 16, 0, 0);
        if (wid == 5 && cur.kind == K_STORE && cur.sub == 0 && cur.pn >= 10 && E.pos != nullptr)
            __builtin_amdgcn_global_load_lds((const unsigned*)(E.pos + cur.pm * 256 + lane * 4), (LAS unsigned*)(lds + STAGE_BYTES + 10240 + (ui & 1) * 1024), 16, 0, 0);
        if (wid == 4 && cur.kind == K_GATE) __builtin_amdgcn_global_load_lds((const unsigned*)(E.b_gate + (size_t)cur.l * 4096 + (cur.sub & 3) * 1024 + cur.pn * 256 + lane * 4), (LAS unsigned*)(lds + STAGE_BYTES + 8192 + (ui & 1) * 1024), 16, 0, 0);
#endif
        for (int t = 0; t < nt; t += 2) {
            const bool last = (t == nt - 2);
            if (last && has_next) S.a_ready(nxt, wid, lane);
            const char* a1 = cA + (size_t)(t + 1) * 128;
            const char* a2 = last ? nA : cA + (size_t)(t + 2) * 128; const char* b2 = last ? nB : cB + (size_t)(t + 2) * 128;
            const int lda2 = last ? nlda : clda, ldb2 = last ? nldb : cldb;
            const char* a3 = a2 + 128; const char* b3 = b2 + 128;
            const int later = __builtin_amdgcn_readfirstlane((t != 0) ? 1 : 0);
#if FRESH_WAITS
#define GM_WAIT_V8_LATER asm volatile("s_cmp_eq_u32 %0, 0\n\ts_cbranch_scc1 .Lgmw%=\n\ts_waitcnt vmcnt(8)\n.Lgmw%=:" :: "s"(later) : "scc", "memory")
#else
#define GM_WAIT_V8_LATER GM_WAIT_V(8)
#endif
            GM_LDB(B0, 0, 0); GM_LDB(B1, 0, 1); GM_SCHED; GM_LDA(At, 0, 0); GM_STAGE(GM_SA(1, 1), a1 + (size_t)clda * 256, clda, R0);
            GM_WAIT_V8_LATER; GM_WAIT_L(0); GM_BAR; GM_MMA(0, 0, At, B0); GM_MMA(0, 1, At, B1); GM_BAR; GM_SCHED;
            GM_LDA(At, 0, 1); GM_STAGE(GM_SB(0, 0), b2, ldb2, RbP); GM_STAGE(GM_SB(0, 1), b2 + (size_t)ldb2 * 256, ldb2, RbP); GM_STAGE(GM_SA(0, 0), a2, lda2, R0);
            GM_WAIT_V8_LATER; GM_WAIT_L(0); GM_BAR; GM_MMA(1, 0, At, B0); GM_MMA(1, 1, At, B1); GM_BAR; GM_SCHED;
#undef GM_WAIT_V8_LATER
            GM_LDB(B0, 1, 0); GM_LDB(B1, 1, 1); GM_SCHED; GM_LDA(At, 1, 0); GM_STAGE(GM_SA(0, 1), a2 + (size_t)lda2 * 256, lda2, R0);
            GM_WAIT_V(8); GM_WAIT_L(0); GM_BAR; GM_MMA(0, 0, At, B0); GM_MMA(0, 1, At, B1); GM_BAR; GM_SCHED;
            GM_LDA(At, 1, 1); GM_STAGE(GM_SB(1, 0), b3, ldb2, RbP); GM_STAGE(GM_SB(1, 1), b3 + (size_t)ldb2 * 256, ldb2, RbP); GM_STAGE(GM_SA(1, 0), a3, lda2, R0);
            GM_WAIT_V(8); GM_WAIT_L(0); GM_BAR; GM_MMA(1, 0, At, B0); GM_MMA(1, 1, At, B1); GM_BAR; GM_SCHED;
        }
        if (wr == 0) GM_BAR;
        if (FRESH_WAITS && (cur.kind == K_AB || (cur.kind == K_STORE && cur.sub == 2) || (cur.kind == K_STORE_T && cur.sub == 1))) GM_WAIT_V(0);
#ifdef PROBE_EPI
        const unsigned long long te0_ = __builtin_amdgcn_s_memrealtime();
#endif
        E(acc, cur, wr, wc, fr, fq, lane, (const LAS float*)(lds + STAGE_BYTES + (ui & 1) * 4096), (const LAS float*)(lds + STAGE_BYTES + 8192 + (ui & 1) * 1024), (const LAS int*)(lds + STAGE_BYTES + 10240 + (ui & 1) * 1024));
#ifdef PROBE_EPI
        if (cur.kind == PROBE_EPI) { asm volatile("s_waitcnt vmcnt(0)" ::: "memory"); const unsigned long long t1_ = __builtin_amdgcn_s_memrealtime(); const unsigned long long d_ = t1_ - te0_; while (__builtin_amdgcn_s_memrealtime() - t1_ < d_) __builtin_amdgcn_s_sleep(2); }
#endif
        if (!has_next) break;
#pragma unroll
        for (int a = 0; a < 2; ++a)
#pragma unroll
            for (int b = 0; b < 2; ++b)
#pragma unroll
                for (int m = 0; m < 4; ++m)
#pragma unroll
                    for (int n = 0; n < 2; ++n) acc[a][b][m][n] = (f32x4){0.f, 0.f, 0.f, 0.f};
        cur = nxt; cA = nA; cB = nB; clda = nlda; cldb = nldb; ++ui;
        if (wr == 1) GM_BAR;
    }
    GM_WAIT_V(0);
    GM_BAR;
#undef GM_SA
#undef GM_SB
#undef GM_STAGE
#undef GM_LDA
#undef GM_LDB
#undef GM_MMA
#undef GM_WAIT_V
#undef GM_WAIT_L
#undef GM_BAR
#undef GM_SCHED
}

#if SS_PREFETCH
#define SSROW(pan, r) row_scale_l(ssl, (r))
#else
#define SSROW(pan, r) row_scale((pan) * BM + (r))
#endif
struct Epi {
    unsigned char* ws;
    const float* xin; float* xout;
    bool wout32;
    const float* b_gate;
    const float* gnext;
    const float* gfinal;
    LAS float* spare;
    const int* pos;
    unsigned char* mrgp;
    DI float row_scale(int row) const { const f32x4 s = *(const f32x4*)((const float*)(ws + WS_SS) + (size_t)row * 4); return rsqrtf(((s.x + s.y) + (s.z + s.w)) * (1.0f / 1024.0f) + EPS); }
    static DI float row_scale_l(const LAS float* ssl, int r) { const f32x4 s = *(const LAS f32x4*)(ssl + r * 4); return rsqrtf(((s.x + s.y) + (s.z + s.w)) * (1.0f / 1024.0f) + EPS); }
    unsigned char* scr_alt;
    DI unsigned char* scratch_tile(int pm, int pn, int alt = 0) const { return (alt ? scr_alt : ws + WS_SCR) + ((size_t)pm * 4 + pn) * 65536; }
    static DI int scratch_off(int ai, int m, int bj, int so0) { return ((ai * 4 + m) * 2 + bj) * 4096 + so0; }
    DI void operator()(f32x4 (&acc)[2][2][4][2], const Unit& u, int wr, int wc, int fr, int fq, int lane, const LAS float* ssl, const LAS float* bil, const LAS int* posl) const {
        int rl0 = wr * 64 + fr, cl0 = wc * 32 + 8 * fq;
        int so0 = (wr * 4 + wc) * 512 + lane * 8;
        asm volatile("" : "+v"(rl0), "+v"(cl0), "+v"(so0));
        if (u.kind == K_STORE) {
            bf16_t* base; int ldc; bool scale = true;
            if (u.sub == 0) {
                if (u.pn < 6) { base = (bf16_t*)(ws + WS_R) + (size_t)u.pm * 256 * RALD + u.pn * 256; ldc = RALD; }
                else { const int pc = u.pn < 8 ? (u.pn - 6) * 256 : (u.pn - 7) * 256; base = (bf16_t*)(ws + WS_P) + (size_t)u.pm * 256 * PLD + pc; ldc = PLD; }
            } else if (u.sub == 1) { base = (bf16_t*)(ws + WS_R) + (size_t)u.pm * 256 * RBLD + u.pn * 256; ldc = RBLD; }
            else { base = (bf16_t*)(ws + WS_KVM) + (size_t)u.l * 1024 * 1024 + (size_t)u.pm * 256 * 256; ldc = 256; scale = false; }
            const bool rope = (u.sub == 0 && u.pn >= 10);
            const float rsc = (u.pn == 11) ? 0.125f : 1.0f;
            const int fi = (cl0 & 63) >> 1;
            f32x4 inv4 = {0.f, 0.f, 0.f, 0.f};
            if (rope) {
#pragma unroll
                for (int j = 0; j < 4; ++j) inv4[j] = exp2f(-(float)(fi + j) * (13.287712379549449f / 32.0f)); }
            float scq[2][4];
#pragma unroll
            for (int ai = 0; ai < 2; ++ai)
#pragma unroll
                for (int m = 0; m < 4; ++m) scq[ai][m] = scale ? SSROW(u.pm, rl0 + ai * HALF + m * 16) : 1.0f;
#pragma unroll
            for (int ai = 0; ai < 2; ++ai) {
#pragma unroll
                for (int m = 0; m < 4; ++m) {
                    const int rl = rl0 + ai * HALF + m * 16;
                    const float sc = scq[ai][m];
                    bf16_t* rowp = base + (size_t)rl * ldc + cl0;
                    f32x4 cs4 = {1.f, 1.f, 1.f, 1.f}, sn4 = {0.f, 0.f, 0.f, 0.f};
                    if (rope) { const float pf = (float)posl[rl];
#pragma unroll
                        for (int j = 0; j < 4; ++j) { const float rev = (pf * inv4[j]) * 0.15915494309189535f, frv = rev - floorf(rev); cs4[j] = __builtin_amdgcn_cosf(frv); sn4[j] = __builtin_amdgcn_sinf(frv); } }
#pragma unroll
                    for (int bj = 0; bj < 2; ++bj) { f32x4 v0 = acc[ai][bj][m][0] * sc, v1 = acc[ai][bj][m][1] * sc;
                        if (rope) { f32x4 r0, r1;
                            r0[0] = (v0[0] * cs4[0] - v0[1] * sn4[0]) * rsc; r0[1] = (v0[0] * sn4[0] + v0[1] * cs4[0]) * rsc; r0[2] = (v0[2] * cs4[1] - v0[3] * sn4[1]) * rsc; r0[3] = (v0[2] * sn4[1] + v0[3] * cs4[1]) * rsc;
                            r1[0] = (v1[0] * cs4[2] - v1[1] * sn4[2]) * rsc; r1[1] = (v1[0] * sn4[2] + v1[1] * cs4[2]) * rsc; r1[2] = (v1[2] * cs4[3] - v1[3] * sn4[3]) * rsc; r1[3] = (v1[2] * sn4[3] + v1[3] * cs4[3]) * rsc;
                            v0 = r0; v1 = r1; }
                        u32x4 w; w.x = pk2(v0[0], v0[1]); w.y = pk2(v0[2], v0[3]); w.z = pk2(v1[0], v1[1]); w.w = pk2(v1[2], v1[3]);
                        *(u32x4*)(rowp + bj * HALF) = w; }
                }
            }
        } else if (u.kind == K_STORE_T) {
            bf16_t* base; const bool scale = (u.sub == 0);
            if (u.sub == 0) base = (bf16_t*)(ws + WS_VTSB) + (size_t)u.pm * 256 * VTLD + u.pn * 256;
            else base = (bf16_t*)(ws + WS_KVM) + (size_t)u.l * 1024 * 1024 + 256 * 2048 + u.pn * 256;
            const int ldc = (u.sub == 0) ? VTLD : 2048;
            f32x4 cs[2][2];
#pragma unroll
            for (int bj = 0; bj < 2; ++bj)
#pragma unroll
                for (int n = 0; n < 2; ++n)
#pragma unroll
                    for (int j = 0; j < 4; ++j) cs[bj][n][j] = scale ? SSROW(u.pn, cl0 + bj * HALF + 4 * n + j) : 1.0f;
#pragma unroll
            for (int ai = 0; ai < 2; ++ai)
#pragma unroll
                for (int m = 0; m < 4; ++m) {
                    const int rl = rl0 + ai * HALF + m * 16;
                    bf16_t* rowp = base + (size_t)rl * ldc + cl0;
#pragma unroll
                    for (int bj = 0; bj < 2; ++bj) { const f32x4 v0 = acc[ai][bj][m][0] * cs[bj][0], v1 = acc[ai][bj][m][1] * cs[bj][1];
                        u32x4 w; w.x = pk2(v0[0], v0[1]); w.y = pk2(v0[2], v0[3]); w.z = pk2(v1[0], v1[1]); w.w = pk2(v1[2], v1[3]);
                        *(u32x4*)(rowp + bj * HALF) = w; }
                }
        } else if (u.kind == K_AB) {
            if (wc == 0 && fq == 0) {
                float* base = (float*)(ws + WS_AB) + (size_t)u.pm * 256 * 8;
#pragma unroll
                for (int ai = 0; ai < 2; ++ai)
#pragma unroll
                    for (int m = 0; m < 4; ++m) {
                        const int rl = rl0 + ai * HALF + m * 16;
                        const float sc = SSROW(u.pm, rl);
                        float* rowp = base + (size_t)rl * 8;
                        *(f32x4*)(rowp) = acc[ai][0][m][0] * sc; *(f32x4*)(rowp + 4) = acc[ai][0][m][1] * sc;
                    }
            }
        } else if (u.kind == K_GATE) {
            unsigned char* base = scratch_tile(u.pm, u.pn, u.sub & 16);
            const float* bias = b_gate + (size_t)u.l * 4096 + (u.sub & 3) * 1024 + u.pn * 256;
            f32x4 bv[2][2];
#pragma unroll
            for (int bj = 0; bj < 2; ++bj)
#pragma unroll
#if SS_PREFETCH
                for (int n = 0; n < 2; ++n) bv[bj][n] = *(const LAS f32x4*)(bil + cl0 + bj * HALF + 4 * n) * -1.4426950408889634f;
#else
                for (int n = 0; n < 2; ++n) bv[bj][n] = *(const f32x4*)(bias + cl0 + bj * HALF + 4 * n) * -1.4426950408889634f;
#endif
            float scq[2][4];
#pragma unroll
            for (int ai = 0; ai < 2; ++ai)
#pragma unroll
                for (int m = 0; m < 4; ++m) scq[ai][m] = SSROW(u.pm, rl0 + ai * HALF + m * 16) * -1.4426950408889634f;
#pragma unroll
            for (int ai = 0; ai < 2; ++ai)
#pragma unroll
                for (int m = 0; m < 4; ++m) {
                    const int rl = rl0 + ai * HALF + m * 16;
                    const float sc = scq[ai][m];
                    unsigned char* rowp = base + (size_t)rl * SCRLD + cl0;
#pragma unroll
                    for (int bj = 0; bj < 2; ++bj) { const f32x4 v0 = acc[ai][bj][m][0] * sc + bv[bj][0], v1 = acc[ai][bj][m][1] * sc + bv[bj][1];
                        unsigned pa = 0u, pb = 0u;
#define G255(x) __builtin_amdgcn_rcpf(__builtin_amdgcn_exp2f(x) * (1.0f / 255.0f) + (1.0f / 255.0f))
                        pa = __builtin_amdgcn_cvt_pk_u8_f32(G255(v0[0]), 0, pa); pa = __builtin_amdgcn_cvt_pk_u8_f32(G255(v0[1]), 1, pa);
                        pa = __builtin_amdgcn_cvt_pk_u8_f32(G255(v0[2]), 2, pa); pa = __builtin_amdgcn_cvt_pk_u8_f32(G255(v0[3]), 3, pa);
                        pb = __builtin_amdgcn_cvt_pk_u8_f32(G255(v1[0]), 0, pb); pb = __builtin_amdgcn_cvt_pk_u8_f32(G255(v1[1]), 1, pb);
                        pb = __builtin_amdgcn_cvt_pk_u8_f32(G255(v1[2]), 2, pb); pb = __builtin_amdgcn_cvt_pk_u8_f32(G255(v1[3]), 3, pb);
#undef G255
                        EPI_ST((u32x2*)(base + scratch_off(ai, m, bj, so0)), ((u32x2){pa, pb})); }
                }
        } else if (u.kind == K_BRANCH) {
            bf16_t* base = (bf16_t*)(ws + WS_MRG) + (size_t)u.pm * 256 * MRGLD + u.pn * 256; const unsigned char* gbase = scratch_tile(u.pm, u.pn, u.sub & 16);
            const bool first = (u.sub & 4) != 0, lastb = (u.sub & 8) != 0;
            unsigned char* pbase = mrgp + ((size_t)u.pm * 4 + u.pn) * 131072;
#ifdef BR_ALL_IN_FLIGHT
            u32x2 gq2[2][4][2]; u32x4 tq[2][4][2];
#pragma unroll
            for (int ai = 0; ai < 2; ++ai)
#pragma unroll
                for (int m = 0; m < 4; ++m) { const int rl = rl0 + ai * HALF + m * 16;
#pragma unroll
                    for (int bj = 0; bj < 2; ++bj) { gq2[ai][m][bj] = EPI_LD((const u32x2*)(gbase + scratch_off(ai, m, bj, so0)));
                        tq[ai][m][bj] = first ? (u32x4){0u, 0u, 0u, 0u} : EPI_LD((const u32x4*)(base + (size_t)rl * MRGLD + cl0 + bj * HALF)); } }
#pragma unroll
            for (int ai = 0; ai < 2; ++ai) {
#pragma unroll
                for (int m = 0; m < 4; ++m) { const int rl = rl0 + ai * HALF + m * 16;
#pragma unroll
                    for (int bj = 0; bj < 2; ++bj) {
                        const u32x4 t = tq[ai][m][bj]; const f32x4 v0 = acc[ai][bj][m][0], v1 = acc[ai][bj][m][1]; const unsigned ga = gq2[ai][m][bj].x, gb = gq2[ai][m][bj].y;
                        u32x4 w;
                        w.x = pk2(bflo(t.x) + (float)(ga & 0xffu) * v0[0], bfhi(t.x) + (float)((ga >> 8) & 0xffu) * v0[1]);
                        w.y = pk2(bflo(t.y) + (float)((ga >> 16) & 0xffu) * v0[2], bfhi(t.y) + (float)(ga >> 24) * v0[3]);
                        w.z = pk2(bflo(t.z) + (float)(gb & 0xffu) * v1[0], bfhi(t.z) + (float)((gb >> 8) & 0xffu) * v1[1]);
                        w.w = pk2(bflo(t.w) + (float)((gb >> 16) & 0xffu) * v1[2], bfhi(t.w) + (float)(gb >> 24) * v1[3]);
                        EPI_ST((u32x4*)(base + (size_t)rl * MRGLD + cl0 + bj * HALF), w); } }
                asm volatile("" ::: "memory");
            }
#else
#pragma unroll
            for (int ai = 0; ai < 2; ++ai) {
                u32x2 gq2[4][2]; u32x4 tq[4][2];
#pragma unroll
                for (int m = 0; m < 4; ++m) { const int rl = rl0 + ai * HALF + m * 16;
#pragma unroll
                    for (int bj = 0; bj < 2; ++bj) { gq2[m][bj] = EPI_LD((const u32x2*)(gbase + scratch_off(ai, m, bj, so0))); (void)rl;
                        tq[m][bj] = first ? (u32x4){0u, 0u, 0u, 0u} : EPI_LD((const u32x4*)(pbase + 2 * scratch_off(ai, m, bj, so0))); } }
#pragma unroll
                for (int m = 0; m < 4; ++m) { const int rl = rl0 + ai * HALF + m * 16;
#pragma unroll
                    for (int bj = 0; bj < 2; ++bj) {
                        const u32x4 t = tq[m][bj]; const f32x4 v0 = acc[ai][bj][m][0], v1 = acc[ai][bj][m][1]; const unsigned ga = gq2[m][bj].x, gb = gq2[m][bj].y;
                        u32x4 w;
                        w.x = pk2(bflo(t.x) + (float)(ga & 0xffu) * v0[0], bfhi(t.x) + (float)((ga >> 8) & 0xffu) * v0[1]);
                        w.y = pk2(bflo(t.y) + (float)((ga >> 16) & 0xffu) * v0[2], bfhi(t.y) + (float)(ga >> 24) * v0[3]);
                        w.z = pk2(bflo(t.z) + (float)(gb & 0xffu) * v1[0], bfhi(t.z) + (float)((gb >> 8) & 0xffu) * v1[1]);
                        w.w = pk2(bflo(t.w) + (float)((gb >> 16) & 0xffu) * v1[2], bfhi(t.w) + (float)(gb >> 24) * v1[3]);
                        if (lastb) EPI_ST((u32x4*)(base + (size_t)rl * MRGLD + cl0 + bj * HALF), w);
                        else EPI_ST((u32x4*)(pbase + 2 * scratch_off(ai, m, bj, so0)), w); } }
                asm volatile("" ::: "memory");
            }
#endif
        } else {
            bf16_t* base = (bf16_t*)(ws + WS_XN) + (size_t)u.pm * 256 * 1024 + u.pn * 256;
            const bool wxn = gnext != nullptr, fin = gfinal != nullptr;
            f32x4 gv[2][2];
#pragma unroll
            for (int bj = 0; bj < 2; ++bj)
#pragma unroll
                for (int n = 0; n < 2; ++n) gv[bj][n] = fin ? *(const f32x4*)(gfinal + u.pn * BM + cl0 + bj * HALF + 4 * n) : (f32x4){0.f, 0.f, 0.f, 0.f};
#pragma unroll
            for (int ah = 0; ah < 4; ++ah) {
                const int ai = ah >> 1, m0 = (ah & 1) * 2;
                f32x4 xq[2][2][2];
#pragma unroll
                for (int mm = 0; mm < 2; ++mm) { const size_t goff = (size_t)(u.pm * BM + rl0 + ai * HALF + (m0 + mm) * 16) * D + u.pn * BM + cl0;
#pragma unroll
                    for (int bj = 0; bj < 2; ++bj) {
                        const u32x4 t = *(const u32x4*)(base + (size_t)(rl0 + ai * HALF + (m0 + mm) * 16) * 1024 + cl0 + bj * HALF); (void)goff;
                        xq[mm][bj][0] = (f32x4){bflo(t.x), bfhi(t.x), bflo(t.y), bfhi(t.y)}; xq[mm][bj][1] = (f32x4){bflo(t.z), bfhi(t.z), bflo(t.w), bfhi(t.w)}; } }
#pragma unroll
                for (int mm = 0; mm < 2; ++mm) {
                    const int m = m0 + mm, rl = rl0 + ai * HALF + m * 16;
                    const size_t goff = (size_t)(u.pm * BM + rl) * D + u.pn * BM + cl0;
                    float sq = 0.f;
#pragma unroll
                    for (int bj = 0; bj < 2; ++bj) {
                        const f32x4 v0 = acc[ai][bj][m][0] + xq[mm][bj][0], v1 = acc[ai][bj][m][1] + xq[mm][bj][1];
                        acc[ai][bj][m][0] = v0; acc[ai][bj][m][1] = v1;
                        if (wout32) { *(f32x4*)(xout + goff + bj * HALF) = v0; *(f32x4*)(xout + goff + bj * HALF + 4) = v1; }
                        sq += (v0[0] * v0[0] + v0[1] * v0[1]) + (v0[2] * v0[2] + v0[3] * v0[3]) + (v1[0] * v1[0] + v1[1] * v1[1]) + (v1[2] * v1[2] + v1[3] * v1[3]);
                        if (wxn) { const f32x4 a = v0, b = v1;
                            u32x4 w; w.x = pk2(a[0], a[1]); w.y = pk2(a[2], a[3]); w.z = pk2(b[0], b[1]); w.w = pk2(b[2], b[3]);
                            *(u32x4*)(base + (size_t)rl * 1024 + cl0 + bj * HALF) = w; }
                    }
                    sq += shx(sq, 16, lane); sq += shx(sq, 32, lane);
                    if (fq == 0) spare[rl * 4 + wc] = sq;
                }
                asm volatile("" ::: "memory");
            }
            LDS_WAIT(); __builtin_amdgcn_s_barrier(); asm volatile("" ::: "memory");
            const int t_ = wr * 256 + wc * 64 + lane;
            unsigned* ssw = (unsigned*)(ws + WS_SS);
            if (t_ < 256) { const int rl = t_; const f32x4 p = *(const LAS f32x4*)(spare + rl * 4); const float tot = (p.x + p.y) + (p.z + p.w);
                if (fin) __hip_atomic_store(ssw + (size_t)(u.pm * BM + rl) * 4 + u.pn, __builtin_bit_cast(unsigned, tot), __ATOMIC_RELAXED, __HIP_MEMORY_SCOPE_AGENT);
                else ((float*)ssw)[(size_t)(u.pm * BM + rl) * 4 + u.pn] = tot; }
            if (fin) {
                unsigned* cnt = (unsigned*)(ws + WS_CTL) + CW_PANEL + 64 * u.pm;
                asm volatile("s_waitcnt vmcnt(0)" ::: "memory");
                __builtin_amdgcn_s_barrier(); asm volatile("" ::: "memory");
                if (t_ == 0) {
                    __hip_atomic_fetch_add(cnt, 1u, __ATOMIC_RELAXED, __HIP_MEMORY_SCOPE_AGENT);
                    unsigned sp_ = 0;
                    while (__hip_atomic_load(cnt, __ATOMIC_RELAXED, __HIP_MEMORY_SCOPE_AGENT) < 4u) { __builtin_amdgcn_s_sleep(1); if (++sp_ > (1u << 22)) break; }
                }
                __builtin_amdgcn_s_barrier(); asm volatile("" ::: "memory");
#pragma unroll
                for (int ai = 0; ai < 2; ++ai)
#pragma unroll
                    for (int m = 0; m < 4; ++m) {
                        const int rl = rl0 + ai * HALF + m * 16; const unsigned* sp4 = ssw + (size_t)(u.pm * BM + rl) * 4;
                        const float p0 = __builtin_bit_cast(float, __hip_atomic_load(sp4 + 0, __ATOMIC_RELAXED, __HIP_MEMORY_SCOPE_AGENT)), p1 = __builtin_bit_cast(float, __hip_atomic_load(sp4 + 1, __ATOMIC_RELAXED, __HIP_MEMORY_SCOPE_AGENT));
                        const float p2 = __builtin_bit_cast(float, __hip_atomic_load(sp4 + 2, __ATOMIC_RELAXED, __HIP_MEMORY_SCOPE_AGENT)), p3 = __builtin_bit_cast(float, __hip_atomic_load(sp4 + 3, __ATOMIC_RELAXED, __HIP_MEMORY_SCOPE_AGENT));
                        const float rs = rsqrtf(((p0 + p1) + (p2 + p3)) * (1.0f / 1024.0f) + EPS);
                        const size_t goff = (size_t)(u.pm * BM + rl) * D + u.pn * BM + cl0;
#pragma unroll
                        for (int bj = 0; bj < 2; ++bj) { __builtin_nontemporal_store(acc[ai][bj][m][0] * rs * gv[bj][0], (f32x4*)(xout + goff + bj * HALF)); __builtin_nontemporal_store(acc[ai][bj][m][1] * rs * gv[bj][1], (f32x4*)(xout + goff + bj * HALF + 4)); }
                    }
            }
        }
    }
};
}

struct Args {
    const float* x; const float* mem; const int* positions; const float* norm_g; const float* mem_norm_g; const float* w_in; const float* b_gate;
    const float* dn_conv_w; const float* dn_a_log; const float* dn_dt_bias; const float* dn_norm_g; const float* ret_norm_g; const float* w_mem_kv;
    const float* w_br_sb; const float* w_br_dn; const float* w_br_ret; const float* w_br_mem; const float* w_out; const float* final_norm_g;
    float* out; unsigned char* ws; int ph_lo, ph_hi, li, pad;
};
struct Frame { LAS unsigned char* lds; int tid, lane, wave, G, gw, NGW; };
DI Frame mkframe(int wv) {
    extern __shared__ __attribute__((aligned(16))) unsigned char lds_raw[];
    Frame F; F.lds = (LAS unsigned char*)lds_raw; F.tid = opaque_tid(wv); F.lane = F.tid & 63; F.wave = wv;
    F.G = gridDim.x; F.gw = opaque_bid() * NWAVES + F.wave; F.NGW = F.G * NWAVES; return F;
}
typedef const __attribute__((address_space(4))) Args* ArgsP;
DI ArgsP kargs() { unsigned long long p = (unsigned long long)__builtin_amdgcn_kernarg_segment_ptr(); asm volatile("" : "+s"(p)); return (ArgsP)p; }
DI unsigned char* rst_base(ArgsP ap, int l) { return l == 0 ? (unsigned char*)ap->out : ap->ws + WS_WG + (size_t)(l - 1) * 4096 * 1024 * 2; }

struct TItem { const float* W; bf16_t* WT; const float* g; float sc; int K, Nsrc, k0, csrc, rdst, rs; };
DI void titem_load(const TItem& t, int lane, float (&v)[32]) {
#pragma unroll
    for (int i = 0; i < 32; ++i) v[i] = __builtin_nontemporal_load(t.W + (size_t)(t.k0 + 2 * i + (lane >> 5)) * t.Nsrc + t.csrc + (lane & 31));
}
DI void titem_store(LAS float* scr, int lane, const TItem& t, const float (&v)[32]) {
#pragma unroll
    for (int i = 0; i < 32; ++i) scr[(2 * i + (lane >> 5)) * 33 + (lane & 31)] = v[i];
    LDS_WAIT(); asm volatile("" ::: "memory");
    const int c = lane & 7;
    f32x4 g0 = {1.f, 1.f, 1.f, 1.f}, g1 = g0;
    if (t.g != nullptr) { g0 = *(const f32x4*)(t.g + t.k0 + 8 * c); g1 = *(const f32x4*)(t.g + t.k0 + 8 * c + 4); }
    g0 = g0 * t.sc; g1 = g1 * t.sc;
#pragma unroll
    for (int j = 0; j < 4; ++j) { const int n = (lane >> 3) + 8 * j; const LAS float* sp = scr + (8 * c) * 33 + n;
        u32x4 o; o.x = pk2(sp[0 * 33] * g0.x, sp[1 * 33] * g0.y); o.y = pk2(sp[2 * 33] * g0.z, sp[3 * 33] * g0.w); o.z = pk2(sp[4 * 33] * g1.x, sp[5 * 33] * g1.y); o.w = pk2(sp[6 * 33] * g1.z, sp[7 * 33] * g1.w);
        *(u32x4*)(t.WT + (size_t)(t.rdst + n * t.rs) * t.K + t.k0 + 8 * c) = o; }
    LDS_WAIT(); asm volatile("" ::: "memory");
}
DI void memn_rows(const Frame& F, ArgsP ap, int l) {
    unsigned char* ws = ap->ws;
    for (int m = F.gw; m < BATCH * MEMLEN; m += F.NGW) {
        const f32x4* xr = (const f32x4*)(ap->mem + (size_t)m * D) + F.lane; const f32x4* gr = (const f32x4*)(ap->mem_norm_g + (size_t)l * D) + F.lane;
        f32x4 v[4]; float sq = 0.f;
#pragma unroll
        for (int j = 0; j < 4; ++j) { v[j] = xr[64 * j]; sq += (v[j].x * v[j].x + v[j].y * v[j].y) + (v[j].z * v[j].z + v[j].w * v[j].w); }
        const float rs = rsqrtf(wave_sum(sq, F.lane) * (1.f / D) + EPS);
        unsigned long long* o8 = (unsigned long long*)((bf16_t*)(ws + WS_MEMN) + (size_t)m * D) + F.lane;
#pragma unroll
        for (int j = 0; j < 4; ++j) { const f32x4 g = gr[64 * j];
            o8[64 * j] = (unsigned long long)pk2(v[j].x * rs * g.x, v[j].y * rs * g.y) | ((unsigned long long)pk2(v[j].z * rs * g.z, v[j].w * rs * g.w) << 32); }
    }
}
struct TSeg { int src, K, Nsrc, c0, ncols, dst, r0; };
DI void convert_weights(const Frame& F, ArgsP ap, int l, int first, int stride, int part) {
    unsigned char* ws = ap->ws;
    LAS float* scr = (LAS float*)(F.lds + F.wave * 16384);
    constexpr int NSEG = 14;
    const TSeg seg[NSEG] = {
        {0, 1024, IN_COLS, 2048, 2048, 0, 0}, {0, 1024, IN_COLS, 5640, 256, 0, 2304}, {0, 1024, IN_COLS, 4104, 256, 0, 2560}, {0, 1024, IN_COLS, 4360, 256, 0, 2816},
        {0, 1024, IN_COLS, 0, 1024, 1, 0}, {0, 1024, IN_COLS, 1536, 512, 1, 1024}, {0, 1024, IN_COLS, 5128, 512, 1, 1536}, {0, 1024, IN_COLS, 1024, 512, 1, 2048}, {0, 1024, IN_COLS, 4616, 512, 1, 2560},
        {0, 1024, IN_COLS, 5896, 4096, 2, 0},
        {1, 512, 1024, 0, 1024, 3, 0}, {2, 512, 1024, 0, 1024, 3, 1024}, {3, 512, 1024, 0, 1024, 3, 2048}, {5, 1024, 1024, 0, 1024, 4, 0} };
    int cum[NSEG + 1]; cum[0] = 0;
#pragma unroll
    for (int q = 0; q < NSEG; ++q) cum[q + 1] = cum[q] + (seg[q].K / 64) * (seg[q].ncols / 32);
    const int per_layer = cum[NSEG] + (256 / 64) * (1024 / 32) + (1024 / 64) * (512 / 32);
    const int c9 = cum[9], c14m = cum[NSEG] + 128;
    const int n1 = c9 + (per_layer - c14m), n2 = c14m - c9, nit = part == 0 ? per_layer : (part == 1 ? n1 : n2);
    auto params = [&](int it, TItem& t) -> bool {
        if (it >= nit) return false;
        int r = part == 0 ? it : (part == 1 ? (it < c9 ? it : it - c9 + c14m) : it + c9);
        const float* W; int K, Nsrc, c0, ncols, r0; bf16_t* WT; bool perm = false;
        if (r < cum[NSEG]) {
            int q = 0;
#pragma unroll
            for (int qq = 1; qq < NSEG; ++qq) if (r >= cum[qq]) q = qq;
            int src = 0, dst = 0; K = 1024; Nsrc = IN_COLS; c0 = 0; ncols = 32; r0 = 0; int base = 0;
#pragma unroll
            for (int qq = 0; qq < NSEG; ++qq) if (q == qq) { src = seg[qq].src; K = seg[qq].K; Nsrc = seg[qq].Nsrc; c0 = seg[qq].c0; ncols = seg[qq].ncols; dst = seg[qq].dst; r0 = seg[qq].r0; base = cum[qq]; }
            r -= base; perm = (q == 2 || q == 3);
            W = src == 0 ? ap->w_in + (size_t)l * D * IN_COLS : src == 1 ? ap->w_br_sb + (size_t)l * 512 * 1024 : src == 2 ? ap->w_br_dn + (size_t)l * 512 * 1024 : src == 3 ? ap->w_br_ret + (size_t)l * 512 * 1024 : ap->w_out + (size_t)l * 1024 * 1024;
            WT = dst == 0 ? (bf16_t*)(ws + WS_WINA) + (size_t)l * 3072 * 1024 : dst == 1 ? (bf16_t*)(ws + WS_WINB) + (size_t)l * 3072 * 1024 : dst == 2 ? (bf16_t*)(ws + WS_WG) + (size_t)l * 4096 * 1024
               : dst == 3 ? (bf16_t*)(ws + WS_WBR) + (size_t)l * 2 * 1024 * 1024 : (bf16_t*)(ws + WS_WOUT) + (size_t)l * 1024 * 1024;
            if (dst == 3) { WT += (size_t)r0 * 512; r0 = 0; }
        } else if (r < cum[NSEG] + 128) { r -= cum[NSEG]; W = ap->w_br_mem + (size_t)l * 256 * 1024; K = 256; Nsrc = 1024; c0 = 0; ncols = 1024; r0 = 0; WT = (bf16_t*)(ws + WS_WBR) + (size_t)l * 2 * 1024 * 1024 + 3 * 1024 * 512; }
        else { r -= cum[NSEG] + 128; W = ap->w_mem_kv + (size_t)l * 1024 * 512; K = 1024; Nsrc = 512; c0 = 0; ncols = 512; r0 = 0; WT = (bf16_t*)(ws + WS_WKV) + (size_t)l * 512 * 1024; }
        const int nblk = ncols / 32, kb = r / nblk, nb = r % nblk;
        t.W = W; t.WT = WT; t.g = (W == ap->w_in + (size_t)l * D * IN_COLS) ? ap->norm_g + (size_t)l * D : nullptr;
        t.sc = ((unsigned char*)WT >= ws + WS_WBR && (unsigned char*)WT < ws + WS_WOUT) ? (1.0f / 255.0f) : 1.0f;
        t.K = K; t.Nsrc = Nsrc; t.k0 = 64 * kb; t.csrc = c0 + 32 * nb; t.rdst = perm ? r0 + (nb >> 1) * 64 + (nb & 1) : r0 + 32 * nb; t.rs = perm ? 2 : 1;
        return true;
    };
    {
        TItem ta, tb; float va[32], vb[32];
        int it = first;
        bool ha = params(it, ta); if (ha) titem_load(ta, F.lane, va);
        while (ha) {
            it += stride; const bool hb = params(it, tb); if (hb) titem_load(tb, F.lane, vb);
            titem_store(scr, F.lane, ta, va);
            if (!hb) break;
            it += stride; ha = params(it, ta); if (ha) titem_load(ta, F.lane, va);
            titem_store(scr, F.lane, tb, vb);
        }
    }
    if (part != 2) {
        const float* win = ap->w_in + (size_t)l * D * IN_COLS; bf16_t* wa = (bf16_t*)(ws + WS_WINA) + (size_t)l * 3072 * 1024;
        for (int i = first * 64 + F.lane; i < 256 * 1024; i += stride * 64) { const int r = i >> 10, k = i & 1023;
            wa[(size_t)(2048 + r) * 1024 + k] = r < 8 ? (bf16_t)f2bf(win[(size_t)k * IN_COLS + 4096 + r] * ap->norm_g[(size_t)l * D + k]) : (bf16_t)0; }
    }
}
DI void p0_prologue(int wv) {
    const Frame F = mkframe(wv);
    const ArgsP ap = kargs();
    unsigned char* ws = ap->ws;
#ifdef PROBE_PRO
    unsigned long long tq0_ = __builtin_amdgcn_s_memrealtime();
#define PRO_ECHO(k) do { asm volatile("s_waitcnt vmcnt(0)" ::: "memory"); const unsigned long long t1_ = __builtin_amdgcn_s_memrealtime(); if (PROBE_PRO == (k)) { const unsigned long long d_ = t1_ - tq0_; while (__builtin_amdgcn_s_memrealtime() - t1_ < d_) __builtin_amdgcn_s_sleep(2); } tq0_ = __builtin_amdgcn_s_memrealtime(); } while (0)
#else
#define PRO_ECHO(k) do { } while (0)
#endif
    convert_weights(F, ap, 0, F.gw, F.NGW, 1);
    PRO_ECHO(1);
    constexpr int XNR = 4;
    for (int m = XNR * F.gw; m < T; m += XNR * F.NGW) {
        f32x4 v[XNR][4]; const f32x4* gr = (const f32x4*)ap->norm_g + F.lane;
#pragma unroll
        for (int q = 0; q < XNR; ++q)
#pragma unroll
            for (int j = 0; j < 4; ++j) v[q][j] = __builtin_nontemporal_load((const f32x4*)(ap->x + (size_t)(m + q) * D) + F.lane + 64 * j);
#pragma unroll
        for (int q = 0; q < XNR; ++q) {
            unsigned long long* o8 = (unsigned long long*)((bf16_t*)(ws + WS_XN) + (size_t)(m + q) * D) + F.lane; float sq = 0.f;
#pragma unroll
            for (int j = 0; j < 4; ++j) { const f32x4 x = v[q][j], g = gr[64 * j]; sq += (x.x * x.x + x.y * x.y) + (x.z * x.z + x.w * x.w);
                (void)g; o8[64 * j] = (unsigned long long)pk2(x.x, x.y) | ((unsigned long long)pk2(x.z, x.w) << 32); }
            sq = wave_sum(sq, F.lane);
            if (F.lane == 0) *(f32x4*)((float*)(ws + WS_SS) + (size_t)(m + q) * 4) = (f32x4){sq, 0.f, 0.f, 0.f};
        }
    }
    PRO_ECHO(2);
    memn_rows(F, ap, 0);
    PRO_ECHO(3);
}

struct SchedP1 {
    gm::TileOrder ord; unsigned char* ws; int l, half, c; bool with_kvm;
    DI void a_ready(const gm::Unit&, int, int) const {}
    DI bool next(int i, gm::Unit& u) const {
        int pm, pn;
        if (ord.tile(i, pm, pn)) {
            const bf16_t* xn = (const bf16_t*)(ws + WS_XN) + (size_t)pm * 256 * 1024;
            const bf16_t* w = (const bf16_t*)(ws + (half == 0 ? WS_WINA : WS_WINB)) + ((size_t)l * 3072 + pn * 256) * 1024;
            u.lda = 1024; u.K = 1024; u.ldb = 1024; u.l = l; u.sub = half;
            if (half == 1 && pn >= 8) { u.A = w; u.B = xn; u.pm = pn - 8; u.pn = pm; u.kind = gm::K_STORE_T; u.sub = 0; }
            else { u.A = xn; u.B = w; u.pm = pm; u.pn = pn; u.kind = (half == 0 && pn == 8) ? gm::K_AB : gm::K_STORE; }
            return true;
        }
        const int kc = ord.c - (ord.nwg % ord.G);
        if (with_kvm && kc >= 0 && kc < 16 && i == (ord.nwg + ord.G - 1 - ord.c) / ord.G) {
            const int ll = l, ty = (kc >> 3) & 1, idx = kc & 7;
            const bf16_t* mn = (const bf16_t*)(ws + WS_MEMN) + (size_t)(idx * 256) * 1024;
            const bf16_t* w = (const bf16_t*)(ws + WS_WKV) + ((size_t)ll * 512 + ty * 256) * 1024;
            u.lda = 1024; u.K = 1024; u.ldb = 1024; u.l = ll;
            if (ty == 0) { u.A = mn; u.B = w; u.pm = idx; u.pn = 0; u.kind = gm::K_STORE; u.sub = 2; }
            else { u.A = w; u.B = mn; u.pm = 0; u.pn = idx; u.kind = gm::K_STORE_T; u.sub = 1; }
            return true;
        }
        return false;
    }
};
struct SchedP3 {
    int mode = 0, pm2 = 0, pn2 = 0, rot2 = 0; bool ok2 = false;
    int pm, pn, l, rot; bool ok; unsigned char* ws;
    DI void a_ready(const gm::Unit& u, int wid, int lane) const {
        if (u.kind != gm::K_BRANCH || (u.sub & 4) == 0) return;
        if (wid == 0) {
            if (lane == 0) { unsigned* cnt = (unsigned*)(ws + WS_CTL) + CW_READY + 4096 * l + 64 * pm; unsigned sp = 0u;
                while (__hip_atomic_load(cnt, __ATOMIC_RELAXED, __HIP_MEMORY_SCOPE_AGENT) < 16u) { __builtin_amdgcn_s_sleep(2); if (++sp > (1u << 20)) break; } }
            __builtin_amdgcn_fence(__ATOMIC_ACQUIRE, "agent");
            asm volatile("s_waitcnt vmcnt(0)" ::: "memory");
        }
        asm volatile("" ::: "memory"); __builtin_amdgcn_s_barrier(); asm volatile("" ::: "memory");
    }
    DI bool next(int i, gm::Unit& u) const {
        if (mode == 1) {
            if (i > 1 || (i == 1 && !ok2)) return false;
            const int tpm = i == 0 ? pm : pm2, tpn = i == 0 ? pn : pn2, br1 = (i == 0 ? rot : rot2) & 3;
            u.pm = tpm; u.pn = tpn; u.sub = br1 | 4 | 16; u.l = l; u.kind = gm::K_GATE;
            u.A = (const bf16_t*)(ws + WS_XN) + (size_t)tpm * 256 * 1024; u.lda = 1024; u.K = 1024; u.ldb = 1024;
            u.B = (const bf16_t*)(ws + WS_WG) + ((size_t)l * 4096 + br1 * 1024 + tpn * 256) * 1024;
            return true;
        }
        int slot = i >> 1, isb = i & 1;
        if (mode == 2) { if (i >= 7) return false; slot = (0x3322101 >> (4 * i)) & 15; isb = (0x56 >> i) & 1; }
        if (!ok || i >= 8) return false;
        const int br = (slot + rot) & 3;
        const bf16_t* R = (const bf16_t*)(ws + WS_R); const bf16_t* P = (const bf16_t*)(ws + WS_P);
        u.pm = pm; u.pn = pn; u.sub = br | (slot == 0 ? 4 : 0) | (slot == 3 ? 8 : 0) | ((mode == 2 && slot == 0) ? 16 : 0); u.l = l;
        if (isb == 0) {
            u.A = (const bf16_t*)(ws + WS_XN) + (size_t)pm * 256 * 1024; u.lda = 1024; u.K = 1024; u.ldb = 1024;
            u.B = (const bf16_t*)(ws + WS_WG) + ((size_t)l * 4096 + br * 1024 + pn * 256) * 1024;
            u.kind = gm::K_GATE;
        } else {
            const bf16_t* wbr = (const bf16_t*)(ws + WS_WBR) + (size_t)l * 2 * 1024 * 1024 + (size_t)br * 1024 * 512;
            const int K = br == 3 ? 256 : 512;
            const int acol = br == 0 ? RB_SBQ : (br == 1 ? P_DNZ : (br == 2 ? RB_RTZ : P_MEMQ));
            const bool inP = (br & 1) != 0;
            u.lda = inP ? PLD : RBLD; u.A = (inP ? P : R) + (size_t)pm * 256 * u.lda + acol; u.K = K; u.ldb = K; u.B = wbr + (size_t)pn * 256 * K;
            u.kind = gm::K_BRANCH;
        }
        return true;
    }
};
struct SchedP4 {
    int pm, pn, l; bool ok; unsigned char* ws;
    DI void a_ready(const gm::Unit&, int, int) const {}
    DI bool next(int i, gm::Unit& u) const {
        if (!ok || i >= 1) return false;
        u.A = (const bf16_t*)(ws + WS_MRG) + (size_t)pm * 256 * MRGLD; u.lda = MRGLD; u.K = 1024; u.ldb = 1024;
        u.B = (const bf16_t*)(ws + WS_WOUT) + ((size_t)l * 1024 + pn * 256) * 1024;
        u.pm = pm; u.pn = pn; u.kind = gm::K_OUT; u.sub = 0; u.l = l;
        return true;
    }
};

typedef float f32x16 __attribute__((ext_vector_type(16)));
typedef short s16x4 __attribute__((ext_vector_type(4)));
#define MFMA32(a, b, c) __builtin_amdgcn_mfma_f32_32x32x16_bf16((a), (b), (c), 0, 0, 0)
DI int crow(int reg, int hh) { return (reg & 3) + 8 * (reg >> 2) + 4 * hh; }
DI bf16x8 pack8(float a0, float a1, float a2, float a3, float a4, float a5, float a6, float a7) {
    u32x4 p;
    asm volatile("s_nop 0\n\tv_cvt_pk_bf16_f32 %0, %4, %5\n\tv_cvt_pk_bf16_f32 %1, %6, %7\n\tv_cvt_pk_bf16_f32 %2, %8, %9\n\tv_cvt_pk_bf16_f32 %3, %10, %11\n\ts_nop 1"
                 : "=&v"(p[0]), "=&v"(p[1]), "=&v"(p[2]), "=&v"(p[3]) : "v"(a0), "v"(a1), "v"(a2), "v"(a3), "v"(a4), "v"(a5), "v"(a6), "v"(a7));
    return __builtin_bit_cast(bf16x8, p);
}
DI bf16x8 pack8m(float a0, float a1, float a2, float a3, float a4, float a5, float a6, float a7) {
    u32x4 p;
    asm volatile("s_nop 15\n\ts_nop 3\n\tv_cvt_pk_bf16_f32 %0, %4, %5\n\tv_cvt_pk_bf16_f32 %1, %6, %7\n\tv_cvt_pk_bf16_f32 %2, %8, %9\n\tv_cvt_pk_bf16_f32 %3, %10, %11\n\ts_nop 1"
                 : "=&v"(p[0]), "=&v"(p[1]), "=&v"(p[2]), "=&v"(p[3]) : "v"(a0), "v"(a1), "v"(a2), "v"(a3), "v"(a4), "v"(a5), "v"(a6), "v"(a7));
    return __builtin_bit_cast(bf16x8, p);
}
namespace at {
constexpr int KST = 144, VST = 136;
constexpr int KT_BYTES = 64 * KST;
DI bf16x8 kfrag(LAS unsigned char* kt, int row, int ks, int hh) { return *(const LAS bf16x8*)(kt + row * KST + ks * 32 + hh * 16); }
DI bf16x8 vfrag(LAS unsigned char* vt, int row, int keyoff, int hh) {
    const LAS unsigned char* pp = vt + row * VST + (keyoff + 4 * hh) * 2;
    const u32x2 lo = *(const LAS u32x2*)pp, hi = *(const LAS u32x2*)(pp + 16);
    u32x4 r; r.x = lo.x; r.y = lo.y; r.z = hi.x; r.w = hi.y; return __builtin_bit_cast(bf16x8, r);
}
}

DI void mem_unit(int wv, int l, int unit) {
    const Frame F = mkframe(wv);
    unsigned char* ws = kargs()->ws; bf16_t* P = (bf16_t*)(ws + WS_P);
    const bf16_t* KM = (const bf16_t*)(ws + WS_KVM) + (size_t)l * 1024 * 1024; const bf16_t* VTM = KM + 2048 * 256;
    const int b = unit >> 5, h = (unit >> 3) & 3, qt = unit & 7, lane = F.lane, r = lane & 31, hh = lane >> 5;
    LAS unsigned char* kt = F.lds; LAS unsigned char* vt = F.lds + 256 * at::KST;
    constexpr int VS = 520;
#pragma unroll
    for (int i = 0; i < 4; ++i) { const int id = F.tid + 512 * i, row = id >> 3, ch = id & 7;
        const u32x4 v = *(const u32x4*)(KM + (size_t)(b * 256 + row) * 256 + h * 64 + ch * 8);
        *(LAS u32x4*)(kt + row * at::KST + ch * 16) = v; }
#pragma unroll
    for (int i = 0; i < 4; ++i) { const int id = F.tid + 512 * i, row = id >> 5, ch = id & 31;
        const u32x4 v = *(const u32x4*)(VTM + (size_t)(h * 64 + row) * 2048 + b * 256 + ch * 8);
        *(LAS u32x2*)(vt + row * VS + ch * 16) = (u32x2){v.x, v.y}; *(LAS u32x2*)(vt + row * VS + ch * 16 + 8) = (u32x2){v.z, v.w}; }
    const int t = b * SEQ + qt * 256 + wv * 32 + r;
    bf16_t* qp = P + (size_t)t * PLD + P_MEMQ + h * 64;
    bf16x8 qf[4];
#pragma unroll
    for (int ks = 0; ks < 4; ++ks) qf[ks] = *(const bf16x8*)(qp + 16 * ks + 8 * hh);
    __syncthreads();
    f32x16 z[8];
#pragma unroll
    for (int st = 0; st < 8; ++st) {
        f32x16 a = {0.f, 0.f, 0.f, 0.f, 0.f, 0.f, 0.f, 0.f, 0.f, 0.f, 0.f, 0.f, 0.f, 0.f, 0.f, 0.f};
#pragma unroll
        for (int ks = 0; ks < 4; ++ks) a = MFMA32(at::kfrag(kt, 32 * st + r, ks, hh), qf[ks], a);
        z[st] = a;
    }
    float mx = -3.0e38f;
#pragma unroll
    for (int st = 0; st < 8; ++st)
#pragma unroll
        for (int i = 0; i < 16; ++i) mx = fmaxf(mx, z[st][i]);
    mx = fmaxf(mx, shx(mx, 32, lane));
    const float c2 = 0.125f * 1.4426950408889634f; float sum = 0.f;
#pragma unroll
    for (int st = 0; st < 8; ++st)
#pragma unroll
        for (int i = 0; i < 16; ++i) { const float e = __builtin_amdgcn_exp2f((z[st][i] - mx) * c2); z[st][i] = e; sum += e; }
    sum += shx(sum, 32, lane);
    f32x16 o0 = {0.f, 0.f, 0.f, 0.f, 0.f, 0.f, 0.f, 0.f, 0.f, 0.f, 0.f, 0.f, 0.f, 0.f, 0.f, 0.f}, o1 = o0;
#pragma unroll
    for (int st = 0; st < 8; ++st)
#pragma unroll
        for (int s2 = 0; s2 < 2; ++s2) {
            const bf16x8 pf = pack8(z[st][8 * s2], z[st][8 * s2 + 1], z[st][8 * s2 + 2], z[st][8 * s2 + 3], z[st][8 * s2 + 4], z[st][8 * s2 + 5], z[st][8 * s2 + 6], z[st][8 * s2 + 7]);
            const int keyoff = 32 * st + 16 * s2;
            { const LAS unsigned char* pp = vt + r * VS + (keyoff + 4 * hh) * 2; const u32x2 lo = *(const LAS u32x2*)pp, hi = *(const LAS u32x2*)(pp + 16);
              u32x4 q; q.x = lo.x; q.y = lo.y; q.z = hi.x; q.w = hi.y; o0 = MFMA32(__builtin_bit_cast(bf16x8, q), pf, o0); }
            { const LAS unsigned char* pp = vt + (32 + r) * VS + (keyoff + 4 * hh) * 2; const u32x2 lo = *(const LAS u32x2*)pp, hi = *(const LAS u32x2*)(pp + 16);
              u32x4 q; q.x = lo.x; q.y = lo.y; q.z = hi.x; q.w = hi.y; o1 = MFMA32(__builtin_bit_cast(bf16x8, q), pf, o1); }
        }
    const float inv = 1.f / sum;
    LAS unsigned char* ob = F.lds + 73728 + wv * (32 * at::KST);
#pragma unroll
    for (int g = 0; g < 4; ++g) {
        *(LAS u32x2*)(ob + r * at::KST + (8 * g + 4 * hh) * 2) = (u32x2){pk2(o0[4 * g] * inv, o0[4 * g + 1] * inv), pk2(o0[4 * g + 2] * inv, o0[4 * g + 3] * inv)};
        *(LAS u32x2*)(ob + r * at::KST + (32 + 8 * g + 4 * hh) * 2) = (u32x2){pk2(o1[4 * g] * inv, o1[4 * g + 1] * inv), pk2(o1[4 * g + 2] * inv, o1[4 * g + 3] * inv)};
    }
#pragma unroll
    for (int k = 0; k < 4; ++k) { const int q = k * 64 + lane, row = q >> 3, pc = q & 7;
        st16_wt(P + (size_t)(t - r + row) * PLD + P_MEMQ + h * 64 + pc * 8, *(const LAS u32x4*)(ob + row * at::KST + pc * 16)); }
    unit_done(ws, l, b * 8 + qt, F.tid);
}

DI void ret_rope_prep(int wv, int c, int n) {
    const Frame F = mkframe(wv);
    unsigned char* ws = kargs()->ws; bf16_t* P = (bf16_t*)(ws + WS_P);
    const float* rc = (const float*)(ws + WS_ROPE); const float* rsn = rc + T * 32;
    for (int it = c * NTHREADS + F.tid; it < T * 32; it += n * NTHREADS) {
        const int t = it >> 5, w = (it >> 4) & 1, h = (it >> 2) & 3, g = it & 3;
        bf16_t* pp = P + (size_t)t * PLD + (w ? P_RTK : P_RTQ) + h * 64 + g * 8;
        const u32x4 a = *(const u32x4*)pp, bq = *(const u32x4*)(pp + 32);
        const f32x4 c0 = *(const f32x4*)(rc + (size_t)t * 32 + g * 8), c1 = *(const f32x4*)(rc + (size_t)t * 32 + g * 8 + 4);
        const f32x4 s0 = *(const f32x4*)(rsn + (size_t)t * 32 + g * 8), s1 = *(const f32x4*)(rsn + (size_t)t * 32 + g * 8 + 4);
        const float sc = w ? 0.125f : 1.0f;
        float x1[8] = {bflo(a.x), bfhi(a.x), bflo(a.y), bfhi(a.y), bflo(a.z), bfhi(a.z), bflo(a.w), bfhi(a.w)};
        float x2[8] = {bflo(bq.x), bfhi(bq.x), bflo(bq.y), bfhi(bq.y), bflo(bq.z), bfhi(bq.z), bflo(bq.w), bfhi(bq.w)};
        float cc[8] = {c0.x, c0.y, c0.z, c0.w, c1.x, c1.y, c1.z, c1.w}, ss[8] = {s0.x, s0.y, s0.z, s0.w, s1.x, s1.y, s1.z, s1.w};
        float y1[8], y2[8];
#pragma unroll
        for (int j = 0; j < 8; ++j) { y1[j] = (x1[j] * cc[j] - x2[j] * ss[j]) * sc; y2[j] = (x1[j] * ss[j] + x2[j] * cc[j]) * sc; }
        *(u32x4*)pp = (u32x4){pk2(y1[0], y1[1]), pk2(y1[2], y1[3]), pk2(y1[4], y1[5]), pk2(y1[6], y1[7])};
        *(u32x4*)(pp + 32) = (u32x4){pk2(y2[0], y2[1]), pk2(y2[2], y2[3]), pk2(y2[4], y2[5]), pk2(y2[6], y2[7])};
    }
}

DI void ret_state_unit(int wv, int l, int unit) {
    const Frame F = mkframe(wv);
    unsigned char* ws = kargs()->ws; const bf16_t* P = (const bf16_t*)(ws + WS_P);
    const int bh = unit / 7, c = unit - 7 * bh, b = bh >> 2, h = bh & 3, lane = F.lane, r = lane & 31, hh = lane >> 5;
    const int s0 = b * SEQ + c * 256;
    const bf16_t* VTg = (const bf16_t*)(ws + WS_VTRT) + (size_t)h * 128 * VTLD + s0;
    const bf16_t* Kg = P + (size_t)s0 * PLD + P_RTK + h * 64;
    constexpr int RS = 528;
    LAS unsigned char* vt = F.lds; LAS unsigned char* kT = F.lds + 128 * RS;
    const float lg = log2f(1.0f - exp2f(-5.0f - (float)h));
    u32x4 vv[8], kv[4];
#pragma unroll
    for (int i = 0; i < 8; ++i) { const int id = F.tid + 512 * i, row = id >> 5, ch = id & 31; vv[i] = *(const u32x4*)(VTg + (size_t)row * VTLD + ch * 8); }
    const int key = F.tid >> 1, chb = (F.tid & 1) * 32;
#pragma unroll
    for (int i = 0; i < 4; ++i) kv[i] = *(const u32x4*)(Kg + (size_t)key * PLD + chb + 8 * i);
#pragma unroll
    for (int i = 0; i < 8; ++i) { const int id = F.tid + 512 * i, row = id >> 5, ch = id & 31; *(LAS u32x4*)(vt + row * RS + ch * 16) = vv[i]; }
    const float fk = exp2f(lg * (float)(255 - key));
#pragma unroll
    for (int i = 0; i < 4; ++i) {
        const unsigned w4[4] = {kv[i].x, kv[i].y, kv[i].z, kv[i].w};
#pragma unroll
        for (int j = 0; j < 4; ++j) { const unsigned u2 = pk2(bflo(w4[j]) * fk, bfhi(w4[j]) * fk);
            LAS unsigned char* wp = kT + (chb + 8 * i + 2 * j) * RS + key * 2;
            *(LAS unsigned short*)wp = (unsigned short)u2; *(LAS unsigned short*)(wp + RS) = (unsigned short)(u2 >> 16); }
    }
    __syncthreads();
    const int d = wv & 3, e = wv >> 2;
    f32x16 acc = {0.f, 0.f, 0.f, 0.f, 0.f, 0.f, 0.f, 0.f, 0.f, 0.f, 0.f, 0.f, 0.f, 0.f, 0.f, 0.f};
#pragma unroll
    for (int sk = 0; sk < 16; ++sk)
        acc = MFMA32(*(const LAS bf16x8*)(vt + (32 * d + r) * RS + (16 * sk + 8 * hh) * 2), *(const LAS bf16x8*)(kT + (32 * e + r) * RS + (16 * sk + 8 * hh) * 2), acc);
    unsigned* Lp = (unsigned*)rst_base(kargs(), l) + (size_t)unit * 8192 + 32 * e + r;
    __builtin_amdgcn_sched_barrier(0); asm volatile("s_nop 15\n\ts_nop 3" ::: "memory"); __builtin_amdgcn_sched_barrier(0);
#pragma unroll
    for (int i = 0; i < 16; ++i) { unsigned* sp_ = Lp + (size_t)(32 * d + crow(i, hh)) * 64; const float av_ = acc[i];
        asm volatile("global_store_dword %0, %1, off sc1" :: "v"(sp_), "v"(av_) : "memory"); }
    VM_WAIT(); lds_barrier();
    if (F.tid == 0) (void)__hip_atomic_fetch_add((unsigned*)(ws + WS_CTL) + CW_RST + 2048 * l + 64 * bh, 1u, __ATOMIC_RELAXED, __HIP_MEMORY_SCOPE_AGENT);
}

template <int MODE>
DI void attn_unit(int wv, int l, int unit) {
    constexpr int DV = MODE == 0 ? 64 : 128, NDT = DV / 32, VST2 = 144, VT_BYTES = DV * VST2, BUF = at::KT_BYTES + VT_BYTES;
    const Frame F = mkframe(wv);
    const ArgsP ap = kargs();
    unsigned char* ws = ap->ws; bf16_t* R = (bf16_t*)(ws + WS_R); bf16_t* P = (bf16_t*)(ws + WS_P);
    const int lane = F.lane, r = lane & 31, hh = lane >> 5, kap = 16 * ((r >> 2) & 1) + (r & 3) + 4 * (r >> 3);
    int b, h, qt;
    if (MODE == 0) { b = unit >> 6; h = (unit >> 3) & 7; qt = unit & 7; } else { qt = unit >> 5; b = (unit >> 2) & 7; h = unit & 3; }
    const int q0 = qt * 256, qw0 = q0 + 32 * wv, tq = qw0 + r, t = b * SEQ + tq;
    const bf16_t* Kg = MODE == 0 ? R + RB_SBK + h * 64 : P + P_RTK + h * 64; const int kld = MODE == 0 ? RBLD : PLD;
    const bf16_t* VTg = (const bf16_t*)(ws + (MODE == 0 ? WS_VTSB : WS_VTRT)) + (size_t)h * DV * VTLD + b * SEQ;
    const bf16_t* qp = MODE == 0 ? R + (size_t)t * RBLD + RB_SBQ + h * 64 : P + (size_t)t * PLD + P_RTQ + h * 64;
    bf16x8 qf[4];
#pragma unroll
    for (int ks = 0; ks < 4; ++ks) qf[ks] = *(const bf16x8*)(qp + 16 * ks + 8 * hh);
    f32x16 o[NDT];
#pragma unroll
    for (int d = 0; d < NDT; ++d) o[d] = (f32x16){0.f, 0.f, 0.f, 0.f, 0.f, 0.f, 0.f, 0.f, 0.f, 0.f, 0.f, 0.f, 0.f, 0.f, 0.f, 0.f};
    volatile LAS unsigned* flags = (volatile LAS unsigned*)(F.lds + 2 * BUF);
    const int jtop = (q0 + 255) >> 6;
    const int srow = F.tid >> 3, sch = F.tid & 7;
    u32x4 kregA, vregA[NDT / 2], kregB, vregB[NDT / 2];
#define AT_LOAD(kr_, vr_, j) do { const int key0_ = (j) * 64; kr_ = __builtin_nontemporal_load((const u32x4*)(Kg + (size_t)(b * SEQ + key0_ + srow) * kld + sch * 8)); \
        _Pragma("unroll") for (int i_ = 0; i_ < NDT / 2; ++i_) vr_[i_] = __builtin_nontemporal_load((const u32x4*)(VTg + (size_t)(srow + 64 * i_) * VTLD + key0_ + sch * 8)); } while (0)
#define AT_WRITE(kr_, vr_, pbuf) do { LAS unsigned char* kb_ = F.lds + (pbuf) * BUF; *(LAS u32x4*)(kb_ + srow * at::KST + sch * 16) = kr_; \
        _Pragma("unroll") for (int i_ = 0; i_ < NDT / 2; ++i_) *(LAS u32x4*)(kb_ + at::KT_BYTES + (srow + 64 * i_) * VST2 + sch * 16) = vr_[i_]; } while (0)
    AT_LOAD(kregA, vregA, jtop); AT_WRITE(kregA, vregA, 0);
    if (jtop > (MODE == 1 ? (q0 >> 6) : 0)) AT_LOAD(kregB, vregB, jtop - 1);
    lds_barrier();
    float carry = MODE == 0 ? 1.f : 0.f; bool done_w = false;
    const float c2 = 0.125f * 1.4426950408889634f;
    const float lg = MODE == 1 ? log2f(1.0f - exp2f(-5.0f - (float)h)) : 0.f;
    float bfac[16];
#pragma unroll
    for (int i = 0; i < 16; ++i) bfac[i] = MODE == 1 ? exp2f(-lg * (float)i) : 0.f;
    const int jlo = MODE == 1 ? (q0 >> 6) : 0;
    if (MODE == 1 && qt > 0) {
        unsigned* cnt = (unsigned*)(ws + WS_CTL) + CW_RST + 2048 * l + 64 * (b * 4 + h);
        if (wv == 0) {
            if (lane == 0) { unsigned sp = 0u; while (__hip_atomic_load(cnt, __ATOMIC_RELAXED, __HIP_MEMORY_SCOPE_AGENT) < 7u) { __builtin_amdgcn_s_sleep(2); if (++sp > (1u << 20)) break; } }
            __builtin_amdgcn_fence(__ATOMIC_ACQUIRE, "agent");
            asm volatile("s_waitcnt vmcnt(0)" ::: "memory");
        }
        lds_barrier();
        const float* L0 = (const float*)rst_base(ap, l) + (size_t)((b * 4 + h) * 7) * 8192;
        const float g256 = exp2f(lg * 256.0f);
        LAS unsigned char* stI = F.lds + 65536;
        {
            f32x4 av[4]; float wg = 1.0f;
#pragma unroll
            for (int k4 = 0; k4 < 4; ++k4) av[k4] = (f32x4){0.f, 0.f, 0.f, 0.f};
            for (int c = qt - 1; c >= 0; c -= 2) {
                const bool two = (c >= 1);
                f32x4 x0[4], x1[4];
#pragma unroll
                for (int k4 = 0; k4 < 4; ++k4) x0[k4] = *(const f32x4*)(L0 + (size_t)c * 8192 + (F.tid + 512 * k4) * 4);
#pragma unroll
                for (int k4 = 0; k4 < 4; ++k4) x1[k4] = two ? *(const f32x4*)(L0 + (size_t)(c - 1) * 8192 + (F.tid + 512 * k4) * 4) : (f32x4){0.f, 0.f, 0.f, 0.f};
                const float w1 = wg * g256;
#pragma unroll
                for (int k4 = 0; k4 < 4; ++k4) av[k4] += x0[k4] * wg + x1[k4] * w1;
                wg = w1 * g256;
            }
#pragma unroll
            for (int k4 = 0; k4 < 4; ++k4) { const int e4 = (F.tid + 512 * k4) * 4;
                *(LAS u32x2*)(stI + (e4 >> 6) * 144 + (e4 & 63) * 2) = (u32x2){pk2(av[k4][0], av[k4][1]), pk2(av[k4][2], av[k4][3])}; }
        }
        lds_barrier();
#pragma unroll
        for (int d = 0; d < NDT; ++d)
#pragma unroll
            for (int ks = 0; ks < 4; ++ks) o[d] = MFMA32(*(const LAS bf16x8*)(stI + (32 * d + r) * 144 + (16 * ks + 8 * hh) * 2), qf[ks], o[d]);
        const float fq = exp2f(lg * (float)(tq - q0 + 1));
#pragma unroll
        for (int d = 0; d < NDT; ++d) o[d] = o[d] * fq;
    }
    auto body = [&](const int j, const int it, u32x4& kL, u32x4 (&vL)[NDT / 2], u32x4& kW, u32x4 (&vW)[NDT / 2]) -> bool {
        const int pbuf = it & 1;
        if (j - 2 >= jlo) AT_LOAD(kL, vL, j - 2);
        LAS unsigned char* kt = F.lds + pbuf * BUF; LAS unsigned char* vt = kt + at::KT_BYTES;
        const int key0 = j * 64;
        if (!done_w) {
#pragma unroll
            for (int sti = 0; sti < 2; ++sti) {
                const int st = 1 - sti, ks0 = key0 + 32 * st;
                if (ks0 <= qw0 + 31 - (MODE == 0 ? 1 : 0)) {
                    const bool full = (ks0 + 31 < qw0);
                    f32x16 z = {0.f, 0.f, 0.f, 0.f, 0.f, 0.f, 0.f, 0.f, 0.f, 0.f, 0.f, 0.f, 0.f, 0.f, 0.f, 0.f};
#pragma unroll
                    for (int ks = 0; ks < 4; ++ks) z = MFMA32(at::kfrag(kt, 32 * st + kap, ks, hh), qf[ks], z);
                    float w[16];
                    const int kb = ks0 + 16 * hh;
                    if (MODE == 0) {
                        float sg[16], sn[16];
#pragma unroll
                        for (int i = 0; i < 16; i += 2) {
                            const f32x2 a2 = (f32x2){z[i], z[i + 1]} * (f32x2){-c2, -c2};
                            const f32x2 d2 = (f32x2){__builtin_amdgcn_exp2f(a2.x), __builtin_amdgcn_exp2f(a2.y)} + (f32x2){1.f, 1.f};
                            const f32x2 r2 = (f32x2){__builtin_amdgcn_rcpf(d2.x), __builtin_amdgcn_rcpf(d2.y)};
                            const f32x2 n2 = (f32x2){1.f, 1.f} - r2;
                            sg[i] = r2.x; sg[i + 1] = r2.y; sn[i] = n2.x; sn[i + 1] = n2.y;
                        }
                        if (!full) {
#pragma unroll
                            for (int i = 0; i < 16; ++i) { const bool m = (kb + i) < tq; sn[i] = m ? sn[i] : 1.f; sg[i] = m ? sg[i] : 0.f; }
                        }
                        float suf[16];
                        suf[15] = 1.f;
#pragma unroll
                        for (int i = 14; i >= 0; --i) suf[i] = suf[i + 1] * sn[i + 1];
                        const float tot = suf[0] * sn[0], totp = shx(tot, 32, lane);
                        const float base = carry * (hh == 0 ? totp : 1.f);
                        carry *= tot * totp;
#pragma unroll
                        for (int i = 0; i < 16; i += 2) { const f32x2 w2 = (f32x2){sg[i], sg[i + 1]} * ((f32x2){suf[i], suf[i + 1]} * (f32x2){base, base}); w[i] = w2.x; w[i + 1] = w2.y; }
                    } else {
                        const float af = __builtin_amdgcn_exp2f(lg * (float)(tq - kb));
                        if (full) {
#pragma unroll
                            for (int i = 0; i < 16; ++i) w[i] = z[i] * (af * bfac[i]);
                        } else {
#pragma unroll
                            for (int i = 0; i < 16; ++i) w[i] = (kb + i <= tq) ? z[i] * (af * bfac[i]) : 0.f;
                        }
                    }
#pragma unroll
                    for (int s2 = 0; s2 < 2; ++s2) {
                        const bf16x8 pf = pack8(w[8 * s2], w[8 * s2 + 1], w[8 * s2 + 2], w[8 * s2 + 3], w[8 * s2 + 4], w[8 * s2 + 5], w[8 * s2 + 6], w[8 * s2 + 7]);
#pragma unroll
                        for (int d = 0; d < NDT; ++d) o[d] = MFMA32(*(const LAS bf16x8*)(vt + (32 * d + r) * VST2 + (32 * st + 16 * hh + 8 * s2) * 2), pf, o[d]);
                    }
                }
            }
            if (MODE == 0) done_w = __all(carry < 1.1754944e-38f);
        }
        if (j > jlo) AT_WRITE(kW, vW, pbuf ^ 1);
        if (MODE == 0 && F.lane == 0) flags[(it & 1) * 8 + wv] = done_w ? 1u : 0u;
        lds_barrier();
        if (j == jlo) return true;
        if (MODE == 0) { unsigned all = 1u;
#pragma unroll
            for (int w8 = 0; w8 < 8; ++w8) all &= flags[(it & 1) * 8 + w8];
            if (all) return true; }
        return false;
    };
    for (int j = jtop, it = 0; ; j -= 2, it += 2) {
        if (body(j, it, kregA, vregA, kregB, vregB)) break;
        if (body(j - 1, it + 1, kregB, vregB, kregA, vregA)) break;
    }
#undef AT_LOAD
#undef AT_WRITE
    constexpr int OST = DV * 2 + 16, PPR = DV / 8;
    LAS unsigned char* ob = F.lds + wv * (32 * OST);
    if (MODE == 0) {
        bf16_t* op = R + (size_t)t * RBLD + RB_SBQ + h * 64; const bf16_t* zp = R + (size_t)t * RBLD + RB_SBZ + h * 64;
#pragma unroll
        for (int d = 0; d < NDT; ++d)
#pragma unroll
            for (int g = 0; g < 4; ++g) { const int c = 32 * d + 8 * g + 4 * hh; const u32x2 zz = *(const u32x2*)(zp + c);
                *(LAS u32x2*)(ob + r * OST + c * 2) = (u32x2){pk2(o[d][4 * g] * siluf_(bflo(zz.x)), o[d][4 * g + 1] * siluf_(bfhi(zz.x))), pk2(o[d][4 * g + 2] * siluf_(bflo(zz.y)), o[d][4 * g + 3] * siluf_(bfhi(zz.y)))}; }
#pragma unroll
        for (int k = 0; k < 32 * PPR / 64; ++k) { const int q = k * 64 + lane, row = q / PPR, pc = q % PPR;
            st16_wt(op + (ptrdiff_t)(row - r) * RBLD + pc * 8, *(const LAS u32x4*)(ob + row * OST + pc * 16)); }
    } else {
        float s1 = 0.f;
#pragma unroll
        for (int d = 0; d < NDT; ++d)
#pragma unroll
            for (int i = 0; i < 16; ++i) s1 += o[d][i];
        s1 += shx(s1, 32, lane);
        const float mu = s1 * (1.f / 128.f); float s2 = 0.f;
#pragma unroll
        for (int d = 0; d < NDT; ++d)
#pragma unroll
            for (int i = 0; i < 16; ++i) { const float dl = o[d][i] - mu; s2 += dl * dl; }
        s2 += shx(s2, 32, lane);
        const float rs = rsqrtf(s2 * (1.f / 128.f) + EPS);
        bf16_t* zp = R + (size_t)t * RBLD + RB_RTZ + h * 128; const float* gp = ap->ret_norm_g + (size_t)l * 512 + h * 128;
#pragma unroll
        for (int d = 0; d < NDT; ++d)
#pragma unroll
            for (int g = 0; g < 4; ++g) { const int c = 32 * d + 8 * g + 4 * hh; const u32x2 zz = *(const u32x2*)(zp + c); const f32x4 gg = *(const f32x4*)(gp + c);
                *(LAS u32x2*)(ob + r * OST + c * 2) = (u32x2){pk2((o[d][4 * g] - mu) * rs * gg.x * siluf_(bflo(zz.x)), (o[d][4 * g + 1] - mu) * rs * gg.y * siluf_(bfhi(zz.x))),
                                                             pk2((o[d][4 * g + 2] - mu) * rs * gg.z * siluf_(bflo(zz.y)), (o[d][4 * g + 3] - mu) * rs * gg.w * siluf_(bfhi(zz.y)))}; }
#pragma unroll
        for (int k = 0; k < 32 * PPR / 64; ++k) { const int q = k * 64 + lane, row = q / PPR, pc = q % PPR;
            st16_wt(zp + (ptrdiff_t)(row - r) * RBLD + pc * 8, *(const LAS u32x4*)(ob + row * OST + pc * 16)); }
    }
    unit_done(ws, l, b * 8 + qt, F.tid);
}

namespace dn {
constexpr int HC_BYTES = 73728, OFF_W = 0, OFF_QG = 16384, OFF_KD = 32768, OFF_AI = 49152, OFF_U = 57344;
constexpr int QST = 272, TST = 144;
constexpr int GRP_BYTES = 71680, Q_OFF = 0, K_OFF = 17408, KT_OFF = 34816, VT_OFF = 53248, VEC_OFF = 143360, VEC_BYTES = 2048;
}

DI void dn_prep(int wv, int l, int pair) {
    const Frame F = mkframe(wv);
    const ArgsP ap = kargs();
    unsigned char* ws = ap->ws;
    const int lane = F.lane, r = lane & 31, hh = lane >> 5, grp = wv >> 2, gw = wv & 3, gt = F.tid & 255;
    const int hc = pair * 2 + grp, h = hc & 3, bn = hc >> 2, b = bn >> 5, n = bn & 31, t0 = b * SEQ + n * 64;
    LAS unsigned char* gb = F.lds + grp * dn::GRP_BYTES;
    LAS unsigned char* qimg = gb + dn::Q_OFF; LAS unsigned char* kimg = gb + dn::K_OFF; LAS unsigned char* ktimg = gb + dn::KT_OFF; LAS unsigned char* vtimg = gb + dn::VT_OFF;
    LAS float* vec = (LAS float*)(F.lds + dn::VEC_OFF + grp * dn::VEC_BYTES);
    LAS float* gcv = vec; LAS float* btv = vec + 64; LAS float* f1v = vec + 128; LAS float* f2v = vec + 192; LAS float* egv = vec + 256;
    unsigned char* blk = ws + WS_DNI + (size_t)hc * dn::HC_BYTES;
    const bf16_t* RA = (const bf16_t*)(ws + WS_R); const float* cw = ap->dn_conv_w + (size_t)l * 4 * 1536; const float* AB = (const float*)(ws + WS_AB);
#ifdef PROBE_PREP
    unsigned long long tp0_ = __builtin_amdgcn_s_memrealtime();
#endif
    {
        const int g8 = gt & 15, ch = g8 * 8;
        float abA[4], abB[4];
#pragma unroll
        for (int k = 0; k < 4; ++k) { const int t = t0 + (gt >> 4) + 16 * k; abA[k] = AB[(size_t)t * 8 + h]; abB[k] = AB[(size_t)t * 8 + 4 + h]; }
        const float dtb = ap->dn_dt_bias[l * 4 + h], nalog = -__expf(ap->dn_a_log[l * 4 + h]);
        u32x4 xs[2][2][4]; f32x4 wj[4][2];
#define DNP_LOADX(st_, set_) do { const int col_ = ((st_) >> 1) * 512 + h * 128 + ch; \
        _Pragma("unroll") for (int kk_ = 0; kk_ < 2; ++kk_) _Pragma("unroll") for (int j_ = 0; j_ < 4; ++j_) { const int m_ = (gt >> 4) + 16 * (2 * ((st_) & 1) + kk_); \
            xs[set_][kk_][j_] = (n * 64 + m_ - 3 + j_ >= 0) ? *(const u32x4*)(RA + (size_t)(t0 + m_ - 3 + j_) * RALD + col_) : (u32x4){0u, 0u, 0u, 0u}; } } while (0)
        DNP_LOADX(0, 0);
#pragma unroll
        for (int st = 0; st < 6; ++st) {
            const int part = st >> 1, col = part * 512 + h * 128 + ch;
            if ((st & 1) == 0) {
#pragma unroll
                for (int j = 0; j < 4; ++j) { wj[j][0] = *(const f32x4*)(cw + j * 1536 + col); wj[j][1] = *(const f32x4*)(cw + j * 1536 + col + 4); } }
            if (st < 5) DNP_LOADX(st + 1, (st + 1) & 1);
#pragma unroll
            for (int kk = 0; kk < 2; ++kk) {
                const int m = (gt >> 4) + 16 * (2 * (st & 1) + kk), t = t0 + m;
                float a[8] = {0.f, 0.f, 0.f, 0.f, 0.f, 0.f, 0.f, 0.f};
#pragma unroll
                for (int j = 0; j < 4; ++j) { const u32x4 x = xs[st & 1][kk][j];
                    a[0] += wj[j][0].x * bflo(x.x); a[1] += wj[j][0].y * bfhi(x.x); a[2] += wj[j][0].z * bflo(x.y); a[3] += wj[j][0].w * bfhi(x.y);
                    a[4] += wj[j][1].x * bflo(x.z); a[5] += wj[j][1].y * bfhi(x.z); a[6] += wj[j][1].z * bflo(x.w); a[7] += wj[j][1].w * bfhi(x.w);
                }
                float ssq = 0.f;
#pragma unroll
                for (int i = 0; i < 8; ++i) { a[i] = siluf_(a[i]); ssq += a[i] * a[i]; }
                if (part < 2) {
                    ssq = sum16(ssq);
                    const float rn = rsqrtf(ssq + EPS);
#pragma unroll
                    for (int i = 0; i < 8; ++i) a[i] *= rn;
                } else {
                    const float beta = sigmoidf_(abB[2 * (st & 1) + kk]);
#pragma unroll
                    for (int i = 0; i < 8; ++i) a[i] *= beta;
                }
                const u32x4 pk = (u32x4){pk2(a[0], a[1]), pk2(a[2], a[3]), pk2(a[4], a[5]), pk2(a[6], a[7])};
                if (part == 0) {
                    *(LAS u32x4*)(qimg + m * dn::QST + ch * 2) = pk;
                    if (g8 == 0) { const float xa = abA[2 * (st & 1) + kk] + dtb; const float sp = xa > 20.f ? xa : log1pf(__expf(xa));
                        gcv[m] = nalog * sp; btv[m] = sigmoidf_(abB[2 * (st & 1) + kk]); }
                } else {
                    if (part == 1) *(LAS u32x4*)(kimg + m * dn::QST + ch * 2) = pk;
                    LAS unsigned char* timg = (part == 1 ? ktimg : vtimg) + (((m >> 3) ^ (g8 & 7)) * 16) + (m & 7) * 2;
                    *(LAS unsigned short*)(timg + (ch + 0) * dn::TST) = (unsigned short)pk.x; *(LAS unsigned short*)(timg + (ch + 1) * dn::TST) = (unsigned short)(pk.x >> 16);
                    *(LAS unsigned short*)(timg + (ch + 2) * dn::TST) = (unsigned short)pk.y; *(LAS unsigned short*)(timg + (ch + 3) * dn::TST) = (unsigned short)(pk.y >> 16);
                    *(LAS unsigned short*)(timg + (ch + 4) * dn::TST) = (unsigned short)pk.z; *(LAS unsigned short*)(timg + (ch + 5) * dn::TST) = (unsigned short)(pk.z >> 16);
                    *(LAS unsigned short*)(timg + (ch + 6) * dn::TST) = (unsigned short)pk.w; *(LAS unsigned short*)(timg + (ch + 7) * dn::TST) = (unsigned short)(pk.w >> 16);
                }
            }
        }
#undef DNP_LOADX
    }
    lds_barrier();
#ifdef PROBE_PREP
    if (PROBE_PREP == 1) { const unsigned long long t1_ = __builtin_amdgcn_s_memrealtime(); const unsigned long long d_ = t1_ - tp0_; while (__builtin_amdgcn_s_memrealtime() - t1_ < d_) __builtin_amdgcn_s_sleep(2); }
    tp0_ = __builtin_amdgcn_s_memrealtime();
#endif
    if (gw == 0) {
        float gc = gcv[lane];
#pragma unroll
        for (int off = 1; off < 64; off <<= 1) { const float o = shx(gc, 0, lane - off < 0 ? lane : lane - off) ; gc += (lane >= off) ? o : 0.f; }
        const float glast = shx(gc, 0, 63);
        const float eg = __expf(gc);
        gcv[lane] = gc; f1v[lane] = btv[lane] * eg; f2v[lane] = __expf(glast - gc); egv[lane] = eg * 0.08838834764831845f;
        if (lane == 0) ((float*)(ws + WS_GB))[hc] = __expf(glast);
    }
    lds_barrier();
    f32x16 Lt = {0.f, 0.f, 0.f, 0.f, 0.f, 0.f, 0.f, 0.f, 0.f, 0.f, 0.f, 0.f, 0.f, 0.f, 0.f, 0.f};
    if (gw < 3) {
        {
            const int ct = gw == 0 ? 0 : 1, mt = gw == 2 ? 1 : 0;
            f32x16 acc = {0.f, 0.f, 0.f, 0.f, 0.f, 0.f, 0.f, 0.f, 0.f, 0.f, 0.f, 0.f, 0.f, 0.f, 0.f, 0.f};
#pragma unroll
            for (int ks = 0; ks < 8; ++ks) acc = MFMA32(*(const LAS bf16x8*)(kimg + (32 * ct + r) * dn::QST + ks * 32 + hh * 16), *(const LAS bf16x8*)(kimg + (32 * mt + r) * dn::QST + ks * 32 + hh * 16), acc);
            const int m = 32 * mt + r; const float gm = gcv[m];
#pragma unroll
            for (int i = 0; i < 16; ++i) { const int c = 32 * ct + crow(i, hh); Lt[i] = (m < c) ? acc[i] * btv[c] * __expf(gcv[c] - gm) : 0.f; }
        }
        {
            const int mt = gw == 2 ? 1 : 0, ct = gw == 0 ? 0 : 1;
            f32x16 acc = {0.f, 0.f, 0.f, 0.f, 0.f, 0.f, 0.f, 0.f, 0.f, 0.f, 0.f, 0.f, 0.f, 0.f, 0.f, 0.f};
#pragma unroll
            for (int ks = 0; ks < 8; ++ks) acc = MFMA32(*(const LAS bf16x8*)(kimg + (32 * mt + r) * dn::QST + ks * 32 + hh * 16), *(const LAS bf16x8*)(qimg + (32 * ct + r) * dn::QST + ks * 32 + hh * 16), acc);
            const int c = 32 * ct + r; const float gcc = gcv[c]; float v[16];
#pragma unroll
            for (int i = 0; i < 16; ++i) { const int m = 32 * mt + crow(i, hh); v[i] = (m <= c) ? acc[i] * __expf(gcc - gcv[m]) * 0.08838834764831845f : 0.f; }
#pragma unroll
            for (int s2 = 0; s2 < 2; ++s2) *(bf16x8*)(blk + dn::OFF_AI + ((ct * 2 + mt) * 2 + s2) * 1024 + lane * 16) = pack8(v[8 * s2], v[8 * s2 + 1], v[8 * s2 + 2], v[8 * s2 + 3], v[8 * s2 + 4], v[8 * s2 + 5], v[8 * s2 + 6], v[8 * s2 + 7]);
        }
    } else {
#pragma unroll 1
        for (int f = 0; f < 16; ++f) { const int ct = f >> 3, tau = (f >> 1) & 3, s2 = f & 1, c = 32 * ct + r; const float e = egv[c];
            const LAS unsigned char* pp = qimg + c * dn::QST + (32 * tau + 16 * s2 + 4 * hh) * 2; const u32x2 lo = *(const LAS u32x2*)pp, hi = *(const LAS u32x2*)(pp + 16);
            *(bf16x8*)(blk + dn::OFF_QG + f * 1024 + lane * 16) = pack8(bflo(lo.x) * e, bfhi(lo.x) * e, bflo(lo.y) * e, bfhi(lo.y) * e, bflo(hi.x) * e, bfhi(hi.x) * e, bflo(hi.y) * e, bfhi(hi.y) * e); }
#pragma unroll 1
        for (int f = 0; f < 16; ++f) { const int tau = f >> 2, m0 = 32 * ((f >> 1) & 1) + 16 * (f & 1) + 4 * hh;
            const int sw = (4 * tau + (r >> 3)) & 7; const LAS unsigned char* rowp = ktimg + (32 * tau + r) * dn::TST + (m0 & 7) * 2;
            const u32x2 lo = *(const LAS u32x2*)(rowp + (((m0 >> 3) ^ sw) * 16)), hi = *(const LAS u32x2*)(rowp + ((((m0 >> 3) + 1) ^ sw) * 16));
            const f32x4 fa = *(const LAS f32x4*)(f2v + m0), fb = *(const LAS f32x4*)(f2v + m0 + 8);
            *(bf16x8*)(blk + dn::OFF_KD + f * 1024 + lane * 16) = pack8(bflo(lo.x) * fa.x, bfhi(lo.x) * fa.y, bflo(lo.y) * fa.z, bfhi(lo.y) * fa.w, bflo(hi.x) * fb.x, bfhi(hi.x) * fb.y, bflo(hi.y) * fb.z, bfhi(hi.y) * fb.w); }
    }
    lds_barrier();
    LAS float* Lm = (LAS float*)qimg;
    if (gw < 3) { const int ct = gw == 0 ? 0 : 1, mt = gw == 2 ? 1 : 0;
#pragma unroll
        for (int i = 0; i < 16; ++i) Lm[(32 * ct + crow(i, hh)) * 64 + 32 * mt + r] = Lt[i]; }
    lds_barrier();
#ifdef PROBE_PREP
    if (PROBE_PREP == 2) { const unsigned long long t1_ = __builtin_amdgcn_s_memrealtime(); const unsigned long long d_ = t1_ - tp0_; while (__builtin_amdgcn_s_memrealtime() - t1_ < d_) __builtin_amdgcn_s_sleep(2); }
    tp0_ = __builtin_amdgcn_s_memrealtime();
#endif
    if (gw == 0) {
        const LAS float* Lb = Lm + (32 * hh) * 64 + 32 * hh;
        const int jc = lane & 31;
        float Tc[32];
#pragma unroll
        for (int i = 0; i < 32; ++i) {
            float a0 = (i == jc) ? 1.f : 0.f, a1 = 0.f, a2 = 0.f, a3 = 0.f;
#pragma unroll
            for (int k4 = 0; k4 < (i + 3) / 4; ++k4) { const f32x4 lv = *(const LAS f32x4*)(Lb + i * 64 + 4 * k4);
                if (4 * k4 + 0 < i) a0 -= lv.x * Tc[4 * k4 + 0]; if (4 * k4 + 1 < i) a1 -= lv.y * Tc[4 * k4 + 1];
                if (4 * k4 + 2 < i) a2 -= lv.z * Tc[4 * k4 + 2]; if (4 * k4 + 3 < i) a3 -= lv.w * Tc[4 * k4 + 3]; }
            Tc[i] = (a0 + a1) + (a2 + a3);
        }
        LDS_WAIT(); asm volatile("" ::: "memory");
        LAS unsigned char* timg = kimg; LAS unsigned char* t00t = kimg + 64 * dn::TST;
#pragma unroll
        for (int i = 0; i < 32; ++i) *(LAS unsigned short*)(timg + (32 * hh + i) * dn::TST + (32 * hh + jc) * 2) = (unsigned short)f2bf(Tc[i]);
        if (hh == 0) {
#pragma unroll
            for (int q = 0; q < 4; ++q) { *(LAS u32x4*)(t00t + jc * 80 + 16 * q) = (u32x4){pk2(Tc[8 * q], Tc[8 * q + 1]), pk2(Tc[8 * q + 2], Tc[8 * q + 3]), pk2(Tc[8 * q + 4], Tc[8 * q + 5]), pk2(Tc[8 * q + 6], Tc[8 * q + 7])};
                *(LAS u32x4*)(timg + jc * dn::TST + 64 + 16 * q) = (u32x4){0u, 0u, 0u, 0u}; }
        }
        LDS_WAIT(); asm volatile("" ::: "memory");
        f32x16 X = {0.f, 0.f, 0.f, 0.f, 0.f, 0.f, 0.f, 0.f, 0.f, 0.f, 0.f, 0.f, 0.f, 0.f, 0.f, 0.f};
#pragma unroll
        for (int s2 = 0; s2 < 2; ++s2) { const f32x4 la = *(const LAS f32x4*)(Lm + (32 + r) * 64 + 16 * s2 + 8 * hh), lb = *(const LAS f32x4*)(Lm + (32 + r) * 64 + 16 * s2 + 8 * hh + 4);
            X = MFMA32(pack8(la.x, la.y, la.z, la.w, lb.x, lb.y, lb.z, lb.w), *(const LAS bf16x8*)(t00t + r * 80 + (16 * s2 + 8 * hh) * 2), X); }
        f32x16 Y = {0.f, 0.f, 0.f, 0.f, 0.f, 0.f, 0.f, 0.f, 0.f, 0.f, 0.f, 0.f, 0.f, 0.f, 0.f, 0.f};
#pragma unroll
        for (int s2 = 0; s2 < 2; ++s2) { const LAS unsigned char* pp = timg + (32 + r) * dn::TST + (32 + 16 * s2 + 4 * hh) * 2; const u32x2 lo = *(const LAS u32x2*)pp, hi = *(const LAS u32x2*)(pp + 16);
            u32x4 af; af.x = lo.x; af.y = lo.y; af.z = hi.x; af.w = hi.y;
            Y = MFMA32(__builtin_bit_cast(bf16x8, af), pack8m(X[8 * s2], X[8 * s2 + 1], X[8 * s2 + 2], X[8 * s2 + 3], X[8 * s2 + 4], X[8 * s2 + 5], X[8 * s2 + 6], X[8 * s2 + 7]), Y); }
#pragma unroll
        for (int i = 0; i < 16; ++i) *(LAS unsigned short*)(timg + (32 + crow(i, hh)) * dn::TST + r * 2) = (unsigned short)f2bf(-Y[i]);
    }
    lds_barrier();
#ifdef PROBE_PREP
    if (PROBE_PREP == 3) { const unsigned long long t1_ = __builtin_amdgcn_s_memrealtime(); const unsigned long long d_ = t1_ - tp0_; while (__builtin_amdgcn_s_memrealtime() - t1_ < d_) __builtin_amdgcn_s_sleep(2); }
    tp0_ = __builtin_amdgcn_s_memrealtime();
#endif
    {
        LAS unsigned char* timg = kimg;
        bf16x8 afr[4];
#pragma unroll
        for (int s4 = 0; s4 < 4; ++s4) { const u32x4 x = *(const LAS u32x4*)(ktimg + (32 * gw + r) * dn::TST + (((2 * s4 + hh) ^ ((4 * gw + (r >> 3)) & 7)) * 16));
            const f32x4 fa = *(const LAS f32x4*)(f1v + 16 * s4 + 8 * hh), fb = *(const LAS f32x4*)(f1v + 16 * s4 + 8 * hh + 4);
            afr[s4] = pack8(-bflo(x.x) * fa.x, -bfhi(x.x) * fa.y, -bflo(x.y) * fa.z, -bfhi(x.y) * fa.w, -bflo(x.z) * fb.x, -bfhi(x.z) * fb.y, -bflo(x.w) * fb.z, -bfhi(x.w) * fb.w); }
#pragma unroll
        for (int ct = 0; ct < 2; ++ct) {
            f32x16 acc = {0.f, 0.f, 0.f, 0.f, 0.f, 0.f, 0.f, 0.f, 0.f, 0.f, 0.f, 0.f, 0.f, 0.f, 0.f, 0.f};
#pragma unroll
            for (int s4 = 0; s4 < 4; ++s4) acc = MFMA32(afr[s4], *(const LAS bf16x8*)(timg + (32 * ct + r) * dn::TST + s4 * 32 + hh * 16), acc);
#pragma unroll
            for (int s2 = 0; s2 < 2; ++s2) *(bf16x8*)(blk + dn::OFF_W + ((ct * 4 + gw) * 2 + s2) * 1024 + lane * 16) = pack8m(acc[8 * s2], acc[8 * s2 + 1], acc[8 * s2 + 2], acc[8 * s2 + 3], acc[8 * s2 + 4], acc[8 * s2 + 5], acc[8 * s2 + 6], acc[8 * s2 + 7]);
        }
#pragma unroll
        for (int ct = 0; ct < 2; ++ct) {
            f32x16 acc = {0.f, 0.f, 0.f, 0.f, 0.f, 0.f, 0.f, 0.f, 0.f, 0.f, 0.f, 0.f, 0.f, 0.f, 0.f, 0.f};
#pragma unroll
            for (int s4 = 0; s4 < 4; ++s4) acc = MFMA32(*(const LAS bf16x8*)(timg + (32 * ct + r) * dn::TST + s4 * 32 + hh * 16), *(const LAS bf16x8*)(vtimg + (32 * gw + r) * dn::TST + (((2 * s4 + hh) ^ ((4 * gw + (r >> 3)) & 7)) * 16)), acc);
#pragma unroll
            for (int s2 = 0; s2 < 2; ++s2) *(bf16x8*)(blk + dn::OFF_U + ((ct * 4 + gw) * 2 + s2) * 1024 + lane * 16) = pack8m(acc[8 * s2], acc[8 * s2 + 1], acc[8 * s2 + 2], acc[8 * s2 + 3], acc[8 * s2 + 4], acc[8 * s2 + 5], acc[8 * s2 + 6], acc[8 * s2 + 7]);
        }
    }
    lds_barrier();
}

DI void dn_scan(int wv, int l, int bh) {
    const Frame F = mkframe(wv);
    const ArgsP ap = kargs();
    unsigned char* ws = ap->ws; bf16_t* P = (bf16_t*)(ws + WS_P);
    const int lane = F.lane, hh = lane >> 5, b = bh >> 2, h = bh & 3, w4 = wv & 3;
    LAS float* part = (LAS float*)(F.lds + 2 * dn::HC_BYTES);
    LAS float* gnl = part + 512;
    LAS float* decs = gnl + 128;
    if (F.tid < 128) gnl[F.tid] = ap->dn_norm_g[l * 128 + F.tid];
    if (F.tid < 32) decs[F.tid] = ((const float*)(ws + WS_GB))[(size_t)(b * 32 + F.tid) * 4 + h];
    const size_t hc_stride = 4 * (size_t)dn::HC_BYTES;
    const unsigned char* blk0 = ws + WS_DNI + ((size_t)(b * 32) * 4 + h) * dn::HC_BYTES;
#define DN_PIECE(src_, pbuf, pc_) __builtin_amdgcn_global_load_lds((const unsigned*)((src_) + (pc_) * 1024 + lane * 16), (LAS unsigned*)(F.lds + (pbuf) * dn::HC_BYTES + (pc_) * 1024), 16, 0, SCAN_AUX)
#define DN_LOAD(nn, pbuf) do { const unsigned char* src_ = blk0 + (size_t)(nn) * hc_stride; \
        if (wv < 4) { _Pragma("unroll") for (int i_ = 0; i_ < 9; ++i_) DN_PIECE(src_, pbuf, wv * 9 + i_); } \
        else { _Pragma("unroll") for (int i_ = 0; i_ < 5; ++i_) DN_PIECE(src_, pbuf, 36 + 5 * w4 + i_); \
               DN_PIECE(src_, pbuf, 56 + 2 * w4); DN_PIECE(src_, pbuf, 57 + 2 * w4); DN_PIECE(src_, pbuf, 64 + 2 * w4); DN_PIECE(src_, pbuf, 65 + 2 * w4); } } while (0)
    DN_LOAD(0, 0);
    f32x16 S[4];
#pragma unroll
    for (int i = 0; i < 4; ++i) S[i] = (f32x16){0.f, 0.f, 0.f, 0.f, 0.f, 0.f, 0.f, 0.f, 0.f, 0.f, 0.f, 0.f, 0.f, 0.f, 0.f, 0.f};
    u32x4 heldO[4], zO[4];
#pragma unroll
    for (int i = 0; i < 4; ++i) { heldO[i] = (u32x4){0u, 0u, 0u, 0u}; zO[i] = heldO[i]; }
    VM_WAIT(); __syncthreads();
    if (wv < 4) {
    for (int k = 0; k < 34; ++k) {
        const int pbuf = k & 1;
#ifdef PROBE_SCANC
        const unsigned long long tc0_ = __builtin_amdgcn_s_memrealtime();
#endif
        LAS unsigned char* buf = F.lds + pbuf * dn::HC_BYTES;
        {
            if (k + 1 < 32) DN_LOAD(k + 1, pbuf ^ 1);
            if (k < 32) {
                const float dec = decs[k];
                f32x16 vn[2], o[2];
#pragma unroll
                for (int ct = 0; ct < 2; ++ct) {
                    o[ct] = (f32x16){0.f, 0.f, 0.f, 0.f, 0.f, 0.f, 0.f, 0.f, 0.f, 0.f, 0.f, 0.f, 0.f, 0.f, 0.f, 0.f};
#pragma unroll
                    for (int s2 = 0; s2 < 2; ++s2) { const u32x4 x = *(const LAS u32x4*)(buf + dn::OFF_U + ((ct * 4 + wv) * 2 + s2) * 1024 + lane * 16);
                        vn[ct][8 * s2] = bflo(x.x); vn[ct][8 * s2 + 1] = bfhi(x.x); vn[ct][8 * s2 + 2] = bflo(x.y); vn[ct][8 * s2 + 3] = bfhi(x.y);
                        vn[ct][8 * s2 + 4] = bflo(x.z); vn[ct][8 * s2 + 5] = bfhi(x.z); vn[ct][8 * s2 + 6] = bflo(x.w); vn[ct][8 * s2 + 7] = bfhi(x.w); }
                }
#define DN_F(off) (*(const LAS bf16x8*)(buf + (off) + lane * 16))
#define DN_WQ(ct, st) ((((ct) * 4 + ((st) >> 1)) * 2 + ((st) & 1)) * 1024)
                bf16x8 fa[4], fb[6];
                fa[0] = DN_F(dn::OFF_W + DN_WQ(0, 0)); fa[1] = DN_F(dn::OFF_QG + DN_WQ(0, 0)); fa[2] = DN_F(dn::OFF_W + DN_WQ(1, 0)); fa[3] = DN_F(dn::OFF_QG + DN_WQ(1, 0));
#pragma unroll
                for (int st = 0; st < 8; ++st) {
                    const int tau = st >> 1, s2 = st & 1;
                    if (st < 7) { fb[0] = DN_F(dn::OFF_W + DN_WQ(0, st + 1)); fb[1] = DN_F(dn::OFF_QG + DN_WQ(0, st + 1)); fb[2] = DN_F(dn::OFF_W + DN_WQ(1, st + 1)); fb[3] = DN_F(dn::OFF_QG + DN_WQ(1, st + 1)); }
                    else { fb[0] = DN_F(dn::OFF_AI + 0 * 1024); fb[1] = DN_F(dn::OFF_AI + 4 * 1024); fb[2] = DN_F(dn::OFF_KD + 0 * 1024); fb[3] = DN_F(dn::OFF_KD + 4 * 1024); fb[4] = DN_F(dn::OFF_KD + 8 * 1024); fb[5] = DN_F(dn::OFF_KD + 12 * 1024); }
                    __builtin_amdgcn_sched_barrier(0);
                    const bf16x8 sf = pack8m(S[tau][8 * s2], S[tau][8 * s2 + 1], S[tau][8 * s2 + 2], S[tau][8 * s2 + 3], S[tau][8 * s2 + 4], S[tau][8 * s2 + 5], S[tau][8 * s2 + 6], S[tau][8 * s2 + 7]);
                    vn[0] = MFMA32(fa[0], sf, vn[0]); o[0] = MFMA32(fa[1], sf, o[0]); vn[1] = MFMA32(fa[2], sf, vn[1]); o[1] = MFMA32(fa[3], sf, o[1]);
                    __builtin_amdgcn_sched_barrier(0);
                    if (st < 7) { fa[0] = fb[0]; fa[1] = fb[1]; fa[2] = fb[2]; fa[3] = fb[3]; }
                }
#pragma unroll
                for (int tau = 0; tau < 4; ++tau) S[tau] = S[tau] * dec;
                bf16x8 fc[6];
#pragma unroll
                for (int g = 0; g < 4; ++g) {
                    const int cm = g >> 1, s2 = g & 1;
                    if (g < 3) { const int cm1 = (g + 1) >> 1, s21 = (g + 1) & 1;
                        fc[0] = DN_F(dn::OFF_AI + ((cm1 * 2 + cm1) * 2 + s21) * 1024); fc[1] = DN_F(dn::OFF_AI + ((1 * 2 + cm1) * 2 + s21) * 1024);
#pragma unroll
                        for (int tau = 0; tau < 4; ++tau) fc[2 + tau] = DN_F(dn::OFF_KD + ((tau * 2 + cm1) * 2 + s21) * 1024); }
                    __builtin_amdgcn_sched_barrier(0);
                    const bf16x8 vf = pack8m(vn[cm][8 * s2], vn[cm][8 * s2 + 1], vn[cm][8 * s2 + 2], vn[cm][8 * s2 + 3], vn[cm][8 * s2 + 4], vn[cm][8 * s2 + 5], vn[cm][8 * s2 + 6], vn[cm][8 * s2 + 7]);
                    if (cm == 0) o[0] = MFMA32(fb[0], vf, o[0]);
                    o[1] = MFMA32(fb[1], vf, o[1]);
#pragma unroll
                    for (int tau = 0; tau < 4; ++tau) S[tau] = MFMA32(fb[2 + tau], vf, S[tau]);
                    __builtin_amdgcn_sched_barrier(0);
                    if (g < 3) {
#pragma unroll
                        for (int q = 0; q < 6; ++q) fb[q] = fc[q]; }
                }
#undef DN_F
#undef DN_WQ
                LDS_WAIT(); __builtin_amdgcn_sched_barrier(0); asm volatile("s_nop 15\n\ts_nop 3" ::: "memory"); __builtin_amdgcn_sched_barrier(0);
#pragma unroll
                for (int ct = 0; ct < 2; ++ct)
#pragma unroll
                    for (int i = 0; i < 16; i += 2) { const int c = 32 * ct + crow(i, hh), q = c >> 4; const unsigned u2 = pk2(o[ct][i], o[ct][i + 1]);
                        LAS unsigned char* wp = buf + dn::OFF_U + (((q >> 1) * 4 + wv) * 2 + (q & 1)) * 1024 + (c & 15) * 64 + (lane & 31) * 2;
                        *(LAS unsigned short*)wp = (unsigned short)u2; *(LAS unsigned short*)(wp + 64) = (unsigned short)(u2 >> 16); }
            }
        }
#ifdef PROBE_SCANC
        { const unsigned long long tc1_ = __builtin_amdgcn_s_memrealtime(); const unsigned long long d_ = tc1_ - tc0_; while (__builtin_amdgcn_s_memrealtime() - tc1_ < d_) __builtin_amdgcn_s_sleep(2); }
#endif
        asm volatile("s_waitcnt vmcnt(0)" ::: "memory");
        lds_barrier();
    }
    } else {
    u32x4 heldN[4], zN[4];
#pragma unroll
    for (int i = 0; i < 4; ++i) { heldN[i] = (u32x4){0u, 0u, 0u, 0u}; zN[i] = heldN[i]; }
    unsigned td0 = 0u, td1 = 0u, td2 = 0u;
    for (int k = 0; k < 34; ++k) {
        const int pbuf = k & 1;
#ifdef PROBE_SCANH
        const unsigned long long th0_ = __builtin_amdgcn_s_memrealtime();
#endif
        const bool rows = (k >= 1 && k <= 32);
        if (rows) {
            const int nn = k - 1; LAS unsigned char* pb = F.lds + (nn & 1) * dn::HC_BYTES;
            const int q = lane >> 4; const LAS unsigned char* rp = pb + dn::OFF_U + (((q >> 1) * 4 + w4) * 2 + (q & 1)) * 1024 + (lane & 15) * 64;
            float ssq = 0.f;
#pragma unroll
            for (int i = 0; i < 4; ++i) { const u32x4 hv = *(const LAS u32x4*)(rp + 16 * i); heldN[i] = hv;
                ssq += bflo(hv.x) * bflo(hv.x) + bfhi(hv.x) * bfhi(hv.x) + bflo(hv.y) * bflo(hv.y) + bfhi(hv.y) * bfhi(hv.y)
                     + bflo(hv.z) * bflo(hv.z) + bfhi(hv.z) * bfhi(hv.z) + bflo(hv.w) * bflo(hv.w) + bfhi(hv.w) * bfhi(hv.w); }
            part[((nn & 1) * 64 + lane) * 4 + w4] = ssq;
        }
        LDS_WAIT(); asm volatile("" ::: "memory");
        if (k + 1 < 32) DN_LOAD(k + 1, pbuf ^ 1);
        __builtin_amdgcn_sched_barrier(0);
        if (rows) { const bf16_t* zp = P + (size_t)(b * SEQ + (k - 1) * 64 + lane) * PLD + P_DNZ + h * 128 + 32 * w4;
#pragma unroll
            for (int i = 0; i < 4; ++i) zN[i] = *(const u32x4*)(zp + 8 * i); }
        __builtin_amdgcn_sched_barrier(0);
#ifdef SCAN_TOUCH_ON
        if (k + 2 < 32) {
            const unsigned char* tb = blk0 + (size_t)(k + 2) * hc_stride + (size_t)(w4 * 144) * 128;
            const unsigned char* a0 = tb + lane * 128; const unsigned char* a1 = tb + (64 + lane) * 128; const unsigned char* a2 = tb + (128 + (lane & 15)) * 128;
            asm volatile("; SCAN_TOUCH\n\tglobal_load_dword %0, %3, off\n\tglobal_load_dword %1, %4, off\n\tglobal_load_dword %2, %5, off" : "+v"(td0), "+v"(td1), "+v"(td2) : "v"(a0), "v"(a1), "v"(a2) : "memory");
        }
        __builtin_amdgcn_sched_barrier(0);
#endif
        u32x4 wo[4];
        if (k >= 2) {
            const int nn = k - 2; const f32x4 p4 = *(const LAS f32x4*)(part + ((nn & 1) * 64 + lane) * 4);
            const float rs = rsqrtf(((p4.x + p4.y) + (p4.z + p4.w)) * (1.f / 128.f) + EPS);
#pragma unroll
            for (int q = 0; q < 4; ++q) { const u32x4 zz = zO[q], hv = heldO[q]; const f32x4 ga = *(const LAS f32x4*)(gnl + 32 * w4 + 8 * q), gb = *(const LAS f32x4*)(gnl + 32 * w4 + 8 * q + 4);
                wo[q].x = pk2(bflo(hv.x) * rs * ga.x * siluf_(bflo(zz.x)), bfhi(hv.x) * rs * ga.y * siluf_(bfhi(zz.x)));
                wo[q].y = pk2(bflo(hv.y) * rs * ga.z * siluf_(bflo(zz.y)), bfhi(hv.y) * rs * ga.w * siluf_(bfhi(zz.y)));
                wo[q].z = pk2(bflo(hv.z) * rs * gb.x * siluf_(bflo(zz.z)), bfhi(hv.z) * rs * gb.y * siluf_(bfhi(zz.z)));
                wo[q].w = pk2(bflo(hv.w) * rs * gb.z * siluf_(bflo(zz.w)), bfhi(hv.w) * rs * gb.w * siluf_(bfhi(zz.w))); }
        }
#ifdef SCAN_TOUCH_ON
        if (k + 2 < 32) asm volatile("; SCAN_E\n\ts_waitcnt vmcnt(3)" ::: "memory"); else
#endif
        asm volatile("s_waitcnt vmcnt(0)" ::: "memory");
        if (k >= 2) { bf16_t* zp = P + (size_t)(b * SEQ + (k - 2) * 64 + lane) * PLD + P_DNZ + h * 128 + 32 * w4;
#pragma unroll
            for (int q = 0; q < 4; ++q) *(u32x4*)(zp + 8 * q) = wo[q]; }
#pragma unroll
        for (int i = 0; i < 4; ++i) { heldO[i] = heldN[i]; zO[i] = zN[i]; }
#ifdef PROBE_SCANH
        { const unsigned long long th1_ = __builtin_amdgcn_s_memrealtime(); const unsigned long long d_ = th1_ - th0_; while (__builtin_amdgcn_s_memrealtime() - th1_ < d_) __builtin_amdgcn_s_sleep(2); }
#endif
        lds_barrier();
    }
    asm volatile("s_waitcnt vmcnt(0)" : "+v"(td0), "+v"(td1), "+v"(td2) :: "memory");
    }
#undef DN_LOAD
#undef DN_PIECE
}

DI void final_norm(int wv) {
    const Frame F = mkframe(wv);
    const ArgsP ap = kargs();
    const float* ss = (const float*)(ap->ws + WS_SS);
    for (int m = F.gw; m < T; m += F.NGW) {
        const f32x4 s = *(const f32x4*)(ss + (size_t)m * 4); const float rs = rsqrtf(((s.x + s.y) + (s.z + s.w)) * (1.f / D) + EPS);
        f32x4* xr = (f32x4*)(ap->out + (size_t)m * D) + F.lane; const f32x4* gr = (const f32x4*)ap->final_norm_g + F.lane;
#pragma unroll
        for (int j = 0; j < 4; ++j) { const f32x4 v = xr[64 * j], g = gr[64 * j]; xr[64 * j] = v * rs * g; }
    }
}

__global__ void __launch_bounds__(NTHREADS, 2) mk_fwd(Args args) {
    extern __shared__ __attribute__((aligned(16))) unsigned char lds_raw[];
    LAS unsigned char* const lds = (LAS unsigned char*)lds_raw;
    volatile LAS unsigned* MISC = (volatile LAS unsigned*)(lds + MISC_OFF);
    const int wv = __builtin_amdgcn_readfirstlane((int)threadIdx.x >> 6);
    { const int t0 = opaque_tid(wv); for (int u = t0; u < (LDS_BYTES - LDSCTL_OFF) / 4; u += NTHREADS) ((LAS unsigned*)(lds + LDSCTL_OFF))[u] = 0u; }
    __syncthreads();
    const int G = gridDim.x;
    XcdBarrier bar; bar.bar = (unsigned*)(args.ws + WS_CTL) + CW_BAR + args.li * XCD_BAR_WORDS; bar.x = 0; bar.st = nullptr;
    if (args.ph_hi - args.ph_lo > 1) bar = xcd_barrier_post(bar.bar, MISC + 8, wv);
#define IN(k) (kargs()->ph_lo <= (k) && (k) < kargs()->ph_hi)
#ifdef PROBE_SUB
    unsigned long long ts_prev_ = 0;
#define SUBSEAM(bit) do { xcd_barrier(bar, wv); { const unsigned long long t1_ = __builtin_amdgcn_s_memrealtime(); \
        if ((PROBE_SUB >> (bit)) & 1u) { const unsigned long long d_ = t1_ - ts_prev_; while (__builtin_amdgcn_s_memrealtime() - t1_ < d_) __builtin_amdgcn_s_sleep(8); } \
        ts_prev_ = __builtin_amdgcn_s_memrealtime(); } } while (0)
#define SUBSTART() do { ts_prev_ = __builtin_amdgcn_s_memrealtime(); } while (0)
#else
#define SUBSEAM(bit) do { } while (0)
#define SUBSTART() do { } while (0)
#endif
#ifdef PROBE_ECHO
    unsigned long long t_prev_ = __builtin_amdgcn_s_memrealtime();
#define SEAM(k) do { if (IN(k) && IN((k) + 1)) xcd_barrier(bar, wv); { const unsigned long long t1_ = __builtin_amdgcn_s_memrealtime(); \
        if ((PROBE_ECHO >> (k)) & 1u) { const unsigned long long d_ = t1_ - t_prev_; while (__builtin_amdgcn_s_memrealtime() - t1_ < d_) __builtin_amdgcn_s_sleep(8); } \
        t_prev_ = __builtin_amdgcn_s_memrealtime(); } } while (0)
#else
#define SEAM(k) do { if (IN(k) && IN((k) + 1)) xcd_barrier(bar, wv); } while (0)
#endif
#define MK_EPI(E) gm::Epi E; E.ws = kargs()->ws; E.xin = nullptr; E.xout = nullptr; E.wout32 = false; E.b_gate = nullptr; E.pos = nullptr; E.mrgp = nullptr; E.gnext = nullptr; E.gfinal = nullptr; E.scr_alt = (unsigned char*)kargs()->out + 44 * MiB; E.spare = (LAS float*)(lds + SPARE_OFF);

#if !defined(ONLY_PH) || ONLY_PH == 0
    if (IN(0)) { p0_prologue(wv); }
#endif
    SEAM(0);

    for (int l0 = 0; l0 < DEPTH; ++l0) {
        int l = l0; asm volatile("" : "+s"(l));
        const int pb = 1 + 6 * l;
#if !defined(ONLY_PH) || ONLY_PH == 1
        if (IN(pb)) { MK_EPI(E); SchedP1 S; S.ord.init(64, 12, G, opaque_bid()); S.ws = kargs()->ws; S.l = l; S.half = 0; S.c = opaque_bid(); S.with_kvm = false; E.pos = kargs()->positions;
            gm::gemm_phase<AUX_P1>(lds, wv, S, E);
#ifdef PROBE_DUP_GEMM
            xcd_barrier(bar, wv); gm::gemm_phase<AUX_P1>(lds, wv, S, E);
#endif
            }
#endif
        SEAM(pb);
#if !defined(ONLY_PH) || ONLY_PH == 2
        if (IN(pb + 1)) {
            SUBSTART();
            SUBSEAM(0);
            for (int pair = opaque_bid(); pair < 512; pair += G) dn_prep(wv, l, pair);
            SUBSEAM(1);
            if (l > 0) { const Frame Fm = mkframe(wv); memn_rows(Fm, kargs(), l); }
 }
#endif
        SEAM(pb + 1);
#if !defined(ONLY_PH) || ONLY_PH == 3
        if (IN(pb + 2)) {
            if (opaque_bid() < 32 && G > 64) dn_scan(wv, l, opaque_bid());
            else { const bool split = G > 64; MK_EPI(E); SchedP1 S; S.ord.init(64, 12, split ? G - 32 : G, split ? opaque_bid() - 32 : opaque_bid()); S.ws = kargs()->ws; S.l = l; S.half = 1; S.c = opaque_bid(); S.with_kvm = true;
                gm::gemm_phase<AUX_P1>(lds, wv, S, E);
#ifdef PROBE_DUP_GEMM
                xcd_barrier(bar, wv); gm::gemm_phase<AUX_P1>(lds, wv, S, E);
#endif
                { const int cp = opaque_bid() - 32; const Frame Fc = mkframe(wv);
                  const int nsh = cp >= 112 ? 3 : 1, sh0 = cp >= 112 ? 3 * (cp - 112) : 336 + cp;
                  for (int q = 0; q < nsh; ++q) { const int first = (sh0 + q) * NWAVES + wv, stride = 448 * NWAVES;
                      if (l == 0) convert_weights(Fc, kargs(), 0, first, stride, 2);
                      if (l + 1 < DEPTH) convert_weights(Fc, kargs(), l + 1, first, stride, 0); } }
                if (split && l + 1 == DEPTH) { const int cp = opaque_bid() - 32; MK_EPI(E3); gm::TileOrder ord; ord.init(64, 4, G, opaque_bid()); SchedP3 S3; S3.mode = 1; S3.ok = ord.tile(0, S3.pm, S3.pn); S3.l = l; S3.rot = (opaque_bid() >> 3) & 3; S3.ws = kargs()->ws;
                    if (cp >= 112 && cp < 144) { gm::TileOrder o2; o2.init(64, 4, G, cp - 112); S3.ok2 = o2.tile(0, S3.pm2, S3.pn2); S3.rot2 = ((cp - 112) >> 3) & 3; }
                    E3.b_gate = kargs()->b_gate;
                    if (S3.ok) gm::gemm_phase<AUX_P3>(lds, wv, S3, E3); }
            }
            if (G <= 64) { for (int bh = opaque_bid(); bh < 32; bh += G) dn_scan(wv, l, bh); }
        }
#endif
        SEAM(pb + 2);
#if !defined(ONLY_PH) || ONLY_PH == 4
        if (IN(pb + 3)) {
            const int wg = opaque_bid();

            unsigned* head = (unsigned*)(kargs()->ws + WS_CTL) + CW_QUEUE + 64 * l;
            volatile LAS unsigned* qslot = (volatile LAS unsigned*)(lds + MISC_OFF + 64);
            for (;;) {
#ifdef PROBE_FETCH
                const unsigned long long tf0_ = __builtin_amdgcn_s_memrealtime();
#endif
                if (opaque_tid(wv) == 0) qslot[0] = __hip_atomic_fetch_add(head, 1u, __ATOMIC_RELAXED, __HIP_MEMORY_SCOPE_AGENT);
                __syncthreads();
                const int unit = (int)qslot[0];
                __syncthreads();
#ifdef PROBE_FETCH
                { const unsigned long long tf1_ = __builtin_amdgcn_s_memrealtime(); const unsigned long long d_ = tf1_ - tf0_; while (__builtin_amdgcn_s_memrealtime() - tf1_ < d_) __builtin_amdgcn_s_sleep(2); }
#endif
                if (unit >= 1248) break;
#ifdef PROBE_UNIT
                const unsigned long long tu0_ = __builtin_amdgcn_s_memrealtime();
#endif
                if (unit < 224) ret_state_unit(wv, l, unit); else if (unit < 480) attn_unit<1>(wv, l, unit - 224); else if (unit < 992) attn_unit<0>(wv, l, unit - 480); else mem_unit(wv, l, unit - 992);
#ifdef PROBE_UNIT
                { const unsigned long long tu1_ = __builtin_amdgcn_s_memrealtime(); if (PROBE_UNIT >= 2 ? (tu1_ - tu0_ > (unsigned long long)PROBE_UNIT * 100ull) : ((unit < 256) == (PROBE_UNIT == 1))) { const unsigned long long d_ = tu1_ - tu0_; while (__builtin_amdgcn_s_memrealtime() - tu1_ < d_) __builtin_amdgcn_s_sleep(8); } }
#endif
            }
        }
#endif
#ifdef KEEP_SEAM3
        SEAM(pb + 3);
#endif
#if !defined(ONLY_PH) || ONLY_PH == 5
        if (IN(pb + 4)) { MK_EPI(E); gm::TileOrder ord; ord.init(64, 4, G, opaque_bid()); SchedP3 S; S.ok = ord.tile(0, S.pm, S.pn); S.l = l; S.rot = (opaque_bid() >> 3) & 3; S.mode = (G > 64 && l + 1 == DEPTH) ? 2 : 0; S.ws = kargs()->ws; E.b_gate = kargs()->b_gate; E.mrgp = (unsigned char*)kargs()->out + 8 * MiB;
            gm::gemm_phase<AUX_P3>(lds, wv, S, E);
#ifdef PROBE_DUP_GEMM
            xcd_barrier(bar, wv); gm::gemm_phase<AUX_P3>(lds, wv, S, E);
#endif
            }
#endif
        SEAM(pb + 4);
#if !defined(ONLY_PH) || ONLY_PH == 6
        if (IN(pb + 5)) { MK_EPI(E); gm::TileOrder ord; ord.init(64, 4, G, opaque_bid()); SchedP4 S; S.ok = ord.tile(0, S.pm, S.pn); S.l = l; S.ws = kargs()->ws;
            E.gnext = (l + 1 < DEPTH) ? kargs()->norm_g + (size_t)(l + 1) * D : nullptr;
            E.gfinal = (l + 1 < DEPTH || G != 256) ? nullptr : kargs()->final_norm_g;
            E.xout = kargs()->out; E.xin = (l == 0) ? kargs()->x : (const float*)kargs()->out;
            E.wout32 = (l + 1 == DEPTH) && G != 256;
            gm::gemm_phase<AUX_P4>(lds, wv, S, E); }
#endif
        if (!(l + 1 == DEPTH && G == 256)) SEAM(pb + 5);
    }
#if !defined(ONLY_PH) || ONLY_PH == 13
    if (IN(13) && G != 256) final_norm(wv);
#endif
#undef IN
#undef SEAM
#undef MK_EPI
}

extern "C" void kernel_launch(void* const* d_in, const int* in_sizes, int n_in, void* d_out, int out_size, void* d_ws, size_t ws_size, hipStream_t stream) {
    static int grid = 0;
    if (grid == 0) {
        if (n_in != 19 || out_size != T * D || ws_size < WS_END) { fprintf(stderr, "kernel_launch: unexpected problem (n_in %d, out %d, ws %zu)\n", n_in, out_size, ws_size); grid = -1; return; }
        int dev = 0, cus = 0, per_cu = 0;
        if (hipGetDevice(&dev) != hipSuccess || hipDeviceGetAttribute(&cus, hipDeviceAttributeMultiprocessorCount, dev) != hipSuccess) { grid = -1; return; }
        if (hipFuncSetAttribute((const void*)mk_fwd, hipFuncAttributeMaxDynamicSharedMemorySize, LDS_BYTES) != hipSuccess) { fprintf(stderr, "kernel_launch: hipFuncSetAttribute failed\n"); grid = -1; return; }
        if (hipOccupancyMaxActiveBlocksPerMultiprocessor(&per_cu, (const void*)mk_fwd, NTHREADS, LDS_BYTES) != hipSuccess || per_cu < 1)
            fprintf(stderr, "kernel_launch: occupancy query reports %d workgroups per CU\n", per_cu);
        (void)hipGetLastError();
        grid = cus;
    }
    if (grid < 0) return;
    if (hipMemsetAsync((char*)d_ws + WS_CTL, 0, CTL_ZERO_BYTES, stream) != hipSuccess) return;
    Args a{};
    a.x = (const float*)d_in[0]; a.mem = (const float*)d_in[1]; a.positions = (const int*)d_in[2]; a.norm_g = (const float*)d_in[3]; a.mem_norm_g = (const float*)d_in[4];
    a.w_in = (const float*)d_in[5]; a.b_gate = (const float*)d_in[6]; a.dn_conv_w = (const float*)d_in[7]; a.dn_a_log = (const float*)d_in[8]; a.dn_dt_bias = (const float*)d_in[9];
    a.dn_norm_g = (const float*)d_in[10]; a.ret_norm_g = (const float*)d_in[11]; a.w_mem_kv = (const float*)d_in[12]; a.w_br_sb = (const float*)d_in[13]; a.w_br_dn = (const float*)d_in[14];
    a.w_br_ret = (const float*)d_in[15]; a.w_br_mem = (const float*)d_in[16]; a.w_out = (const float*)d_in[17]; a.final_norm_g = (const float*)d_in[18];
    a.out = (float*)d_out; a.ws = (unsigned char*)d_ws;
#if MK_N_LAUNCHES == 1
    a.ph_lo = 0; a.ph_hi = NPHASE; a.li = 0;
    hipLaunchKernelGGL(mk_fwd, dim3(grid), dim3(NTHREADS), LDS_BYTES, stream, a);
#else
    for (int p = 0; p < NPHASE; ++p) { a.ph_lo = p; a.ph_hi = p + 1; a.li = 0;
        hipLaunchKernelGGL(mk_fwd, dim3(grid), dim3(NTHREADS), LDS_BYTES, stream, a); }
#endif
}
```
